# Optimizing an MI355X kernel written in HIP

```python
import jax
import jax.numpy as jnp
from jax import lax
import numpy as np

D_MODEL = 1024
BATCH = 8
SEQ = 2048
DEPTH = 2

MEM_LEN = 256
N_ATT_HEADS = 8
ATT_HEAD_DIM = 64
ATT_WIDTH = N_ATT_HEADS * ATT_HEAD_DIM
N_RWKV_HEADS = 8
RWKV_HEAD_DIM = 64
RWKV_WIDTH = N_RWKV_HEADS * RWKV_HEAD_DIM
MIX_WIDTH = ATT_WIDTH + RWKV_WIDTH
MOBA_BLOCK = 256
MOBA_TOP_BLOCKS = 3
MOBA_Q_CHUNK = 16
DECAY_LORA = 64
ICLR_LORA = 64
VRES_LORA = 32
GATE_LORA = 128
RWKV_GN_EPS = 64e-5
N_MEM_HEADS = 4
MEM_HEAD_DIM = D_MODEL // N_MEM_HEADS
N_EXPERTS = 32
N_EXPERT_GROUPS = 8
EXPERTS_PER_GROUP = N_EXPERTS // N_EXPERT_GROUPS
TOP_K = 2
D_EXPERT = 512
MOE_ROW_BLOCK = 128
LN_EPS = 1e-5
RMS_EPS = 1e-6
NEG_INF = -1e30
DEEPNORM_ALPHA = (2 * DEPTH) ** 0.25
DEEPNORM_BETA = (8 * DEPTH) ** -0.25
SHIFT_COLS = 3 * RWKV_WIDTH + DECAY_LORA + ICLR_LORA + GATE_LORA
IN_COLS = 3 * ATT_WIDTH + SHIFT_COLS
RWKV_SPLITS = (RWKV_WIDTH, 2 * RWKV_WIDTH, 3 * RWKV_WIDTH, 3 * RWKV_WIDTH + DECAY_LORA, 3 * RWKV_WIDTH + DECAY_LORA + ICLR_LORA)

kernel_name = 'hybrid_moba_rwkv7_moe_deepnorm'


def layer_norm(x, g, b):
    xf = x.astype(jnp.float32)
    mu = jnp.mean(xf, -1, keepdims=True)
    var = jnp.mean(jnp.square(xf - mu), -1, keepdims=True)
    return ((xf - mu) * lax.rsqrt(var + LN_EPS) * g + b).astype(x.dtype)


def alibi_slopes(n_heads):
    return 2.0 ** (-8.0 * jnp.arange(1, n_heads + 1, dtype=jnp.float32) / n_heads)


def token_shift(z):
    return jnp.pad(z, ((0, 0), (1, 0), (0, 0)))[:, :-1]


def moba_attention(q, k, v):
    B, S, H, hd = q.shape
    nb = -(-S // MOBA_BLOCK)
    s_pad = nb * MOBA_BLOCK
    ksel = max(1, min(MOBA_TOP_BLOCKS, nb - 1))
    pad = ((0, 0), (0, 0), (0, s_pad - S), (0, 0))
    qh = jnp.pad(q.transpose(0, 2, 1, 3), pad) * hd ** -0.5
    kh = jnp.pad(k.transpose(0, 2, 1, 3), pad)
    vh = jnp.pad(v.transpose(0, 2, 1, 3), pad)
    kb = kh.reshape(B, H, nb, MOBA_BLOCK, hd)
    vb = vh.reshape(B, H, nb, MOBA_BLOCK, hd)
    kmean = jnp.mean(kb, axis=3)
    slopes = alibi_slopes(H)[None, :, None, None]
    bi = jnp.arange(B)[:, None, None, None]
    hi = jnp.arange(H)[None, :, None, None]
    blk_ids = jnp.arange(nb)
    offs = jnp.arange(MOBA_BLOCK)
    n_sel = ksel * MOBA_BLOCK

    def chunk(start):
        cur = start // MOBA_BLOCK
        pos_q = start + jnp.arange(MOBA_Q_CHUNK)
        qc = lax.dynamic_slice(qh, (0, 0, start, 0), (B, H, MOBA_Q_CHUNK, hd))
        gate = jnp.einsum('bhqd,bhnd->bhqn', qc, kmean)
        gate = jnp.where(blk_ids < cur, gate, NEG_INF)
        _, idx = lax.top_k(gate, ksel)
        valid = jnp.arange(ksel) < cur
        k_sel = kb[bi, hi, idx]
        v_sel = vb[bi, hi, idx]
        s_sel = jnp.einsum('bhqd,bhqnld->bhqnl', qc, k_sel)
        dist_sel = pos_q[:, None, None] - (idx[..., None] * MOBA_BLOCK + offs)
        s_sel = jnp.where(valid[:, None], s_sel - slopes[..., None] * dist_sel, NEG_INF)
        k_own = lax.dynamic_slice(kh, (0, 0, cur * MOBA_BLOCK, 0), (B, H, MOBA_BLOCK, hd))
        v_own = lax.dynamic_slice(vh, (0, 0, cur * MOBA_BLOCK, 0), (B, H, MOBA_BLOCK, hd))
        dist_own = pos_q[:, None] - (cur * MOBA_BLOCK + offs)[None, :]
        s_own = jnp.einsum('bhqd,bhld->bhql', qc, k_own)
        s_own = jnp.where(dist_own >= 0, s_own - slopes * dist_own, NEG_INF)
        logits = jnp.concatenate([s_sel.reshape(B, H, MOBA_Q_CHUNK, n_sel), s_own], axis=-1)
        p = jax.nn.softmax(logits, axis=-1)
        p_sel = p[..., :n_sel].reshape(B, H, MOBA_Q_CHUNK, ksel, MOBA_BLOCK)
        p_own = p[..., n_sel:]
        return (jnp.einsum('bhqnl,bhqnld->bhqd', p_sel, v_sel)
                + jnp.einsum('bhql,bhld->bhqd', p_own, v_own))

    starts = jnp.arange(0, s_pad, MOBA_Q_CHUNK)
    out = lax.map(chunk, starts)
    out = out.transpose(1, 2, 0, 3, 4).reshape(B, H, s_pad, hd)[:, :, :S]
    return out.transpose(0, 2, 1, 3)


def rwkv7_recurrence(r, w, k, v, a, b):
    B, S, H, hd = r.shape

    def step(state, inp):
        r_t, w_t, k_t, v_t, a_t, b_t = inp
        sa = jnp.einsum('bhij,bhj->bhi', state, a_t)
        state = (state * w_t[:, :, None, :] + sa[..., None] * b_t[:, :, None, :]
                 + v_t[..., None] * k_t[:, :, None, :])
        return state, jnp.einsum('bhij,bhj->bhi', state, r_t)

    xs = tuple(t.transpose(1, 0, 2, 3) for t in (r, w, k, v, a, b))
    _, y = lax.scan(step, jnp.zeros((B, H, hd, hd), jnp.float32), xs)
    return y.transpose(1, 0, 2, 3)


def rwkv7_time_mix(r, k, v, zw, za, zg, w0, w_decay_up, a0, w_iclr_up, w_gate_up,
                   k_k, k_a, r_k, lnx_g, lnx_b):
    B, S, _ = r.shape
    H, hd = N_RWKV_HEADS, RWKV_HEAD_DIM
    log_w = -jax.nn.softplus(-(w0 + jnp.tanh(zw) @ w_decay_up)) - 0.5
    decay = jnp.exp(-jnp.exp(log_w))
    a = jax.nn.sigmoid(a0 + za @ w_iclr_up)
    g = jax.nn.sigmoid(zg) @ w_gate_up
    heads = lambda t: t.reshape(B, S, H, hd)
    kk = heads(k * k_k)
    kk = kk * lax.rsqrt(jnp.maximum(jnp.sum(kk * kk, -1, keepdims=True), 1e-24))
    k = heads(k * (1.0 + (a - 1.0) * k_a))
    r, v, a = heads(r), heads(v), heads(a)
    y = rwkv7_recurrence(r, heads(decay), k, v, -kk, kk * a)
    mu = jnp.mean(y, -1, keepdims=True)
    var = jnp.mean(jnp.square(y - mu), -1, keepdims=True)
    y = ((y - mu) * lax.rsqrt(var + RWKV_GN_EPS)).reshape(B, S, RWKV_WIDTH) * lnx_g + lnx_b
    bonus = (jnp.sum(r * k * r_k, -1, keepdims=True) * v).reshape(B, S, RWKV_WIDTH)
    return (y + bonus) * g


def memory_cross_attention(x, mem, w_q, w_kv, w_o):
    B, S, D = x.shape
    q = (x @ w_q).reshape(B, S, N_MEM_HEADS, MEM_HEAD_DIM).astype(jnp.float32)
    kv = (mem @ w_kv).reshape(B, mem.shape[1], 2, N_MEM_HEADS, MEM_HEAD_DIM).astype(jnp.float32)
    s = jnp.einsum('bshd,bmhd->bhsm', q, kv[:, :, 0]) * MEM_HEAD_DIM ** -0.5
    p = jax.nn.softmax(s, axis=-1)
    o = jnp.einsum('bhsm,bmhd->bshd', p, kv[:, :, 1]).reshape(B, S, D).astype(x.dtype)
    return o @ w_o


def route(xf, w_router, b_router):
    s = jax.nn.sigmoid((xf @ w_router).astype(jnp.float32))
    sel = s + b_router.astype(jnp.float32)
    grp = jnp.sum(lax.top_k(sel.reshape(-1, N_EXPERT_GROUPS, EXPERTS_PER_GROUP), 2)[0], -1)
    g_best = jnp.argmax(grp, axis=-1)
    in_grp = (jnp.arange(N_EXPERTS) // EXPERTS_PER_GROUP)[None, :] == g_best[:, None]
    _, e_idx = lax.top_k(jnp.where(in_grp, sel, NEG_INF), TOP_K)
    w = jnp.take_along_axis(s, e_idx, axis=-1)
    return e_idx, w / jnp.sum(w, -1, keepdims=True)


def moe_ffn(xf, e_idx, gate, w_gate, w_up, w_down):
    N, D = xf.shape
    A = N * TOP_K
    eid = e_idx.reshape(-1)
    tok = jnp.repeat(jnp.arange(N), TOP_K)
    gt = gate.reshape(-1)
    order = jnp.argsort(eid)
    eid_s, tok_s, gt_s = eid[order], tok[order], gt[order]
    counts = jnp.bincount(eid, length=N_EXPERTS)
    off = jnp.cumsum(counts) - counts
    pcounts = (counts + MOE_ROW_BLOCK - 1) // MOE_ROW_BLOCK * MOE_ROW_BLOCK
    pend = jnp.cumsum(pcounts)
    poff = pend - pcounts
    dest = poff[eid_s] + (jnp.arange(A) - off[eid_s])
    M = A + N_EXPERTS * MOE_ROW_BLOCK
    n_blk = M // MOE_ROW_BLOCK
    row_tok = jnp.full((M,), N, jnp.int32).at[dest].set(tok_s.astype(jnp.int32))
    row_gate = jnp.zeros((M,), xf.dtype).at[dest].set(gt_s)
    blk_expert = jnp.minimum(jnp.searchsorted(pend, jnp.arange(n_blk) * MOE_ROW_BLOCK, side='right'), N_EXPERTS - 1)
    x_rows = jnp.concatenate([xf, jnp.zeros((1, D), xf.dtype)], 0)[row_tok]
    x_rows = x_rows.reshape(n_blk, MOE_ROW_BLOCK, D)

    def expert_block(args):
        xb, e = args
        h = jax.nn.silu(xb @ w_gate[e]) * (xb @ w_up[e])
        return h @ w_down[e]

    y = lax.map(expert_block, (x_rows, blk_expert)).reshape(M, D)
    return jax.ops.segment_sum(y * row_gate[:, None], row_tok, num_segments=N + 1)[:N]


def setup_inputs(seed: int = 0) -> dict:
    key = jax.random.key(seed)
    ks = iter(jax.random.split(key, 40))
    f32 = jnp.float32

    def nrm(shape, scale):
        return jax.random.normal(next(ks), shape, f32) * scale

    def unif(shape, lo, hi):
        return jax.random.uniform(next(ks), shape, f32, lo, hi)

    beta = DEEPNORM_BETA
    rv = 3 * ATT_WIDTH + 2 * RWKV_WIDTH
    col_scale = (jnp.ones((IN_COLS,), f32).at[2 * ATT_WIDTH:3 * ATT_WIDTH].set(beta)
                 .at[rv:rv + RWKV_WIDTH].set(beta))
    kv_scale = jnp.concatenate([jnp.ones((D_MODEL,), f32), jnp.full((D_MODEL,), beta, f32)])
    dm1 = max(DEPTH - 1, 0)
    return {
        'x': nrm((BATCH, SEQ, D_MODEL), 1.0),
        'mem': nrm((BATCH, MEM_LEN, D_MODEL), 1.0),
        'w_in': nrm((DEPTH, D_MODEL, IN_COLS), D_MODEL ** -0.5) * col_scale,
        'w_in_vres': nrm((dm1, D_MODEL, VRES_LORA), D_MODEL ** -0.5),
        'mu_shift': unif((DEPTH, SHIFT_COLS), 0.0, 1.0),
        'mu_vres': unif((dm1, VRES_LORA), 0.0, 1.0),
        'w0': unif((DEPTH, RWKV_WIDTH), -3.0, 0.0),
        'w_decay_up': nrm((DEPTH, DECAY_LORA, RWKV_WIDTH), 0.5 * DECAY_LORA ** -0.5),
        'a0': nrm((DEPTH, RWKV_WIDTH), 0.1),
        'w_iclr_up': nrm((DEPTH, ICLR_LORA, RWKV_WIDTH), ICLR_LORA ** -0.5),
        'v0': nrm((dm1, RWKV_WIDTH), 0.1),
        'w_vres_up': nrm((dm1, VRES_LORA, RWKV_WIDTH), VRES_LORA ** -0.5),
        'w_gate_up': nrm((DEPTH, GATE_LORA, RWKV_WIDTH), GATE_LORA ** -0.5),
        'k_k': 0.85 + nrm((DEPTH, RWKV_WIDTH), 0.05),
        'k_a': 1.0 + nrm((DEPTH, RWKV_WIDTH), 0.05),
        'r_k': nrm((DEPTH, N_RWKV_HEADS, RWKV_HEAD_DIM), 0.1),
        'lnx_g': 1.0 + nrm((DEPTH, RWKV_WIDTH), 0.05),
        'lnx_b': nrm((DEPTH, RWKV_WIDTH), 0.02),
        'attn_out_g': 1.0 + nrm((DEPTH, ATT_WIDTH), 0.05),
        'w_out': nrm((DEPTH, MIX_WIDTH, D_MODEL), beta * MIX_WIDTH ** -0.5),
        'w_mem_q': nrm((DEPTH, D_MODEL, D_MODEL), D_MODEL ** -0.5),
        'w_mem_kv': nrm((DEPTH, D_MODEL, 2 * D_MODEL), D_MODEL ** -0.5) * kv_scale,
        'w_mem_o': nrm((DEPTH, D_MODEL, D_MODEL), beta * D_MODEL ** -0.5),
        'w_router': nrm((D_MODEL, N_EXPERTS), D_MODEL ** -0.5),
        'b_router': nrm((N_EXPERTS,), 0.01),
        'w_exp_gate': nrm((DEPTH, N_EXPERTS, D_MODEL, D_EXPERT), D_MODEL ** -0.5),
        'w_exp_up': nrm((DEPTH, N_EXPERTS, D_MODEL, D_EXPERT), D_MODEL ** -0.5),
        'w_exp_down': nrm((DEPTH, N_EXPERTS, D_EXPERT, D_MODEL), beta * D_EXPERT ** -0.5),
        'ln_g': 1.0 + nrm((DEPTH, 3, D_MODEL), 0.05),
        'ln_b': nrm((DEPTH, 3, D_MODEL), 0.02),
    }


def reference(x, mem, w_in, w_in_vres, mu_shift, mu_vres, w0, w_decay_up, a0, w_iclr_up,
              v0, w_vres_up, w_gate_up, k_k, k_a, r_k, lnx_g, lnx_b, attn_out_g, w_out,
              w_mem_q, w_mem_kv, w_mem_o, w_router, b_router, w_exp_gate, w_exp_up,
              w_exp_down, ln_g, ln_b):
    B, S, D = x.shape
    f32 = jnp.float32
    v_first = None
    for l in range(DEPTH):
        w_comb = w_in[l] if l == 0 else jnp.concatenate([w_in[l], w_in_vres[l - 1]], axis=1)
        z = x @ w_comb
        att = z[..., :3 * ATT_WIDTH].astype(f32).reshape(B, S, 3, N_ATT_HEADS, ATT_HEAD_DIM)
        o_att = moba_attention(att[:, :, 0], att[:, :, 1], att[:, :, 2])
        o_att = (o_att * lax.rsqrt(jnp.mean(o_att * o_att, -1, keepdims=True) + RMS_EPS)
                 * attn_out_g[l].reshape(N_ATT_HEADS, ATT_HEAD_DIM)).reshape(B, S, ATT_WIDTH)
        zs = z[..., 3 * ATT_WIDTH:3 * ATT_WIDTH + SHIFT_COLS].astype(f32)
        zs = zs + (token_shift(zs) - zs) * mu_shift[l]
        r, kr, vr, zw, za, zg = jnp.split(zs, RWKV_SPLITS, axis=-1)
        if l == 0:
            v_first = vr
        else:
            zv = z[..., 3 * ATT_WIDTH + SHIFT_COLS:].astype(f32)
            zv = zv + (token_shift(zv) - zv) * mu_vres[l - 1]
            vr = vr + (v_first - vr) * jax.nn.sigmoid(v0[l - 1] + zv @ w_vres_up[l - 1])
        o_rwkv = rwkv7_time_mix(r, kr, vr, zw, za, zg, w0[l], w_decay_up[l], a0[l], w_iclr_up[l],
                                w_gate_up[l], k_k[l], k_a[l], r_k[l], lnx_g[l], lnx_b[l])
        mix = jnp.concatenate([o_att, o_rwkv], axis=-1).astype(x.dtype)
        x = layer_norm(DEEPNORM_ALPHA * x + mix @ w_out[l], ln_g[l, 0], ln_b[l, 0])
        x = layer_norm(DEEPNORM_ALPHA * x + memory_cross_attention(x, mem, w_mem_q[l], w_mem_kv[l], w_mem_o[l]),
                       ln_g[l, 1], ln_b[l, 1])
        xf = x.reshape(B * S, D)
        e_idx, gate = route(xf, w_router, b_router)
        y = moe_ffn(xf, e_idx, gate.astype(x.dtype), w_exp_gate[l], w_exp_up[l], w_exp_down[l])
        x = layer_norm(DEEPNORM_ALPHA * x + y.reshape(B, S, D), ln_g[l, 2], ln_b[l, 2])
    return x
```

```cpp
#include <hip/hip_runtime.h>
#include <stdint.h>
#include <cstring>

#ifndef MK_ONE_LAUNCH
#define MK_ONE_LAUNCH 1
#endif

namespace {
constexpr int NTHREADS = 512;
constexpr int NTOK = 16384, SEQ = 2048, NBATCH = 8, DM = 1024;
constexpr int MEMLEN = 256;
constexpr int NH = 8, HD = 64;
constexpr int IN_COLS = 3328, ZLD = 3360;
constexpr int C_Q = 0, C_K = 512, C_V = 1024, C_R = 1536, C_KR = 2048, C_VR = 2560, C_ZW = 3072, C_ZA = 3136, C_ZG = 3200, C_ZV = 3328;
constexpr int NEXP = 32, DEXP = 512;
constexpr int LCAP = 16384;
constexpr float ALPHA = 1.4142135623730951f;
constexpr float NEG_INF = -1e30f;
constexpr int LDS_BYTES = 147456;

constexpr size_t MiB = 1u << 20;
constexpr size_t WS_CTL = 0, CTL_ZERO_BYTES = 64 * 1024;
constexpr size_t WS_LIST = 2 * MiB;
constexpr size_t WS_TOKPOS = 10 * MiB;
constexpr size_t WS_KMEAN = 11 * MiB;
constexpr size_t WS_XL1 = 16 * MiB, WS_X1 = 80 * MiB, WS_X2 = 144 * MiB, WS_VFIRST = 208 * MiB;
constexpr size_t WS_Z = 240 * MiB, WS_MIX = 450 * MiB, WS_END = 514 * MiB;
constexpr size_t WS_RW = 80 * MiB, WS_RA = 112 * MiB, WS_RG = 144 * MiB, WS_RVG = 176 * MiB;
constexpr size_t WS_PRE = 240 * MiB, WS_Q = 304 * MiB, WS_O = 368 * MiB, WS_KV = 432 * MiB;
constexpr size_t WS_H = 240 * MiB, WS_Y = 312 * MiB;

constexpr int CW_CNT = 0;
constexpr int CW_BAR = 1024;

#define XB_TMO      128
#define XB_XCNT(j)  (256  + 64 * (j))
#define XB_XSUB(j)  (1280 + 64 * (j))
#define XB_XGEN(j)  (2304 + 64 * (j))
#define XB_TOP      3328
#define XB_TOPGEN   3392
#define XCD_BAR_WORDS 3456
#define XB_SPIN_CAP (1u << 18)
#define LAS __attribute__((address_space(3)))
__device__ __forceinline__ unsigned xb_ld(unsigned* p)              { return __hip_atomic_load(p, __ATOMIC_RELAXED, __HIP_MEMORY_SCOPE_AGENT); }
__device__ __forceinline__ unsigned xb_add(unsigned* p, unsigned v) { return __hip_atomic_fetch_add(p, v, __ATOMIC_RELAXED, __HIP_MEMORY_SCOPE_AGENT); }
__device__ __forceinline__ unsigned xb_xcc_id() { return (unsigned)__builtin_amdgcn_s_getreg((3 << 11) | 20) & 0xFu; }
#define XB_SPIN(cond, bar) do { unsigned _sp = 0; while (cond) { __builtin_amdgcn_s_sleep(1); \
    if ((++_sp & 255u) == 0u) { if (xb_ld(&(bar)[XB_TMO])) break; if (_sp > XB_SPIN_CAP) { atomicAdd(&(bar)[XB_TMO], 1u); break; } } } } while (0)
struct XcdBarrier { unsigned* bar; unsigned x; volatile LAS unsigned* st; };
__device__ __forceinline__ XcdBarrier xcd_barrier_post(unsigned* bar, volatile LAS unsigned* st) {
    XcdBarrier b; b.bar = bar; b.x = xb_xcc_id(); b.st = st;
    if (threadIdx.x == 0) (void)xb_add(&bar[XB_XCNT(b.x)], 1u);
    return b;
}
__device__ __forceinline__ void xcd_barrier_complete(unsigned* bar, unsigned x, unsigned& nloc, unsigned& nx) {
    const unsigned G = gridDim.x * gridDim.y * gridDim.z;
    unsigned sum, cnt, mine, sp = 0u;
    for (;;) {
        sum = 0u; cnt = 0u; mine = 0u;
#pragma unroll
        for (unsigned j = 0; j < 16; ++j) { const unsigned c = xb_ld(&bar[XB_XCNT(j)]); sum += c; cnt += (c > 0u) ? 1u : 0u; mine = (j == x) ? c : mine; }
        if (sum == G) break;
        __builtin_amdgcn_s_sleep(1);
        if ((++sp & 255u) == 0u) { if (xb_ld(&bar[XB_TMO])) break; if (sp > XB_SPIN_CAP) { atomicAdd(&bar[XB_TMO], 1u); break; } }
    }
    nloc = mine > 0u ? mine : 1u; nx = cnt > 0u ? cnt : 1u;
}
__device__ __forceinline__ void xcd_barrier(const XcdBarrier& b) {
    asm volatile("s_waitcnt vmcnt(0)" ::: "memory");
    __syncthreads();
    if (threadIdx.x == 0) {
        unsigned* bar = b.bar;
        __builtin_amdgcn_s_waitcnt(0);
        unsigned nloc = b.st[0], nx = b.st[1];
        if (nloc == 0u) { xcd_barrier_complete(bar, b.x, nloc, nx); b.st[0] = nloc; b.st[1] = nx; }
        const unsigned old = xb_add(&bar[XB_XSUB(b.x)], 1u);
        const unsigned gen = old / nloc;
        if (old + 1u == (gen + 1u) * nloc) {
            __builtin_amdgcn_fence(__ATOMIC_RELEASE, "agent");
            asm volatile("s_waitcnt vmcnt(0)" ::: "memory");
            const unsigned og = xb_add(&bar[XB_TOP], 1u);
            const unsigned tg = og / nx;
            if (og + 1u == (tg + 1u) * nx) xb_add(&bar[XB_TOPGEN], 1u);
            else XB_SPIN(xb_ld(&bar[XB_TOPGEN]) == tg, bar);
            __builtin_amdgcn_fence(__ATOMIC_ACQUIRE, "agent");
            xb_add(&bar[XB_XGEN(b.x)], 1u);
            asm volatile("s_waitcnt vmcnt(0)" ::: "memory");
        } else {
            XB_SPIN(xb_ld(&bar[XB_XGEN(b.x)]) == gen, bar);
            __builtin_amdgcn_fence(__ATOMIC_ACQUIRE, "agent");
            asm volatile("s_waitcnt vmcnt(0)" ::: "memory");
        }
    }
    __syncthreads();
}

__device__ __forceinline__ float wsum(float v) {
#pragma unroll
    for (int o = 32; o > 0; o >>= 1) v += __shfl_xor(v, o);
    return v;
}
__device__ __forceinline__ float wmax(float v) {
#pragma unroll
    for (int o = 32; o > 0; o >>= 1) v = fmaxf(v, __shfl_xor(v, o));
    return v;
}
__device__ __forceinline__ float sigmoidf_(float x) { return 1.0f / (1.0f + __expf(-x)); }
__device__ __forceinline__ float softplusf_(float x) { return x > 20.f ? x : log1pf(__expf(x)); }

struct Args {
    const float* in[30];
    float* out;
    unsigned char* ws;
    int ph_lo, ph_hi;
};

template <int NBM, class AF, class Epi>
__device__ __forceinline__ void sgemm_tile(float* lds, int K, AF arow, const float* __restrict__ B0, const float* __restrict__ B1, int ldb, int n0, int N, Epi epi) {
    const int tid = threadIdx.x;
    float* As = lds;
    float* Bs0 = lds + 16 * 132;
    float* Bs1 = lds + 2 * 16 * 132;
    const int ty = tid >> 5, tx = tid & 31;
    float acc0[8][4], acc1[8][4];
#pragma unroll
    for (int i = 0; i < 8; ++i)
#pragma unroll
        for (int j = 0; j < 4; ++j) { acc0[i][j] = 0.f; acc1[i][j] = 0.f; }
    const int ar = tid >> 2, ak = (tid & 3) * 4;
    const float* ap = arow(ar);
    const int bk = tid >> 5, bn = (tid & 31) * 4;
    const bool bok = (n0 + bn) < N;
    for (int k0 = 0; k0 < K; k0 += 16) {
        float4 av = ap ? *(const float4*)(ap + k0 + ak) : make_float4(0.f, 0.f, 0.f, 0.f);
        float4 bv0 = bok ? *(const float4*)(B0 + (size_t)(k0 + bk) * ldb + n0 + bn) : make_float4(0.f, 0.f, 0.f, 0.f);
        float4 bv1 = make_float4(0.f, 0.f, 0.f, 0.f);
        if (NBM == 2) { if (bok) bv1 = *(const float4*)(B1 + (size_t)(k0 + bk) * ldb + n0 + bn); }
        __syncthreads();
        As[(ak + 0) * 132 + ar] = av.x; As[(ak + 1) * 132 + ar] = av.y; As[(ak + 2) * 132 + ar] = av.z; As[(ak + 3) * 132 + ar] = av.w;
        *(float4*)&Bs0[bk * 132 + bn] = bv0;
        if (NBM == 2) *(float4*)&Bs1[bk * 132 + bn] = bv1;
        __syncthreads();
#pragma unroll 2
        for (int k = 0; k < 16; ++k) {
            const float4 a0 = *(const float4*)&As[k * 132 + ty * 8], a1 = *(const float4*)&As[k * 132 + ty * 8 + 4];
            const float a[8] = {a0.x, a0.y, a0.z, a0.w, a1.x, a1.y, a1.z, a1.w};
            const float4 b0 = *(const float4*)&Bs0[k * 132 + tx * 4];
            const float bb0[4] = {b0.x, b0.y, b0.z, b0.w};
#pragma unroll
            for (int i = 0; i < 8; ++i)
#pragma unroll
                for (int j = 0; j < 4; ++j) acc0[i][j] = fmaf(a[i], bb0[j], acc0[i][j]);
            if (NBM == 2) {
                const float4 b1 = *(const float4*)&Bs1[k * 132 + tx * 4];
                const float bb1[4] = {b1.x, b1.y, b1.z, b1.w};
#pragma unroll
                for (int i = 0; i < 8; ++i)
#pragma unroll
                    for (int j = 0; j < 4; ++j) acc1[i][j] = fmaf(a[i], bb1[j], acc1[i][j]);
            }
        }
    }
    if (bok) {
#pragma unroll
        for (int i = 0; i < 8; ++i)
#pragma unroll
            for (int j = 0; j < 4; ++j) epi(ty * 8 + i, tx * 4 + j, acc0[i][j], acc1[i][j]);
    }
}

__device__ __forceinline__ void phase_g1(const Args& a, int l, const float* xin, float* lds) {
    float* Z = (float*)(a.ws + WS_Z);
    const float* W = a.in[2] + (size_t)l * DM * IN_COLS;
    const float* Wv = a.in[3];
    const int nct = IN_COLS / 128;
    const int total = 128 * (nct + (l == 1 ? 1 : 0));
    for (int u = blockIdx.x; u < total; u += gridDim.x) {
        const int rt = u % 128, ct = u / 128;
        auto arow = [&](int r) { return xin + (size_t)(rt * 128 + r) * DM; };
        if (ct < nct) {
            auto epi = [&](int r, int c, float v, float) { Z[(size_t)(rt * 128 + r) * ZLD + ct * 128 + c] = v; };
            sgemm_tile<1>(lds, DM, arow, W, W, IN_COLS, ct * 128, IN_COLS, epi);
        } else {
            auto epi = [&](int r, int c, float v, float) { Z[(size_t)(rt * 128 + r) * ZLD + C_ZV + c] = v; };
            sgemm_tile<1>(lds, DM, arow, Wv, Wv, 32, 0, 32, epi);
        }
    }
}

__device__ __forceinline__ void phase_prep(const Args& a, int l, float* lds) {
    const float* Z = (const float*)(a.ws + WS_Z);
    const int tid = threadIdx.x, lane = tid & 63, wid = tid >> 6;
    float* KM = (float*)(a.ws + WS_KMEAN);
    for (int u = blockIdx.x * 8 + wid; u < NBATCH * NH * 8; u += gridDim.x * 8) {
        const int nb = u & 7, h = (u >> 3) & 7, b = u >> 6;
        const float* p = Z + (size_t)(b * SEQ + nb * 256) * ZLD + C_K + h * HD + lane;
        float s = 0.f;
#pragma unroll 8
        for (int i = 0; i < 256; ++i) s += p[(size_t)i * ZLD];
        KM[(size_t)u * 64 + lane] = s * (1.0f / 256.0f);
    }
    const float* mu = a.in[4] + (size_t)l * 1792;
    const float* muv = a.in[5];
    const float* w0 = a.in[6] + l * 512;
    const float* Wd = a.in[7] + (size_t)l * 64 * 512;
    const float* a0 = a.in[8] + l * 512;
    const float* Wi = a.in[9] + (size_t)l * 64 * 512;
    const float* v0 = a.in[10];
    const float* Wv = a.in[11];
    const float* Wg = a.in[12] + (size_t)l * 128 * 512;
    float* RWp = (float*)(a.ws + WS_RW); float* RAp = (float*)(a.ws + WS_RA); float* RGp = (float*)(a.ws + WS_RG); float* RVGp = (float*)(a.ws + WS_RVG);
    float* sh = lds;
    for (int tok = blockIdx.x; tok < NTOK; tok += gridDim.x) {
        const bool first = (tok % SEQ) == 0;
        __syncthreads();
        if (tid < 288) {
            const int zc = (tid < 256) ? (C_ZW + tid) : (C_ZV + tid - 256);
            const float m = (tid < 256) ? mu[zc - C_R] : muv[tid - 256];
            const bool ok = (tid < 256) || (l == 1);
            float v = 0.f;
            if (ok) {
                const float cur = Z[(size_t)tok * ZLD + zc];
                const float prev = first ? 0.f : Z[(size_t)(tok - 1) * ZLD + zc];
                v = cur + (prev - cur) * m;
                if (tid < 64) v = tanhf(v);
                else if (tid >= 128 && tid < 256) v = sigmoidf_(v);
            }
            sh[tid] = v;
        }
        __syncthreads();
        const int c = tid;
        float sd = w0[c], sa = a0[c], sg = 0.f;
#pragma unroll 8
        for (int j = 0; j < 64; ++j) { sd = fmaf(sh[j], Wd[j * 512 + c], sd); sa = fmaf(sh[64 + j], Wi[j * 512 + c], sa); }
#pragma unroll 8
        for (int j = 0; j < 128; ++j) sg = fmaf(sh[128 + j], Wg[j * 512 + c], sg);
        const float log_w = -softplusf_(-sd) - 0.5f;
        RWp[(size_t)tok * 512 + c] = __expf(-__expf(log_w));
        RAp[(size_t)tok * 512 + c] = sigmoidf_(sa);
        RGp[(size_t)tok * 512 + c] = sg;
        if (l == 1) {
            float sv = v0[c];
#pragma unroll 8
            for (int j = 0; j < 32; ++j) sv = fmaf(sh[256 + j], Wv[j * 512 + c], sv);
            RVGp[(size_t)tok * 512 + c] = sigmoidf_(sv);
        }
    }
}

__device__ __forceinline__ void scan_bh(const Args& a, int l, int bh, float* sh  ) {
    const int lane = threadIdx.x & 63;
    const int b = bh >> 3, h = bh & 7, c = h * 64 + lane;
    const float* Z = (const float*)(a.ws + WS_Z);
    const float* RWp = (const float*)(a.ws + WS_RW); const float* RAp = (const float*)(a.ws + WS_RA);
    const float* RGp = (const float*)(a.ws + WS_RG); const float* RVGp = (const float*)(a.ws + WS_RVG);
    float* VF = (float*)(a.ws + WS_VFIRST);
    float* MIX = (float*)(a.ws + WS_MIX);
    const float* mu = a.in[4] + (size_t)l * 1792;
    const float mu_r = mu[c], mu_k = mu[512 + c], mu_v = mu[1024 + c];
    const float kk_c = a.in[13][l * 512 + c], ka_c = a.in[14][l * 512 + c], rk_c = a.in[15][l * 512 + c];
    const float lg = a.in[16][l * 512 + c], lb = a.in[17][l * 512 + c];
    float S[64];
#pragma unroll
    for (int j = 0; j < 64; ++j) S[j] = 0.f;
    float pr = 0.f, pk = 0.f, pv = 0.f;
    for (int t = 0; t < SEQ; ++t) {
        const size_t tok = (size_t)b * SEQ + t;
        const float zr = Z[tok * ZLD + C_R + c], zk = Z[tok * ZLD + C_KR + c], zv = Z[tok * ZLD + C_VR + c];
        const float r = zr + (pr - zr) * mu_r, k = zk + (pk - zk) * mu_k;
        float v = zv + (pv - zv) * mu_v;
        pr = zr; pk = zk; pv = zv;
        const float ai = RAp[tok * 512 + c], w = RWp[tok * 512 + c];
        if (l == 0) VF[tok * 512 + c] = v; else v = v + (VF[tok * 512 + c] - v) * RVGp[tok * 512 + c];
        float kk = k * kk_c;
        const float ss = wsum(kk * kk);
        kk = kk * rsqrtf(fmaxf(ss, 1e-24f));
        const float kp = k * (1.0f + (ai - 1.0f) * ka_c);
        asm volatile("s_waitcnt lgkmcnt(0)" ::: "memory");
        sh[lane] = w; sh[64 + lane] = -kk; sh[128 + lane] = kk * ai; sh[192 + lane] = kp; sh[256 + lane] = r;
        asm volatile("s_waitcnt lgkmcnt(0)" ::: "memory");
        float sa = 0.f;
#pragma unroll
        for (int j4 = 0; j4 < 16; ++j4) { const float4 av = *(const float4*)&sh[64 + j4 * 4];
            sa = fmaf(S[j4 * 4], av.x, sa); sa = fmaf(S[j4 * 4 + 1], av.y, sa); sa = fmaf(S[j4 * 4 + 2], av.z, sa); sa = fmaf(S[j4 * 4 + 3], av.w, sa); }
        float y = 0.f;
#pragma unroll
        for (int j4 = 0; j4 < 16; ++j4) {
            const float4 wv = *(const float4*)&sh[j4 * 4], bv = *(const float4*)&sh[128 + j4 * 4], kv = *(const float4*)&sh[192 + j4 * 4], rv = *(const float4*)&sh[256 + j4 * 4];
            S[j4 * 4 + 0] = fmaf(S[j4 * 4 + 0], wv.x, fmaf(sa, bv.x, v * kv.x)); y = fmaf(S[j4 * 4 + 0], rv.x, y);
            S[j4 * 4 + 1] = fmaf(S[j4 * 4 + 1], wv.y, fmaf(sa, bv.y, v * kv.y)); y = fmaf(S[j4 * 4 + 1], rv.y, y);
            S[j4 * 4 + 2] = fmaf(S[j4 * 4 + 2], wv.z, fmaf(sa, bv.z, v * kv.z)); y = fmaf(S[j4 * 4 + 2], rv.z, y);
            S[j4 * 4 + 3] = fmaf(S[j4 * 4 + 3], wv.w, fmaf(sa, bv.w, v * kv.w)); y = fmaf(S[j4 * 4 + 3], rv.w, y);
        }
        const float my = wsum(y) * (1.0f / 64.0f);
        const float dy = y - my;
        const float var = wsum(dy * dy) * (1.0f / 64.0f);
        const float yn = dy * rsqrtf(var + 64e-5f) * lg + lb;
        const float bonus = wsum(r * kp * rk_c) * v;
        MIX[tok * DM + 512 + c] = (yn + bonus) * RGp[tok * 512 + c];
    }
}

__device__ __forceinline__ void att_query(const Args& a, int l, int b, int h, int i, float* qs  , float* sc  ) {
    const int lane = threadIdx.x & 63;
    const float* Z = (const float*)(a.ws + WS_Z);
    const float* KM = (const float*)(a.ws + WS_KMEAN);
    float* MIX = (float*)(a.ws + WS_MIX);
    const size_t tok = (size_t)b * SEQ + i;
    const int cur = i >> 8;
    const float slope = exp2f(-(float)(h + 1));
    const float q = Z[tok * ZLD + C_Q + h * HD + lane] * 0.125f;
    asm volatile("s_waitcnt lgkmcnt(0)" ::: "memory");
    qs[lane] = q;
    asm volatile("s_waitcnt lgkmcnt(0)" ::: "memory");
    float g[8];
#pragma unroll
    for (int n = 0; n < 8; ++n) { const float p = (n < cur) ? q * KM[((size_t)(b * NH + h) * 8 + n) * 64 + lane] : 0.f; g[n] = (n < cur) ? wsum(p) : NEG_INF; }
    int sel0 = -1, sel1 = -1, sel2 = -1;
    {
        float bv = -3e38f; int bi = -1;
#pragma unroll
        for (int n = 0; n < 8; ++n) if (g[n] > bv) { bv = g[n]; bi = n; }
        sel0 = bi; bv = -3e38f; bi = -1;
#pragma unroll
        for (int n = 0; n < 8; ++n) if (n != sel0 && g[n] > bv) { bv = g[n]; bi = n; }
        sel1 = bi; bv = -3e38f; bi = -1;
#pragma unroll
        for (int n = 0; n < 8; ++n) if (n != sel0 && n != sel1 && g[n] > bv) { bv = g[n]; bi = n; }
        sel2 = bi;
    }
    const int nsel = cur < 3 ? cur : 3;
    float mx = NEG_INF;
    for (int s = 0; s <= nsel; ++s) {
        const int blk = (s == nsel) ? cur : (s == 0 ? sel0 : (s == 1 ? sel1 : sel2));
#pragma unroll
        for (int m = 0; m < 4; ++m) {
            const int kpos = blk * 256 + m * 64 + lane;
            const float* kp = Z + ((size_t)b * SEQ + kpos) * ZLD + C_K + h * HD;
            float d = 0.f;
#pragma unroll
            for (int d4 = 0; d4 < 16; ++d4) { const float4 kv = *(const float4*)(kp + d4 * 4); const float4 qv = *(const float4*)&qs[d4 * 4];
                d = fmaf(qv.x, kv.x, d); d = fmaf(qv.y, kv.y, d); d = fmaf(qv.z, kv.z, d); d = fmaf(qv.w, kv.w, d); }
            const int dist = i - kpos;
            float sv = (dist >= 0) ? d - slope * (float)dist : NEG_INF;
            sc[s * 256 + m * 64 + lane] = sv;
            mx = fmaxf(mx, sv);
        }
    }
    mx = wmax(mx);
    float den = 0.f;
    for (int s = 0; s <= nsel; ++s)
#pragma unroll
        for (int m = 0; m < 4; ++m) { const int idx = s * 256 + m * 64 + lane; const float p = __expf(sc[idx] - mx); sc[idx] = p; den += p; }
    den = wsum(den);
    asm volatile("s_waitcnt lgkmcnt(0)" ::: "memory");
    float o = 0.f;
    for (int s = 0; s <= nsel; ++s) {
        const int blk = (s == nsel) ? cur : (s == 0 ? sel0 : (s == 1 ? sel1 : sel2));
        const float* vp = Z + ((size_t)b * SEQ + blk * 256) * ZLD + C_V + h * HD + lane;
        const int nk = (s == nsel) ? (i - cur * 256 + 1) : 256;
        for (int j = 0; j < nk; ++j) o = fmaf(sc[s * 256 + j], vp[(size_t)j * ZLD], o);
    }
    o = o / den;
    const float ms = wsum(o * o) * (1.0f / 64.0f);
    MIX[tok * DM + h * HD + lane] = o * rsqrtf(ms + 1e-6f) * a.in[18][l * 512 + h * HD + lane];
}

__device__ __forceinline__ void phase_att_scan(const Args& a, int l, float* lds) {
    const int tid = threadIdx.x, wid = tid >> 6;
    if (blockIdx.x < 64) {
        if (wid == 0) scan_bh(a, l, blockIdx.x, lds);
    } else {
        float* qs = lds + wid * 64;
        float* sc = lds + 8 * 64 + wid * 1024;
        const int nb = gridDim.x - 64;
        for (int u = (blockIdx.x - 64) * 8 + wid; u < NBATCH * NH * SEQ; u += nb * 8) {
            const int i = u % SEQ, h = (u / SEQ) % NH, b = u / (SEQ * NH);
            att_query(a, l, b, h, i, qs, sc);
        }
    }
}

__device__ __forceinline__ void phase_dense(const float* A, int M, int K, const float* W, int N, const float* RES, float* OUT, float* lds) {
    const int nrt = M / 128, nct = N / 128;
    for (int u = blockIdx.x; u < nrt * nct; u += gridDim.x) {
        const int rt = u % nrt, ct = u / nrt;
        auto arow = [&](int r) { return A + (size_t)(rt * 128 + r) * K; };
        auto epi = [&](int r, int c, float v, float) { const size_t o = (size_t)(rt * 128 + r) * N + ct * 128 + c; OUT[o] = RES ? fmaf(ALPHA, RES[o], v) : v; };
        sgemm_tile<1>(lds, K, arow, W, W, N, ct * 128, N, epi);
    }
}

__device__ __forceinline__ void ln_row(const float* in, const float* g, const float* bta, float* out, int lane, float (&xn)[16]) {
    float x[16];
#pragma unroll
    for (int m = 0; m < 4; ++m) { const float4 v = *(const float4*)(in + m * 256 + lane * 4); x[m * 4] = v.x; x[m * 4 + 1] = v.y; x[m * 4 + 2] = v.z; x[m * 4 + 3] = v.w; }
    float s = 0.f;
#pragma unroll
    for (int k = 0; k < 16; ++k) s += x[k];
    const float mean = wsum(s) * (1.0f / 1024.0f);
    float q = 0.f;
#pragma unroll
    for (int k = 0; k < 16; ++k) { const float d = x[k] - mean; q = fmaf(d, d, q); }
    const float var = wsum(q) * (1.0f / 1024.0f);
    const float rstd = rsqrtf(var + 1e-5f);
#pragma unroll
    for (int m = 0; m < 4; ++m) {
        const float4 gv = *(const float4*)(g + m * 256 + lane * 4), bv = *(const float4*)(bta + m * 256 + lane * 4);
        float4 o;
        o.x = (x[m * 4] - mean) * rstd * gv.x + bv.x; o.y = (x[m * 4 + 1] - mean) * rstd * gv.y + bv.y;
        o.z = (x[m * 4 + 2] - mean) * rstd * gv.z + bv.z; o.w = (x[m * 4 + 3] - mean) * rstd * gv.w + bv.w;
        xn[m * 4] = o.x; xn[m * 4 + 1] = o.y; xn[m * 4 + 2] = o.z; xn[m * 4 + 3] = o.w;
        *(float4*)(out + m * 256 + lane * 4) = o;
    }
}
__device__ __forceinline__ void phase_ln(const float* IN, const float* g, const float* bta, float* OUT) {
    const int lane = threadIdx.x & 63, wid = threadIdx.x >> 6;
    for (int row = blockIdx.x * 8 + wid; row < NTOK; row += gridDim.x * 8) {
        float xn[16];
        ln_row(IN + (size_t)row * DM, g, bta, OUT + (size_t)row * DM, lane, xn);
    }
}

__device__ __forceinline__ void phase_ln2_router(const Args& a, int l, float* lds) {
    const int tid = threadIdx.x, lane = tid & 63, wid = tid >> 6;
    const float* PRE = (const float*)(a.ws + WS_PRE);
    float* X2 = (float*)(a.ws + WS_X2);
    const float* g = a.in[28] + (size_t)(l * 3 + 1) * DM; const float* bta = a.in[29] + (size_t)(l * 3 + 1) * DM;
    const float* WR = a.in[23]; const float* BR = a.in[24];
    unsigned* cnt = (unsigned*)(a.ws + WS_CTL) + CW_CNT + l * 32;
    int2* list = (int2*)(a.ws + WS_LIST);
    int2* tokpos = (int2*)(a.ws + WS_TOKPOS);
    __syncthreads();
    for (int idx = tid; idx < DM * NEXP; idx += NTHREADS) { const int k = idx >> 5, e = idx & 31; lds[e * DM + k] = WR[idx]; }
    __syncthreads();
    for (int row = blockIdx.x * 8 + wid; row < NTOK; row += gridDim.x * 8) {
        float xn[16];
        ln_row(PRE + (size_t)row * DM, g, bta, X2 + (size_t)row * DM, lane, xn);
        float mylogit = 0.f;
#pragma unroll 4
        for (int e = 0; e < NEXP; ++e) {
            float p = 0.f;
#pragma unroll
            for (int m = 0; m < 4; ++m) { const float4 wv = *(const float4*)&lds[e * DM + m * 256 + lane * 4];
                p = fmaf(xn[m * 4], wv.x, p); p = fmaf(xn[m * 4 + 1], wv.y, p); p = fmaf(xn[m * 4 + 2], wv.z, p); p = fmaf(xn[m * 4 + 3], wv.w, p); }
            p = wsum(p);
            if (lane == e) mylogit = p;
        }
        const float s = sigmoidf_(mylogit);
        const float sel = (lane < 32) ? s + BR[lane & 31] : NEG_INF;
        const int gb = lane & ~3;
        const float v0 = __shfl(sel, gb), v1 = __shfl(sel, gb + 1), v2 = __shfl(sel, gb + 2), v3 = __shfl(sel, gb + 3);
        const float m1 = fmaxf(fmaxf(v0, v1), fmaxf(v2, v3));
        const float sum4 = v0 + v1 + v2 + v3; (void)sum4;
        float m2;
        { const float lo01 = fminf(v0, v1), hi01 = fmaxf(v0, v1), lo23 = fminf(v2, v3), hi23 = fmaxf(v2, v3);
          m2 = fmaxf(fminf(hi01, hi23), fmaxf(lo01, lo23)); }
        float gs = (lane < 32) ? (m1 + m2) : NEG_INF;
        int gi = lane >> 2;
#pragma unroll
        for (int o = 32; o > 0; o >>= 1) { const float ov = __shfl_xor(gs, o); const int oi = __shfl_xor(gi, o); if (ov > gs || (ov == gs && oi < gi)) { gs = ov; gi = oi; } }
        const int gbest = gi;
        const float c0 = __shfl(sel, gbest * 4), c1 = __shfl(sel, gbest * 4 + 1), c2 = __shfl(sel, gbest * 4 + 2), c3 = __shfl(sel, gbest * 4 + 3);
        int j0 = 0; float b0 = c0;
        if (c1 > b0) { b0 = c1; j0 = 1; } if (c2 > b0) { b0 = c2; j0 = 2; } if (c3 > b0) { b0 = c3; j0 = 3; }
        int j1 = -1; float b1 = -3e38f;
        if (j0 != 0 && c0 > b1) { b1 = c0; j1 = 0; } if (j0 != 1 && c1 > b1) { b1 = c1; j1 = 1; } if (j0 != 2 && c2 > b1) { b1 = c2; j1 = 2; } if (j0 != 3 && c3 > b1) { b1 = c3; j1 = 3; }
        const int e0 = gbest * 4 + j0, e1 = gbest * 4 + j1;
        const float s0 = __shfl(s, e0), s1 = __shfl(s, e1);
        const float inv = 1.0f / (s0 + s1);
        if (lane == 0) {
            const unsigned r0 = atomicAdd(&cnt[e0], 1u), r1 = atomicAdd(&cnt[e1], 1u);
            list[(size_t)e0 * LCAP + r0] = make_int2(row, __float_as_int(s0 * inv));
            list[(size_t)e1 * LCAP + r1] = make_int2(row, __float_as_int(s1 * inv));
            tokpos[row * 2] = make_int2(e0, (int)r0); tokpos[row * 2 + 1] = make_int2(e1, (int)r1);
        }
    }
}

__device__ __forceinline__ bool moe_tile(const unsigned* cnt, int ti, int& e, int& rt, int& base, unsigned& ce) {
    int acc = 0;
    for (int x = 0; x < NEXP; ++x) { const unsigned c = cnt[x]; const int nt = (int)((c + 127u) >> 7); if (ti < acc + nt) { e = x; rt = ti - acc; base = acc; ce = c; return true; } acc += nt; }
    return false;
}
__device__ __forceinline__ int moe_total(const unsigned* cnt) { int acc = 0; for (int x = 0; x < NEXP; ++x) acc += (int)((cnt[x] + 127u) >> 7); return acc; }

__device__ __forceinline__ void phase_f3(const Args& a, int l, float* lds) {
    const unsigned* cnt = (const unsigned*)(a.ws + WS_CTL) + CW_CNT + l * 32;
    const int2* list = (const int2*)(a.ws + WS_LIST);
    const float* X2 = (const float*)(a.ws + WS_X2);
    float* H = (float*)(a.ws + WS_H);
    const int total = moe_total(cnt);
    for (int u = blockIdx.x; u < total * 4; u += gridDim.x) {
        const int ti = u >> 2, ct = u & 3; int e, rt, base; unsigned ce;
        moe_tile(cnt, ti, e, rt, base, ce);
        const float* Wg = a.in[25] + ((size_t)l * NEXP + e) * DM * DEXP;
        const float* Wu = a.in[26] + ((size_t)l * NEXP + e) * DM * DEXP;
        auto arow = [&](int r) -> const float* { const unsigned rank = rt * 128 + r; return rank < ce ? X2 + (size_t)list[(size_t)e * LCAP + rank].x * DM : nullptr; };
        auto epi = [&](int r, int c, float g, float up) {
            const unsigned rank = rt * 128 + r; float hv = 0.f;
            if (rank < ce) { const float gate = __int_as_float(list[(size_t)e * LCAP + rank].y); hv = g * sigmoidf_(g) * up * gate; }
            H[((size_t)(base + rt) * 128 + r) * DEXP + ct * 128 + c] = hv;
        };
        sgemm_tile<2>(lds, DM, arow, Wg, Wu, DEXP, ct * 128, DEXP, epi);
    }
}
__device__ __forceinline__ void phase_f4(const Args& a, int l, float* lds) {
    const unsigned* cnt = (const unsigned*)(a.ws + WS_CTL) + CW_CNT + l * 32;
    const float* H = (const float*)(a.ws + WS_H);
    float* Y = (float*)(a.ws + WS_Y);
    const int total = moe_total(cnt);
    for (int u = blockIdx.x; u < total * 8; u += gridDim.x) {
        const int ti = u >> 3, ct = u & 7; int e, rt, base; unsigned ce;
        moe_tile(cnt, ti, e, rt, base, ce);
        const float* Wd = a.in[27] + ((size_t)l * NEXP + e) * DEXP * DM;
        auto arow = [&](int r) { return H + ((size_t)(base + rt) * 128 + r) * DEXP; };
        auto epi = [&](int r, int c, float v, float) { Y[((size_t)(base + rt) * 128 + r) * DM + ct * 128 + c] = v; };
        sgemm_tile<1>(lds, DEXP, arow, Wd, Wd, DM, ct * 128, DM, epi);
    }
}
__device__ __forceinline__ void phase_ln3(const Args& a, int l, float* OUT) {
    const int lane = threadIdx.x & 63, wid = threadIdx.x >> 6;
    const unsigned* cnt = (const unsigned*)(a.ws + WS_CTL) + CW_CNT + l * 32;
    const int2* tokpos = (const int2*)(a.ws + WS_TOKPOS);
    const float* X2 = (const float*)(a.ws + WS_X2); const float* Y = (const float*)(a.ws + WS_Y);
    const float* g = a.in[28] + (size_t)(l * 3 + 2) * DM; const float* bta = a.in[29] + (size_t)(l * 3 + 2) * DM;
    int mybase = 0;
    { int acc = 0; for (int x = 0; x < NEXP; ++x) { if (x == lane) mybase = acc; acc += (int)((cnt[x] + 127u) >> 7); } }
    for (int row = blockIdx.x * 8 + wid; row < NTOK; row += gridDim.x * 8) {
        const int2 p0 = tokpos[row * 2], p1 = tokpos[row * 2 + 1];
        const size_t h0 = (size_t)__shfl(mybase, p0.x) * 128 + p0.y, h1 = (size_t)__shfl(mybase, p1.x) * 128 + p1.y;
        const float* xr = X2 + (size_t)row * DM; const float* y0 = Y + h0 * DM; const float* y1 = Y + h1 * DM;
        float x[16];
#pragma unroll
        for (int m = 0; m < 4; ++m) { const int o = m * 256 + lane * 4; const float4 xv = *(const float4*)(xr + o), a0 = *(const float4*)(y0 + o), a1 = *(const float4*)(y1 + o);
            x[m * 4] = fmaf(ALPHA, xv.x, a0.x + a1.x); x[m * 4 + 1] = fmaf(ALPHA, xv.y, a0.y + a1.y); x[m * 4 + 2] = fmaf(ALPHA, xv.z, a0.z + a1.z); x[m * 4 + 3] = fmaf(ALPHA, xv.w, a0.w + a1.w); }
        float s = 0.f;
#pragma unroll
        for (int k = 0; k < 16; ++k) s += x[k];
        const float mean = wsum(s) * (1.0f / 1024.0f);
        float q = 0.f;
#pragma unroll
        for (int k = 0; k < 16; ++k) { const float d = x[k] - mean; q = fmaf(d, d, q); }
        const float rstd = rsqrtf(wsum(q) * (1.0f / 1024.0f) + 1e-5f);
#pragma unroll
        for (int m = 0; m < 4; ++m) { const int o = m * 256 + lane * 4; const float4 gv = *(const float4*)(g + o), bv = *(const float4*)(bta + o); float4 r;
            r.x = (x[m * 4] - mean) * rstd * gv.x + bv.x; r.y = (x[m * 4 + 1] - mean) * rstd * gv.y + bv.y; r.z = (x[m * 4 + 2] - mean) * rstd * gv.z + bv.z; r.w = (x[m * 4 + 3] - mean) * rstd * gv.w + bv.w;
            *(float4*)(OUT + (size_t)row * DM + o) = r; }
    }
}

__device__ __forceinline__ void phase_matt(const Args& a, float* lds) {
    const int lane = threadIdx.x & 63, wid = threadIdx.x >> 6;
    const float* Q = (const float*)(a.ws + WS_Q); const float* KV = (const float*)(a.ws + WS_KV); float* O = (float*)(a.ws + WS_O);
    float* qs = lds + wid * 256; float* sc = lds + 8 * 256 + wid * 256;
    for (int u = blockIdx.x * 8 + wid; u < NTOK * 4; u += gridDim.x * 8) {
        const int hm = u & 3, tok = u >> 2, b = tok / SEQ;
        asm volatile("s_waitcnt lgkmcnt(0)" ::: "memory");
        { const float4 qv = *(const float4*)(Q + (size_t)tok * DM + hm * 256 + lane * 4);
          *(float4*)&qs[lane * 4] = make_float4(qv.x * 0.0625f, qv.y * 0.0625f, qv.z * 0.0625f, qv.w * 0.0625f); }
        asm volatile("s_waitcnt lgkmcnt(0)" ::: "memory");
        float sv[4]; float mx = NEG_INF;
#pragma unroll
        for (int m = 0; m < 4; ++m) {
            const float* kp = KV + ((size_t)b * MEMLEN + m * 64 + lane) * 2048 + hm * 256;
            float d = 0.f;
            for (int d4 = 0; d4 < 64; ++d4) { const float4 kv = *(const float4*)(kp + d4 * 4); const float4 qv = *(const float4*)&qs[d4 * 4];
                d = fmaf(qv.x, kv.x, d); d = fmaf(qv.y, kv.y, d); d = fmaf(qv.z, kv.z, d); d = fmaf(qv.w, kv.w, d); }
            sv[m] = d; mx = fmaxf(mx, d);
        }
        mx = wmax(mx);
        float den = 0.f;
#pragma unroll
        for (int m = 0; m < 4; ++m) { const float p = __expf(sv[m] - mx); sc[m * 64 + lane] = p; den += p; }
        den = wsum(den);
        asm volatile("s_waitcnt lgkmcnt(0)" ::: "memory");
        float4 o = make_float4(0.f, 0.f, 0.f, 0.f);
        const float* vp = KV + (size_t)b * MEMLEN * 2048 + 1024 + hm * 256 + lane * 4;
        for (int j = 0; j < MEMLEN; ++j) { const float p = sc[j]; const float4 vv = *(const float4*)(vp + (size_t)j * 2048);
            o.x = fmaf(p, vv.x, o.x); o.y = fmaf(p, vv.y, o.y); o.z = fmaf(p, vv.z, o.z); o.w = fmaf(p, vv.w, o.w); }
        const float inv = 1.0f / den;
        *(float4*)(O + (size_t)tok * DM + hm * 256 + lane * 4) = make_float4(o.x * inv, o.y * inv, o.z * inv, o.w * inv);
    }
}

constexpr int PH_PER_LAYER = 12, N_PHASES = 2 * PH_PER_LAYER;

__global__ void __launch_bounds__(NTHREADS, 2) mk_fwd(Args a) {
    extern __shared__ __attribute__((aligned(16))) unsigned char smem[];
    float* lds = (float*)smem;
    volatile LAS unsigned* xbw = (volatile LAS unsigned*)(smem + LDS_BYTES - 16);
    const int lo = a.ph_lo, hi = a.ph_hi;
    unsigned* ctl = (unsigned*)(a.ws + WS_CTL);
    XcdBarrier bar; bar.bar = ctl + CW_BAR; bar.x = 0; bar.st = xbw;
    if (hi - lo > 1) {
        if (threadIdx.x == 0) { xbw[0] = 0u; xbw[1] = 0u; }
        __syncthreads();
        bar = xcd_barrier_post(ctl + CW_BAR, xbw);
    }
#define IN(k) (lo <= (k) && (k) < hi)
#define SEAM(k) do { if (IN(k) && IN((k) + 1)) xcd_barrier(bar); } while (0)
#define LAYER_BODY(l) do { \
        const int p0 = l * PH_PER_LAYER; \
        const float* xin = (l == 0) ? a.in[0] : (const float*)(a.ws + WS_XL1); \
        float* xout = (l == 0) ? (float*)(a.ws + WS_XL1) : a.out; \
        if (IN(p0 + 0)) phase_g1(a, l, xin, lds); \
        SEAM(p0 + 0); \
        if (IN(p0 + 1)) phase_prep(a, l, lds); \
        SEAM(p0 + 1); \
        if (IN(p0 + 2)) phase_att_scan(a, l, lds); \
        SEAM(p0 + 2); \
        if (IN(p0 + 3)) phase_dense((const float*)(a.ws + WS_MIX), NTOK, DM, a.in[19] + (size_t)l * DM * DM, DM, xin, (float*)(a.ws + WS_PRE), lds); \
        SEAM(p0 + 3); \
        if (IN(p0 + 4)) phase_ln((const float*)(a.ws + WS_PRE), a.in[28] + (size_t)(l * 3) * DM, a.in[29] + (size_t)(l * 3) * DM, (float*)(a.ws + WS_X1)); \
        SEAM(p0 + 4); \
        if (IN(p0 + 5)) { \
            phase_dense((const float*)(a.ws + WS_X1), NTOK, DM, a.in[20] + (size_t)l * DM * DM, DM, nullptr, (float*)(a.ws + WS_Q), lds); \
            phase_dense(a.in[1], NBATCH * MEMLEN, DM, a.in[21] + (size_t)l * DM * 2048, 2048, nullptr, (float*)(a.ws + WS_KV), lds); \
        } \
        SEAM(p0 + 5); \
        if (IN(p0 + 6)) phase_matt(a, lds); \
        SEAM(p0 + 6); \
        if (IN(p0 + 7)) phase_dense((const float*)(a.ws + WS_O), NTOK, DM, a.in[22] + (size_t)l * DM * DM, DM, (const float*)(a.ws + WS_X1), (float*)(a.ws + WS_PRE), lds); \
        SEAM(p0 + 7); \
        if (IN(p0 + 8)) phase_ln2_router(a, l, lds); \
        SEAM(p0 + 8); \
        if (IN(p0 + 9)) phase_f3(a, l, lds); \
        SEAM(p0 + 9); \
        if (IN(p0 + 10)) phase_f4(a, l, lds); \
        SEAM(p0 + 10); \
        if (IN(p0 + 11)) phase_ln3(a, l, xout); \
        SEAM(p0 + 11); \
    } while (0)
    LAYER_BODY(0);
    LAYER_BODY(1);
}
}

extern "C" void kernel_launch(void* const* d_in, const int* in_sizes, int n_in, void* d_out, int out_size, void* d_ws, size_t ws_size, hipStream_t stream) {
    static int grid = 0;
    if (!grid) {
        int dev = 0, cus = 0, per_cu = 0;
        hipGetDevice(&dev);
        hipDeviceGetAttribute(&cus, hipDeviceAttributeMultiprocessorCount, dev);
        hipFuncSetAttribute((const void*)mk_fwd, hipFuncAttributeMaxDynamicSharedMemorySize, LDS_BYTES);
        hipOccupancyMaxActiveBlocksPerMultiprocessor(&per_cu, mk_fwd, NTHREADS, LDS_BYTES);
        if (per_cu < 1) per_cu = 1;
        grid = cus * 1;
        if (grid < 65) grid = 256;
    }
    if (ws_size < WS_END) return;
    hipMemsetAsync(d_ws, 0, CTL_ZERO_BYTES, stream);
    Args a;
    memset(&a, 0, sizeof(a));
    for (int i = 0; i < 30; ++i) a.in[i] = (const float*)d_in[i];
    a.out = (float*)d_out; a.ws = (unsigned char*)d_ws;
#if MK_ONE_LAUNCH
    a.ph_lo = 0; a.ph_hi = N_PHASES;
    hipLaunchKernelGGL(mk_fwd, dim3(grid), dim3(NTHREADS), LDS_BYTES, stream, a);
#else
    for (int p = 0; p < N_PHASES; ++p) {
        a.ph_lo = p; a.ph_hi = p + 1;
        hipLaunchKernelGGL(mk_fwd, dim3(grid), dim3(NTHREADS), LDS_BYTES, stream, a);
    }
#endif
}
```

```cpp
#include <hip/hip_runtime.h>
#include <stdint.h>
#include <cstring>

#ifndef MK_ONE_LAUNCH
#define MK_ONE_LAUNCH 1
#endif

namespace {
constexpr int NTHREADS = 512;
constexpr int NTOK = 16384, SEQ = 2048, NBATCH = 8, DM = 1024;
constexpr int MEMLEN = 256;
constexpr int NH = 8, HD = 64;
constexpr int IN_COLS = 3328, ZLD = 3584;
constexpr int C_Q = 0, C_K = 512, C_V = 1024, C_R = 1536, C_KR = 2048, C_VR = 2560, C_ZW = 3072, C_ZA = 3136, C_ZG = 3200, C_ZV = 3328;
constexpr int NEXP = 32, DEXP = 512;
constexpr int LCAP = 16384;
constexpr float ALPHA = 1.4142135623730951f;
constexpr float NEG_INF = -1e30f;
constexpr int LDS_BYTES = 147456;

typedef unsigned short bf16_t;
typedef float f32x2_t __attribute__((ext_vector_type(2)));
typedef __bf16 bf16x2_t __attribute__((ext_vector_type(2)));
__device__ __forceinline__ unsigned pk2(float lo, float hi) { f32x2_t v = {lo, hi}; bf16x2_t b = __builtin_convertvector(v, bf16x2_t); return __builtin_bit_cast(unsigned, b); }
__device__ __forceinline__ bf16_t f2bf(float f) { return (bf16_t)(pk2(f, 0.f) & 0xffffu); }
__device__ __forceinline__ float bf2f(bf16_t h) { return __uint_as_float((unsigned)h << 16); }
__device__ __forceinline__ float bflo(unsigned u) { return __uint_as_float(u << 16); }
__device__ __forceinline__ float bfhi(unsigned u) { return __uint_as_float(u & 0xffff0000u); }

constexpr size_t MiB = 1u << 20;
constexpr size_t WS_CTL = 0, CTL_ZERO_BYTES = 64 * 1024;
constexpr size_t WS_LIST = 2 * MiB;
constexpr size_t WS_KB = 6 * MiB;
constexpr size_t WS_TOKPOS = 10 * MiB;
constexpr size_t WS_TOKGATE = 10 * MiB + 512 * 1024;
constexpr size_t WS_KMEAN = 11 * MiB;
constexpr size_t WS_MEMB = 12 * MiB;
constexpr size_t WS_VT = 16 * MiB;
constexpr size_t WS_WIN0 = 24 * MiB, WS_WIN1 = 31 * MiB;
constexpr size_t WS_WOUT = 38 * MiB, WS_WQ = 42 * MiB, WS_WKV = 46 * MiB, WS_WO = 54 * MiB;
constexpr size_t WS_WEXP = 58 * MiB;
constexpr size_t WS_XL1 = 154 * MiB, WS_XB = 218 * MiB, WS_VFIRST = 250 * MiB;
constexpr size_t WS_Z = 266 * MiB, WS_MIX = 378 * MiB, WS_R3 = 410 * MiB, WS_END = 506 * MiB;
constexpr size_t WS_REC = 410 * MiB;
constexpr size_t WS_YRAW = 490 * MiB;
constexpr size_t WS_RVT = 218 * MiB, WS_RG = 234 * MiB;
constexpr size_t WS_BON = 20 * MiB;
constexpr size_t WS_PRE = 266 * MiB, WS_X1 = 410 * MiB, WS_X1B = 474 * MiB;
constexpr size_t WS_Q = 330 * MiB, WS_KV = 362 * MiB, WS_O = 266 * MiB, WS_PRE2 = 330 * MiB;
constexpr size_t WS_X2 = 410 * MiB, WS_X2B = 474 * MiB;
constexpr size_t WS_H = 266 * MiB, WS_Y = 306 * MiB;

constexpr int CW_CNT = 0;
constexpr int CW_BAR = 1024;

#define XB_TMO      128
#define XB_XCNT(j)  (256  + 64 * (j))
#define XB_XSUB(j)  (1280 + 64 * (j))
#define XB_XGEN(j)  (2304 + 64 * (j))
#define XB_TOP      3328
#define XB_TOPGEN   3392
#define XCD_BAR_WORDS 3456
#define XB_SPIN_CAP (1u << 18)
#define LAS __attribute__((address_space(3)))
__device__ __forceinline__ unsigned xb_ld(unsigned* p)              { return __hip_atomic_load(p, __ATOMIC_RELAXED, __HIP_MEMORY_SCOPE_AGENT); }
__device__ __forceinline__ unsigned xb_add(unsigned* p, unsigned v) { return __hip_atomic_fetch_add(p, v, __ATOMIC_RELAXED, __HIP_MEMORY_SCOPE_AGENT); }
__device__ __forceinline__ unsigned xb_xcc_id() { return (unsigned)__builtin_amdgcn_s_getreg((3 << 11) | 20) & 0xFu; }
#define XB_SPIN(cond, bar) do { unsigned _sp = 0; while (cond) { __builtin_amdgcn_s_sleep(1); \
    if ((++_sp & 255u) == 0u) { if (xb_ld(&(bar)[XB_TMO])) break; if (_sp > XB_SPIN_CAP) { atomicAdd(&(bar)[XB_TMO], 1u); break; } } } } while (0)
struct XcdBarrier { unsigned* bar; unsigned x; volatile LAS unsigned* st; };
__device__ __forceinline__ XcdBarrier xcd_barrier_post(unsigned* bar, volatile LAS unsigned* st) {
    XcdBarrier b; b.bar = bar; b.x = xb_xcc_id(); b.st = st;
    if (threadIdx.x == 0) (void)xb_add(&bar[XB_XCNT(b.x)], 1u);
    return b;
}
__device__ __forceinline__ void xcd_barrier_complete(unsigned* bar, unsigned x, unsigned& nloc, unsigned& nx) {
    const unsigned G = gridDim.x * gridDim.y * gridDim.z;
    unsigned sum, cnt, mine, sp = 0u;
    for (;;) {
        sum = 0u; cnt = 0u; mine = 0u;
#pragma unroll
        for (unsigned j = 0; j < 16; ++j) { const unsigned c = xb_ld(&bar[XB_XCNT(j)]); sum += c; cnt += (c > 0u) ? 1u : 0u; mine = (j == x) ? c : mine; }
        if (sum == G) break;
        __builtin_amdgcn_s_sleep(1);
        if ((++sp & 255u) == 0u) { if (xb_ld(&bar[XB_TMO])) break; if (sp > XB_SPIN_CAP) { atomicAdd(&bar[XB_TMO], 1u); break; } }
    }
    nloc = mine > 0u ? mine : 1u; nx = cnt > 0u ? cnt : 1u;
}
__device__ __forceinline__ void xcd_barrier(const XcdBarrier& b) {
    asm volatile("s_waitcnt vmcnt(0)" ::: "memory");
    __syncthreads();
    if (threadIdx.x == 0) {
        unsigned* bar = b.bar;
        __builtin_amdgcn_s_waitcnt(0);
        unsigned nloc = b.st[0], nx = b.st[1];
        if (nloc == 0u) { xcd_barrier_complete(bar, b.x, nloc, nx); b.st[0] = nloc; b.st[1] = nx; }
        const unsigned old = xb_add(&bar[XB_XSUB(b.x)], 1u);
        const unsigned gen = old / nloc;
        if (old + 1u == (gen + 1u) * nloc) {
            __builtin_amdgcn_fence(__ATOMIC_RELEASE, "agent");
            asm volatile("s_waitcnt vmcnt(0)" ::: "memory");
            const unsigned og = xb_add(&bar[XB_TOP], 1u);
            const unsigned tg = og / nx;
            if (og + 1u == (tg + 1u) * nx) xb_add(&bar[XB_TOPGEN], 1u);
            else XB_SPIN(xb_ld(&bar[XB_TOPGEN]) == tg, bar);
            __builtin_amdgcn_fence(__ATOMIC_ACQUIRE, "agent");
            xb_add(&bar[XB_XGEN(b.x)], 1u);
            asm volatile("s_waitcnt vmcnt(0)" ::: "memory");
        } else {
            XB_SPIN(xb_ld(&bar[XB_XGEN(b.x)]) == gen, bar);
            __builtin_amdgcn_fence(__ATOMIC_ACQUIRE, "agent");
            asm volatile("s_waitcnt vmcnt(0)" ::: "memory");
        }
    }
    __syncthreads();
}

__device__ __forceinline__ int tid_fresh() { int t = threadIdx.x; asm volatile("" : "+v"(t)); return t; }
__device__ __forceinline__ float wsum(float v) {
#pragma unroll
    for (int o = 32; o > 0; o >>= 1) v += __shfl_xor(v, o);
    return v;
}
__device__ __forceinline__ float wmax(float v) {
#pragma unroll
    for (int o = 32; o > 0; o >>= 1) v = fmaxf(v, __shfl_xor(v, o));
    return v;
}
__device__ __forceinline__ float sigmoidf_(float x) { return 1.0f / (1.0f + __expf(-x)); }
__device__ __forceinline__ float softplusf_(float x) { return x > 20.f ? x : log1pf(__expf(x)); }

struct Args {
    const float* in[30];
    float* out;
    unsigned char* ws;
    int ph_lo, ph_hi;
};

namespace pg8 {
#define PG8_LAS __attribute__((address_space(3)))
typedef short bf16x8 __attribute__((ext_vector_type(8)));
typedef float f32x4 __attribute__((ext_vector_type(4)));
typedef unsigned u32x4 __attribute__((ext_vector_type(4)));
constexpr int BM = 256, BK = 64, HALF = 128, HTB = HALF * BK * 2, STAGE_BYTES = 8 * HTB, NXCD = 8, WGM = 8;

__host__ __device__ __forceinline__ int lds_byte(int r, int c) { const int st = (r >> 4) * 2 + (c >> 5), rr = r & 15, cc = c & 31, ob = rr * 64 + cc * 2; return st * 1024 + (ob ^ (((ob >> 9) & 1) << 5)); }
__host__ __device__ __forceinline__ void stage_rc(int b, int& R, int& C) { const int st = b / 1024, sb = b % 1024, swz = sb ^ (((sb >> 9) & 1) << 5); R = (st >> 1) * 16 + swz / 64; C = (st & 1) * 32 + (swz % 64) / 2; }
__host__ __device__ __forceinline__ int perm32(int rho) { const int n = rho >> 4, i = rho & 15; return 8 * (i >> 2) + 4 * n + (i & 3); }

struct Unit { const char* A; const char* B; int row0, col0, aux, aux2; };
struct Dims { int lda, ldb, K; };

struct TileOrder {
    int nM, nN, nwg, G, c;
    __device__ void init(int nM_, int nN_, int G_, int c_) { nM = nM_; nN = nN_; nwg = nM * nN; G = G_; c = c_; }
    __device__ bool tile(int i, int& pm, int& pn) const {
        const long L = (long)i * G + c; if (L >= nwg) return false;
        int wgid = (int)L; { const int q = nwg / NXCD, r = nwg % NXCD, xcd = wgid % NXCD, off = wgid / NXCD; wgid = (xcd < r ? xcd * (q + 1) : r * (q + 1) + (xcd - r) * q) + off; }
        const int nig = WGM * nN, gid = wgid / nig, fm = gid * WGM, gsz = (nM - fm) < WGM ? (nM - fm) : WGM;
        pm = fm + ((wgid % nig) % gsz); pn = (wgid % nig) / gsz; return true;
    }
};
struct DenseSched {
    TileOrder o; const char* A; const char* B; int lda, ldb;
    __device__ void init(const void* A_, int lda_, int M, const void* B_, int ldb_, int N) { A = (const char*)A_; B = (const char*)B_; lda = lda_; ldb = ldb_; o.init(M / BM, N / BM, gridDim.x, blockIdx.x); }
    __device__ __forceinline__ bool next(int i, Unit& u) const { int pm, pn; if (!o.tile(i, pm, pn)) return false;
        u.A = A + (size_t)pm * BM * lda * 2; u.B = B + (size_t)pn * BM * ldb * 2; u.row0 = pm * BM; u.col0 = pn * BM; u.aux = 0; u.aux2 = 0; return true; }
    __device__ __forceinline__ int arow(const Unit&, int r) const { return r; }
};

__device__ __forceinline__ unsigned cvt_pk_bf16(float lo, float hi) { unsigned r; asm volatile("v_cvt_pk_bf16_f32 %0, %1, %2" : "=v"(r) : "v"(lo), "v"(hi)); return r; }

struct EpiBf16 {
    static constexpr bool PERM = true;
    bf16_t* O; int ldc;
    __device__ __forceinline__ void operator()(const f32x4 (&acc)[2][2][4][2], const Unit& u, int wr, int wc, int fr, int fq) const {
        const int row0 = u.row0 + wr * 64 + fr, col0 = u.col0 + wc * 32 + 8 * fq;
#pragma unroll
        for (int ai = 0; ai < 2; ++ai)
#pragma unroll
            for (int m = 0; m < 4; ++m) { bf16_t* rowp = O + (size_t)(row0 + ai * HALF + m * 16) * ldc + col0;
#pragma unroll
                for (int bj = 0; bj < 2; ++bj) { const f32x4 v0 = acc[ai][bj][m][0], v1 = acc[ai][bj][m][1];
                    u32x4 w; w.x = cvt_pk_bf16(v0[0], v0[1]); w.y = cvt_pk_bf16(v0[2], v0[3]); w.z = cvt_pk_bf16(v1[0], v1[1]); w.w = cvt_pk_bf16(v1[2], v1[3]);
                    *(u32x4*)(rowp + bj * HALF) = w; } }
    }
};
struct EpiF32Res {
    static constexpr bool PERM = false;
    float* C; const float* RES; int ldc; float rs;
    __device__ __forceinline__ void operator()(const f32x4 (&acc)[2][2][4][2], const Unit& u, int wr, int wc, int fr, int fq) const {
        const int row0 = u.row0 + wr * 64 + fr, col0 = u.col0 + wc * 32 + 4 * fq;
#pragma unroll
        for (int ai = 0; ai < 2; ++ai)
#pragma unroll
            for (int m = 0; m < 4; ++m) { const size_t ro = (size_t)(row0 + ai * HALF + m * 16) * ldc + col0;
#pragma unroll
                for (int bj = 0; bj < 2; ++bj)
#pragma unroll
                    for (int n = 0; n < 2; ++n) { const f32x4 r = *(const f32x4*)(RES + ro + bj * HALF + n * 16); *(f32x4*)(C + ro + bj * HALF + n * 16) = acc[ai][bj][m][n] + r * rs; } }
    }
};

template <class Epi, class Sched, bool GATHER>
__device__ __forceinline__ void gemm_phase(PG8_LAS unsigned char* lds, const Dims g, const Sched& S, const Epi& E) {
    const int tid = tid_fresh(), wid = __builtin_amdgcn_readfirstlane(tid >> 6), lane = tid & 63, wr = wid >> 2, wc = wid & 3, fr = lane & 15, fq = lane >> 4;
    const int K = g.K, nt = K / BK;
    unsigned voffB[2];
#pragma unroll
    for (int i = 0; i < 2; ++i) { int R, C; stage_rc(tid * 16 + i * 8192, R, C); const int Rb = Epi::PERM ? ((R & ~31) + perm32(R & 31)) : R;
        voffB[i] = (unsigned)(Rb * g.ldb + C) * 2u; }
    const size_t kstep = (size_t)(BK * 2);
    const size_t hstepB = (size_t)HALF * g.ldb * 2;
    const unsigned ldsw = (unsigned)wid * 1024u;
    const int aoff = lds_byte(wr * 64 + fr, fq * 8), boff = lds_byte(wc * 32 + fr, fq * 8);
#define PG8_SA(b, h) (((b) * 2 + (h)) * HTB)
#define PG8_SB(b, h) ((4 + (b) * 2 + (h)) * HTB)
#define PG8_STAGE(bufoff, gbase, v0, v1) do { \
        __builtin_amdgcn_global_load_lds((const unsigned*)((const char*)(gbase) + (v0)), (PG8_LAS unsigned*)(lds + (bufoff) + ldsw), 16, 0, 0); \
        __builtin_amdgcn_global_load_lds((const unsigned*)((const char*)(gbase) + (v1)), (PG8_LAS unsigned*)(lds + (bufoff) + ldsw + 8192), 16, 0, 0); } while (0)
#define PG8_STAGEB(bufoff, gbase) PG8_STAGE(bufoff, gbase, voffB[0], voffB[1])
#define PG8_LDA(dst, b, h) do { _Pragma("unroll") for (int m = 0; m < 4; ++m) _Pragma("unroll") for (int k = 0; k < 2; ++k) dst[m][k] = *(const PG8_LAS bf16x8*)(lds + PG8_SA(b, h) + aoff + m * 2048 + k * 1024); } while (0)
#define PG8_LDB(dst, b, h) do { _Pragma("unroll") for (int n = 0; n < 2; ++n) _Pragma("unroll") for (int k = 0; k < 2; ++k) dst[n][k] = *(const PG8_LAS bf16x8*)(lds + PG8_SB(b, h) + boff + n * 2048 + k * 1024); } while (0)
#define PG8_MMA(ai, bj, At, Bt) do { __builtin_amdgcn_s_setprio(1); _Pragma("unroll") for (int m = 0; m < 4; ++m) _Pragma("unroll") for (int n = 0; n < 2; ++n) _Pragma("unroll") for (int k = 0; k < 2; ++k) \
        acc[ai][bj][m][n] = __builtin_amdgcn_mfma_f32_16x16x32_bf16(Bt[n][k], At[m][k], acc[ai][bj][m][n], 0, 0, 0); __builtin_amdgcn_s_setprio(0); } while (0)
#define PG8_WAIT_V(n) asm volatile("s_waitcnt vmcnt(" #n ")" ::: "memory")
#define PG8_WAIT_L(n) asm volatile("s_waitcnt lgkmcnt(" #n ")" ::: "memory")
#define PG8_BAR __builtin_amdgcn_s_barrier()
#define PG8_SCHED __builtin_amdgcn_sched_barrier(0)
#define PG8_VOFFA(dst, u) do { _Pragma("unroll") for (int i_ = 0; i_ < 2; ++i_) { int R_, C_; stage_rc(tid * 16 + i_ * 8192, R_, C_); _Pragma("unroll") for (int h_ = 0; h_ < 2; ++h_) { \
        const int rr_ = GATHER ? S.arow(u, R_ + h_ * HALF) : (R_ + h_ * HALF); dst[h_ * 2 + i_] = (unsigned)(rr_ * g.lda + C_) * 2u; } } } while (0)
    Unit cur, nxt; int ui = 0;
    if (!S.next(0, cur)) return;
    f32x4 acc[2][2][4][2];
#pragma unroll
    for (int a = 0; a < 2; ++a)
#pragma unroll
        for (int b = 0; b < 2; ++b)
#pragma unroll
            for (int m = 0; m < 4; ++m)
#pragma unroll
                for (int n = 0; n < 2; ++n) acc[a][b][m][n] = (f32x4){0.f, 0.f, 0.f, 0.f};
    bf16x8 At[4][2], B0[2][2], B1[2][2];
    unsigned vC[4];
    PG8_VOFFA(vC, cur);
    PG8_LAS u32x4* myN = (PG8_LAS u32x4*)(lds + STAGE_BYTES + tid * 16);
    const char* cA = cur.A; const char* cB = cur.B;
    PG8_STAGEB(PG8_SB(0, 0), cB); PG8_STAGEB(PG8_SB(0, 1), cB + hstepB); PG8_STAGE(PG8_SA(0, 0), cA, vC[0], vC[1]); PG8_STAGE(PG8_SA(0, 1), cA, vC[2], vC[3]);
    if (wr == 1) PG8_BAR;
    PG8_WAIT_V(2); PG8_BAR;
    PG8_STAGEB(PG8_SB(1, 0), cB + kstep); PG8_STAGE(PG8_SA(1, 0), cA + kstep, vC[0], vC[1]); PG8_STAGEB(PG8_SB(1, 1), cB + hstepB + kstep);
    PG8_WAIT_V(6); PG8_BAR;
    for (;;) {
        const bool has_next = S.next(ui + 1, nxt);
        const char* nA = cA; const char* nB = cB;
        { unsigned vT[4];
#pragma unroll
          for (int q = 0; q < 4; ++q) vT[q] = vC[q];
          if (has_next) { nA = nxt.A; nB = nxt.B; PG8_VOFFA(vT, nxt); }
          *myN = (u32x4){vT[0], vT[1], vT[2], vT[3]}; }
        for (int t = 0; t < nt; t += 2) {
            const bool last = (t == nt - 2);
            const char* a1 = cA + (size_t)(t + 1) * kstep;
            const char* a2 = last ? nA : cA + (size_t)(t + 2) * kstep; const char* b2 = last ? nB : cB + (size_t)(t + 2) * kstep;
            const char* a3 = a2 + kstep; const char* b3 = b2 + kstep;
            PG8_LDB(B0, 0, 0); PG8_LDB(B1, 0, 1); PG8_SCHED; PG8_LDA(At, 0, 0); PG8_STAGE(PG8_SA(1, 1), a1, vC[2], vC[3]);
            if (last) { const u32x4 vn = *myN; vC[0] = vn.x; vC[1] = vn.y; vC[2] = vn.z; vC[3] = vn.w; }
            PG8_WAIT_V(8); PG8_WAIT_L(0); PG8_BAR; PG8_MMA(0, 0, At, B0); PG8_MMA(0, 1, At, B1); PG8_BAR; PG8_SCHED;
            PG8_LDA(At, 0, 1); PG8_STAGEB(PG8_SB(0, 0), b2); PG8_STAGEB(PG8_SB(0, 1), b2 + hstepB); PG8_STAGE(PG8_SA(0, 0), a2, vC[0], vC[1]);
            PG8_WAIT_V(8); PG8_WAIT_L(0); PG8_BAR; PG8_MMA(1, 0, At, B0); PG8_MMA(1, 1, At, B1); PG8_BAR; PG8_SCHED;
            PG8_LDB(B0, 1, 0); PG8_LDB(B1, 1, 1); PG8_SCHED; PG8_LDA(At, 1, 0); PG8_STAGE(PG8_SA(0, 1), a2, vC[2], vC[3]);
            PG8_WAIT_V(8); PG8_WAIT_L(0); PG8_BAR; PG8_MMA(0, 0, At, B0); PG8_MMA(0, 1, At, B1); PG8_BAR; PG8_SCHED;
            PG8_LDA(At, 1, 1); PG8_STAGEB(PG8_SB(1, 0), b3); PG8_STAGEB(PG8_SB(1, 1), b3 + hstepB); PG8_STAGE(PG8_SA(1, 0), a3, vC[0], vC[1]);
            PG8_WAIT_V(8); PG8_WAIT_L(0); PG8_BAR; PG8_MMA(1, 0, At, B0); PG8_MMA(1, 1, At, B1); PG8_BAR; PG8_SCHED;
        }
        if (wr == 0) PG8_BAR;
        E(acc, cur, wr, wc, fr, fq);
        if (!has_next) break;
#pragma unroll
        for (int a = 0; a < 2; ++a)
#pragma unroll
            for (int b = 0; b < 2; ++b)
#pragma unroll
                for (int m = 0; m < 4; ++m)
#pragma unroll
                    for (int n = 0; n < 2; ++n) acc[a][b][m][n] = (f32x4){0.f, 0.f, 0.f, 0.f};
        cur = nxt; cA = nA; cB = nB; ++ui;
        if (wr == 1) PG8_BAR;
    }
    PG8_WAIT_V(0);
    PG8_BAR;
#undef PG8_SA
#undef PG8_SB
#undef PG8_STAGE
#undef PG8_STAGEB
#undef PG8_LDA
#undef PG8_LDB
#undef PG8_MMA
#undef PG8_WAIT_V
#undef PG8_WAIT_L
#undef PG8_BAR
#undef PG8_SCHED
#undef PG8_VOFFA
}
}

template <int NBM, class AF, class Epi>
__device__ __forceinline__ void sgemm_tile(float* lds, int K, AF arow, const float* __restrict__ B0, const float* __restrict__ B1, int ldb, int n0, int N, Epi epi) {
    const int tid = tid_fresh();
    float* As = lds;
    float* Bs0 = lds + 16 * 132;
    float* Bs1 = lds + 2 * 16 * 132;
    const int ty = tid >> 5, tx = tid & 31;
    float acc0[8][4], acc1[8][4];
#pragma unroll
    for (int i = 0; i < 8; ++i)
#pragma unroll
        for (int j = 0; j < 4; ++j) { acc0[i][j] = 0.f; acc1[i][j] = 0.f; }
    const int ar = tid >> 2, ak = (tid & 3) * 4;
    const float* ap = arow(ar);
    const int bk = tid >> 5, bn = (tid & 31) * 4;
    const bool bok = (n0 + bn) < N;
    for (int k0 = 0; k0 < K; k0 += 16) {
        float4 av = ap ? *(const float4*)(ap + k0 + ak) : make_float4(0.f, 0.f, 0.f, 0.f);
        float4 bv0 = bok ? *(const float4*)(B0 + (size_t)(k0 + bk) * ldb + n0 + bn) : make_float4(0.f, 0.f, 0.f, 0.f);
        float4 bv1 = make_float4(0.f, 0.f, 0.f, 0.f);
        if (NBM == 2) { if (bok) bv1 = *(const float4*)(B1 + (size_t)(k0 + bk) * ldb + n0 + bn); }
        __syncthreads();
        As[(ak + 0) * 132 + ar] = av.x; As[(ak + 1) * 132 + ar] = av.y; As[(ak + 2) * 132 + ar] = av.z; As[(ak + 3) * 132 + ar] = av.w;
        *(float4*)&Bs0[bk * 132 + bn] = bv0;
        if (NBM == 2) *(float4*)&Bs1[bk * 132 + bn] = bv1;
        __syncthreads();
#pragma unroll 2
        for (int k = 0; k < 16; ++k) {
            const float4 a0 = *(const float4*)&As[k * 132 + ty * 8], a1 = *(const float4*)&As[k * 132 + ty * 8 + 4];
            const float a[8] = {a0.x, a0.y, a0.z, a0.w, a1.x, a1.y, a1.z, a1.w};
            const float4 b0 = *(const float4*)&Bs0[k * 132 + tx * 4];
            const float bb0[4] = {b0.x, b0.y, b0.z, b0.w};
#pragma unroll
            for (int i = 0; i < 8; ++i)
#pragma unroll
                for (int j = 0; j < 4; ++j) acc0[i][j] = fmaf(a[i], bb0[j], acc0[i][j]);
            if (NBM == 2) {
                const float4 b1 = *(const float4*)&Bs1[k * 132 + tx * 4];
                const float bb1[4] = {b1.x, b1.y, b1.z, b1.w};
#pragma unroll
                for (int i = 0; i < 8; ++i)
#pragma unroll
                    for (int j = 0; j < 4; ++j) acc1[i][j] = fmaf(a[i], bb1[j], acc1[i][j]);
            }
        }
    }
    if (bok) {
#pragma unroll
        for (int i = 0; i < 8; ++i)
#pragma unroll
            for (int j = 0; j < 4; ++j) epi(ty * 8 + i, tx * 4 + j, acc0[i][j], acc1[i][j]);
    }
}

__device__ __forceinline__ void transpose_blk(const float* W, int N, bf16_t* WT, int K, int k0, int n0, int drow0, float* scr, int lane) {
#pragma unroll 8
    for (int i = 0; i < 32; ++i) { const int kk = 2 * i + (lane >> 5); scr[kk * 33 + (lane & 31)] = W[(size_t)(k0 + kk) * N + n0 + (lane & 31)]; }
    asm volatile("s_waitcnt lgkmcnt(0)" ::: "memory");
    const int c = lane & 7;
#pragma unroll
    for (int j = 0; j < 4; ++j) { const int n = (lane >> 3) + 8 * j; const float* sp = scr + (8 * c) * 33 + n;
        uint4 o; o.x = pk2(sp[0 * 33], sp[1 * 33]); o.y = pk2(sp[2 * 33], sp[3 * 33]); o.z = pk2(sp[4 * 33], sp[5 * 33]); o.w = pk2(sp[6 * 33], sp[7 * 33]);
        *(uint4*)(WT + (size_t)(drow0 + n) * K + k0 + 8 * c) = o; }
    asm volatile("s_waitcnt lgkmcnt(0)" ::: "memory");
}
__device__ __forceinline__ void transpose_item(const float* W, int K, int N, bf16_t* WT, int row_off, float* scr, int item, int lane) {
    const int nblk = N / 32, kb = item / nblk, nb = item % nblk;
    transpose_blk(W, N, WT, K, 64 * kb, 32 * nb, row_off + 32 * nb, scr, lane);
}
__device__ __forceinline__ void convert_experts(const Args& a, int l, float* lds) {
    const int tid = tid_fresh(), lane = tid & 63, wid = tid >> 6;
    float* scr = lds + wid * (64 * 33);
    const int gw = blockIdx.x * 8 + wid, NGW = gridDim.x * 8;
    bf16_t* WGU = (bf16_t*)(a.ws + WS_WEXP); bf16_t* WD = WGU + (size_t)NEXP * 1024 * 1024;
    for (int it = gw; it < NEXP * 768; it += NGW) {
        const int e = it / 768; int r = it % 768;
        if (r < 512) {
            const bool up = r >= 256; r &= 255; const int kb = r >> 4, nb = r & 15, n0 = 32 * nb;
            const float* W = (up ? a.in[26] : a.in[25]) + ((size_t)l * NEXP + e) * DM * DEXP;
            transpose_blk(W, DEXP, WGU + (size_t)e * 1024 * 1024, DM, 64 * kb, n0, 256 * (n0 >> 7) + (n0 & 127) + (up ? 128 : 0), scr, lane);
        } else {
            r -= 512; const int kb = r >> 5, nb = r & 31;
            const float* W = a.in[27] + ((size_t)l * NEXP + e) * DEXP * DM;
            transpose_blk(W, DM, WD + (size_t)e * 1024 * 512, DEXP, 64 * kb, 32 * nb, 32 * nb, scr, lane);
        }
    }
}
__device__ __forceinline__ void cvt_row(const float* in, bf16_t* out, int lane) {
#pragma unroll
    for (int j = 0; j < 4; ++j) { const float4 v = *(const float4*)(in + j * 256 + lane * 4); uint2 o; o.x = pk2(v.x, v.y); o.y = pk2(v.z, v.w); *(uint2*)(out + j * 256 + lane * 4) = o; }
}
__device__ __forceinline__ void phase_prologue(const Args& a, float* lds) {
    const int tid = tid_fresh(), lane = tid & 63, wid = tid >> 6;
    float* scr = lds + wid * (64 * 33);
    const int gw = blockIdx.x * 8 + wid, NGW = gridDim.x * 8;
    bf16_t* WIN0 = (bf16_t*)(a.ws + WS_WIN0); bf16_t* WIN1 = (bf16_t*)(a.ws + WS_WIN1);
    constexpr int I_IN = 16 * 104, I_VR = 16, I_SQ = 16 * 32, I_KV = 16 * 64;
    constexpr int NITEMS = 2 * I_IN + I_VR + 6 * I_SQ + 2 * I_KV;
    for (int it = gw; it < NITEMS; it += NGW) {
        int r = it;
        if (r < I_IN) { transpose_item(a.in[2], DM, IN_COLS, WIN0, 0, scr, r, lane); continue; } r -= I_IN;
        if (r < I_IN) { transpose_item(a.in[2] + (size_t)DM * IN_COLS, DM, IN_COLS, WIN1, 0, scr, r, lane); continue; } r -= I_IN;
        if (r < I_VR) { transpose_item(a.in[3], DM, 32, WIN1, IN_COLS, scr, r, lane); continue; } r -= I_VR;
        constexpr int I_L = 3 * I_SQ + I_KV;
        const int l = r / I_L; r -= l * I_L;
        if (r < I_SQ) { transpose_item(a.in[19] + (size_t)l * DM * DM, DM, DM, (bf16_t*)(a.ws + WS_WOUT) + (size_t)l * DM * DM, 0, scr, r, lane); continue; } r -= I_SQ;
        if (r < I_SQ) { transpose_item(a.in[20] + (size_t)l * DM * DM, DM, DM, (bf16_t*)(a.ws + WS_WQ) + (size_t)l * DM * DM, 0, scr, r, lane); continue; } r -= I_SQ;
        if (r < I_KV) { transpose_item(a.in[21] + (size_t)l * DM * 2048, DM, 2048, (bf16_t*)(a.ws + WS_WKV) + (size_t)l * DM * 2048, 0, scr, r, lane); continue; } r -= I_KV;
        transpose_item(a.in[22] + (size_t)l * DM * DM, DM, DM, (bf16_t*)(a.ws + WS_WO) + (size_t)l * DM * DM, 0, scr, r, lane);
    }
    for (int r = gw; r < 224; r += NGW) {
#pragma unroll
        for (int j = 0; j < 2; ++j) *(uint4*)(WIN1 + (size_t)(3360 + r) * DM + j * 512 + lane * 8) = make_uint4(0u, 0u, 0u, 0u);
    }
    bf16_t* XB = (bf16_t*)(a.ws + WS_XB); bf16_t* MEMB = (bf16_t*)(a.ws + WS_MEMB);
    for (int m = gw; m < NTOK; m += NGW) cvt_row(a.in[0] + (size_t)m * DM, XB + (size_t)m * DM, lane);
    for (int m = gw; m < NBATCH * MEMLEN; m += NGW) cvt_row(a.in[1] + (size_t)m * DM, MEMB + (size_t)m * DM, lane);
    convert_experts(a, 0, lds);
}

__device__ __forceinline__ void phase_g1(const Args& a, int l, PG8_LAS unsigned char* lds) {
    pg8::DenseSched S; S.init(a.ws + WS_XB, DM, NTOK, a.ws + (l == 0 ? WS_WIN0 : WS_WIN1), DM, l == 0 ? IN_COLS : ZLD);
    pg8::EpiBf16 E{(bf16_t*)(a.ws + WS_Z), ZLD};
    pg8::gemm_phase<pg8::EpiBf16, pg8::DenseSched, false>(lds, pg8::Dims{DM, DM, DM}, S, E);
}

typedef _Float16 h8_t __attribute__((ext_vector_type(8)));
typedef _Float16 h2_t __attribute__((ext_vector_type(2)));
__device__ __forceinline__ unsigned pkh2(float lo, float hi) { h2_t v = {(_Float16)lo, (_Float16)hi}; return __builtin_bit_cast(unsigned, v); }
__device__ __forceinline__ void phase_prep(const Args& a, int l, float* lds) {
    const bf16_t* Z = (const bf16_t*)(a.ws + WS_Z);
    const int tid = tid_fresh(), lane = tid & 63, wid = tid >> 6;
    float* KM = (float*)(a.ws + WS_KMEAN);
    for (int u = blockIdx.x * 8 + wid; u < NBATCH * NH * 8; u += gridDim.x * 8) {
        const int nb = u & 7, h = (u >> 3) & 7, b = u >> 6;
        const bf16_t* p = Z + (size_t)(b * SEQ + nb * 256) * ZLD + C_K + h * HD + lane;
        float s = 0.f;
#pragma unroll 8
        for (int i = 0; i < 256; ++i) s += bf2f(p[(size_t)i * ZLD]);
        KM[(size_t)u * 64 + lane] = s * (1.0f / 256.0f);
    }
    const float* mu = a.in[4] + (size_t)l * 1792;
    const float* muv = a.in[5];
    const float* Wd = a.in[7] + (size_t)l * 64 * 512;
    const float* Wi = a.in[9] + (size_t)l * 64 * 512;
    const float* Wv = a.in[11];
    const float* Wg = a.in[12] + (size_t)l * 128 * 512;
    const int c = tid, h = wid, j = lane;
    const float w0c = a.in[6][l * 512 + c], a0c = a.in[8][l * 512 + c], v0c = a.in[10][c];
    const float mu_r = mu[c], mu_k = mu[512 + c], mu_v = mu[1024 + c];
    const float kk_c = a.in[13][l * 512 + c], ka_c = a.in[14][l * 512 + c], rk_c = a.in[15][l * 512 + c];
    unsigned* REC = (unsigned*)(a.ws + WS_REC);
    _Float16* RVT = (_Float16*)(a.ws + WS_RVT); bf16_t* RGp = (bf16_t*)(a.ws + WS_RG); float* BON = (float*)(a.ws + WS_BON);
    bf16_t* VF = (bf16_t*)(a.ws + WS_VFIRST);
    float* sh = lds;
    for (int tok = blockIdx.x; tok < NTOK; tok += gridDim.x) {
        const bool first = (tok % SEQ) == 0;
        const int b = tok / SEQ, t = tok % SEQ, bh = b * NH + h;
        __syncthreads();
        if (tid < 288) {
            const int zc = (tid < 256) ? (C_ZW + tid) : (C_ZV + tid - 256);
            const float m = (tid < 256) ? mu[zc - C_R] : muv[tid - 256];
            const bool ok = (tid < 256) || (l == 1);
            float v = 0.f;
            if (ok) {
                const float cur = bf2f(Z[(size_t)tok * ZLD + zc]);
                const float prev = first ? 0.f : bf2f(Z[(size_t)(tok - 1) * ZLD + zc]);
                v = cur + (prev - cur) * m;
                if (tid < 64) v = tanhf(v);
                else if (tid >= 128 && tid < 256) v = sigmoidf_(v);
            }
            sh[tid] = v;
        }
        __syncthreads();
        float sd = w0c, sa = a0c, sg = 0.f;
#pragma unroll 8
        for (int q = 0; q < 64; ++q) { sd = fmaf(sh[q], Wd[q * 512 + c], sd); sa = fmaf(sh[64 + q], Wi[q * 512 + c], sa); }
#pragma unroll 8
        for (int q = 0; q < 128; ++q) sg = fmaf(sh[128 + q], Wg[q * 512 + c], sg);
        const float log_w = -softplusf_(-sd) - 0.5f;
        const float uu = -expm1f(-__expf(log_w));
        const float ai = sigmoidf_(sa);
        const float zr = bf2f(Z[(size_t)tok * ZLD + C_R + c]), zk = bf2f(Z[(size_t)tok * ZLD + C_KR + c]), zv = bf2f(Z[(size_t)tok * ZLD + C_VR + c]);
        float pr = 0.f, pk = 0.f, pv = 0.f;
        if (!first) { pr = bf2f(Z[(size_t)(tok - 1) * ZLD + C_R + c]); pk = bf2f(Z[(size_t)(tok - 1) * ZLD + C_KR + c]); pv = bf2f(Z[(size_t)(tok - 1) * ZLD + C_VR + c]); }
        const float r = zr + (pr - zr) * mu_r, k = zk + (pk - zk) * mu_k;
        float v = zv + (pv - zv) * mu_v;
        if (l == 0) VF[(size_t)tok * 512 + c] = f2bf(v);
        else {
            float sv = v0c;
#pragma unroll 8
            for (int q = 0; q < 32; ++q) sv = fmaf(sh[256 + q], Wv[q * 512 + c], sv);
            v = v + (bf2f(VF[(size_t)tok * 512 + c]) - v) * sigmoidf_(sv);
        }
        float kk = k * kk_c;
        const float ss = wsum(kk * kk);
        kk = kk * rsqrtf(fmaxf(ss, 1e-24f));
        const float kp = k * (1.0f + (ai - 1.0f) * ka_c);
        const float bon = wsum(r * kp * rk_c);
        const float vals[5] = {uu, -kk, kk * ai, kp, r};
        const size_t rbase = ((((size_t)bh * 512 + (t >> 2)) * 32 + (j >> 1)) * 4 + (t & 3)) * 5;
#pragma unroll
        for (int q = 0; q < 5; ++q) { const float o = __shfl_down(vals[q], 1); if (!(j & 1)) REC[rbase + q] = pkh2(vals[q], o); }
        RVT[(((size_t)bh * 256 + (t >> 3)) * 64 + j) * 8 + (t & 7)] = (_Float16)v;
        RGp[(size_t)tok * 512 + c] = f2bf(sg);
        if (j == 0) BON[tok * 8 + h] = bon;
    }
}

__device__ __forceinline__ float dpp_add(float x, float y_src, int) { return x + y_src; }
#define SC_DPP(x, ctrl) __int_as_float(__builtin_amdgcn_mov_dpp(__float_as_int(x), ctrl, 0xF, 0xF, true))
__device__ __forceinline__ float red32(float x) {
    x += SC_DPP(x, 0xB1); x += SC_DPP(x, 0x4E); x += SC_DPP(x, 0x141); x += SC_DPP(x, 0x140);
    auto rr = __builtin_amdgcn_permlane32_swap(__float_as_uint(x), __float_as_uint(x), false, false);
    return __uint_as_float(rr[0]) + __uint_as_float(rr[1]);
}
__device__ __forceinline__ void phase_scan(const Args& a, int l, PG8_LAS unsigned char* lds) {
    const int tid = tid_fresh(), lane = tid & 63, wid = __builtin_amdgcn_readfirstlane(tid >> 6);
    const int j2 = (lane & 15) | ((lane >> 5) << 4), rr = (lane >> 4) & 1;
    const char* REC = (const char*)(a.ws + WS_REC); const char* RVT = (const char*)(a.ws + WS_RVT);
    bf16_t* YR = (bf16_t*)(a.ws + WS_YRAW);
    constexpr int CH_REC = 40960, CH_V = 8192, CH = CH_REC + CH_V;
    for (int u = blockIdx.x; u < 256; u += gridDim.x) {
        const int bh = u >> 2, rg = u & 3, b = bh >> 3, h = bh & 7;
        const int irow = rg * 16 + wid * 2 + rr;
        const char* grec = REC + (size_t)bh * 32 * CH_REC; const char* gv = RVT + (size_t)bh * 32 * CH_V;
        float S0 = 0.f, S1 = 0.f, ykeep = 0.f;
        __syncthreads();
#pragma unroll
        for (int k = 0; k < 6; ++k) { const int pc = wid * 6 + k; const char* src = (pc < 40) ? grec + pc * 1024 + lane * 16 : gv + (pc - 40) * 1024 + lane * 16;
            __builtin_amdgcn_global_load_lds((const unsigned*)src, (PG8_LAS unsigned*)(lds + pc * 1024), 16, 0, 0); }
        for (int ch = 0; ch < 32; ++ch) {
            asm volatile("s_waitcnt vmcnt(0)" ::: "memory");
            __syncthreads();
            if (ch + 1 < 32) {
                const int nb = ((ch + 1) & 1) * CH;
#pragma unroll
                for (int k = 0; k < 6; ++k) { const int pc = wid * 6 + k; const char* src = (pc < 40) ? grec + (size_t)(ch + 1) * CH_REC + pc * 1024 + lane * 16 : gv + (size_t)(ch + 1) * CH_V + (pc - 40) * 1024 + lane * 16;
                    __builtin_amdgcn_global_load_lds((const unsigned*)src, (PG8_LAS unsigned*)(lds + nb + pc * 1024), 16, 0, 0); }
            }
            PG8_LAS const unsigned char* bufp = lds + (ch & 1) * CH;
            for (int g8 = 0; g8 < 8; ++g8) {
                const h8_t vv = *(PG8_LAS const h8_t*)(bufp + CH_REC + (g8 * 64 + irow) * 16);
#pragma unroll
                for (int hf = 0; hf < 2; ++hf) {
                    PG8_LAS const unsigned char* rp = bufp + ((g8 * 2 + hf) * 32 + j2) * 80;
                    h8_t rv[5];
#pragma unroll
                    for (int k = 0; k < 5; ++k) rv[k] = *(PG8_LAS const h8_t*)(rp + 16 * k);
#pragma unroll
                    for (int ts = 0; ts < 4; ++ts) {
#define SC_H(n) ((float)rv[(n) >> 3][(n) & 7])
                        const float u0 = SC_H(ts * 10 + 0), u1 = SC_H(ts * 10 + 1), a0 = SC_H(ts * 10 + 2), a1 = SC_H(ts * 10 + 3), b0 = SC_H(ts * 10 + 4), b1 = SC_H(ts * 10 + 5);
                        const float k0 = SC_H(ts * 10 + 6), k1 = SC_H(ts * 10 + 7), r0 = SC_H(ts * 10 + 8), r1 = SC_H(ts * 10 + 9);
#undef SC_H
                        const float v = (float)vv[hf * 4 + ts];
                        const float sa = red32(fmaf(S1, a1, S0 * a0));
                        S0 = fmaf(v, k0, fmaf(sa, b0, fmaf(-S0, u0, S0)));
                        S1 = fmaf(v, k1, fmaf(sa, b1, fmaf(-S1, u1, S1)));
                        const float y = red32(fmaf(S1, r1, S0 * r0));
                        if (j2 == ((g8 & 3) * 8 + hf * 4 + ts)) ykeep = y;
                    }
                }
                if ((g8 & 3) == 3) {
                    const int t = ch * 64 + (g8 >> 2) * 32 + j2;
                    YR[((size_t)b * SEQ + t) * 512 + h * 64 + irow] = f2bf(ykeep);
                }
            }
        }
    }
}

__device__ __forceinline__ void phase_post(const Args& a, int l) {
    const int tid = tid_fresh(), lane = tid & 63, wid = tid >> 6;
    const bf16_t* YR = (const bf16_t*)(a.ws + WS_YRAW); const _Float16* RVT = (const _Float16*)(a.ws + WS_RVT);
    const bf16_t* RGp = (const bf16_t*)(a.ws + WS_RG); const float* BON = (const float*)(a.ws + WS_BON);
    bf16_t* MIX = (bf16_t*)(a.ws + WS_MIX);
    for (int u = blockIdx.x; u < 64 * 256; u += gridDim.x) {
        const int bh = u >> 8, t8 = u & 255, b = bh >> 3, h = bh & 7, t = t8 * 8 + wid;
        const size_t tok = (size_t)b * SEQ + t; const int c = h * 64 + lane;
        const float y = bf2f(YR[tok * 512 + c]);
        const float my = wsum(y) * (1.0f / 64.0f);
        const float dy = y - my;
        const float var = wsum(dy * dy) * (1.0f / 64.0f);
        const float yn = dy * rsqrtf(var + 64e-5f) * a.in[16][l * 512 + c] + a.in[17][l * 512 + c];
        const float v = (float)RVT[(((size_t)bh * 256 + t8) * 64 + lane) * 8 + wid];
        MIX[tok * DM + 512 + c] = f2bf((yn + BON[tok * 8 + h] * v) * bf2f(RGp[tok * 512 + c]));
    }
}

namespace att {
typedef short bf16x8 __attribute__((ext_vector_type(8)));
typedef short s16x4 __attribute__((ext_vector_type(4)));
typedef float f32x16 __attribute__((ext_vector_type(16)));
typedef __attribute__((address_space(3))) const unsigned char* lds_cptr;
constexpr int SLOT = 8192, L_K = 0, L_V = 2 * SLOT, L_WS = 4 * SLOT, L_KM = L_WS + 8 * 256, L_OST = L_KM + 2048, OST_LD = 68, L_END = L_OST + 8 * 32 * OST_LD * 4;
constexpr float C2 = 0.125f * 1.4426950408889634f;
__device__ __forceinline__ int crow(int r, int hi) { return (r & 3) + 8 * (r >> 2) + 4 * hi; }
__device__ __forceinline__ s16x4 vtr(lds_cptr p) { return __builtin_bit_cast(s16x4, __builtin_amdgcn_ds_read_tr16_b64_v4i16((__attribute__((address_space(3))) s16x4*)p)); }
__device__ __forceinline__ float swapmax(float x) { auto rr = __builtin_amdgcn_permlane32_swap(__float_as_uint(x), __float_as_uint(x), false, false); return fmaxf(__uint_as_float(rr[0]), __uint_as_float(rr[1])); }
__device__ __forceinline__ float swapsum(float x) { auto rr = __builtin_amdgcn_permlane32_swap(__float_as_uint(x), __float_as_uint(x), false, false); return __uint_as_float(rr[0]) + __uint_as_float(rr[1]); }

__device__ __forceinline__ void unit(const Args& a, int l, int b, int h, int cur, PG8_LAS unsigned char* lds) {
    const int tid = tid_fresh(), lane = tid & 63, r32 = lane & 31, hi = lane >> 5, wid = __builtin_amdgcn_readfirstlane(tid >> 6);
    const bf16_t* Zb = (const bf16_t*)(a.ws + WS_Z) + (size_t)b * SEQ * ZLD;
    const int qrel = wid * 32 + r32, qpos = cur * 256 + qrel;
    PG8_LAS float* wsf = (PG8_LAS float*)(lds + L_WS) + wid * 64;
    PG8_LAS float* kmf = (PG8_LAS float*)(lds + L_KM);
    __syncthreads();
    kmf[tid] = ((const float*)(a.ws + WS_KMEAN))[(size_t)(b * NH + h) * 512 + tid];
    const bf16_t* ksrc = Zb + (size_t)lane * ZLD + C_K + h * HD + wid * 8;
    const bf16_t* vsrc = Zb + (size_t)(16 * (wid & 3) + (lane >> 2)) * ZLD + C_V + h * HD + (wid >> 2) * 32 + (lane & 3) * 8;
#define ATT_DMA(kpos0, slot) do { \
        __builtin_amdgcn_global_load_lds((const unsigned*)(ksrc + (size_t)(kpos0) * ZLD), (PG8_LAS unsigned*)(lds + L_K + (slot) * SLOT + wid * 1024), 16, 0, 0); \
        __builtin_amdgcn_global_load_lds((const unsigned*)(vsrc + (size_t)(kpos0) * ZLD), (PG8_LAS unsigned*)(lds + L_V + (slot) * SLOT + wid * 1024), 16, 0, 0); } while (0)
    ATT_DMA(cur * 256, 0);
    bf16x8 qr[4];
#pragma unroll
    for (int d0 = 0; d0 < 4; ++d0) qr[d0] = *(const bf16x8*)(Zb + (size_t)qpos * ZLD + C_Q + h * HD + d0 * 16 + hi * 8);
    __syncthreads();
    unsigned selbits = 0u;
    {
        float g[8];
#pragma unroll
        for (int n = 0; n < 8; ++n) g[n] = 0.f;
#pragma unroll
        for (int d0 = 0; d0 < 4; ++d0)
#pragma unroll
            for (int j = 0; j < 8; ++j) { const float qv = bf2f((bf16_t)qr[d0][j]);
#pragma unroll
                for (int n = 0; n < 8; ++n) g[n] = fmaf(qv, kmf[n * 64 + d0 * 16 + hi * 8 + j], g[n]); }
#pragma unroll
        for (int n = 0; n < 8; ++n) g[n] = (n < cur) ? swapsum(g[n]) : NEG_INF;
        if (cur <= 3) selbits = (1u << cur) - 1u;
        else {
            int s0 = -1, s1 = -1, s2 = -1; float bv = -3e38f;
#pragma unroll
            for (int n = 0; n < 8; ++n) if (g[n] > bv) { bv = g[n]; s0 = n; }
            bv = -3e38f;
#pragma unroll
            for (int n = 0; n < 8; ++n) if (n != s0 && g[n] > bv) { bv = g[n]; s1 = n; }
            bv = -3e38f;
#pragma unroll
            for (int n = 0; n < 8; ++n) if (n != s0 && n != s1 && g[n] > bv) { bv = g[n]; s2 = n; }
            selbits = (1u << s0) | (1u << s1) | (1u << s2);
        }
    }
    const float s8 = 8.0f * exp2f(-(float)(h + 1));
    f32x16 base;
#pragma unroll
    for (int r = 0; r < 16; ++r) base[r] = s8 * (float)crow(r, hi);
    f32x16 o0, o1;
#pragma unroll
    for (int r = 0; r < 16; ++r) { o0[r] = 0.f; o1[r] = 0.f; }
    float m = -INFINITY, lsum = 0.f;
    const int NT = 4 * (cur + 1);
    const lds_cptr kp = (lds_cptr)(lds + L_K) + hi * 1024 + r32 * 16;
    const lds_cptr vp = (lds_cptr)(lds + L_V) + ((lane >> 4) & 1) * 32 + (lane & 3) * 8 + (4 * hi + ((lane & 15) >> 2)) * 64;
    for (int it = 0; it < NT; ++it) {
        asm volatile("s_waitcnt vmcnt(0)" ::: "memory");
        __syncthreads();
        const int blk = (it < 4) ? cur : ((it >> 2) - 1);
        const int kpos0 = blk * 256 + (it & 3) * 64;
        if (it + 1 < NT) { const int nblk = (it + 1 < 4) ? cur : (((it + 1) >> 2) - 1); ATT_DMA(nblk * 256 + ((it + 1) & 3) * 64, (it + 1) & 1); }
        const int so = (it & 1) * SLOT;
        f32x16 p0 = base, p1 = base;
#pragma unroll
        for (int d0 = 0; d0 < 4; ++d0) {
            const bf16x8 k0 = *(const __attribute__((address_space(3))) bf16x8*)(kp + so + d0 * 2048);
            const bf16x8 k1 = *(const __attribute__((address_space(3))) bf16x8*)(kp + so + d0 * 2048 + 512);
            p0 = __builtin_amdgcn_mfma_f32_32x32x16_bf16(k0, qr[d0], p0, 0, 0, 0);
            p1 = __builtin_amdgcn_mfma_f32_32x32x16_bf16(k1, qr[d0], p1, 0, 0, 0);
        }
        const bool rowsel = (it < 4) || ((selbits >> blk) & 1u);
        const float cb = rowsel ? -s8 * (float)(qpos - kpos0) : -INFINITY;
        const float cb1 = cb + s8 * 32.0f;
        if (it < 4) {
            const int kb0 = (it & 3) * 64 + 4 * hi;
#pragma unroll
            for (int r = 0; r < 16; ++r) { const int kv = kb0 + (r & 3) + 8 * (r >> 2); if (kv > qrel) p0[r] = -INFINITY; if (kv + 32 > qrel) p1[r] = -INFINITY; }
        }
        float mx0 = p0[0], mx1 = p1[0];
#pragma unroll
        for (int r = 1; r < 16; ++r) { mx0 = fmaxf(mx0, p0[r]); mx1 = fmaxf(mx1, p1[r]); }
        const float mx = swapmax(fmaxf(mx0 + cb, mx1 + cb1));
        if (__any((mx - m) * C2 > 6.0f)) {
            const float mn = fmaxf(m, mx);
            const float alpha = __builtin_amdgcn_exp2f((m - mn) * C2);
            m = mn; lsum *= alpha;
            asm volatile("s_waitcnt lgkmcnt(0)" ::: "memory");
            if (hi == 0) wsf[r32] = alpha;
            asm volatile("s_waitcnt lgkmcnt(0)" ::: "memory");
#pragma unroll
            for (int r = 0; r < 16; ++r) { const float al = wsf[crow(r, hi)]; o0[r] *= al; o1[r] *= al; }
        }
        const float tb0 = (cb - m) * C2, tb1 = (cb1 - m) * C2;
        float ls = 0.f;
#pragma unroll
        for (int r = 0; r < 16; ++r) { p0[r] = __builtin_amdgcn_exp2f(fmaf(p0[r], C2, tb0)); p1[r] = __builtin_amdgcn_exp2f(fmaf(p1[r], C2, tb1)); ls += p0[r] + p1[r]; }
        lsum += ls;
        pg8::u32x4 w0, w1, w2, w3;
        w0.x = pk2(p0[0], p0[1]); w0.y = pk2(p0[2], p0[3]); w0.z = pk2(p0[4], p0[5]); w0.w = pk2(p0[6], p0[7]);
        w1.x = pk2(p0[8], p0[9]); w1.y = pk2(p0[10], p0[11]); w1.z = pk2(p0[12], p0[13]); w1.w = pk2(p0[14], p0[15]);
        w2.x = pk2(p1[0], p1[1]); w2.y = pk2(p1[2], p1[3]); w2.z = pk2(p1[4], p1[5]); w2.w = pk2(p1[6], p1[7]);
        w3.x = pk2(p1[8], p1[9]); w3.y = pk2(p1[10], p1[11]); w3.z = pk2(p1[12], p1[13]); w3.w = pk2(p1[14], p1[15]);
        const bf16x8 pa0 = __builtin_bit_cast(bf16x8, w0), pa1 = __builtin_bit_cast(bf16x8, w1), pa2 = __builtin_bit_cast(bf16x8, w2), pa3 = __builtin_bit_cast(bf16x8, w3);
#define ATT_VF(d0, ks) ({ const s16x4 lo_ = vtr(vp + so + (d0) * 4096 + (ks) * 1024), hi_ = vtr(vp + so + (d0) * 4096 + (ks) * 1024 + 512); \
        (bf16x8){lo_[0], lo_[1], lo_[2], lo_[3], hi_[0], hi_[1], hi_[2], hi_[3]}; })
        o0 = __builtin_amdgcn_mfma_f32_32x32x16_bf16(pa0, ATT_VF(0, 0), o0, 0, 0, 0);
        o1 = __builtin_amdgcn_mfma_f32_32x32x16_bf16(pa0, ATT_VF(1, 0), o1, 0, 0, 0);
        o0 = __builtin_amdgcn_mfma_f32_32x32x16_bf16(pa1, ATT_VF(0, 1), o0, 0, 0, 0);
        o1 = __builtin_amdgcn_mfma_f32_32x32x16_bf16(pa1, ATT_VF(1, 1), o1, 0, 0, 0);
        o0 = __builtin_amdgcn_mfma_f32_32x32x16_bf16(pa2, ATT_VF(0, 2), o0, 0, 0, 0);
        o1 = __builtin_amdgcn_mfma_f32_32x32x16_bf16(pa2, ATT_VF(1, 2), o1, 0, 0, 0);
        o0 = __builtin_amdgcn_mfma_f32_32x32x16_bf16(pa3, ATT_VF(0, 3), o0, 0, 0, 0);
        o1 = __builtin_amdgcn_mfma_f32_32x32x16_bf16(pa3, ATT_VF(1, 3), o1, 0, 0, 0);
#undef ATT_VF
    }
#undef ATT_DMA
    const float lt = swapsum(lsum);
    asm volatile("s_waitcnt lgkmcnt(0)" ::: "memory");
    if (hi == 0) wsf[r32] = 1.0f / lt;
    asm volatile("s_waitcnt lgkmcnt(0)" ::: "memory");
    PG8_LAS float* stg = (PG8_LAS float*)(lds + L_OST) + wid * (32 * OST_LD);
#pragma unroll
    for (int r = 0; r < 16; ++r) { const int orow = crow(r, hi); const float il = wsf[orow]; stg[orow * OST_LD + r32] = o0[r] * il; stg[orow * OST_LD + 32 + r32] = o1[r] * il; }
    asm volatile("s_waitcnt lgkmcnt(0)" ::: "memory");
    const float* gain = a.in[18] + l * 512 + h * HD;
    bf16_t* MIX = (bf16_t*)(a.ws + WS_MIX);
#pragma unroll
    for (int i = 0; i < 4; ++i) {
        const int row = i * 8 + (lane >> 3), ch = lane & 7;
        const pg8::f32x4 va = *(PG8_LAS const pg8::f32x4*)(stg + row * OST_LD + ch * 8), vb = *(PG8_LAS const pg8::f32x4*)(stg + row * OST_LD + ch * 8 + 4);
        float ss = va[0] * va[0] + va[1] * va[1] + va[2] * va[2] + va[3] * va[3] + vb[0] * vb[0] + vb[1] * vb[1] + vb[2] * vb[2] + vb[3] * vb[3];
        ss += SC_DPP(ss, 0xB1); ss += SC_DPP(ss, 0x4E); ss += SC_DPP(ss, 0x141);
        const float rs = rsqrtf(ss * (1.0f / 64.0f) + 1e-6f);
        const pg8::f32x4 ga = *(const pg8::f32x4*)(gain + ch * 8), gb = *(const pg8::f32x4*)(gain + ch * 8 + 4);
        pg8::u32x4 w; w.x = pk2(va[0] * rs * ga[0], va[1] * rs * ga[1]); w.y = pk2(va[2] * rs * ga[2], va[3] * rs * ga[3]);
        w.z = pk2(vb[0] * rs * gb[0], vb[1] * rs * gb[1]); w.w = pk2(vb[2] * rs * gb[2], vb[3] * rs * gb[3]);
        *(pg8::u32x4*)(MIX + ((size_t)b * SEQ + cur * 256 + wid * 32 + row) * DM + h * HD + ch * 8) = w;
    }
}
}

__device__ __forceinline__ void phase_att(const Args& a, int l, PG8_LAS unsigned char* lds) {
    const int G = gridDim.x, bx = blockIdx.x;
    const int v = (G % 8 == 0) ? (bx % 8) * (G / 8) + bx / 8 : bx;
    for (int w = v; w < 256; w += G) {
        const int bh = w >> 2, s = w & 3;
        att::unit(a, l, bh >> 3, bh & 7, 7 - s, lds);
        att::unit(a, l, bh >> 3, bh & 7, s, lds);
    }
}

__device__ __forceinline__ void phase_dense_res(const void* A, const void* WT, const float* RES, float* OUT, PG8_LAS unsigned char* lds) {
    pg8::DenseSched S; S.init(A, DM, NTOK, WT, DM, DM);
    pg8::EpiF32Res E{OUT, RES, DM, ALPHA};
    pg8::gemm_phase<pg8::EpiF32Res, pg8::DenseSched, false>(lds, pg8::Dims{DM, DM, DM}, S, E);
}
__device__ __forceinline__ void phase_dense_bf16(const void* A, int M, const void* WT, int N, bf16_t* OUT, PG8_LAS unsigned char* lds) {
    pg8::DenseSched S; S.init(A, DM, M, WT, DM, N);
    pg8::EpiBf16 E{OUT, N};
    pg8::gemm_phase<pg8::EpiBf16, pg8::DenseSched, false>(lds, pg8::Dims{DM, DM, DM}, S, E);
}

__device__ __forceinline__ void ln_row(const float* in, const float* g, const float* bta, float* out, bf16_t* outb, int lane, float (&xn)[16]) {
    float x[16];
#pragma unroll
    for (int m = 0; m < 4; ++m) { const float4 v = *(const float4*)(in + m * 256 + lane * 4); x[m * 4] = v.x; x[m * 4 + 1] = v.y; x[m * 4 + 2] = v.z; x[m * 4 + 3] = v.w; }
    float s = 0.f;
#pragma unroll
    for (int k = 0; k < 16; ++k) s += x[k];
    const float mean = wsum(s) * (1.0f / 1024.0f);
    float q = 0.f;
#pragma unroll
    for (int k = 0; k < 16; ++k) { const float d = x[k] - mean; q = fmaf(d, d, q); }
    const float var = wsum(q) * (1.0f / 1024.0f);
    const float rstd = rsqrtf(var + 1e-5f);
#pragma unroll
    for (int m = 0; m < 4; ++m) {
        const float4 gv = *(const float4*)(g + m * 256 + lane * 4), bv = *(const float4*)(bta + m * 256 + lane * 4);
        float4 o;
        o.x = (x[m * 4] - mean) * rstd * gv.x + bv.x; o.y = (x[m * 4 + 1] - mean) * rstd * gv.y + bv.y;
        o.z = (x[m * 4 + 2] - mean) * rstd * gv.z + bv.z; o.w = (x[m * 4 + 3] - mean) * rstd * gv.w + bv.w;
        xn[m * 4] = o.x; xn[m * 4 + 1] = o.y; xn[m * 4 + 2] = o.z; xn[m * 4 + 3] = o.w;
        *(float4*)(out + m * 256 + lane * 4) = o;
        uint2 ob; ob.x = pk2(o.x, o.y); ob.y = pk2(o.z, o.w); *(uint2*)(outb + m * 256 + lane * 4) = ob;
    }
}
__device__ __forceinline__ void phase_ln(const float* IN, const float* g, const float* bta, float* OUT, bf16_t* OUTB) {
    const int tid = tid_fresh(), lane = tid & 63, wid = tid >> 6;
    for (int row = blockIdx.x * 8 + wid; row < NTOK; row += gridDim.x * 8) {
        float xn[16];
        ln_row(IN + (size_t)row * DM, g, bta, OUT + (size_t)row * DM, OUTB + (size_t)row * DM, lane, xn);
    }
}

__device__ __forceinline__ void phase_ln2_router(const Args& a, int l, float* lds) {
    const int tid = tid_fresh(), lane = tid & 63, wid = tid >> 6;
    const float* PRE = (const float*)(a.ws + WS_PRE2);
    float* X2 = (float*)(a.ws + WS_X2); bf16_t* X2B = (bf16_t*)(a.ws + WS_X2B);
    const float* g = a.in[28] + (size_t)(l * 3 + 1) * DM; const float* bta = a.in[29] + (size_t)(l * 3 + 1) * DM;
    const float* WR = a.in[23]; const float* BR = a.in[24];
    unsigned* cnt = (unsigned*)(a.ws + WS_CTL) + CW_CNT + l * 32;
    int2* list = (int2*)(a.ws + WS_LIST);
    int2* tokpos = (int2*)(a.ws + WS_TOKPOS);
    __syncthreads();
    for (int idx = tid; idx < DM * NEXP; idx += NTHREADS) { const int k = idx >> 5, e = idx & 31; lds[e * DM + k] = WR[idx]; }
    __syncthreads();
    for (int row = blockIdx.x * 8 + wid; row < NTOK; row += gridDim.x * 8) {
        float xn[16];
        ln_row(PRE + (size_t)row * DM, g, bta, X2 + (size_t)row * DM, X2B + (size_t)row * DM, lane, xn);
        float mylogit = 0.f;
#pragma unroll 4
        for (int e = 0; e < NEXP; ++e) {
            float p = 0.f;
#pragma unroll
            for (int m = 0; m < 4; ++m) { const float4 wv = *(const float4*)&lds[e * DM + m * 256 + lane * 4];
                p = fmaf(xn[m * 4], wv.x, p); p = fmaf(xn[m * 4 + 1], wv.y, p); p = fmaf(xn[m * 4 + 2], wv.z, p); p = fmaf(xn[m * 4 + 3], wv.w, p); }
            p = wsum(p);
            if (lane == e) mylogit = p;
        }
        const float s = sigmoidf_(mylogit);
        const float sel = (lane < 32) ? s + BR[lane & 31] : NEG_INF;
        const int gb = lane & ~3;
        const float v0 = __shfl(sel, gb), v1 = __shfl(sel, gb + 1), v2 = __shfl(sel, gb + 2), v3 = __shfl(sel, gb + 3);
        const float m1 = fmaxf(fmaxf(v0, v1), fmaxf(v2, v3));
        float m2;
        { const float lo01 = fminf(v0, v1), hi01 = fmaxf(v0, v1), lo23 = fminf(v2, v3), hi23 = fmaxf(v2, v3);
          m2 = fmaxf(fminf(hi01, hi23), fmaxf(lo01, lo23)); }
        float gs = (lane < 32) ? (m1 + m2) : NEG_INF;
        int gi = lane >> 2;
#pragma unroll
        for (int o = 32; o > 0; o >>= 1) { const float ov = __shfl_xor(gs, o); const int oi = __shfl_xor(gi, o); if (ov > gs || (ov == gs && oi < gi)) { gs = ov; gi = oi; } }
        const int gbest = gi;
        const float c0 = __shfl(sel, gbest * 4), c1 = __shfl(sel, gbest * 4 + 1), c2 = __shfl(sel, gbest * 4 + 2), c3 = __shfl(sel, gbest * 4 + 3);
        int j0 = 0; float b0 = c0;
        if (c1 > b0) { b0 = c1; j0 = 1; } if (c2 > b0) { b0 = c2; j0 = 2; } if (c3 > b0) { b0 = c3; j0 = 3; }
        int j1 = -1; float b1 = -3e38f;
        if (j0 != 0 && c0 > b1) { b1 = c0; j1 = 0; } if (j0 != 1 && c1 > b1) { b1 = c1; j1 = 1; } if (j0 != 2 && c2 > b1) { b1 = c2; j1 = 2; } if (j0 != 3 && c3 > b1) { b1 = c3; j1 = 3; }
        const int e0 = gbest * 4 + j0, e1 = gbest * 4 + j1;
        const float s0 = __shfl(s, e0), s1 = __shfl(s, e1);
        const float inv = 1.0f / (s0 + s1);
        if (lane == 0) {
            const unsigned r0 = atomicAdd(&cnt[e0], 1u), r1 = atomicAdd(&cnt[e1], 1u);
            list[(size_t)e0 * LCAP + r0] = make_int2(row, __float_as_int(s0 * inv));
            list[(size_t)e1 * LCAP + r1] = make_int2(row, __float_as_int(s1 * inv));
            tokpos[row * 2] = make_int2(e0, (int)r0); tokpos[row * 2 + 1] = make_int2(e1, (int)r1);
            ((float2*)(a.ws + WS_TOKGATE))[row] = make_float2(s0 * inv, s1 * inv);
        }
    }
}

constexpr int ZERO_ROW = 32768 / 2048;
struct I2 { int x, y; };
struct MoeSched {
    int G, c, T, npn; PG8_LAS I2* tab;
    const char* A; const char* B; size_t b_e, b_pn, a_tile; int colw;
    const int2* list; int gat_row0;
    __device__ void init(PG8_LAS unsigned char* lds, const unsigned* cnt, int npn_, const void* A_, size_t a_tile_, const void* B_, size_t b_e_, size_t b_pn_, int colw_, const int2* list_, int gat_row0_) {
        const int lane = tid_fresh() & 63, x = lane & 31;
        G = gridDim.x; c = blockIdx.x; npn = npn_; A = (const char*)A_; a_tile = a_tile_; B = (const char*)B_; b_e = b_e_; b_pn = b_pn_; colw = colw_; list = list_; gat_row0 = gat_row0_;
        const unsigned cnt_l = __hip_atomic_load(cnt + x, __ATOMIC_RELAXED, __HIP_MEMORY_SCOPE_AGENT);
        const int tiles = (int)((cnt_l + 255u) >> 8);
        int inc = tiles;
#pragma unroll
        for (int o = 1; o < 32; o <<= 1) { const int t = __shfl_up(inc, o, 32); if (x >= o) inc += t; }
        tab = (PG8_LAS I2*)(lds + pg8::STAGE_BYTES + 8192);
        tab[x].x = (int)cnt_l; tab[x].y = inc - tiles;
        T = __builtin_amdgcn_readfirstlane(__shfl(inc, 31));
        __syncthreads();
    }
    __device__ __forceinline__ bool next(int i, pg8::Unit& u) const {
        const long L = (long)i * G + c; if (L >= (long)T * npn) return false;
        const int ti = (int)(L / npn), pn = (int)(L % npn);
        const int my_excl = tab[__builtin_amdgcn_mbcnt_lo(~0u, 0u) & 31].y;
        const unsigned long long m = __ballot(my_excl <= ti) & 0xffffffffull;
        const int e = __popcll(m) - 1;
        const int rt = ti - tab[e].y;
        const unsigned ce = (unsigned)tab[e].x;
        u.aux = __builtin_amdgcn_readfirstlane(e | (rt << 8)); u.aux2 = __builtin_amdgcn_readfirstlane((int)ce);
        u.row0 = ti * 256; u.col0 = pn * colw;
        u.A = A + (size_t)ti * a_tile; u.B = B + (size_t)e * b_e + (size_t)pn * b_pn;
        return true;
    }
    __device__ __forceinline__ int arow(const pg8::Unit& u, int r) const {
        const int e = u.aux & 255, rank = (u.aux >> 8) * 256 + r;
        return rank < u.aux2 ? gat_row0 + list[(size_t)e * LCAP + rank].x : ZERO_ROW;
    }
};
struct EpiSwiGLU {
    static constexpr bool PERM = true;
    bf16_t* H;
    __device__ __forceinline__ void operator()(const pg8::f32x4 (&acc)[2][2][4][2], const pg8::Unit& u, int wr, int wc, int fr, int fq) const {
        const int col = u.col0 + wc * 32 + 8 * fq;
#pragma unroll
        for (int ai = 0; ai < 2; ++ai)
#pragma unroll
            for (int m = 0; m < 4; ++m) {
                const int r = wr * 64 + fr + ai * 128 + m * 16;
                float hv[8];
#pragma unroll
                for (int n = 0; n < 2; ++n)
#pragma unroll
                    for (int j = 0; j < 4; ++j) { const float g = acc[ai][0][m][n][j], up = acc[ai][1][m][n][j]; hv[n * 4 + j] = g * up * __builtin_amdgcn_rcpf(1.0f + __expf(-g)); }
                pg8::u32x4 w; w.x = pk2(hv[0], hv[1]); w.y = pk2(hv[2], hv[3]); w.z = pk2(hv[4], hv[5]); w.w = pk2(hv[6], hv[7]);
                *(pg8::u32x4*)(H + (size_t)(u.row0 + r) * DEXP + col) = w;
            }
    }
};
__device__ __forceinline__ void phase_f3(const Args& a, int l, PG8_LAS unsigned char* lds) {
    const unsigned* cnt = (const unsigned*)(a.ws + WS_CTL) + CW_CNT + l * 32;
    const int2* list = (const int2*)(a.ws + WS_LIST);
    MoeSched S; S.init(lds, cnt, 4, a.ws, 0, a.ws + WS_WEXP, (size_t)1024 * 1024 * 2, (size_t)256 * 1024 * 2, 128, list, (int)(WS_X2B / 2048));
    EpiSwiGLU E{(bf16_t*)(a.ws + WS_H)};
    pg8::gemm_phase<EpiSwiGLU, MoeSched, true>(lds, pg8::Dims{DM, DM, DM}, S, E);
}
__device__ __forceinline__ void phase_f4(const Args& a, int l, PG8_LAS unsigned char* lds) {
    const unsigned* cnt = (const unsigned*)(a.ws + WS_CTL) + CW_CNT + l * 32;
    MoeSched S; S.init(lds, cnt, 4, a.ws + WS_H, (size_t)256 * DEXP * 2, a.ws + WS_WEXP + (size_t)NEXP * 1024 * 1024 * 2, (size_t)1024 * 512 * 2, (size_t)256 * 512 * 2, 256, nullptr, 0);
    pg8::EpiBf16 E{(bf16_t*)(a.ws + WS_Y), DM};
    pg8::gemm_phase<pg8::EpiBf16, MoeSched, false>(lds, pg8::Dims{DEXP, DEXP, DEXP}, S, E);
}
__device__ __forceinline__ void phase_ln3(const Args& a, int l, float* OUT, bf16_t* OUTB) {
    const int tid = tid_fresh(), lane = tid & 63, wid = tid >> 6;
    const unsigned* cnt = (const unsigned*)(a.ws + WS_CTL) + CW_CNT + l * 32;
    const int2* tokpos = (const int2*)(a.ws + WS_TOKPOS);
    const float* X2 = (const float*)(a.ws + WS_X2); const bf16_t* Y = (const bf16_t*)(a.ws + WS_Y);
    const float* g = a.in[28] + (size_t)(l * 3 + 2) * DM; const float* bta = a.in[29] + (size_t)(l * 3 + 2) * DM;
    int mybase = 0;
    { int acc = 0; for (int x = 0; x < NEXP; ++x) { if (x == lane) mybase = acc; acc += (int)((cnt[x] + 255u) >> 8); } }
    for (int row = blockIdx.x * 8 + wid; row < NTOK; row += gridDim.x * 8) {
        const int2 p0 = tokpos[row * 2], p1 = tokpos[row * 2 + 1]; const float2 tg = ((const float2*)(a.ws + WS_TOKGATE))[row];
        const size_t h0 = (size_t)__shfl(mybase, p0.x) * 256 + p0.y, h1 = (size_t)__shfl(mybase, p1.x) * 256 + p1.y;
        const float* xr = X2 + (size_t)row * DM; const bf16_t* y0 = Y + h0 * DM; const bf16_t* y1 = Y + h1 * DM;
        float x[16];
#pragma unroll
        for (int m = 0; m < 4; ++m) { const int o = m * 256 + lane * 4; const float4 xv = *(const float4*)(xr + o); const uint2 a0 = *(const uint2*)(y0 + o), a1 = *(const uint2*)(y1 + o);
            x[m * 4] = fmaf(ALPHA, xv.x, fmaf(tg.x, bflo(a0.x), tg.y * bflo(a1.x))); x[m * 4 + 1] = fmaf(ALPHA, xv.y, fmaf(tg.x, bfhi(a0.x), tg.y * bfhi(a1.x)));
            x[m * 4 + 2] = fmaf(ALPHA, xv.z, fmaf(tg.x, bflo(a0.y), tg.y * bflo(a1.y))); x[m * 4 + 3] = fmaf(ALPHA, xv.w, fmaf(tg.x, bfhi(a0.y), tg.y * bfhi(a1.y))); }
        float s = 0.f;
#pragma unroll
        for (int k = 0; k < 16; ++k) s += x[k];
        const float mean = wsum(s) * (1.0f / 1024.0f);
        float q = 0.f;
#pragma unroll
        for (int k = 0; k < 16; ++k) { const float d = x[k] - mean; q = fmaf(d, d, q); }
        const float rstd = rsqrtf(wsum(q) * (1.0f / 1024.0f) + 1e-5f);
#pragma unroll
        for (int m = 0; m < 4; ++m) { const int o = m * 256 + lane * 4; const float4 gv = *(const float4*)(g + o), bv = *(const float4*)(bta + o); float4 r;
            r.x = (x[m * 4] - mean) * rstd * gv.x + bv.x; r.y = (x[m * 4 + 1] - mean) * rstd * gv.y + bv.y; r.z = (x[m * 4 + 2] - mean) * rstd * gv.z + bv.z; r.w = (x[m * 4 + 3] - mean) * rstd * gv.w + bv.w;
            *(float4*)(OUT + (size_t)row * DM + o) = r;
            if (OUTB) { uint2 ob; ob.x = pk2(r.x, r.y); ob.y = pk2(r.z, r.w); *(uint2*)(OUTB + (size_t)row * DM + o) = ob; } }
    }
}

__device__ __forceinline__ void phase_matt(const Args& a, float* lds) {
    const int tid = tid_fresh(), lane = tid & 63, wid = tid >> 6;
    const bf16_t* Q = (const bf16_t*)(a.ws + WS_Q); const bf16_t* KV = (const bf16_t*)(a.ws + WS_KV); bf16_t* O = (bf16_t*)(a.ws + WS_O);
    float* qs = lds + wid * 256; float* sc = lds + 8 * 256 + wid * 256;
    for (int u = blockIdx.x * 8 + wid; u < NTOK * 4; u += gridDim.x * 8) {
        const int hm = u & 3, tok = u >> 2, b = tok / SEQ;
        asm volatile("s_waitcnt lgkmcnt(0)" ::: "memory");
        { const uint2 qv = *(const uint2*)(Q + (size_t)tok * DM + hm * 256 + lane * 4);
          *(float4*)&qs[lane * 4] = make_float4(bflo(qv.x) * 0.0625f, bfhi(qv.x) * 0.0625f, bflo(qv.y) * 0.0625f, bfhi(qv.y) * 0.0625f); }
        asm volatile("s_waitcnt lgkmcnt(0)" ::: "memory");
        float sv[4]; float mx = NEG_INF;
#pragma unroll
        for (int m = 0; m < 4; ++m) {
            const bf16_t* kp = KV + ((size_t)b * MEMLEN + m * 64 + lane) * 2048 + hm * 256;
            float d = 0.f;
            for (int d8 = 0; d8 < 32; ++d8) { const uint4 kv = *(const uint4*)(kp + d8 * 8); const float4 q0 = *(const float4*)&qs[d8 * 8], q1 = *(const float4*)&qs[d8 * 8 + 4];
                d = fmaf(q0.x, bflo(kv.x), d); d = fmaf(q0.y, bfhi(kv.x), d); d = fmaf(q0.z, bflo(kv.y), d); d = fmaf(q0.w, bfhi(kv.y), d);
                d = fmaf(q1.x, bflo(kv.z), d); d = fmaf(q1.y, bfhi(kv.z), d); d = fmaf(q1.z, bflo(kv.w), d); d = fmaf(q1.w, bfhi(kv.w), d); }
            sv[m] = d; mx = fmaxf(mx, d);
        }
        mx = wmax(mx);
        float den = 0.f;
#pragma unroll
        for (int m = 0; m < 4; ++m) { const float p = __expf(sv[m] - mx); sc[m * 64 + lane] = p; den += p; }
        den = wsum(den);
        asm volatile("s_waitcnt lgkmcnt(0)" ::: "memory");
        float4 o = make_float4(0.f, 0.f, 0.f, 0.f);
        const bf16_t* vp = KV + (size_t)b * MEMLEN * 2048 + 1024 + hm * 256 + lane * 4;
        for (int j = 0; j < MEMLEN; ++j) { const float p = sc[j]; const uint2 vv = *(const uint2*)(vp + (size_t)j * 2048);
            o.x = fmaf(p, bflo(vv.x), o.x); o.y = fmaf(p, bfhi(vv.x), o.y); o.z = fmaf(p, bflo(vv.y), o.z); o.w = fmaf(p, bfhi(vv.y), o.w); }
        const float inv = 1.0f / den;
        uint2 ob; ob.x = pk2(o.x * inv, o.y * inv); ob.y = pk2(o.z * inv, o.w * inv);
        *(uint2*)(O + (size_t)tok * DM + hm * 256 + lane * 4) = ob;
    }
}

constexpr int PH_PER_LAYER = 13, N_PHASES = 1 + 2 * PH_PER_LAYER;

__global__ void __launch_bounds__(NTHREADS, 2) mk_fwd(Args a) {
    extern __shared__ __attribute__((aligned(16))) unsigned char smem[];
    float* lds = (float*)smem;
    PG8_LAS unsigned char* lds3 = (PG8_LAS unsigned char*)smem;
    volatile LAS unsigned* xbw = (volatile LAS unsigned*)(smem + LDS_BYTES - 16);
    const int lo = a.ph_lo, hi = a.ph_hi;
    unsigned* ctl = (unsigned*)(a.ws + WS_CTL);
    XcdBarrier bar; bar.bar = ctl + CW_BAR; bar.x = 0; bar.st = xbw;
    if (hi - lo > 1) {
        if (threadIdx.x == 0) { xbw[0] = 0u; xbw[1] = 0u; }
        __syncthreads();
        bar = xcd_barrier_post(ctl + CW_BAR, xbw);
    }
#define IN(k) (lo <= (k) && (k) < hi)
#define SEAM(k) do { if (IN(k) && IN((k) + 1)) xcd_barrier(bar); } while (0)
    if (IN(0)) phase_prologue(a, lds);
    SEAM(0);
#define LAYER_BODY(l) do { \
        const int p0 = 1 + l * PH_PER_LAYER; \
        const float* xin = (l == 0) ? a.in[0] : (const float*)(a.ws + WS_XL1); \
        float* xout = (l == 0) ? (float*)(a.ws + WS_XL1) : a.out; \
        if (IN(p0 + 0)) phase_g1(a, l, lds3); \
        SEAM(p0 + 0); \
        if (IN(p0 + 1)) phase_prep(a, l, lds); \
        SEAM(p0 + 1); \
        if (IN(p0 + 2)) phase_scan(a, l, lds3); \
        SEAM(p0 + 2); \
        if (IN(p0 + 3)) { phase_post(a, l); phase_att(a, l, lds3); } \
        SEAM(p0 + 3); \
        if (IN(p0 + 4)) phase_dense_res(a.ws + WS_MIX, a.ws + WS_WOUT + (size_t)l * 2 * MiB, xin, (float*)(a.ws + WS_PRE), lds3); \
        SEAM(p0 + 4); \
        if (IN(p0 + 5)) phase_ln((const float*)(a.ws + WS_PRE), a.in[28] + (size_t)(l * 3) * DM, a.in[29] + (size_t)(l * 3) * DM, (float*)(a.ws + WS_X1), (bf16_t*)(a.ws + WS_X1B)); \
        SEAM(p0 + 5); \
        if (IN(p0 + 6)) { \
            phase_dense_bf16(a.ws + WS_X1B, NTOK, a.ws + WS_WQ + (size_t)l * 2 * MiB, DM, (bf16_t*)(a.ws + WS_Q), lds3); \
            phase_dense_bf16(a.ws + WS_MEMB, NBATCH * MEMLEN, a.ws + WS_WKV + (size_t)l * 4 * MiB, 2048, (bf16_t*)(a.ws + WS_KV), lds3); \
        } \
        SEAM(p0 + 6); \
        if (IN(p0 + 7)) phase_matt(a, lds); \
        SEAM(p0 + 7); \
        if (IN(p0 + 8)) phase_dense_res(a.ws + WS_O, a.ws + WS_WO + (size_t)l * 2 * MiB, (const float*)(a.ws + WS_X1), (float*)(a.ws + WS_PRE2), lds3); \
        SEAM(p0 + 8); \
        if (IN(p0 + 9)) phase_ln2_router(a, l, lds); \
        SEAM(p0 + 9); \
        if (IN(p0 + 10)) phase_f3(a, l, lds3); \
        SEAM(p0 + 10); \
        if (IN(p0 + 11)) phase_f4(a, l, lds3); \
        SEAM(p0 + 11); \
        if (IN(p0 + 12)) { phase_ln3(a, l, xout, (l == 0) ? (bf16_t*)(a.ws + WS_XB) : (bf16_t*)nullptr); if (l == 0) convert_experts(a, 1, lds); } \
        SEAM(p0 + 12); \
    } while (0)
    LAYER_BODY(0);
    LAYER_BODY(1);
}
}

extern "C" void kernel_launch(void* const* d_in, const int* in_sizes, int n_in, void* d_out, int out_size, void* d_ws, size_t ws_size, hipStream_t stream) {
    static int grid = 0;
    if (!grid) {
        int dev = 0, cus = 0, per_cu = 0;
        (void)hipGetDevice(&dev);
        (void)hipDeviceGetAttribute(&cus, hipDeviceAttributeMultiprocessorCount, dev);
        (void)hipFuncSetAttribute((const void*)mk_fwd, hipFuncAttributeMaxDynamicSharedMemorySize, LDS_BYTES);
        (void)hipOccupancyMaxActiveBlocksPerMultiprocessor(&per_cu, mk_fwd, NTHREADS, LDS_BYTES);
        (void)hipGetLastError();
        grid = cus * 1;
        if (grid < 65) grid = 256;
    }
    if (ws_size < WS_END) return;
    (void)hipMemsetAsync(d_ws, 0, CTL_ZERO_BYTES, stream);
    Args a;
    memset(&a, 0, sizeof(a));
    for (int i = 0; i < 30; ++i) a.in[i] = (const float*)d_in[i];
    a.out = (float*)d_out; a.ws = (unsigned char*)d_ws;
#if MK_ONE_LAUNCH
    a.ph_lo = 0; a.ph_hi = N_PHASES;
    hipLaunchKernelGGL(mk_fwd, dim3(grid), dim3(NTHREADS), LDS_BYTES, stream, a);
#else
    for (int p = 0; p < N_PHASES; ++p) {
        a.ph_lo = p; a.ph_hi = p + 1;
        hipLaunchKernelGGL(mk_fwd, dim3(grid), dim3(NTHREADS), LDS_BYTES, stream, a);
    }
#endif
}
```

```cpp
#include <hip/hip_runtime.h>
#include <stdint.h>
#include <cstring>

#ifndef MK_ONE_LAUNCH
#define MK_ONE_LAUNCH 1
#endif

namespace {
constexpr int NTHREADS = 512;
constexpr int NTOK = 16384, SEQ = 2048, NBATCH = 8, DM = 1024;
constexpr int MEMLEN = 256;
constexpr int NH = 8, HD = 64;
constexpr int IN_COLS = 3328, ZLD = 3584;
constexpr int C_Q = 0, C_K = 512, C_V = 1024, C_R = 1536, C_KR = 2048, C_VR = 2560, C_ZW = 3072, C_ZA = 3136, C_ZG = 3200, C_ZV = 3328;
constexpr int NEXP = 32, DEXP = 512;
constexpr int LCAP = 16384;
constexpr float ALPHA = 1.4142135623730951f;
constexpr float NEG_INF = -1e30f;
constexpr int LDS_BYTES = 147456;

typedef unsigned short bf16_t;
typedef float f32x2_t __attribute__((ext_vector_type(2)));
typedef __bf16 bf16x2_t __attribute__((ext_vector_type(2)));
__device__ __forceinline__ unsigned pk2(float lo, float hi) { f32x2_t v = {lo, hi}; bf16x2_t b = __builtin_convertvector(v, bf16x2_t); return __builtin_bit_cast(unsigned, b); }
__device__ __forceinline__ bf16_t f2bf(float f) { return (bf16_t)(pk2(f, 0.f) & 0xffffu); }
__device__ __forceinline__ float bf2f(bf16_t h) { return __uint_as_float((unsigned)h << 16); }
__device__ __forceinline__ float bflo(unsigned u) { return __uint_as_float(u << 16); }
__device__ __forceinline__ float bfhi(unsigned u) { return __uint_as_float(u & 0xffff0000u); }

constexpr size_t MiB = 1u << 20;
constexpr size_t WS_CTL = 0, CTL_ZERO_BYTES = 64 * 1024;
constexpr size_t WS_LIST = 2 * MiB;
constexpr size_t WS_KB = 6 * MiB;
constexpr size_t WS_TOKPOS = 10 * MiB;
constexpr size_t WS_TOKGATE = 10 * MiB + 512 * 1024;
constexpr size_t WS_KMEAN = 11 * MiB;
constexpr size_t WS_MEMB = 12 * MiB;
constexpr size_t WS_VT = 16 * MiB;
constexpr size_t WS_WIN0 = 24 * MiB, WS_WIN1 = 31 * MiB;
constexpr size_t WS_WOUT = 38 * MiB, WS_WQ = 42 * MiB, WS_WKV = 46 * MiB, WS_WO = 54 * MiB;
constexpr size_t WS_WEXP = 58 * MiB;
constexpr size_t WS_XL1 = 154 * MiB, WS_XB = 218 * MiB, WS_VFIRST = 250 * MiB;
constexpr size_t WS_Z = 266 * MiB, WS_MIX = 378 * MiB, WS_R3 = 410 * MiB, WS_END = 506 * MiB;
constexpr size_t WS_REC = 410 * MiB;
constexpr size_t WS_YRAW = 490 * MiB;
constexpr size_t WS_RVT = 218 * MiB, WS_RG = 234 * MiB;
constexpr size_t WS_BON = 20 * MiB;
constexpr size_t WS_LORA = 22 * MiB;
constexpr size_t LORA_L = 512 * 288 * 2, LORA_I = 512 * 64 * 2, LORA_G = 2 * 512 * 64 * 2, LORA_V = LORA_G + 512 * 128 * 2;
constexpr size_t WS_LSUM = 21 * MiB;
constexpr size_t WS_P = 298 * MiB;
constexpr size_t WS_PRE = 266 * MiB, WS_X1 = 410 * MiB, WS_X1B = 474 * MiB;
constexpr size_t WS_Q = 330 * MiB, WS_KV = 362 * MiB, WS_O = 266 * MiB, WS_PRE2 = 330 * MiB;
constexpr size_t WS_X2 = 410 * MiB, WS_X2B = 474 * MiB;
constexpr size_t WS_H = 266 * MiB, WS_Y = 306 * MiB;

constexpr int CW_CNT = 0;
constexpr int CW_BAR = 1024;

#define XB_TMO      128
#define XB_XCNT(j)  (256  + 64 * (j))
#define XB_XSUB(j)  (1280 + 64 * (j))
#define XB_XGEN(j)  (2304 + 64 * (j))
#define XB_TOP      3328
#define XB_TOPGEN   3392
#define XCD_BAR_WORDS 3456
#define XB_SPIN_CAP (1u << 18)
#define LAS __attribute__((address_space(3)))
__device__ __forceinline__ unsigned xb_ld(unsigned* p)              { return __hip_atomic_load(p, __ATOMIC_RELAXED, __HIP_MEMORY_SCOPE_AGENT); }
__device__ __forceinline__ unsigned xb_add(unsigned* p, unsigned v) { return __hip_atomic_fetch_add(p, v, __ATOMIC_RELAXED, __HIP_MEMORY_SCOPE_AGENT); }
__device__ __forceinline__ unsigned xb_xcc_id() { return (unsigned)__builtin_amdgcn_s_getreg((3 << 11) | 20) & 0xFu; }
#define XB_SPIN(cond, bar) do { unsigned _sp = 0; while (cond) { __builtin_amdgcn_s_sleep(1); \
    if ((++_sp & 255u) == 0u) { if (xb_ld(&(bar)[XB_TMO])) break; if (_sp > XB_SPIN_CAP) { atomicAdd(&(bar)[XB_TMO], 1u); break; } } } } while (0)
struct XcdBarrier { unsigned* bar; unsigned x; volatile LAS unsigned* st; };
__device__ __forceinline__ XcdBarrier xcd_barrier_post(unsigned* bar, volatile LAS unsigned* st) {
    XcdBarrier b; b.bar = bar; b.x = xb_xcc_id(); b.st = st;
    if (threadIdx.x == 0) (void)xb_add(&bar[XB_XCNT(b.x)], 1u);
    return b;
}
__device__ __forceinline__ void xcd_barrier_complete(unsigned* bar, unsigned x, unsigned& nloc, unsigned& nx) {
    const unsigned G = gridDim.x * gridDim.y * gridDim.z;
    unsigned sum, cnt, mine, sp = 0u;
    for (;;) {
        sum = 0u; cnt = 0u; mine = 0u;
#pragma unroll
        for (unsigned j = 0; j < 16; ++j) { const unsigned c = xb_ld(&bar[XB_XCNT(j)]); sum += c; cnt += (c > 0u) ? 1u : 0u; mine = (j == x) ? c : mine; }
        if (sum == G) break;
        __builtin_amdgcn_s_sleep(1);
        if ((++sp & 255u) == 0u) { if (xb_ld(&bar[XB_TMO])) break; if (sp > XB_SPIN_CAP) { atomicAdd(&bar[XB_TMO], 1u); break; } }
    }
    nloc = mine > 0u ? mine : 1u; nx = cnt > 0u ? cnt : 1u;
}
__device__ __forceinline__ void xcd_barrier(const XcdBarrier& b) {
    asm volatile("s_waitcnt vmcnt(0)" ::: "memory");
    __syncthreads();
    if (threadIdx.x == 0) {
        unsigned* bar = b.bar;
        __builtin_amdgcn_s_waitcnt(0);
        unsigned nloc = b.st[0], nx = b.st[1];
        if (nloc == 0u) { xcd_barrier_complete(bar, b.x, nloc, nx); b.st[0] = nloc; b.st[1] = nx; }
        const unsigned old = xb_add(&bar[XB_XSUB(b.x)], 1u);
        const unsigned gen = old / nloc;
        if (old + 1u == (gen + 1u) * nloc) {
            __builtin_amdgcn_fence(__ATOMIC_RELEASE, "agent");
            asm volatile("s_waitcnt vmcnt(0)" ::: "memory");
            const unsigned og = xb_add(&bar[XB_TOP], 1u);
            const unsigned tg = og / nx;
            if (og + 1u == (tg + 1u) * nx) xb_add(&bar[XB_TOPGEN], 1u);
            else XB_SPIN(xb_ld(&bar[XB_TOPGEN]) == tg, bar);
            __builtin_amdgcn_fence(__ATOMIC_ACQUIRE, "agent");
            xb_add(&bar[XB_XGEN(b.x)], 1u);
            asm volatile("s_waitcnt vmcnt(0)" ::: "memory");
        } else {
            XB_SPIN(xb_ld(&bar[XB_XGEN(b.x)]) == gen, bar);
            __builtin_amdgcn_fence(__ATOMIC_ACQUIRE, "agent");
            asm volatile("s_waitcnt vmcnt(0)" ::: "memory");
        }
    }
    __syncthreads();
}

__device__ __forceinline__ int tid_fresh() { int t = threadIdx.x; asm volatile("" : "+v"(t)); return t; }
__device__ __forceinline__ float wsum(float v) {
#pragma unroll
    for (int o = 32; o > 0; o >>= 1) v += __shfl_xor(v, o);
    return v;
}
__device__ __forceinline__ float wmax(float v) {
#pragma unroll
    for (int o = 32; o > 0; o >>= 1) v = fmaxf(v, __shfl_xor(v, o));
    return v;
}
__device__ __forceinline__ float sigmoidf_(float x) { return 1.0f / (1.0f + __expf(-x)); }
__device__ __forceinline__ float softplusf_(float x) { return x > 20.f ? x : log1pf(__expf(x)); }

struct Args {
    const float* in[30];
    float* out;
    unsigned char* ws;
    int ph_lo, ph_hi;
};

namespace pg8 {
#define PG8_LAS __attribute__((address_space(3)))
typedef short bf16x8 __attribute__((ext_vector_type(8)));
typedef float f32x4 __attribute__((ext_vector_type(4)));
typedef unsigned u32x4 __attribute__((ext_vector_type(4)));
constexpr int BM = 256, BK = 64, HALF = 128, HTB = HALF * BK * 2, STAGE_BYTES = 8 * HTB, NXCD = 8, WGM = 8;

__host__ __device__ __forceinline__ int lds_byte(int r, int c) { const int st = (r >> 4) * 2 + (c >> 5), rr = r & 15, cc = c & 31, ob = rr * 64 + cc * 2; return st * 1024 + (ob ^ (((ob >> 9) & 1) << 5)); }
__host__ __device__ __forceinline__ void stage_rc(int b, int& R, int& C) { const int st = b / 1024, sb = b % 1024, swz = sb ^ (((sb >> 9) & 1) << 5); R = (st >> 1) * 16 + swz / 64; C = (st & 1) * 32 + (swz % 64) / 2; }
__host__ __device__ __forceinline__ int perm32(int rho) { const int n = rho >> 4, i = rho & 15; return 8 * (i >> 2) + 4 * n + (i & 3); }

struct Unit { const char* A; const char* B; int row0, col0, aux, aux2; };
struct Dims { int lda, ldb, K; };

struct TileOrder {
    int nM, nN, nwg, G, c;
    __device__ void init(int nM_, int nN_, int G_, int c_) { nM = nM_; nN = nN_; nwg = nM * nN; G = G_; c = c_; }
    __device__ bool tile(int i, int& pm, int& pn) const {
        const long L = (long)i * G + c; if (L >= nwg) return false;
        int wgid = (int)L; { const int q = nwg / NXCD, r = nwg % NXCD, xcd = wgid % NXCD, off = wgid / NXCD; wgid = (xcd < r ? xcd * (q + 1) : r * (q + 1) + (xcd - r) * q) + off; }
        const int nig = WGM * nN, gid = wgid / nig, fm = gid * WGM, gsz = (nM - fm) < WGM ? (nM - fm) : WGM;
        pm = fm + ((wgid % nig) % gsz); pn = (wgid % nig) / gsz; return true;
    }
};
struct DenseSched {
    TileOrder o; const char* A; const char* B; int lda, ldb;
    __device__ void init(const void* A_, int lda_, int M, const void* B_, int ldb_, int N) { A = (const char*)A_; B = (const char*)B_; lda = lda_; ldb = ldb_; o.init(M / BM, N / BM, gridDim.x, blockIdx.x); }
    __device__ __forceinline__ bool next(int i, Unit& u) const { int pm, pn; if (!o.tile(i, pm, pn)) return false;
        u.A = A + (size_t)pm * BM * lda * 2; u.B = B + (size_t)pn * BM * ldb * 2; u.row0 = pm * BM; u.col0 = pn * BM; u.aux = 0; u.aux2 = 0; return true; }
    __device__ __forceinline__ int arow(const Unit&, int r) const { return r; }
};

__device__ __forceinline__ unsigned cvt_pk_bf16(float lo, float hi) { unsigned r; asm volatile("v_cvt_pk_bf16_f32 %0, %1, %2" : "=v"(r) : "v"(lo), "v"(hi)); return r; }

struct EpiBf16 {
    static constexpr bool PERM = true;
    bf16_t* O; int ldc;
    __device__ __forceinline__ void operator()(const f32x4 (&acc)[2][2][4][2], const Unit& u, int wr, int wc, int fr, int fq) const {
        const int row0 = u.row0 + wr * 64 + fr, col0 = u.col0 + wc * 32 + 8 * fq;
#pragma unroll
        for (int ai = 0; ai < 2; ++ai)
#pragma unroll
            for (int m = 0; m < 4; ++m) { bf16_t* rowp = O + (size_t)(row0 + ai * HALF + m * 16) * ldc + col0;
#pragma unroll
                for (int bj = 0; bj < 2; ++bj) { const f32x4 v0 = acc[ai][bj][m][0], v1 = acc[ai][bj][m][1];
                    u32x4 w; w.x = cvt_pk_bf16(v0[0], v0[1]); w.y = cvt_pk_bf16(v0[2], v0[3]); w.z = cvt_pk_bf16(v1[0], v1[1]); w.w = cvt_pk_bf16(v1[2], v1[3]);
                    *(u32x4*)(rowp + bj * HALF) = w; } }
    }
};
struct EpiF32Res {
    static constexpr bool PERM = false;
    float* C; const float* RES; int ldc; float rs;
    __device__ __forceinline__ void operator()(const f32x4 (&acc)[2][2][4][2], const Unit& u, int wr, int wc, int fr, int fq) const {
        const int row0 = u.row0 + wr * 64 + fr, col0 = u.col0 + wc * 32 + 4 * fq;
#pragma unroll
        for (int ai = 0; ai < 2; ++ai)
#pragma unroll
            for (int m = 0; m < 4; ++m) { const size_t ro = (size_t)(row0 + ai * HALF + m * 16) * ldc + col0;
#pragma unroll
                for (int bj = 0; bj < 2; ++bj)
#pragma unroll
                    for (int n = 0; n < 2; ++n) { const f32x4 r = *(const f32x4*)(RES + ro + bj * HALF + n * 16); *(f32x4*)(C + ro + bj * HALF + n * 16) = acc[ai][bj][m][n] + r * rs; } }
    }
};

__device__ __forceinline__ void store_bf16_tile(const f32x4 (&acc)[2][2][4][2], bf16_t* O, int ldc, int row0, int col0) {
#pragma unroll
    for (int ai = 0; ai < 2; ++ai)
#pragma unroll
        for (int m = 0; m < 4; ++m) { bf16_t* rowp = O + (size_t)(row0 + ai * HALF + m * 16) * ldc + col0;
#pragma unroll
            for (int bj = 0; bj < 2; ++bj) { const f32x4 v0 = acc[ai][bj][m][0], v1 = acc[ai][bj][m][1];
                u32x4 w; w.x = cvt_pk_bf16(v0[0], v0[1]); w.y = cvt_pk_bf16(v0[2], v0[3]); w.z = cvt_pk_bf16(v1[0], v1[1]); w.w = cvt_pk_bf16(v1[2], v1[3]);
                *(u32x4*)(rowp + bj * HALF) = w; } }
}
struct EpiG1 {
    static constexpr bool PERM = true;
    bf16_t* Z; bf16_t* KB; bf16_t* VT;
    __device__ __forceinline__ void operator()(const f32x4 (&acc)[2][2][4][2], const Unit& u, int wr, int wc, int fr, int fq) const {
        bf16_t* O = Z; int ldc = ZLD;
        if (u.aux == 1) { O = KB; ldc = 1024; } else if (u.aux >= 2) { O = VT + (size_t)(u.aux - 2) * 1024 * 256; ldc = 256; }
        store_bf16_tile(acc, O, ldc, u.row0 + wr * 64 + fr, u.col0 + wc * 32 + 8 * fq);
    }
};
struct EpiSoftmax {
    static constexpr bool PERM = true;
    bf16_t* P; float* LSUM; PG8_LAS float* xmax;
    __device__ __forceinline__ void operator()(const f32x4 (&acc)[2][2][4][2], const Unit& u, int wr, int wc, int fr, int fq) const {
        const float c = 0.0625f * 1.4426950408889634f;
#pragma unroll
        for (int ai = 0; ai < 2; ++ai)
#pragma unroll
            for (int m = 0; m < 4; ++m) {
                float mx = acc[ai][0][m][0][0];
#pragma unroll
                for (int bj = 0; bj < 2; ++bj)
#pragma unroll
                    for (int n = 0; n < 2; ++n)
#pragma unroll
                        for (int j = 0; j < 4; ++j) mx = fmaxf(mx, acc[ai][bj][m][n][j]);
                mx = fmaxf(mx, __shfl_xor(mx, 16)); mx = fmaxf(mx, __shfl_xor(mx, 32));
                if (fq == 0) xmax[wc * 256 + wr * 64 + fr + ai * 128 + m * 16] = mx;
            }
        asm volatile("s_waitcnt lgkmcnt(0)" ::: "memory"); __builtin_amdgcn_s_barrier(); asm volatile("" ::: "memory");
        const int hm = u.col0 >> 8;
#pragma unroll
        for (int ai = 0; ai < 2; ++ai)
#pragma unroll
            for (int m = 0; m < 4; ++m) {
                int r = wr * 64 + fr + ai * 128 + m * 16; asm volatile("" : "+v"(r) :: "memory");
                const float M = fmaxf(fmaxf(xmax[r], xmax[256 + r]), fmaxf(xmax[512 + r], xmax[768 + r]));
                float sum = 0.f; bf16_t* rowp = P + (size_t)(u.row0 + r) * 1024 + u.col0 + wc * 32 + 8 * fq;
#pragma unroll
                for (int bj = 0; bj < 2; ++bj) {
                    float e[8];
#pragma unroll
                    for (int n = 0; n < 2; ++n)
#pragma unroll
                        for (int j = 0; j < 4; ++j) { e[n * 4 + j] = __builtin_amdgcn_exp2f((acc[ai][bj][m][n][j] - M) * c); sum += e[n * 4 + j]; }
                    u32x4 w; w.x = pk2(e[0], e[1]); w.y = pk2(e[2], e[3]); w.z = pk2(e[4], e[5]); w.w = pk2(e[6], e[7]);
                    *(u32x4*)(rowp + bj * HALF) = w;
                }
                sum += __shfl_xor(sum, 16); sum += __shfl_xor(sum, 32);
                if (fq == 0) LSUM[((size_t)(u.row0 + r) * 4 + hm) * 4 + wc] = sum;
            }
        asm volatile("s_waitcnt lgkmcnt(0)" ::: "memory"); __builtin_amdgcn_s_barrier(); asm volatile("" ::: "memory");
    }
};
struct EpiPV {
    static constexpr bool PERM = true;
    bf16_t* O; const float* LSUM;
    __device__ __forceinline__ void operator()(const f32x4 (&acc)[2][2][4][2], const Unit& u, int wr, int wc, int fr, int fq) const {
        const int hm = u.col0 >> 8;
#pragma unroll
        for (int ai = 0; ai < 2; ++ai)
#pragma unroll
            for (int m = 0; m < 4; ++m) {
                int row = u.row0 + wr * 64 + fr + ai * 128 + m * 16; asm volatile("" : "+v"(row) :: "memory");
                const f32x4 ls = *(const f32x4*)(LSUM + ((size_t)row * 4 + hm) * 4);
                const float inv = 1.0f / ((ls[0] + ls[1]) + (ls[2] + ls[3]));
                bf16_t* rowp = O + (size_t)row * 1024 + u.col0 + wc * 32 + 8 * fq;
#pragma unroll
                for (int bj = 0; bj < 2; ++bj) { const f32x4 v0 = acc[ai][bj][m][0] * inv, v1 = acc[ai][bj][m][1] * inv;
                    u32x4 w; w.x = cvt_pk_bf16(v0[0], v0[1]); w.y = cvt_pk_bf16(v0[2], v0[3]); w.z = cvt_pk_bf16(v1[0], v1[1]); w.w = cvt_pk_bf16(v1[2], v1[3]);
                    *(u32x4*)(rowp + bj * HALF) = w; }
            }
    }
};
struct G1Sched {
    TileOrder o; const char *XB, *WIN, *MEMB, *WKV;
    __device__ void init(const void* XB_, const void* WIN_, int nN, const void* MEMB_, const void* WKV_) { XB = (const char*)XB_; WIN = (const char*)WIN_; MEMB = (const char*)MEMB_; WKV = (const char*)WKV_; o.init(64, nN, gridDim.x, blockIdx.x); }
    __device__ __forceinline__ bool next(int i, Unit& u) const {
        int pm, pn; u.aux2 = 0;
        if (o.tile(i, pm, pn)) { u.A = XB + (size_t)pm * BM * 2048; u.B = WIN + (size_t)pn * BM * 2048; u.row0 = pm * BM; u.col0 = pn * BM; u.aux = 0; return true; }
        const long L = (long)i * o.G + o.c - o.nwg;
        if (L >= 64) return false;
        if (L < 32) { pm = (int)L >> 2; pn = (int)L & 3; u.A = MEMB + (size_t)pm * BM * 2048; u.B = WKV + (size_t)pn * BM * 2048; u.row0 = pm * BM; u.col0 = pn * BM; u.aux = 1; return true; }
        const int b = ((int)L - 32) >> 2; pm = ((int)L - 32) & 3;
        u.A = WKV + (size_t)(1024 + pm * BM) * 2048; u.B = MEMB + (size_t)b * BM * 2048; u.row0 = pm * BM; u.col0 = 0; u.aux = 2 + b; return true;
    }
    __device__ __forceinline__ int arow(const Unit&, int r) const { return r; }
};
struct MattSched {
    int G, c; const char* A; const char* B; size_t b_batch; int b_head;
    __device__ void init(const void* A_, const void* B_, size_t b_batch_, int b_head_) { G = gridDim.x; c = blockIdx.x; A = (const char*)A_; B = (const char*)B_; b_batch = b_batch_; b_head = b_head_; }
    __device__ __forceinline__ bool next(int i, Unit& u) const {
        const long L = (long)i * G + c; if (L >= 256) return false;
        const int pm = (int)L >> 2, hm = (int)L & 3;
        u.A = A + ((size_t)pm * BM * 1024 + hm * 256) * 2; u.B = B + (size_t)(pm >> 3) * b_batch + (size_t)hm * b_head;
        u.row0 = pm * BM; u.col0 = hm * 256; u.aux = 0; u.aux2 = 0; return true;
    }
    __device__ __forceinline__ int arow(const Unit&, int r) const { return r; }
};

template <class Epi, class Sched, bool GATHER>
__device__ __forceinline__ void gemm_phase(PG8_LAS unsigned char* lds, const Dims g, const Sched& S, const Epi& E) {
    const int tid = tid_fresh(), wid = __builtin_amdgcn_readfirstlane(tid >> 6), wr = wid >> 2, wc = wid & 3;
    const int K = g.K, nt = K / BK;
    unsigned voffB[2];
#pragma unroll
    for (int i = 0; i < 2; ++i) { int R, C; stage_rc(tid * 16 + i * 8192, R, C); const int Rb = Epi::PERM ? ((R & ~31) + perm32(R & 31)) : R;
        voffB[i] = (unsigned)(Rb * g.ldb + C) * 2u; }
    const size_t kstep = (size_t)(BK * 2);
    const size_t hstepB = (size_t)HALF * g.ldb * 2;
    const unsigned ldsw = (unsigned)wid * 1024u;
    const int aoff = lds_byte(wr * 64 + (tid & 15), ((tid & 63) >> 4) * 8), boff = lds_byte(wc * 32 + (tid & 15), ((tid & 63) >> 4) * 8);
    const size_t hstepA = GATHER ? 0 : (size_t)HALF * g.lda * 2;
#define PG8_SA(b, h) (((b) * 2 + (h)) * HTB)
#define PG8_SB(b, h) ((4 + (b) * 2 + (h)) * HTB)
#define PG8_STAGE(bufoff, gbase, v0, v1) do { \
        __builtin_amdgcn_global_load_lds((const unsigned*)((const char*)(gbase) + (v0)), (PG8_LAS unsigned*)(lds + (bufoff) + ldsw), 16, 0, 0); \
        __builtin_amdgcn_global_load_lds((const unsigned*)((const char*)(gbase) + (v1)), (PG8_LAS unsigned*)(lds + (bufoff) + ldsw + 8192), 16, 0, 0); } while (0)
#define PG8_STAGEB(bufoff, gbase) PG8_STAGE(bufoff, gbase, voffB[0], voffB[1])
#define PG8_LDA(dst, b, h) do { _Pragma("unroll") for (int m = 0; m < 4; ++m) _Pragma("unroll") for (int k = 0; k < 2; ++k) dst[m][k] = *(const PG8_LAS bf16x8*)(lds + PG8_SA(b, h) + aoff + m * 2048 + k * 1024); } while (0)
#define PG8_LDB(dst, b, h) do { _Pragma("unroll") for (int n = 0; n < 2; ++n) _Pragma("unroll") for (int k = 0; k < 2; ++k) dst[n][k] = *(const PG8_LAS bf16x8*)(lds + PG8_SB(b, h) + boff + n * 2048 + k * 1024); } while (0)
#define PG8_MMA(ai, bj, At, Bt) do { __builtin_amdgcn_s_setprio(1); _Pragma("unroll") for (int m = 0; m < 4; ++m) _Pragma("unroll") for (int n = 0; n < 2; ++n) _Pragma("unroll") for (int k = 0; k < 2; ++k) \
        acc[ai][bj][m][n] = __builtin_amdgcn_mfma_f32_16x16x32_bf16(Bt[n][k], At[m][k], acc[ai][bj][m][n], 0, 0, 0); __builtin_amdgcn_s_setprio(0); } while (0)
#define PG8_WAIT_V(n) asm volatile("s_waitcnt vmcnt(" #n ")" ::: "memory")
#define PG8_WAIT_L(n) asm volatile("s_waitcnt lgkmcnt(" #n ")" ::: "memory")
#define PG8_BAR __builtin_amdgcn_s_barrier()
#define PG8_SCHED __builtin_amdgcn_sched_barrier(0)
#define PG8_VOFFA(dst, u) do { _Pragma("unroll") for (int i_ = 0; i_ < 2; ++i_) { int R_, C_; stage_rc(tid * 16 + i_ * 8192, R_, C_); _Pragma("unroll") for (int h_ = 0; h_ < 2; ++h_) { \
        const int rr_ = GATHER ? S.arow(u, R_ + h_ * HALF) : R_; dst[h_ * 2 + i_] = (unsigned)(rr_ * g.lda + C_) * 2u; } } } while (0)
    Unit cur, nxt; int ui = 0;
    if (!S.next(0, cur)) return;
    f32x4 acc[2][2][4][2];
#pragma unroll
    for (int a = 0; a < 2; ++a)
#pragma unroll
        for (int b = 0; b < 2; ++b)
#pragma unroll
            for (int m = 0; m < 4; ++m)
#pragma unroll
                for (int n = 0; n < 2; ++n) acc[a][b][m][n] = (f32x4){0.f, 0.f, 0.f, 0.f};
    bf16x8 At[4][2], B0[2][2], B1[2][2];
    unsigned vC[4];
    PG8_VOFFA(vC, cur);
    PG8_LAS u32x4* myN = (PG8_LAS u32x4*)(lds + STAGE_BYTES + tid * 16);
    const char* cA = cur.A; const char* cB = cur.B;
    PG8_STAGEB(PG8_SB(0, 0), cB); PG8_STAGEB(PG8_SB(0, 1), cB + hstepB); PG8_STAGE(PG8_SA(0, 0), cA, vC[0], vC[1]); PG8_STAGE(PG8_SA(0, 1), cA + hstepA, vC[2], vC[3]);
    if (wr == 1) PG8_BAR;
    PG8_WAIT_V(2); PG8_BAR;
    PG8_STAGEB(PG8_SB(1, 0), cB + kstep); PG8_STAGE(PG8_SA(1, 0), cA + kstep, vC[0], vC[1]); PG8_STAGEB(PG8_SB(1, 1), cB + hstepB + kstep);
    PG8_WAIT_V(6); PG8_BAR;
    for (;;) {
        const bool has_next = S.next(ui + 1, nxt);
        const char* nA = cA; const char* nB = cB;
        { unsigned vT[4];
#pragma unroll
          for (int q = 0; q < 4; ++q) vT[q] = vC[q];
          if (has_next) { nA = nxt.A; nB = nxt.B; PG8_VOFFA(vT, nxt); }
          *myN = (u32x4){vT[0], vT[1], vT[2], vT[3]}; }
#pragma unroll 1
        for (int t = 0; t < nt; t += 2) {
            const bool last = (t == nt - 2);
            const char* a1 = cA + (size_t)(t + 1) * kstep;
            const char* a2 = last ? nA : cA + (size_t)(t + 2) * kstep; const char* b2 = last ? nB : cB + (size_t)(t + 2) * kstep;
            const char* a3 = a2 + kstep; const char* b3 = b2 + kstep;
            PG8_LDB(B0, 0, 0); PG8_LDB(B1, 0, 1); PG8_SCHED; PG8_LDA(At, 0, 0); PG8_STAGE(PG8_SA(1, 1), a1 + hstepA, vC[2], vC[3]);
            if (last) { const u32x4 vn = *myN; vC[0] = vn.x; vC[1] = vn.y; vC[2] = vn.z; vC[3] = vn.w; }
            PG8_WAIT_V(8); PG8_WAIT_L(0); PG8_BAR; PG8_MMA(0, 0, At, B0); PG8_MMA(0, 1, At, B1); PG8_BAR; PG8_SCHED;
            PG8_LDA(At, 0, 1); PG8_STAGEB(PG8_SB(0, 0), b2); PG8_STAGEB(PG8_SB(0, 1), b2 + hstepB); PG8_STAGE(PG8_SA(0, 0), a2, vC[0], vC[1]);
            PG8_WAIT_V(8); PG8_WAIT_L(0); PG8_BAR; PG8_MMA(1, 0, At, B0); PG8_MMA(1, 1, At, B1); PG8_BAR; PG8_SCHED;
            PG8_LDB(B0, 1, 0); PG8_LDB(B1, 1, 1); PG8_SCHED; PG8_LDA(At, 1, 0); PG8_STAGE(PG8_SA(0, 1), a2 + hstepA, vC[2], vC[3]);
            PG8_WAIT_V(8); PG8_WAIT_L(0); PG8_BAR; PG8_MMA(0, 0, At, B0); PG8_MMA(0, 1, At, B1); PG8_BAR; PG8_SCHED;
            PG8_LDA(At, 1, 1); PG8_STAGEB(PG8_SB(1, 0), b3); PG8_STAGEB(PG8_SB(1, 1), b3 + hstepB); PG8_STAGE(PG8_SA(1, 0), a3, vC[0], vC[1]);
            PG8_WAIT_V(8); PG8_WAIT_L(0); PG8_BAR; PG8_MMA(1, 0, At, B0); PG8_MMA(1, 1, At, B1); PG8_BAR; PG8_SCHED;
        }
        if (wr == 0) PG8_BAR;
        { int ln_ = (int)__builtin_amdgcn_mbcnt_hi(~0u, __builtin_amdgcn_mbcnt_lo(~0u, 0u)); asm volatile("" : "+v"(ln_));
          E(acc, cur, wr, wc, ln_ & 15, ln_ >> 4); }
        if (!has_next) break;
#pragma unroll
        for (int a = 0; a < 2; ++a)
#pragma unroll
            for (int b = 0; b < 2; ++b)
#pragma unroll
                for (int m = 0; m < 4; ++m)
#pragma unroll
                    for (int n = 0; n < 2; ++n) acc[a][b][m][n] = (f32x4){0.f, 0.f, 0.f, 0.f};
        cur = nxt; cA = nA; cB = nB; ++ui;
        if (wr == 1) PG8_BAR;
    }
    PG8_WAIT_V(0);
    PG8_BAR;
#undef PG8_SA
#undef PG8_SB
#undef PG8_STAGE
#undef PG8_STAGEB
#undef PG8_LDA
#undef PG8_LDB
#undef PG8_MMA
#undef PG8_WAIT_V
#undef PG8_WAIT_L
#undef PG8_BAR
#undef PG8_SCHED
#undef PG8_VOFFA
}
}

template <int NBM, class AF, class Epi>
__device__ __forceinline__ void sgemm_tile(float* lds, int K, AF arow, const float* __restrict__ B0, const float* __restrict__ B1, int ldb, int n0, int N, Epi epi) {
    const int tid = tid_fresh();
    float* As = lds;
    float* Bs0 = lds + 16 * 132;
    float* Bs1 = lds + 2 * 16 * 132;
    const int ty = tid >> 5, tx = tid & 31;
    float acc0[8][4], acc1[8][4];
#pragma unroll
    for (int i = 0; i < 8; ++i)
#pragma unroll
        for (int j = 0; j < 4; ++j) { acc0[i][j] = 0.f; acc1[i][j] = 0.f; }
    const int ar = tid >> 2, ak = (tid & 3) * 4;
    const float* ap = arow(ar);
    const int bk = tid >> 5, bn = (tid & 31) * 4;
    const bool bok = (n0 + bn) < N;
    for (int k0 = 0; k0 < K; k0 += 16) {
        float4 av = ap ? *(const float4*)(ap + k0 + ak) : make_float4(0.f, 0.f, 0.f, 0.f);
        float4 bv0 = bok ? *(const float4*)(B0 + (size_t)(k0 + bk) * ldb + n0 + bn) : make_float4(0.f, 0.f, 0.f, 0.f);
        float4 bv1 = make_float4(0.f, 0.f, 0.f, 0.f);
        if (NBM == 2) { if (bok) bv1 = *(const float4*)(B1 + (size_t)(k0 + bk) * ldb + n0 + bn); }
        __syncthreads();
        As[(ak + 0) * 132 + ar] = av.x; As[(ak + 1) * 132 + ar] = av.y; As[(ak + 2) * 132 + ar] = av.z; As[(ak + 3) * 132 + ar] = av.w;
        *(float4*)&Bs0[bk * 132 + bn] = bv0;
        if (NBM == 2) *(float4*)&Bs1[bk * 132 + bn] = bv1;
        __syncthreads();
#pragma unroll 2
        for (int k = 0; k < 16; ++k) {
            const float4 a0 = *(const float4*)&As[k * 132 + ty * 8], a1 = *(const float4*)&As[k * 132 + ty * 8 + 4];
            const float a[8] = {a0.x, a0.y, a0.z, a0.w, a1.x, a1.y, a1.z, a1.w};
            const float4 b0 = *(const float4*)&Bs0[k * 132 + tx * 4];
            const float bb0[4] = {b0.x, b0.y, b0.z, b0.w};
#pragma unroll
            for (int i = 0; i < 8; ++i)
#pragma unroll
                for (int j = 0; j < 4; ++j) acc0[i][j] = fmaf(a[i], bb0[j], acc0[i][j]);
            if (NBM == 2) {
                const float4 b1 = *(const float4*)&Bs1[k * 132 + tx * 4];
                const float bb1[4] = {b1.x, b1.y, b1.z, b1.w};
#pragma unroll
                for (int i = 0; i < 8; ++i)
#pragma unroll
                    for (int j = 0; j < 4; ++j) acc1[i][j] = fmaf(a[i], bb1[j], acc1[i][j]);
            }
        }
    }
    if (bok) {
#pragma unroll
        for (int i = 0; i < 8; ++i)
#pragma unroll
            for (int j = 0; j < 4; ++j) epi(ty * 8 + i, tx * 4 + j, acc0[i][j], acc1[i][j]);
    }
}

__device__ __forceinline__ void transpose_blk(const float* W, int N, bf16_t* WT, int K, int k0, int n0, int drow0, float* scr, int lane) {
#pragma unroll 8
    for (int i = 0; i < 32; ++i) { const int kk = 2 * i + (lane >> 5); scr[kk * 33 + (lane & 31)] = W[(size_t)(k0 + kk) * N + n0 + (lane & 31)]; }
    asm volatile("s_waitcnt lgkmcnt(0)" ::: "memory");
    const int c = lane & 7;
#pragma unroll
    for (int j = 0; j < 4; ++j) { const int n = (lane >> 3) + 8 * j; const float* sp = scr + (8 * c) * 33 + n;
        uint4 o; o.x = pk2(sp[0 * 33], sp[1 * 33]); o.y = pk2(sp[2 * 33], sp[3 * 33]); o.z = pk2(sp[4 * 33], sp[5 * 33]); o.w = pk2(sp[6 * 33], sp[7 * 33]);
        *(uint4*)(WT + (size_t)(drow0 + n) * K + k0 + 8 * c) = o; }
    asm volatile("s_waitcnt lgkmcnt(0)" ::: "memory");
}
__device__ __forceinline__ void transpose_item(const float* W, int K, int N, bf16_t* WT, int row_off, float* scr, int item, int lane) {
    const int nblk = N / 32, kb = item / nblk, nb = item % nblk;
    transpose_blk(W, N, WT, K, 64 * kb, 32 * nb, row_off + 32 * nb, scr, lane);
}
__device__ __forceinline__ void convert_experts(const Args& a, int l, float* lds) {
    const int tid = tid_fresh(), lane = tid & 63, wid = tid >> 6;
    float* scr = lds + wid * (64 * 33);
    const int gw = blockIdx.x * 8 + wid, NGW = gridDim.x * 8;
    bf16_t* WGU = (bf16_t*)(a.ws + WS_WEXP); bf16_t* WD = WGU + (size_t)NEXP * 1024 * 1024;
    for (int it = gw; it < NEXP * 768; it += NGW) {
        const int e = it / 768; int r = it % 768;
        if (r < 512) {
            const bool up = r >= 256; r &= 255; const int kb = r >> 4, nb = r & 15, n0 = 32 * nb;
            const float* W = (up ? a.in[26] : a.in[25]) + ((size_t)l * NEXP + e) * DM * DEXP;
            transpose_blk(W, DEXP, WGU + (size_t)e * 1024 * 1024, DM, 64 * kb, n0, 256 * (n0 >> 7) + (n0 & 127) + (up ? 128 : 0), scr, lane);
        } else {
            r -= 512; const int kb = r >> 5, nb = r & 31;
            const float* W = a.in[27] + ((size_t)l * NEXP + e) * DEXP * DM;
            transpose_blk(W, DM, WD + (size_t)e * 1024 * 512, DEXP, 64 * kb, 32 * nb, 32 * nb, scr, lane);
        }
    }
}
__device__ __forceinline__ void cvt_row(const float* in, bf16_t* out, int lane) {
#pragma unroll
    for (int j = 0; j < 4; ++j) { const float4 v = *(const float4*)(in + j * 256 + lane * 4); uint2 o; o.x = pk2(v.x, v.y); o.y = pk2(v.z, v.w); *(uint2*)(out + j * 256 + lane * 4) = o; }
}
__device__ __forceinline__ void phase_prologue(const Args& a, float* lds) {
    const int tid = tid_fresh(), lane = tid & 63, wid = tid >> 6;
    float* scr = lds + wid * (64 * 33);
    const int gw = blockIdx.x * 8 + wid, NGW = gridDim.x * 8;
    bf16_t* WIN0 = (bf16_t*)(a.ws + WS_WIN0); bf16_t* WIN1 = (bf16_t*)(a.ws + WS_WIN1);
    constexpr int I_IN = 16 * 104, I_VR = 16, I_SQ = 16 * 32, I_KV = 16 * 64;
    constexpr int NITEMS = 2 * I_IN + I_VR + 6 * I_SQ + 2 * I_KV;
    for (int it = gw; it < NITEMS; it += NGW) {
        int r = it;
        if (r < I_IN) { transpose_item(a.in[2], DM, IN_COLS, WIN0, 0, scr, r, lane); continue; } r -= I_IN;
        if (r < I_IN) { transpose_item(a.in[2] + (size_t)DM * IN_COLS, DM, IN_COLS, WIN1, 0, scr, r, lane); continue; } r -= I_IN;
        if (r < I_VR) { transpose_item(a.in[3], DM, 32, WIN1, IN_COLS, scr, r, lane); continue; } r -= I_VR;
        constexpr int I_L = 3 * I_SQ + I_KV;
        const int l = r / I_L; r -= l * I_L;
        if (r < I_SQ) { transpose_item(a.in[19] + (size_t)l * DM * DM, DM, DM, (bf16_t*)(a.ws + WS_WOUT) + (size_t)l * DM * DM, 0, scr, r, lane); continue; } r -= I_SQ;
        if (r < I_SQ) { transpose_item(a.in[20] + (size_t)l * DM * DM, DM, DM, (bf16_t*)(a.ws + WS_WQ) + (size_t)l * DM * DM, 0, scr, r, lane); continue; } r -= I_SQ;
        if (r < I_KV) { transpose_item(a.in[21] + (size_t)l * DM * 2048, DM, 2048, (bf16_t*)(a.ws + WS_WKV) + (size_t)l * DM * 2048, 0, scr, r, lane); continue; } r -= I_KV;
        transpose_item(a.in[22] + (size_t)l * DM * DM, DM, DM, (bf16_t*)(a.ws + WS_WO) + (size_t)l * DM * DM, 0, scr, r, lane);
    }
    for (int r = gw; r < 224; r += NGW) {
#pragma unroll
        for (int j = 0; j < 2; ++j) *(uint4*)(WIN1 + (size_t)(3360 + r) * DM + j * 512 + lane * 8) = make_uint4(0u, 0u, 0u, 0u);
    }
    bf16_t* XB = (bf16_t*)(a.ws + WS_XB); bf16_t* MEMB = (bf16_t*)(a.ws + WS_MEMB);
    for (int m = gw; m < NTOK; m += NGW) cvt_row(a.in[0] + (size_t)m * DM, XB + (size_t)m * DM, lane);
    for (int m = gw; m < NBATCH * MEMLEN; m += NGW) cvt_row(a.in[1] + (size_t)m * DM, MEMB + (size_t)m * DM, lane);
    {
        const int gt = blockIdx.x * NTHREADS + tid, NGT = gridDim.x * NTHREADS;
        for (int idx = gt; idx < 2 * 512 * 288; idx += NGT) {
            const int l = idx / (512 * 288); int r = idx % (512 * 288);
            bf16_t* base = (bf16_t*)(a.ws + WS_LORA + (size_t)l * LORA_L);
            if (r < 512 * 64) { const int n = r >> 6, k = r & 63; base[r] = f2bf(a.in[7][((size_t)l * 64 + k) * 512 + n]); continue; } r -= 512 * 64;
            if (r < 512 * 64) { const int n = r >> 6, k = r & 63; base[512 * 64 + r] = f2bf(a.in[9][((size_t)l * 64 + k) * 512 + n]); continue; } r -= 512 * 64;
            if (r < 512 * 128) { const int n = r >> 7, k = r & 127; base[2 * 512 * 64 + r] = f2bf(a.in[12][((size_t)l * 128 + k) * 512 + n]); continue; } r -= 512 * 128;
            { const int n = r >> 5, k = r & 31; base[2 * 512 * 64 + 512 * 128 + r] = f2bf(a.in[11][(size_t)k * 512 + n]); }
        }
    }
    convert_experts(a, 0, lds);
}

__device__ __forceinline__ void phase_g1(const Args& a, int l, PG8_LAS unsigned char* lds) {
    pg8::G1Sched S; S.init(a.ws + WS_XB, a.ws + (l == 0 ? WS_WIN0 : WS_WIN1), l == 0 ? IN_COLS / 256 : ZLD / 256, a.ws + WS_MEMB, a.ws + WS_WKV + (size_t)l * 4 * MiB);
    pg8::EpiG1 E{(bf16_t*)(a.ws + WS_Z), (bf16_t*)(a.ws + WS_KB), (bf16_t*)(a.ws + WS_VT)};
    pg8::gemm_phase<pg8::EpiG1, pg8::G1Sched, false>(lds, pg8::Dims{DM, DM, DM}, S, E);
}
__device__ __forceinline__ void phase_matt_s(const Args& a, PG8_LAS unsigned char* lds) {
    pg8::MattSched S; S.init(a.ws + WS_Q, a.ws + WS_KB, (size_t)256 * 1024 * 2, 256 * 2);
    pg8::EpiSoftmax E{(bf16_t*)(a.ws + WS_P), (float*)(a.ws + WS_LSUM), (PG8_LAS float*)(lds + pg8::STAGE_BYTES + 8192 + 512)};
    pg8::gemm_phase<pg8::EpiSoftmax, pg8::MattSched, false>(lds, pg8::Dims{1024, 1024, 256}, S, E);
}
__device__ __forceinline__ void phase_matt_pv(const Args& a, PG8_LAS unsigned char* lds) {
    pg8::MattSched S; S.init(a.ws + WS_P, a.ws + WS_VT, (size_t)1024 * 256 * 2, 256 * 256 * 2);
    pg8::EpiPV E{(bf16_t*)(a.ws + WS_O), (const float*)(a.ws + WS_LSUM)};
    pg8::gemm_phase<pg8::EpiPV, pg8::MattSched, false>(lds, pg8::Dims{1024, 256, 256}, S, E);
}

typedef _Float16 h8_t __attribute__((ext_vector_type(8)));
typedef _Float16 h2_t __attribute__((ext_vector_type(2)));
__device__ __forceinline__ unsigned pkh2(float lo, float hi) { h2_t v = {(_Float16)lo, (_Float16)hi}; return __builtin_bit_cast(unsigned, v); }
#define SC_DPP(x, ctrl) __int_as_float(__builtin_amdgcn_mov_dpp(__float_as_int(x), ctrl, 0xF, 0xF, true))
__device__ __forceinline__ float sum32(float x) {
    x += SC_DPP(x, 0xB1); x += SC_DPP(x, 0x4E); x += SC_DPP(x, 0x141); x += SC_DPP(x, 0x140);
    return x + __shfl_xor(x, 16);
}
__device__ __forceinline__ void phase_prep(const Args& a, int l, float* lds) {
    typedef short bf16x8 __attribute__((ext_vector_type(8)));
    typedef float f32x16 __attribute__((ext_vector_type(16)));
    const bf16_t* Z = (const bf16_t*)(a.ws + WS_Z);
    const int tid = tid_fresh(), lane = tid & 63, wid = tid >> 6, r32 = lane & 31, hi = lane >> 5;
    float* KM = (float*)(a.ws + WS_KMEAN);
    for (int u = blockIdx.x * 8 + wid; u < NBATCH * NH * 8; u += gridDim.x * 8) {
        const int nb = u & 7, h = (u >> 3) & 7, b = u >> 6, rg = lane >> 3, ch = lane & 7;
        const bf16_t* p = Z + (size_t)(b * SEQ + nb * 256 + rg) * ZLD + C_K + h * HD + ch * 8;
        float acc[8];
#pragma unroll
        for (int j = 0; j < 8; ++j) acc[j] = 0.f;
#pragma unroll 8
        for (int i = 0; i < 32; ++i) { const uint4 v = *(const uint4*)(p + (size_t)(i * 8) * ZLD);
            acc[0] += bflo(v.x); acc[1] += bfhi(v.x); acc[2] += bflo(v.y); acc[3] += bfhi(v.y); acc[4] += bflo(v.z); acc[5] += bfhi(v.z); acc[6] += bflo(v.w); acc[7] += bfhi(v.w); }
#pragma unroll
        for (int j = 0; j < 8; ++j) { float x = acc[j]; x += __shfl_xor(x, 8); x += __shfl_xor(x, 16); x += __shfl_xor(x, 32); acc[j] = x * (1.0f / 256.0f); }
        if (rg == 0) { *(float4*)(KM + (size_t)u * 64 + ch * 8) = make_float4(acc[0], acc[1], acc[2], acc[3]); *(float4*)(KM + (size_t)u * 64 + ch * 8 + 4) = make_float4(acc[4], acc[5], acc[6], acc[7]); }
    }
    const float* mu = a.in[4] + (size_t)l * 1792;
    const float* muv = a.in[5];
    const bf16_t* WdT = (const bf16_t*)(a.ws + WS_LORA + (size_t)l * LORA_L); const bf16_t* WiT = (const bf16_t*)(a.ws + WS_LORA + (size_t)l * LORA_L + LORA_I);
    const bf16_t* WgT = (const bf16_t*)(a.ws + WS_LORA + (size_t)l * LORA_L + LORA_G); const bf16_t* WvT = (const bf16_t*)(a.ws + WS_LORA + LORA_V);
    unsigned* REC = (unsigned*)(a.ws + WS_REC);
    _Float16* RVT = (_Float16*)(a.ws + WS_RVT); bf16_t* RGp = (bf16_t*)(a.ws + WS_RG); float* BON = (float*)(a.ws + WS_BON);
    bf16_t* VF = (bf16_t*)(a.ws + WS_VFIRST);
    for (int task = blockIdx.x * 8 + wid; task < 512 * 8; task += gridDim.x * 8) {
        const int h = task & 7, tb = task >> 3, t0 = tb * 32, b = t0 / SEQ, tt0 = t0 % SEQ, bh = b * NH + h;
        const size_t tokA = (size_t)t0 + r32;
        const bool firstA = (tt0 == 0) && (r32 == 0);
#define PREP_AFRAG(dst, zcol, mup, ACT) do { \
            const uint4 cu_ = *(const uint4*)(Z + tokA * ZLD + (zcol)); uint4 pv_ = make_uint4(0u, 0u, 0u, 0u); if (!firstA) pv_ = *(const uint4*)(Z + (tokA - 1) * ZLD + (zcol)); \
            const float4 m0_ = *(const float4*)(mup), m1_ = *(const float4*)((mup) + 4); \
            float x_[8]; const unsigned cw_[4] = {cu_.x, cu_.y, cu_.z, cu_.w}, pw_[4] = {pv_.x, pv_.y, pv_.z, pv_.w}; const float mm_[8] = {m0_.x, m0_.y, m0_.z, m0_.w, m1_.x, m1_.y, m1_.z, m1_.w}; \
            _Pragma("unroll") for (int q_ = 0; q_ < 4; ++q_) { const float c0_ = bflo(cw_[q_]), c1_ = bfhi(cw_[q_]); x_[2 * q_] = c0_ + (bflo(pw_[q_]) - c0_) * mm_[2 * q_]; x_[2 * q_ + 1] = c1_ + (bfhi(pw_[q_]) - c1_) * mm_[2 * q_ + 1]; } \
            _Pragma("unroll") for (int q_ = 0; q_ < 8; ++q_) { if (ACT == 1) x_[q_] = 1.0f - 2.0f * __builtin_amdgcn_rcpf(__expf(2.0f * x_[q_]) + 1.0f); else if (ACT == 2) x_[q_] = __builtin_amdgcn_rcpf(1.0f + __expf(-x_[q_])); } \
            pg8::u32x4 w_; w_.x = pk2(x_[0], x_[1]); w_.y = pk2(x_[2], x_[3]); w_.z = pk2(x_[4], x_[5]); w_.w = pk2(x_[6], x_[7]); dst = __builtin_bit_cast(bf16x8, w_); } while (0)
        const int chB = h * 64 + r32;
#define PREP_TOK(r) int hq_ = hi; asm volatile("" : "+v"(hq_)); const int tq = ((r) & 3) + 8 * ((r) >> 2) + 4 * hq_, t = tt0 + tq; const size_t tok = (size_t)t0 + tq; (void)t; (void)tok
#define PREP_RB(t, j) (((((size_t)bh * 512 + ((t) >> 2)) * 32 + ((j) >> 1)) * 4 + ((t) & 3)) * 5)
        f32x16 acc[2];
#pragma unroll
        for (int nb = 0; nb < 2; ++nb)
#pragma unroll
            for (int r = 0; r < 16; ++r) acc[nb][r] = 0.f;
#pragma unroll 1
        for (int sI = 0; sI < 8; ++sI) {
            bf16x8 af; PREP_AFRAG(af, C_ZG + 16 * sI + 8 * hi, mu + (C_ZG - C_R) + 16 * sI + 8 * hi, 2);
#pragma unroll
            for (int nb = 0; nb < 2; ++nb) acc[nb] = __builtin_amdgcn_mfma_f32_32x32x16_bf16(af, *(const bf16x8*)(WgT + (size_t)(chB + 32 * nb) * 128 + 16 * sI + 8 * hi), acc[nb], 0, 0, 0);
        }
#pragma unroll
        for (int nb = 0; nb < 2; ++nb)
#pragma unroll
            for (int r = 0; r < 16; ++r) { PREP_TOK(r); const float sg = acc[nb][r], og = SC_DPP(sg, 0xB1); if (!(r32 & 1)) *(unsigned*)(RGp + tok * 512 + chB + 32 * nb) = pk2(sg, og); }
#pragma unroll
        for (int nb = 0; nb < 2; ++nb)
#pragma unroll
            for (int r = 0; r < 16; ++r) acc[nb][r] = 0.f;
#pragma unroll 1
        for (int sI = 0; sI < 4; ++sI) {
            bf16x8 af; PREP_AFRAG(af, C_ZW + 16 * sI + 8 * hi, mu + (C_ZW - C_R) + 16 * sI + 8 * hi, 1);
#pragma unroll
            for (int nb = 0; nb < 2; ++nb) acc[nb] = __builtin_amdgcn_mfma_f32_32x32x16_bf16(af, *(const bf16x8*)(WdT + (size_t)(chB + 32 * nb) * 64 + 16 * sI + 8 * hi), acc[nb], 0, 0, 0);
        }
#pragma unroll
        for (int nb = 0; nb < 2; ++nb) {
            const float w0c = a.in[6][l * 512 + chB + 32 * nb];
#pragma unroll
            for (int r = 0; r < 16; ++r) { PREP_TOK(r); const float sd = w0c + acc[nb][r]; const float uu = -expm1f(-__expf(-softplusf_(-sd) - 0.5f)); const float o0 = SC_DPP(uu, 0xB1);
                if (!(r32 & 1)) REC[PREP_RB(t, 32 * nb + r32) + 0] = pkh2(uu, o0); }
        }
        f32x16 aia[2], vga[2];
#pragma unroll
        for (int nb = 0; nb < 2; ++nb)
#pragma unroll
            for (int r = 0; r < 16; ++r) { aia[nb][r] = 0.f; vga[nb][r] = 0.f; }
#pragma unroll 1
        for (int sI = 0; sI < 4; ++sI) {
            bf16x8 af; PREP_AFRAG(af, C_ZA + 16 * sI + 8 * hi, mu + (C_ZA - C_R) + 16 * sI + 8 * hi, 0);
#pragma unroll
            for (int nb = 0; nb < 2; ++nb) aia[nb] = __builtin_amdgcn_mfma_f32_32x32x16_bf16(af, *(const bf16x8*)(WiT + (size_t)(chB + 32 * nb) * 64 + 16 * sI + 8 * hi), aia[nb], 0, 0, 0);
        }
        if (l == 1) {
#pragma unroll 1
            for (int sI = 0; sI < 2; ++sI) {
                bf16x8 af; PREP_AFRAG(af, C_ZV + 16 * sI + 8 * hi, muv + 16 * sI + 8 * hi, 0);
#pragma unroll
                for (int nb = 0; nb < 2; ++nb) vga[nb] = __builtin_amdgcn_mfma_f32_32x32x16_bf16(af, *(const bf16x8*)(WvT + (size_t)(chB + 32 * nb) * 32 + 16 * sI + 8 * hi), vga[nb], 0, 0, 0);
            }
        }
#undef PREP_AFRAG
        float ss[16], bon[16]; f32x16 kkr[2];
#pragma unroll
        for (int r = 0; r < 16; ++r) { ss[r] = 0.f; bon[r] = 0.f; }
#pragma unroll
        for (int nb = 0; nb < 2; ++nb) {
            const int j = 32 * nb + r32, c = h * 64 + j;
            const float a0c = a.in[8][l * 512 + c], v0c = a.in[10][c];
            const float mu_r = mu[c], mu_k = mu[512 + c], mu_v = mu[1024 + c];
            const float kk_c = a.in[13][l * 512 + c], ka_c = a.in[14][l * 512 + c], rk_c = a.in[15][l * 512 + c];
            float vkeep = 0.f;
#pragma unroll
            for (int r = 0; r < 16; ++r) {
                asm volatile("" ::: "memory");
                PREP_TOK(r);
                const float ai = sigmoidf_(a0c + aia[nb][r]);
                const float zr = bf2f(Z[tok * ZLD + C_R + c]), zk = bf2f(Z[tok * ZLD + C_KR + c]), zv = bf2f(Z[tok * ZLD + C_VR + c]);
                float pr = 0.f, pk = 0.f, pv = 0.f;
                if (t != 0) { pr = bf2f(Z[(tok - 1) * ZLD + C_R + c]); pk = bf2f(Z[(tok - 1) * ZLD + C_KR + c]); pv = bf2f(Z[(tok - 1) * ZLD + C_VR + c]); }
                const float rr_ = zr + (pr - zr) * mu_r, kx = zk + (pk - zk) * mu_k;
                float v = zv + (pv - zv) * mu_v;
                if (l == 0) { const float vo = SC_DPP(v, 0xB1); if (!(r32 & 1)) *(unsigned*)(VF + tok * 512 + c) = pk2(v, vo); }
                else v = v + (bf2f(VF[tok * 512 + c]) - v) * sigmoidf_(v0c + vga[nb][r]);
                const float kkraw = kx * kk_c, kp = kx * (1.0f + (ai - 1.0f) * ka_c);
                ss[r] = fmaf(kkraw, kkraw, ss[r]); bon[r] = fmaf(rr_ * kp, rk_c, bon[r]);
                kkr[nb][r] = kkraw; aia[nb][r] = ai;
                { const float o3 = SC_DPP(kp, 0xB1), o4 = SC_DPP(rr_, 0xB1); const size_t rb = PREP_RB(t, j);
                  if (!(r32 & 1)) { REC[rb + 3] = pkh2(kp, o3); REC[rb + 4] = pkh2(rr_, o4); } }
                if (r & 1) *(unsigned*)(RVT + (((size_t)bh * 256 + (t >> 3)) * 64 + j) * 8 + ((t - 1) & 7)) = pkh2(vkeep, v); else vkeep = v;
            }
        }
#pragma unroll
        for (int r = 0; r < 16; ++r) {
            asm volatile("" ::: "memory");
            PREP_TOK(r);
            const float sst = sum32(ss[r]), bt = sum32(bon[r]);
            const float rn = rsqrtf(fmaxf(sst, 1e-24f));
#pragma unroll
            for (int nb = 0; nb < 2; ++nb) {
                const int j = 32 * nb + r32;
                const float kk = kkr[nb][r] * rn, an = -kk, bn = kk * aia[nb][r];
                const float o1 = SC_DPP(an, 0xB1), o2 = SC_DPP(bn, 0xB1);
                const size_t rb = PREP_RB(t, j);
                if (!(r32 & 1)) { REC[rb + 1] = pkh2(an, o1); REC[rb + 2] = pkh2(bn, o2); }
            }
            if (r32 == 0) BON[tok * 8 + h] = bt;
        }
#undef PREP_TOK
#undef PREP_RB
    }
}

__device__ __forceinline__ float dpp_add(float x, float y_src, int) { return x + y_src; }
__device__ __forceinline__ float red32(float x) {
    x += SC_DPP(x, 0xB1); x += SC_DPP(x, 0x4E); x += SC_DPP(x, 0x141); x += SC_DPP(x, 0x140);
    auto rr = __builtin_amdgcn_permlane32_swap(__float_as_uint(x), __float_as_uint(x), false, false);
    return __uint_as_float(rr[0]) + __uint_as_float(rr[1]);
}
__device__ __forceinline__ void phase_scan(const Args& a, int l, PG8_LAS unsigned char* lds) {
    const int tid = tid_fresh(), lane = tid & 63, wid = __builtin_amdgcn_readfirstlane(tid >> 6);
    const int j2 = (lane & 15) | ((lane >> 5) << 4), rr = (lane >> 4) & 1;
    const char* REC = (const char*)(a.ws + WS_REC); const char* RVT = (const char*)(a.ws + WS_RVT);
    bf16_t* YR = (bf16_t*)(a.ws + WS_YRAW);
    constexpr int CH_REC = 40960, CH_V = 8192, CH = CH_REC + CH_V;
    for (int u = blockIdx.x; u < 256; u += gridDim.x) {
        const int bh = u >> 2, rg = u & 3, b = bh >> 3, h = bh & 7;
        const int irow = rg * 16 + wid * 2 + rr;
        const char* grec = REC + (size_t)bh * 32 * CH_REC; const char* gv = RVT + (size_t)bh * 32 * CH_V;
        float S0 = 0.f, S1 = 0.f, ykeep = 0.f;
        __syncthreads();
#pragma unroll
        for (int k = 0; k < 6; ++k) { const int pc = wid * 6 + k; const char* src = (pc < 40) ? grec + pc * 1024 + lane * 16 : gv + (pc - 40) * 1024 + lane * 16;
            __builtin_amdgcn_global_load_lds((const unsigned*)src, (PG8_LAS unsigned*)(lds + pc * 1024), 16, 0, 0); }
        for (int ch = 0; ch < 32; ++ch) {
            asm volatile("s_waitcnt vmcnt(0)" ::: "memory");
            __syncthreads();
            if (ch + 1 < 32) {
                const int nb = ((ch + 1) & 1) * CH;
#pragma unroll
                for (int k = 0; k < 6; ++k) { const int pc = wid * 6 + k; const char* src = (pc < 40) ? grec + (size_t)(ch + 1) * CH_REC + pc * 1024 + lane * 16 : gv + (size_t)(ch + 1) * CH_V + (pc - 40) * 1024 + lane * 16;
                    __builtin_amdgcn_global_load_lds((const unsigned*)src, (PG8_LAS unsigned*)(lds + nb + pc * 1024), 16, 0, 0); }
            }
            PG8_LAS const unsigned char* bufp = lds + (ch & 1) * CH;
            for (int g8 = 0; g8 < 8; ++g8) {
                const h8_t vv = *(PG8_LAS const h8_t*)(bufp + CH_REC + (g8 * 64 + irow) * 16);
#pragma unroll
                for (int hf = 0; hf < 2; ++hf) {
                    PG8_LAS const unsigned char* rp = bufp + ((g8 * 2 + hf) * 32 + j2) * 80;
                    h8_t rv[5];
#pragma unroll
                    for (int k = 0; k < 5; ++k) rv[k] = *(PG8_LAS const h8_t*)(rp + 16 * k);
#pragma unroll
                    for (int ts = 0; ts < 4; ++ts) {
#define SC_H(n) ((float)rv[(n) >> 3][(n) & 7])
                        const float u0 = SC_H(ts * 10 + 0), u1 = SC_H(ts * 10 + 1), a0 = SC_H(ts * 10 + 2), a1 = SC_H(ts * 10 + 3), b0 = SC_H(ts * 10 + 4), b1 = SC_H(ts * 10 + 5);
                        const float k0 = SC_H(ts * 10 + 6), k1 = SC_H(ts * 10 + 7), r0 = SC_H(ts * 10 + 8), r1 = SC_H(ts * 10 + 9);
#undef SC_H
                        const float v = (float)vv[hf * 4 + ts];
                        const float sa = red32(fmaf(S1, a1, S0 * a0));
                        S0 = fmaf(v, k0, fmaf(sa, b0, fmaf(-S0, u0, S0)));
                        S1 = fmaf(v, k1, fmaf(sa, b1, fmaf(-S1, u1, S1)));
                        const float y = red32(fmaf(S1, r1, S0 * r0));
                        if (j2 == ((g8 & 3) * 8 + hf * 4 + ts)) ykeep = y;
                    }
                }
                if ((g8 & 3) == 3) {
                    const int t = ch * 64 + (g8 >> 2) * 32 + j2;
                    YR[((size_t)b * SEQ + t) * 512 + h * 64 + irow] = f2bf(ykeep);
                }
            }
        }
    }
}

__device__ __forceinline__ void phase_post(const Args& a, int l) {
    const int tid = tid_fresh(), lane = tid & 63, wid = tid >> 6;
    const bf16_t* YR = (const bf16_t*)(a.ws + WS_YRAW); const _Float16* RVT = (const _Float16*)(a.ws + WS_RVT);
    const bf16_t* RGp = (const bf16_t*)(a.ws + WS_RG); const float* BON = (const float*)(a.ws + WS_BON);
    bf16_t* MIX = (bf16_t*)(a.ws + WS_MIX);
    for (int u = blockIdx.x; u < 64 * 256; u += gridDim.x) {
        const int bh = u >> 8, t8 = u & 255, b = bh >> 3, h = bh & 7, t = t8 * 8 + wid;
        const size_t tok = (size_t)b * SEQ + t; const int c = h * 64 + lane;
        const float y = bf2f(YR[tok * 512 + c]);
        const float my = wsum(y) * (1.0f / 64.0f);
        const float dy = y - my;
        const float var = wsum(dy * dy) * (1.0f / 64.0f);
        const float yn = dy * rsqrtf(var + 64e-5f) * a.in[16][l * 512 + c] + a.in[17][l * 512 + c];
        const float v = (float)RVT[(((size_t)bh * 256 + t8) * 64 + lane) * 8 + wid];
        MIX[tok * DM + 512 + c] = f2bf((yn + BON[tok * 8 + h] * v) * bf2f(RGp[tok * 512 + c]));
    }
}

namespace att {
typedef short bf16x8 __attribute__((ext_vector_type(8)));
typedef short s16x4 __attribute__((ext_vector_type(4)));
typedef float f32x16 __attribute__((ext_vector_type(16)));
typedef __attribute__((address_space(3))) const unsigned char* lds_cptr;
constexpr int SLOT = 8192, L_K = 0, L_V = 2 * SLOT, L_WS = 4 * SLOT, L_KM = L_WS + 8 * 256, L_OST = L_KM + 2048, OST_LD = 68, L_END = L_OST + 8 * 32 * OST_LD * 4;
constexpr float C2 = 0.125f * 1.4426950408889634f;
__device__ __forceinline__ int crow(int r, int hi) { return (r & 3) + 8 * (r >> 2) + 4 * hi; }
__device__ __forceinline__ s16x4 vtr(lds_cptr p) { return __builtin_bit_cast(s16x4, __builtin_amdgcn_ds_read_tr16_b64_v4i16((__attribute__((address_space(3))) s16x4*)p)); }
__device__ __forceinline__ float swapmax(float x) { auto rr = __builtin_amdgcn_permlane32_swap(__float_as_uint(x), __float_as_uint(x), false, false); return fmaxf(__uint_as_float(rr[0]), __uint_as_float(rr[1])); }
__device__ __forceinline__ float swapsum(float x) { auto rr = __builtin_amdgcn_permlane32_swap(__float_as_uint(x), __float_as_uint(x), false, false); return __uint_as_float(rr[0]) + __uint_as_float(rr[1]); }

__device__ __forceinline__ void unit(const Args& a, int l, int b, int h, int cur, PG8_LAS unsigned char* lds) {
    const int tid = tid_fresh(), lane = tid & 63, r32 = lane & 31, hi = lane >> 5, wid = __builtin_amdgcn_readfirstlane(tid >> 6);
    const bf16_t* Zb = (const bf16_t*)(a.ws + WS_Z) + (size_t)b * SEQ * ZLD;
    const int qrel = wid * 32 + r32, qpos = cur * 256 + qrel;
    PG8_LAS float* wsf = (PG8_LAS float*)(lds + L_WS) + wid * 64;
    PG8_LAS float* kmf = (PG8_LAS float*)(lds + L_KM);
    __syncthreads();
    kmf[tid] = ((const float*)(a.ws + WS_KMEAN))[(size_t)(b * NH + h) * 512 + tid];
    const bf16_t* ksrc = Zb + (size_t)lane * ZLD + C_K + h * HD + wid * 8;
    const bf16_t* vsrc = Zb + (size_t)(16 * (wid & 3) + (lane >> 2)) * ZLD + C_V + h * HD + (wid >> 2) * 32 + (lane & 3) * 8;
#define ATT_DMA(kpos0, slot) do { \
        __builtin_amdgcn_global_load_lds((const unsigned*)(ksrc + (size_t)(kpos0) * ZLD), (PG8_LAS unsigned*)(lds + L_K + (slot) * SLOT + wid * 1024), 16, 0, 0); \
        __builtin_amdgcn_global_load_lds((const unsigned*)(vsrc + (size_t)(kpos0) * ZLD), (PG8_LAS unsigned*)(lds + L_V + (slot) * SLOT + wid * 1024), 16, 0, 0); } while (0)
    ATT_DMA(cur * 256, 0);
    bf16x8 qr[4];
#pragma unroll
    for (int d0 = 0; d0 < 4; ++d0) qr[d0] = *(const bf16x8*)(Zb + (size_t)qpos * ZLD + C_Q + h * HD + d0 * 16 + hi * 8);
    __syncthreads();
    unsigned selbits = 0u;
    {
        float g[8];
#pragma unroll
        for (int n = 0; n < 8; ++n) g[n] = 0.f;
#pragma unroll
        for (int d0 = 0; d0 < 4; ++d0)
#pragma unroll
            for (int j = 0; j < 8; ++j) { const float qv = bf2f((bf16_t)qr[d0][j]);
#pragma unroll
                for (int n = 0; n < 8; ++n) g[n] = fmaf(qv, kmf[n * 64 + d0 * 16 + hi * 8 + j], g[n]); }
#pragma unroll
        for (int n = 0; n < 8; ++n) g[n] = (n < cur) ? swapsum(g[n]) : NEG_INF;
        if (cur <= 3) selbits = (1u << cur) - 1u;
        else {
            int s0 = -1, s1 = -1, s2 = -1; float bv = -3e38f;
#pragma unroll
            for (int n = 0; n < 8; ++n) if (g[n] > bv) { bv = g[n]; s0 = n; }
            bv = -3e38f;
#pragma unroll
            for (int n = 0; n < 8; ++n) if (n != s0 && g[n] > bv) { bv = g[n]; s1 = n; }
            bv = -3e38f;
#pragma unroll
            for (int n = 0; n < 8; ++n) if (n != s0 && n != s1 && g[n] > bv) { bv = g[n]; s2 = n; }
            selbits = (1u << s0) | (1u << s1) | (1u << s2);
        }
    }
    const float s8 = 8.0f * exp2f(-(float)(h + 1));
    f32x16 base;
#pragma unroll
    for (int r = 0; r < 16; ++r) base[r] = s8 * (float)crow(r, hi);
    f32x16 o0, o1;
#pragma unroll
    for (int r = 0; r < 16; ++r) { o0[r] = 0.f; o1[r] = 0.f; }
    float m = -INFINITY, lsum = 0.f;
    const int NT = 4 * (cur + 1);
    const lds_cptr kp = (lds_cptr)(lds + L_K) + hi * 1024 + r32 * 16;
    const lds_cptr vp = (lds_cptr)(lds + L_V) + ((lane >> 4) & 1) * 32 + (lane & 3) * 8 + (4 * hi + ((lane & 15) >> 2)) * 64;
    for (int it = 0; it < NT; ++it) {
        asm volatile("s_waitcnt vmcnt(0)" ::: "memory");
        __syncthreads();
        const int blk = (it < 4) ? cur : ((it >> 2) - 1);
        const int kpos0 = blk * 256 + (it & 3) * 64;
        if (it + 1 < NT) { const int nblk = (it + 1 < 4) ? cur : (((it + 1) >> 2) - 1); ATT_DMA(nblk * 256 + ((it + 1) & 3) * 64, (it + 1) & 1); }
        const int so = (it & 1) * SLOT;
        f32x16 p0 = base, p1 = base;
#pragma unroll
        for (int d0 = 0; d0 < 4; ++d0) {
            const bf16x8 k0 = *(const __attribute__((address_space(3))) bf16x8*)(kp + so + d0 * 2048);
            const bf16x8 k1 = *(const __attribute__((address_space(3))) bf16x8*)(kp + so + d0 * 2048 + 512);
            p0 = __builtin_amdgcn_mfma_f32_32x32x16_bf16(k0, qr[d0], p0, 0, 0, 0);
            p1 = __builtin_amdgcn_mfma_f32_32x32x16_bf16(k1, qr[d0], p1, 0, 0, 0);
        }
        const bool rowsel = (it < 4) || ((selbits >> blk) & 1u);
        const float cb = rowsel ? -s8 * (float)(qpos - kpos0) : -INFINITY;
        const float cb1 = cb + s8 * 32.0f;
        if (it < 4) {
            const int kb0 = (it & 3) * 64 + 4 * hi;
#pragma unroll
            for (int r = 0; r < 16; ++r) { const int kv = kb0 + (r & 3) + 8 * (r >> 2); if (kv > qrel) p0[r] = -INFINITY; if (kv + 32 > qrel) p1[r] = -INFINITY; }
        }
        float mx0 = p0[0], mx1 = p1[0];
#pragma unroll
        for (int r = 1; r < 16; ++r) { mx0 = fmaxf(mx0, p0[r]); mx1 = fmaxf(mx1, p1[r]); }
        const float mx = swapmax(fmaxf(mx0 + cb, mx1 + cb1));
        if (__any((mx - m) * C2 > 6.0f)) {
            const float mn = fmaxf(m, mx);
            const float alpha = __builtin_amdgcn_exp2f((m - mn) * C2);
            m = mn; lsum *= alpha;
            asm volatile("s_waitcnt lgkmcnt(0)" ::: "memory");
            if (hi == 0) wsf[r32] = alpha;
            asm volatile("s_waitcnt lgkmcnt(0)" ::: "memory");
#pragma unroll
            for (int r = 0; r < 16; ++r) { const float al = wsf[crow(r, hi)]; o0[r] *= al; o1[r] *= al; }
        }
        const float tb0 = (cb - m) * C2, tb1 = (cb1 - m) * C2;
        float ls = 0.f;
#pragma unroll
        for (int r = 0; r < 16; ++r) { p0[r] = __builtin_amdgcn_exp2f(fmaf(p0[r], C2, tb0)); p1[r] = __builtin_amdgcn_exp2f(fmaf(p1[r], C2, tb1)); ls += p0[r] + p1[r]; }
        lsum += ls;
        pg8::u32x4 w0, w1, w2, w3;
        w0.x = pk2(p0[0], p0[1]); w0.y = pk2(p0[2], p0[3]); w0.z = pk2(p0[4], p0[5]); w0.w = pk2(p0[6], p0[7]);
        w1.x = pk2(p0[8], p0[9]); w1.y = pk2(p0[10], p0[11]); w1.z = pk2(p0[12], p0[13]); w1.w = pk2(p0[14], p0[15]);
        w2.x = pk2(p1[0], p1[1]); w2.y = pk2(p1[2], p1[3]); w2.z = pk2(p1[4], p1[5]); w2.w = pk2(p1[6], p1[7]);
        w3.x = pk2(p1[8], p1[9]); w3.y = pk2(p1[10], p1[11]); w3.z = pk2(p1[12], p1[13]); w3.w = pk2(p1[14], p1[15]);
        const bf16x8 pa0 = __builtin_bit_cast(bf16x8, w0), pa1 = __builtin_bit_cast(bf16x8, w1), pa2 = __builtin_bit_cast(bf16x8, w2), pa3 = __builtin_bit_cast(bf16x8, w3);
#define ATT_VF(d0, ks) ({ const s16x4 lo_ = vtr(vp + so + (d0) * 4096 + (ks) * 1024), hi_ = vtr(vp + so + (d0) * 4096 + (ks) * 1024 + 512); \
        (bf16x8){lo_[0], lo_[1], lo_[2], lo_[3], hi_[0], hi_[1], hi_[2], hi_[3]}; })
        o0 = __builtin_amdgcn_mfma_f32_32x32x16_bf16(pa0, ATT_VF(0, 0), o0, 0, 0, 0);
        o1 = __builtin_amdgcn_mfma_f32_32x32x16_bf16(pa0, ATT_VF(1, 0), o1, 0, 0, 0);
        o0 = __builtin_amdgcn_mfma_f32_32x32x16_bf16(pa1, ATT_VF(0, 1), o0, 0, 0, 0);
        o1 = __builtin_amdgcn_mfma_f32_32x32x16_bf16(pa1, ATT_VF(1, 1), o1, 0, 0, 0);
        o0 = __builtin_amdgcn_mfma_f32_32x32x16_bf16(pa2, ATT_VF(0, 2), o0, 0, 0, 0);
        o1 = __builtin_amdgcn_mfma_f32_32x32x16_bf16(pa2, ATT_VF(1, 2), o1, 0, 0, 0);
        o0 = __builtin_amdgcn_mfma_f32_32x32x16_bf16(pa3, ATT_VF(0, 3), o0, 0, 0, 0);
        o1 = __builtin_amdgcn_mfma_f32_32x32x16_bf16(pa3, ATT_VF(1, 3), o1, 0, 0, 0);
#undef ATT_VF
    }
#undef ATT_DMA
    const float lt = swapsum(lsum);
    asm volatile("s_waitcnt lgkmcnt(0)" ::: "memory");
    if (hi == 0) wsf[r32] = 1.0f / lt;
    asm volatile("s_waitcnt lgkmcnt(0)" ::: "memory");
    PG8_LAS float* stg = (PG8_LAS float*)(lds + L_OST) + wid * (32 * OST_LD);
#pragma unroll
    for (int r = 0; r < 16; ++r) { const int orow = crow(r, hi); const float il = wsf[orow]; stg[orow * OST_LD + r32] = o0[r] * il; stg[orow * OST_LD + 32 + r32] = o1[r] * il; }
    asm volatile("s_waitcnt lgkmcnt(0)" ::: "memory");
    const float* gain = a.in[18] + l * 512 + h * HD;
    bf16_t* MIX = (bf16_t*)(a.ws + WS_MIX);
#pragma unroll
    for (int i = 0; i < 4; ++i) {
        const int row = i * 8 + (lane >> 3), ch = lane & 7;
        const pg8::f32x4 va = *(PG8_LAS const pg8::f32x4*)(stg + row * OST_LD + ch * 8), vb = *(PG8_LAS const pg8::f32x4*)(stg + row * OST_LD + ch * 8 + 4);
        float ss = va[0] * va[0] + va[1] * va[1] + va[2] * va[2] + va[3] * va[3] + vb[0] * vb[0] + vb[1] * vb[1] + vb[2] * vb[2] + vb[3] * vb[3];
        ss += SC_DPP(ss, 0xB1); ss += SC_DPP(ss, 0x4E); ss += SC_DPP(ss, 0x141);
        const float rs = rsqrtf(ss * (1.0f / 64.0f) + 1e-6f);
        const pg8::f32x4 ga = *(const pg8::f32x4*)(gain + ch * 8), gb = *(const pg8::f32x4*)(gain + ch * 8 + 4);
        pg8::u32x4 w; w.x = pk2(va[0] * rs * ga[0], va[1] * rs * ga[1]); w.y = pk2(va[2] * rs * ga[2], va[3] * rs * ga[3]);
        w.z = pk2(vb[0] * rs * gb[0], vb[1] * rs * gb[1]); w.w = pk2(vb[2] * rs * gb[2], vb[3] * rs * gb[3]);
        *(pg8::u32x4*)(MIX + ((size_t)b * SEQ + cur * 256 + wid * 32 + row) * DM + h * HD + ch * 8) = w;
    }
}
}

__device__ __forceinline__ void phase_att(const Args& a, int l, PG8_LAS unsigned char* lds) {
    const int G = gridDim.x, bx = blockIdx.x;
    const int v = (G % 8 == 0) ? (bx % 8) * (G / 8) + bx / 8 : bx;
    for (int w = v; w < 256; w += G) {
        const int bh = w >> 2, s = w & 3;
        att::unit(a, l, bh >> 3, bh & 7, 7 - s, lds);
        att::unit(a, l, bh >> 3, bh & 7, s, lds);
    }
}

__device__ __forceinline__ void phase_dense_res(const void* A, const void* WT, const float* RES, float* OUT, PG8_LAS unsigned char* lds) {
    pg8::DenseSched S; S.init(A, DM, NTOK, WT, DM, DM);
    pg8::EpiF32Res E{OUT, RES, DM, ALPHA};
    pg8::gemm_phase<pg8::EpiF32Res, pg8::DenseSched, false>(lds, pg8::Dims{DM, DM, DM}, S, E);
}
__device__ __forceinline__ void phase_dense_bf16(const void* A, int M, const void* WT, int N, bf16_t* OUT, PG8_LAS unsigned char* lds) {
    pg8::DenseSched S; S.init(A, DM, M, WT, DM, N);
    pg8::EpiBf16 E{OUT, N};
    pg8::gemm_phase<pg8::EpiBf16, pg8::DenseSched, false>(lds, pg8::Dims{DM, DM, DM}, S, E);
}

__device__ __forceinline__ void ln_row(const float* in, const float* g, const float* bta, float* out, bf16_t* outb, int lane, float (&xn)[16]) {
    float x[16];
#pragma unroll
    for (int m = 0; m < 4; ++m) { const float4 v = *(const float4*)(in + m * 256 + lane * 4); x[m * 4] = v.x; x[m * 4 + 1] = v.y; x[m * 4 + 2] = v.z; x[m * 4 + 3] = v.w; }
    float s = 0.f;
#pragma unroll
    for (int k = 0; k < 16; ++k) s += x[k];
    const float mean = wsum(s) * (1.0f / 1024.0f);
    float q = 0.f;
#pragma unroll
    for (int k = 0; k < 16; ++k) { const float d = x[k] - mean; q = fmaf(d, d, q); }
    const float var = wsum(q) * (1.0f / 1024.0f);
    const float rstd = rsqrtf(var + 1e-5f);
#pragma unroll
    for (int m = 0; m < 4; ++m) {
        const float4 gv = *(const float4*)(g + m * 256 + lane * 4), bv = *(const float4*)(bta + m * 256 + lane * 4);
        float4 o;
        o.x = (x[m * 4] - mean) * rstd * gv.x + bv.x; o.y = (x[m * 4 + 1] - mean) * rstd * gv.y + bv.y;
        o.z = (x[m * 4 + 2] - mean) * rstd * gv.z + bv.z; o.w = (x[m * 4 + 3] - mean) * rstd * gv.w + bv.w;
        xn[m * 4] = o.x; xn[m * 4 + 1] = o.y; xn[m * 4 + 2] = o.z; xn[m * 4 + 3] = o.w;
        *(float4*)(out + m * 256 + lane * 4) = o;
        uint2 ob; ob.x = pk2(o.x, o.y); ob.y = pk2(o.z, o.w); *(uint2*)(outb + m * 256 + lane * 4) = ob;
    }
}
__device__ __forceinline__ void phase_ln(const float* IN, const float* g, const float* bta, float* OUT, bf16_t* OUTB) {
    const int tid = tid_fresh(), lane = tid & 63, wid = tid >> 6;
    for (int row = blockIdx.x * 8 + wid; row < NTOK; row += gridDim.x * 8) {
        float xn[16];
        ln_row(IN + (size_t)row * DM, g, bta, OUT + (size_t)row * DM, OUTB + (size_t)row * DM, lane, xn);
    }
}

__device__ __forceinline__ void phase_ln2_router(const Args& a, int l, float* lds) {
    const int tid = tid_fresh(), lane = tid & 63, wid = tid >> 6;
    const float* PRE = (const float*)(a.ws + WS_PRE2);
    float* X2 = (float*)(a.ws + WS_X2); bf16_t* X2B = (bf16_t*)(a.ws + WS_X2B);
    const float* g = a.in[28] + (size_t)(l * 3 + 1) * DM; const float* bta = a.in[29] + (size_t)(l * 3 + 1) * DM;
    const float* WR = a.in[23]; const float* BR = a.in[24];
    unsigned* cnt = (unsigned*)(a.ws + WS_CTL) + CW_CNT + l * 32;
    int2* list = (int2*)(a.ws + WS_LIST);
    int2* tokpos = (int2*)(a.ws + WS_TOKPOS);
    __syncthreads();
    for (int idx = tid; idx < DM * NEXP; idx += NTHREADS) { const int k = idx >> 5, e = idx & 31; lds[e * DM + k] = WR[idx]; }
    __syncthreads();
    for (int row = blockIdx.x * 8 + wid; row < NTOK; row += gridDim.x * 8) {
        float xn[16];
        ln_row(PRE + (size_t)row * DM, g, bta, X2 + (size_t)row * DM, X2B + (size_t)row * DM, lane, xn);
        float mylogit = 0.f;
#pragma unroll 4
        for (int e = 0; e < NEXP; ++e) {
            float p = 0.f;
#pragma unroll
            for (int m = 0; m < 4; ++m) { const float4 wv = *(const float4*)&lds[e * DM + m * 256 + lane * 4];
                p = fmaf(xn[m * 4], wv.x, p); p = fmaf(xn[m * 4 + 1], wv.y, p); p = fmaf(xn[m * 4 + 2], wv.z, p); p = fmaf(xn[m * 4 + 3], wv.w, p); }
            p = wsum(p);
            if (lane == e) mylogit = p;
        }
        const float s = sigmoidf_(mylogit);
        const float sel = (lane < 32) ? s + BR[lane & 31] : NEG_INF;
        const int gb = lane & ~3;
        const float v0 = __shfl(sel, gb), v1 = __shfl(sel, gb + 1), v2 = __shfl(sel, gb + 2), v3 = __shfl(sel, gb + 3);
        const float m1 = fmaxf(fmaxf(v0, v1), fmaxf(v2, v3));
        float m2;
        { const float lo01 = fminf(v0, v1), hi01 = fmaxf(v0, v1), lo23 = fminf(v2, v3), hi23 = fmaxf(v2, v3);
          m2 = fmaxf(fminf(hi01, hi23), fmaxf(lo01, lo23)); }
        float gs = (lane < 32) ? (m1 + m2) : NEG_INF;
        int gi = lane >> 2;
#pragma unroll
        for (int o = 32; o > 0; o >>= 1) { const float ov = __shfl_xor(gs, o); const int oi = __shfl_xor(gi, o); if (ov > gs || (ov == gs && oi < gi)) { gs = ov; gi = oi; } }
        const int gbest = gi;
        const float c0 = __shfl(sel, gbest * 4), c1 = __shfl(sel, gbest * 4 + 1), c2 = __shfl(sel, gbest * 4 + 2), c3 = __shfl(sel, gbest * 4 + 3);
        int j0 = 0; float b0 = c0;
        if (c1 > b0) { b0 = c1; j0 = 1; } if (c2 > b0) { b0 = c2; j0 = 2; } if (c3 > b0) { b0 = c3; j0 = 3; }
        int j1 = -1; float b1 = -3e38f;
        if (j0 != 0 && c0 > b1) { b1 = c0; j1 = 0; } if (j0 != 1 && c1 > b1) { b1 = c1; j1 = 1; } if (j0 != 2 && c2 > b1) { b1 = c2; j1 = 2; } if (j0 != 3 && c3 > b1) { b1 = c3; j1 = 3; }
        const int e0 = gbest * 4 + j0, e1 = gbest * 4 + j1;
        const float s0 = __shfl(s, e0), s1 = __shfl(s, e1);
        const float inv = 1.0f / (s0 + s1);
        if (lane == 0) {
            const unsigned r0 = atomicAdd(&cnt[e0], 1u), r1 = atomicAdd(&cnt[e1], 1u);
            list[(size_t)e0 * LCAP + r0] = make_int2(row, __float_as_int(s0 * inv));
            list[(size_t)e1 * LCAP + r1] = make_int2(row, __float_as_int(s1 * inv));
            tokpos[row * 2] = make_int2(e0, (int)r0); tokpos[row * 2 + 1] = make_int2(e1, (int)r1);
            ((float2*)(a.ws + WS_TOKGATE))[row] = make_float2(s0 * inv, s1 * inv);
        }
    }
}

constexpr int ZERO_ROW = 32768 / 2048;
struct I2 { int x, y; };
struct MoeSched {
    int G, c, T, npn; PG8_LAS I2* tab;
    const char* A; const char* B; size_t b_e, b_pn, a_tile; int colw;
    const int2* list; int gat_row0;
    __device__ void init(PG8_LAS unsigned char* lds, const unsigned* cnt, int npn_, const void* A_, size_t a_tile_, const void* B_, size_t b_e_, size_t b_pn_, int colw_, const int2* list_, int gat_row0_) {
        const int lane = tid_fresh() & 63, x = lane & 31;
        G = gridDim.x; c = blockIdx.x; npn = npn_; A = (const char*)A_; a_tile = a_tile_; B = (const char*)B_; b_e = b_e_; b_pn = b_pn_; colw = colw_; list = list_; gat_row0 = gat_row0_;
        const unsigned cnt_l = __hip_atomic_load(cnt + x, __ATOMIC_RELAXED, __HIP_MEMORY_SCOPE_AGENT);
        const int tiles = (int)((cnt_l + 255u) >> 8);
        int inc = tiles;
#pragma unroll
        for (int o = 1; o < 32; o <<= 1) { const int t = __shfl_up(inc, o, 32); if (x >= o) inc += t; }
        tab = (PG8_LAS I2*)(lds + pg8::STAGE_BYTES + 8192);
        tab[x].x = (int)cnt_l; tab[x].y = inc - tiles;
        T = __builtin_amdgcn_readfirstlane(__shfl(inc, 31));
        __syncthreads();
    }
    __device__ __forceinline__ bool next(int i, pg8::Unit& u) const {
        const long L = (long)i * G + c; if (L >= (long)T * npn) return false;
        const int ti = (int)(L / npn), pn = (int)(L % npn);
        const int my_excl = tab[__builtin_amdgcn_mbcnt_lo(~0u, 0u) & 31].y;
        const unsigned long long m = __ballot(my_excl <= ti) & 0xffffffffull;
        const int e = __popcll(m) - 1;
        const int rt = ti - tab[e].y;
        const unsigned ce = (unsigned)tab[e].x;
        u.aux = __builtin_amdgcn_readfirstlane(e | (rt << 8)); u.aux2 = __builtin_amdgcn_readfirstlane((int)ce);
        u.row0 = ti * 256; u.col0 = pn * colw;
        u.A = A + (size_t)ti * a_tile; u.B = B + (size_t)e * b_e + (size_t)pn * b_pn;
        return true;
    }
    __device__ __forceinline__ int arow(const pg8::Unit& u, int r) const {
        const int e = u.aux & 255, rank = (u.aux >> 8) * 256 + r;
        return rank < u.aux2 ? gat_row0 + list[(size_t)e * LCAP + rank].x : ZERO_ROW;
    }
};
struct EpiSwiGLU {
    static constexpr bool PERM = true;
    bf16_t* H;
    __device__ __forceinline__ void operator()(const pg8::f32x4 (&acc)[2][2][4][2], const pg8::Unit& u, int wr, int wc, int fr, int fq) const {
        const int col = u.col0 + wc * 32 + 8 * fq;
#pragma unroll
        for (int ai = 0; ai < 2; ++ai)
#pragma unroll
            for (int m = 0; m < 4; ++m) {
                const int r = wr * 64 + fr + ai * 128 + m * 16;
                float hv[8];
#pragma unroll
                for (int n = 0; n < 2; ++n)
#pragma unroll
                    for (int j = 0; j < 4; ++j) { const float g = acc[ai][0][m][n][j], up = acc[ai][1][m][n][j]; hv[n * 4 + j] = g * up * __builtin_amdgcn_rcpf(1.0f + __expf(-g)); }
                pg8::u32x4 w; w.x = pk2(hv[0], hv[1]); w.y = pk2(hv[2], hv[3]); w.z = pk2(hv[4], hv[5]); w.w = pk2(hv[6], hv[7]);
                *(pg8::u32x4*)(H + (size_t)(u.row0 + r) * DEXP + col) = w;
            }
    }
};
__device__ __forceinline__ void phase_f3(const Args& a, int l, PG8_LAS unsigned char* lds) {
    const unsigned* cnt = (const unsigned*)(a.ws + WS_CTL) + CW_CNT + l * 32;
    const int2* list = (const int2*)(a.ws + WS_LIST);
    MoeSched S; S.init(lds, cnt, 4, a.ws, 0, a.ws + WS_WEXP, (size_t)1024 * 1024 * 2, (size_t)256 * 1024 * 2, 128, list, (int)(WS_X2B / 2048));
    EpiSwiGLU E{(bf16_t*)(a.ws + WS_H)};
    pg8::gemm_phase<EpiSwiGLU, MoeSched, true>(lds, pg8::Dims{DM, DM, DM}, S, E);
}
__device__ __forceinline__ void phase_f4(const Args& a, int l, PG8_LAS unsigned char* lds) {
    const unsigned* cnt = (const unsigned*)(a.ws + WS_CTL) + CW_CNT + l * 32;
    MoeSched S; S.init(lds, cnt, 4, a.ws + WS_H, (size_t)256 * DEXP * 2, a.ws + WS_WEXP + (size_t)NEXP * 1024 * 1024 * 2, (size_t)1024 * 512 * 2, (size_t)256 * 512 * 2, 256, nullptr, 0);
    pg8::EpiBf16 E{(bf16_t*)(a.ws + WS_Y), DM};
    pg8::gemm_phase<pg8::EpiBf16, MoeSched, false>(lds, pg8::Dims{DEXP, DEXP, DEXP}, S, E);
}
__device__ __forceinline__ void phase_ln3(const Args& a, int l, float* OUT, bf16_t* OUTB) {
    const int tid = tid_fresh(), lane = tid & 63, wid = tid >> 6;
    const unsigned* cnt = (const unsigned*)(a.ws + WS_CTL) + CW_CNT + l * 32;
    const int2* tokpos = (const int2*)(a.ws + WS_TOKPOS);
    const float* X2 = (const float*)(a.ws + WS_X2); const bf16_t* Y = (const bf16_t*)(a.ws + WS_Y);
    const float* g = a.in[28] + (size_t)(l * 3 + 2) * DM; const float* bta = a.in[29] + (size_t)(l * 3 + 2) * DM;
    int mybase = 0;
    { int acc = 0; for (int x = 0; x < NEXP; ++x) { if (x == lane) mybase = acc; acc += (int)((cnt[x] + 255u) >> 8); } }
    for (int row = blockIdx.x * 8 + wid; row < NTOK; row += gridDim.x * 8) {
        const int2 p0 = tokpos[row * 2], p1 = tokpos[row * 2 + 1]; const float2 tg = ((const float2*)(a.ws + WS_TOKGATE))[row];
        const size_t h0 = (size_t)__shfl(mybase, p0.x) * 256 + p0.y, h1 = (size_t)__shfl(mybase, p1.x) * 256 + p1.y;
        const float* xr = X2 + (size_t)row * DM; const bf16_t* y0 = Y + h0 * DM; const bf16_t* y1 = Y + h1 * DM;
        float x[16];
#pragma unroll
        for (int m = 0; m < 4; ++m) { const int o = m * 256 + lane * 4; const float4 xv = *(const float4*)(xr + o); const uint2 a0 = *(const uint2*)(y0 + o), a1 = *(const uint2*)(y1 + o);
            x[m * 4] = fmaf(ALPHA, xv.x, fmaf(tg.x, bflo(a0.x), tg.y * bflo(a1.x))); x[m * 4 + 1] = fmaf(ALPHA, xv.y, fmaf(tg.x, bfhi(a0.x), tg.y * bfhi(a1.x)));
            x[m * 4 + 2] = fmaf(ALPHA, xv.z, fmaf(tg.x, bflo(a0.y), tg.y * bflo(a1.y))); x[m * 4 + 3] = fmaf(ALPHA, xv.w, fmaf(tg.x, bfhi(a0.y), tg.y * bfhi(a1.y))); }
        float s = 0.f;
#pragma unroll
        for (int k = 0; k < 16; ++k) s += x[k];
        const float mean = wsum(s) * (1.0f / 1024.0f);
        float q = 0.f;
#pragma unroll
        for (int k = 0; k < 16; ++k) { const float d = x[k] - mean; q = fmaf(d, d, q); }
        const float rstd = rsqrtf(wsum(q) * (1.0f / 1024.0f) + 1e-5f);
#pragma unroll
        for (int m = 0; m < 4; ++m) { const int o = m * 256 + lane * 4; const float4 gv = *(const float4*)(g + o), bv = *(const float4*)(bta + o); float4 r;
            r.x = (x[m * 4] - mean) * rstd * gv.x + bv.x; r.y = (x[m * 4 + 1] - mean) * rstd * gv.y + bv.y; r.z = (x[m * 4 + 2] - mean) * rstd * gv.z + bv.z; r.w = (x[m * 4 + 3] - mean) * rstd * gv.w + bv.w;
            *(float4*)(OUT + (size_t)row * DM + o) = r;
            if (OUTB) { uint2 ob; ob.x = pk2(r.x, r.y); ob.y = pk2(r.z, r.w); *(uint2*)(OUTB + (size_t)row * DM + o) = ob; } }
    }
}

constexpr int PH_PER_LAYER = 14, N_PHASES = 1 + 2 * PH_PER_LAYER;

__global__ void __launch_bounds__(NTHREADS, 2) mk_fwd(Args a) {
    extern __shared__ __attribute__((aligned(16))) unsigned char smem[];
    float* lds = (float*)smem;
    PG8_LAS unsigned char* lds3 = (PG8_LAS unsigned char*)smem;
    volatile LAS unsigned* xbw = (volatile LAS unsigned*)(smem + LDS_BYTES - 16);
    const int lo = a.ph_lo, hi = a.ph_hi;
    unsigned* ctl = (unsigned*)(a.ws + WS_CTL);
    XcdBarrier bar; bar.bar = ctl + CW_BAR; bar.x = 0; bar.st = xbw;
    if (hi - lo > 1) {
        if (threadIdx.x == 0) { xbw[0] = 0u; xbw[1] = 0u; }
        __syncthreads();
        bar = xcd_barrier_post(ctl + CW_BAR, xbw);
    }
#define IN(k) (lo <= (k) && (k) < hi)
#define SEAM(k) do { if (IN(k) && IN((k) + 1)) xcd_barrier(bar); } while (0)
    if (IN(0)) phase_prologue(a, lds);
    SEAM(0);
#define LAYER_BODY(l) do { \
        const int p0 = 1 + l * PH_PER_LAYER; \
        const float* xin = (l == 0) ? a.in[0] : (const float*)(a.ws + WS_XL1); \
        float* xout = (l == 0) ? (float*)(a.ws + WS_XL1) : a.out; \
        if (IN(p0 + 0)) phase_g1(a, l, lds3); \
        SEAM(p0 + 0); \
        if (IN(p0 + 1)) phase_prep(a, l, lds); \
        SEAM(p0 + 1); \
        if (IN(p0 + 2)) phase_scan(a, l, lds3); \
        SEAM(p0 + 2); \
        if (IN(p0 + 3)) { phase_post(a, l); phase_att(a, l, lds3); } \
        SEAM(p0 + 3); \
        if (IN(p0 + 4)) phase_dense_res(a.ws + WS_MIX, a.ws + WS_WOUT + (size_t)l * 2 * MiB, xin, (float*)(a.ws + WS_PRE), lds3); \
        SEAM(p0 + 4); \
        if (IN(p0 + 5)) phase_ln((const float*)(a.ws + WS_PRE), a.in[28] + (size_t)(l * 3) * DM, a.in[29] + (size_t)(l * 3) * DM, (float*)(a.ws + WS_X1), (bf16_t*)(a.ws + WS_X1B)); \
        SEAM(p0 + 5); \
        if (IN(p0 + 6)) phase_dense_bf16(a.ws + WS_X1B, NTOK, a.ws + WS_WQ + (size_t)l * 2 * MiB, DM, (bf16_t*)(a.ws + WS_Q), lds3); \
        SEAM(p0 + 6); \
        if (IN(p0 + 7)) phase_matt_s(a, lds3); \
        SEAM(p0 + 7); \
        if (IN(p0 + 8)) phase_matt_pv(a, lds3); \
        SEAM(p0 + 8); \
        if (IN(p0 + 9)) phase_dense_res(a.ws + WS_O, a.ws + WS_WO + (size_t)l * 2 * MiB, (const float*)(a.ws + WS_X1), (float*)(a.ws + WS_PRE2), lds3); \
        SEAM(p0 + 9); \
        if (IN(p0 + 10)) phase_ln2_router(a, l, lds); \
        SEAM(p0 + 10); \
        if (IN(p0 + 11)) phase_f3(a, l, lds3); \
        SEAM(p0 + 11); \
        if (IN(p0 + 12)) phase_f4(a, l, lds3); \
        SEAM(p0 + 12); \
        if (IN(p0 + 13)) { phase_ln3(a, l, xout, (l == 0) ? (bf16_t*)(a.ws + WS_XB) : (bf16_t*)nullptr); if (l == 0) convert_experts(a, 1, lds); } \
        SEAM(p0 + 13); \
    } while (0)
    LAYER_BODY(0);
    LAYER_BODY(1);
}
}

extern "C" void kernel_launch(void* const* d_in, const int* in_sizes, int n_in, void* d_out, int out_size, void* d_ws, size_t ws_size, hipStream_t stream) {
    static int grid = 0;
    if (!grid) {
        int dev = 0, cus = 0, per_cu = 0;
        (void)hipGetDevice(&dev);
        (void)hipDeviceGetAttribute(&cus, hipDeviceAttributeMultiprocessorCount, dev);
        (void)hipFuncSetAttribute((const void*)mk_fwd, hipFuncAttributeMaxDynamicSharedMemorySize, LDS_BYTES);
        (void)hipOccupancyMaxActiveBlocksPerMultiprocessor(&per_cu, mk_fwd, NTHREADS, LDS_BYTES);
        (void)hipGetLastError();
        grid = cus * 1;
        if (grid < 65) grid = 256;
    }
    if (ws_size < WS_END) return;
    (void)hipMemsetAsync(d_ws, 0, CTL_ZERO_BYTES, stream);
    Args a;
    memset(&a, 0, sizeof(a));
    for (int i = 0; i < 30; ++i) a.in[i] = (const float*)d_in[i];
    a.out = (float*)d_out; a.ws = (unsigned char*)d_ws;
#if MK_ONE_LAUNCH
    a.ph_lo = 0; a.ph_hi = N_PHASES;
    hipLaunchKernelGGL(mk_fwd, dim3(grid), dim3(NTHREADS), LDS_BYTES, stream, a);
#else
    for (int p = 0; p < N_PHASES; ++p) {
        a.ph_lo = p; a.ph_hi = p + 1;
        hipLaunchKernelGGL(mk_fwd, dim3(grid), dim3(NTHREADS), LDS_BYTES, stream, a);
    }
#endif
}
```

```cpp
#include <hip/hip_runtime.h>
#include <stdint.h>
#include <cstring>

#ifndef PROBE_REP
#define PROBE_REP -1
#endif
#ifndef MK_ONE_LAUNCH
#define MK_ONE_LAUNCH 1
#endif

namespace {
constexpr int NTHREADS = 512;
constexpr int NTOK = 16384, SEQ = 2048, NBATCH = 8, DM = 1024;
constexpr int MEMLEN = 256;
constexpr int NH = 8, HD = 64;
constexpr int IN_COLS = 3328, ZLD = 3584;
constexpr int C_Q = 0, C_K = 512, C_V = 1024, C_R = 1536, C_KR = 2048, C_VR = 2560, C_ZW = 3072, C_ZA = 3136, C_ZG = 3200, C_ZV = 3328;
constexpr int NEXP = 32, DEXP = 512;
constexpr int LCAP = 16384;
constexpr float ALPHA = 1.4142135623730951f;
constexpr float NEG_INF = -1e30f;
constexpr int LDS_BYTES = 147456;

typedef unsigned short bf16_t;
typedef float f32x2_t __attribute__((ext_vector_type(2)));
typedef __bf16 bf16x2_t __attribute__((ext_vector_type(2)));
__device__ __forceinline__ unsigned pk2(float lo, float hi) { f32x2_t v = {lo, hi}; bf16x2_t b = __builtin_convertvector(v, bf16x2_t); return __builtin_bit_cast(unsigned, b); }
__device__ __forceinline__ bf16_t f2bf(float f) { return (bf16_t)(pk2(f, 0.f) & 0xffffu); }
__device__ __forceinline__ float bf2f(bf16_t h) { return __uint_as_float((unsigned)h << 16); }
__device__ __forceinline__ float bflo(unsigned u) { return __uint_as_float(u << 16); }
__device__ __forceinline__ float bfhi(unsigned u) { return __uint_as_float(u & 0xffff0000u); }

constexpr size_t MiB = 1u << 20;
constexpr size_t WS_CTL = 0, CTL_ZERO_BYTES = 64 * 1024;
constexpr size_t WS_LIST = 2 * MiB;
constexpr size_t WS_KB = 6 * MiB;
constexpr size_t WS_TOKPOS = 10 * MiB;
constexpr size_t WS_TOKGATE = 10 * MiB + 512 * 1024;
constexpr size_t WS_KMEAN = 11 * MiB;
constexpr size_t WS_MEMB = 12 * MiB;
constexpr size_t WS_VT = 16 * MiB;
constexpr size_t WS_WIN0 = 24 * MiB, WS_WIN1 = 31 * MiB;
constexpr size_t WS_WOUT = 38 * MiB, WS_WQ = 42 * MiB, WS_WKV = 46 * MiB, WS_WO = 54 * MiB;
constexpr size_t WS_WEXP = 58 * MiB;
constexpr size_t WS_XL1 = 154 * MiB, WS_XB = 218 * MiB, WS_VFIRST = 250 * MiB;
constexpr size_t WS_Z = 266 * MiB, WS_MIX = 378 * MiB, WS_R3 = 410 * MiB, WS_END = 506 * MiB;
constexpr size_t WS_REC = 410 * MiB;
constexpr size_t WS_YRAW = 490 * MiB;
constexpr size_t WS_RVT = 218 * MiB, WS_RG = 234 * MiB;
constexpr size_t WS_BON = 20 * MiB;
constexpr size_t WS_LORA = 22 * MiB;
constexpr size_t LORA_L = 512 * 288 * 2, LORA_I = 512 * 64 * 2, LORA_G = 2 * 512 * 64 * 2, LORA_V = LORA_G + 512 * 128 * 2;
constexpr size_t WS_LSUM = 21 * MiB;
constexpr size_t WS_P = 298 * MiB;
constexpr size_t WS_PRE = 266 * MiB, WS_X1 = 410 * MiB, WS_X1B = 474 * MiB;
constexpr size_t WS_Q = 330 * MiB, WS_KV = 362 * MiB, WS_O = 266 * MiB, WS_PRE2 = 330 * MiB;
constexpr size_t WS_X2 = 410 * MiB, WS_X2B = 474 * MiB;
constexpr size_t WS_H = 266 * MiB, WS_Y = 306 * MiB;

constexpr int CW_CNT = 0;
constexpr int CW_BAR = 1024;

#define XB_TMO      128
#define XB_XCNT(j)  (256  + 64 * (j))
#define XB_XSUB(j)  (1280 + 64 * (j))
#define XB_XGEN(j)  (2304 + 64 * (j))
#define XB_TOP      3328
#define XB_TOPGEN   3392
#define XCD_BAR_WORDS 3456
#define XB_SPIN_CAP (1u << 18)
#define LAS __attribute__((address_space(3)))
__device__ __forceinline__ unsigned xb_ld(unsigned* p)              { return __hip_atomic_load(p, __ATOMIC_RELAXED, __HIP_MEMORY_SCOPE_AGENT); }
__device__ __forceinline__ unsigned xb_add(unsigned* p, unsigned v) { return __hip_atomic_fetch_add(p, v, __ATOMIC_RELAXED, __HIP_MEMORY_SCOPE_AGENT); }
__device__ __forceinline__ unsigned xb_xcc_id() { return (unsigned)__builtin_amdgcn_s_getreg((3 << 11) | 20) & 0xFu; }
#define XB_SPIN(cond, bar) do { unsigned _sp = 0; while (cond) { __builtin_amdgcn_s_sleep(1); \
    if ((++_sp & 255u) == 0u) { if (xb_ld(&(bar)[XB_TMO])) break; if (_sp > XB_SPIN_CAP) { atomicAdd(&(bar)[XB_TMO], 1u); break; } } } } while (0)
struct XcdBarrier { unsigned* bar; unsigned x; volatile LAS unsigned* st; };
__device__ __forceinline__ XcdBarrier xcd_barrier_post(unsigned* bar, volatile LAS unsigned* st) {
    XcdBarrier b; b.bar = bar; b.x = xb_xcc_id(); b.st = st;
    if (threadIdx.x == 0) (void)xb_add(&bar[XB_XCNT(b.x)], 1u);
    return b;
}
__device__ __forceinline__ void xcd_barrier_complete(unsigned* bar, unsigned x, unsigned& nloc, unsigned& nx) {
    const unsigned G = gridDim.x * gridDim.y * gridDim.z;
    unsigned sum, cnt, mine, sp = 0u;
    for (;;) {
        sum = 0u; cnt = 0u; mine = 0u;
#pragma unroll
        for (unsigned j = 0; j < 16; ++j) { const unsigned c = xb_ld(&bar[XB_XCNT(j)]); sum += c; cnt += (c > 0u) ? 1u : 0u; mine = (j == x) ? c : mine; }
        if (sum == G) break;
        __builtin_amdgcn_s_sleep(1);
        if ((++sp & 255u) == 0u) { if (xb_ld(&bar[XB_TMO])) break; if (sp > XB_SPIN_CAP) { atomicAdd(&bar[XB_TMO], 1u); break; } }
    }
    nloc = mine > 0u ? mine : 1u; nx = cnt > 0u ? cnt : 1u;
}
__device__ __forceinline__ void xcd_barrier(const XcdBarrier& b) {
    asm volatile("s_waitcnt vmcnt(0)" ::: "memory");
    __syncthreads();
    if (threadIdx.x == 0) {
        unsigned* bar = b.bar;
        __builtin_amdgcn_s_waitcnt(0);
        unsigned nloc = b.st[0], nx = b.st[1];
        if (nloc == 0u) { xcd_barrier_complete(bar, b.x, nloc, nx); b.st[0] = nloc; b.st[1] = nx; }
        const unsigned old = xb_add(&bar[XB_XSUB(b.x)], 1u);
        const unsigned gen = old / nloc;
        if (old + 1u == (gen + 1u) * nloc) {
            __builtin_amdgcn_fence(__ATOMIC_RELEASE, "agent");
            asm volatile("s_waitcnt vmcnt(0)" ::: "memory");
            const unsigned og = xb_add(&bar[XB_TOP], 1u);
            const unsigned tg = og / nx;
            if (og + 1u == (tg + 1u) * nx) xb_add(&bar[XB_TOPGEN], 1u);
            else XB_SPIN(xb_ld(&bar[XB_TOPGEN]) == tg, bar);
            __builtin_amdgcn_fence(__ATOMIC_ACQUIRE, "agent");
            xb_add(&bar[XB_XGEN(b.x)], 1u);
            asm volatile("s_waitcnt vmcnt(0)" ::: "memory");
        } else {
            XB_SPIN(xb_ld(&bar[XB_XGEN(b.x)]) == gen, bar);
            __builtin_amdgcn_fence(__ATOMIC_ACQUIRE, "agent");
            asm volatile("s_waitcnt vmcnt(0)" ::: "memory");
        }
    }
    __syncthreads();
}

__device__ __forceinline__ int tid_fresh() { int t = threadIdx.x; asm volatile("" : "+v"(t)); return t; }
__device__ __forceinline__ float wsum(float v) {
#pragma unroll
    for (int o = 32; o > 0; o >>= 1) v += __shfl_xor(v, o);
    return v;
}
__device__ __forceinline__ float wmax(float v) {
#pragma unroll
    for (int o = 32; o > 0; o >>= 1) v = fmaxf(v, __shfl_xor(v, o));
    return v;
}
__device__ __forceinline__ float sigmoidf_(float x) { return 1.0f / (1.0f + __expf(-x)); }
__device__ __forceinline__ float softplusf_(float x) { return x > 20.f ? x : log1pf(__expf(x)); }

struct Args {
    const float* in[30];
    float* out;
    unsigned char* ws;
    int ph_lo, ph_hi;
};

namespace pg8 {
#define PG8_LAS __attribute__((address_space(3)))
typedef short bf16x8 __attribute__((ext_vector_type(8)));
typedef float f32x4 __attribute__((ext_vector_type(4)));
typedef unsigned u32x4 __attribute__((ext_vector_type(4)));
constexpr int BM = 256, BK = 64, HALF = 128, HTB = HALF * BK * 2, STAGE_BYTES = 8 * HTB, NXCD = 8, WGM = 8;

__host__ __device__ __forceinline__ int lds_byte(int r, int c) { const int st = (r >> 4) * 2 + (c >> 5), rr = r & 15, cc = c & 31, ob = rr * 64 + cc * 2; return st * 1024 + (ob ^ (((ob >> 9) & 1) << 5)); }
__host__ __device__ __forceinline__ void stage_rc(int b, int& R, int& C) { const int st = b / 1024, sb = b % 1024, swz = sb ^ (((sb >> 9) & 1) << 5); R = (st >> 1) * 16 + swz / 64; C = (st & 1) * 32 + (swz % 64) / 2; }
__host__ __device__ __forceinline__ int perm32(int rho) { const int n = rho >> 4, i = rho & 15; return 8 * (i >> 2) + 4 * n + (i & 3); }

struct Unit { const char* A; const char* B; int row0, col0, aux, aux2; };
struct Dims { int lda, ldb, K; };

struct TileOrder {
    int nM, nN, nwg, G, c;
    __device__ void init(int nM_, int nN_, int G_, int c_) { nM = nM_; nN = nN_; nwg = nM * nN; G = G_; c = c_; }
    __device__ bool tile(int i, int& pm, int& pn) const {
        const long L = (long)i * G + c; if (L >= nwg) return false;
        int wgid = (int)L; { const int q = nwg / NXCD, r = nwg % NXCD, xcd = wgid % NXCD, off = wgid / NXCD; wgid = (xcd < r ? xcd * (q + 1) : r * (q + 1) + (xcd - r) * q) + off; }
        const int nig = WGM * nN, gid = wgid / nig, fm = gid * WGM, gsz = (nM - fm) < WGM ? (nM - fm) : WGM;
        pm = fm + ((wgid % nig) % gsz); pn = (wgid % nig) / gsz; return true;
    }
};
struct DenseSched {
    TileOrder o; const char* A; const char* B; int lda, ldb;
    __device__ void init(const void* A_, int lda_, int M, const void* B_, int ldb_, int N) { A = (const char*)A_; B = (const char*)B_; lda = lda_; ldb = ldb_; o.init(M / BM, N / BM, gridDim.x, blockIdx.x); }
    __device__ __forceinline__ bool next(int i, Unit& u) const { int pm, pn; if (!o.tile(i, pm, pn)) return false;
        u.A = A + (size_t)pm * BM * lda * 2; u.B = B + (size_t)pn * BM * ldb * 2; u.row0 = pm * BM; u.col0 = pn * BM; u.aux = 0; u.aux2 = 0; return true; }
    __device__ __forceinline__ int arow(const Unit&, int r) const { return r; }
};

__device__ __forceinline__ unsigned cvt_pk_bf16(float lo, float hi) { unsigned r; asm volatile("v_cvt_pk_bf16_f32 %0, %1, %2" : "=v"(r) : "v"(lo), "v"(hi)); return r; }

struct EpiBf16 {
    static constexpr bool PERM = true;
    bf16_t* O; int ldc;
    __device__ __forceinline__ void operator()(const f32x4 (&acc)[2][2][4][2], const Unit& u, int wr, int wc, int fr, int fq) const {
        const int row0 = u.row0 + wr * 64 + fr, col0 = u.col0 + wc * 32 + 8 * fq;
#pragma unroll
        for (int ai = 0; ai < 2; ++ai)
#pragma unroll
            for (int m = 0; m < 4; ++m) { bf16_t* rowp = O + (size_t)(row0 + ai * HALF + m * 16) * ldc + col0;
#pragma unroll
                for (int bj = 0; bj < 2; ++bj) { const f32x4 v0 = acc[ai][bj][m][0], v1 = acc[ai][bj][m][1];
                    u32x4 w; w.x = cvt_pk_bf16(v0[0], v0[1]); w.y = cvt_pk_bf16(v0[2], v0[3]); w.z = cvt_pk_bf16(v1[0], v1[1]); w.w = cvt_pk_bf16(v1[2], v1[3]);
                    *(u32x4*)(rowp + bj * HALF) = w; } }
    }
};
struct EpiF32Res {
    static constexpr bool PERM = false;
    float* C; const float* RES; int ldc; float rs;
    __device__ __forceinline__ void operator()(const f32x4 (&acc)[2][2][4][2], const Unit& u, int wr, int wc, int fr, int fq) const {
        const int row0 = u.row0 + wr * 64 + fr, col0 = u.col0 + wc * 32 + 4 * fq;
#pragma unroll
        for (int ai = 0; ai < 2; ++ai)
#pragma unroll
            for (int m = 0; m < 4; ++m) { const size_t ro = (size_t)(row0 + ai * HALF + m * 16) * ldc + col0;
#pragma unroll
                for (int bj = 0; bj < 2; ++bj)
#pragma unroll
                    for (int n = 0; n < 2; ++n) { const f32x4 r = *(const f32x4*)(RES + ro + bj * HALF + n * 16); *(f32x4*)(C + ro + bj * HALF + n * 16) = acc[ai][bj][m][n] + r * rs; } }
    }
};

__device__ __forceinline__ void store_bf16_tile(const f32x4 (&acc)[2][2][4][2], bf16_t* O, int ldc, int row0, int col0) {
#pragma unroll
    for (int ai = 0; ai < 2; ++ai)
#pragma unroll
        for (int m = 0; m < 4; ++m) { bf16_t* rowp = O + (size_t)(row0 + ai * HALF + m * 16) * ldc + col0;
#pragma unroll
            for (int bj = 0; bj < 2; ++bj) { const f32x4 v0 = acc[ai][bj][m][0], v1 = acc[ai][bj][m][1];
                u32x4 w; w.x = cvt_pk_bf16(v0[0], v0[1]); w.y = cvt_pk_bf16(v0[2], v0[3]); w.z = cvt_pk_bf16(v1[0], v1[1]); w.w = cvt_pk_bf16(v1[2], v1[3]);
                *(u32x4*)(rowp + bj * HALF) = w; } }
}
struct EpiG1 {
    static constexpr bool PERM = true;
    bf16_t* Z; bf16_t* KB; bf16_t* VT;
    __device__ __forceinline__ void operator()(const f32x4 (&acc)[2][2][4][2], const Unit& u, int wr, int wc, int fr, int fq) const {
        bf16_t* O = Z; int ldc = ZLD;
        if (u.aux == 1) { O = KB; ldc = 1024; } else if (u.aux >= 2) { O = VT + (size_t)(u.aux - 2) * 1024 * 256; ldc = 256; }
        store_bf16_tile(acc, O, ldc, u.row0 + wr * 64 + fr, u.col0 + wc * 32 + 8 * fq);
    }
};
struct EpiSoftmax {
    static constexpr bool PERM = true;
    bf16_t* P; float* LSUM; PG8_LAS float* xmax;
    __device__ __forceinline__ void operator()(const f32x4 (&acc)[2][2][4][2], const Unit& u, int wr, int wc, int fr, int fq) const {
        const float c = 0.0625f * 1.4426950408889634f;
#pragma unroll
        for (int ai = 0; ai < 2; ++ai)
#pragma unroll
            for (int m = 0; m < 4; ++m) {
                float mx = acc[ai][0][m][0][0];
#pragma unroll
                for (int bj = 0; bj < 2; ++bj)
#pragma unroll
                    for (int n = 0; n < 2; ++n)
#pragma unroll
                        for (int j = 0; j < 4; ++j) mx = fmaxf(mx, acc[ai][bj][m][n][j]);
                mx = fmaxf(mx, __shfl_xor(mx, 16)); mx = fmaxf(mx, __shfl_xor(mx, 32));
                if (fq == 0) xmax[wc * 256 + wr * 64 + fr + ai * 128 + m * 16] = mx;
            }
        asm volatile("s_waitcnt lgkmcnt(0)" ::: "memory"); __builtin_amdgcn_s_barrier(); asm volatile("" ::: "memory");
        const int hm = u.col0 >> 8;
#pragma unroll
        for (int ai = 0; ai < 2; ++ai)
#pragma unroll
            for (int m = 0; m < 4; ++m) {
                int r = wr * 64 + fr + ai * 128 + m * 16; asm volatile("" : "+v"(r) :: "memory");
                const float M = fmaxf(fmaxf(xmax[r], xmax[256 + r]), fmaxf(xmax[512 + r], xmax[768 + r]));
                float sum = 0.f; bf16_t* rowp = P + (size_t)(u.row0 + r) * 1024 + u.col0 + wc * 32 + 8 * fq;
#pragma unroll
                for (int bj = 0; bj < 2; ++bj) {
                    float e[8];
#pragma unroll
                    for (int n = 0; n < 2; ++n)
#pragma unroll
                        for (int j = 0; j < 4; ++j) { e[n * 4 + j] = __builtin_amdgcn_exp2f((acc[ai][bj][m][n][j] - M) * c); sum += e[n * 4 + j]; }
                    u32x4 w; w.x = pk2(e[0], e[1]); w.y = pk2(e[2], e[3]); w.z = pk2(e[4], e[5]); w.w = pk2(e[6], e[7]);
                    *(u32x4*)(rowp + bj * HALF) = w;
                }
                sum += __shfl_xor(sum, 16); sum += __shfl_xor(sum, 32);
                if (fq == 0) LSUM[((size_t)(u.row0 + r) * 4 + hm) * 4 + wc] = sum;
            }
        asm volatile("s_waitcnt lgkmcnt(0)" ::: "memory"); __builtin_amdgcn_s_barrier(); asm volatile("" ::: "memory");
    }
};
struct EpiPV {
    static constexpr bool PERM = true;
    bf16_t* O; const float* LSUM;
    __device__ __forceinline__ void operator()(const f32x4 (&acc)[2][2][4][2], const Unit& u, int wr, int wc, int fr, int fq) const {
        const int hm = u.col0 >> 8;
#pragma unroll
        for (int ai = 0; ai < 2; ++ai)
#pragma unroll
            for (int m = 0; m < 4; ++m) {
                int row = u.row0 + wr * 64 + fr + ai * 128 + m * 16; asm volatile("" : "+v"(row) :: "memory");
                const f32x4 ls = *(const f32x4*)(LSUM + ((size_t)row * 4 + hm) * 4);
                const float inv = 1.0f / ((ls[0] + ls[1]) + (ls[2] + ls[3]));
                bf16_t* rowp = O + (size_t)row * 1024 + u.col0 + wc * 32 + 8 * fq;
#pragma unroll
                for (int bj = 0; bj < 2; ++bj) { const f32x4 v0 = acc[ai][bj][m][0] * inv, v1 = acc[ai][bj][m][1] * inv;
                    u32x4 w; w.x = cvt_pk_bf16(v0[0], v0[1]); w.y = cvt_pk_bf16(v0[2], v0[3]); w.z = cvt_pk_bf16(v1[0], v1[1]); w.w = cvt_pk_bf16(v1[2], v1[3]);
                    *(u32x4*)(rowp + bj * HALF) = w; }
            }
    }
};
struct G1Sched {
    TileOrder o; const char *XB, *WIN, *MEMB, *WKV;
    __device__ void init(const void* XB_, const void* WIN_, int nN, const void* MEMB_, const void* WKV_) { XB = (const char*)XB_; WIN = (const char*)WIN_; MEMB = (const char*)MEMB_; WKV = (const char*)WKV_; o.init(64, nN, gridDim.x, blockIdx.x); }
    __device__ __forceinline__ bool next(int i, Unit& u) const {
        int pm, pn; u.aux2 = 0;
        if (o.tile(i, pm, pn)) { u.A = XB + (size_t)pm * BM * 2048; u.B = WIN + (size_t)pn * BM * 2048; u.row0 = pm * BM; u.col0 = pn * BM; u.aux = 0; return true; }
        const long L = (long)i * o.G + o.c - o.nwg;
        if (L >= 64) return false;
        if (L < 32) { pm = (int)L >> 2; pn = (int)L & 3; u.A = MEMB + (size_t)pm * BM * 2048; u.B = WKV + (size_t)pn * BM * 2048; u.row0 = pm * BM; u.col0 = pn * BM; u.aux = 1; return true; }
        const int b = ((int)L - 32) >> 2; pm = ((int)L - 32) & 3;
        u.A = WKV + (size_t)(1024 + pm * BM) * 2048; u.B = MEMB + (size_t)b * BM * 2048; u.row0 = pm * BM; u.col0 = 0; u.aux = 2 + b; return true;
    }
    __device__ __forceinline__ int arow(const Unit&, int r) const { return r; }
};
struct MattSched {
    int G, c; const char* A; const char* B; size_t b_batch; int b_head;
    __device__ void init(const void* A_, const void* B_, size_t b_batch_, int b_head_) { G = gridDim.x; c = blockIdx.x; A = (const char*)A_; B = (const char*)B_; b_batch = b_batch_; b_head = b_head_; }
    __device__ __forceinline__ bool next(int i, Unit& u) const {
        const long L = (long)i * G + c; if (L >= 256) return false;
        const int pm = (int)L >> 2, hm = (int)L & 3;
        u.A = A + ((size_t)pm * BM * 1024 + hm * 256) * 2; u.B = B + (size_t)(pm >> 3) * b_batch + (size_t)hm * b_head;
        u.row0 = pm * BM; u.col0 = hm * 256; u.aux = 0; u.aux2 = 0; return true;
    }
    __device__ __forceinline__ int arow(const Unit&, int r) const { return r; }
};

template <class Epi, class Sched, bool GATHER>
__device__ __forceinline__ void gemm_phase(PG8_LAS unsigned char* lds, const Dims g, const Sched& S, const Epi& E) {
    const int tid = tid_fresh(), wid = __builtin_amdgcn_readfirstlane(tid >> 6), wr = wid >> 2, wc = wid & 3;
    const int K = g.K, nt = K / BK;
    unsigned voffB[2];
#pragma unroll
    for (int i = 0; i < 2; ++i) { int R, C; stage_rc(tid * 16 + i * 8192, R, C); const int Rb = Epi::PERM ? ((R & ~31) + perm32(R & 31)) : R;
        voffB[i] = (unsigned)(Rb * g.ldb + C) * 2u; }
    const size_t kstep = (size_t)(BK * 2);
    const size_t hstepB = (size_t)HALF * g.ldb * 2;
    const unsigned ldsw = (unsigned)wid * 1024u;
    const int aoff = lds_byte(wr * 64 + (tid & 15), ((tid & 63) >> 4) * 8), boff = lds_byte(wc * 32 + (tid & 15), ((tid & 63) >> 4) * 8);
    const size_t hstepA = GATHER ? 0 : (size_t)HALF * g.lda * 2;
#define PG8_SA(b, h) (((b) * 2 + (h)) * HTB)
#define PG8_SB(b, h) ((4 + (b) * 2 + (h)) * HTB)
#define PG8_STAGE(bufoff, gbase, v0, v1) do { \
        __builtin_amdgcn_global_load_lds((const unsigned*)((const char*)(gbase) + (v0)), (PG8_LAS unsigned*)(lds + (bufoff) + ldsw), 16, 0, 0); \
        __builtin_amdgcn_global_load_lds((const unsigned*)((const char*)(gbase) + (v1)), (PG8_LAS unsigned*)(lds + (bufoff) + ldsw + 8192), 16, 0, 0); } while (0)
#define PG8_STAGEB(bufoff, gbase) PG8_STAGE(bufoff, gbase, voffB[0], voffB[1])
#define PG8_LDA(dst, b, h) do { _Pragma("unroll") for (int m = 0; m < 4; ++m) _Pragma("unroll") for (int k = 0; k < 2; ++k) dst[m][k] = *(const PG8_LAS bf16x8*)(lds + PG8_SA(b, h) + aoff + m * 2048 + k * 1024); } while (0)
#define PG8_LDB(dst, b, h) do { _Pragma("unroll") for (int n = 0; n < 2; ++n) _Pragma("unroll") for (int k = 0; k < 2; ++k) dst[n][k] = *(const PG8_LAS bf16x8*)(lds + PG8_SB(b, h) + boff + n * 2048 + k * 1024); } while (0)
#define PG8_MMA(ai, bj, At, Bt) do { __builtin_amdgcn_s_setprio(1); _Pragma("unroll") for (int m = 0; m < 4; ++m) _Pragma("unroll") for (int n = 0; n < 2; ++n) _Pragma("unroll") for (int k = 0; k < 2; ++k) \
        acc[ai][bj][m][n] = __builtin_amdgcn_mfma_f32_16x16x32_bf16(Bt[n][k], At[m][k], acc[ai][bj][m][n], 0, 0, 0); __builtin_amdgcn_s_setprio(0); } while (0)
#define PG8_WAIT_V(n) asm volatile("s_waitcnt vmcnt(" #n ")" ::: "memory")
#define PG8_WAIT_L(n) asm volatile("s_waitcnt lgkmcnt(" #n ")" ::: "memory")
#define PG8_BAR __builtin_amdgcn_s_barrier()
#define PG8_SCHED __builtin_amdgcn_sched_barrier(0)
#define PG8_VOFFA(dst, u) do { _Pragma("unroll") for (int i_ = 0; i_ < 2; ++i_) { int R_, C_; stage_rc(tid * 16 + i_ * 8192, R_, C_); _Pragma("unroll") for (int h_ = 0; h_ < 2; ++h_) { \
        const int rr_ = GATHER ? S.arow(u, R_ + h_ * HALF) : R_; dst[h_ * 2 + i_] = (unsigned)(rr_ * g.lda + C_) * 2u; } } } while (0)
    Unit cur, nxt; int ui = 0;
    if (!S.next(0, cur)) return;
    f32x4 acc[2][2][4][2];
#pragma unroll
    for (int a = 0; a < 2; ++a)
#pragma unroll
        for (int b = 0; b < 2; ++b)
#pragma unroll
            for (int m = 0; m < 4; ++m)
#pragma unroll
                for (int n = 0; n < 2; ++n) acc[a][b][m][n] = (f32x4){0.f, 0.f, 0.f, 0.f};
    bf16x8 At[4][2], B0[2][2], B1[2][2];
    unsigned vC[4];
    PG8_VOFFA(vC, cur);
    PG8_LAS u32x4* myN = (PG8_LAS u32x4*)(lds + STAGE_BYTES + tid * 16);
    const char* cA = cur.A; const char* cB = cur.B;
    PG8_STAGEB(PG8_SB(0, 0), cB); PG8_STAGEB(PG8_SB(0, 1), cB + hstepB); PG8_STAGE(PG8_SA(0, 0), cA, vC[0], vC[1]); PG8_STAGE(PG8_SA(0, 1), cA + hstepA, vC[2], vC[3]);
    if (wr == 1) PG8_BAR;
    PG8_WAIT_V(2); PG8_BAR;
    PG8_STAGEB(PG8_SB(1, 0), cB + kstep); PG8_STAGE(PG8_SA(1, 0), cA + kstep, vC[0], vC[1]); PG8_STAGEB(PG8_SB(1, 1), cB + hstepB + kstep);
    PG8_WAIT_V(6); PG8_BAR;
    for (;;) {
        const bool has_next = S.next(ui + 1, nxt);
        const char* nA = cA; const char* nB = cB;
        { unsigned vT[4];
#pragma unroll
          for (int q = 0; q < 4; ++q) vT[q] = vC[q];
          if (has_next) { nA = nxt.A; nB = nxt.B; PG8_VOFFA(vT, nxt); }
          *myN = (u32x4){vT[0], vT[1], vT[2], vT[3]}; }
#pragma unroll 1
        for (int t = 0; t < nt; t += 2) {
            const bool last = (t == nt - 2);
            const char* a1 = cA + (size_t)(t + 1) * kstep;
            const char* a2 = last ? nA : cA + (size_t)(t + 2) * kstep; const char* b2 = last ? nB : cB + (size_t)(t + 2) * kstep;
            const char* a3 = a2 + kstep; const char* b3 = b2 + kstep;
            PG8_LDB(B0, 0, 0); PG8_LDB(B1, 0, 1); PG8_SCHED; PG8_LDA(At, 0, 0); PG8_STAGE(PG8_SA(1, 1), a1 + hstepA, vC[2], vC[3]);
            if (last) { const u32x4 vn = *myN; vC[0] = vn.x; vC[1] = vn.y; vC[2] = vn.z; vC[3] = vn.w; }
            PG8_WAIT_V(8); PG8_WAIT_L(0); PG8_BAR; PG8_MMA(0, 0, At, B0); PG8_MMA(0, 1, At, B1); PG8_BAR; PG8_SCHED;
            PG8_LDA(At, 0, 1); PG8_STAGEB(PG8_SB(0, 0), b2); PG8_STAGEB(PG8_SB(0, 1), b2 + hstepB); PG8_STAGE(PG8_SA(0, 0), a2, vC[0], vC[1]);
            PG8_WAIT_V(8); PG8_WAIT_L(0); PG8_BAR; PG8_MMA(1, 0, At, B0); PG8_MMA(1, 1, At, B1); PG8_BAR; PG8_SCHED;
            PG8_LDB(B0, 1, 0); PG8_LDB(B1, 1, 1); PG8_SCHED; PG8_LDA(At, 1, 0); PG8_STAGE(PG8_SA(0, 1), a2 + hstepA, vC[2], vC[3]);
            PG8_WAIT_V(8); PG8_WAIT_L(0); PG8_BAR; PG8_MMA(0, 0, At, B0); PG8_MMA(0, 1, At, B1); PG8_BAR; PG8_SCHED;
            PG8_LDA(At, 1, 1); PG8_STAGEB(PG8_SB(1, 0), b3); PG8_STAGEB(PG8_SB(1, 1), b3 + hstepB); PG8_STAGE(PG8_SA(1, 0), a3, vC[0], vC[1]);
            PG8_WAIT_V(8); PG8_WAIT_L(0); PG8_BAR; PG8_MMA(1, 0, At, B0); PG8_MMA(1, 1, At, B1); PG8_BAR; PG8_SCHED;
        }
        if (wr == 0) PG8_BAR;
        { int ln_ = (int)__builtin_amdgcn_mbcnt_hi(~0u, __builtin_amdgcn_mbcnt_lo(~0u, 0u)); asm volatile("" : "+v"(ln_));
          E(acc, cur, wr, wc, ln_ & 15, ln_ >> 4); }
        if (!has_next) break;
#pragma unroll
        for (int a = 0; a < 2; ++a)
#pragma unroll
            for (int b = 0; b < 2; ++b)
#pragma unroll
                for (int m = 0; m < 4; ++m)
#pragma unroll
                    for (int n = 0; n < 2; ++n) acc[a][b][m][n] = (f32x4){0.f, 0.f, 0.f, 0.f};
        cur = nxt; cA = nA; cB = nB; ++ui;
        if (wr == 1) PG8_BAR;
    }
    PG8_WAIT_V(0);
    PG8_BAR;
#undef PG8_SA
#undef PG8_SB
#undef PG8_STAGE
#undef PG8_STAGEB
#undef PG8_LDA
#undef PG8_LDB
#undef PG8_MMA
#undef PG8_WAIT_V
#undef PG8_WAIT_L
#undef PG8_BAR
#undef PG8_SCHED
#undef PG8_VOFFA
}
}

template <int NBM, class AF, class Epi>
__device__ __forceinline__ void sgemm_tile(float* lds, int K, AF arow, const float* __restrict__ B0, const float* __restrict__ B1, int ldb, int n0, int N, Epi epi) {
    const int tid = tid_fresh();
    float* As = lds;
    float* Bs0 = lds + 16 * 132;
    float* Bs1 = lds + 2 * 16 * 132;
    const int ty = tid >> 5, tx = tid & 31;
    float acc0[8][4], acc1[8][4];
#pragma unroll
    for (int i = 0; i < 8; ++i)
#pragma unroll
        for (int j = 0; j < 4; ++j) { acc0[i][j] = 0.f; acc1[i][j] = 0.f; }
    const int ar = tid >> 2, ak = (tid & 3) * 4;
    const float* ap = arow(ar);
    const int bk = tid >> 5, bn = (tid & 31) * 4;
    const bool bok = (n0 + bn) < N;
    for (int k0 = 0; k0 < K; k0 += 16) {
        float4 av = ap ? *(const float4*)(ap + k0 + ak) : make_float4(0.f, 0.f, 0.f, 0.f);
        float4 bv0 = bok ? *(const float4*)(B0 + (size_t)(k0 + bk) * ldb + n0 + bn) : make_float4(0.f, 0.f, 0.f, 0.f);
        float4 bv1 = make_float4(0.f, 0.f, 0.f, 0.f);
        if (NBM == 2) { if (bok) bv1 = *(const float4*)(B1 + (size_t)(k0 + bk) * ldb + n0 + bn); }
        __syncthreads();
        As[(ak + 0) * 132 + ar] = av.x; As[(ak + 1) * 132 + ar] = av.y; As[(ak + 2) * 132 + ar] = av.z; As[(ak + 3) * 132 + ar] = av.w;
        *(float4*)&Bs0[bk * 132 + bn] = bv0;
        if (NBM == 2) *(float4*)&Bs1[bk * 132 + bn] = bv1;
        __syncthreads();
#pragma unroll 2
        for (int k = 0; k < 16; ++k) {
            const float4 a0 = *(const float4*)&As[k * 132 + ty * 8], a1 = *(const float4*)&As[k * 132 + ty * 8 + 4];
            const float a[8] = {a0.x, a0.y, a0.z, a0.w, a1.x, a1.y, a1.z, a1.w};
            const float4 b0 = *(const float4*)&Bs0[k * 132 + tx * 4];
            const float bb0[4] = {b0.x, b0.y, b0.z, b0.w};
#pragma unroll
            for (int i = 0; i < 8; ++i)
#pragma unroll
                for (int j = 0; j < 4; ++j) acc0[i][j] = fmaf(a[i], bb0[j], acc0[i][j]);
            if (NBM == 2) {
                const float4 b1 = *(const float4*)&Bs1[k * 132 + tx * 4];
                const float bb1[4] = {b1.x, b1.y, b1.z, b1.w};
#pragma unroll
                for (int i = 0; i < 8; ++i)
#pragma unroll
                    for (int j = 0; j < 4; ++j) acc1[i][j] = fmaf(a[i], bb1[j], acc1[i][j]);
            }
        }
    }
    if (bok) {
#pragma unroll
        for (int i = 0; i < 8; ++i)
#pragma unroll
            for (int j = 0; j < 4; ++j) epi(ty * 8 + i, tx * 4 + j, acc0[i][j], acc1[i][j]);
    }
}

__device__ __forceinline__ void transpose_blk(const float* W, int N, bf16_t* WT, int K, int k0, int n0, int drow0, float* scr, int lane) {
    const int kr = lane >> 3, n4 = (lane & 7) * 4;
    float4 v[8];
#pragma unroll
    for (int i = 0; i < 8; ++i) v[i] = *(const float4*)(W + (size_t)(k0 + i * 8 + kr) * N + n0 + n4);
#pragma unroll
    for (int i = 0; i < 8; ++i) { float* d = scr + (i * 8 + kr) * 33 + n4; d[0] = v[i].x; d[1] = v[i].y; d[2] = v[i].z; d[3] = v[i].w; }
    asm volatile("s_waitcnt lgkmcnt(0)" ::: "memory");
    const int c = lane & 7;
#pragma unroll
    for (int j = 0; j < 4; ++j) { const int n = (lane >> 3) + 8 * j; const float* sp = scr + (8 * c) * 33 + n;
        uint4 o; o.x = pk2(sp[0 * 33], sp[1 * 33]); o.y = pk2(sp[2 * 33], sp[3 * 33]); o.z = pk2(sp[4 * 33], sp[5 * 33]); o.w = pk2(sp[6 * 33], sp[7 * 33]);
        *(uint4*)(WT + (size_t)(drow0 + n) * K + k0 + 8 * c) = o; }
    asm volatile("s_waitcnt lgkmcnt(0)" ::: "memory");
}
__device__ __forceinline__ void transpose_item(const float* W, int K, int N, bf16_t* WT, int row_off, float* scr, int item, int lane) {
    const int nblk = N / 32, kb = item / nblk, nb = item % nblk;
    transpose_blk(W, N, WT, K, 64 * kb, 32 * nb, row_off + 32 * nb, scr, lane);
}
__device__ __forceinline__ void convert_experts(const Args& a, int l, float* lds) {
    const int tid = tid_fresh(), lane = tid & 63, wid = tid >> 6;
    float* scr = lds + wid * (64 * 33);
    const int gw = blockIdx.x * 8 + wid, NGW = gridDim.x * 8;
    bf16_t* WGU = (bf16_t*)(a.ws + WS_WEXP); bf16_t* WD = WGU + (size_t)NEXP * 1024 * 1024;
    for (int it = gw; it < NEXP * 768; it += NGW) {
        const int e = it / 768; int r = it % 768;
        if (r < 512) {
            const bool up = r >= 256; r &= 255; const int kb = r >> 4, nb = r & 15, n0 = 32 * nb;
            const float* W = (up ? a.in[26] : a.in[25]) + ((size_t)l * NEXP + e) * DM * DEXP;
            transpose_blk(W, DEXP, WGU + (size_t)e * 1024 * 1024, DM, 64 * kb, n0, 256 * (n0 >> 7) + (n0 & 127) + (up ? 128 : 0), scr, lane);
        } else {
            r -= 512; const int kb = r >> 5, nb = r & 31;
            const float* W = a.in[27] + ((size_t)l * NEXP + e) * DEXP * DM;
            transpose_blk(W, DM, WD + (size_t)e * 1024 * 512, DEXP, 64 * kb, 32 * nb, 32 * nb, scr, lane);
        }
    }
}
__device__ __forceinline__ void cvt_row(const float* in, bf16_t* out, int lane) {
#pragma unroll
    for (int j = 0; j < 4; ++j) { const float4 v = *(const float4*)(in + j * 256 + lane * 4); uint2 o; o.x = pk2(v.x, v.y); o.y = pk2(v.z, v.w); *(uint2*)(out + j * 256 + lane * 4) = o; }
}
__device__ __forceinline__ void phase_prologue(const Args& a, float* lds) {
    const int tid = tid_fresh(), lane = tid & 63, wid = tid >> 6;
    float* scr = lds + wid * (64 * 33);
    const int gw = blockIdx.x * 8 + wid, NGW = gridDim.x * 8;
    bf16_t* WIN0 = (bf16_t*)(a.ws + WS_WIN0); bf16_t* WIN1 = (bf16_t*)(a.ws + WS_WIN1);
    constexpr int I_IN = 16 * 104, I_VR = 16, I_SQ = 16 * 32, I_KV = 16 * 64;
    constexpr int NITEMS = 2 * I_IN + I_VR + 6 * I_SQ + 2 * I_KV;
    for (int it = gw; it < NITEMS; it += NGW) {
        int r = it;
        if (r < I_IN) { transpose_item(a.in[2], DM, IN_COLS, WIN0, 0, scr, r, lane); continue; } r -= I_IN;
        if (r < I_IN) { transpose_item(a.in[2] + (size_t)DM * IN_COLS, DM, IN_COLS, WIN1, 0, scr, r, lane); continue; } r -= I_IN;
        if (r < I_VR) { transpose_item(a.in[3], DM, 32, WIN1, IN_COLS, scr, r, lane); continue; } r -= I_VR;
        constexpr int I_L = 3 * I_SQ + I_KV;
        const int l = r / I_L; r -= l * I_L;
        if (r < I_SQ) { transpose_item(a.in[19] + (size_t)l * DM * DM, DM, DM, (bf16_t*)(a.ws + WS_WOUT) + (size_t)l * DM * DM, 0, scr, r, lane); continue; } r -= I_SQ;
        if (r < I_SQ) { transpose_item(a.in[20] + (size_t)l * DM * DM, DM, DM, (bf16_t*)(a.ws + WS_WQ) + (size_t)l * DM * DM, 0, scr, r, lane); continue; } r -= I_SQ;
        if (r < I_KV) { transpose_item(a.in[21] + (size_t)l * DM * 2048, DM, 2048, (bf16_t*)(a.ws + WS_WKV) + (size_t)l * DM * 2048, 0, scr, r, lane); continue; } r -= I_KV;
        transpose_item(a.in[22] + (size_t)l * DM * DM, DM, DM, (bf16_t*)(a.ws + WS_WO) + (size_t)l * DM * DM, 0, scr, r, lane);
    }
    for (int r = gw; r < 224; r += NGW) {
#pragma unroll
        for (int j = 0; j < 2; ++j) *(uint4*)(WIN1 + (size_t)(3360 + r) * DM + j * 512 + lane * 8) = make_uint4(0u, 0u, 0u, 0u);
    }
    bf16_t* XB = (bf16_t*)(a.ws + WS_XB); bf16_t* MEMB = (bf16_t*)(a.ws + WS_MEMB);
    for (int m = gw; m < NTOK; m += NGW) cvt_row(a.in[0] + (size_t)m * DM, XB + (size_t)m * DM, lane);
    for (int m = gw; m < NBATCH * MEMLEN; m += NGW) cvt_row(a.in[1] + (size_t)m * DM, MEMB + (size_t)m * DM, lane);
    {
        const int gt = blockIdx.x * NTHREADS + tid, NGT = gridDim.x * NTHREADS;
        for (int idx = gt; idx < 2 * 512 * 288; idx += NGT) {
            const int l = idx / (512 * 288); int r = idx % (512 * 288);
            bf16_t* base = (bf16_t*)(a.ws + WS_LORA + (size_t)l * LORA_L);
            if (r < 512 * 64) { const int n = r >> 6, k = r & 63; base[r] = f2bf(a.in[7][((size_t)l * 64 + k) * 512 + n]); continue; } r -= 512 * 64;
            if (r < 512 * 64) { const int n = r >> 6, k = r & 63; base[512 * 64 + r] = f2bf(a.in[9][((size_t)l * 64 + k) * 512 + n]); continue; } r -= 512 * 64;
            if (r < 512 * 128) { const int n = r >> 7, k = r & 127; base[2 * 512 * 64 + r] = f2bf(a.in[12][((size_t)l * 128 + k) * 512 + n]); continue; } r -= 512 * 128;
            { const int n = r >> 5, k = r & 31; base[2 * 512 * 64 + 512 * 128 + r] = f2bf(a.in[11][(size_t)k * 512 + n]); }
        }
    }
    convert_experts(a, 0, lds);
}

__device__ __forceinline__ void phase_g1(const Args& a, int l, PG8_LAS unsigned char* lds) {
    pg8::G1Sched S; S.init(a.ws + WS_XB, a.ws + (l == 0 ? WS_WIN0 : WS_WIN1), l == 0 ? IN_COLS / 256 : ZLD / 256, a.ws + WS_MEMB, a.ws + WS_WKV + (size_t)l * 4 * MiB);
    pg8::EpiG1 E{(bf16_t*)(a.ws + WS_Z), (bf16_t*)(a.ws + WS_KB), (bf16_t*)(a.ws + WS_VT)};
    pg8::gemm_phase<pg8::EpiG1, pg8::G1Sched, false>(lds, pg8::Dims{DM, DM, DM}, S, E);
}
__device__ __forceinline__ void phase_matt_s(const Args& a, PG8_LAS unsigned char* lds) {
    pg8::MattSched S; S.init(a.ws + WS_Q, a.ws + WS_KB, (size_t)256 * 1024 * 2, 256 * 2);
    pg8::EpiSoftmax E{(bf16_t*)(a.ws + WS_P), (float*)(a.ws + WS_LSUM), (PG8_LAS float*)(lds + pg8::STAGE_BYTES + 8192 + 512)};
    pg8::gemm_phase<pg8::EpiSoftmax, pg8::MattSched, false>(lds, pg8::Dims{1024, 1024, 256}, S, E);
}
__device__ __forceinline__ void phase_matt_pv(const Args& a, PG8_LAS unsigned char* lds) {
    pg8::MattSched S; S.init(a.ws + WS_P, a.ws + WS_VT, (size_t)1024 * 256 * 2, 256 * 256 * 2);
    pg8::EpiPV E{(bf16_t*)(a.ws + WS_O), (const float*)(a.ws + WS_LSUM)};
    pg8::gemm_phase<pg8::EpiPV, pg8::MattSched, false>(lds, pg8::Dims{1024, 256, 256}, S, E);
}

typedef _Float16 h8_t __attribute__((ext_vector_type(8)));
typedef _Float16 h2_t __attribute__((ext_vector_type(2)));
__device__ __forceinline__ unsigned pkh2(float lo, float hi) { h2_t v = {(_Float16)lo, (_Float16)hi}; return __builtin_bit_cast(unsigned, v); }
#define SC_DPP(x, ctrl) __int_as_float(__builtin_amdgcn_mov_dpp(__float_as_int(x), ctrl, 0xF, 0xF, true))
__device__ __forceinline__ float sum32(float x) {
    x += SC_DPP(x, 0xB1); x += SC_DPP(x, 0x4E); x += SC_DPP(x, 0x141); x += SC_DPP(x, 0x140);
    return x + __shfl_xor(x, 16);
}
__device__ __forceinline__ void phase_prep(const Args& a, int l, float* lds) {
    typedef short bf16x8 __attribute__((ext_vector_type(8)));
    typedef float f32x16 __attribute__((ext_vector_type(16)));
    const bf16_t* Z = (const bf16_t*)(a.ws + WS_Z);
    const int tid = tid_fresh(), lane = tid & 63, wid = tid >> 6;
    float* KM = (float*)(a.ws + WS_KMEAN);
    for (int u = blockIdx.x * 8 + wid; u < NBATCH * NH * 8; u += gridDim.x * 8) {
        const int nb = u & 7, h = (u >> 3) & 7, b = u >> 6, rg = lane >> 3, ch = lane & 7;
        const bf16_t* p = Z + (size_t)(b * SEQ + nb * 256 + rg) * ZLD + C_K + h * HD + ch * 8;
        float acc[8];
#pragma unroll
        for (int j = 0; j < 8; ++j) acc[j] = 0.f;
#pragma unroll 8
        for (int i = 0; i < 32; ++i) { const uint4 v = *(const uint4*)(p + (size_t)(i * 8) * ZLD);
            acc[0] += bflo(v.x); acc[1] += bfhi(v.x); acc[2] += bflo(v.y); acc[3] += bfhi(v.y); acc[4] += bflo(v.z); acc[5] += bfhi(v.z); acc[6] += bflo(v.w); acc[7] += bfhi(v.w); }
#pragma unroll
        for (int j = 0; j < 8; ++j) { float x = acc[j]; x += __shfl_xor(x, 8); x += __shfl_xor(x, 16); x += __shfl_xor(x, 32); acc[j] = x * (1.0f / 256.0f); }
        if (rg == 0) { *(float4*)(KM + (size_t)u * 64 + ch * 8) = make_float4(acc[0], acc[1], acc[2], acc[3]); *(float4*)(KM + (size_t)u * 64 + ch * 8 + 4) = make_float4(acc[4], acc[5], acc[6], acc[7]); }
    }
    const float* mu = a.in[4] + (size_t)l * 1792;
    const float* muv = a.in[5];
    const bf16_t* WdT = (const bf16_t*)(a.ws + WS_LORA + (size_t)l * LORA_L); const bf16_t* WiT = (const bf16_t*)(a.ws + WS_LORA + (size_t)l * LORA_L + LORA_I);
    const bf16_t* WgT = (const bf16_t*)(a.ws + WS_LORA + (size_t)l * LORA_L + LORA_G); const bf16_t* WvT = (const bf16_t*)(a.ws + WS_LORA + LORA_V);
    unsigned* REC = (unsigned*)(a.ws + WS_REC);
    _Float16* RVT = (_Float16*)(a.ws + WS_RVT); bf16_t* RGp = (bf16_t*)(a.ws + WS_RG); float* BON = (float*)(a.ws + WS_BON);
    bf16_t* VF = (bf16_t*)(a.ws + WS_VFIRST);
    for (int task = blockIdx.x * 8 + wid; task < 512 * 8; task += gridDim.x * 8) {
        int lane_t = lane; asm volatile("" : "+v"(lane_t));
        const int r32 = lane_t & 31, hi = lane_t >> 5;
        const int h = task & 7, tb = task >> 3, t0 = tb * 32, b = t0 / SEQ, tt0 = t0 % SEQ, bh = b * NH + h;
        const size_t tokA = (size_t)t0 + r32;
        const bool firstA = (tt0 == 0) && (r32 == 0);
        const size_t tokP = firstA ? tokA : tokA - 1;
#define PREP_AFRAG(dst, zcol, mup, ACT) do { \
            const uint4 cu_ = *(const uint4*)(Z + tokA * ZLD + (zcol)); uint4 pv_ = *(const uint4*)(Z + tokP * ZLD + (zcol)); if (firstA) pv_ = make_uint4(0u, 0u, 0u, 0u); \
            const float4 m0_ = *(const float4*)(mup), m1_ = *(const float4*)((mup) + 4); \
            float x_[8]; const unsigned cw_[4] = {cu_.x, cu_.y, cu_.z, cu_.w}, pw_[4] = {pv_.x, pv_.y, pv_.z, pv_.w}; const float mm_[8] = {m0_.x, m0_.y, m0_.z, m0_.w, m1_.x, m1_.y, m1_.z, m1_.w}; \
            _Pragma("unroll") for (int q_ = 0; q_ < 4; ++q_) { const float c0_ = bflo(cw_[q_]), c1_ = bfhi(cw_[q_]); x_[2 * q_] = c0_ + (bflo(pw_[q_]) - c0_) * mm_[2 * q_]; x_[2 * q_ + 1] = c1_ + (bfhi(pw_[q_]) - c1_) * mm_[2 * q_ + 1]; } \
            _Pragma("unroll") for (int q_ = 0; q_ < 8; ++q_) { if (ACT == 1) x_[q_] = 1.0f - 2.0f * __builtin_amdgcn_rcpf(__expf(2.0f * x_[q_]) + 1.0f); else if (ACT == 2) x_[q_] = __builtin_amdgcn_rcpf(1.0f + __expf(-x_[q_])); } \
            pg8::u32x4 w_; w_.x = pk2(x_[0], x_[1]); w_.y = pk2(x_[2], x_[3]); w_.z = pk2(x_[4], x_[5]); w_.w = pk2(x_[6], x_[7]); dst = __builtin_bit_cast(bf16x8, w_); } while (0)
        const int chB = h * 64 + r32;
#define PREP_TOK(r) int hq_ = hi; asm volatile("" : "+v"(hq_)); const int tq = ((r) & 3) + 8 * ((r) >> 2) + 4 * hq_, t = tt0 + tq; const size_t tok = (size_t)t0 + tq; (void)t; (void)tok
#define PREP_RB(t, j) (((((size_t)bh * 512 + ((t) >> 2)) * 32 + ((j) >> 1)) * 4 + ((t) & 3)) * 5)
        f32x16 acc[2];
#pragma unroll
        for (int nb = 0; nb < 2; ++nb)
#pragma unroll
            for (int r = 0; r < 16; ++r) acc[nb][r] = 0.f;
#pragma unroll 1
        for (int sO = 0; sO < 8; sO += 4) {
            asm volatile("" ::: "memory");
#pragma unroll
            for (int sJ = 0; sJ < 4; ++sJ) { const int sI = sO + sJ;
                bf16x8 af; PREP_AFRAG(af, C_ZG + 16 * sI + 8 * hi, mu + (C_ZG - C_R) + 16 * sI + 8 * hi, 2);
#pragma unroll
                for (int nb = 0; nb < 2; ++nb) acc[nb] = __builtin_amdgcn_mfma_f32_32x32x16_bf16(af, *(const bf16x8*)(WgT + (size_t)(chB + 32 * nb) * 128 + 16 * sI + 8 * hi), acc[nb], 0, 0, 0); }
        }
#pragma unroll
        for (int nb = 0; nb < 2; ++nb)
#pragma unroll
            for (int r = 0; r < 16; ++r) { PREP_TOK(r); RGp[tok * 512 + chB + 32 * nb] = f2bf(acc[nb][r]); }
#pragma unroll
        for (int nb = 0; nb < 2; ++nb)
#pragma unroll
            for (int r = 0; r < 16; ++r) acc[nb][r] = 0.f;
        asm volatile("" ::: "memory");
#pragma unroll
        for (int sI = 0; sI < 4; ++sI) {
            bf16x8 af; PREP_AFRAG(af, C_ZW + 16 * sI + 8 * hi, mu + (C_ZW - C_R) + 16 * sI + 8 * hi, 1);
#pragma unroll
            for (int nb = 0; nb < 2; ++nb) acc[nb] = __builtin_amdgcn_mfma_f32_32x32x16_bf16(af, *(const bf16x8*)(WdT + (size_t)(chB + 32 * nb) * 64 + 16 * sI + 8 * hi), acc[nb], 0, 0, 0);
        }
        unsigned UW[2][8];
#pragma unroll
        for (int nb = 0; nb < 2; ++nb) {
            const float w0c = a.in[6][l * 512 + chB + 32 * nb];
#pragma unroll
            for (int g = 0; g < 4; ++g)
#pragma unroll
                for (int ts = 0; ts < 2; ++ts) { float uu[2];
#pragma unroll
                    for (int e = 0; e < 2; ++e) { const float sd = w0c + acc[nb][4 * g + ts + 2 * e]; const float sp = (sd < -15.f) ? -sd : __logf(1.0f + __expf(-sd)); uu[e] = 1.0f - __expf(-__expf(-sp - 0.5f)); }
                    UW[nb][2 * g + ts] = pkh2(uu[0], uu[1]); }
        }
        f32x16 aia[2], vga[2];
#pragma unroll
        for (int nb = 0; nb < 2; ++nb)
#pragma unroll
            for (int r = 0; r < 16; ++r) { aia[nb][r] = 0.f; vga[nb][r] = 0.f; }
        asm volatile("" ::: "memory");
#pragma unroll
        for (int sI = 0; sI < 4; ++sI) {
            bf16x8 af; PREP_AFRAG(af, C_ZA + 16 * sI + 8 * hi, mu + (C_ZA - C_R) + 16 * sI + 8 * hi, 0);
#pragma unroll
            for (int nb = 0; nb < 2; ++nb) aia[nb] = __builtin_amdgcn_mfma_f32_32x32x16_bf16(af, *(const bf16x8*)(WiT + (size_t)(chB + 32 * nb) * 64 + 16 * sI + 8 * hi), aia[nb], 0, 0, 0);
        }
        if (l == 1) {
            asm volatile("" ::: "memory");
#pragma unroll
            for (int sI = 0; sI < 2; ++sI) {
                bf16x8 af; PREP_AFRAG(af, C_ZV + 16 * sI + 8 * hi, muv + 16 * sI + 8 * hi, 0);
#pragma unroll
                for (int nb = 0; nb < 2; ++nb) vga[nb] = __builtin_amdgcn_mfma_f32_32x32x16_bf16(af, *(const bf16x8*)(WvT + (size_t)(chB + 32 * nb) * 32 + 16 * sI + 8 * hi), vga[nb], 0, 0, 0);
            }
        }
#undef PREP_AFRAG
        float ss[16], bon[16]; unsigned KW[2][8], RW[2][8], QW[2][8], AW[2][8];
#pragma unroll
        for (int r = 0; r < 16; ++r) { ss[r] = 0.f; bon[r] = 0.f; }
#pragma unroll
        for (int nb = 0; nb < 2; ++nb) {
            const int j = 32 * nb + r32, c = h * 64 + j;
            const float a0c = a.in[8][l * 512 + c], v0c = a.in[10][c];
            const float mu_r = mu[c], mu_k = mu[512 + c], mu_v = mu[1024 + c];
            const float kk_c = a.in[13][l * 512 + c], ka_c = a.in[14][l * 512 + c], rk_c = a.in[15][l * 512 + c];
            float v4[4], kp2[2], rr2[2], kq2[2], ai2[2];
#pragma unroll
            for (int r = 0; r < 16; ++r) {
                if ((r & 3) == 0) asm volatile("" ::: "memory");
                PREP_TOK(r);
                const float ai = sigmoidf_(a0c + aia[nb][r]);
                const float zr = bf2f(Z[tok * ZLD + C_R + c]), zk = bf2f(Z[tok * ZLD + C_KR + c]), zv = bf2f(Z[tok * ZLD + C_VR + c]);
                const size_t tokp = (t != 0) ? tok - 1 : tok; const float pm_ = (t != 0) ? 1.0f : 0.0f;
                const float pr = pm_ * bf2f(Z[tokp * ZLD + C_R + c]), pk = pm_ * bf2f(Z[tokp * ZLD + C_KR + c]), pv = pm_ * bf2f(Z[tokp * ZLD + C_VR + c]);
                const float rr_ = zr + (pr - zr) * mu_r, kx = zk + (pk - zk) * mu_k;
                float v = zv + (pv - zv) * mu_v;
                if (l == 0) VF[tok * 512 + c] = f2bf(v);
                else v = v + (bf2f(VF[tok * 512 + c]) - v) * sigmoidf_(v0c + vga[nb][r]);
                const float kkraw = kx * kk_c, kp = kx * (1.0f + (ai - 1.0f) * ka_c);
                ss[r] = fmaf(kkraw, kkraw, ss[r]); bon[r] = fmaf(rr_ * kp, rk_c, bon[r]);
                if ((r & 3) < 2) { kp2[r & 1] = kp; rr2[r & 1] = rr_; kq2[r & 1] = kkraw; ai2[r & 1] = ai; }
                else { const int wI = 2 * (r >> 2) + (r & 1); KW[nb][wI] = pkh2(kp2[r & 1], kp); RW[nb][wI] = pkh2(rr2[r & 1], rr_); QW[nb][wI] = pkh2(kq2[r & 1], kkraw); AW[nb][wI] = pkh2(ai2[r & 1], ai); }
                v4[r & 3] = v;
                if ((r & 3) == 3) {
                    uint2 pv2; pv2.x = pkh2(v4[0], v4[1]); pv2.y = pkh2(v4[2], v4[3]);
                    *(uint2*)(RVT + (((size_t)bh * 256 + ((tt0 >> 3) + (r >> 2))) * 64 + j) * 8 + 4 * hi) = pv2;
                }
            }
        }
        float rn[16];
#pragma unroll
        for (int r = 0; r < 16; ++r) {
            PREP_TOK(r);
            const float sst = sum32(ss[r]), bt = sum32(bon[r]);
            rn[r] = rsqrtf(fmaxf(sst, 1e-24f));
            BON[tok * 8 + h] = bt;
        }
        const unsigned psel = (r32 & 1) ? 0x03020706u : 0x05040100u;
#pragma unroll
        for (int nb = 0; nb < 2; ++nb)
#pragma unroll
            for (int g = 0; g < 4; ++g) {
                asm volatile("" ::: "memory");
                unsigned outw[10];
#pragma unroll
                for (int ts = 0; ts < 2; ++ts) {
                    const int wI = 2 * g + ts;
                    const h2_t q2 = __builtin_bit_cast(h2_t, QW[nb][wI]), a2 = __builtin_bit_cast(h2_t, AW[nb][wI]);
                    const float k0 = (float)q2[0] * rn[4 * g + ts], k1 = (float)q2[1] * rn[4 * g + ts + 2];
                    const unsigned mine[5] = {UW[nb][wI], pkh2(-k0, -k1), pkh2(k0 * (float)a2[0], k1 * (float)a2[1]), KW[nb][wI], RW[nb][wI]};
#pragma unroll
                    for (int q = 0; q < 5; ++q) { const unsigned oth = (unsigned)__builtin_amdgcn_mov_dpp((int)mine[q], 0xB1, 0xF, 0xF, true); outw[ts * 5 + q] = __builtin_amdgcn_perm(oth, mine[q], psel); }
                }
                const int tg = (tt0 >> 2) + 2 * g + hi, j2r = 16 * nb + (r32 >> 1);
                unsigned* dst = REC + (((size_t)bh * 512 + tg) * 32 + j2r) * 20 + ((r32 & 1) ? 10 : 0);
#pragma unroll
                for (int k = 0; k < 5; ++k) { uint2 o2; o2.x = outw[2 * k]; o2.y = outw[2 * k + 1]; *(uint2*)(dst + 2 * k) = o2; }
            }
#undef PREP_TOK
#undef PREP_RB
    }
}

__device__ __forceinline__ float dpp_add(float x, float y_src, int) { return x + y_src; }
__device__ __forceinline__ float red32(float x) {
    x += SC_DPP(x, 0xB1); x += SC_DPP(x, 0x4E); x += SC_DPP(x, 0x141); x += SC_DPP(x, 0x140);
    auto rr = __builtin_amdgcn_permlane32_swap(__float_as_uint(x), __float_as_uint(x), false, false);
    return __uint_as_float(rr[0]) + __uint_as_float(rr[1]);
}
__device__ __forceinline__ float fmul_lo(float a, unsigned h) { float d; asm("v_fma_mix_f32 %0, %1, %2, 0 op_sel_hi:[0,1,0]" : "=v"(d) : "v"(a), "v"(h)); return d; }
__device__ __forceinline__ float fmix_lo(float a, unsigned h, float c) { float d; asm("v_fma_mix_f32 %0, %1, %2, %3 op_sel_hi:[0,1,0]" : "=v"(d) : "v"(a), "v"(h), "v"(c)); return d; }
__device__ __forceinline__ float fmix_hi(float a, unsigned h, float c) { float d; asm("v_fma_mix_f32 %0, %1, %2, %3 op_sel:[0,1,0] op_sel_hi:[0,1,0]" : "=v"(d) : "v"(a), "v"(h), "v"(c)); return d; }
__device__ __forceinline__ float fdec_lo(float sv, unsigned u) { float d; asm("v_fma_mix_f32 %0, -%1, %2, %1 op_sel_hi:[0,1,0]" : "=v"(d) : "v"(sv), "v"(u)); return d; }
__device__ __forceinline__ float fdec_hi(float sv, unsigned u) { float d; asm("v_fma_mix_f32 %0, -%1, %2, %1 op_sel:[0,1,0] op_sel_hi:[0,1,0]" : "=v"(d) : "v"(sv), "v"(u)); return d; }
template <int VH> __device__ __forceinline__ float fvk_lo(unsigned v, unsigned k, float c) { float d;
    if (VH) asm("v_fma_mix_f32 %0, %1, %2, %3 op_sel:[1,0,0] op_sel_hi:[1,1,0]" : "=v"(d) : "v"(v), "v"(k), "v"(c)); else asm("v_fma_mix_f32 %0, %1, %2, %3 op_sel:[0,0,0] op_sel_hi:[1,1,0]" : "=v"(d) : "v"(v), "v"(k), "v"(c)); return d; }
template <int VH> __device__ __forceinline__ float fvk_hi(unsigned v, unsigned k, float c) { float d;
    if (VH) asm("v_fma_mix_f32 %0, %1, %2, %3 op_sel:[1,1,0] op_sel_hi:[1,1,0]" : "=v"(d) : "v"(v), "v"(k), "v"(c)); else asm("v_fma_mix_f32 %0, %1, %2, %3 op_sel:[0,1,0] op_sel_hi:[1,1,0]" : "=v"(d) : "v"(v), "v"(k), "v"(c)); return d; }

__device__ __forceinline__ void phase_scan(const Args& a, int l, PG8_LAS unsigned char* lds) {
    const int tid = tid_fresh(), lane = tid & 63, wid = __builtin_amdgcn_readfirstlane(tid >> 6);
    const int j2 = (lane & 15) | ((lane >> 5) << 4), rr = (lane >> 4) & 1;
    const char* REC = (const char*)(a.ws + WS_REC); const char* RVT = (const char*)(a.ws + WS_RVT);
    bf16_t* YR = (bf16_t*)(a.ws + WS_YRAW);
    constexpr int CH_REC = 40960, CH_V = 8192, CH = CH_REC + CH_V;
    constexpr int YB_LD = 68, YB_WAVE = 16 * YB_LD * 4;
    PG8_LAS float* yb = (PG8_LAS float*)(lds + 2 * CH + wid * YB_WAVE);
    for (int u = blockIdx.x; u < 256; u += gridDim.x) {
        const int bh = u >> 2, rg = u & 3, b = bh >> 3, h = bh & 7;
        const int irow = rg * 16 + wid * 2 + rr;
        const char* grec = REC + (size_t)bh * 32 * CH_REC; const char* gv = RVT + (size_t)bh * 32 * CH_V;
        float S0 = 0.f, S1 = 0.f;
        __syncthreads();
#pragma unroll
        for (int k = 0; k < 6; ++k) { const int pc = wid * 6 + k; const char* src = (pc < 40) ? grec + pc * 1024 + lane * 16 : gv + (pc - 40) * 1024 + lane * 16;
            __builtin_amdgcn_global_load_lds((const unsigned*)src, (PG8_LAS unsigned*)(lds + pc * 1024), 16, 0, 0); }
        for (int ch = 0; ch < 32; ++ch) {
            asm volatile("s_waitcnt vmcnt(0)" ::: "memory");
            __syncthreads();
            if (ch + 1 < 32) {
                const int nb = ((ch + 1) & 1) * CH;
#pragma unroll
                for (int k = 0; k < 6; ++k) { const int pc = wid * 6 + k; const char* src = (pc < 40) ? grec + (size_t)(ch + 1) * CH_REC + pc * 1024 + lane * 16 : gv + (size_t)(ch + 1) * CH_V + (pc - 40) * 1024 + lane * 16;
                    __builtin_amdgcn_global_load_lds((const unsigned*)src, (PG8_LAS unsigned*)(lds + nb + pc * 1024), 16, 0, 0); }
            }
            PG8_LAS const unsigned char* bufp = lds + (ch & 1) * CH;
#define SCAN_LOADW(W, grp) do { PG8_LAS const unsigned char* rp_ = bufp + ((grp) * 32 + j2) * 80; _Pragma("unroll") for (int k_ = 0; k_ < 5; ++k_) { \
                const pg8::u32x4 q_ = *(PG8_LAS const pg8::u32x4*)(rp_ + 16 * k_); W[4 * k_] = q_.x; W[4 * k_ + 1] = q_.y; W[4 * k_ + 2] = q_.z; W[4 * k_ + 3] = q_.w; } } while (0)
#define SCAN_STEPS(W, hf) do { _Pragma("unroll") for (int ts = 0; ts < 4; ++ts) { \
                const unsigned wu = W[ts * 5], wa = W[ts * 5 + 1], wb = W[ts * 5 + 2], wk = W[ts * 5 + 3], wr_ = W[ts * 5 + 4]; \
                const unsigned vw = vv[(hf) * 2 + (ts >> 1)]; \
                const float sa = red32(fmix_hi(S1, wa, fmul_lo(S0, wa))); \
                float t0 = fdec_lo(S0, wu), t1 = fdec_hi(S1, wu); \
                if (ts & 1) { t0 = fvk_lo<1>(vw, wk, t0); t1 = fvk_hi<1>(vw, wk, t1); } else { t0 = fvk_lo<0>(vw, wk, t0); t1 = fvk_hi<0>(vw, wk, t1); } \
                S0 = fmix_lo(sa, wb, t0); S1 = fmix_hi(sa, wb, t1); \
                yb[((g8 & 1) * 8 + (hf) * 4 + ts) * YB_LD + rr * 32 + j2] = fmix_hi(S1, wr_, fmul_lo(S0, wr_)); } } while (0)
            unsigned wA[20], wB[20];
            SCAN_LOADW(wA, 0);
#pragma unroll 1
            for (int g8 = 0; g8 < 8; ++g8) {
                const pg8::u32x4 vv = *(PG8_LAS const pg8::u32x4*)(bufp + CH_REC + (g8 * 64 + irow) * 16);
                SCAN_LOADW(wB, g8 * 2 + 1);
                SCAN_STEPS(wA, 0);
                if (g8 < 7) SCAN_LOADW(wA, g8 * 2 + 2);
                SCAN_STEPS(wB, 1);
                if (g8 & 1) {
                    asm volatile("s_waitcnt lgkmcnt(0)" ::: "memory");
                    PG8_LAS const float* yp = yb + (j2 & 15) * YB_LD + rr * 32 + (j2 >> 4) * 16;
                    const pg8::f32x4 y0 = *(PG8_LAS const pg8::f32x4*)(yp), y1 = *(PG8_LAS const pg8::f32x4*)(yp + 4), y2 = *(PG8_LAS const pg8::f32x4*)(yp + 8), y3 = *(PG8_LAS const pg8::f32x4*)(yp + 12);
                    const pg8::f32x4 ys = (y0 + y1) + (y2 + y3);
                    float y = (ys[0] + ys[1]) + (ys[2] + ys[3]);
                    { auto sw = __builtin_amdgcn_permlane32_swap(__float_as_uint(y), __float_as_uint(y), false, false); y = __uint_as_float(sw[0]) + __uint_as_float(sw[1]); }
                    const int t = ch * 64 + (g8 >> 1) * 16 + (j2 & 15);
                    if (j2 < 16) YR[((size_t)b * SEQ + t) * 512 + h * 64 + irow] = f2bf(y);
                    asm volatile("s_waitcnt lgkmcnt(0)" ::: "memory");
                }
            }
#undef SCAN_LOADW
#undef SCAN_STEPS
        }
    }
}

__device__ __forceinline__ void phase_post(const Args& a, int l) {
    const int tid = tid_fresh(), lane = tid & 63, wid = tid >> 6;
    const bf16_t* YR = (const bf16_t*)(a.ws + WS_YRAW); const _Float16* RVT = (const _Float16*)(a.ws + WS_RVT);
    const bf16_t* RGp = (const bf16_t*)(a.ws + WS_RG); const float* BON = (const float*)(a.ws + WS_BON);
    bf16_t* MIX = (bf16_t*)(a.ws + WS_MIX);
    for (int u = blockIdx.x; u < 64 * 256; u += gridDim.x) {
        const int bh = u >> 8, t8 = u & 255, b = bh >> 3, h = bh & 7, t = t8 * 8 + wid;
        const size_t tok = (size_t)b * SEQ + t; const int c = h * 64 + lane;
        const float y = bf2f(YR[tok * 512 + c]);
        const float my = wsum(y) * (1.0f / 64.0f);
        const float dy = y - my;
        const float var = wsum(dy * dy) * (1.0f / 64.0f);
        const float yn = dy * rsqrtf(var + 64e-5f) * a.in[16][l * 512 + c] + a.in[17][l * 512 + c];
        const float v = (float)RVT[(((size_t)bh * 256 + t8) * 64 + lane) * 8 + wid];
        MIX[tok * DM + 512 + c] = f2bf((yn + BON[tok * 8 + h] * v) * bf2f(RGp[tok * 512 + c]));
    }
}

namespace att {
typedef short bf16x8 __attribute__((ext_vector_type(8)));
typedef short s16x4 __attribute__((ext_vector_type(4)));
typedef float f32x16 __attribute__((ext_vector_type(16)));
typedef __attribute__((address_space(3))) const unsigned char* lds_cptr;
constexpr int SLOT = 8192, L_K = 0, L_V = 2 * SLOT, L_WS = 4 * SLOT, L_KM = L_WS + 8 * 256, L_OST = L_KM + 2048, OST_LD = 68, L_END = L_OST + 8 * 32 * OST_LD * 4;
constexpr float C2 = 0.125f * 1.4426950408889634f;
__device__ __forceinline__ int crow(int r, int hi) { return (r & 3) + 8 * (r >> 2) + 4 * hi; }
__device__ __forceinline__ s16x4 vtr(lds_cptr p) { return __builtin_bit_cast(s16x4, __builtin_amdgcn_ds_read_tr16_b64_v4i16((__attribute__((address_space(3))) s16x4*)p)); }
__device__ __forceinline__ float swapmax(float x) { auto rr = __builtin_amdgcn_permlane32_swap(__float_as_uint(x), __float_as_uint(x), false, false); return fmaxf(__uint_as_float(rr[0]), __uint_as_float(rr[1])); }
__device__ __forceinline__ float swapsum(float x) { auto rr = __builtin_amdgcn_permlane32_swap(__float_as_uint(x), __float_as_uint(x), false, false); return __uint_as_float(rr[0]) + __uint_as_float(rr[1]); }

__device__ __forceinline__ void unit(const Args& a, int l, int b, int h, int cur, PG8_LAS unsigned char* lds) {
    const int tid = tid_fresh(), lane = tid & 63, r32 = lane & 31, hi = lane >> 5, wid = __builtin_amdgcn_readfirstlane(tid >> 6);
    const bf16_t* Zb = (const bf16_t*)(a.ws + WS_Z) + (size_t)b * SEQ * ZLD;
    const int qrel = wid * 32 + r32, qpos = cur * 256 + qrel;
    PG8_LAS float* wsf = (PG8_LAS float*)(lds + L_WS) + wid * 64;
    PG8_LAS float* kmf = (PG8_LAS float*)(lds + L_KM);
    __syncthreads();
    kmf[tid] = ((const float*)(a.ws + WS_KMEAN))[(size_t)(b * NH + h) * 512 + tid];
    const bf16_t* ksrc = Zb + (size_t)lane * ZLD + C_K + h * HD + wid * 8;
    const bf16_t* vsrc = Zb + (size_t)(16 * (wid & 3) + (lane >> 2)) * ZLD + C_V + h * HD + (wid >> 2) * 32 + (lane & 3) * 8;
#define ATT_DMA(kpos0, slot) do { \
        __builtin_amdgcn_global_load_lds((const unsigned*)(ksrc + (size_t)(kpos0) * ZLD), (PG8_LAS unsigned*)(lds + L_K + (slot) * SLOT + wid * 1024), 16, 0, 0); \
        __builtin_amdgcn_global_load_lds((const unsigned*)(vsrc + (size_t)(kpos0) * ZLD), (PG8_LAS unsigned*)(lds + L_V + (slot) * SLOT + wid * 1024), 16, 0, 0); } while (0)
    ATT_DMA(cur * 256, 0);
    bf16x8 qr[4];
#pragma unroll
    for (int d0 = 0; d0 < 4; ++d0) qr[d0] = *(const bf16x8*)(Zb + (size_t)qpos * ZLD + C_Q + h * HD + d0 * 16 + hi * 8);
    __syncthreads();
    unsigned selbits = 0u;
    {
        float g[8];
#pragma unroll
        for (int n = 0; n < 8; ++n) g[n] = 0.f;
#pragma unroll
        for (int d0 = 0; d0 < 4; ++d0)
#pragma unroll
            for (int j = 0; j < 8; ++j) { const float qv = bf2f((bf16_t)qr[d0][j]);
#pragma unroll
                for (int n = 0; n < 8; ++n) g[n] = fmaf(qv, kmf[n * 64 + d0 * 16 + hi * 8 + j], g[n]); }
#pragma unroll
        for (int n = 0; n < 8; ++n) g[n] = (n < cur) ? swapsum(g[n]) : NEG_INF;
        if (cur <= 3) selbits = (1u << cur) - 1u;
        else {
            int s0 = -1, s1 = -1, s2 = -1; float bv = -3e38f;
#pragma unroll
            for (int n = 0; n < 8; ++n) if (g[n] > bv) { bv = g[n]; s0 = n; }
            bv = -3e38f;
#pragma unroll
            for (int n = 0; n < 8; ++n) if (n != s0 && g[n] > bv) { bv = g[n]; s1 = n; }
            bv = -3e38f;
#pragma unroll
            for (int n = 0; n < 8; ++n) if (n != s0 && n != s1 && g[n] > bv) { bv = g[n]; s2 = n; }
            selbits = (1u << s0) | (1u << s1) | (1u << s2);
        }
    }
    const float s8 = 8.0f * exp2f(-(float)(h + 1));
    f32x16 base;
#pragma unroll
    for (int r = 0; r < 16; ++r) base[r] = s8 * (float)crow(r, hi);
    f32x16 o0, o1;
#pragma unroll
    for (int r = 0; r < 16; ++r) { o0[r] = 0.f; o1[r] = 0.f; }
    float m = -INFINITY, lsum = 0.f;
    const int NT = 4 * (cur + 1);
    const lds_cptr kp = (lds_cptr)(lds + L_K) + hi * 1024 + r32 * 16;
    const lds_cptr vp = (lds_cptr)(lds + L_V) + ((lane >> 4) & 1) * 32 + (lane & 3) * 8 + (4 * hi + ((lane & 15) >> 2)) * 64;
    for (int it = 0; it < NT; ++it) {
        asm volatile("s_waitcnt vmcnt(0)" ::: "memory");
        __syncthreads();
        const int blk = (it < 4) ? cur : ((it >> 2) - 1);
        const int kpos0 = blk * 256 + (it & 3) * 64;
        if (it + 1 < NT) { const int nblk = (it + 1 < 4) ? cur : (((it + 1) >> 2) - 1); ATT_DMA(nblk * 256 + ((it + 1) & 3) * 64, (it + 1) & 1); }
        const int so = (it & 1) * SLOT;
        f32x16 p0 = base, p1 = base;
#pragma unroll
        for (int d0 = 0; d0 < 4; ++d0) {
            const bf16x8 k0 = *(const __attribute__((address_space(3))) bf16x8*)(kp + so + d0 * 2048);
            const bf16x8 k1 = *(const __attribute__((address_space(3))) bf16x8*)(kp + so + d0 * 2048 + 512);
            p0 = __builtin_amdgcn_mfma_f32_32x32x16_bf16(k0, qr[d0], p0, 0, 0, 0);
            p1 = __builtin_amdgcn_mfma_f32_32x32x16_bf16(k1, qr[d0], p1, 0, 0, 0);
        }
        const bool rowsel = (it < 4) || ((selbits >> blk) & 1u);
        const float cb = rowsel ? -s8 * (float)(qpos - kpos0) : -INFINITY;
        const float cb1 = cb + s8 * 32.0f;
        if (it < 4) {
            const int kb0 = (it & 3) * 64 + 4 * hi;
#pragma unroll
            for (int r = 0; r < 16; ++r) { const int kv = kb0 + (r & 3) + 8 * (r >> 2); if (kv > qrel) p0[r] = -INFINITY; if (kv + 32 > qrel) p1[r] = -INFINITY; }
        }
        float mx0 = p0[0], mx1 = p1[0];
#pragma unroll
        for (int r = 1; r < 16; ++r) { mx0 = fmaxf(mx0, p0[r]); mx1 = fmaxf(mx1, p1[r]); }
        const float mx = swapmax(fmaxf(mx0 + cb, mx1 + cb1));
        if (__any((mx - m) * C2 > 6.0f)) {
            const float mn = fmaxf(m, mx);
            const float alpha = __builtin_amdgcn_exp2f((m - mn) * C2);
            m = mn; lsum *= alpha;
            asm volatile("s_waitcnt lgkmcnt(0)" ::: "memory");
            if (hi == 0) wsf[r32] = alpha;
            asm volatile("s_waitcnt lgkmcnt(0)" ::: "memory");
#pragma unroll
            for (int r = 0; r < 16; ++r) { const float al = wsf[crow(r, hi)]; o0[r] *= al; o1[r] *= al; }
        }
        const float tb0 = (cb - m) * C2, tb1 = (cb1 - m) * C2;
        float ls = 0.f;
#pragma unroll
        for (int r = 0; r < 16; ++r) { p0[r] = __builtin_amdgcn_exp2f(fmaf(p0[r], C2, tb0)); p1[r] = __builtin_amdgcn_exp2f(fmaf(p1[r], C2, tb1)); ls += p0[r] + p1[r]; }
        lsum += ls;
        pg8::u32x4 w0, w1, w2, w3;
        w0.x = pk2(p0[0], p0[1]); w0.y = pk2(p0[2], p0[3]); w0.z = pk2(p0[4], p0[5]); w0.w = pk2(p0[6], p0[7]);
        w1.x = pk2(p0[8], p0[9]); w1.y = pk2(p0[10], p0[11]); w1.z = pk2(p0[12], p0[13]); w1.w = pk2(p0[14], p0[15]);
        w2.x = pk2(p1[0], p1[1]); w2.y = pk2(p1[2], p1[3]); w2.z = pk2(p1[4], p1[5]); w2.w = pk2(p1[6], p1[7]);
        w3.x = pk2(p1[8], p1[9]); w3.y = pk2(p1[10], p1[11]); w3.z = pk2(p1[12], p1[13]); w3.w = pk2(p1[14], p1[15]);
        const bf16x8 pa0 = __builtin_bit_cast(bf16x8, w0), pa1 = __builtin_bit_cast(bf16x8, w1), pa2 = __builtin_bit_cast(bf16x8, w2), pa3 = __builtin_bit_cast(bf16x8, w3);
#define ATT_VF(d0, ks) ({ const s16x4 lo_ = vtr(vp + so + (d0) * 4096 + (ks) * 1024), hi_ = vtr(vp + so + (d0) * 4096 + (ks) * 1024 + 512); \
        (bf16x8){lo_[0], lo_[1], lo_[2], lo_[3], hi_[0], hi_[1], hi_[2], hi_[3]}; })
        o0 = __builtin_amdgcn_mfma_f32_32x32x16_bf16(pa0, ATT_VF(0, 0), o0, 0, 0, 0);
        o1 = __builtin_amdgcn_mfma_f32_32x32x16_bf16(pa0, ATT_VF(1, 0), o1, 0, 0, 0);
        o0 = __builtin_amdgcn_mfma_f32_32x32x16_bf16(pa1, ATT_VF(0, 1), o0, 0, 0, 0);
        o1 = __builtin_amdgcn_mfma_f32_32x32x16_bf16(pa1, ATT_VF(1, 1), o1, 0, 0, 0);
        o0 = __builtin_amdgcn_mfma_f32_32x32x16_bf16(pa2, ATT_VF(0, 2), o0, 0, 0, 0);
        o1 = __builtin_amdgcn_mfma_f32_32x32x16_bf16(pa2, ATT_VF(1, 2), o1, 0, 0, 0);
        o0 = __builtin_amdgcn_mfma_f32_32x32x16_bf16(pa3, ATT_VF(0, 3), o0, 0, 0, 0);
        o1 = __builtin_amdgcn_mfma_f32_32x32x16_bf16(pa3, ATT_VF(1, 3), o1, 0, 0, 0);
#undef ATT_VF
    }
#undef ATT_DMA
    const float lt = swapsum(lsum);
    asm volatile("s_waitcnt lgkmcnt(0)" ::: "memory");
    if (hi == 0) wsf[r32] = 1.0f / lt;
    asm volatile("s_waitcnt lgkmcnt(0)" ::: "memory");
    PG8_LAS float* stg = (PG8_LAS float*)(lds + L_OST) + wid * (32 * OST_LD);
#pragma unroll
    for (int r = 0; r < 16; ++r) { const int orow = crow(r, hi); const float il = wsf[orow]; stg[orow * OST_LD + r32] = o0[r] * il; stg[orow * OST_LD + 32 + r32] = o1[r] * il; }
    asm volatile("s_waitcnt lgkmcnt(0)" ::: "memory");
    const float* gain = a.in[18] + l * 512 + h * HD;
    bf16_t* MIX = (bf16_t*)(a.ws + WS_MIX);
#pragma unroll
    for (int i = 0; i < 4; ++i) {
        const int row = i * 8 + (lane >> 3), ch = lane & 7;
        const pg8::f32x4 va = *(PG8_LAS const pg8::f32x4*)(stg + row * OST_LD + ch * 8), vb = *(PG8_LAS const pg8::f32x4*)(stg + row * OST_LD + ch * 8 + 4);
        float ss = va[0] * va[0] + va[1] * va[1] + va[2] * va[2] + va[3] * va[3] + vb[0] * vb[0] + vb[1] * vb[1] + vb[2] * vb[2] + vb[3] * vb[3];
        ss += SC_DPP(ss, 0xB1); ss += SC_DPP(ss, 0x4E); ss += SC_DPP(ss, 0x141);
        const float rs = rsqrtf(ss * (1.0f / 64.0f) + 1e-6f);
        const pg8::f32x4 ga = *(const pg8::f32x4*)(gain + ch * 8), gb = *(const pg8::f32x4*)(gain + ch * 8 + 4);
        pg8::u32x4 w; w.x = pk2(va[0] * rs * ga[0], va[1] * rs * ga[1]); w.y = pk2(va[2] * rs * ga[2], va[3] * rs * ga[3]);
        w.z = pk2(vb[0] * rs * gb[0], vb[1] * rs * gb[1]); w.w = pk2(vb[2] * rs * gb[2], vb[3] * rs * gb[3]);
        *(pg8::u32x4*)(MIX + ((size_t)b * SEQ + cur * 256 + wid * 32 + row) * DM + h * HD + ch * 8) = w;
    }
}
}

__device__ __forceinline__ void phase_att(const Args& a, int l, PG8_LAS unsigned char* lds) {
    const int G = gridDim.x, bx = blockIdx.x;
    const int v = (G % 8 == 0) ? (bx % 8) * (G / 8) + bx / 8 : bx;
    for (int w = v; w < 256; w += G) {
        const int bh = w >> 2, s = w & 3;
        att::unit(a, l, bh >> 3, bh & 7, 7 - s, lds);
        att::unit(a, l, bh >> 3, bh & 7, s, lds);
    }
}

__device__ __forceinline__ void phase_dense_res(const void* A, const void* WT, const float* RES, float* OUT, PG8_LAS unsigned char* lds) {
    pg8::DenseSched S; S.init(A, DM, NTOK, WT, DM, DM);
    pg8::EpiF32Res E{OUT, RES, DM, ALPHA};
    pg8::gemm_phase<pg8::EpiF32Res, pg8::DenseSched, false>(lds, pg8::Dims{DM, DM, DM}, S, E);
}
__device__ __forceinline__ void phase_dense_bf16(const void* A, int M, const void* WT, int N, bf16_t* OUT, PG8_LAS unsigned char* lds) {
    pg8::DenseSched S; S.init(A, DM, M, WT, DM, N);
    pg8::EpiBf16 E{OUT, N};
    pg8::gemm_phase<pg8::EpiBf16, pg8::DenseSched, false>(lds, pg8::Dims{DM, DM, DM}, S, E);
}

__device__ __forceinline__ void ln_row(const float* in, const float* g, const float* bta, float* out, bf16_t* outb, int lane, float (&xn)[16]) {
    float x[16];
#pragma unroll
    for (int m = 0; m < 4; ++m) { const float4 v = *(const float4*)(in + m * 256 + lane * 4); x[m * 4] = v.x; x[m * 4 + 1] = v.y; x[m * 4 + 2] = v.z; x[m * 4 + 3] = v.w; }
    float s = 0.f;
#pragma unroll
    for (int k = 0; k < 16; ++k) s += x[k];
    const float mean = wsum(s) * (1.0f / 1024.0f);
    float q = 0.f;
#pragma unroll
    for (int k = 0; k < 16; ++k) { const float d = x[k] - mean; q = fmaf(d, d, q); }
    const float var = wsum(q) * (1.0f / 1024.0f);
    const float rstd = rsqrtf(var + 1e-5f);
#pragma unroll
    for (int m = 0; m < 4; ++m) {
        const float4 gv = *(const float4*)(g + m * 256 + lane * 4), bv = *(const float4*)(bta + m * 256 + lane * 4);
        float4 o;
        o.x = (x[m * 4] - mean) * rstd * gv.x + bv.x; o.y = (x[m * 4 + 1] - mean) * rstd * gv.y + bv.y;
        o.z = (x[m * 4 + 2] - mean) * rstd * gv.z + bv.z; o.w = (x[m * 4 + 3] - mean) * rstd * gv.w + bv.w;
        xn[m * 4] = o.x; xn[m * 4 + 1] = o.y; xn[m * 4 + 2] = o.z; xn[m * 4 + 3] = o.w;
        *(float4*)(out + m * 256 + lane * 4) = o;
        uint2 ob; ob.x = pk2(o.x, o.y); ob.y = pk2(o.z, o.w); *(uint2*)(outb + m * 256 + lane * 4) = ob;
    }
}
__device__ __forceinline__ void phase_ln(const float* IN, const float* g, const float* bta, float* OUT, bf16_t* OUTB) {
    const int tid = tid_fresh(), lane = tid & 63, wid = tid >> 6;
    for (int row = blockIdx.x * 8 + wid; row < NTOK; row += gridDim.x * 8) {
        float xn[16];
        ln_row(IN + (size_t)row * DM, g, bta, OUT + (size_t)row * DM, OUTB + (size_t)row * DM, lane, xn);
    }
}

__device__ __forceinline__ float treduce32(float (&p)[32], int lane) {
    float q[16], r[8], s4[4], t2[2];
#pragma unroll
    for (int i = 0; i < 16; ++i) { auto sw = __builtin_amdgcn_permlane32_swap(__float_as_uint(p[i]), __float_as_uint(p[i + 16]), false, false); q[i] = __uint_as_float(sw[0]) + __uint_as_float(sw[1]); }
    const bool L4 = (lane & 16) != 0, L3 = (lane & 8) != 0, L2 = (lane & 4) != 0, L1 = (lane & 2) != 0;
#pragma unroll
    for (int i = 0; i < 8; ++i) { const float snd = L4 ? q[i] : q[i + 8], keep = L4 ? q[i + 8] : q[i]; r[i] = keep + __shfl_xor(snd, 16); }
#pragma unroll
    for (int i = 0; i < 4; ++i) { const float snd = L3 ? r[i] : r[i + 4], keep = L3 ? r[i + 4] : r[i]; s4[i] = keep + SC_DPP(snd, 0x140); }
#pragma unroll
    for (int i = 0; i < 2; ++i) { const float snd = L2 ? s4[i] : s4[i + 2], keep = L2 ? s4[i + 2] : s4[i]; t2[i] = keep + SC_DPP(snd, 0x141); }
    const float snd = L1 ? t2[0] : t2[1], keep = L1 ? t2[1] : t2[0];
    float u = keep + SC_DPP(snd, 0x4E);
    u += SC_DPP(u, 0xB1);
    return __shfl(u, (lane & 31) * 2);
}
struct RouteRes { int e0, e1; float g0, g1; };
__device__ __forceinline__ RouteRes route_row(float mylogit, int lane, const float* BR) {
    const float s = sigmoidf_(mylogit);
    const float sel = (lane < 32) ? s + BR[lane & 31] : NEG_INF;
    const int gb = lane & ~3;
    const float v0 = __shfl(sel, gb), v1 = __shfl(sel, gb + 1), v2 = __shfl(sel, gb + 2), v3 = __shfl(sel, gb + 3);
    const float m1 = fmaxf(fmaxf(v0, v1), fmaxf(v2, v3));
    float m2;
    { const float lo01 = fminf(v0, v1), hi01 = fmaxf(v0, v1), lo23 = fminf(v2, v3), hi23 = fmaxf(v2, v3);
      m2 = fmaxf(fminf(hi01, hi23), fmaxf(lo01, lo23)); }
    float gs = (lane < 32) ? (m1 + m2) : NEG_INF;
    int gi = lane >> 2;
#pragma unroll
    for (int o = 32; o > 0; o >>= 1) { const float ov = __shfl_xor(gs, o); const int oi = __shfl_xor(gi, o); if (ov > gs || (ov == gs && oi < gi)) { gs = ov; gi = oi; } }
    const int gbest = gi;
    const float c0 = __shfl(sel, gbest * 4), c1 = __shfl(sel, gbest * 4 + 1), c2 = __shfl(sel, gbest * 4 + 2), c3 = __shfl(sel, gbest * 4 + 3);
    int j0 = 0; float b0 = c0;
    if (c1 > b0) { b0 = c1; j0 = 1; } if (c2 > b0) { b0 = c2; j0 = 2; } if (c3 > b0) { b0 = c3; j0 = 3; }
    int j1 = -1; float b1 = -3e38f;
    if (j0 != 0 && c0 > b1) { b1 = c0; j1 = 0; } if (j0 != 1 && c1 > b1) { b1 = c1; j1 = 1; } if (j0 != 2 && c2 > b1) { b1 = c2; j1 = 2; } if (j0 != 3 && c3 > b1) { b1 = c3; j1 = 3; }
    RouteRes R; R.e0 = gbest * 4 + j0; R.e1 = gbest * 4 + j1;
    const float s0 = __shfl(s, R.e0), s1 = __shfl(s, R.e1);
    const float inv = 1.0f / (s0 + s1);
    R.g0 = s0 * inv; R.g1 = s1 * inv;
    return R;
}
__device__ __forceinline__ void phase_ln2_router(const Args& a, int l, float* lds, bool dummy = false) {
    const int tid = tid_fresh(), lane = tid & 63, wid = tid >> 6;
    const float* PRE = (const float*)(a.ws + WS_PRE2);
    float* X2 = (float*)(a.ws + WS_X2); bf16_t* X2B = (bf16_t*)(a.ws + WS_X2B);
    const float* g = a.in[28] + (size_t)(l * 3 + 1) * DM; const float* bta = a.in[29] + (size_t)(l * 3 + 1) * DM;
    const float* WR = a.in[23]; const float* BR = a.in[24];
    unsigned* cnt = (unsigned*)(a.ws + WS_CTL) + CW_CNT + l * 32 + (dummy ? 128 : 0);
    int2* list = (int2*)(a.ws + (dummy ? WS_H : WS_LIST));
    int2* tokpos = (int2*)(a.ws + (dummy ? WS_H + 8 * MiB : WS_TOKPOS));
    float2* tokgate = (float2*)(a.ws + (dummy ? WS_H + 9 * MiB : WS_TOKGATE));
    constexpr int WR_LD = DM + 4;
    unsigned* lcnt = (unsigned*)(lds + NEXP * WR_LD);
    int* lres = (int*)(lds + NEXP * WR_LD + 64);
    __syncthreads();
    for (int idx = tid; idx < DM * NEXP; idx += NTHREADS) { const int k = idx >> 5, e = idx & 31; lds[e * WR_LD + k] = WR[idx]; }
    if (tid < 64) lcnt[tid] = 0u;
    __syncthreads();
    int nloc = 0;
    for (int row = (blockIdx.x * 8 + wid) * 2; row < NTOK; row += gridDim.x * 16) {
        float xa[16], xb[16];
        ln_row(PRE + (size_t)row * DM, g, bta, X2 + (size_t)row * DM, X2B + (size_t)row * DM, lane, xa);
        ln_row(PRE + (size_t)(row + 1) * DM, g, bta, X2 + (size_t)(row + 1) * DM, X2B + (size_t)(row + 1) * DM, lane, xb);
        float pa[32], pb[32];
#pragma unroll
        for (int e = 0; e < NEXP; ++e) {
            float sa_ = 0.f, sb_ = 0.f;
#pragma unroll
            for (int m = 0; m < 4; ++m) { const float4 wv = *(const float4*)&lds[e * WR_LD + m * 256 + lane * 4];
                sa_ = fmaf(xa[m * 4], wv.x, sa_); sa_ = fmaf(xa[m * 4 + 1], wv.y, sa_); sa_ = fmaf(xa[m * 4 + 2], wv.z, sa_); sa_ = fmaf(xa[m * 4 + 3], wv.w, sa_);
                sb_ = fmaf(xb[m * 4], wv.x, sb_); sb_ = fmaf(xb[m * 4 + 1], wv.y, sb_); sb_ = fmaf(xb[m * 4 + 2], wv.z, sb_); sb_ = fmaf(xb[m * 4 + 3], wv.w, sb_); }
            pa[e] = sa_; pb[e] = sb_;
        }
        const float la = treduce32(pa, lane), lb = treduce32(pb, lane);
#pragma unroll
        for (int q = 0; q < 2; ++q) {
            const RouteRes R = route_row(q ? lb : la, lane, BR);
            if (lane == 0) {
                const unsigned r0 = atomicAdd(&lcnt[R.e0], 1u), r1 = atomicAdd(&lcnt[R.e1], 1u);
                int* o = lres + (wid * 32 + nloc + q) * 8;
                o[0] = row + q; o[1] = R.e0; o[2] = R.e1; o[3] = (int)r0; o[4] = (int)r1; o[5] = __float_as_int(R.g0); o[6] = __float_as_int(R.g1);
            }
        }
        nloc += 2;
    }
    __syncthreads();
    if (tid < 32) lcnt[32 + tid] = atomicAdd(&cnt[tid], lcnt[tid]);
    __syncthreads();
    for (int i = lane; i < nloc; i += 64) {
        const int* o = lres + (wid * 32 + i) * 8;
        const int row = o[0], e0 = o[1], e1 = o[2]; const unsigned r0 = lcnt[32 + e0] + (unsigned)o[3], r1 = lcnt[32 + e1] + (unsigned)o[4];
        list[(size_t)e0 * LCAP + r0] = make_int2(row, o[5]);
        list[(size_t)e1 * LCAP + r1] = make_int2(row, o[6]);
        tokpos[row * 2] = make_int2(e0, (int)r0); tokpos[row * 2 + 1] = make_int2(e1, (int)r1);
        tokgate[row] = make_float2(__int_as_float(o[5]), __int_as_float(o[6]));
    }
}

constexpr int ZERO_ROW = 32768 / 2048;
struct I2 { int x, y; };
struct MoeSched {
    int G, c, T, npn; PG8_LAS I2* tab;
    const char* A; const char* B; size_t b_e, b_pn, a_tile; int colw;
    const int2* list; int gat_row0;
    __device__ void init(PG8_LAS unsigned char* lds, const unsigned* cnt, int npn_, const void* A_, size_t a_tile_, const void* B_, size_t b_e_, size_t b_pn_, int colw_, const int2* list_, int gat_row0_) {
        const int lane = tid_fresh() & 63, x = lane & 31;
        G = gridDim.x; c = blockIdx.x; npn = npn_; A = (const char*)A_; a_tile = a_tile_; B = (const char*)B_; b_e = b_e_; b_pn = b_pn_; colw = colw_; list = list_; gat_row0 = gat_row0_;
        const unsigned cnt_l = __hip_atomic_load(cnt + x, __ATOMIC_RELAXED, __HIP_MEMORY_SCOPE_AGENT);
        const int tiles = (int)((cnt_l + 255u) >> 8);
        int inc = tiles;
#pragma unroll
        for (int o = 1; o < 32; o <<= 1) { const int t = __shfl_up(inc, o, 32); if (x >= o) inc += t; }
        tab = (PG8_LAS I2*)(lds + pg8::STAGE_BYTES + 8192);
        tab[x].x = (int)cnt_l; tab[x].y = inc - tiles;
        T = __builtin_amdgcn_readfirstlane(__shfl(inc, 31));
        __syncthreads();
    }
    __device__ __forceinline__ bool next(int i, pg8::Unit& u) const {
        const long L = (long)i * G + c; if (L >= (long)T * npn) return false;
        const int ti = (int)(L / npn), pn = (int)(L % npn);
        const int my_excl = tab[__builtin_amdgcn_mbcnt_lo(~0u, 0u) & 31].y;
        const unsigned long long m = __ballot(my_excl <= ti) & 0xffffffffull;
        const int e = __popcll(m) - 1;
        const int rt = ti - tab[e].y;
        const unsigned ce = (unsigned)tab[e].x;
        u.aux = __builtin_amdgcn_readfirstlane(e | (rt << 8)); u.aux2 = __builtin_amdgcn_readfirstlane((int)ce);
        u.row0 = ti * 256; u.col0 = pn * colw;
        u.A = A + (size_t)ti * a_tile; u.B = B + (size_t)e * b_e + (size_t)pn * b_pn;
        return true;
    }
    __device__ __forceinline__ int arow(const pg8::Unit& u, int r) const {
        const int e = u.aux & 255, rank = (u.aux >> 8) * 256 + r;
        return rank < u.aux2 ? gat_row0 + list[(size_t)e * LCAP + rank].x : ZERO_ROW;
    }
};
struct EpiSwiGLU {
    static constexpr bool PERM = true;
    bf16_t* H;
    __device__ __forceinline__ void operator()(const pg8::f32x4 (&acc)[2][2][4][2], const pg8::Unit& u, int wr, int wc, int fr, int fq) const {
        const int col = u.col0 + wc * 32 + 8 * fq;
#pragma unroll
        for (int ai = 0; ai < 2; ++ai)
#pragma unroll
            for (int m = 0; m < 4; ++m) {
                const int r = wr * 64 + fr + ai * 128 + m * 16;
                float hv[8];
#pragma unroll
                for (int n = 0; n < 2; ++n)
#pragma unroll
                    for (int j = 0; j < 4; ++j) { const float g = acc[ai][0][m][n][j], up = acc[ai][1][m][n][j]; hv[n * 4 + j] = g * up * __builtin_amdgcn_rcpf(1.0f + __expf(-g)); }
                pg8::u32x4 w; w.x = pk2(hv[0], hv[1]); w.y = pk2(hv[2], hv[3]); w.z = pk2(hv[4], hv[5]); w.w = pk2(hv[6], hv[7]);
                *(pg8::u32x4*)(H + (size_t)(u.row0 + r) * DEXP + col) = w;
            }
    }
};
__device__ __forceinline__ void phase_f3(const Args& a, int l, PG8_LAS unsigned char* lds) {
    const unsigned* cnt = (const unsigned*)(a.ws + WS_CTL) + CW_CNT + l * 32;
    const int2* list = (const int2*)(a.ws + WS_LIST);
    MoeSched S; S.init(lds, cnt, 4, a.ws, 0, a.ws + WS_WEXP, (size_t)1024 * 1024 * 2, (size_t)256 * 1024 * 2, 128, list, (int)(WS_X2B / 2048));
    EpiSwiGLU E{(bf16_t*)(a.ws + WS_H)};
    pg8::gemm_phase<EpiSwiGLU, MoeSched, true>(lds, pg8::Dims{DM, DM, DM}, S, E);
}
__device__ __forceinline__ void phase_f4(const Args& a, int l, PG8_LAS unsigned char* lds) {
    const unsigned* cnt = (const unsigned*)(a.ws + WS_CTL) + CW_CNT + l * 32;
    MoeSched S; S.init(lds, cnt, 4, a.ws + WS_H, (size_t)256 * DEXP * 2, a.ws + WS_WEXP + (size_t)NEXP * 1024 * 1024 * 2, (size_t)1024 * 512 * 2, (size_t)256 * 512 * 2, 256, nullptr, 0);
    pg8::EpiBf16 E{(bf16_t*)(a.ws + WS_Y), DM};
    pg8::gemm_phase<pg8::EpiBf16, MoeSched, false>(lds, pg8::Dims{DEXP, DEXP, DEXP}, S, E);
}
__device__ __forceinline__ void phase_ln3(const Args& a, int l, float* OUT, bf16_t* OUTB) {
    const int tid = tid_fresh(), lane = tid & 63, wid = tid >> 6;
    const unsigned* cnt = (const unsigned*)(a.ws + WS_CTL) + CW_CNT + l * 32;
    const int2* tokpos = (const int2*)(a.ws + WS_TOKPOS);
    const float* X2 = (const float*)(a.ws + WS_X2); const bf16_t* Y = (const bf16_t*)(a.ws + WS_Y);
    const float* g = a.in[28] + (size_t)(l * 3 + 2) * DM; const float* bta = a.in[29] + (size_t)(l * 3 + 2) * DM;
    int mybase = 0;
    { int acc = 0; for (int x = 0; x < NEXP; ++x) { if (x == lane) mybase = acc; acc += (int)((cnt[x] + 255u) >> 8); } }
    for (int row = blockIdx.x * 8 + wid; row < NTOK; row += gridDim.x * 8) {
        const int2 p0 = tokpos[row * 2], p1 = tokpos[row * 2 + 1]; const float2 tg = ((const float2*)(a.ws + WS_TOKGATE))[row];
        const size_t h0 = (size_t)__shfl(mybase, p0.x) * 256 + p0.y, h1 = (size_t)__shfl(mybase, p1.x) * 256 + p1.y;
        const float* xr = X2 + (size_t)row * DM; const bf16_t* y0 = Y + h0 * DM; const bf16_t* y1 = Y + h1 * DM;
        float x[16];
#pragma unroll
        for (int m = 0; m < 4; ++m) { const int o = m * 256 + lane * 4; const float4 xv = *(const float4*)(xr + o); const uint2 a0 = *(const uint2*)(y0 + o), a1 = *(const uint2*)(y1 + o);
            x[m * 4] = fmaf(ALPHA, xv.x, fmaf(tg.x, bflo(a0.x), tg.y * bflo(a1.x))); x[m * 4 + 1] = fmaf(ALPHA, xv.y, fmaf(tg.x, bfhi(a0.x), tg.y * bfhi(a1.x)));
            x[m * 4 + 2] = fmaf(ALPHA, xv.z, fmaf(tg.x, bflo(a0.y), tg.y * bflo(a1.y))); x[m * 4 + 3] = fmaf(ALPHA, xv.w, fmaf(tg.x, bfhi(a0.y), tg.y * bfhi(a1.y))); }
        float s = 0.f;
#pragma unroll
        for (int k = 0; k < 16; ++k) s += x[k];
        const float mean = wsum(s) * (1.0f / 1024.0f);
        float q = 0.f;
#pragma unroll
        for (int k = 0; k < 16; ++k) { const float d = x[k] - mean; q = fmaf(d, d, q); }
        const float rstd = rsqrtf(wsum(q) * (1.0f / 1024.0f) + 1e-5f);
#pragma unroll
        for (int m = 0; m < 4; ++m) { const int o = m * 256 + lane * 4; const float4 gv = *(const float4*)(g + o), bv = *(const float4*)(bta + o); float4 r;
            r.x = (x[m * 4] - mean) * rstd * gv.x + bv.x; r.y = (x[m * 4 + 1] - mean) * rstd * gv.y + bv.y; r.z = (x[m * 4 + 2] - mean) * rstd * gv.z + bv.z; r.w = (x[m * 4 + 3] - mean) * rstd * gv.w + bv.w;
            *(float4*)(OUT + (size_t)row * DM + o) = r;
            if (OUTB) { uint2 ob; ob.x = pk2(r.x, r.y); ob.y = pk2(r.z, r.w); *(uint2*)(OUTB + (size_t)row * DM + o) = ob; } }
    }
}

constexpr int PH_PER_LAYER = 14, N_PHASES = 1 + 2 * PH_PER_LAYER;

__global__ void __launch_bounds__(NTHREADS, 2) mk_fwd(Args a) {
    extern __shared__ __attribute__((aligned(16))) unsigned char smem[];
    float* lds = (float*)smem;
    PG8_LAS unsigned char* lds3 = (PG8_LAS unsigned char*)smem;
    volatile LAS unsigned* xbw = (volatile LAS unsigned*)(smem + LDS_BYTES - 16);
    const int lo = a.ph_lo, hi = a.ph_hi;
    unsigned* ctl = (unsigned*)(a.ws + WS_CTL);
    XcdBarrier bar; bar.bar = ctl + CW_BAR; bar.x = 0; bar.st = xbw;
    if (hi - lo > 1) {
        if (threadIdx.x == 0) { xbw[0] = 0u; xbw[1] = 0u; }
        __syncthreads();
        bar = xcd_barrier_post(ctl + CW_BAR, xbw);
    }
#define IN(k) (lo <= (k) && (k) < hi)
#define SEAM(k) do { if (IN(k) && IN((k) + 1)) xcd_barrier(bar); } while (0)
    if (IN(0)) { phase_prologue(a, lds); if (PROBE_REP == 99) { xcd_barrier(bar); phase_prologue(a, lds); } }
    SEAM(0);
#define LAYER_BODY(l) do { \
        const int p0 = 1 + l * PH_PER_LAYER; \
        const float* xin = (l == 0) ? a.in[0] : (const float*)(a.ws + WS_XL1); \
        float* xout = (l == 0) ? (float*)(a.ws + WS_XL1) : a.out; \
        if (IN(p0 + 0)) { phase_g1(a, l, lds3); if (PROBE_REP == 0) { xcd_barrier(bar); phase_g1(a, l, lds3); } } \
        SEAM(p0 + 0); \
        if (IN(p0 + 1)) { phase_prep(a, l, lds); if (PROBE_REP == 1) { xcd_barrier(bar); phase_prep(a, l, lds); } } \
        SEAM(p0 + 1); \
        if (IN(p0 + 2)) { phase_scan(a, l, lds3); if (PROBE_REP == 2) { xcd_barrier(bar); phase_scan(a, l, lds3); } } \
        SEAM(p0 + 2); \
        if (IN(p0 + 3)) { { phase_post(a, l); phase_att(a, l, lds3); } if (PROBE_REP == 3) { xcd_barrier(bar); { phase_post(a, l); phase_att(a, l, lds3); } } } \
        SEAM(p0 + 3); \
        if (IN(p0 + 4)) { phase_dense_res(a.ws + WS_MIX, a.ws + WS_WOUT + (size_t)l * 2 * MiB, xin, (float*)(a.ws + WS_PRE), lds3); if (PROBE_REP == 4) { xcd_barrier(bar); phase_dense_res(a.ws + WS_MIX, a.ws + WS_WOUT + (size_t)l * 2 * MiB, xin, (float*)(a.ws + WS_PRE), lds3); } } \
        SEAM(p0 + 4); \
        if (IN(p0 + 5)) { phase_ln((const float*)(a.ws + WS_PRE), a.in[28] + (size_t)(l * 3) * DM, a.in[29] + (size_t)(l * 3) * DM, (float*)(a.ws + WS_X1), (bf16_t*)(a.ws + WS_X1B)); if (PROBE_REP == 5) { xcd_barrier(bar); phase_ln((const float*)(a.ws + WS_PRE), a.in[28] + (size_t)(l * 3) * DM, a.in[29] + (size_t)(l * 3) * DM, (float*)(a.ws + WS_X1), (bf16_t*)(a.ws + WS_X1B)); } } \
        SEAM(p0 + 5); \
        if (IN(p0 + 6)) { phase_dense_bf16(a.ws + WS_X1B, NTOK, a.ws + WS_WQ + (size_t)l * 2 * MiB, DM, (bf16_t*)(a.ws + WS_Q), lds3); if (PROBE_REP == 6) { xcd_barrier(bar); phase_dense_bf16(a.ws + WS_X1B, NTOK, a.ws + WS_WQ + (size_t)l * 2 * MiB, DM, (bf16_t*)(a.ws + WS_Q), lds3); } } \
        SEAM(p0 + 6); \
        if (IN(p0 + 7)) { phase_matt_s(a, lds3); if (PROBE_REP == 7) { xcd_barrier(bar); phase_matt_s(a, lds3); } } \
        SEAM(p0 + 7); \
        if (IN(p0 + 8)) { phase_matt_pv(a, lds3); if (PROBE_REP == 8) { xcd_barrier(bar); phase_matt_pv(a, lds3); } } \
        SEAM(p0 + 8); \
        if (IN(p0 + 9)) { phase_dense_res(a.ws + WS_O, a.ws + WS_WO + (size_t)l * 2 * MiB, (const float*)(a.ws + WS_X1), (float*)(a.ws + WS_PRE2), lds3); if (PROBE_REP == 9) { xcd_barrier(bar); phase_dense_res(a.ws + WS_O, a.ws + WS_WO + (size_t)l * 2 * MiB, (const float*)(a.ws + WS_X1), (float*)(a.ws + WS_PRE2), lds3); } } \
        SEAM(p0 + 9); \
        if (IN(p0 + 10)) { phase_ln2_router(a, l, lds); if (PROBE_REP == 10) { xcd_barrier(bar); phase_ln2_router(a, l, lds, true); } } \
        SEAM(p0 + 10); \
        if (IN(p0 + 11)) { phase_f3(a, l, lds3); if (PROBE_REP == 11) { xcd_barrier(bar); phase_f3(a, l, lds3); } } \
        SEAM(p0 + 11); \
        if (IN(p0 + 12)) { phase_f4(a, l, lds3); if (PROBE_REP == 12) { xcd_barrier(bar); phase_f4(a, l, lds3); } } \
        SEAM(p0 + 12); \
        if (IN(p0 + 13)) { { phase_ln3(a, l, xout, (l == 0) ? (bf16_t*)(a.ws + WS_XB) : (bf16_t*)nullptr); if (l == 0) convert_experts(a, 1, lds); } if (PROBE_REP == 13) { xcd_barrier(bar); { phase_ln3(a, l, xout, (l == 0) ? (bf16_t*)(a.ws + WS_XB) : (bf16_t*)nullptr); if (l == 0) convert_experts(a, 1, lds); } } } \
        SEAM(p0 + 13); \
    } while (0)
    LAYER_BODY(0);
    LAYER_BODY(1);
}
}

extern "C" void kernel_launch(void* const* d_in, const int* in_sizes, int n_in, void* d_out, int out_size, void* d_ws, size_t ws_size, hipStream_t stream) {
    static int grid = 0;
    if (!grid) {
        int dev = 0, cus = 0, per_cu = 0;
        (void)hipGetDevice(&dev);
        (void)hipDeviceGetAttribute(&cus, hipDeviceAttributeMultiprocessorCount, dev);
        (void)hipFuncSetAttribute((const void*)mk_fwd, hipFuncAttributeMaxDynamicSharedMemorySize, LDS_BYTES);
        (void)hipOccupancyMaxActiveBlocksPerMultiprocessor(&per_cu, mk_fwd, NTHREADS, LDS_BYTES);
        (void)hipGetLastError();
        grid = cus * 1;
        if (grid < 65) grid = 256;
    }
    if (ws_size < WS_END) return;
    (void)hipMemsetAsync(d_ws, 0, CTL_ZERO_BYTES, stream);
    Args a;
    memset(&a, 0, sizeof(a));
    for (int i = 0; i < 30; ++i) a.in[i] = (const float*)d_in[i];
    a.out = (float*)d_out; a.ws = (unsigned char*)d_ws;
#if MK_ONE_LAUNCH
    a.ph_lo = 0; a.ph_hi = N_PHASES;
    hipLaunchKernelGGL(mk_fwd, dim3(grid), dim3(NTHREADS), LDS_BYTES, stream, a);
#else
    for (int p = 0; p < N_PHASES; ++p) {
        a.ph_lo = p; a.ph_hi = p + 1;
        hipLaunchKernelGGL(mk_fwd, dim3(grid), dim3(NTHREADS), LDS_BYTES, stream, a);
    }
#endif
}
```

```cpp
#include <hip/hip_runtime.h>
#include <stdint.h>
#include <cstring>

#ifndef PROBE_REP
#define PROBE_REP -1
#endif
#ifndef MK_ONE_LAUNCH
#define MK_ONE_LAUNCH 1
#endif

namespace {
constexpr int NTHREADS = 512;
constexpr int NTOK = 16384, SEQ = 2048, NBATCH = 8, DM = 1024;
constexpr int MEMLEN = 256;
constexpr int NH = 8, HD = 64;
constexpr int IN_COLS = 3328, ZLD = 3584;
constexpr int C_Q = 0, C_K = 512, C_V = 1024, C_R = 1536, C_KR = 2048, C_VR = 2560, C_ZW = 3072, C_ZA = 3136, C_ZG = 3200, C_ZV = 3328;
constexpr int NEXP = 32, DEXP = 512;
constexpr int LCAP = 16384;
constexpr float ALPHA = 1.4142135623730951f;
constexpr float NEG_INF = -1e30f;
constexpr int LDS_BYTES = 147456;

typedef unsigned short bf16_t;
typedef float f32x2_t __attribute__((ext_vector_type(2)));
typedef __bf16 bf16x2_t __attribute__((ext_vector_type(2)));
__device__ __forceinline__ unsigned pk2(float lo, float hi) { f32x2_t v = {lo, hi}; bf16x2_t b = __builtin_convertvector(v, bf16x2_t); return __builtin_bit_cast(unsigned, b); }
__device__ __forceinline__ bf16_t f2bf(float f) { return (bf16_t)(pk2(f, 0.f) & 0xffffu); }
__device__ __forceinline__ float bf2f(bf16_t h) { return __uint_as_float((unsigned)h << 16); }
__device__ __forceinline__ float bflo(unsigned u) { return __uint_as_float(u << 16); }
__device__ __forceinline__ float bfhi(unsigned u) { return __uint_as_float(u & 0xffff0000u); }

constexpr size_t MiB = 1u << 20;
constexpr size_t WS_CTL = 0, CTL_ZERO_BYTES = 64 * 1024;
constexpr size_t WS_LIST = 2 * MiB;
constexpr size_t WS_KB = 6 * MiB;
constexpr size_t WS_TOKPOS = 10 * MiB;
constexpr size_t WS_TOKGATE = 10 * MiB + 512 * 1024;
constexpr size_t WS_KMEAN = 11 * MiB;
constexpr size_t WS_MEMB = 12 * MiB;
constexpr size_t WS_VT = 16 * MiB;
constexpr size_t WS_WIN0 = 24 * MiB, WS_WIN1 = 31 * MiB;
constexpr size_t WS_WOUT = 38 * MiB, WS_WQ = 42 * MiB, WS_WKV = 46 * MiB, WS_WO = 54 * MiB;
constexpr size_t WS_WEXP = 58 * MiB;
constexpr size_t WS_XL1 = 154 * MiB, WS_XB = 218 * MiB, WS_VFIRST = 250 * MiB;
constexpr size_t WS_Z = 266 * MiB, WS_MIX = 378 * MiB, WS_R3 = 410 * MiB, WS_END = 508 * MiB;
constexpr int REC_TG = 644;
constexpr size_t WS_REC = 410 * MiB;
constexpr size_t WS_YRAW = 492 * MiB;
constexpr size_t WS_RVT = 218 * MiB, WS_RG = 234 * MiB;
constexpr size_t WS_BON = 20 * MiB;
constexpr size_t WS_LORA = 22 * MiB;
constexpr size_t LORA_L = 512 * 288 * 2, LORA_I = 512 * 64 * 2, LORA_G = 2 * 512 * 64 * 2, LORA_V = LORA_G + 512 * 128 * 2;
constexpr size_t WS_LSUM = 21 * MiB;
constexpr size_t WS_P = 298 * MiB;
constexpr size_t WS_PRE = 266 * MiB, WS_X1 = 410 * MiB, WS_X1B = 474 * MiB;
constexpr size_t WS_Q = 330 * MiB, WS_KV = 362 * MiB, WS_O = 266 * MiB, WS_PRE2 = 330 * MiB;
constexpr size_t WS_X2 = 410 * MiB, WS_X2B = 474 * MiB;
constexpr size_t WS_H = 266 * MiB, WS_Y = 306 * MiB;

constexpr int CW_CNT = 0;
constexpr int CW_BAR = 1024;

#define XB_TMO      128
#define XB_XCNT(j)  (256  + 64 * (j))
#define XB_XSUB(j)  (1280 + 64 * (j))
#define XB_XGEN(j)  (2304 + 64 * (j))
#define XB_TOP      3328
#define XB_TOPGEN   3392
#define XCD_BAR_WORDS 3456
#define XB_SPIN_CAP (1u << 18)
#define LAS __attribute__((address_space(3)))
__device__ __forceinline__ unsigned xb_ld(unsigned* p)              { return __hip_atomic_load(p, __ATOMIC_RELAXED, __HIP_MEMORY_SCOPE_AGENT); }
__device__ __forceinline__ unsigned xb_add(unsigned* p, unsigned v) { return __hip_atomic_fetch_add(p, v, __ATOMIC_RELAXED, __HIP_MEMORY_SCOPE_AGENT); }
__device__ __forceinline__ unsigned xb_xcc_id() { return (unsigned)__builtin_amdgcn_s_getreg((3 << 11) | 20) & 0xFu; }
#define XB_SPIN(cond, bar) do { unsigned _sp = 0; while (cond) { __builtin_amdgcn_s_sleep(1); \
    if ((++_sp & 255u) == 0u) { if (xb_ld(&(bar)[XB_TMO])) break; if (_sp > XB_SPIN_CAP) { atomicAdd(&(bar)[XB_TMO], 1u); break; } } } } while (0)
struct XcdBarrier { unsigned* bar; unsigned x; volatile LAS unsigned* st; };
__device__ __forceinline__ XcdBarrier xcd_barrier_post(unsigned* bar, volatile LAS unsigned* st) {
    XcdBarrier b; b.bar = bar; b.x = xb_xcc_id(); b.st = st;
    if (threadIdx.x == 0) (void)xb_add(&bar[XB_XCNT(b.x)], 1u);
    return b;
}
__device__ __forceinline__ void xcd_barrier_complete(unsigned* bar, unsigned x, unsigned& nloc, unsigned& nx) {
    const unsigned G = gridDim.x * gridDim.y * gridDim.z;
    unsigned sum, cnt, mine, sp = 0u;
    for (;;) {
        sum = 0u; cnt = 0u; mine = 0u;
#pragma unroll
        for (unsigned j = 0; j < 16; ++j) { const unsigned c = xb_ld(&bar[XB_XCNT(j)]); sum += c; cnt += (c > 0u) ? 1u : 0u; mine = (j == x) ? c : mine; }
        if (sum == G) break;
        __builtin_amdgcn_s_sleep(1);
        if ((++sp & 255u) == 0u) { if (xb_ld(&bar[XB_TMO])) break; if (sp > XB_SPIN_CAP) { atomicAdd(&bar[XB_TMO], 1u); break; } }
    }
    nloc = mine > 0u ? mine : 1u; nx = cnt > 0u ? cnt : 1u;
}
__device__ __forceinline__ void xcd_barrier(const XcdBarrier& b) {
    asm volatile("s_waitcnt vmcnt(0)" ::: "memory");
    __syncthreads();
    if (threadIdx.x == 0) {
        unsigned* bar = b.bar;
        __builtin_amdgcn_s_waitcnt(0);
        unsigned nloc = b.st[0], nx = b.st[1];
        if (nloc == 0u) { xcd_barrier_complete(bar, b.x, nloc, nx); b.st[0] = nloc; b.st[1] = nx; }
        const unsigned old = xb_add(&bar[XB_XSUB(b.x)], 1u);
        const unsigned gen = old / nloc;
        if (old + 1u == (gen + 1u) * nloc) {
            __builtin_amdgcn_fence(__ATOMIC_RELEASE, "agent");
            asm volatile("s_waitcnt vmcnt(0)" ::: "memory");
            const unsigned og = xb_add(&bar[XB_TOP], 1u);
            const unsigned tg = og / nx;
            if (og + 1u == (tg + 1u) * nx) xb_add(&bar[XB_TOPGEN], 1u);
            else XB_SPIN(xb_ld(&bar[XB_TOPGEN]) == tg, bar);
            __builtin_amdgcn_fence(__ATOMIC_ACQUIRE, "agent");
            xb_add(&bar[XB_XGEN(b.x)], 1u);
            asm volatile("s_waitcnt vmcnt(0)" ::: "memory");
        } else {
            XB_SPIN(xb_ld(&bar[XB_XGEN(b.x)]) == gen, bar);
            __builtin_amdgcn_fence(__ATOMIC_ACQUIRE, "agent");
            asm volatile("s_waitcnt vmcnt(0)" ::: "memory");
        }
    }
    __syncthreads();
}

__device__ __forceinline__ int tid_fresh() { int t = threadIdx.x; asm volatile("" : "+v"(t)); return t; }
__device__ __forceinline__ float wsum(float v) {
#pragma unroll
    for (int o = 32; o > 0; o >>= 1) v += __shfl_xor(v, o);
    return v;
}
__device__ __forceinline__ float wmax(float v) {
#pragma unroll
    for (int o = 32; o > 0; o >>= 1) v = fmaxf(v, __shfl_xor(v, o));
    return v;
}
__device__ __forceinline__ float sigmoidf_(float x) { return 1.0f / (1.0f + __expf(-x)); }
__device__ __forceinline__ float softplusf_(float x) { return x > 20.f ? x : log1pf(__expf(x)); }

struct Args {
    const float* in[30];
    float* out;
    unsigned char* ws;
    int ph_lo, ph_hi;
};

namespace pg8 {
#define PG8_LAS __attribute__((address_space(3)))
typedef short bf16x8 __attribute__((ext_vector_type(8)));
typedef float f32x4 __attribute__((ext_vector_type(4)));
typedef unsigned u32x4 __attribute__((ext_vector_type(4)));
constexpr int BM = 256, BK = 64, HALF = 128, HTB = HALF * BK * 2, STAGE_BYTES = 8 * HTB, NXCD = 8, WGM = 8;

__host__ __device__ __forceinline__ int lds_byte(int r, int c) { const int st = (r >> 4) * 2 + (c >> 5), rr = r & 15, cc = c & 31, ob = rr * 64 + cc * 2; return st * 1024 + (ob ^ (((ob >> 9) & 1) << 5)); }
__host__ __device__ __forceinline__ void stage_rc(int b, int& R, int& C) { const int st = b / 1024, sb = b % 1024, swz = sb ^ (((sb >> 9) & 1) << 5); R = (st >> 1) * 16 + swz / 64; C = (st & 1) * 32 + (swz % 64) / 2; }
__host__ __device__ __forceinline__ int perm32(int rho) { const int n = rho >> 4, i = rho & 15; return 8 * (i >> 2) + 4 * n + (i & 3); }

struct Unit { const char* A; const char* B; int row0, col0, aux, aux2; };
struct Dims { int lda, ldb, K; };

struct TileOrder {
    int nM, nN, nwg, G, c;
    __device__ void init(int nM_, int nN_, int G_, int c_) { nM = nM_; nN = nN_; nwg = nM * nN; G = G_; c = c_; }
    __device__ bool tile(int i, int& pm, int& pn) const {
        const long L = (long)i * G + c; if (L >= nwg) return false;
        int wgid = (int)L; { const int q = nwg / NXCD, r = nwg % NXCD, xcd = wgid % NXCD, off = wgid / NXCD; wgid = (xcd < r ? xcd * (q + 1) : r * (q + 1) + (xcd - r) * q) + off; }
        const int nig = WGM * nN, gid = wgid / nig, fm = gid * WGM, gsz = (nM - fm) < WGM ? (nM - fm) : WGM;
        pm = fm + ((wgid % nig) % gsz); pn = (wgid % nig) / gsz; return true;
    }
};
struct DenseSched {
    TileOrder o; const char* A; const char* B; int lda, ldb;
    __device__ void init(const void* A_, int lda_, int M, const void* B_, int ldb_, int N) { A = (const char*)A_; B = (const char*)B_; lda = lda_; ldb = ldb_; o.init(M / BM, N / BM, gridDim.x, blockIdx.x); }
    __device__ __forceinline__ bool next(int i, Unit& u) const { int pm, pn; if (!o.tile(i, pm, pn)) return false;
        u.A = A + (size_t)pm * BM * lda * 2; u.B = B + (size_t)pn * BM * ldb * 2; u.row0 = pm * BM; u.col0 = pn * BM; u.aux = 0; u.aux2 = 0; return true; }
    __device__ __forceinline__ int arow(const Unit&, int r) const { return r; }
};

__device__ __forceinline__ unsigned cvt_pk_bf16(float lo, float hi) { unsigned r; asm volatile("v_cvt_pk_bf16_f32 %0, %1, %2" : "=v"(r) : "v"(lo), "v"(hi)); return r; }

struct EpiBf16 {
    static constexpr bool PERM = true;
    bf16_t* O; int ldc;
    __device__ __forceinline__ void operator()(const f32x4 (&acc)[2][2][4][2], const Unit& u, int wr, int wc, int fr, int fq) const {
        const int row0 = u.row0 + wr * 64 + fr, col0 = u.col0 + wc * 32 + 8 * fq;
#pragma unroll
        for (int ai = 0; ai < 2; ++ai)
#pragma unroll
            for (int m = 0; m < 4; ++m) { bf16_t* rowp = O + (size_t)(row0 + ai * HALF + m * 16) * ldc + col0;
#pragma unroll
                for (int bj = 0; bj < 2; ++bj) { const f32x4 v0 = acc[ai][bj][m][0], v1 = acc[ai][bj][m][1];
                    u32x4 w; w.x = cvt_pk_bf16(v0[0], v0[1]); w.y = cvt_pk_bf16(v0[2], v0[3]); w.z = cvt_pk_bf16(v1[0], v1[1]); w.w = cvt_pk_bf16(v1[2], v1[3]);
                    *(u32x4*)(rowp + bj * HALF) = w; } }
    }
};
struct EpiF32Res {
    static constexpr bool PERM = false;
    float* C; const float* RES; int ldc; float rs;
    __device__ __forceinline__ void operator()(const f32x4 (&acc)[2][2][4][2], const Unit& u, int wr, int wc, int fr, int fq) const {
        const int row0 = u.row0 + wr * 64 + fr, col0 = u.col0 + wc * 32 + 4 * fq;
#pragma unroll
        for (int ai = 0; ai < 2; ++ai)
#pragma unroll
            for (int m = 0; m < 4; ++m) { const size_t ro = (size_t)(row0 + ai * HALF + m * 16) * ldc + col0;
#pragma unroll
                for (int bj = 0; bj < 2; ++bj)
#pragma unroll
                    for (int n = 0; n < 2; ++n) { const f32x4 r = *(const f32x4*)(RES + ro + bj * HALF + n * 16); *(f32x4*)(C + ro + bj * HALF + n * 16) = acc[ai][bj][m][n] + r * rs; } }
    }
};

__device__ __forceinline__ void store_bf16_tile(const f32x4 (&acc)[2][2][4][2], bf16_t* O, int ldc, int row0, int col0) {
#pragma unroll
    for (int ai = 0; ai < 2; ++ai)
#pragma unroll
        for (int m = 0; m < 4; ++m) { bf16_t* rowp = O + (size_t)(row0 + ai * HALF + m * 16) * ldc + col0;
#pragma unroll
            for (int bj = 0; bj < 2; ++bj) { const f32x4 v0 = acc[ai][bj][m][0], v1 = acc[ai][bj][m][1];
                u32x4 w; w.x = cvt_pk_bf16(v0[0], v0[1]); w.y = cvt_pk_bf16(v0[2], v0[3]); w.z = cvt_pk_bf16(v1[0], v1[1]); w.w = cvt_pk_bf16(v1[2], v1[3]);
                *(u32x4*)(rowp + bj * HALF) = w; } }
}
struct EpiG1 {
    static constexpr bool PERM = true;
    bf16_t* Z; bf16_t* KB; bf16_t* VT;
    __device__ __forceinline__ void operator()(const f32x4 (&acc)[2][2][4][2], const Unit& u, int wr, int wc, int fr, int fq) const {
        bf16_t* O = Z; int ldc = ZLD;
        if (u.aux == 1) { O = KB; ldc = 1024; } else if (u.aux >= 2) { O = VT + (size_t)(u.aux - 2) * 1024 * 256; ldc = 256; }
        store_bf16_tile(acc, O, ldc, u.row0 + wr * 64 + fr, u.col0 + wc * 32 + 8 * fq);
    }
};
struct EpiSoftmax {
    static constexpr bool PERM = true;
    bf16_t* P; float* LSUM; PG8_LAS float* xmax;
    __device__ __forceinline__ void operator()(const f32x4 (&acc)[2][2][4][2], const Unit& u, int wr, int wc, int fr, int fq) const {
        const float c = 0.0625f * 1.4426950408889634f;
#pragma unroll
        for (int ai = 0; ai < 2; ++ai)
#pragma unroll
            for (int m = 0; m < 4; ++m) {
                float mx = acc[ai][0][m][0][0];
#pragma unroll
                for (int bj = 0; bj < 2; ++bj)
#pragma unroll
                    for (int n = 0; n < 2; ++n)
#pragma unroll
                        for (int j = 0; j < 4; ++j) mx = fmaxf(mx, acc[ai][bj][m][n][j]);
                mx = fmaxf(mx, __shfl_xor(mx, 16)); mx = fmaxf(mx, __shfl_xor(mx, 32));
                if (fq == 0) xmax[wc * 256 + wr * 64 + fr + ai * 128 + m * 16] = mx;
            }
        asm volatile("s_waitcnt lgkmcnt(0)" ::: "memory"); __builtin_amdgcn_s_barrier(); asm volatile("" ::: "memory");
        const int hm = u.col0 >> 8;
#pragma unroll
        for (int ai = 0; ai < 2; ++ai)
#pragma unroll
            for (int m = 0; m < 4; ++m) {
                int r = wr * 64 + fr + ai * 128 + m * 16; asm volatile("" : "+v"(r) :: "memory");
                const float M = fmaxf(fmaxf(xmax[r], xmax[256 + r]), fmaxf(xmax[512 + r], xmax[768 + r]));
                float sum = 0.f; bf16_t* rowp = P + (size_t)(u.row0 + r) * 1024 + u.col0 + wc * 32 + 8 * fq;
#pragma unroll
                for (int bj = 0; bj < 2; ++bj) {
                    float e[8];
#pragma unroll
                    for (int n = 0; n < 2; ++n)
#pragma unroll
                        for (int j = 0; j < 4; ++j) { e[n * 4 + j] = __builtin_amdgcn_exp2f((acc[ai][bj][m][n][j] - M) * c); sum += e[n * 4 + j]; }
                    u32x4 w; w.x = pk2(e[0], e[1]); w.y = pk2(e[2], e[3]); w.z = pk2(e[4], e[5]); w.w = pk2(e[6], e[7]);
                    *(u32x4*)(rowp + bj * HALF) = w;
                }
                sum += __shfl_xor(sum, 16); sum += __shfl_xor(sum, 32);
                if (fq == 0) LSUM[((size_t)(u.row0 + r) * 4 + hm) * 4 + wc] = sum;
            }
        asm volatile("s_waitcnt lgkmcnt(0)" ::: "memory"); __builtin_amdgcn_s_barrier(); asm volatile("" ::: "memory");
    }
};
struct EpiPV {
    static constexpr bool PERM = true;
    bf16_t* O; const float* LSUM;
    __device__ __forceinline__ void operator()(const f32x4 (&acc)[2][2][4][2], const Unit& u, int wr, int wc, int fr, int fq) const {
        const int hm = u.col0 >> 8;
#pragma unroll
        for (int ai = 0; ai < 2; ++ai)
#pragma unroll
            for (int m = 0; m < 4; ++m) {
                int row = u.row0 + wr * 64 + fr + ai * 128 + m * 16; asm volatile("" : "+v"(row) :: "memory");
                const f32x4 ls = *(const f32x4*)(LSUM + ((size_t)row * 4 + hm) * 4);
                const float inv = 1.0f / ((ls[0] + ls[1]) + (ls[2] + ls[3]));
                bf16_t* rowp = O + (size_t)row * 1024 + u.col0 + wc * 32 + 8 * fq;
#pragma unroll
                for (int bj = 0; bj < 2; ++bj) { const f32x4 v0 = acc[ai][bj][m][0] * inv, v1 = acc[ai][bj][m][1] * inv;
                    u32x4 w; w.x = cvt_pk_bf16(v0[0], v0[1]); w.y = cvt_pk_bf16(v0[2], v0[3]); w.z = cvt_pk_bf16(v1[0], v1[1]); w.w = cvt_pk_bf16(v1[2], v1[3]);
                    *(u32x4*)(rowp + bj * HALF) = w; }
            }
    }
};
struct G1Sched {
    TileOrder o; const char *XB, *WIN, *MEMB, *WKV;
    __device__ void init(const void* XB_, const void* WIN_, int nN, const void* MEMB_, const void* WKV_) { XB = (const char*)XB_; WIN = (const char*)WIN_; MEMB = (const char*)MEMB_; WKV = (const char*)WKV_; o.init(64, nN, gridDim.x, blockIdx.x); }
    __device__ __forceinline__ bool next(int i, Unit& u) const {
        int pm, pn; u.aux2 = 0;
        if (o.tile(i, pm, pn)) { u.A = XB + (size_t)pm * BM * 2048; u.B = WIN + (size_t)pn * BM * 2048; u.row0 = pm * BM; u.col0 = pn * BM; u.aux = 0; return true; }
        const long L = (long)i * o.G + o.c - o.nwg;
        if (L >= 64) return false;
        if (L < 32) { pm = (int)L >> 2; pn = (int)L & 3; u.A = MEMB + (size_t)pm * BM * 2048; u.B = WKV + (size_t)pn * BM * 2048; u.row0 = pm * BM; u.col0 = pn * BM; u.aux = 1; return true; }
        const int b = ((int)L - 32) >> 2; pm = ((int)L - 32) & 3;
        u.A = WKV + (size_t)(1024 + pm * BM) * 2048; u.B = MEMB + (size_t)b * BM * 2048; u.row0 = pm * BM; u.col0 = 0; u.aux = 2 + b; return true;
    }
    __device__ __forceinline__ int arow(const Unit&, int r) const { return r; }
};
struct MattSched {
    int G, c; const char* A; const char* B; size_t b_batch; int b_head;
    __device__ void init(const void* A_, const void* B_, size_t b_batch_, int b_head_) { G = gridDim.x; c = blockIdx.x; A = (const char*)A_; B = (const char*)B_; b_batch = b_batch_; b_head = b_head_; }
    __device__ __forceinline__ bool next(int i, Unit& u) const {
        const long L = (long)i * G + c; if (L >= 256) return false;
        const int pm = (int)L >> 2, hm = (int)L & 3;
        u.A = A + ((size_t)pm * BM * 1024 + hm * 256) * 2; u.B = B + (size_t)(pm >> 3) * b_batch + (size_t)hm * b_head;
        u.row0 = pm * BM; u.col0 = hm * 256; u.aux = 0; u.aux2 = 0; return true;
    }
    __device__ __forceinline__ int arow(const Unit&, int r) const { return r; }
};

template <class Epi, class Sched, bool GATHER>
__device__ __forceinline__ void gemm_phase(PG8_LAS unsigned char* lds, const Dims g, const Sched& S, const Epi& E) {
    const int tid = tid_fresh(), wid = __builtin_amdgcn_readfirstlane(tid >> 6), wr = wid >> 2, wc = wid & 3;
    const int K = g.K, nt = K / BK;
    unsigned voffB[2];
#pragma unroll
    for (int i = 0; i < 2; ++i) { int R, C; stage_rc(tid * 16 + i * 8192, R, C); const int Rb = Epi::PERM ? ((R & ~31) + perm32(R & 31)) : R;
        voffB[i] = (unsigned)(Rb * g.ldb + C) * 2u; }
    const size_t kstep = (size_t)(BK * 2);
    const size_t hstepB = (size_t)HALF * g.ldb * 2;
    const unsigned ldsw = (unsigned)wid * 1024u;
    const int aoff = lds_byte(wr * 64 + (tid & 15), ((tid & 63) >> 4) * 8), boff = lds_byte(wc * 32 + (tid & 15), ((tid & 63) >> 4) * 8);
    const size_t hstepA = GATHER ? 0 : (size_t)HALF * g.lda * 2;
#define PG8_SA(b, h) (((b) * 2 + (h)) * HTB)
#define PG8_SB(b, h) ((4 + (b) * 2 + (h)) * HTB)
#define PG8_STAGE(bufoff, gbase, v0, v1) do { \
        __builtin_amdgcn_global_load_lds((const unsigned*)((const char*)(gbase) + (v0)), (PG8_LAS unsigned*)(lds + (bufoff) + ldsw), 16, 0, 0); \
        __builtin_amdgcn_global_load_lds((const unsigned*)((const char*)(gbase) + (v1)), (PG8_LAS unsigned*)(lds + (bufoff) + ldsw + 8192), 16, 0, 0); } while (0)
#define PG8_STAGEB(bufoff, gbase) PG8_STAGE(bufoff, gbase, voffB[0], voffB[1])
#define PG8_LDA(dst, b, h) do { _Pragma("unroll") for (int m = 0; m < 4; ++m) _Pragma("unroll") for (int k = 0; k < 2; ++k) dst[m][k] = *(const PG8_LAS bf16x8*)(lds + PG8_SA(b, h) + aoff + m * 2048 + k * 1024); } while (0)
#define PG8_LDB(dst, b, h) do { _Pragma("unroll") for (int n = 0; n < 2; ++n) _Pragma("unroll") for (int k = 0; k < 2; ++k) dst[n][k] = *(const PG8_LAS bf16x8*)(lds + PG8_SB(b, h) + boff + n * 2048 + k * 1024); } while (0)
#define PG8_MMA(ai, bj, At, Bt) do { __builtin_amdgcn_s_setprio(1); _Pragma("unroll") for (int m = 0; m < 4; ++m) _Pragma("unroll") for (int n = 0; n < 2; ++n) _Pragma("unroll") for (int k = 0; k < 2; ++k) \
        acc[ai][bj][m][n] = __builtin_amdgcn_mfma_f32_16x16x32_bf16(Bt[n][k], At[m][k], acc[ai][bj][m][n], 0, 0, 0); __builtin_amdgcn_s_setprio(0); } while (0)
#define PG8_WAIT_V(n) asm volatile("s_waitcnt vmcnt(" #n ")" ::: "memory")
#define PG8_WAIT_L(n) asm volatile("s_waitcnt lgkmcnt(" #n ")" ::: "memory")
#define PG8_BAR __builtin_amdgcn_s_barrier()
#define PG8_SCHED __builtin_amdgcn_sched_barrier(0)
#define PG8_VOFFA(dst, u) do { _Pragma("unroll") for (int i_ = 0; i_ < 2; ++i_) { int R_, C_; stage_rc(tid * 16 + i_ * 8192, R_, C_); _Pragma("unroll") for (int h_ = 0; h_ < 2; ++h_) { \
        const int rr_ = GATHER ? S.arow(u, R_ + h_ * HALF) : R_; dst[h_ * 2 + i_] = (unsigned)(rr_ * g.lda + C_) * 2u; } } } while (0)
    Unit cur, nxt; int ui = 0;
    if (!S.next(0, cur)) return;
    f32x4 acc[2][2][4][2];
#pragma unroll
    for (int a = 0; a < 2; ++a)
#pragma unroll
        for (int b = 0; b < 2; ++b)
#pragma unroll
            for (int m = 0; m < 4; ++m)
#pragma unroll
                for (int n = 0; n < 2; ++n) acc[a][b][m][n] = (f32x4){0.f, 0.f, 0.f, 0.f};
    bf16x8 At[4][2], B0[2][2], B1[2][2];
    unsigned vC[4];
    PG8_VOFFA(vC, cur);
    PG8_LAS u32x4* myN = (PG8_LAS u32x4*)(lds + STAGE_BYTES + tid * 16);
    const char* cA = cur.A; const char* cB = cur.B;
    PG8_STAGEB(PG8_SB(0, 0), cB); PG8_STAGEB(PG8_SB(0, 1), cB + hstepB); PG8_STAGE(PG8_SA(0, 0), cA, vC[0], vC[1]); PG8_STAGE(PG8_SA(0, 1), cA + hstepA, vC[2], vC[3]);
    if (wr == 1) PG8_BAR;
    PG8_WAIT_V(2); PG8_BAR;
    PG8_STAGEB(PG8_SB(1, 0), cB + kstep); PG8_STAGE(PG8_SA(1, 0), cA + kstep, vC[0], vC[1]); PG8_STAGEB(PG8_SB(1, 1), cB + hstepB + kstep);
    PG8_WAIT_V(6); PG8_BAR;
    for (;;) {
        const bool has_next = S.next(ui + 1, nxt);
        const char* nA = cA; const char* nB = cB;
        { unsigned vT[4];
#pragma unroll
          for (int q = 0; q < 4; ++q) vT[q] = vC[q];
          if (has_next) { nA = nxt.A; nB = nxt.B; PG8_VOFFA(vT, nxt); }
          *myN = (u32x4){vT[0], vT[1], vT[2], vT[3]}; }
#pragma unroll 1
        for (int t = 0; t < nt; t += 2) {
            const bool last = (t == nt - 2);
            const char* a1 = cA + (size_t)(t + 1) * kstep;
            const char* a2 = last ? nA : cA + (size_t)(t + 2) * kstep; const char* b2 = last ? nB : cB + (size_t)(t + 2) * kstep;
            const char* a3 = a2 + kstep; const char* b3 = b2 + kstep;
            PG8_LDB(B0, 0, 0); PG8_LDB(B1, 0, 1); PG8_SCHED; PG8_LDA(At, 0, 0); PG8_STAGE(PG8_SA(1, 1), a1 + hstepA, vC[2], vC[3]);
            if (last) { const u32x4 vn = *myN; vC[0] = vn.x; vC[1] = vn.y; vC[2] = vn.z; vC[3] = vn.w; }
            PG8_WAIT_V(8); PG8_WAIT_L(0); PG8_BAR; PG8_MMA(0, 0, At, B0); PG8_MMA(0, 1, At, B1); PG8_BAR; PG8_SCHED;
            PG8_LDA(At, 0, 1); PG8_STAGEB(PG8_SB(0, 0), b2); PG8_STAGEB(PG8_SB(0, 1), b2 + hstepB); PG8_STAGE(PG8_SA(0, 0), a2, vC[0], vC[1]);
            PG8_WAIT_V(8); PG8_WAIT_L(0); PG8_BAR; PG8_MMA(1, 0, At, B0); PG8_MMA(1, 1, At, B1); PG8_BAR; PG8_SCHED;
            PG8_LDB(B0, 1, 0); PG8_LDB(B1, 1, 1); PG8_SCHED; PG8_LDA(At, 1, 0); PG8_STAGE(PG8_SA(0, 1), a2 + hstepA, vC[2], vC[3]);
            PG8_WAIT_V(8); PG8_WAIT_L(0); PG8_BAR; PG8_MMA(0, 0, At, B0); PG8_MMA(0, 1, At, B1); PG8_BAR; PG8_SCHED;
            PG8_LDA(At, 1, 1); PG8_STAGEB(PG8_SB(1, 0), b3); PG8_STAGEB(PG8_SB(1, 1), b3 + hstepB); PG8_STAGE(PG8_SA(1, 0), a3, vC[0], vC[1]);
            PG8_WAIT_V(8); PG8_WAIT_L(0); PG8_BAR; PG8_MMA(1, 0, At, B0); PG8_MMA(1, 1, At, B1); PG8_BAR; PG8_SCHED;
        }
        if (wr == 0) PG8_BAR;
        { int ln_ = (int)__builtin_amdgcn_mbcnt_hi(~0u, __builtin_amdgcn_mbcnt_lo(~0u, 0u)); asm volatile("" : "+v"(ln_));
          E(acc, cur, wr, wc, ln_ & 15, ln_ >> 4); }
        if (!has_next) break;
#pragma unroll
        for (int a = 0; a < 2; ++a)
#pragma unroll
            for (int b = 0; b < 2; ++b)
#pragma unroll
                for (int m = 0; m < 4; ++m)
#pragma unroll
                    for (int n = 0; n < 2; ++n) acc[a][b][m][n] = (f32x4){0.f, 0.f, 0.f, 0.f};
        cur = nxt; cA = nA; cB = nB; ++ui;
        if (wr == 1) PG8_BAR;
    }
    PG8_WAIT_V(0);
    PG8_BAR;
#undef PG8_SA
#undef PG8_SB
#undef PG8_STAGE
#undef PG8_STAGEB
#undef PG8_LDA
#undef PG8_LDB
#undef PG8_MMA
#undef PG8_WAIT_V
#undef PG8_WAIT_L
#undef PG8_BAR
#undef PG8_SCHED
#undef PG8_VOFFA
}
}

template <int NBM, class AF, class Epi>
__device__ __forceinline__ void sgemm_tile(float* lds, int K, AF arow, const float* __restrict__ B0, const float* __restrict__ B1, int ldb, int n0, int N, Epi epi) {
    const int tid = tid_fresh();
    float* As = lds;
    float* Bs0 = lds + 16 * 132;
    float* Bs1 = lds + 2 * 16 * 132;
    const int ty = tid >> 5, tx = tid & 31;
    float acc0[8][4], acc1[8][4];
#pragma unroll
    for (int i = 0; i < 8; ++i)
#pragma unroll
        for (int j = 0; j < 4; ++j) { acc0[i][j] = 0.f; acc1[i][j] = 0.f; }
    const int ar = tid >> 2, ak = (tid & 3) * 4;
    const float* ap = arow(ar);
    const int bk = tid >> 5, bn = (tid & 31) * 4;
    const bool bok = (n0 + bn) < N;
    for (int k0 = 0; k0 < K; k0 += 16) {
        float4 av = ap ? *(const float4*)(ap + k0 + ak) : make_float4(0.f, 0.f, 0.f, 0.f);
        float4 bv0 = bok ? *(const float4*)(B0 + (size_t)(k0 + bk) * ldb + n0 + bn) : make_float4(0.f, 0.f, 0.f, 0.f);
        float4 bv1 = make_float4(0.f, 0.f, 0.f, 0.f);
        if (NBM == 2) { if (bok) bv1 = *(const float4*)(B1 + (size_t)(k0 + bk) * ldb + n0 + bn); }
        __syncthreads();
        As[(ak + 0) * 132 + ar] = av.x; As[(ak + 1) * 132 + ar] = av.y; As[(ak + 2) * 132 + ar] = av.z; As[(ak + 3) * 132 + ar] = av.w;
        *(float4*)&Bs0[bk * 132 + bn] = bv0;
        if (NBM == 2) *(float4*)&Bs1[bk * 132 + bn] = bv1;
        __syncthreads();
#pragma unroll 2
        for (int k = 0; k < 16; ++k) {
            const float4 a0 = *(const float4*)&As[k * 132 + ty * 8], a1 = *(const float4*)&As[k * 132 + ty * 8 + 4];
            const float a[8] = {a0.x, a0.y, a0.z, a0.w, a1.x, a1.y, a1.z, a1.w};
            const float4 b0 = *(const float4*)&Bs0[k * 132 + tx * 4];
            const float bb0[4] = {b0.x, b0.y, b0.z, b0.w};
#pragma unroll
            for (int i = 0; i < 8; ++i)
#pragma unroll
                for (int j = 0; j < 4; ++j) acc0[i][j] = fmaf(a[i], bb0[j], acc0[i][j]);
            if (NBM == 2) {
                const float4 b1 = *(const float4*)&Bs1[k * 132 + tx * 4];
                const float bb1[4] = {b1.x, b1.y, b1.z, b1.w};
#pragma unroll
                for (int i = 0; i < 8; ++i)
#pragma unroll
                    for (int j = 0; j < 4; ++j) acc1[i][j] = fmaf(a[i], bb1[j], acc1[i][j]);
            }
        }
    }
    if (bok) {
#pragma unroll
        for (int i = 0; i < 8; ++i)
#pragma unroll
            for (int j = 0; j < 4; ++j) epi(ty * 8 + i, tx * 4 + j, acc0[i][j], acc1[i][j]);
    }
}

__device__ __forceinline__ void transpose_blk(const float* W, int N, bf16_t* WT, int K, int k0, int n0, int drow0, float* scr, int lane) {
    const int kr = lane >> 3, n4 = (lane & 7) * 4;
    float4 v[8];
#pragma unroll
    for (int i = 0; i < 8; ++i) v[i] = *(const float4*)(W + (size_t)(k0 + i * 8 + kr) * N + n0 + n4);
#pragma unroll
    for (int i = 0; i < 8; ++i) { float* d = scr + (i * 8 + kr) * 33 + n4; d[0] = v[i].x; d[1] = v[i].y; d[2] = v[i].z; d[3] = v[i].w; }
    asm volatile("s_waitcnt lgkmcnt(0)" ::: "memory");
    const int c = lane & 7;
#pragma unroll
    for (int j = 0; j < 4; ++j) { const int n = (lane >> 3) + 8 * j; const float* sp = scr + (8 * c) * 33 + n;
        uint4 o; o.x = pk2(sp[0 * 33], sp[1 * 33]); o.y = pk2(sp[2 * 33], sp[3 * 33]); o.z = pk2(sp[4 * 33], sp[5 * 33]); o.w = pk2(sp[6 * 33], sp[7 * 33]);
        *(uint4*)(WT + (size_t)(drow0 + n) * K + k0 + 8 * c) = o; }
    asm volatile("s_waitcnt lgkmcnt(0)" ::: "memory");
}
__device__ __forceinline__ void transpose_item(const float* W, int K, int N, bf16_t* WT, int row_off, float* scr, int item, int lane) {
    const int nblk = N / 32, kb = item / nblk, nb = item % nblk;
    transpose_blk(W, N, WT, K, 64 * kb, 32 * nb, row_off + 32 * nb, scr, lane);
}
struct CvtItem { const float* W; bf16_t* WT; int N, K, k0, n0, drow0; };
__device__ __forceinline__ bool cvt_decode(const Args& a, int l, int it, CvtItem& c) {
    if (it >= NEXP * 768) return false;
    bf16_t* WGU = (bf16_t*)(a.ws + WS_WEXP); bf16_t* WD = WGU + (size_t)NEXP * 1024 * 1024;
    const int e = it / 768; int r = it % 768;
    if (r < 512) {
        const bool up = r >= 256; r &= 255; const int kb = r >> 4, nb = r & 15, n0 = 32 * nb;
        c.W = (up ? a.in[26] : a.in[25]) + ((size_t)l * NEXP + e) * DM * DEXP; c.N = DEXP; c.WT = WGU + (size_t)e * 1024 * 1024; c.K = DM; c.k0 = 64 * kb; c.n0 = n0; c.drow0 = 256 * (n0 >> 7) + (n0 & 127) + (up ? 128 : 0);
    } else {
        r -= 512; const int kb = r >> 5, nb = r & 31;
        c.W = a.in[27] + ((size_t)l * NEXP + e) * DEXP * DM; c.N = DM; c.WT = WD + (size_t)e * 1024 * 512; c.K = DEXP; c.k0 = 64 * kb; c.n0 = 32 * nb; c.drow0 = 32 * nb;
    }
    return true;
}
__device__ __forceinline__ void cvt_load(const CvtItem& c, int lane, float4 (&v)[8]) {
    const int kr = lane >> 3, n4 = (lane & 7) * 4;
#pragma unroll
    for (int i = 0; i < 8; ++i) v[i] = *(const float4*)(c.W + (size_t)(c.k0 + i * 8 + kr) * c.N + c.n0 + n4);
}
__device__ __forceinline__ void cvt_finish(const CvtItem& c, int lane, const float4 (&v)[8], float* scr) {
    const int kr = lane >> 3, n4 = (lane & 7) * 4;
#pragma unroll
    for (int i = 0; i < 8; ++i) { float* d = scr + (i * 8 + kr) * 33 + n4; d[0] = v[i].x; d[1] = v[i].y; d[2] = v[i].z; d[3] = v[i].w; }
    asm volatile("s_waitcnt lgkmcnt(0)" ::: "memory");
    const int cc = lane & 7;
#pragma unroll
    for (int j = 0; j < 4; ++j) { const int n = (lane >> 3) + 8 * j; const float* sp = scr + (8 * cc) * 33 + n;
        uint4 o; o.x = pk2(sp[0 * 33], sp[1 * 33]); o.y = pk2(sp[2 * 33], sp[3 * 33]); o.z = pk2(sp[4 * 33], sp[5 * 33]); o.w = pk2(sp[6 * 33], sp[7 * 33]);
        *(uint4*)(c.WT + (size_t)(c.drow0 + n) * c.K + c.k0 + 8 * cc) = o; }
    asm volatile("s_waitcnt lgkmcnt(0)" ::: "memory");
}
__device__ __forceinline__ void convert_experts(const Args& a, int l, float* lds) {
    const int tid = tid_fresh(), lane = tid & 63, wid = tid >> 6;
    float* scr = lds + wid * (64 * 33);
    const int gw = blockIdx.x * 8 + wid, NGW = gridDim.x * 8;
    bf16_t* WGU = (bf16_t*)(a.ws + WS_WEXP); bf16_t* WD = WGU + (size_t)NEXP * 1024 * 1024;
    for (int it = gw; it < NEXP * 768; it += NGW) {
        const int e = it / 768; int r = it % 768;
        if (r < 512) {
            const bool up = r >= 256; r &= 255; const int kb = r >> 4, nb = r & 15, n0 = 32 * nb;
            const float* W = (up ? a.in[26] : a.in[25]) + ((size_t)l * NEXP + e) * DM * DEXP;
            transpose_blk(W, DEXP, WGU + (size_t)e * 1024 * 1024, DM, 64 * kb, n0, 256 * (n0 >> 7) + (n0 & 127) + (up ? 128 : 0), scr, lane);
        } else {
            r -= 512; const int kb = r >> 5, nb = r & 31;
            const float* W = a.in[27] + ((size_t)l * NEXP + e) * DEXP * DM;
            transpose_blk(W, DM, WD + (size_t)e * 1024 * 512, DEXP, 64 * kb, 32 * nb, 32 * nb, scr, lane);
        }
    }
}
__device__ __forceinline__ void cvt_row(const float* in, bf16_t* out, int lane) {
#pragma unroll
    for (int j = 0; j < 4; ++j) { const float4 v = *(const float4*)(in + j * 256 + lane * 4); uint2 o; o.x = pk2(v.x, v.y); o.y = pk2(v.z, v.w); *(uint2*)(out + j * 256 + lane * 4) = o; }
}
__device__ __forceinline__ void phase_prologue(const Args& a, float* lds) {
    const int tid = tid_fresh(), lane = tid & 63, wid = tid >> 6;
    float* scr = lds + wid * (64 * 33);
    const int gw = blockIdx.x * 8 + wid, NGW = gridDim.x * 8;
    bf16_t* WIN0 = (bf16_t*)(a.ws + WS_WIN0); bf16_t* WIN1 = (bf16_t*)(a.ws + WS_WIN1);
    constexpr int I_IN = 16 * 104, I_VR = 16, I_SQ = 16 * 32, I_KV = 16 * 64;
    constexpr int NITEMS = 2 * I_IN + I_VR + 6 * I_SQ + 2 * I_KV;
    for (int it = gw; it < NITEMS; it += NGW) {
        int r = it;
        if (r < I_IN) { transpose_item(a.in[2], DM, IN_COLS, WIN0, 0, scr, r, lane); continue; } r -= I_IN;
        if (r < I_IN) { transpose_item(a.in[2] + (size_t)DM * IN_COLS, DM, IN_COLS, WIN1, 0, scr, r, lane); continue; } r -= I_IN;
        if (r < I_VR) { transpose_item(a.in[3], DM, 32, WIN1, IN_COLS, scr, r, lane); continue; } r -= I_VR;
        constexpr int I_L = 3 * I_SQ + I_KV;
        const int l = r / I_L; r -= l * I_L;
        if (r < I_SQ) { transpose_item(a.in[19] + (size_t)l * DM * DM, DM, DM, (bf16_t*)(a.ws + WS_WOUT) + (size_t)l * DM * DM, 0, scr, r, lane); continue; } r -= I_SQ;
        if (r < I_SQ) { transpose_item(a.in[20] + (size_t)l * DM * DM, DM, DM, (bf16_t*)(a.ws + WS_WQ) + (size_t)l * DM * DM, 0, scr, r, lane); continue; } r -= I_SQ;
        if (r < I_KV) { transpose_item(a.in[21] + (size_t)l * DM * 2048, DM, 2048, (bf16_t*)(a.ws + WS_WKV) + (size_t)l * DM * 2048, 0, scr, r, lane); continue; } r -= I_KV;
        transpose_item(a.in[22] + (size_t)l * DM * DM, DM, DM, (bf16_t*)(a.ws + WS_WO) + (size_t)l * DM * DM, 0, scr, r, lane);
    }
    for (int r = gw; r < 224; r += NGW) {
#pragma unroll
        for (int j = 0; j < 2; ++j) *(uint4*)(WIN1 + (size_t)(3360 + r) * DM + j * 512 + lane * 8) = make_uint4(0u, 0u, 0u, 0u);
    }
    bf16_t* XB = (bf16_t*)(a.ws + WS_XB); bf16_t* MEMB = (bf16_t*)(a.ws + WS_MEMB);
    for (int m = gw; m < NTOK; m += NGW) cvt_row(a.in[0] + (size_t)m * DM, XB + (size_t)m * DM, lane);
    for (int m = gw; m < NBATCH * MEMLEN; m += NGW) cvt_row(a.in[1] + (size_t)m * DM, MEMB + (size_t)m * DM, lane);
    {
        const int gt = blockIdx.x * NTHREADS + tid, NGT = gridDim.x * NTHREADS;
        for (int idx = gt; idx < 2 * 512 * 288; idx += NGT) {
            const int l = idx / (512 * 288); int r = idx % (512 * 288);
            bf16_t* base = (bf16_t*)(a.ws + WS_LORA + (size_t)l * LORA_L);
            if (r < 512 * 64) { const int n = r >> 6, k = r & 63; base[r] = f2bf(a.in[7][((size_t)l * 64 + k) * 512 + n]); continue; } r -= 512 * 64;
            if (r < 512 * 64) { const int n = r >> 6, k = r & 63; base[512 * 64 + r] = f2bf(a.in[9][((size_t)l * 64 + k) * 512 + n]); continue; } r -= 512 * 64;
            if (r < 512 * 128) { const int n = r >> 7, k = r & 127; base[2 * 512 * 64 + r] = f2bf(a.in[12][((size_t)l * 128 + k) * 512 + n]); continue; } r -= 512 * 128;
            { const int n = r >> 5, k = r & 31; base[2 * 512 * 64 + 512 * 128 + r] = f2bf(a.in[11][(size_t)k * 512 + n]); }
        }
    }
}

__device__ __forceinline__ void phase_g1(const Args& a, int l, PG8_LAS unsigned char* lds) {
    pg8::G1Sched S; S.init(a.ws + WS_XB, a.ws + (l == 0 ? WS_WIN0 : WS_WIN1), l == 0 ? IN_COLS / 256 : ZLD / 256, a.ws + WS_MEMB, a.ws + WS_WKV + (size_t)l * 4 * MiB);
    pg8::EpiG1 E{(bf16_t*)(a.ws + WS_Z), (bf16_t*)(a.ws + WS_KB), (bf16_t*)(a.ws + WS_VT)};
    pg8::gemm_phase<pg8::EpiG1, pg8::G1Sched, false>(lds, pg8::Dims{DM, DM, DM}, S, E);
}
__device__ __forceinline__ void phase_matt_s(const Args& a, PG8_LAS unsigned char* lds) {
    pg8::MattSched S; S.init(a.ws + WS_Q, a.ws + WS_KB, (size_t)256 * 1024 * 2, 256 * 2);
    pg8::EpiSoftmax E{(bf16_t*)(a.ws + WS_P), (float*)(a.ws + WS_LSUM), (PG8_LAS float*)(lds + pg8::STAGE_BYTES + 8192 + 512)};
    pg8::gemm_phase<pg8::EpiSoftmax, pg8::MattSched, false>(lds, pg8::Dims{1024, 1024, 256}, S, E);
}
__device__ __forceinline__ void phase_matt_pv(const Args& a, PG8_LAS unsigned char* lds) {
    pg8::MattSched S; S.init(a.ws + WS_P, a.ws + WS_VT, (size_t)1024 * 256 * 2, 256 * 256 * 2);
    pg8::EpiPV E{(bf16_t*)(a.ws + WS_O), (const float*)(a.ws + WS_LSUM)};
    pg8::gemm_phase<pg8::EpiPV, pg8::MattSched, false>(lds, pg8::Dims{1024, 256, 256}, S, E);
}

typedef _Float16 h8_t __attribute__((ext_vector_type(8)));
typedef _Float16 h2_t __attribute__((ext_vector_type(2)));
__device__ __forceinline__ unsigned pkh2(float lo, float hi) { h2_t v = {(_Float16)lo, (_Float16)hi}; return __builtin_bit_cast(unsigned, v); }
#define SC_DPP(x, ctrl) __int_as_float(__builtin_amdgcn_mov_dpp(__float_as_int(x), ctrl, 0xF, 0xF, true))
__device__ __forceinline__ float sum32(float x) {
    x += SC_DPP(x, 0xB1); x += SC_DPP(x, 0x4E); x += SC_DPP(x, 0x141); x += SC_DPP(x, 0x140);
    return x + __shfl_xor(x, 16);
}
__device__ __forceinline__ void phase_prep(const Args& a, int l, float* lds) {
    typedef short bf16x8 __attribute__((ext_vector_type(8)));
    typedef float f32x16 __attribute__((ext_vector_type(16)));
    const bf16_t* Z = (const bf16_t*)(a.ws + WS_Z);
    const int tid = tid_fresh(), lane = tid & 63, wid = tid >> 6;
    float* KM = (float*)(a.ws + WS_KMEAN);
    for (int u = blockIdx.x * 8 + wid; u < NBATCH * NH * 8; u += gridDim.x * 8) {
        const int nb = u & 7, h = (u >> 3) & 7, b = u >> 6, rg = lane >> 3, ch = lane & 7;
        const bf16_t* p = Z + (size_t)(b * SEQ + nb * 256 + rg) * ZLD + C_K + h * HD + ch * 8;
        float acc[8];
#pragma unroll
        for (int j = 0; j < 8; ++j) acc[j] = 0.f;
#pragma unroll 8
        for (int i = 0; i < 32; ++i) { const uint4 v = *(const uint4*)(p + (size_t)(i * 8) * ZLD);
            acc[0] += bflo(v.x); acc[1] += bfhi(v.x); acc[2] += bflo(v.y); acc[3] += bfhi(v.y); acc[4] += bflo(v.z); acc[5] += bfhi(v.z); acc[6] += bflo(v.w); acc[7] += bfhi(v.w); }
#pragma unroll
        for (int j = 0; j < 8; ++j) { float x = acc[j]; x += __shfl_xor(x, 8); x += __shfl_xor(x, 16); x += __shfl_xor(x, 32); acc[j] = x * (1.0f / 256.0f); }
        if (rg == 0) { *(float4*)(KM + (size_t)u * 64 + ch * 8) = make_float4(acc[0], acc[1], acc[2], acc[3]); *(float4*)(KM + (size_t)u * 64 + ch * 8 + 4) = make_float4(acc[4], acc[5], acc[6], acc[7]); }
    }
    const float* mu = a.in[4] + (size_t)l * 1792;
    const float* muv = a.in[5];
    const bf16_t* WdT = (const bf16_t*)(a.ws + WS_LORA + (size_t)l * LORA_L); const bf16_t* WiT = (const bf16_t*)(a.ws + WS_LORA + (size_t)l * LORA_L + LORA_I);
    const bf16_t* WgT = (const bf16_t*)(a.ws + WS_LORA + (size_t)l * LORA_L + LORA_G); const bf16_t* WvT = (const bf16_t*)(a.ws + WS_LORA + LORA_V);
    unsigned* REC = (unsigned*)(a.ws + WS_REC);
    _Float16* RVT = (_Float16*)(a.ws + WS_RVT); bf16_t* RGp = (bf16_t*)(a.ws + WS_RG); float* BON = (float*)(a.ws + WS_BON);
    bf16_t* VF = (bf16_t*)(a.ws + WS_VFIRST);
    uint4* afr = (uint4*)lds;
    for (int tb = blockIdx.x; tb < 512; tb += gridDim.x) {
        int lane_t = lane; asm volatile("" : "+v"(lane_t));
        const int r32 = lane_t & 31, hi = lane_t >> 5;
        const int h = wid, t0 = tb * 32, b = t0 / SEQ, tt0 = t0 % SEQ, bh = b * NH + h;
        const size_t tokA = (size_t)t0 + r32;
        const bool firstA = (tt0 == 0) && (r32 == 0);
        const size_t tokP = firstA ? tokA : tokA - 1;
        __syncthreads();
#pragma unroll
        for (int m = 0; m < 3; ++m) {
            const int idx = wid + 8 * m;
            if (idx < (l == 1 ? 18 : 16)) {
                int zcol; const float* mup; int act;
                if (idx < 8) { zcol = C_ZG + 16 * idx; mup = mu + (C_ZG - C_R) + 16 * idx; act = 2; }
                else if (idx < 12) { zcol = C_ZW + 16 * (idx - 8); mup = mu + (C_ZW - C_R) + 16 * (idx - 8); act = 1; }
                else if (idx < 16) { zcol = C_ZA + 16 * (idx - 12); mup = mu + (C_ZA - C_R) + 16 * (idx - 12); act = 0; }
                else { zcol = C_ZV + 16 * (idx - 16); mup = muv + 16 * (idx - 16); act = 0; }
                zcol += 8 * hi; mup += 8 * hi;
                const uint4 cu_ = *(const uint4*)(Z + tokA * ZLD + zcol); uint4 pv_ = *(const uint4*)(Z + tokP * ZLD + zcol); if (firstA) pv_ = make_uint4(0u, 0u, 0u, 0u);
                const float4 m0_ = *(const float4*)(mup), m1_ = *(const float4*)(mup + 4);
                float x_[8]; const unsigned cw_[4] = {cu_.x, cu_.y, cu_.z, cu_.w}, pw_[4] = {pv_.x, pv_.y, pv_.z, pv_.w}; const float mm_[8] = {m0_.x, m0_.y, m0_.z, m0_.w, m1_.x, m1_.y, m1_.z, m1_.w};
#pragma unroll
                for (int q_ = 0; q_ < 4; ++q_) { const float c0_ = bflo(cw_[q_]), c1_ = bfhi(cw_[q_]); x_[2 * q_] = c0_ + (bflo(pw_[q_]) - c0_) * mm_[2 * q_]; x_[2 * q_ + 1] = c1_ + (bfhi(pw_[q_]) - c1_) * mm_[2 * q_ + 1]; }
                if (act == 1) {
#pragma unroll
                    for (int q_ = 0; q_ < 8; ++q_) x_[q_] = 1.0f - 2.0f * __builtin_amdgcn_rcpf(__expf(2.0f * x_[q_]) + 1.0f);
                } else if (act == 2) {
#pragma unroll
                    for (int q_ = 0; q_ < 8; ++q_) x_[q_] = __builtin_amdgcn_rcpf(1.0f + __expf(-x_[q_]));
                }
                afr[idx * 64 + lane_t] = make_uint4(pk2(x_[0], x_[1]), pk2(x_[2], x_[3]), pk2(x_[4], x_[5]), pk2(x_[6], x_[7]));
            }
        }
        __syncthreads();
#define PREP_AFRAG(dst, idx_) do { const uint4 q_ = afr[(idx_) * 64 + lane_t]; pg8::u32x4 w_; w_.x = q_.x; w_.y = q_.y; w_.z = q_.z; w_.w = q_.w; dst = __builtin_bit_cast(bf16x8, w_); } while (0)
        const int chB = h * 64 + r32;
#define PREP_TOK(r) int hq_ = hi; asm volatile("" : "+v"(hq_)); const int tq = ((r) & 3) + 8 * ((r) >> 2) + 4 * hq_, t = tt0 + tq; const size_t tok = (size_t)t0 + tq; (void)t; (void)tok
#define PREP_RB(t, j) (((((size_t)bh * 512 + ((t) >> 2)) * 32 + ((j) >> 1)) * 4 + ((t) & 3)) * 5)
        f32x16 acc[2];
#pragma unroll
        for (int nb = 0; nb < 2; ++nb)
#pragma unroll
            for (int r = 0; r < 16; ++r) acc[nb][r] = 0.f;
#pragma unroll 1
        for (int sO = 0; sO < 8; sO += 4) {
            asm volatile("" ::: "memory");
#pragma unroll
            for (int sJ = 0; sJ < 4; ++sJ) { const int sI = sO + sJ;
                bf16x8 af; PREP_AFRAG(af, sI);
#pragma unroll
                for (int nb = 0; nb < 2; ++nb) acc[nb] = __builtin_amdgcn_mfma_f32_32x32x16_bf16(af, *(const bf16x8*)(WgT + (size_t)(chB + 32 * nb) * 128 + 16 * sI + 8 * hi), acc[nb], 0, 0, 0); }
        }
#pragma unroll
        for (int nb = 0; nb < 2; ++nb)
#pragma unroll
            for (int r = 0; r < 16; ++r) { PREP_TOK(r); RGp[tok * 512 + chB + 32 * nb] = f2bf(acc[nb][r]); }
#pragma unroll
        for (int nb = 0; nb < 2; ++nb)
#pragma unroll
            for (int r = 0; r < 16; ++r) acc[nb][r] = 0.f;
        asm volatile("" ::: "memory");
#pragma unroll
        for (int sI = 0; sI < 4; ++sI) {
            bf16x8 af; PREP_AFRAG(af, 8 + sI);
#pragma unroll
            for (int nb = 0; nb < 2; ++nb) acc[nb] = __builtin_amdgcn_mfma_f32_32x32x16_bf16(af, *(const bf16x8*)(WdT + (size_t)(chB + 32 * nb) * 64 + 16 * sI + 8 * hi), acc[nb], 0, 0, 0);
        }
        unsigned UW[2][8];
#pragma unroll
        for (int nb = 0; nb < 2; ++nb) {
            const float w0c = a.in[6][l * 512 + chB + 32 * nb];
#pragma unroll
            for (int g = 0; g < 4; ++g)
#pragma unroll
                for (int ts = 0; ts < 2; ++ts) { float uu[2];
#pragma unroll
                    for (int e = 0; e < 2; ++e) { const float sd = w0c + acc[nb][4 * g + ts + 2 * e]; const float sp = (sd < -15.f) ? -sd : __logf(1.0f + __expf(-sd)); uu[e] = 1.0f - __expf(-__expf(-sp - 0.5f)); }
                    UW[nb][2 * g + ts] = pkh2(uu[0], uu[1]); }
        }
        f32x16 aia[2], vga[2];
#pragma unroll
        for (int nb = 0; nb < 2; ++nb)
#pragma unroll
            for (int r = 0; r < 16; ++r) { aia[nb][r] = 0.f; vga[nb][r] = 0.f; }
        asm volatile("" ::: "memory");
#pragma unroll
        for (int sI = 0; sI < 4; ++sI) {
            bf16x8 af; PREP_AFRAG(af, 12 + sI);
#pragma unroll
            for (int nb = 0; nb < 2; ++nb) aia[nb] = __builtin_amdgcn_mfma_f32_32x32x16_bf16(af, *(const bf16x8*)(WiT + (size_t)(chB + 32 * nb) * 64 + 16 * sI + 8 * hi), aia[nb], 0, 0, 0);
        }
        if (l == 1) {
            asm volatile("" ::: "memory");
#pragma unroll
            for (int sI = 0; sI < 2; ++sI) {
                bf16x8 af; PREP_AFRAG(af, 16 + sI);
#pragma unroll
                for (int nb = 0; nb < 2; ++nb) vga[nb] = __builtin_amdgcn_mfma_f32_32x32x16_bf16(af, *(const bf16x8*)(WvT + (size_t)(chB + 32 * nb) * 32 + 16 * sI + 8 * hi), vga[nb], 0, 0, 0);
            }
        }
#undef PREP_AFRAG
        float ss[16], bon[16]; unsigned KW[2][8], RW[2][8], QW[2][8], AW[2][8];
#pragma unroll
        for (int r = 0; r < 16; ++r) { ss[r] = 0.f; bon[r] = 0.f; }
#pragma unroll
        for (int nb = 0; nb < 2; ++nb) {
            const int j = 32 * nb + r32, c = h * 64 + j;
            const float a0c = a.in[8][l * 512 + c], v0c = a.in[10][c];
            const float mu_r = mu[c], mu_k = mu[512 + c], mu_v = mu[1024 + c];
            const float kk_c = a.in[13][l * 512 + c], ka_c = a.in[14][l * 512 + c], rk_c = a.in[15][l * 512 + c];
            float v4[4], kp2[2], rr2[2], kq2[2], ai2[2];
#pragma unroll
            for (int r = 0; r < 16; ++r) {
                if ((r & 3) == 0) asm volatile("" ::: "memory");
                PREP_TOK(r);
                const float ai = sigmoidf_(a0c + aia[nb][r]);
                const float zr = bf2f(Z[tok * ZLD + C_R + c]), zk = bf2f(Z[tok * ZLD + C_KR + c]), zv = bf2f(Z[tok * ZLD + C_VR + c]);
                const size_t tokp = (t != 0) ? tok - 1 : tok; const float pm_ = (t != 0) ? 1.0f : 0.0f;
                const float pr = pm_ * bf2f(Z[tokp * ZLD + C_R + c]), pk = pm_ * bf2f(Z[tokp * ZLD + C_KR + c]), pv = pm_ * bf2f(Z[tokp * ZLD + C_VR + c]);
                const float rr_ = zr + (pr - zr) * mu_r, kx = zk + (pk - zk) * mu_k;
                float v = zv + (pv - zv) * mu_v;
                if (l == 0) VF[tok * 512 + c] = f2bf(v);
                else v = v + (bf2f(VF[tok * 512 + c]) - v) * sigmoidf_(v0c + vga[nb][r]);
                const float kkraw = kx * kk_c, kp = kx * (1.0f + (ai - 1.0f) * ka_c);
                ss[r] = fmaf(kkraw, kkraw, ss[r]); bon[r] = fmaf(rr_ * kp, rk_c, bon[r]);
                if ((r & 3) < 2) { kp2[r & 1] = kp; rr2[r & 1] = rr_; kq2[r & 1] = kkraw; ai2[r & 1] = ai; }
                else { const int wI = 2 * (r >> 2) + (r & 1); KW[nb][wI] = pkh2(kp2[r & 1], kp); RW[nb][wI] = pkh2(rr2[r & 1], rr_); QW[nb][wI] = pkh2(kq2[r & 1], kkraw); AW[nb][wI] = pkh2(ai2[r & 1], ai); }
                v4[r & 3] = v;
                if ((r & 3) == 3) {
                    uint2 pv2; pv2.x = pkh2(v4[0], v4[1]); pv2.y = pkh2(v4[2], v4[3]);
                    *(uint2*)(RVT + (((size_t)bh * 256 + ((tt0 >> 3) + (r >> 2))) * 64 + j) * 8 + 4 * hi) = pv2;
                }
            }
        }
        float rn[16];
#pragma unroll
        for (int r = 0; r < 16; ++r) {
            PREP_TOK(r);
            const float sst = sum32(ss[r]), bt = sum32(bon[r]);
            rn[r] = rsqrtf(fmaxf(sst, 1e-24f));
            BON[tok * 8 + h] = bt;
        }
        const unsigned psel = (r32 & 1) ? 0x03020706u : 0x05040100u;
#pragma unroll
        for (int nb = 0; nb < 2; ++nb)
#pragma unroll
            for (int g = 0; g < 4; ++g) {
                asm volatile("" ::: "memory");
                unsigned outw[10];
#pragma unroll
                for (int ts = 0; ts < 2; ++ts) {
                    const int wI = 2 * g + ts;
                    const h2_t q2 = __builtin_bit_cast(h2_t, QW[nb][wI]), a2 = __builtin_bit_cast(h2_t, AW[nb][wI]);
                    const float k0 = (float)q2[0] * rn[4 * g + ts], k1 = (float)q2[1] * rn[4 * g + ts + 2];
                    const unsigned mine[5] = {UW[nb][wI], pkh2(-k0, -k1), pkh2(k0 * (float)a2[0], k1 * (float)a2[1]), KW[nb][wI], RW[nb][wI]};
#pragma unroll
                    for (int q = 0; q < 5; ++q) { const unsigned oth = (unsigned)__builtin_amdgcn_mov_dpp((int)mine[q], 0xB1, 0xF, 0xF, true); outw[ts * 5 + q] = __builtin_amdgcn_perm(oth, mine[q], psel); }
                }
                const int tg = (tt0 >> 2) + 2 * g + hi, j2r = 16 * nb + (r32 >> 1);
                unsigned* dst = REC + ((size_t)bh * 512 + tg) * REC_TG + j2r * 20 + (j2r >> 4) * 4 + ((r32 & 1) ? 10 : 0);
#pragma unroll
                for (int k = 0; k < 5; ++k) { uint2 o2; o2.x = outw[2 * k]; o2.y = outw[2 * k + 1]; *(uint2*)(dst + 2 * k) = o2; }
            }
#undef PREP_TOK
#undef PREP_RB
    }
}

__device__ __forceinline__ float dpp_add(float x, float y_src, int) { return x + y_src; }
__device__ __forceinline__ float red32(float x) {
    x += SC_DPP(x, 0xB1); x += SC_DPP(x, 0x4E); x += SC_DPP(x, 0x141); x += SC_DPP(x, 0x140);
    auto rr = __builtin_amdgcn_permlane32_swap(__float_as_uint(x), __float_as_uint(x), false, false);
    return __uint_as_float(rr[0]) + __uint_as_float(rr[1]);
}
__device__ __forceinline__ float fmul_lo(float a, unsigned h) { float d; asm("v_fma_mix_f32 %0, %1, %2, 0 op_sel_hi:[0,1,0]" : "=v"(d) : "v"(a), "v"(h)); return d; }
__device__ __forceinline__ float fmix_lo(float a, unsigned h, float c) { float d; asm("v_fma_mix_f32 %0, %1, %2, %3 op_sel_hi:[0,1,0]" : "=v"(d) : "v"(a), "v"(h), "v"(c)); return d; }
__device__ __forceinline__ float fmix_hi(float a, unsigned h, float c) { float d; asm("v_fma_mix_f32 %0, %1, %2, %3 op_sel:[0,1,0] op_sel_hi:[0,1,0]" : "=v"(d) : "v"(a), "v"(h), "v"(c)); return d; }
__device__ __forceinline__ float fdec_lo(float sv, unsigned u) { float d; asm("v_fma_mix_f32 %0, -%1, %2, %1 op_sel_hi:[0,1,0]" : "=v"(d) : "v"(sv), "v"(u)); return d; }
__device__ __forceinline__ float fdec_hi(float sv, unsigned u) { float d; asm("v_fma_mix_f32 %0, -%1, %2, %1 op_sel:[0,1,0] op_sel_hi:[0,1,0]" : "=v"(d) : "v"(sv), "v"(u)); return d; }
template <int VH> __device__ __forceinline__ float fvk_lo(unsigned v, unsigned k, float c) { float d;
    if (VH) asm("v_fma_mix_f32 %0, %1, %2, %3 op_sel:[1,0,0] op_sel_hi:[1,1,0]" : "=v"(d) : "v"(v), "v"(k), "v"(c)); else asm("v_fma_mix_f32 %0, %1, %2, %3 op_sel:[0,0,0] op_sel_hi:[1,1,0]" : "=v"(d) : "v"(v), "v"(k), "v"(c)); return d; }
template <int VH> __device__ __forceinline__ float fvk_hi(unsigned v, unsigned k, float c) { float d;
    if (VH) asm("v_fma_mix_f32 %0, %1, %2, %3 op_sel:[1,1,0] op_sel_hi:[1,1,0]" : "=v"(d) : "v"(v), "v"(k), "v"(c)); else asm("v_fma_mix_f32 %0, %1, %2, %3 op_sel:[0,1,0] op_sel_hi:[1,1,0]" : "=v"(d) : "v"(v), "v"(k), "v"(c)); return d; }

__device__ __forceinline__ float red16(float x) {
    x += SC_DPP(x, 0xB1); x += SC_DPP(x, 0x4E); x += SC_DPP(x, 0x141); x += SC_DPP(x, 0x140);
    return x;
}
__device__ __forceinline__ float ffma(float a, float b, float c) { float d; asm("v_fma_f32 %0, %1, %2, %3" : "=v"(d) : "v"(a), "v"(b), "v"(c)); return d; }
__device__ __forceinline__ float fmul(float a, float b) { float d; asm("v_mul_f32 %0, %1, %2" : "=v"(d) : "v"(a), "v"(b)); return d; }
__device__ __forceinline__ float fnfma(float a, float b, float c) { float d; asm("v_fma_f32 %0, -%1, %2, %3" : "=v"(d) : "v"(a), "v"(b), "v"(c)); return d; }
__device__ __forceinline__ float h2f_lo(unsigned w) { float d; asm("v_cvt_f32_f16 %0, %1" : "=v"(d) : "v"(w)); return d; }
__device__ __forceinline__ float h2f_hi(unsigned w) { float d; asm("v_cvt_f32_f16_sdwa %0, %1 dst_sel:DWORD dst_unused:UNUSED_PAD src0_sel:WORD_1" : "=v"(d) : "v"(w)); return d; }
__device__ __forceinline__ void phase_scan(const Args& a, int l, PG8_LAS unsigned char* lds) {
    const int tid = tid_fresh(), lane = tid & 63, wid = __builtin_amdgcn_readfirstlane(tid >> 6);
    const int j2 = (lane & 15) | ((lane >> 5) << 4), rr = (lane >> 4) & 1;
    const char* REC = (const char*)(a.ws + WS_REC); const char* RVT = (const char*)(a.ws + WS_RVT);
    bf16_t* YR = (bf16_t*)(a.ws + WS_YRAW);
    constexpr int CSTEPS = 32, NCH = SEQ / CSTEPS, G_REC = 8 * REC_TG * 4  , CH_REC = 21 * 1024, CH_V = 4096, CH = CH_REC + CH_V, NPC = 25;
    constexpr int YB_LD = 68, YB_WAVE = 16 * YB_LD * 4;
    PG8_LAS float* yb = (PG8_LAS float*)(lds + 2 * CH + wid * YB_WAVE);
    float* scr = (float*)((unsigned char*)lds + 2 * CH + 8 * YB_WAVE) + (wid & 3) * (64 * 33);
    const bool cvw = wid < 4;
    const int cw = blockIdx.x * 4 + (wid & 3), NCW = gridDim.x * 4;
    int cvt_next = cvw ? cw : NEXP * 768; bool have = false; CvtItem ci; float4 cv[8];
    for (int u = blockIdx.x; u < 256; u += gridDim.x) {
        const int bh = u >> 2, rg = u & 3, b = bh >> 3, h = bh & 7;
        const int irow = rg * 16 + wid * 2 + rr;
        const char* grec = REC + (size_t)bh * NCH * G_REC; const char* gv = RVT + (size_t)bh * NCH * CH_V;
        float S0 = 0.f, S1 = 0.f;
        __syncthreads();
#define SCAN_DMA(chn, bufo) do { _Pragma("unroll") for (int k_ = 0; k_ < 4; ++k_) { const int pc_ = wid * 4 + k_; if (pc_ < NPC) { \
            const char* src_ = (pc_ < 21) ? grec + (size_t)(chn) * G_REC + pc_ * 1024 + lane * 16 : gv + (size_t)(chn) * CH_V + (pc_ - 21) * 1024 + lane * 16; \
            __builtin_amdgcn_global_load_lds((const unsigned*)src_, (PG8_LAS unsigned*)(lds + (bufo) + pc_ * 1024), 16, 0, 0); } } } while (0)
        SCAN_DMA(0, 0);
        for (int ch = 0; ch < NCH; ++ch) {
            asm volatile("s_waitcnt vmcnt(0)" ::: "memory");
            __syncthreads();
            if (ch + 1 < NCH) SCAN_DMA(ch + 1, ((ch + 1) & 1) * CH);
            if (have) { cvt_finish(ci, lane, cv, scr); have = false; }
            { const int cm = ch & 7; if (cvw && (cm == 0 || cm == 3 || cm == 5)) { if (cvt_decode(a, l, cvt_next, ci)) { cvt_load(ci, lane, cv); have = true; cvt_next += NCW; } } }
            PG8_LAS const unsigned char* bufp = lds + (ch & 1) * CH;
#define SCAN_LOADW(W, grp) do { PG8_LAS const unsigned char* rp_ = bufp + (grp) * (REC_TG * 4) + j2 * 80 + (j2 >> 4) * 16; _Pragma("unroll") for (int k_ = 0; k_ < 5; ++k_) { \
                const pg8::u32x4 q_ = *(PG8_LAS const pg8::u32x4*)(rp_ + 16 * k_); W[4 * k_] = q_.x; W[4 * k_ + 1] = q_.y; W[4 * k_ + 2] = q_.z; W[4 * k_ + 3] = q_.w; } } while (0)
#define SCAN_STEPS(W, hf) do { _Pragma("unroll") for (int ts = 0; ts < 4; ++ts) { \
                const unsigned wu = W[ts * 5], wa = W[ts * 5 + 1], wb = W[ts * 5 + 2], wk = W[ts * 5 + 3], wr_ = W[ts * 5 + 4]; \
                const unsigned vw = vv[(hf) * 2 + (ts >> 1)]; \
                const float sa = red32(fmix_hi(S1, wa, fmul_lo(S0, wa))); \
                float t0 = fdec_lo(S0, wu), t1 = fdec_hi(S1, wu); \
                if (ts & 1) { t0 = fvk_lo<1>(vw, wk, t0); t1 = fvk_hi<1>(vw, wk, t1); } else { t0 = fvk_lo<0>(vw, wk, t0); t1 = fvk_hi<0>(vw, wk, t1); } \
                S0 = fmix_lo(sa, wb, t0); S1 = fmix_hi(sa, wb, t1); \
                yb[((g8 & 1) * 8 + (hf) * 4 + ts) * YB_LD + rr * 32 + j2] = fmix_hi(S1, wr_, fmul_lo(S0, wr_)); } } while (0)
            unsigned wA[20], wB[20];
            SCAN_LOADW(wA, 0);
#pragma unroll 1
            for (int g8 = 0; g8 < 4; ++g8) {
                const pg8::u32x4 vv = *(PG8_LAS const pg8::u32x4*)(bufp + CH_REC + (g8 * 64 + irow) * 16);
                SCAN_LOADW(wB, g8 * 2 + 1);
                SCAN_STEPS(wA, 0);
                if (g8 < 3) SCAN_LOADW(wA, g8 * 2 + 2);
                SCAN_STEPS(wB, 1);
                if (g8 & 1) {
                    asm volatile("s_waitcnt lgkmcnt(0)" ::: "memory");
                    PG8_LAS const float* yp = yb + (j2 & 15) * YB_LD + rr * 32 + (j2 >> 4) * 16;
                    const pg8::f32x4 y0 = *(PG8_LAS const pg8::f32x4*)(yp), y1 = *(PG8_LAS const pg8::f32x4*)(yp + 4), y2 = *(PG8_LAS const pg8::f32x4*)(yp + 8), y3 = *(PG8_LAS const pg8::f32x4*)(yp + 12);
                    const pg8::f32x4 ys = (y0 + y1) + (y2 + y3);
                    float y = (ys[0] + ys[1]) + (ys[2] + ys[3]);
                    { auto sw = __builtin_amdgcn_permlane32_swap(__float_as_uint(y), __float_as_uint(y), false, false); y = __uint_as_float(sw[0]) + __uint_as_float(sw[1]); }
                    const int t = ch * CSTEPS + (g8 >> 1) * 16 + (j2 & 15);
                    if (j2 < 16) YR[((size_t)b * SEQ + t) * 512 + h * 64 + irow] = f2bf(y);
                    asm volatile("s_waitcnt lgkmcnt(0)" ::: "memory");
                }
            }
#undef SCAN_LOADW
#undef SCAN_STEPS
        }
#undef SCAN_DMA
    }
    if (have) cvt_finish(ci, lane, cv, scr);
    while (cvt_decode(a, l, cvt_next, ci)) { cvt_load(ci, lane, cv); cvt_finish(ci, lane, cv, scr); cvt_next += NCW; }
}

__device__ __forceinline__ void phase_post(const Args& a, int l) {
    const int tid = tid_fresh(), lane = tid & 63, wid = tid >> 6;
    const bf16_t* YR = (const bf16_t*)(a.ws + WS_YRAW); const _Float16* RVT = (const _Float16*)(a.ws + WS_RVT);
    const bf16_t* RGp = (const bf16_t*)(a.ws + WS_RG); const float* BON = (const float*)(a.ws + WS_BON);
    bf16_t* MIX = (bf16_t*)(a.ws + WS_MIX);
    for (int u = blockIdx.x; u < 64 * 256; u += gridDim.x) {
        const int bh = u >> 8, t8 = u & 255, b = bh >> 3, h = bh & 7, t = t8 * 8 + wid;
        const size_t tok = (size_t)b * SEQ + t; const int c = h * 64 + lane;
        const float y = bf2f(YR[tok * 512 + c]);
        const float my = wsum(y) * (1.0f / 64.0f);
        const float dy = y - my;
        const float var = wsum(dy * dy) * (1.0f / 64.0f);
        const float yn = dy * rsqrtf(var + 64e-5f) * a.in[16][l * 512 + c] + a.in[17][l * 512 + c];
        const float v = (float)RVT[(((size_t)bh * 256 + t8) * 64 + lane) * 8 + wid];
        MIX[tok * DM + 512 + c] = f2bf((yn + BON[tok * 8 + h] * v) * bf2f(RGp[tok * 512 + c]));
    }
}

namespace att {
typedef short bf16x8 __attribute__((ext_vector_type(8)));
typedef short s16x4 __attribute__((ext_vector_type(4)));
typedef float f32x16 __attribute__((ext_vector_type(16)));
typedef __attribute__((address_space(3))) const unsigned char* lds_cptr;
constexpr int SLOT = 8192, L_K = 0, L_V = 2 * SLOT, L_WS = 4 * SLOT, L_KM = L_WS + 8 * 256, L_OST = L_KM + 2048, OST_LD = 68, L_END = L_OST + 8 * 32 * OST_LD * 4;
constexpr float C2 = 0.125f * 1.4426950408889634f;
__device__ __forceinline__ int crow(int r, int hi) { return (r & 3) + 8 * (r >> 2) + 4 * hi; }
__device__ __forceinline__ s16x4 vtr(lds_cptr p) { return __builtin_bit_cast(s16x4, __builtin_amdgcn_ds_read_tr16_b64_v4i16((__attribute__((address_space(3))) s16x4*)p)); }
__device__ __forceinline__ float swapmax(float x) { auto rr = __builtin_amdgcn_permlane32_swap(__float_as_uint(x), __float_as_uint(x), false, false); return fmaxf(__uint_as_float(rr[0]), __uint_as_float(rr[1])); }
__device__ __forceinline__ float swapsum(float x) { auto rr = __builtin_amdgcn_permlane32_swap(__float_as_uint(x), __float_as_uint(x), false, false); return __uint_as_float(rr[0]) + __uint_as_float(rr[1]); }

__device__ __forceinline__ void unit(const Args& a, int l, int b, int h, int cur, PG8_LAS unsigned char* lds) {
    const int tid = tid_fresh(), lane = tid & 63, r32 = lane & 31, hi = lane >> 5, wid = __builtin_amdgcn_readfirstlane(tid >> 6);
    const bf16_t* Zb = (const bf16_t*)(a.ws + WS_Z) + (size_t)b * SEQ * ZLD;
    const int qrel = wid * 32 + r32, qpos = cur * 256 + qrel;
    PG8_LAS float* wsf = (PG8_LAS float*)(lds + L_WS) + wid * 64;
    PG8_LAS float* kmf = (PG8_LAS float*)(lds + L_KM);
    __syncthreads();
    kmf[tid] = ((const float*)(a.ws + WS_KMEAN))[(size_t)(b * NH + h) * 512 + tid];
    const bf16_t* ksrc = Zb + (size_t)lane * ZLD + C_K + h * HD + wid * 8;
    const bf16_t* vsrc = Zb + (size_t)(16 * (wid & 3) + (lane >> 2)) * ZLD + C_V + h * HD + (wid >> 2) * 32 + (lane & 3) * 8;
#define ATT_DMA(kpos0, slot) do { \
        __builtin_amdgcn_global_load_lds((const unsigned*)(ksrc + (size_t)(kpos0) * ZLD), (PG8_LAS unsigned*)(lds + L_K + (slot) * SLOT + wid * 1024), 16, 0, 0); \
        __builtin_amdgcn_global_load_lds((const unsigned*)(vsrc + (size_t)(kpos0) * ZLD), (PG8_LAS unsigned*)(lds + L_V + (slot) * SLOT + wid * 1024), 16, 0, 0); } while (0)
    ATT_DMA(cur * 256, 0);
    bf16x8 qr[4];
#pragma unroll
    for (int d0 = 0; d0 < 4; ++d0) qr[d0] = *(const bf16x8*)(Zb + (size_t)qpos * ZLD + C_Q + h * HD + d0 * 16 + hi * 8);
    __syncthreads();
    unsigned selbits = 0u;
    {
        float g[8];
#pragma unroll
        for (int n = 0; n < 8; ++n) g[n] = 0.f;
#pragma unroll
        for (int d0 = 0; d0 < 4; ++d0)
#pragma unroll
            for (int j = 0; j < 8; ++j) { const float qv = bf2f((bf16_t)qr[d0][j]);
#pragma unroll
                for (int n = 0; n < 8; ++n) g[n] = fmaf(qv, kmf[n * 64 + d0 * 16 + hi * 8 + j], g[n]); }
#pragma unroll
        for (int n = 0; n < 8; ++n) g[n] = (n < cur) ? swapsum(g[n]) : NEG_INF;
        if (cur <= 3) selbits = (1u << cur) - 1u;
        else {
            int s0 = -1, s1 = -1, s2 = -1; float bv = -3e38f;
#pragma unroll
            for (int n = 0; n < 8; ++n) if (g[n] > bv) { bv = g[n]; s0 = n; }
            bv = -3e38f;
#pragma unroll
            for (int n = 0; n < 8; ++n) if (n != s0 && g[n] > bv) { bv = g[n]; s1 = n; }
            bv = -3e38f;
#pragma unroll
            for (int n = 0; n < 8; ++n) if (n != s0 && n != s1 && g[n] > bv) { bv = g[n]; s2 = n; }
            selbits = (1u << s0) | (1u << s1) | (1u << s2);
        }
    }
    const float s8 = 8.0f * exp2f(-(float)(h + 1));
    f32x16 base;
#pragma unroll
    for (int r = 0; r < 16; ++r) base[r] = s8 * (float)crow(r, hi);
    f32x16 o0, o1;
#pragma unroll
    for (int r = 0; r < 16; ++r) { o0[r] = 0.f; o1[r] = 0.f; }
    float m = -INFINITY, lsum = 0.f;
    const int NT = 4 * (cur + 1);
    const lds_cptr kp = (lds_cptr)(lds + L_K) + hi * 1024 + r32 * 16;
    const lds_cptr vp = (lds_cptr)(lds + L_V) + ((lane >> 4) & 1) * 32 + (lane & 3) * 8 + (4 * hi + ((lane & 15) >> 2)) * 64;
    for (int it = 0; it < NT; ++it) {
        asm volatile("s_waitcnt vmcnt(0)" ::: "memory");
        __syncthreads();
        const int blk = (it < 4) ? cur : ((it >> 2) - 1);
        const int kpos0 = blk * 256 + (it & 3) * 64;
        if (it + 1 < NT) { const int nblk = (it + 1 < 4) ? cur : (((it + 1) >> 2) - 1); ATT_DMA(nblk * 256 + ((it + 1) & 3) * 64, (it + 1) & 1); }
        const int so = (it & 1) * SLOT;
        f32x16 p0 = base, p1 = base;
#pragma unroll
        for (int d0 = 0; d0 < 4; ++d0) {
            const bf16x8 k0 = *(const __attribute__((address_space(3))) bf16x8*)(kp + so + d0 * 2048);
            const bf16x8 k1 = *(const __attribute__((address_space(3))) bf16x8*)(kp + so + d0 * 2048 + 512);
            p0 = __builtin_amdgcn_mfma_f32_32x32x16_bf16(k0, qr[d0], p0, 0, 0, 0);
            p1 = __builtin_amdgcn_mfma_f32_32x32x16_bf16(k1, qr[d0], p1, 0, 0, 0);
        }
        const bool rowsel = (it < 4) || ((selbits >> blk) & 1u);
        const float cb = rowsel ? -s8 * (float)(qpos - kpos0) : -INFINITY;
        const float cb1 = cb + s8 * 32.0f;
        if (it < 4) {
            const int kb0 = (it & 3) * 64 + 4 * hi;
#pragma unroll
            for (int r = 0; r < 16; ++r) { const int kv = kb0 + (r & 3) + 8 * (r >> 2); if (kv > qrel) p0[r] = -INFINITY; if (kv + 32 > qrel) p1[r] = -INFINITY; }
        }
        float mx0 = p0[0], mx1 = p1[0];
#pragma unroll
        for (int r = 1; r < 16; ++r) { mx0 = fmaxf(mx0, p0[r]); mx1 = fmaxf(mx1, p1[r]); }
        const float mx = swapmax(fmaxf(mx0 + cb, mx1 + cb1));
        if (__any((mx - m) * C2 > 6.0f)) {
            const float mn = fmaxf(m, mx);
            const float alpha = __builtin_amdgcn_exp2f((m - mn) * C2);
            m = mn; lsum *= alpha;
            asm volatile("s_waitcnt lgkmcnt(0)" ::: "memory");
            if (hi == 0) wsf[r32] = alpha;
            asm volatile("s_waitcnt lgkmcnt(0)" ::: "memory");
#pragma unroll
            for (int r = 0; r < 16; ++r) { const float al = wsf[crow(r, hi)]; o0[r] *= al; o1[r] *= al; }
        }
        const float tb0 = (cb - m) * C2, tb1 = (cb1 - m) * C2;
        float ls = 0.f;
#pragma unroll
        for (int r = 0; r < 16; ++r) { p0[r] = __builtin_amdgcn_exp2f(fmaf(p0[r], C2, tb0)); p1[r] = __builtin_amdgcn_exp2f(fmaf(p1[r], C2, tb1)); ls += p0[r] + p1[r]; }
        lsum += ls;
        pg8::u32x4 w0, w1, w2, w3;
        w0.x = pk2(p0[0], p0[1]); w0.y = pk2(p0[2], p0[3]); w0.z = pk2(p0[4], p0[5]); w0.w = pk2(p0[6], p0[7]);
        w1.x = pk2(p0[8], p0[9]); w1.y = pk2(p0[10], p0[11]); w1.z = pk2(p0[12], p0[13]); w1.w = pk2(p0[14], p0[15]);
        w2.x = pk2(p1[0], p1[1]); w2.y = pk2(p1[2], p1[3]); w2.z = pk2(p1[4], p1[5]); w2.w = pk2(p1[6], p1[7]);
        w3.x = pk2(p1[8], p1[9]); w3.y = pk2(p1[10], p1[11]); w3.z = pk2(p1[12], p1[13]); w3.w = pk2(p1[14], p1[15]);
        const bf16x8 pa0 = __builtin_bit_cast(bf16x8, w0), pa1 = __builtin_bit_cast(bf16x8, w1), pa2 = __builtin_bit_cast(bf16x8, w2), pa3 = __builtin_bit_cast(bf16x8, w3);
#define ATT_VF(d0, ks) ({ const s16x4 lo_ = vtr(vp + so + (d0) * 4096 + (ks) * 1024), hi_ = vtr(vp + so + (d0) * 4096 + (ks) * 1024 + 512); \
        (bf16x8){lo_[0], lo_[1], lo_[2], lo_[3], hi_[0], hi_[1], hi_[2], hi_[3]}; })
        o0 = __builtin_amdgcn_mfma_f32_32x32x16_bf16(pa0, ATT_VF(0, 0), o0, 0, 0, 0);
        o1 = __builtin_amdgcn_mfma_f32_32x32x16_bf16(pa0, ATT_VF(1, 0), o1, 0, 0, 0);
        o0 = __builtin_amdgcn_mfma_f32_32x32x16_bf16(pa1, ATT_VF(0, 1), o0, 0, 0, 0);
        o1 = __builtin_amdgcn_mfma_f32_32x32x16_bf16(pa1, ATT_VF(1, 1), o1, 0, 0, 0);
        o0 = __builtin_amdgcn_mfma_f32_32x32x16_bf16(pa2, ATT_VF(0, 2), o0, 0, 0, 0);
        o1 = __builtin_amdgcn_mfma_f32_32x32x16_bf16(pa2, ATT_VF(1, 2), o1, 0, 0, 0);
        o0 = __builtin_amdgcn_mfma_f32_32x32x16_bf16(pa3, ATT_VF(0, 3), o0, 0, 0, 0);
        o1 = __builtin_amdgcn_mfma_f32_32x32x16_bf16(pa3, ATT_VF(1, 3), o1, 0, 0, 0);
#undef ATT_VF
    }
#undef ATT_DMA
    const float lt = swapsum(lsum);
    asm volatile("s_waitcnt lgkmcnt(0)" ::: "memory");
    if (hi == 0) wsf[r32] = 1.0f / lt;
    asm volatile("s_waitcnt lgkmcnt(0)" ::: "memory");
    PG8_LAS float* stg = (PG8_LAS float*)(lds + L_OST) + wid * (32 * OST_LD);
#pragma unroll
    for (int r = 0; r < 16; ++r) { const int orow = crow(r, hi); const float il = wsf[orow]; stg[orow * OST_LD + r32] = o0[r] * il; stg[orow * OST_LD + 32 + r32] = o1[r] * il; }
    asm volatile("s_waitcnt lgkmcnt(0)" ::: "memory");
    const float* gain = a.in[18] + l * 512 + h * HD;
    bf16_t* MIX = (bf16_t*)(a.ws + WS_MIX);
#pragma unroll
    for (int i = 0; i < 4; ++i) {
        const int row = i * 8 + (lane >> 3), ch = lane & 7;
        const pg8::f32x4 va = *(PG8_LAS const pg8::f32x4*)(stg + row * OST_LD + ch * 8), vb = *(PG8_LAS const pg8::f32x4*)(stg + row * OST_LD + ch * 8 + 4);
        float ss = va[0] * va[0] + va[1] * va[1] + va[2] * va[2] + va[3] * va[3] + vb[0] * vb[0] + vb[1] * vb[1] + vb[2] * vb[2] + vb[3] * vb[3];
        ss += SC_DPP(ss, 0xB1); ss += SC_DPP(ss, 0x4E); ss += SC_DPP(ss, 0x141);
        const float rs = rsqrtf(ss * (1.0f / 64.0f) + 1e-6f);
        const pg8::f32x4 ga = *(const pg8::f32x4*)(gain + ch * 8), gb = *(const pg8::f32x4*)(gain + ch * 8 + 4);
        pg8::u32x4 w; w.x = pk2(va[0] * rs * ga[0], va[1] * rs * ga[1]); w.y = pk2(va[2] * rs * ga[2], va[3] * rs * ga[3]);
        w.z = pk2(vb[0] * rs * gb[0], vb[1] * rs * gb[1]); w.w = pk2(vb[2] * rs * gb[2], vb[3] * rs * gb[3]);
        *(pg8::u32x4*)(MIX + ((size_t)b * SEQ + cur * 256 + wid * 32 + row) * DM + h * HD + ch * 8) = w;
    }
}
}

__device__ __forceinline__ void phase_att(const Args& a, int l, PG8_LAS unsigned char* lds) {
    const int G = gridDim.x, bx = blockIdx.x;
    const int v = (G % 8 == 0) ? (bx % 8) * (G / 8) + bx / 8 : bx;
    for (int w = v; w < 256; w += G) {
        const int bh = w >> 2, s = w & 3;
        att::unit(a, l, bh >> 3, bh & 7, 7 - s, lds);
        att::unit(a, l, bh >> 3, bh & 7, s, lds);
    }
}

__device__ __forceinline__ void scan32(const Args& a, int l, int j, PG8_LAS unsigned char* lds) {
    const int tid = tid_fresh(), lane = tid & 63, wid = __builtin_amdgcn_readfirstlane(tid >> 6);
    const int jq = lane & 15, rr = lane >> 4;
    const char* REC = (const char*)(a.ws + WS_REC); const char* RVT = (const char*)(a.ws + WS_RVT);
    bf16_t* YR = (bf16_t*)(a.ws + WS_YRAW);
    constexpr int CSTEPS = 32, NCH = SEQ / CSTEPS, G_REC = 8 * REC_TG * 4, CH_REC = 21 * 1024, CH_V = 4096, CH = CH_REC + CH_V, NPC = 25;
    constexpr int YB_LD = 68, YB_WAVE = 16 * YB_LD * 4;
    PG8_LAS float* yb = (PG8_LAS float*)(lds + 2 * CH + wid * YB_WAVE);
    const int bh = j >> 1, hf32 = j & 1, b = bh >> 3, h = bh & 7;
    const int irow = hf32 * 32 + wid * 4 + rr;
    const char* grec = REC + (size_t)bh * NCH * G_REC; const char* gv = RVT + (size_t)bh * NCH * CH_V;
    float S0 = 0.f, S1 = 0.f, S2 = 0.f, S3 = 0.f;
    asm volatile("s_waitcnt vmcnt(0) lgkmcnt(0)" ::: "memory"); __builtin_amdgcn_s_barrier(); asm volatile("" ::: "memory");
#define SCAN_DMA(chn, bufo) do { _Pragma("unroll") for (int k_ = 0; k_ < 4; ++k_) { const int pc_ = wid * 4 + k_; if (pc_ < NPC) { \
        const char* src_ = (pc_ < 21) ? grec + (size_t)(chn) * G_REC + pc_ * 1024 + lane * 16 : gv + (size_t)(chn) * CH_V + (pc_ - 21) * 1024 + lane * 16; \
        __builtin_amdgcn_global_load_lds((const unsigned*)src_, (PG8_LAS unsigned*)(lds + (bufo) + pc_ * 1024), 16, 0, 0); } } } while (0)
    SCAN_DMA(0, 0);
    for (int ch = 0; ch < NCH; ++ch) {
        asm volatile("s_waitcnt vmcnt(0) lgkmcnt(0)" ::: "memory"); __builtin_amdgcn_s_barrier(); asm volatile("" ::: "memory");
        if (ch + 1 < NCH) SCAN_DMA(ch + 1, ((ch + 1) & 1) * CH);
        PG8_LAS const unsigned char* bufp = lds + (ch & 1) * CH;
#define SCAN_LOADW(WA, WB, grp) do { PG8_LAS const unsigned char* rp_ = bufp + (grp) * (REC_TG * 4) + jq * 160 + (jq >> 3) * 16; _Pragma("unroll") for (int k_ = 0; k_ < 5; ++k_) { \
        const pg8::u32x4 q_ = *(PG8_LAS const pg8::u32x4*)(rp_ + 16 * k_), q2_ = *(PG8_LAS const pg8::u32x4*)(rp_ + 80 + 16 * k_); \
        WA[4 * k_] = q_.x; WA[4 * k_ + 1] = q_.y; WA[4 * k_ + 2] = q_.z; WA[4 * k_ + 3] = q_.w; WB[4 * k_] = q2_.x; WB[4 * k_ + 1] = q2_.y; WB[4 * k_ + 2] = q2_.z; WB[4 * k_ + 3] = q2_.w; } } while (0)
#define SCAN_STEPS(WA, WB, hf) do { _Pragma("unroll") for (int ts = 0; ts < 4; ++ts) { \
        const unsigned uA = WA[ts * 5], aA = WA[ts * 5 + 1], bA = WA[ts * 5 + 2], kA = WA[ts * 5 + 3], rA = WA[ts * 5 + 4]; \
        const unsigned uB = WB[ts * 5], aB = WB[ts * 5 + 1], bB = WB[ts * 5 + 2], kB = WB[ts * 5 + 3], rB = WB[ts * 5 + 4]; \
        const unsigned vw = vv[(hf) * 2 + (ts >> 1)]; \
        const float sa = red16(fmix_hi(S3, aB, fmix_lo(S2, aB, fmix_hi(S1, aA, fmul_lo(S0, aA))))); \
        float t0 = fdec_lo(S0, uA), t1 = fdec_hi(S1, uA), t2 = fdec_lo(S2, uB), t3 = fdec_hi(S3, uB); \
        if (ts & 1) { t0 = fvk_lo<1>(vw, kA, t0); t1 = fvk_hi<1>(vw, kA, t1); t2 = fvk_lo<1>(vw, kB, t2); t3 = fvk_hi<1>(vw, kB, t3); } \
        else { t0 = fvk_lo<0>(vw, kA, t0); t1 = fvk_hi<0>(vw, kA, t1); t2 = fvk_lo<0>(vw, kB, t2); t3 = fvk_hi<0>(vw, kB, t3); } \
        S0 = fmix_lo(sa, bA, t0); S1 = fmix_hi(sa, bA, t1); S2 = fmix_lo(sa, bB, t2); S3 = fmix_hi(sa, bB, t3); \
        yb[((g8 & 1) * 8 + (hf) * 4 + ts) * YB_LD + rr * 16 + jq] = fmix_hi(S3, rB, fmix_lo(S2, rB, fmix_hi(S1, rA, fmul_lo(S0, rA)))); } } while (0)
        unsigned wA0[20], wB0[20], wA1[20], wB1[20];
        SCAN_LOADW(wA0, wB0, 0);
#pragma unroll 1
        for (int g8 = 0; g8 < 4; ++g8) {
            const pg8::u32x4 vv = *(PG8_LAS const pg8::u32x4*)(bufp + CH_REC + (g8 * 64 + irow) * 16);
            SCAN_LOADW(wA1, wB1, g8 * 2 + 1);
            SCAN_STEPS(wA0, wB0, 0);
            if (g8 < 3) SCAN_LOADW(wA0, wB0, g8 * 2 + 2);
            SCAN_STEPS(wA1, wB1, 1);
            if (g8 & 1) {
                asm volatile("s_waitcnt lgkmcnt(0)" ::: "memory");
                PG8_LAS const float* yp = yb + jq * YB_LD + rr * 16;
                const pg8::f32x4 y0 = *(PG8_LAS const pg8::f32x4*)(yp), y1 = *(PG8_LAS const pg8::f32x4*)(yp + 4), y2 = *(PG8_LAS const pg8::f32x4*)(yp + 8), y3 = *(PG8_LAS const pg8::f32x4*)(yp + 12);
                const pg8::f32x4 ys = (y0 + y1) + (y2 + y3);
                const float y = (ys[0] + ys[1]) + (ys[2] + ys[3]);
                const int t = ch * CSTEPS + (g8 >> 1) * 16 + jq;
                YR[((size_t)b * SEQ + t) * 512 + h * 64 + irow] = f2bf(y);
                asm volatile("s_waitcnt lgkmcnt(0)" ::: "memory");
            }
        }
#undef SCAN_LOADW
#undef SCAN_STEPS
    }
#undef SCAN_DMA
}
__device__ __forceinline__ void phase_scan_att2(const Args& a, int l, PG8_LAS unsigned char* lds) {
    const int bx = blockIdx.x;
    const int j = (bx & 7) * 16 + (bx >> 4);
    if (((bx >> 3) & 1) == 0) scan32(a, l, j, lds);
    else {
        const int bh = j >> 1, b = bh >> 3, h = bh & 7;
#pragma unroll 1
        for (int q = 0; q < 2; ++q) { const int s = 2 * (j & 1) + q; att::unit(a, l, b, h, 7 - s, lds); att::unit(a, l, b, h, s, lds); }
        __syncthreads();
        const int tid = tid_fresh(), lane = tid & 63, wid = tid >> 6;
        float* scr = (float*)((unsigned char*)lds) + wid * (64 * 33);
        CvtItem c0, c1; float4 v0[8], v1[8];
        int it = j * 8 + wid; const int NCW = 128 * 8;
        bool h0 = cvt_decode(a, l, it, c0); if (h0) cvt_load(c0, lane, v0);
        while (h0) {
            const bool h1 = cvt_decode(a, l, it + NCW, c1); if (h1) cvt_load(c1, lane, v1);
            cvt_finish(c0, lane, v0, scr);
            it += 2 * NCW;
            h0 = h1 && cvt_decode(a, l, it, c0); if (h0) cvt_load(c0, lane, v0);
            if (h1) cvt_finish(c1, lane, v1, scr);
        }
    }
}

__device__ __forceinline__ void phase_dense_res(const void* A, const void* WT, const float* RES, float* OUT, PG8_LAS unsigned char* lds) {
    pg8::DenseSched S; S.init(A, DM, NTOK, WT, DM, DM);
    pg8::EpiF32Res E{OUT, RES, DM, ALPHA};
    pg8::gemm_phase<pg8::EpiF32Res, pg8::DenseSched, false>(lds, pg8::Dims{DM, DM, DM}, S, E);
}
__device__ __forceinline__ void phase_dense_bf16(const void* A, int M, const void* WT, int N, bf16_t* OUT, PG8_LAS unsigned char* lds) {
    pg8::DenseSched S; S.init(A, DM, M, WT, DM, N);
    pg8::EpiBf16 E{OUT, N};
    pg8::gemm_phase<pg8::EpiBf16, pg8::DenseSched, false>(lds, pg8::Dims{DM, DM, DM}, S, E);
}

__device__ __forceinline__ void ln_row(const float* in, const float* g, const float* bta, float* out, bf16_t* outb, int lane, float (&xn)[16]) {
    float x[16];
#pragma unroll
    for (int m = 0; m < 4; ++m) { const float4 v = *(const float4*)(in + m * 256 + lane * 4); x[m * 4] = v.x; x[m * 4 + 1] = v.y; x[m * 4 + 2] = v.z; x[m * 4 + 3] = v.w; }
    float s = 0.f;
#pragma unroll
    for (int k = 0; k < 16; ++k) s += x[k];
    const float mean = wsum(s) * (1.0f / 1024.0f);
    float q = 0.f;
#pragma unroll
    for (int k = 0; k < 16; ++k) { const float d = x[k] - mean; q = fmaf(d, d, q); }
    const float var = wsum(q) * (1.0f / 1024.0f);
    const float rstd = rsqrtf(var + 1e-5f);
#pragma unroll
    for (int m = 0; m < 4; ++m) {
        const float4 gv = *(const float4*)(g + m * 256 + lane * 4), bv = *(const float4*)(bta + m * 256 + lane * 4);
        float4 o;
        o.x = (x[m * 4] - mean) * rstd * gv.x + bv.x; o.y = (x[m * 4 + 1] - mean) * rstd * gv.y + bv.y;
        o.z = (x[m * 4 + 2] - mean) * rstd * gv.z + bv.z; o.w = (x[m * 4 + 3] - mean) * rstd * gv.w + bv.w;
        xn[m * 4] = o.x; xn[m * 4 + 1] = o.y; xn[m * 4 + 2] = o.z; xn[m * 4 + 3] = o.w;
        *(float4*)(out + m * 256 + lane * 4) = o;
        uint2 ob; ob.x = pk2(o.x, o.y); ob.y = pk2(o.z, o.w); *(uint2*)(outb + m * 256 + lane * 4) = ob;
    }
}
__device__ __forceinline__ void phase_ln(const float* IN, const float* g, const float* bta, float* OUT, bf16_t* OUTB) {
    const int tid = tid_fresh(), lane = tid & 63, wid = tid >> 6;
    for (int row = blockIdx.x * 8 + wid; row < NTOK; row += gridDim.x * 8) {
        float xn[16];
        ln_row(IN + (size_t)row * DM, g, bta, OUT + (size_t)row * DM, OUTB + (size_t)row * DM, lane, xn);
    }
}

__device__ __forceinline__ float treduce32(float (&p)[32], int lane) {
    float q[16], r[8], s4[4], t2[2];
#pragma unroll
    for (int i = 0; i < 16; ++i) { auto sw = __builtin_amdgcn_permlane32_swap(__float_as_uint(p[i]), __float_as_uint(p[i + 16]), false, false); q[i] = __uint_as_float(sw[0]) + __uint_as_float(sw[1]); }
    const bool L4 = (lane & 16) != 0, L3 = (lane & 8) != 0, L2 = (lane & 4) != 0, L1 = (lane & 2) != 0;
#pragma unroll
    for (int i = 0; i < 8; ++i) { const float snd = L4 ? q[i] : q[i + 8], keep = L4 ? q[i + 8] : q[i]; r[i] = keep + __shfl_xor(snd, 16); }
#pragma unroll
    for (int i = 0; i < 4; ++i) { const float snd = L3 ? r[i] : r[i + 4], keep = L3 ? r[i + 4] : r[i]; s4[i] = keep + SC_DPP(snd, 0x140); }
#pragma unroll
    for (int i = 0; i < 2; ++i) { const float snd = L2 ? s4[i] : s4[i + 2], keep = L2 ? s4[i + 2] : s4[i]; t2[i] = keep + SC_DPP(snd, 0x141); }
    const float snd = L1 ? t2[0] : t2[1], keep = L1 ? t2[1] : t2[0];
    float u = keep + SC_DPP(snd, 0x4E);
    u += SC_DPP(u, 0xB1);
    return __shfl(u, (lane & 31) * 2);
}
struct RouteRes { int e0, e1; float g0, g1; };
__device__ __forceinline__ RouteRes route_row(float mylogit, int lane, const float* BR) {
    const float s = sigmoidf_(mylogit);
    const float sel = (lane < 32) ? s + BR[lane & 31] : NEG_INF;
    const int gb = lane & ~3;
    const float v0 = __shfl(sel, gb), v1 = __shfl(sel, gb + 1), v2 = __shfl(sel, gb + 2), v3 = __shfl(sel, gb + 3);
    const float m1 = fmaxf(fmaxf(v0, v1), fmaxf(v2, v3));
    float m2;
    { const float lo01 = fminf(v0, v1), hi01 = fmaxf(v0, v1), lo23 = fminf(v2, v3), hi23 = fmaxf(v2, v3);
      m2 = fmaxf(fminf(hi01, hi23), fmaxf(lo01, lo23)); }
    float gs = (lane < 32) ? (m1 + m2) : NEG_INF;
    int gi = lane >> 2;
#pragma unroll
    for (int o = 32; o > 0; o >>= 1) { const float ov = __shfl_xor(gs, o); const int oi = __shfl_xor(gi, o); if (ov > gs || (ov == gs && oi < gi)) { gs = ov; gi = oi; } }
    const int gbest = gi;
    const float c0 = __shfl(sel, gbest * 4), c1 = __shfl(sel, gbest * 4 + 1), c2 = __shfl(sel, gbest * 4 + 2), c3 = __shfl(sel, gbest * 4 + 3);
    int j0 = 0; float b0 = c0;
    if (c1 > b0) { b0 = c1; j0 = 1; } if (c2 > b0) { b0 = c2; j0 = 2; } if (c3 > b0) { b0 = c3; j0 = 3; }
    int j1 = -1; float b1 = -3e38f;
    if (j0 != 0 && c0 > b1) { b1 = c0; j1 = 0; } if (j0 != 1 && c1 > b1) { b1 = c1; j1 = 1; } if (j0 != 2 && c2 > b1) { b1 = c2; j1 = 2; } if (j0 != 3 && c3 > b1) { b1 = c3; j1 = 3; }
    RouteRes R; R.e0 = gbest * 4 + j0; R.e1 = gbest * 4 + j1;
    const float s0 = __shfl(s, R.e0), s1 = __shfl(s, R.e1);
    const float inv = 1.0f / (s0 + s1);
    R.g0 = s0 * inv; R.g1 = s1 * inv;
    return R;
}
__device__ __forceinline__ void phase_ln2_router(const Args& a, int l, float* lds, bool dummy = false) {
    const int tid = tid_fresh(), lane = tid & 63, wid = tid >> 6;
    const float* PRE = (const float*)(a.ws + WS_PRE2);
    float* X2 = (float*)(a.ws + WS_X2); bf16_t* X2B = (bf16_t*)(a.ws + WS_X2B);
    const float* g = a.in[28] + (size_t)(l * 3 + 1) * DM; const float* bta = a.in[29] + (size_t)(l * 3 + 1) * DM;
    const float* WR = a.in[23]; const float* BR = a.in[24];
    unsigned* cnt = (unsigned*)(a.ws + WS_CTL) + CW_CNT + l * 32 + (dummy ? 128 : 0);
    int2* list = (int2*)(a.ws + (dummy ? WS_H : WS_LIST));
    int2* tokpos = (int2*)(a.ws + (dummy ? WS_H + 8 * MiB : WS_TOKPOS));
    float2* tokgate = (float2*)(a.ws + (dummy ? WS_H + 9 * MiB : WS_TOKGATE));
    constexpr int WR_LD = DM + 4;
    unsigned* lcnt = (unsigned*)(lds + NEXP * WR_LD);
    int* lres = (int*)(lds + NEXP * WR_LD + 64);
    __syncthreads();
    {
        float4 wv[16];
#pragma unroll
        for (int q = 0; q < 16; ++q) wv[q] = *(const float4*)(WR + (size_t)(q * NTHREADS + tid) * 4);
#pragma unroll
        for (int q = 0; q < 16; ++q) { const int idx = (q * NTHREADS + tid) * 4, k = idx >> 5, e = idx & 31;
            lds[e * WR_LD + k] = wv[q].x; lds[(e + 1) * WR_LD + k] = wv[q].y; lds[(e + 2) * WR_LD + k] = wv[q].z; lds[(e + 3) * WR_LD + k] = wv[q].w; }
    }
    if (tid < 64) lcnt[tid] = 0u;
    __syncthreads();
    int nloc = 0;
    for (int row = (blockIdx.x * 8 + wid) * 2; row < NTOK; row += gridDim.x * 16) {
        float xa[16], xb[16];
        ln_row(PRE + (size_t)row * DM, g, bta, X2 + (size_t)row * DM, X2B + (size_t)row * DM, lane, xa);
        ln_row(PRE + (size_t)(row + 1) * DM, g, bta, X2 + (size_t)(row + 1) * DM, X2B + (size_t)(row + 1) * DM, lane, xb);
        float pa[32], pb[32];
#pragma unroll
        for (int e = 0; e < NEXP; ++e) {
            float sa_ = 0.f, sb_ = 0.f;
#pragma unroll
            for (int m = 0; m < 4; ++m) { const float4 wv = *(const float4*)&lds[e * WR_LD + m * 256 + lane * 4];
                sa_ = fmaf(xa[m * 4], wv.x, sa_); sa_ = fmaf(xa[m * 4 + 1], wv.y, sa_); sa_ = fmaf(xa[m * 4 + 2], wv.z, sa_); sa_ = fmaf(xa[m * 4 + 3], wv.w, sa_);
                sb_ = fmaf(xb[m * 4], wv.x, sb_); sb_ = fmaf(xb[m * 4 + 1], wv.y, sb_); sb_ = fmaf(xb[m * 4 + 2], wv.z, sb_); sb_ = fmaf(xb[m * 4 + 3], wv.w, sb_); }
            pa[e] = sa_; pb[e] = sb_;
        }
        const float la = treduce32(pa, lane), lb = treduce32(pb, lane);
#pragma unroll
        for (int q = 0; q < 2; ++q) {
            const RouteRes R = route_row(q ? lb : la, lane, BR);
            if (lane == 0) {
                const unsigned r0 = atomicAdd(&lcnt[R.e0], 1u), r1 = atomicAdd(&lcnt[R.e1], 1u);
                int* o = lres + (wid * 32 + nloc + q) * 8;
                o[0] = row + q; o[1] = R.e0; o[2] = R.e1; o[3] = (int)r0; o[4] = (int)r1; o[5] = __float_as_int(R.g0); o[6] = __float_as_int(R.g1);
            }
        }
        nloc += 2;
    }
    __syncthreads();
    if (tid < 32) lcnt[32 + tid] = atomicAdd(&cnt[tid], lcnt[tid]);
    __syncthreads();
    for (int i = lane; i < nloc; i += 64) {
        const int* o = lres + (wid * 32 + i) * 8;
        const int row = o[0], e0 = o[1], e1 = o[2]; const unsigned r0 = lcnt[32 + e0] + (unsigned)o[3], r1 = lcnt[32 + e1] + (unsigned)o[4];
        list[(size_t)e0 * LCAP + r0] = make_int2(row, o[5]);
        list[(size_t)e1 * LCAP + r1] = make_int2(row, o[6]);
        tokpos[row * 2] = make_int2(e0, (int)r0); tokpos[row * 2 + 1] = make_int2(e1, (int)r1);
        tokgate[row] = make_float2(__int_as_float(o[5]), __int_as_float(o[6]));
    }
}

constexpr int ZERO_ROW = 32768 / 2048;
struct I2 { int x, y; };
struct MoeSched {
    int G, c, T, npn; PG8_LAS I2* tab;
    const char* A; const char* B; size_t b_e, b_pn, a_tile; int colw;
    const int2* list; int gat_row0;
    __device__ void init(PG8_LAS unsigned char* lds, const unsigned* cnt, int npn_, const void* A_, size_t a_tile_, const void* B_, size_t b_e_, size_t b_pn_, int colw_, const int2* list_, int gat_row0_) {
        const int lane = tid_fresh() & 63, x = lane & 31;
        G = gridDim.x; c = blockIdx.x; npn = npn_; A = (const char*)A_; a_tile = a_tile_; B = (const char*)B_; b_e = b_e_; b_pn = b_pn_; colw = colw_; list = list_; gat_row0 = gat_row0_;
        const unsigned cnt_l = __hip_atomic_load(cnt + x, __ATOMIC_RELAXED, __HIP_MEMORY_SCOPE_AGENT);
        const int tiles = (int)((cnt_l + 255u) >> 8);
        int inc = tiles;
#pragma unroll
        for (int o = 1; o < 32; o <<= 1) { const int t = __shfl_up(inc, o, 32); if (x >= o) inc += t; }
        tab = (PG8_LAS I2*)(lds + pg8::STAGE_BYTES + 8192);
        tab[x].x = (int)cnt_l; tab[x].y = inc - tiles;
        T = __builtin_amdgcn_readfirstlane(__shfl(inc, 31));
        __syncthreads();
    }
    __device__ __forceinline__ bool next(int i, pg8::Unit& u) const {
        const long L = (long)i * G + c; if (L >= (long)T * npn) return false;
        const int ti = (int)(L / npn), pn = (int)(L % npn);
        const int my_excl = tab[__builtin_amdgcn_mbcnt_lo(~0u, 0u) & 31].y;
        const unsigned long long m = __ballot(my_excl <= ti) & 0xffffffffull;
        const int e = __popcll(m) - 1;
        const int rt = ti - tab[e].y;
        const unsigned ce = (unsigned)tab[e].x;
        u.aux = __builtin_amdgcn_readfirstlane(e | (rt << 8)); u.aux2 = __builtin_amdgcn_readfirstlane((int)ce);
        u.row0 = ti * 256; u.col0 = pn * colw;
        u.A = A + (size_t)ti * a_tile; u.B = B + (size_t)e * b_e + (size_t)pn * b_pn;
        return true;
    }
    __device__ __forceinline__ int arow(const pg8::Unit& u, int r) const {
        const int e = u.aux & 255, rank = (u.aux >> 8) * 256 + r;
        return rank < u.aux2 ? gat_row0 + list[(size_t)e * LCAP + rank].x : ZERO_ROW;
    }
};
struct EpiSwiGLU {
    static constexpr bool PERM = true;
    bf16_t* H;
    __device__ __forceinline__ void operator()(const pg8::f32x4 (&acc)[2][2][4][2], const pg8::Unit& u, int wr, int wc, int fr, int fq) const {
        const int col = u.col0 + wc * 32 + 8 * fq;
#pragma unroll
        for (int ai = 0; ai < 2; ++ai)
#pragma unroll
            for (int m = 0; m < 4; ++m) {
                const int r = wr * 64 + fr + ai * 128 + m * 16;
                float hv[8];
#pragma unroll
                for (int n = 0; n < 2; ++n)
#pragma unroll
                    for (int j = 0; j < 4; ++j) { const float g = acc[ai][0][m][n][j], up = acc[ai][1][m][n][j]; hv[n * 4 + j] = g * up * __builtin_amdgcn_rcpf(1.0f + __expf(-g)); }
                pg8::u32x4 w; w.x = pk2(hv[0], hv[1]); w.y = pk2(hv[2], hv[3]); w.z = pk2(hv[4], hv[5]); w.w = pk2(hv[6], hv[7]);
                *(pg8::u32x4*)(H + (size_t)(u.row0 + r) * DEXP + col) = w;
            }
    }
};
__device__ __forceinline__ void phase_f3(const Args& a, int l, PG8_LAS unsigned char* lds) {
    const unsigned* cnt = (const unsigned*)(a.ws + WS_CTL) + CW_CNT + l * 32;
    const int2* list = (const int2*)(a.ws + WS_LIST);
    MoeSched S; S.init(lds, cnt, 4, a.ws, 0, a.ws + WS_WEXP, (size_t)1024 * 1024 * 2, (size_t)256 * 1024 * 2, 128, list, (int)(WS_X2B / 2048));
    EpiSwiGLU E{(bf16_t*)(a.ws + WS_H)};
    pg8::gemm_phase<EpiSwiGLU, MoeSched, true>(lds, pg8::Dims{DM, DM, DM}, S, E);
}
__device__ __forceinline__ void phase_f4(const Args& a, int l, PG8_LAS unsigned char* lds) {
    const unsigned* cnt = (const unsigned*)(a.ws + WS_CTL) + CW_CNT + l * 32;
    MoeSched S; S.init(lds, cnt, 4, a.ws + WS_H, (size_t)256 * DEXP * 2, a.ws + WS_WEXP + (size_t)NEXP * 1024 * 1024 * 2, (size_t)1024 * 512 * 2, (size_t)256 * 512 * 2, 256, nullptr, 0);
    pg8::EpiBf16 E{(bf16_t*)(a.ws + WS_Y), DM};
    pg8::gemm_phase<pg8::EpiBf16, MoeSched, false>(lds, pg8::Dims{DEXP, DEXP, DEXP}, S, E);
}
__device__ __forceinline__ void phase_ln3(const Args& a, int l, float* OUT, bf16_t* OUTB) {
    const int tid = tid_fresh(), lane = tid & 63, wid = tid >> 6;
    const unsigned* cnt = (const unsigned*)(a.ws + WS_CTL) + CW_CNT + l * 32;
    const int2* tokpos = (const int2*)(a.ws + WS_TOKPOS);
    const float* X2 = (const float*)(a.ws + WS_X2); const bf16_t* Y = (const bf16_t*)(a.ws + WS_Y);
    const float* g = a.in[28] + (size_t)(l * 3 + 2) * DM; const float* bta = a.in[29] + (size_t)(l * 3 + 2) * DM;
    int mybase = 0;
    { int acc = 0; for (int x = 0; x < NEXP; ++x) { if (x == lane) mybase = acc; acc += (int)((cnt[x] + 255u) >> 8); } }
    for (int row = blockIdx.x * 8 + wid; row < NTOK; row += gridDim.x * 8) {
        const int2 p0 = tokpos[row * 2], p1 = tokpos[row * 2 + 1]; const float2 tg = ((const float2*)(a.ws + WS_TOKGATE))[row];
        const size_t h0 = (size_t)__shfl(mybase, p0.x) * 256 + p0.y, h1 = (size_t)__shfl(mybase, p1.x) * 256 + p1.y;
        const float* xr = X2 + (size_t)row * DM; const bf16_t* y0 = Y + h0 * DM; const bf16_t* y1 = Y + h1 * DM;
        float x[16];
#pragma unroll
        for (int m = 0; m < 4; ++m) { const int o = m * 256 + lane * 4; const float4 xv = *(const float4*)(xr + o); const uint2 a0 = *(const uint2*)(y0 + o), a1 = *(const uint2*)(y1 + o);
            x[m * 4] = fmaf(ALPHA, xv.x, fmaf(tg.x, bflo(a0.x), tg.y * bflo(a1.x))); x[m * 4 + 1] = fmaf(ALPHA, xv.y, fmaf(tg.x, bfhi(a0.x), tg.y * bfhi(a1.x)));
            x[m * 4 + 2] = fmaf(ALPHA, xv.z, fmaf(tg.x, bflo(a0.y), tg.y * bflo(a1.y))); x[m * 4 + 3] = fmaf(ALPHA, xv.w, fmaf(tg.x, bfhi(a0.y), tg.y * bfhi(a1.y))); }
        float s = 0.f;
#pragma unroll
        for (int k = 0; k < 16; ++k) s += x[k];
        const float mean = wsum(s) * (1.0f / 1024.0f);
        float q = 0.f;
#pragma unroll
        for (int k = 0; k < 16; ++k) { const float d = x[k] - mean; q = fmaf(d, d, q); }
        const float rstd = rsqrtf(wsum(q) * (1.0f / 1024.0f) + 1e-5f);
#pragma unroll
        for (int m = 0; m < 4; ++m) { const int o = m * 256 + lane * 4; const float4 gv = *(const float4*)(g + o), bv = *(const float4*)(bta + o); float4 r;
            r.x = (x[m * 4] - mean) * rstd * gv.x + bv.x; r.y = (x[m * 4 + 1] - mean) * rstd * gv.y + bv.y; r.z = (x[m * 4 + 2] - mean) * rstd * gv.z + bv.z; r.w = (x[m * 4 + 3] - mean) * rstd * gv.w + bv.w;
            *(float4*)(OUT + (size_t)row * DM + o) = r;
            if (OUTB) { uint2 ob; ob.x = pk2(r.x, r.y); ob.y = pk2(r.z, r.w); *(uint2*)(OUTB + (size_t)row * DM + o) = ob; } }
    }
}

constexpr int PH_PER_LAYER = 14, N_PHASES = 1 + 2 * PH_PER_LAYER;

__global__ void __launch_bounds__(NTHREADS, 2) mk_fwd(Args a) {
    extern __shared__ __attribute__((aligned(16))) unsigned char smem[];
    float* lds = (float*)smem;
    PG8_LAS unsigned char* lds3 = (PG8_LAS unsigned char*)smem;
    volatile LAS unsigned* xbw = (volatile LAS unsigned*)(smem + LDS_BYTES - 16);
    const int lo = a.ph_lo, hi = a.ph_hi;
    unsigned* ctl = (unsigned*)(a.ws + WS_CTL);
    XcdBarrier bar; bar.bar = ctl + CW_BAR; bar.x = 0; bar.st = xbw;
    if (hi - lo > 1) {
        if (threadIdx.x == 0) { xbw[0] = 0u; xbw[1] = 0u; }
        __syncthreads();
        bar = xcd_barrier_post(ctl + CW_BAR, xbw);
    }
#define IN(k) (lo <= (k) && (k) < hi)
#define SEAM(k) do { if (IN(k) && IN((k) + 1)) xcd_barrier(bar); } while (0)
    if (IN(0)) { phase_prologue(a, lds); if (PROBE_REP == 99) { xcd_barrier(bar); phase_prologue(a, lds); } }
    SEAM(0);
#define LAYER_BODY(l) do { \
        const int p0 = 1 + l * PH_PER_LAYER; \
        const float* xin = (l == 0) ? a.in[0] : (const float*)(a.ws + WS_XL1); \
        float* xout = (l == 0) ? (float*)(a.ws + WS_XL1) : a.out; \
        if (IN(p0 + 0)) { phase_g1(a, l, lds3); if (PROBE_REP == 0) { xcd_barrier(bar); phase_g1(a, l, lds3); } } \
        SEAM(p0 + 0); \
        if (IN(p0 + 1)) { phase_prep(a, l, lds); if (PROBE_REP == 1) { xcd_barrier(bar); phase_prep(a, l, lds); } } \
        SEAM(p0 + 1); \
        if (IN(p0 + 2)) { phase_scan_att2(a, l, lds3); if (PROBE_REP == 2) { xcd_barrier(bar); phase_scan_att2(a, l, lds3); } } \
        SEAM(p0 + 2); \
        if (IN(p0 + 3)) { phase_post(a, l); if (PROBE_REP == 3) { xcd_barrier(bar); phase_post(a, l); } } \
        SEAM(p0 + 3); \
        if (IN(p0 + 4)) { phase_dense_res(a.ws + WS_MIX, a.ws + WS_WOUT + (size_t)l * 2 * MiB, xin, (float*)(a.ws + WS_PRE), lds3); if (PROBE_REP == 4) { xcd_barrier(bar); phase_dense_res(a.ws + WS_MIX, a.ws + WS_WOUT + (size_t)l * 2 * MiB, xin, (float*)(a.ws + WS_PRE), lds3); } } \
        SEAM(p0 + 4); \
        if (IN(p0 + 5)) { phase_ln((const float*)(a.ws + WS_PRE), a.in[28] + (size_t)(l * 3) * DM, a.in[29] + (size_t)(l * 3) * DM, (float*)(a.ws + WS_X1), (bf16_t*)(a.ws + WS_X1B)); if (PROBE_REP == 5) { xcd_barrier(bar); phase_ln((const float*)(a.ws + WS_PRE), a.in[28] + (size_t)(l * 3) * DM, a.in[29] + (size_t)(l * 3) * DM, (float*)(a.ws + WS_X1), (bf16_t*)(a.ws + WS_X1B)); } } \
        SEAM(p0 + 5); \
        if (IN(p0 + 6)) { phase_dense_bf16(a.ws + WS_X1B, NTOK, a.ws + WS_WQ + (size_t)l * 2 * MiB, DM, (bf16_t*)(a.ws + WS_Q), lds3); if (PROBE_REP == 6) { xcd_barrier(bar); phase_dense_bf16(a.ws + WS_X1B, NTOK, a.ws + WS_WQ + (size_t)l * 2 * MiB, DM, (bf16_t*)(a.ws + WS_Q), lds3); } } \
        SEAM(p0 + 6); \
        if (IN(p0 + 7)) { phase_matt_s(a, lds3); if (PROBE_REP == 7) { xcd_barrier(bar); phase_matt_s(a, lds3); } } \
        SEAM(p0 + 7); \
        if (IN(p0 + 8)) { phase_matt_pv(a, lds3); if (PROBE_REP == 8) { xcd_barrier(bar); phase_matt_pv(a, lds3); } } \
        SEAM(p0 + 8); \
        if (IN(p0 + 9)) { phase_dense_res(a.ws + WS_O, a.ws + WS_WO + (size_t)l * 2 * MiB, (const float*)(a.ws + WS_X1), (float*)(a.ws + WS_PRE2), lds3); if (PROBE_REP == 9) { xcd_barrier(bar); phase_dense_res(a.ws + WS_O, a.ws + WS_WO + (size_t)l * 2 * MiB, (const float*)(a.ws + WS_X1), (float*)(a.ws + WS_PRE2), lds3); } } \
        SEAM(p0 + 9); \
        if (IN(p0 + 10)) { phase_ln2_router(a, l, lds); if (PROBE_REP == 10) { xcd_barrier(bar); phase_ln2_router(a, l, lds, true); } } \
        SEAM(p0 + 10); \
        if (IN(p0 + 11)) { phase_f3(a, l, lds3); if (PROBE_REP == 11) { xcd_barrier(bar); phase_f3(a, l, lds3); } } \
        SEAM(p0 + 11); \
        if (IN(p0 + 12)) { phase_f4(a, l, lds3); if (PROBE_REP == 12) { xcd_barrier(bar); phase_f4(a, l, lds3); } } \
        SEAM(p0 + 12); \
        if (IN(p0 + 13)) { { phase_ln3(a, l, xout, (l == 0) ? (bf16_t*)(a.ws + WS_XB) : (bf16_t*)nullptr); } if (PROBE_REP == 13) { xcd_barrier(bar); { phase_ln3(a, l, xout, (l == 0) ? (bf16_t*)(a.ws + WS_XB) : (bf16_t*)nullptr); } } } \
        SEAM(p0 + 13); \
    } while (0)
    LAYER_BODY(0);
    LAYER_BODY(1);
}
}

extern "C" void kernel_launch(void* const* d_in, const int* in_sizes, int n_in, void* d_out, int out_size, void* d_ws, size_t ws_size, hipStream_t stream) {
    static int grid = 0;
    if (!grid) {
        int dev = 0, cus = 0, per_cu = 0;
        (void)hipGetDevice(&dev);
        (void)hipDeviceGetAttribute(&cus, hipDeviceAttributeMultiprocessorCount, dev);
        (void)hipFuncSetAttribute((const void*)mk_fwd, hipFuncAttributeMaxDynamicSharedMemorySize, LDS_BYTES);
        (void)hipOccupancyMaxActiveBlocksPerMultiprocessor(&per_cu, mk_fwd, NTHREADS, LDS_BYTES);
        (void)hipGetLastError();
        grid = cus * 1;
        if (grid != 256) grid = 256;
    }
    if (ws_size < WS_END) return;
    (void)hipMemsetAsync(d_ws, 0, CTL_ZERO_BYTES, stream);
    Args a;
    memset(&a, 0, sizeof(a));
    for (int i = 0; i < 30; ++i) a.in[i] = (const float*)d_in[i];
    a.out = (float*)d_out; a.ws = (unsigned char*)d_ws;
#if MK_ONE_LAUNCH
    a.ph_lo = 0; a.ph_hi = N_PHASES;
    hipLaunchKernelGGL(mk_fwd, dim3(grid), dim3(NTHREADS), LDS_BYTES, stream, a);
#else
    for (int p = 0; p < N_PHASES; ++p) {
        a.ph_lo = p; a.ph_hi = p + 1;
        hipLaunchKernelGGL(mk_fwd, dim3(grid), dim3(NTHREADS), LDS_BYTES, stream, a);
    }
#endif
}
```

```cpp
#include <hip/hip_runtime.h>
#include <stdint.h>
#include <cstring>

#ifndef PROBE_REP
#define PROBE_REP -1
#endif
#ifndef MK_ONE_LAUNCH
#define MK_ONE_LAUNCH 1
#endif

namespace {
constexpr int NTHREADS = 512;
constexpr int NTOK = 16384, SEQ = 2048, NBATCH = 8, DM = 1024;
constexpr int MEMLEN = 256;
constexpr int NH = 8, HD = 64;
constexpr int IN_COLS = 3328, ZLD = 3584;
constexpr int C_Q = 0, C_K = 512, C_V = 1024, C_R = 1536, C_KR = 2048, C_VR = 2560, C_ZW = 3072, C_ZA = 3136, C_ZG = 3200, C_ZV = 3328;
constexpr int NEXP = 32, DEXP = 512;
constexpr int LCAP = 16384;
constexpr float ALPHA = 1.4142135623730951f;
constexpr float NEG_INF = -1e30f;
constexpr int LDS_BYTES = 147456;

typedef unsigned short bf16_t;
typedef float f32x2_t __attribute__((ext_vector_type(2)));
typedef __bf16 bf16x2_t __attribute__((ext_vector_type(2)));
__device__ __forceinline__ unsigned pk2(float lo, float hi) { f32x2_t v = {lo, hi}; bf16x2_t b = __builtin_convertvector(v, bf16x2_t); return __builtin_bit_cast(unsigned, b); }
__device__ __forceinline__ bf16_t f2bf(float f) { return (bf16_t)(pk2(f, 0.f) & 0xffffu); }
__device__ __forceinline__ float bf2f(bf16_t h) { return __uint_as_float((unsigned)h << 16); }
__device__ __forceinline__ float bflo(unsigned u) { return __uint_as_float(u << 16); }
__device__ __forceinline__ float bfhi(unsigned u) { return __uint_as_float(u & 0xffff0000u); }

constexpr size_t MiB = 1u << 20;
constexpr size_t WS_CTL = 0, CTL_ZERO_BYTES = 64 * 1024;
constexpr size_t WS_LIST = 2 * MiB;
constexpr size_t WS_KB = 6 * MiB;
constexpr size_t WS_TOKPOS = 10 * MiB;
constexpr size_t WS_TOKGATE = 10 * MiB + 512 * 1024;
constexpr size_t WS_KMEAN = 11 * MiB;
constexpr size_t WS_MEMB = 12 * MiB;
constexpr size_t WS_VT = 16 * MiB;
constexpr size_t WS_WIN0 = 24 * MiB, WS_WIN1 = 31 * MiB;
constexpr size_t WS_WOUT = 38 * MiB, WS_WQ = 42 * MiB, WS_WKV = 46 * MiB, WS_WO = 54 * MiB;
constexpr size_t WS_WEXP = 58 * MiB;
constexpr size_t WS_XL1 = 154 * MiB, WS_XB = 218 * MiB, WS_VFIRST = 250 * MiB;
constexpr size_t WS_Z = 266 * MiB, WS_MIX = 378 * MiB, WS_R3 = 410 * MiB, WS_END = 508 * MiB;
constexpr int REC_TG = 644;
constexpr size_t WS_REC = 410 * MiB;
constexpr size_t WS_YRAW = 492 * MiB;
constexpr size_t WS_RVT = 154 * MiB, WS_RG = 170 * MiB;
constexpr size_t WS_BON = 20 * MiB;
constexpr size_t WS_LORA = 22 * MiB;
constexpr size_t LORA_L = 512 * 288 * 2, LORA_I = 512 * 64 * 2, LORA_G = 2 * 512 * 64 * 2, LORA_V = LORA_G + 512 * 128 * 2;
constexpr size_t WS_LSUM = 21 * MiB;
constexpr size_t WS_P = 298 * MiB;
constexpr size_t WS_PRE = 266 * MiB, WS_X1 = 410 * MiB, WS_X1B = 474 * MiB;
constexpr size_t WS_Q = 330 * MiB, WS_KV = 362 * MiB, WS_O = 266 * MiB, WS_PRE2 = 330 * MiB;
constexpr size_t WS_X2 = 410 * MiB, WS_X2B = 474 * MiB;
constexpr size_t WS_H = 266 * MiB, WS_Y = 306 * MiB;

constexpr int CW_CNT = 0;
constexpr int CW_BAR = 1024;

#define XB_TMO      128
#define XB_XCNT(j)  (256  + 64 * (j))
#define XB_XSUB(j)  (1280 + 64 * (j))
#define XB_XGEN(j)  (2304 + 64 * (j))
#define XB_TOP      3328
#define XB_TOPGEN   3392
#define XCD_BAR_WORDS 3456
#define XB_SPIN_CAP (1u << 18)
#define LAS __attribute__((address_space(3)))
__device__ __forceinline__ unsigned xb_ld(unsigned* p)              { return __hip_atomic_load(p, __ATOMIC_RELAXED, __HIP_MEMORY_SCOPE_AGENT); }
__device__ __forceinline__ unsigned xb_add(unsigned* p, unsigned v) { return __hip_atomic_fetch_add(p, v, __ATOMIC_RELAXED, __HIP_MEMORY_SCOPE_AGENT); }
__device__ __forceinline__ unsigned xb_xcc_id() { return (unsigned)__builtin_amdgcn_s_getreg((3 << 11) | 20) & 0xFu; }
#define XB_SPIN(cond, bar) do { unsigned _sp = 0; while (cond) { __builtin_amdgcn_s_sleep(1); \
    if ((++_sp & 255u) == 0u) { if (xb_ld(&(bar)[XB_TMO])) break; if (_sp > XB_SPIN_CAP) { atomicAdd(&(bar)[XB_TMO], 1u); break; } } } } while (0)
struct XcdBarrier { unsigned* bar; unsigned x; volatile LAS unsigned* st; };
__device__ __forceinline__ XcdBarrier xcd_barrier_post(unsigned* bar, volatile LAS unsigned* st) {
    XcdBarrier b; b.bar = bar; b.x = xb_xcc_id(); b.st = st;
    if (threadIdx.x == 0) (void)xb_add(&bar[XB_XCNT(b.x)], 1u);
    return b;
}
__device__ __forceinline__ void xcd_barrier_complete(unsigned* bar, unsigned x, unsigned& nloc, unsigned& nx) {
    const unsigned G = gridDim.x * gridDim.y * gridDim.z;
    unsigned sum, cnt, mine, sp = 0u;
    for (;;) {
        sum = 0u; cnt = 0u; mine = 0u;
#pragma unroll
        for (unsigned j = 0; j < 16; ++j) { const unsigned c = xb_ld(&bar[XB_XCNT(j)]); sum += c; cnt += (c > 0u) ? 1u : 0u; mine = (j == x) ? c : mine; }
        if (sum == G) break;
        __builtin_amdgcn_s_sleep(1);
        if ((++sp & 255u) == 0u) { if (xb_ld(&bar[XB_TMO])) break; if (sp > XB_SPIN_CAP) { atomicAdd(&bar[XB_TMO], 1u); break; } }
    }
    nloc = mine > 0u ? mine : 1u; nx = cnt > 0u ? cnt : 1u;
}
__device__ __forceinline__ void xcd_barrier(const XcdBarrier& b) {
    asm volatile("s_waitcnt vmcnt(0)" ::: "memory");
    __syncthreads();
    if (threadIdx.x == 0) {
        unsigned* bar = b.bar;
        __builtin_amdgcn_s_waitcnt(0);
        unsigned nloc = b.st[0], nx = b.st[1];
        if (nloc == 0u) { xcd_barrier_complete(bar, b.x, nloc, nx); b.st[0] = nloc; b.st[1] = nx; }
        const unsigned old = xb_add(&bar[XB_XSUB(b.x)], 1u);
        const unsigned gen = old / nloc;
        if (old + 1u == (gen + 1u) * nloc) {
            __builtin_amdgcn_fence(__ATOMIC_RELEASE, "agent");
            asm volatile("s_waitcnt vmcnt(0)" ::: "memory");
            const unsigned og = xb_add(&bar[XB_TOP], 1u);
            const unsigned tg = og / nx;
            if (og + 1u == (tg + 1u) * nx) xb_add(&bar[XB_TOPGEN], 1u);
            else XB_SPIN(xb_ld(&bar[XB_TOPGEN]) == tg, bar);
            __builtin_amdgcn_fence(__ATOMIC_ACQUIRE, "agent");
            xb_add(&bar[XB_XGEN(b.x)], 1u);
            asm volatile("s_waitcnt vmcnt(0)" ::: "memory");
        } else {
            XB_SPIN(xb_ld(&bar[XB_XGEN(b.x)]) == gen, bar);
            __builtin_amdgcn_fence(__ATOMIC_ACQUIRE, "agent");
            asm volatile("s_waitcnt vmcnt(0)" ::: "memory");
        }
    }
    __syncthreads();
}

__device__ __forceinline__ int tid_fresh() { int t = threadIdx.x; asm volatile("" : "+v"(t)); return t; }
__device__ __forceinline__ float wsum(float v) {
#pragma unroll
    for (int o = 32; o > 0; o >>= 1) v += __shfl_xor(v, o);
    return v;
}
__device__ __forceinline__ float wmax(float v) {
#pragma unroll
    for (int o = 32; o > 0; o >>= 1) v = fmaxf(v, __shfl_xor(v, o));
    return v;
}
__device__ __forceinline__ float sigmoidf_(float x) { return 1.0f / (1.0f + __expf(-x)); }
__device__ __forceinline__ float softplusf_(float x) { return x > 20.f ? x : log1pf(__expf(x)); }

struct Args {
    const float* in[30];
    float* out;
    unsigned char* ws;
    int ph_lo, ph_hi;
};

namespace pg8 {
#define PG8_LAS __attribute__((address_space(3)))
typedef short bf16x8 __attribute__((ext_vector_type(8)));
typedef float f32x4 __attribute__((ext_vector_type(4)));
typedef unsigned u32x4 __attribute__((ext_vector_type(4)));
constexpr int BM = 256, BK = 64, HALF = 128, HTB = HALF * BK * 2, STAGE_BYTES = 8 * HTB, NXCD = 8, WGM = 8;

__host__ __device__ __forceinline__ int lds_byte(int r, int c) { const int st = (r >> 4) * 2 + (c >> 5), rr = r & 15, cc = c & 31, ob = rr * 64 + cc * 2; return st * 1024 + (ob ^ (((ob >> 9) & 1) << 5)); }
__host__ __device__ __forceinline__ void stage_rc(int b, int& R, int& C) { const int st = b / 1024, sb = b % 1024, swz = sb ^ (((sb >> 9) & 1) << 5); R = (st >> 1) * 16 + swz / 64; C = (st & 1) * 32 + (swz % 64) / 2; }
__host__ __device__ __forceinline__ int perm32(int rho) { const int n = rho >> 4, i = rho & 15; return 8 * (i >> 2) + 4 * n + (i & 3); }

struct Unit { const char* A; const char* B; int row0, col0, aux, aux2; };
struct Dims { int lda, ldb, K; };

struct TileOrder {
    int nM, nN, nwg, G, c;
    __device__ void init(int nM_, int nN_, int G_, int c_) { nM = nM_; nN = nN_; nwg = nM * nN; G = G_; c = c_; }
    __device__ bool tile(int i, int& pm, int& pn) const {
        const long L = (long)i * G + c; if (L >= nwg) return false;
        int wgid = (int)L; { const int q = nwg / NXCD, r = nwg % NXCD, xcd = wgid % NXCD, off = wgid / NXCD; wgid = (xcd < r ? xcd * (q + 1) : r * (q + 1) + (xcd - r) * q) + off; }
        const int nig = WGM * nN, gid = wgid / nig, fm = gid * WGM, gsz = (nM - fm) < WGM ? (nM - fm) : WGM;
        pm = fm + ((wgid % nig) % gsz); pn = (wgid % nig) / gsz; return true;
    }
};
struct DenseSched {
    TileOrder o; const char* A; const char* B; int lda, ldb;
    __device__ void init(const void* A_, int lda_, int M, const void* B_, int ldb_, int N) { A = (const char*)A_; B = (const char*)B_; lda = lda_; ldb = ldb_; o.init(M / BM, N / BM, gridDim.x, blockIdx.x); }
    __device__ __forceinline__ bool next(int i, Unit& u) const { int pm, pn; if (!o.tile(i, pm, pn)) return false;
        u.A = A + (size_t)pm * BM * lda * 2; u.B = B + (size_t)pn * BM * ldb * 2; u.row0 = pm * BM; u.col0 = pn * BM; u.aux = 0; u.aux2 = 0; return true; }
    __device__ __forceinline__ int arow(const Unit&, int r) const { return r; }
};

__device__ __forceinline__ unsigned cvt_pk_bf16(float lo, float hi) { unsigned r; asm volatile("v_cvt_pk_bf16_f32 %0, %1, %2" : "=v"(r) : "v"(lo), "v"(hi)); return r; }

struct EpiBf16 {
    static constexpr bool PERM = true;
    bf16_t* O; int ldc;
    __device__ __forceinline__ void operator()(const f32x4 (&acc)[2][2][4][2], const Unit& u, int wr, int wc, int fr, int fq) const {
        const int row0 = u.row0 + wr * 64 + fr, col0 = u.col0 + wc * 32 + 8 * fq;
#pragma unroll
        for (int ai = 0; ai < 2; ++ai)
#pragma unroll
            for (int m = 0; m < 4; ++m) { bf16_t* rowp = O + (size_t)(row0 + ai * HALF + m * 16) * ldc + col0;
#pragma unroll
                for (int bj = 0; bj < 2; ++bj) { const f32x4 v0 = acc[ai][bj][m][0], v1 = acc[ai][bj][m][1];
                    u32x4 w; w.x = cvt_pk_bf16(v0[0], v0[1]); w.y = cvt_pk_bf16(v0[2], v0[3]); w.z = cvt_pk_bf16(v1[0], v1[1]); w.w = cvt_pk_bf16(v1[2], v1[3]);
                    *(u32x4*)(rowp + bj * HALF) = w; } }
    }
};
struct EpiF32Res {
    static constexpr bool PERM = false;
    float* C; const float* RES; int ldc; float rs; const bf16_t* RESB;
    __device__ __forceinline__ void operator()(const f32x4 (&acc)[2][2][4][2], const Unit& u, int wr, int wc, int fr, int fq) const {
        const int row0 = u.row0 + wr * 64 + fr, col0 = u.col0 + wc * 32 + 4 * fq;
#pragma unroll
        for (int ai = 0; ai < 2; ++ai)
#pragma unroll
            for (int m = 0; m < 4; ++m) { const size_t ro = (size_t)(row0 + ai * HALF + m * 16) * ldc + col0;
#pragma unroll
                for (int bj = 0; bj < 2; ++bj)
#pragma unroll
                    for (int n = 0; n < 2; ++n) { f32x4 r;
                        if (RESB) { const uint2 rb = *(const uint2*)(RESB + ro + bj * HALF + n * 16); r = (f32x4){bflo(rb.x), bfhi(rb.x), bflo(rb.y), bfhi(rb.y)}; }
                        else r = *(const f32x4*)(RES + ro + bj * HALF + n * 16);
                        *(f32x4*)(C + ro + bj * HALF + n * 16) = acc[ai][bj][m][n] + r * rs; } }
    }
};

struct EpiBf16Res {
    static constexpr bool PERM = true;
    bf16_t* O; const float* RES; int ldc; float rs; const bf16_t* RESB;
    __device__ __forceinline__ void operator()(const f32x4 (&acc)[2][2][4][2], const Unit& u, int wr, int wc, int fr, int fq) const {
        const int row0 = u.row0 + wr * 64 + fr, col0 = u.col0 + wc * 32 + 8 * fq;
#pragma unroll
        for (int ai = 0; ai < 2; ++ai)
#pragma unroll
            for (int m = 0; m < 4; ++m) { const size_t ro = (size_t)(row0 + ai * HALF + m * 16) * ldc + col0;
#pragma unroll
                for (int bj = 0; bj < 2; ++bj) { f32x4 r0, r1;
                    if (RESB) { const uint4 rb = *(const uint4*)(RESB + ro + bj * HALF); r0 = (f32x4){bflo(rb.x), bfhi(rb.x), bflo(rb.y), bfhi(rb.y)}; r1 = (f32x4){bflo(rb.z), bfhi(rb.z), bflo(rb.w), bfhi(rb.w)}; }
                    else { r0 = *(const f32x4*)(RES + ro + bj * HALF); r1 = *(const f32x4*)(RES + ro + bj * HALF + 4); }
                    const f32x4 v0 = acc[ai][bj][m][0] + r0 * rs, v1 = acc[ai][bj][m][1] + r1 * rs;
                    u32x4 w; w.x = cvt_pk_bf16(v0[0], v0[1]); w.y = cvt_pk_bf16(v0[2], v0[3]); w.z = cvt_pk_bf16(v1[0], v1[1]); w.w = cvt_pk_bf16(v1[2], v1[3]);
                    *(u32x4*)(O + ro + bj * HALF) = w; } }
    }
};

__device__ __forceinline__ void store_bf16_tile(const f32x4 (&acc)[2][2][4][2], bf16_t* O, int ldc, int row0, int col0) {
#pragma unroll
    for (int ai = 0; ai < 2; ++ai)
#pragma unroll
        for (int m = 0; m < 4; ++m) { bf16_t* rowp = O + (size_t)(row0 + ai * HALF + m * 16) * ldc + col0;
#pragma unroll
            for (int bj = 0; bj < 2; ++bj) { const f32x4 v0 = acc[ai][bj][m][0], v1 = acc[ai][bj][m][1];
                u32x4 w; w.x = cvt_pk_bf16(v0[0], v0[1]); w.y = cvt_pk_bf16(v0[2], v0[3]); w.z = cvt_pk_bf16(v1[0], v1[1]); w.w = cvt_pk_bf16(v1[2], v1[3]);
                *(u32x4*)(rowp + bj * HALF) = w; } }
}
struct EpiG1 {
    static constexpr bool PERM = true;
    bf16_t* Z; bf16_t* KB; bf16_t* VT;
    __device__ __forceinline__ void operator()(const f32x4 (&acc)[2][2][4][2], const Unit& u, int wr, int wc, int fr, int fq) const {
        bf16_t* O = Z; int ldc = ZLD;
        if (u.aux == 1) { O = KB; ldc = 1024; } else if (u.aux >= 2) { O = VT + (size_t)(u.aux - 2) * 1024 * 256; ldc = 256; }
        store_bf16_tile(acc, O, ldc, u.row0 + wr * 64 + fr, u.col0 + wc * 32 + 8 * fq);
    }
};
struct EpiSoftmax {
    static constexpr bool PERM = true;
    bf16_t* P; float* LSUM; PG8_LAS float* xmax;
    __device__ __forceinline__ void operator()(const f32x4 (&acc)[2][2][4][2], const Unit& u, int wr, int wc, int fr, int fq) const {
        const float c = 0.0625f * 1.4426950408889634f;
#pragma unroll
        for (int ai = 0; ai < 2; ++ai)
#pragma unroll
            for (int m = 0; m < 4; ++m) {
                float mx = acc[ai][0][m][0][0];
#pragma unroll
                for (int bj = 0; bj < 2; ++bj)
#pragma unroll
                    for (int n = 0; n < 2; ++n)
#pragma unroll
                        for (int j = 0; j < 4; ++j) mx = fmaxf(mx, acc[ai][bj][m][n][j]);
                mx = fmaxf(mx, __shfl_xor(mx, 16)); mx = fmaxf(mx, __shfl_xor(mx, 32));
                if (fq == 0) xmax[wc * 256 + wr * 64 + fr + ai * 128 + m * 16] = mx;
            }
        asm volatile("s_waitcnt lgkmcnt(0)" ::: "memory"); __builtin_amdgcn_s_barrier(); asm volatile("" ::: "memory");
        const int hm = u.col0 >> 8;
#pragma unroll
        for (int ai = 0; ai < 2; ++ai)
#pragma unroll
            for (int m = 0; m < 4; ++m) {
                int r = wr * 64 + fr + ai * 128 + m * 16; asm volatile("" : "+v"(r) :: "memory");
                const float M = fmaxf(fmaxf(xmax[r], xmax[256 + r]), fmaxf(xmax[512 + r], xmax[768 + r]));
                float sum = 0.f; bf16_t* rowp = P + (size_t)(u.row0 + r) * 1024 + u.col0 + wc * 32 + 8 * fq;
#pragma unroll
                for (int bj = 0; bj < 2; ++bj) {
                    float e[8];
#pragma unroll
                    for (int n = 0; n < 2; ++n)
#pragma unroll
                        for (int j = 0; j < 4; ++j) { e[n * 4 + j] = __builtin_amdgcn_exp2f((acc[ai][bj][m][n][j] - M) * c); sum += e[n * 4 + j]; }
                    u32x4 w; w.x = pk2(e[0], e[1]); w.y = pk2(e[2], e[3]); w.z = pk2(e[4], e[5]); w.w = pk2(e[6], e[7]);
                    *(u32x4*)(rowp + bj * HALF) = w;
                }
                sum += __shfl_xor(sum, 16); sum += __shfl_xor(sum, 32);
                if (fq == 0) LSUM[((size_t)(u.row0 + r) * 4 + hm) * 4 + wc] = sum;
            }
        asm volatile("s_waitcnt lgkmcnt(0)" ::: "memory"); __builtin_amdgcn_s_barrier(); asm volatile("" ::: "memory");
    }
};
struct EpiPV {
    static constexpr bool PERM = true;
    bf16_t* O; const float* LSUM;
    __device__ __forceinline__ void operator()(const f32x4 (&acc)[2][2][4][2], const Unit& u, int wr, int wc, int fr, int fq) const {
        const int hm = u.col0 >> 8;
#pragma unroll
        for (int ai = 0; ai < 2; ++ai)
#pragma unroll
            for (int m = 0; m < 4; ++m) {
                int row = u.row0 + wr * 64 + fr + ai * 128 + m * 16; asm volatile("" : "+v"(row) :: "memory");
                const f32x4 ls = *(const f32x4*)(LSUM + ((size_t)row * 4 + hm) * 4);
                const float inv = 1.0f / ((ls[0] + ls[1]) + (ls[2] + ls[3]));
                bf16_t* rowp = O + (size_t)row * 1024 + u.col0 + wc * 32 + 8 * fq;
#pragma unroll
                for (int bj = 0; bj < 2; ++bj) { const f32x4 v0 = acc[ai][bj][m][0] * inv, v1 = acc[ai][bj][m][1] * inv;
                    u32x4 w; w.x = cvt_pk_bf16(v0[0], v0[1]); w.y = cvt_pk_bf16(v0[2], v0[3]); w.z = cvt_pk_bf16(v1[0], v1[1]); w.w = cvt_pk_bf16(v1[2], v1[3]);
                    *(u32x4*)(rowp + bj * HALF) = w; }
            }
    }
};
struct G1Sched {
    TileOrder o; const char *XB, *WIN, *MEMB, *WKV;
    __device__ void init(const void* XB_, const void* WIN_, int nN, const void* MEMB_, const void* WKV_) { XB = (const char*)XB_; WIN = (const char*)WIN_; MEMB = (const char*)MEMB_; WKV = (const char*)WKV_; o.init(64, nN, gridDim.x, blockIdx.x); }
    __device__ __forceinline__ bool next(int i, Unit& u) const {
        int pm, pn; u.aux2 = 0;
        if (o.tile(i, pm, pn)) { u.A = XB + (size_t)pm * BM * 2048; u.B = WIN + (size_t)pn * BM * 2048; u.row0 = pm * BM; u.col0 = pn * BM; u.aux = 0; return true; }
        const long L = (long)i * o.G + o.c - o.nwg;
        if (L >= 64) return false;
        if (L < 32) { pm = (int)L >> 2; pn = (int)L & 3; u.A = MEMB + (size_t)pm * BM * 2048; u.B = WKV + (size_t)pn * BM * 2048; u.row0 = pm * BM; u.col0 = pn * BM; u.aux = 1; return true; }
        const int b = ((int)L - 32) >> 2; pm = ((int)L - 32) & 3;
        u.A = WKV + (size_t)(1024 + pm * BM) * 2048; u.B = MEMB + (size_t)b * BM * 2048; u.row0 = pm * BM; u.col0 = 0; u.aux = 2 + b; return true;
    }
    __device__ __forceinline__ int arow(const Unit&, int r) const { return r; }
};
struct MattSched {
    int G, c; const char* A; const char* B; size_t b_batch; int b_head;
    __device__ void init(const void* A_, const void* B_, size_t b_batch_, int b_head_) { G = gridDim.x; c = blockIdx.x; A = (const char*)A_; B = (const char*)B_; b_batch = b_batch_; b_head = b_head_; }
    __device__ __forceinline__ bool next(int i, Unit& u) const {
        const long L = (long)i * G + c; if (L >= 256) return false;
        const int pm = (int)L >> 2, hm = (int)L & 3;
        u.A = A + ((size_t)pm * BM * 1024 + hm * 256) * 2; u.B = B + (size_t)(pm >> 3) * b_batch + (size_t)hm * b_head;
        u.row0 = pm * BM; u.col0 = hm * 256; u.aux = 0; u.aux2 = 0; return true;
    }
    __device__ __forceinline__ int arow(const Unit&, int r) const { return r; }
};

template <class Epi, class Sched, bool GATHER>
__device__ __forceinline__ void gemm_phase(PG8_LAS unsigned char* lds, const Dims g, const Sched& S, const Epi& E) {
    const int tid = tid_fresh(), wid = __builtin_amdgcn_readfirstlane(tid >> 6), wr = wid >> 2, wc = wid & 3;
    const int K = g.K, nt = K / BK;
    unsigned voffB[2];
#pragma unroll
    for (int i = 0; i < 2; ++i) { int R, C; stage_rc(tid * 16 + i * 8192, R, C); const int Rb = Epi::PERM ? ((R & ~31) + perm32(R & 31)) : R;
        voffB[i] = (unsigned)(Rb * g.ldb + C) * 2u; }
    const size_t kstep = (size_t)(BK * 2);
    const size_t hstepB = (size_t)HALF * g.ldb * 2;
    const unsigned ldsw = (unsigned)wid * 1024u;
    const int aoff = lds_byte(wr * 64 + (tid & 15), ((tid & 63) >> 4) * 8), boff = lds_byte(wc * 32 + (tid & 15), ((tid & 63) >> 4) * 8);
    const size_t hstepA = GATHER ? 0 : (size_t)HALF * g.lda * 2;
#define PG8_SA(b, h) (((b) * 2 + (h)) * HTB)
#define PG8_SB(b, h) ((4 + (b) * 2 + (h)) * HTB)
#define PG8_STAGE(bufoff, gbase, v0, v1) do { \
        __builtin_amdgcn_global_load_lds((const unsigned*)((const char*)(gbase) + (v0)), (PG8_LAS unsigned*)(lds + (bufoff) + ldsw), 16, 0, 0); \
        __builtin_amdgcn_global_load_lds((const unsigned*)((const char*)(gbase) + (v1)), (PG8_LAS unsigned*)(lds + (bufoff) + ldsw + 8192), 16, 0, 0); } while (0)
#define PG8_STAGEB(bufoff, gbase) PG8_STAGE(bufoff, gbase, voffB[0], voffB[1])
#define PG8_LDA(dst, b, h) do { _Pragma("unroll") for (int m = 0; m < 4; ++m) _Pragma("unroll") for (int k = 0; k < 2; ++k) dst[m][k] = *(const PG8_LAS bf16x8*)(lds + PG8_SA(b, h) + aoff + m * 2048 + k * 1024); } while (0)
#define PG8_LDB(dst, b, h) do { _Pragma("unroll") for (int n = 0; n < 2; ++n) _Pragma("unroll") for (int k = 0; k < 2; ++k) dst[n][k] = *(const PG8_LAS bf16x8*)(lds + PG8_SB(b, h) + boff + n * 2048 + k * 1024); } while (0)
#define PG8_MMA(ai, bj, At, Bt) do { __builtin_amdgcn_s_setprio(1); _Pragma("unroll") for (int m = 0; m < 4; ++m) _Pragma("unroll") for (int n = 0; n < 2; ++n) _Pragma("unroll") for (int k = 0; k < 2; ++k) \
        acc[ai][bj][m][n] = __builtin_amdgcn_mfma_f32_16x16x32_bf16(Bt[n][k], At[m][k], acc[ai][bj][m][n], 0, 0, 0); __builtin_amdgcn_s_setprio(0); } while (0)
#define PG8_WAIT_V(n) asm volatile("s_waitcnt vmcnt(" #n ")" ::: "memory")
#define PG8_WAIT_L(n) asm volatile("s_waitcnt lgkmcnt(" #n ")" ::: "memory")
#define PG8_BAR __builtin_amdgcn_s_barrier()
#define PG8_SCHED __builtin_amdgcn_sched_barrier(0)
#define PG8_VOFFA(dst, u) do { _Pragma("unroll") for (int i_ = 0; i_ < 2; ++i_) { int R_, C_; stage_rc(tid * 16 + i_ * 8192, R_, C_); _Pragma("unroll") for (int h_ = 0; h_ < 2; ++h_) { \
        const int rr_ = GATHER ? S.arow(u, R_ + h_ * HALF) : R_; dst[h_ * 2 + i_] = (unsigned)(rr_ * g.lda + C_) * 2u; } } } while (0)
    Unit cur, nxt; int ui = 0;
    if (!S.next(0, cur)) return;
    f32x4 acc[2][2][4][2];
#pragma unroll
    for (int a = 0; a < 2; ++a)
#pragma unroll
        for (int b = 0; b < 2; ++b)
#pragma unroll
            for (int m = 0; m < 4; ++m)
#pragma unroll
                for (int n = 0; n < 2; ++n) acc[a][b][m][n] = (f32x4){0.f, 0.f, 0.f, 0.f};
    bf16x8 At[4][2], B0[2][2], B1[2][2];
    unsigned vC[4];
    PG8_VOFFA(vC, cur);
    PG8_LAS u32x4* myN = (PG8_LAS u32x4*)(lds + STAGE_BYTES + tid * 16);
    const char* cA = cur.A; const char* cB = cur.B;
    PG8_STAGEB(PG8_SB(0, 0), cB); PG8_STAGEB(PG8_SB(0, 1), cB + hstepB); PG8_STAGE(PG8_SA(0, 0), cA, vC[0], vC[1]); PG8_STAGE(PG8_SA(0, 1), cA + hstepA, vC[2], vC[3]);
    if (wr == 1) PG8_BAR;
    PG8_WAIT_V(2); PG8_BAR;
    PG8_STAGEB(PG8_SB(1, 0), cB + kstep); PG8_STAGE(PG8_SA(1, 0), cA + kstep, vC[0], vC[1]); PG8_STAGEB(PG8_SB(1, 1), cB + hstepB + kstep);
    PG8_WAIT_V(6); PG8_BAR;
    for (;;) {
        const bool has_next = S.next(ui + 1, nxt);
        const char* nA = cA; const char* nB = cB;
        { unsigned vT[4];
#pragma unroll
          for (int q = 0; q < 4; ++q) vT[q] = vC[q];
          if (has_next) { nA = nxt.A; nB = nxt.B; PG8_VOFFA(vT, nxt); }
          *myN = (u32x4){vT[0], vT[1], vT[2], vT[3]}; }
#pragma unroll 1
        for (int t = 0; t < nt; t += 2) {
            const bool last = (t == nt - 2);
            const char* a1 = cA + (size_t)(t + 1) * kstep;
            const char* a2 = last ? nA : cA + (size_t)(t + 2) * kstep; const char* b2 = last ? nB : cB + (size_t)(t + 2) * kstep;
            const char* a3 = a2 + kstep; const char* b3 = b2 + kstep;
            PG8_LDB(B0, 0, 0); PG8_LDB(B1, 0, 1); PG8_SCHED; PG8_LDA(At, 0, 0); PG8_STAGE(PG8_SA(1, 1), a1 + hstepA, vC[2], vC[3]);
            if (last) { const u32x4 vn = *myN; vC[0] = vn.x; vC[1] = vn.y; vC[2] = vn.z; vC[3] = vn.w; }
            PG8_WAIT_V(8); PG8_WAIT_L(0); PG8_BAR; PG8_MMA(0, 0, At, B0); PG8_MMA(0, 1, At, B1); PG8_BAR; PG8_SCHED;
            PG8_LDA(At, 0, 1); PG8_STAGEB(PG8_SB(0, 0), b2); PG8_STAGEB(PG8_SB(0, 1), b2 + hstepB); PG8_STAGE(PG8_SA(0, 0), a2, vC[0], vC[1]);
            PG8_WAIT_V(8); PG8_WAIT_L(0); PG8_BAR; PG8_MMA(1, 0, At, B0); PG8_MMA(1, 1, At, B1); PG8_BAR; PG8_SCHED;
            PG8_LDB(B0, 1, 0); PG8_LDB(B1, 1, 1); PG8_SCHED; PG8_LDA(At, 1, 0); PG8_STAGE(PG8_SA(0, 1), a2 + hstepA, vC[2], vC[3]);
            PG8_WAIT_V(8); PG8_WAIT_L(0); PG8_BAR; PG8_MMA(0, 0, At, B0); PG8_MMA(0, 1, At, B1); PG8_BAR; PG8_SCHED;
            PG8_LDA(At, 1, 1); PG8_STAGEB(PG8_SB(1, 0), b3); PG8_STAGEB(PG8_SB(1, 1), b3 + hstepB); PG8_STAGE(PG8_SA(1, 0), a3, vC[0], vC[1]);
            PG8_WAIT_V(8); PG8_WAIT_L(0); PG8_BAR; PG8_MMA(1, 0, At, B0); PG8_MMA(1, 1, At, B1); PG8_BAR; PG8_SCHED;
        }
        if (wr == 0) PG8_BAR;
        { int ln_ = (int)__builtin_amdgcn_mbcnt_hi(~0u, __builtin_amdgcn_mbcnt_lo(~0u, 0u)); asm volatile("" : "+v"(ln_));
          E(acc, cur, wr, wc, ln_ & 15, ln_ >> 4); }
        if (!has_next) break;
#pragma unroll
        for (int a = 0; a < 2; ++a)
#pragma unroll
            for (int b = 0; b < 2; ++b)
#pragma unroll
                for (int m = 0; m < 4; ++m)
#pragma unroll
                    for (int n = 0; n < 2; ++n) acc[a][b][m][n] = (f32x4){0.f, 0.f, 0.f, 0.f};
        cur = nxt; cA = nA; cB = nB; ++ui;
        if (wr == 1) PG8_BAR;
    }
    PG8_WAIT_V(0);
    PG8_BAR;
#undef PG8_SA
#undef PG8_SB
#undef PG8_STAGE
#undef PG8_STAGEB
#undef PG8_LDA
#undef PG8_LDB
#undef PG8_MMA
#undef PG8_WAIT_V
#undef PG8_WAIT_L
#undef PG8_BAR
#undef PG8_SCHED
#undef PG8_VOFFA
}
}

template <int NBM, class AF, class Epi>
__device__ __forceinline__ void sgemm_tile(float* lds, int K, AF arow, const float* __restrict__ B0, const float* __restrict__ B1, int ldb, int n0, int N, Epi epi) {
    const int tid = tid_fresh();
    float* As = lds;
    float* Bs0 = lds + 16 * 132;
    float* Bs1 = lds + 2 * 16 * 132;
    const int ty = tid >> 5, tx = tid & 31;
    float acc0[8][4], acc1[8][4];
#pragma unroll
    for (int i = 0; i < 8; ++i)
#pragma unroll
        for (int j = 0; j < 4; ++j) { acc0[i][j] = 0.f; acc1[i][j] = 0.f; }
    const int ar = tid >> 2, ak = (tid & 3) * 4;
    const float* ap = arow(ar);
    const int bk = tid >> 5, bn = (tid & 31) * 4;
    const bool bok = (n0 + bn) < N;
    for (int k0 = 0; k0 < K; k0 += 16) {
        float4 av = ap ? *(const float4*)(ap + k0 + ak) : make_float4(0.f, 0.f, 0.f, 0.f);
        float4 bv0 = bok ? *(const float4*)(B0 + (size_t)(k0 + bk) * ldb + n0 + bn) : make_float4(0.f, 0.f, 0.f, 0.f);
        float4 bv1 = make_float4(0.f, 0.f, 0.f, 0.f);
        if (NBM == 2) { if (bok) bv1 = *(const float4*)(B1 + (size_t)(k0 + bk) * ldb + n0 + bn); }
        __syncthreads();
        As[(ak + 0) * 132 + ar] = av.x; As[(ak + 1) * 132 + ar] = av.y; As[(ak + 2) * 132 + ar] = av.z; As[(ak + 3) * 132 + ar] = av.w;
        *(float4*)&Bs0[bk * 132 + bn] = bv0;
        if (NBM == 2) *(float4*)&Bs1[bk * 132 + bn] = bv1;
        __syncthreads();
#pragma unroll 2
        for (int k = 0; k < 16; ++k) {
            const float4 a0 = *(const float4*)&As[k * 132 + ty * 8], a1 = *(const float4*)&As[k * 132 + ty * 8 + 4];
            const float a[8] = {a0.x, a0.y, a0.z, a0.w, a1.x, a1.y, a1.z, a1.w};
            const float4 b0 = *(const float4*)&Bs0[k * 132 + tx * 4];
            const float bb0[4] = {b0.x, b0.y, b0.z, b0.w};
#pragma unroll
            for (int i = 0; i < 8; ++i)
#pragma unroll
                for (int j = 0; j < 4; ++j) acc0[i][j] = fmaf(a[i], bb0[j], acc0[i][j]);
            if (NBM == 2) {
                const float4 b1 = *(const float4*)&Bs1[k * 132 + tx * 4];
                const float bb1[4] = {b1.x, b1.y, b1.z, b1.w};
#pragma unroll
                for (int i = 0; i < 8; ++i)
#pragma unroll
                    for (int j = 0; j < 4; ++j) acc1[i][j] = fmaf(a[i], bb1[j], acc1[i][j]);
            }
        }
    }
    if (bok) {
#pragma unroll
        for (int i = 0; i < 8; ++i)
#pragma unroll
            for (int j = 0; j < 4; ++j) epi(ty * 8 + i, tx * 4 + j, acc0[i][j], acc1[i][j]);
    }
}

__device__ __forceinline__ void transpose_blk(const float* W, int N, bf16_t* WT, int K, int k0, int n0, int drow0, float* scr, int lane) {
    const int kr = lane >> 3, n4 = (lane & 7) * 4;
    float4 v[8];
#pragma unroll
    for (int i = 0; i < 8; ++i) v[i] = *(const float4*)(W + (size_t)(k0 + i * 8 + kr) * N + n0 + n4);
#pragma unroll
    for (int i = 0; i < 8; ++i) { float* d = scr + (i * 8 + kr) * 33 + n4; d[0] = v[i].x; d[1] = v[i].y; d[2] = v[i].z; d[3] = v[i].w; }
    asm volatile("s_waitcnt lgkmcnt(0)" ::: "memory");
    const int c = lane & 7;
#pragma unroll
    for (int j = 0; j < 4; ++j) { const int n = (lane >> 3) + 8 * j; const float* sp = scr + (8 * c) * 33 + n;
        uint4 o; o.x = pk2(sp[0 * 33], sp[1 * 33]); o.y = pk2(sp[2 * 33], sp[3 * 33]); o.z = pk2(sp[4 * 33], sp[5 * 33]); o.w = pk2(sp[6 * 33], sp[7 * 33]);
        *(uint4*)(WT + (size_t)(drow0 + n) * K + k0 + 8 * c) = o; }
    asm volatile("s_waitcnt lgkmcnt(0)" ::: "memory");
}
__device__ __forceinline__ void transpose_item(const float* W, int K, int N, bf16_t* WT, int row_off, float* scr, int item, int lane) {
    const int nblk = N / 32, kb = item / nblk, nb = item % nblk;
    transpose_blk(W, N, WT, K, 64 * kb, 32 * nb, row_off + 32 * nb, scr, lane);
}
struct CvtItem { const float* W; bf16_t* WT; int N, K, k0, n0, drow0; };
__device__ __forceinline__ bool cvt_decode(const Args& a, int l, int it, CvtItem& c) {
    if (it >= NEXP * 768) return false;
    bf16_t* WGU = (bf16_t*)(a.ws + WS_WEXP); bf16_t* WD = WGU + (size_t)NEXP * 1024 * 1024;
    const int e = it / 768; int r = it % 768;
    if (r < 512) {
        const bool up = r >= 256; r &= 255; const int kb = r >> 4, nb = r & 15, n0 = 32 * nb;
        c.W = (up ? a.in[26] : a.in[25]) + ((size_t)l * NEXP + e) * DM * DEXP; c.N = DEXP; c.WT = WGU + (size_t)e * 1024 * 1024; c.K = DM; c.k0 = 64 * kb; c.n0 = n0; c.drow0 = 256 * (n0 >> 7) + (n0 & 127) + (up ? 128 : 0);
    } else {
        r -= 512; const int kb = r >> 5, nb = r & 31;
        c.W = a.in[27] + ((size_t)l * NEXP + e) * DEXP * DM; c.N = DM; c.WT = WD + (size_t)e * 1024 * 512; c.K = DEXP; c.k0 = 64 * kb; c.n0 = 32 * nb; c.drow0 = 32 * nb;
    }
    return true;
}
__device__ __forceinline__ void cvt_load(const CvtItem& c, int lane, float4 (&v)[8]) {
    const int kr = lane >> 3, n4 = (lane & 7) * 4;
#pragma unroll
    for (int i = 0; i < 8; ++i) v[i] = *(const float4*)(c.W + (size_t)(c.k0 + i * 8 + kr) * c.N + c.n0 + n4);
}
__device__ __forceinline__ void cvt_finish(const CvtItem& c, int lane, const float4 (&v)[8], float* scr) {
    const int kr = lane >> 3, n4 = (lane & 7) * 4;
#pragma unroll
    for (int i = 0; i < 8; ++i) { float* d = scr + (i * 8 + kr) * 33 + n4; d[0] = v[i].x; d[1] = v[i].y; d[2] = v[i].z; d[3] = v[i].w; }
    asm volatile("s_waitcnt lgkmcnt(0)" ::: "memory");
    const int cc = lane & 7;
#pragma unroll
    for (int j = 0; j < 4; ++j) { const int n = (lane >> 3) + 8 * j; const float* sp = scr + (8 * cc) * 33 + n;
        uint4 o; o.x = pk2(sp[0 * 33], sp[1 * 33]); o.y = pk2(sp[2 * 33], sp[3 * 33]); o.z = pk2(sp[4 * 33], sp[5 * 33]); o.w = pk2(sp[6 * 33], sp[7 * 33]);
        *(uint4*)(c.WT + (size_t)(c.drow0 + n) * c.K + c.k0 + 8 * cc) = o; }
    asm volatile("s_waitcnt lgkmcnt(0)" ::: "memory");
}
__device__ __forceinline__ void convert_experts(const Args& a, int l, float* lds) {
    const int tid = tid_fresh(), lane = tid & 63, wid = tid >> 6;
    float* scr = lds + wid * (64 * 33);
    const int gw = blockIdx.x * 8 + wid, NGW = gridDim.x * 8;
    bf16_t* WGU = (bf16_t*)(a.ws + WS_WEXP); bf16_t* WD = WGU + (size_t)NEXP * 1024 * 1024;
    for (int it = gw; it < NEXP * 768; it += NGW) {
        const int e = it / 768; int r = it % 768;
        if (r < 512) {
            const bool up = r >= 256; r &= 255; const int kb = r >> 4, nb = r & 15, n0 = 32 * nb;
            const float* W = (up ? a.in[26] : a.in[25]) + ((size_t)l * NEXP + e) * DM * DEXP;
            transpose_blk(W, DEXP, WGU + (size_t)e * 1024 * 1024, DM, 64 * kb, n0, 256 * (n0 >> 7) + (n0 & 127) + (up ? 128 : 0), scr, lane);
        } else {
            r -= 512; const int kb = r >> 5, nb = r & 31;
            const float* W = a.in[27] + ((size_t)l * NEXP + e) * DEXP * DM;
            transpose_blk(W, DM, WD + (size_t)e * 1024 * 512, DEXP, 64 * kb, 32 * nb, 32 * nb, scr, lane);
        }
    }
}
__device__ __forceinline__ void cvt_row(const float* in, bf16_t* out, int lane) {
#pragma unroll
    for (int j = 0; j < 4; ++j) { const float4 v = *(const float4*)(in + j * 256 + lane * 4); uint2 o; o.x = pk2(v.x, v.y); o.y = pk2(v.z, v.w); *(uint2*)(out + j * 256 + lane * 4) = o; }
}
__device__ __forceinline__ void phase_prologue(const Args& a, float* lds) {
    const int tid = tid_fresh(), lane = tid & 63, wid = tid >> 6;
    float* scr = lds + wid * (64 * 33);
    const int gw = blockIdx.x * 8 + wid, NGW = gridDim.x * 8;
    bf16_t* WIN0 = (bf16_t*)(a.ws + WS_WIN0); bf16_t* WIN1 = (bf16_t*)(a.ws + WS_WIN1);
    constexpr int I_IN = 16 * 104, I_VR = 16, I_SQ = 16 * 32, I_KV = 16 * 64;
    constexpr int NITEMS = 2 * I_IN + I_VR + 6 * I_SQ + 2 * I_KV;
    for (int it = gw; it < NITEMS; it += NGW) {
        int r = it;
        if (r < I_IN) { transpose_item(a.in[2], DM, IN_COLS, WIN0, 0, scr, r, lane); continue; } r -= I_IN;
        if (r < I_IN) { transpose_item(a.in[2] + (size_t)DM * IN_COLS, DM, IN_COLS, WIN1, 0, scr, r, lane); continue; } r -= I_IN;
        if (r < I_VR) { transpose_item(a.in[3], DM, 32, WIN1, IN_COLS, scr, r, lane); continue; } r -= I_VR;
        constexpr int I_L = 3 * I_SQ + I_KV;
        const int l = r / I_L; r -= l * I_L;
        if (r < I_SQ) { transpose_item(a.in[19] + (size_t)l * DM * DM, DM, DM, (bf16_t*)(a.ws + WS_WOUT) + (size_t)l * DM * DM, 0, scr, r, lane); continue; } r -= I_SQ;
        if (r < I_SQ) { transpose_item(a.in[20] + (size_t)l * DM * DM, DM, DM, (bf16_t*)(a.ws + WS_WQ) + (size_t)l * DM * DM, 0, scr, r, lane); continue; } r -= I_SQ;
        if (r < I_KV) { transpose_item(a.in[21] + (size_t)l * DM * 2048, DM, 2048, (bf16_t*)(a.ws + WS_WKV) + (size_t)l * DM * 2048, 0, scr, r, lane); continue; } r -= I_KV;
        transpose_item(a.in[22] + (size_t)l * DM * DM, DM, DM, (bf16_t*)(a.ws + WS_WO) + (size_t)l * DM * DM, 0, scr, r, lane);
    }
    for (int r = gw; r < 224; r += NGW) {
#pragma unroll
        for (int j = 0; j < 2; ++j) *(uint4*)(WIN1 + (size_t)(3360 + r) * DM + j * 512 + lane * 8) = make_uint4(0u, 0u, 0u, 0u);
    }
    bf16_t* XB = (bf16_t*)(a.ws + WS_XB); bf16_t* MEMB = (bf16_t*)(a.ws + WS_MEMB);
    for (int m = gw; m < NTOK; m += NGW) cvt_row(a.in[0] + (size_t)m * DM, XB + (size_t)m * DM, lane);
    for (int m = gw; m < NBATCH * MEMLEN; m += NGW) cvt_row(a.in[1] + (size_t)m * DM, MEMB + (size_t)m * DM, lane);
    {
        const int gt = blockIdx.x * NTHREADS + tid, NGT = gridDim.x * NTHREADS;
        for (int idx = gt; idx < 2 * 512 * 288; idx += NGT) {
            const int l = idx / (512 * 288); int r = idx % (512 * 288);
            bf16_t* base = (bf16_t*)(a.ws + WS_LORA + (size_t)l * LORA_L);
            if (r < 512 * 64) { const int n = r >> 6, k = r & 63; base[r] = f2bf(a.in[7][((size_t)l * 64 + k) * 512 + n]); continue; } r -= 512 * 64;
            if (r < 512 * 64) { const int n = r >> 6, k = r & 63; base[512 * 64 + r] = f2bf(a.in[9][((size_t)l * 64 + k) * 512 + n]); continue; } r -= 512 * 64;
            if (r < 512 * 128) { const int n = r >> 7, k = r & 127; base[2 * 512 * 64 + r] = f2bf(a.in[12][((size_t)l * 128 + k) * 512 + n]); continue; } r -= 512 * 128;
            { const int n = r >> 5, k = r & 31; base[2 * 512 * 64 + 512 * 128 + r] = f2bf(a.in[11][(size_t)k * 512 + n]); }
        }
    }
}

__device__ __forceinline__ void phase_g1(const Args& a, int l, PG8_LAS unsigned char* lds) {
    pg8::G1Sched S; S.init(a.ws + WS_XB, a.ws + (l == 0 ? WS_WIN0 : WS_WIN1), l == 0 ? IN_COLS / 256 : ZLD / 256, a.ws + WS_MEMB, a.ws + WS_WKV + (size_t)l * 4 * MiB);
    pg8::EpiG1 E{(bf16_t*)(a.ws + WS_Z), (bf16_t*)(a.ws + WS_KB), (bf16_t*)(a.ws + WS_VT)};
    pg8::gemm_phase<pg8::EpiG1, pg8::G1Sched, false>(lds, pg8::Dims{DM, DM, DM}, S, E);
}
__device__ __forceinline__ void phase_matt_s(const Args& a, PG8_LAS unsigned char* lds) {
    pg8::MattSched S; S.init(a.ws + WS_Q, a.ws + WS_KB, (size_t)256 * 1024 * 2, 256 * 2);
    pg8::EpiSoftmax E{(bf16_t*)(a.ws + WS_P), (float*)(a.ws + WS_LSUM), (PG8_LAS float*)(lds + pg8::STAGE_BYTES + 8192 + 512)};
    pg8::gemm_phase<pg8::EpiSoftmax, pg8::MattSched, false>(lds, pg8::Dims{1024, 1024, 256}, S, E);
}
__device__ __forceinline__ void phase_matt_pv(const Args& a, PG8_LAS unsigned char* lds) {
    pg8::MattSched S; S.init(a.ws + WS_P, a.ws + WS_VT, (size_t)1024 * 256 * 2, 256 * 256 * 2);
    pg8::EpiPV E{(bf16_t*)(a.ws + WS_O), (const float*)(a.ws + WS_LSUM)};
    pg8::gemm_phase<pg8::EpiPV, pg8::MattSched, false>(lds, pg8::Dims{1024, 256, 256}, S, E);
}

typedef _Float16 h8_t __attribute__((ext_vector_type(8)));
typedef _Float16 h2_t __attribute__((ext_vector_type(2)));
__device__ __forceinline__ unsigned pkh2(float lo, float hi) { h2_t v = {(_Float16)lo, (_Float16)hi}; return __builtin_bit_cast(unsigned, v); }
#define SC_DPP(x, ctrl) __int_as_float(__builtin_amdgcn_mov_dpp(__float_as_int(x), ctrl, 0xF, 0xF, true))
__device__ __forceinline__ float sum32(float x) {
    x += SC_DPP(x, 0xB1); x += SC_DPP(x, 0x4E); x += SC_DPP(x, 0x141); x += SC_DPP(x, 0x140);
    return x + __shfl_xor(x, 16);
}
__device__ __forceinline__ void phase_prep(const Args& a, int l, float* lds) {
    typedef short bf16x8 __attribute__((ext_vector_type(8)));
    typedef float f32x16 __attribute__((ext_vector_type(16)));
    const bf16_t* Z = (const bf16_t*)(a.ws + WS_Z);
    const int tid = tid_fresh(), lane = tid & 63, wid = tid >> 6;
    float* KM = (float*)(a.ws + WS_KMEAN);
    for (int u = blockIdx.x * 8 + wid; u < NBATCH * NH * 8; u += gridDim.x * 8) {
        const int nb = u & 7, h = (u >> 3) & 7, b = u >> 6, rg = lane >> 3, ch = lane & 7;
        const bf16_t* p = Z + (size_t)(b * SEQ + nb * 256 + rg) * ZLD + C_K + h * HD + ch * 8;
        float acc[8];
#pragma unroll
        for (int j = 0; j < 8; ++j) acc[j] = 0.f;
#pragma unroll 8
        for (int i = 0; i < 32; ++i) { const uint4 v = *(const uint4*)(p + (size_t)(i * 8) * ZLD);
            acc[0] += bflo(v.x); acc[1] += bfhi(v.x); acc[2] += bflo(v.y); acc[3] += bfhi(v.y); acc[4] += bflo(v.z); acc[5] += bfhi(v.z); acc[6] += bflo(v.w); acc[7] += bfhi(v.w); }
#pragma unroll
        for (int j = 0; j < 8; ++j) { float x = acc[j]; x += __shfl_xor(x, 8); x += __shfl_xor(x, 16); x += __shfl_xor(x, 32); acc[j] = x * (1.0f / 256.0f); }
        if (rg == 0) { *(float4*)(KM + (size_t)u * 64 + ch * 8) = make_float4(acc[0], acc[1], acc[2], acc[3]); *(float4*)(KM + (size_t)u * 64 + ch * 8 + 4) = make_float4(acc[4], acc[5], acc[6], acc[7]); }
    }
    const float* mu = a.in[4] + (size_t)l * 1792;
    const float* muv = a.in[5];
    const bf16_t* WdT = (const bf16_t*)(a.ws + WS_LORA + (size_t)l * LORA_L); const bf16_t* WiT = (const bf16_t*)(a.ws + WS_LORA + (size_t)l * LORA_L + LORA_I);
    const bf16_t* WgT = (const bf16_t*)(a.ws + WS_LORA + (size_t)l * LORA_L + LORA_G); const bf16_t* WvT = (const bf16_t*)(a.ws + WS_LORA + LORA_V);
    unsigned* REC = (unsigned*)(a.ws + WS_REC);
    _Float16* RVT = (_Float16*)(a.ws + WS_RVT); bf16_t* RGp = (bf16_t*)(a.ws + WS_RG); float* BON = (float*)(a.ws + WS_BON);
    bf16_t* VF = (bf16_t*)(a.ws + WS_VFIRST);
    uint4* afr = (uint4*)lds;
    for (int tb = blockIdx.x; tb < 512; tb += gridDim.x) {
        int lane_t = lane; asm volatile("" : "+v"(lane_t));
        const int r32 = lane_t & 31, hi = lane_t >> 5;
        const int h = wid, t0 = tb * 32, b = t0 / SEQ, tt0 = t0 % SEQ, bh = b * NH + h;
        const size_t tokA = (size_t)t0 + r32;
        const bool firstA = (tt0 == 0) && (r32 == 0);
        const size_t tokP = firstA ? tokA : tokA - 1;
        __syncthreads();
#pragma unroll
        for (int m = 0; m < 3; ++m) {
            const int idx = wid + 8 * m;
            if (idx < (l == 1 ? 18 : 16)) {
                int zcol; const float* mup; int act;
                if (idx < 8) { zcol = C_ZG + 16 * idx; mup = mu + (C_ZG - C_R) + 16 * idx; act = 2; }
                else if (idx < 12) { zcol = C_ZW + 16 * (idx - 8); mup = mu + (C_ZW - C_R) + 16 * (idx - 8); act = 1; }
                else if (idx < 16) { zcol = C_ZA + 16 * (idx - 12); mup = mu + (C_ZA - C_R) + 16 * (idx - 12); act = 0; }
                else { zcol = C_ZV + 16 * (idx - 16); mup = muv + 16 * (idx - 16); act = 0; }
                zcol += 8 * hi; mup += 8 * hi;
                const uint4 cu_ = *(const uint4*)(Z + tokA * ZLD + zcol); uint4 pv_ = *(const uint4*)(Z + tokP * ZLD + zcol); if (firstA) pv_ = make_uint4(0u, 0u, 0u, 0u);
                const float4 m0_ = *(const float4*)(mup), m1_ = *(const float4*)(mup + 4);
                float x_[8]; const unsigned cw_[4] = {cu_.x, cu_.y, cu_.z, cu_.w}, pw_[4] = {pv_.x, pv_.y, pv_.z, pv_.w}; const float mm_[8] = {m0_.x, m0_.y, m0_.z, m0_.w, m1_.x, m1_.y, m1_.z, m1_.w};
#pragma unroll
                for (int q_ = 0; q_ < 4; ++q_) { const float c0_ = bflo(cw_[q_]), c1_ = bfhi(cw_[q_]); x_[2 * q_] = c0_ + (bflo(pw_[q_]) - c0_) * mm_[2 * q_]; x_[2 * q_ + 1] = c1_ + (bfhi(pw_[q_]) - c1_) * mm_[2 * q_ + 1]; }
                if (act == 1) {
#pragma unroll
                    for (int q_ = 0; q_ < 8; ++q_) x_[q_] = 1.0f - 2.0f * __builtin_amdgcn_rcpf(__expf(2.0f * x_[q_]) + 1.0f);
                } else if (act == 2) {
#pragma unroll
                    for (int q_ = 0; q_ < 8; ++q_) x_[q_] = __builtin_amdgcn_rcpf(1.0f + __expf(-x_[q_]));
                }
                afr[idx * 64 + lane_t] = make_uint4(pk2(x_[0], x_[1]), pk2(x_[2], x_[3]), pk2(x_[4], x_[5]), pk2(x_[6], x_[7]));
            }
        }
        __syncthreads();
#define PREP_AFRAG(dst, idx_) do { const uint4 q_ = afr[(idx_) * 64 + lane_t]; pg8::u32x4 w_; w_.x = q_.x; w_.y = q_.y; w_.z = q_.z; w_.w = q_.w; dst = __builtin_bit_cast(bf16x8, w_); } while (0)
        const int chB = h * 64 + r32;
#define PREP_TOK(r) int hq_ = hi; asm volatile("" : "+v"(hq_)); const int tq = ((r) & 3) + 8 * ((r) >> 2) + 4 * hq_, t = tt0 + tq; const size_t tok = (size_t)t0 + tq; (void)t; (void)tok
#define PREP_RB(t, j) (((((size_t)bh * 512 + ((t) >> 2)) * 32 + ((j) >> 1)) * 4 + ((t) & 3)) * 5)
        f32x16 acc[2];
#pragma unroll
        for (int nb = 0; nb < 2; ++nb)
#pragma unroll
            for (int r = 0; r < 16; ++r) acc[nb][r] = 0.f;
#pragma unroll 1
        for (int sO = 0; sO < 8; sO += 4) {
            asm volatile("" ::: "memory");
#pragma unroll
            for (int sJ = 0; sJ < 4; ++sJ) { const int sI = sO + sJ;
                bf16x8 af; PREP_AFRAG(af, sI);
#pragma unroll
                for (int nb = 0; nb < 2; ++nb) acc[nb] = __builtin_amdgcn_mfma_f32_32x32x16_bf16(af, *(const bf16x8*)(WgT + (size_t)(chB + 32 * nb) * 128 + 16 * sI + 8 * hi), acc[nb], 0, 0, 0); }
        }
#pragma unroll
        for (int nb = 0; nb < 2; ++nb)
#pragma unroll
            for (int r = 0; r < 16; ++r) { PREP_TOK(r); RGp[tok * 512 + chB + 32 * nb] = f2bf(acc[nb][r]); }
#pragma unroll
        for (int nb = 0; nb < 2; ++nb)
#pragma unroll
            for (int r = 0; r < 16; ++r) acc[nb][r] = 0.f;
        asm volatile("" ::: "memory");
#pragma unroll
        for (int sI = 0; sI < 4; ++sI) {
            bf16x8 af; PREP_AFRAG(af, 8 + sI);
#pragma unroll
            for (int nb = 0; nb < 2; ++nb) acc[nb] = __builtin_amdgcn_mfma_f32_32x32x16_bf16(af, *(const bf16x8*)(WdT + (size_t)(chB + 32 * nb) * 64 + 16 * sI + 8 * hi), acc[nb], 0, 0, 0);
        }
        unsigned UW[2][8];
#pragma unroll
        for (int nb = 0; nb < 2; ++nb) {
            const float w0c = a.in[6][l * 512 + chB + 32 * nb];
#pragma unroll
            for (int g = 0; g < 4; ++g)
#pragma unroll
                for (int ts = 0; ts < 2; ++ts) { float uu[2];
#pragma unroll
                    for (int e = 0; e < 2; ++e) { const float sd = w0c + acc[nb][4 * g + ts + 2 * e]; const float sp = (sd < -15.f) ? -sd : __logf(1.0f + __expf(-sd)); uu[e] = 1.0f - __expf(-__expf(-sp - 0.5f)); }
                    UW[nb][2 * g + ts] = pkh2(uu[0], uu[1]); }
        }
        f32x16 aia[2], vga[2];
#pragma unroll
        for (int nb = 0; nb < 2; ++nb)
#pragma unroll
            for (int r = 0; r < 16; ++r) { aia[nb][r] = 0.f; vga[nb][r] = 0.f; }
        asm volatile("" ::: "memory");
#pragma unroll
        for (int sI = 0; sI < 4; ++sI) {
            bf16x8 af; PREP_AFRAG(af, 12 + sI);
#pragma unroll
            for (int nb = 0; nb < 2; ++nb) aia[nb] = __builtin_amdgcn_mfma_f32_32x32x16_bf16(af, *(const bf16x8*)(WiT + (size_t)(chB + 32 * nb) * 64 + 16 * sI + 8 * hi), aia[nb], 0, 0, 0);
        }
        if (l == 1) {
            asm volatile("" ::: "memory");
#pragma unroll
            for (int sI = 0; sI < 2; ++sI) {
                bf16x8 af; PREP_AFRAG(af, 16 + sI);
#pragma unroll
                for (int nb = 0; nb < 2; ++nb) vga[nb] = __builtin_amdgcn_mfma_f32_32x32x16_bf16(af, *(const bf16x8*)(WvT + (size_t)(chB + 32 * nb) * 32 + 16 * sI + 8 * hi), vga[nb], 0, 0, 0);
            }
        }
#undef PREP_AFRAG
        float ss[16], bon[16]; unsigned KW[2][8], RW[2][8], QW[2][8], AW[2][8];
#pragma unroll
        for (int r = 0; r < 16; ++r) { ss[r] = 0.f; bon[r] = 0.f; }
#pragma unroll
        for (int nb = 0; nb < 2; ++nb) {
            const int j = 32 * nb + r32, c = h * 64 + j;
            const float a0c = a.in[8][l * 512 + c], v0c = a.in[10][c];
            const float mu_r = mu[c], mu_k = mu[512 + c], mu_v = mu[1024 + c];
            const float kk_c = a.in[13][l * 512 + c], ka_c = a.in[14][l * 512 + c], rk_c = a.in[15][l * 512 + c];
            float v4[4], kp2[2], rr2[2], kq2[2], ai2[2];
#pragma unroll
            for (int r = 0; r < 16; ++r) {
                if ((r & 3) == 0) asm volatile("" ::: "memory");
                PREP_TOK(r);
                const float ai = sigmoidf_(a0c + aia[nb][r]);
                const float zr = bf2f(Z[tok * ZLD + C_R + c]), zk = bf2f(Z[tok * ZLD + C_KR + c]), zv = bf2f(Z[tok * ZLD + C_VR + c]);
                const size_t tokp = (t != 0) ? tok - 1 : tok; const float pm_ = (t != 0) ? 1.0f : 0.0f;
                const float pr = pm_ * bf2f(Z[tokp * ZLD + C_R + c]), pk = pm_ * bf2f(Z[tokp * ZLD + C_KR + c]), pv = pm_ * bf2f(Z[tokp * ZLD + C_VR + c]);
                const float rr_ = zr + (pr - zr) * mu_r, kx = zk + (pk - zk) * mu_k;
                float v = zv + (pv - zv) * mu_v;
                if (l == 0) VF[tok * 512 + c] = f2bf(v);
                else v = v + (bf2f(VF[tok * 512 + c]) - v) * sigmoidf_(v0c + vga[nb][r]);
                const float kkraw = kx * kk_c, kp = kx * (1.0f + (ai - 1.0f) * ka_c);
                ss[r] = fmaf(kkraw, kkraw, ss[r]); bon[r] = fmaf(rr_ * kp, rk_c, bon[r]);
                if ((r & 3) < 2) { kp2[r & 1] = kp; rr2[r & 1] = rr_; kq2[r & 1] = kkraw; ai2[r & 1] = ai; }
                else { const int wI = 2 * (r >> 2) + (r & 1); KW[nb][wI] = pkh2(kp2[r & 1], kp); RW[nb][wI] = pkh2(rr2[r & 1], rr_); QW[nb][wI] = pkh2(kq2[r & 1], kkraw); AW[nb][wI] = pkh2(ai2[r & 1], ai); }
                v4[r & 3] = v;
                if ((r & 3) == 3) {
                    uint2 pv2; pv2.x = pkh2(v4[0], v4[1]); pv2.y = pkh2(v4[2], v4[3]);
                    *(uint2*)(RVT + (((size_t)bh * 256 + ((tt0 >> 3) + (r >> 2))) * 64 + j) * 8 + 4 * hi) = pv2;
                }
            }
        }
        float rn[16];
#pragma unroll
        for (int r = 0; r < 16; ++r) {
            PREP_TOK(r);
            const float sst = sum32(ss[r]), bt = sum32(bon[r]);
            rn[r] = rsqrtf(fmaxf(sst, 1e-24f));
            BON[tok * 8 + h] = bt;
        }
        const unsigned psel = (r32 & 1) ? 0x03020706u : 0x05040100u;
#pragma unroll
        for (int nb = 0; nb < 2; ++nb)
#pragma unroll
            for (int g = 0; g < 4; ++g) {
                asm volatile("" ::: "memory");
                unsigned outw[10];
#pragma unroll
                for (int ts = 0; ts < 2; ++ts) {
                    const int wI = 2 * g + ts;
                    const h2_t q2 = __builtin_bit_cast(h2_t, QW[nb][wI]), a2 = __builtin_bit_cast(h2_t, AW[nb][wI]);
                    const float k0 = (float)q2[0] * rn[4 * g + ts], k1 = (float)q2[1] * rn[4 * g + ts + 2];
                    const unsigned mine[5] = {UW[nb][wI], pkh2(-k0, -k1), pkh2(k0 * (float)a2[0], k1 * (float)a2[1]), KW[nb][wI], RW[nb][wI]};
#pragma unroll
                    for (int q = 0; q < 5; ++q) { const unsigned oth = (unsigned)__builtin_amdgcn_mov_dpp((int)mine[q], 0xB1, 0xF, 0xF, true); outw[ts * 5 + q] = __builtin_amdgcn_perm(oth, mine[q], psel); }
                }
                const int tg = (tt0 >> 2) + 2 * g + hi, j2r = 16 * nb + (r32 >> 1);
                unsigned* dst = REC + ((size_t)bh * 512 + tg) * REC_TG + j2r * 20 + (j2r >> 4) * 4 + ((r32 & 1) ? 10 : 0);
#pragma unroll
                for (int k = 0; k < 5; ++k) { uint2 o2; o2.x = outw[2 * k]; o2.y = outw[2 * k + 1]; *(uint2*)(dst + 2 * k) = o2; }
            }
#undef PREP_TOK
#undef PREP_RB
    }
}

__device__ __forceinline__ float dpp_add(float x, float y_src, int) { return x + y_src; }
__device__ __forceinline__ float red32(float x) {
    x += SC_DPP(x, 0xB1); x += SC_DPP(x, 0x4E); x += SC_DPP(x, 0x141); x += SC_DPP(x, 0x140);
    auto rr = __builtin_amdgcn_permlane32_swap(__float_as_uint(x), __float_as_uint(x), false, false);
    return __uint_as_float(rr[0]) + __uint_as_float(rr[1]);
}
__device__ __forceinline__ float fmul_lo(float a, unsigned h) { float d; asm("v_fma_mix_f32 %0, %1, %2, 0 op_sel_hi:[0,1,0]" : "=v"(d) : "v"(a), "v"(h)); return d; }
__device__ __forceinline__ float fmix_lo(float a, unsigned h, float c) { float d; asm("v_fma_mix_f32 %0, %1, %2, %3 op_sel_hi:[0,1,0]" : "=v"(d) : "v"(a), "v"(h), "v"(c)); return d; }
__device__ __forceinline__ float fmix_hi(float a, unsigned h, float c) { float d; asm("v_fma_mix_f32 %0, %1, %2, %3 op_sel:[0,1,0] op_sel_hi:[0,1,0]" : "=v"(d) : "v"(a), "v"(h), "v"(c)); return d; }
__device__ __forceinline__ float fdec_lo(float sv, unsigned u) { float d; asm("v_fma_mix_f32 %0, -%1, %2, %1 op_sel_hi:[0,1,0]" : "=v"(d) : "v"(sv), "v"(u)); return d; }
__device__ __forceinline__ float fdec_hi(float sv, unsigned u) { float d; asm("v_fma_mix_f32 %0, -%1, %2, %1 op_sel:[0,1,0] op_sel_hi:[0,1,0]" : "=v"(d) : "v"(sv), "v"(u)); return d; }
template <int VH> __device__ __forceinline__ float fvk_lo(unsigned v, unsigned k, float c) { float d;
    if (VH) asm("v_fma_mix_f32 %0, %1, %2, %3 op_sel:[1,0,0] op_sel_hi:[1,1,0]" : "=v"(d) : "v"(v), "v"(k), "v"(c)); else asm("v_fma_mix_f32 %0, %1, %2, %3 op_sel:[0,0,0] op_sel_hi:[1,1,0]" : "=v"(d) : "v"(v), "v"(k), "v"(c)); return d; }
template <int VH> __device__ __forceinline__ float fvk_hi(unsigned v, unsigned k, float c) { float d;
    if (VH) asm("v_fma_mix_f32 %0, %1, %2, %3 op_sel:[1,1,0] op_sel_hi:[1,1,0]" : "=v"(d) : "v"(v), "v"(k), "v"(c)); else asm("v_fma_mix_f32 %0, %1, %2, %3 op_sel:[0,1,0] op_sel_hi:[1,1,0]" : "=v"(d) : "v"(v), "v"(k), "v"(c)); return d; }

__device__ __forceinline__ float red16(float x) {
    x += SC_DPP(x, 0xB1); x += SC_DPP(x, 0x4E); x += SC_DPP(x, 0x141); x += SC_DPP(x, 0x140);
    return x;
}
__device__ __forceinline__ float ffma(float a, float b, float c) { float d; asm("v_fma_f32 %0, %1, %2, %3" : "=v"(d) : "v"(a), "v"(b), "v"(c)); return d; }
__device__ __forceinline__ float fmul(float a, float b) { float d; asm("v_mul_f32 %0, %1, %2" : "=v"(d) : "v"(a), "v"(b)); return d; }
__device__ __forceinline__ float fnfma(float a, float b, float c) { float d; asm("v_fma_f32 %0, -%1, %2, %3" : "=v"(d) : "v"(a), "v"(b), "v"(c)); return d; }
__device__ __forceinline__ float h2f_lo(unsigned w) { float d; asm("v_cvt_f32_f16 %0, %1" : "=v"(d) : "v"(w)); return d; }
__device__ __forceinline__ float h2f_hi(unsigned w) { float d; asm("v_cvt_f32_f16_sdwa %0, %1 dst_sel:DWORD dst_unused:UNUSED_PAD src0_sel:WORD_1" : "=v"(d) : "v"(w)); return d; }
__device__ __forceinline__ void phase_scan(const Args& a, int l, PG8_LAS unsigned char* lds) {
    const int tid = tid_fresh(), lane = tid & 63, wid = __builtin_amdgcn_readfirstlane(tid >> 6);
    const int j2 = (lane & 15) | ((lane >> 5) << 4), rr = (lane >> 4) & 1;
    const char* REC = (const char*)(a.ws + WS_REC); const char* RVT = (const char*)(a.ws + WS_RVT);
    bf16_t* YR = (bf16_t*)(a.ws + WS_YRAW);
    constexpr int CSTEPS = 32, NCH = SEQ / CSTEPS, G_REC = 8 * REC_TG * 4  , CH_REC = 21 * 1024, CH_V = 4096, CH = CH_REC + CH_V, NPC = 25;
    constexpr int YB_LD = 68, YB_WAVE = 16 * YB_LD * 4;
    PG8_LAS float* yb = (PG8_LAS float*)(lds + 2 * CH + wid * YB_WAVE);
    float* scr = (float*)((unsigned char*)lds + 2 * CH + 8 * YB_WAVE) + (wid & 3) * (64 * 33);
    const bool cvw = wid < 4;
    const int cw = blockIdx.x * 4 + (wid & 3), NCW = gridDim.x * 4;
    int cvt_next = cvw ? cw : NEXP * 768; bool have = false; CvtItem ci; float4 cv[8];
    for (int u = blockIdx.x; u < 256; u += gridDim.x) {
        const int bh = u >> 2, rg = u & 3, b = bh >> 3, h = bh & 7;
        const int irow = rg * 16 + wid * 2 + rr;
        const char* grec = REC + (size_t)bh * NCH * G_REC; const char* gv = RVT + (size_t)bh * NCH * CH_V;
        float S0 = 0.f, S1 = 0.f;
        __syncthreads();
#define SCAN_DMA(chn, bufo) do { _Pragma("unroll") for (int k_ = 0; k_ < 4; ++k_) { const int pc_ = wid * 4 + k_; if (pc_ < NPC) { \
            const char* src_ = (pc_ < 21) ? grec + (size_t)(chn) * G_REC + pc_ * 1024 + lane * 16 : gv + (size_t)(chn) * CH_V + (pc_ - 21) * 1024 + lane * 16; \
            __builtin_amdgcn_global_load_lds((const unsigned*)src_, (PG8_LAS unsigned*)(lds + (bufo) + pc_ * 1024), 16, 0, 0); } } } while (0)
        SCAN_DMA(0, 0);
        for (int ch = 0; ch < NCH; ++ch) {
            asm volatile("s_waitcnt vmcnt(0)" ::: "memory");
            __syncthreads();
            if (ch + 1 < NCH) SCAN_DMA(ch + 1, ((ch + 1) & 1) * CH);
            if (have) { cvt_finish(ci, lane, cv, scr); have = false; }
            { const int cm = ch & 7; if (cvw && (cm == 0 || cm == 3 || cm == 5)) { if (cvt_decode(a, l, cvt_next, ci)) { cvt_load(ci, lane, cv); have = true; cvt_next += NCW; } } }
            PG8_LAS const unsigned char* bufp = lds + (ch & 1) * CH;
#define SCAN_LOADW(W, grp) do { PG8_LAS const unsigned char* rp_ = bufp + (grp) * (REC_TG * 4) + j2 * 80 + (j2 >> 4) * 16; _Pragma("unroll") for (int k_ = 0; k_ < 5; ++k_) { \
                const pg8::u32x4 q_ = *(PG8_LAS const pg8::u32x4*)(rp_ + 16 * k_); W[4 * k_] = q_.x; W[4 * k_ + 1] = q_.y; W[4 * k_ + 2] = q_.z; W[4 * k_ + 3] = q_.w; } } while (0)
#define SCAN_STEPS(W, hf) do { _Pragma("unroll") for (int ts = 0; ts < 4; ++ts) { \
                const unsigned wu = W[ts * 5], wa = W[ts * 5 + 1], wb = W[ts * 5 + 2], wk = W[ts * 5 + 3], wr_ = W[ts * 5 + 4]; \
                const unsigned vw = vv[(hf) * 2 + (ts >> 1)]; \
                const float sa = red32(fmix_hi(S1, wa, fmul_lo(S0, wa))); \
                float t0 = fdec_lo(S0, wu), t1 = fdec_hi(S1, wu); \
                if (ts & 1) { t0 = fvk_lo<1>(vw, wk, t0); t1 = fvk_hi<1>(vw, wk, t1); } else { t0 = fvk_lo<0>(vw, wk, t0); t1 = fvk_hi<0>(vw, wk, t1); } \
                S0 = fmix_lo(sa, wb, t0); S1 = fmix_hi(sa, wb, t1); \
                yb[((g8 & 1) * 8 + (hf) * 4 + ts) * YB_LD + rr * 32 + j2] = fmix_hi(S1, wr_, fmul_lo(S0, wr_)); } } while (0)
            unsigned wA[20], wB[20];
            SCAN_LOADW(wA, 0);
#pragma unroll 1
            for (int g8 = 0; g8 < 4; ++g8) {
                const pg8::u32x4 vv = *(PG8_LAS const pg8::u32x4*)(bufp + CH_REC + (g8 * 64 + irow) * 16);
                SCAN_LOADW(wB, g8 * 2 + 1);
                SCAN_STEPS(wA, 0);
                if (g8 < 3) SCAN_LOADW(wA, g8 * 2 + 2);
                SCAN_STEPS(wB, 1);
                if (g8 & 1) {
                    asm volatile("s_waitcnt lgkmcnt(0)" ::: "memory");
                    PG8_LAS const float* yp = yb + (j2 & 15) * YB_LD + rr * 32 + (j2 >> 4) * 16;
                    const pg8::f32x4 y0 = *(PG8_LAS const pg8::f32x4*)(yp), y1 = *(PG8_LAS const pg8::f32x4*)(yp + 4), y2 = *(PG8_LAS const pg8::f32x4*)(yp + 8), y3 = *(PG8_LAS const pg8::f32x4*)(yp + 12);
                    const pg8::f32x4 ys = (y0 + y1) + (y2 + y3);
                    float y = (ys[0] + ys[1]) + (ys[2] + ys[3]);
                    { auto sw = __builtin_amdgcn_permlane32_swap(__float_as_uint(y), __float_as_uint(y), false, false); y = __uint_as_float(sw[0]) + __uint_as_float(sw[1]); }
                    const int t = ch * CSTEPS + (g8 >> 1) * 16 + (j2 & 15);
                    if (j2 < 16) YR[((size_t)b * SEQ + t) * 512 + h * 64 + irow] = f2bf(y);
                    asm volatile("s_waitcnt lgkmcnt(0)" ::: "memory");
                }
            }
#undef SCAN_LOADW
#undef SCAN_STEPS
        }
#undef SCAN_DMA
    }
    if (have) cvt_finish(ci, lane, cv, scr);
    while (cvt_decode(a, l, cvt_next, ci)) { cvt_load(ci, lane, cv); cvt_finish(ci, lane, cv, scr); cvt_next += NCW; }
}

__device__ __forceinline__ void phase_post(const Args& a, int l) {
    const int tid = tid_fresh(), lane = tid & 63, wid = tid >> 6;
    const bf16_t* YR = (const bf16_t*)(a.ws + WS_YRAW); const _Float16* RVT = (const _Float16*)(a.ws + WS_RVT);
    const bf16_t* RGp = (const bf16_t*)(a.ws + WS_RG); const float* BON = (const float*)(a.ws + WS_BON);
    bf16_t* MIX = (bf16_t*)(a.ws + WS_MIX);
    for (int u = blockIdx.x; u < 64 * 256; u += gridDim.x) {
        const int bh = u >> 8, t8 = u & 255, b = bh >> 3, h = bh & 7, t = t8 * 8 + wid;
        const size_t tok = (size_t)b * SEQ + t; const int c = h * 64 + lane;
        const float y = bf2f(YR[tok * 512 + c]);
        const float my = wsum(y) * (1.0f / 64.0f);
        const float dy = y - my;
        const float var = wsum(dy * dy) * (1.0f / 64.0f);
        const float yn = dy * rsqrtf(var + 64e-5f) * a.in[16][l * 512 + c] + a.in[17][l * 512 + c];
        const float v = (float)RVT[(((size_t)bh * 256 + t8) * 64 + lane) * 8 + wid];
        MIX[tok * DM + 512 + c] = f2bf((yn + BON[tok * 8 + h] * v) * bf2f(RGp[tok * 512 + c]));
    }
}

namespace att {
typedef short bf16x8 __attribute__((ext_vector_type(8)));
typedef short s16x4 __attribute__((ext_vector_type(4)));
typedef float f32x16 __attribute__((ext_vector_type(16)));
typedef __attribute__((address_space(3))) const unsigned char* lds_cptr;
constexpr int SLOT = 8192, L_K = 0, L_V = 2 * SLOT, L_WS = 4 * SLOT, L_KM = L_WS + 8 * 256, L_OST = L_KM + 2048, OST_LD = 68, L_END = L_OST + 8 * 32 * OST_LD * 4;
constexpr float C2 = 0.125f * 1.4426950408889634f;
__device__ __forceinline__ int crow(int r, int hi) { return (r & 3) + 8 * (r >> 2) + 4 * hi; }
__device__ __forceinline__ s16x4 vtr(lds_cptr p) { return __builtin_bit_cast(s16x4, __builtin_amdgcn_ds_read_tr16_b64_v4i16((__attribute__((address_space(3))) s16x4*)p)); }
__device__ __forceinline__ float swapmax(float x) { auto rr = __builtin_amdgcn_permlane32_swap(__float_as_uint(x), __float_as_uint(x), false, false); return fmaxf(__uint_as_float(rr[0]), __uint_as_float(rr[1])); }
__device__ __forceinline__ float swapsum(float x) { auto rr = __builtin_amdgcn_permlane32_swap(__float_as_uint(x), __float_as_uint(x), false, false); return __uint_as_float(rr[0]) + __uint_as_float(rr[1]); }

__device__ __forceinline__ void unit(const Args& a, int l, int b, int h, int cur, PG8_LAS unsigned char* lds) {
    const int tid = tid_fresh(), lane = tid & 63, r32 = lane & 31, hi = lane >> 5, wid = __builtin_amdgcn_readfirstlane(tid >> 6);
    const bf16_t* Zb = (const bf16_t*)(a.ws + WS_Z) + (size_t)b * SEQ * ZLD;
    const int qrel = wid * 32 + r32, qpos = cur * 256 + qrel;
    PG8_LAS float* wsf = (PG8_LAS float*)(lds + L_WS) + wid * 64;
    PG8_LAS float* kmf = (PG8_LAS float*)(lds + L_KM);
    __syncthreads();
    kmf[tid] = ((const float*)(a.ws + WS_KMEAN))[(size_t)(b * NH + h) * 512 + tid];
    const bf16_t* ksrc = Zb + (size_t)lane * ZLD + C_K + h * HD + wid * 8;
    const bf16_t* vsrc = Zb + (size_t)(16 * (wid & 3) + (lane >> 2)) * ZLD + C_V + h * HD + (wid >> 2) * 32 + (lane & 3) * 8;
#define ATT_DMA(kpos0, slot) do { \
        __builtin_amdgcn_global_load_lds((const unsigned*)(ksrc + (size_t)(kpos0) * ZLD), (PG8_LAS unsigned*)(lds + L_K + (slot) * SLOT + wid * 1024), 16, 0, 0); \
        __builtin_amdgcn_global_load_lds((const unsigned*)(vsrc + (size_t)(kpos0) * ZLD), (PG8_LAS unsigned*)(lds + L_V + (slot) * SLOT + wid * 1024), 16, 0, 0); } while (0)
    ATT_DMA(cur * 256, 0);
    bf16x8 qr[4];
#pragma unroll
    for (int d0 = 0; d0 < 4; ++d0) qr[d0] = *(const bf16x8*)(Zb + (size_t)qpos * ZLD + C_Q + h * HD + d0 * 16 + hi * 8);
    __syncthreads();
    unsigned selbits = 0u;
    {
        float g[8];
#pragma unroll
        for (int n = 0; n < 8; ++n) g[n] = 0.f;
#pragma unroll
        for (int d0 = 0; d0 < 4; ++d0)
#pragma unroll
            for (int j = 0; j < 8; ++j) { const float qv = bf2f((bf16_t)qr[d0][j]);
#pragma unroll
                for (int n = 0; n < 8; ++n) g[n] = fmaf(qv, kmf[n * 64 + d0 * 16 + hi * 8 + j], g[n]); }
#pragma unroll
        for (int n = 0; n < 8; ++n) g[n] = (n < cur) ? swapsum(g[n]) : NEG_INF;
        if (cur <= 3) selbits = (1u << cur) - 1u;
        else {
            int s0 = -1, s1 = -1, s2 = -1; float bv = -3e38f;
#pragma unroll
            for (int n = 0; n < 8; ++n) if (g[n] > bv) { bv = g[n]; s0 = n; }
            bv = -3e38f;
#pragma unroll
            for (int n = 0; n < 8; ++n) if (n != s0 && g[n] > bv) { bv = g[n]; s1 = n; }
            bv = -3e38f;
#pragma unroll
            for (int n = 0; n < 8; ++n) if (n != s0 && n != s1 && g[n] > bv) { bv = g[n]; s2 = n; }
            selbits = (1u << s0) | (1u << s1) | (1u << s2);
        }
    }
    const float s8 = 8.0f * exp2f(-(float)(h + 1));
    f32x16 base;
#pragma unroll
    for (int r = 0; r < 16; ++r) base[r] = s8 * (float)crow(r, hi);
    f32x16 o0, o1;
#pragma unroll
    for (int r = 0; r < 16; ++r) { o0[r] = 0.f; o1[r] = 0.f; }
    float m = -INFINITY, lsum = 0.f;
    const int NT = 4 * (cur + 1);
    const lds_cptr kp = (lds_cptr)(lds + L_K) + hi * 1024 + r32 * 16;
    const lds_cptr vp = (lds_cptr)(lds + L_V) + ((lane >> 4) & 1) * 32 + (lane & 3) * 8 + (4 * hi + ((lane & 15) >> 2)) * 64;
    for (int it = 0; it < NT; ++it) {
        asm volatile("s_waitcnt vmcnt(0)" ::: "memory");
        __syncthreads();
        const int blk = (it < 4) ? cur : ((it >> 2) - 1);
        const int kpos0 = blk * 256 + (it & 3) * 64;
        if (it + 1 < NT) { const int nblk = (it + 1 < 4) ? cur : (((it + 1) >> 2) - 1); ATT_DMA(nblk * 256 + ((it + 1) & 3) * 64, (it + 1) & 1); }
        const int so = (it & 1) * SLOT;
        f32x16 p0 = base, p1 = base;
#pragma unroll
        for (int d0 = 0; d0 < 4; ++d0) {
            const bf16x8 k0 = *(const __attribute__((address_space(3))) bf16x8*)(kp + so + d0 * 2048);
            const bf16x8 k1 = *(const __attribute__((address_space(3))) bf16x8*)(kp + so + d0 * 2048 + 512);
            p0 = __builtin_amdgcn_mfma_f32_32x32x16_bf16(k0, qr[d0], p0, 0, 0, 0);
            p1 = __builtin_amdgcn_mfma_f32_32x32x16_bf16(k1, qr[d0], p1, 0, 0, 0);
        }
        const bool rowsel = (it < 4) || ((selbits >> blk) & 1u);
        const float cb = rowsel ? -s8 * (float)(qpos - kpos0) : -INFINITY;
        const float cb1 = cb + s8 * 32.0f;
        if (it < 4) {
            const int kb0 = (it & 3) * 64 + 4 * hi;
#pragma unroll
            for (int r = 0; r < 16; ++r) { const int kv = kb0 + (r & 3) + 8 * (r >> 2); if (kv > qrel) p0[r] = -INFINITY; if (kv + 32 > qrel) p1[r] = -INFINITY; }
        }
        float mx0 = p0[0], mx1 = p1[0];
#pragma unroll
        for (int r = 1; r < 16; ++r) { mx0 = fmaxf(mx0, p0[r]); mx1 = fmaxf(mx1, p1[r]); }
        const float mx = swapmax(fmaxf(mx0 + cb, mx1 + cb1));
        if (__any((mx - m) * C2 > 6.0f)) {
            const float mn = fmaxf(m, mx);
            const float alpha = __builtin_amdgcn_exp2f((m - mn) * C2);
            m = mn; lsum *= alpha;
            asm volatile("s_waitcnt lgkmcnt(0)" ::: "memory");
            if (hi == 0) wsf[r32] = alpha;
            asm volatile("s_waitcnt lgkmcnt(0)" ::: "memory");
#pragma unroll
            for (int r = 0; r < 16; ++r) { const float al = wsf[crow(r, hi)]; o0[r] *= al; o1[r] *= al; }
        }
        const float tb0 = (cb - m) * C2, tb1 = (cb1 - m) * C2;
        float ls = 0.f;
#pragma unroll
        for (int r = 0; r < 16; ++r) { p0[r] = __builtin_amdgcn_exp2f(fmaf(p0[r], C2, tb0)); p1[r] = __builtin_amdgcn_exp2f(fmaf(p1[r], C2, tb1)); ls += p0[r] + p1[r]; }
        lsum += ls;
        pg8::u32x4 w0, w1, w2, w3;
        w0.x = pk2(p0[0], p0[1]); w0.y = pk2(p0[2], p0[3]); w0.z = pk2(p0[4], p0[5]); w0.w = pk2(p0[6], p0[7]);
        w1.x = pk2(p0[8], p0[9]); w1.y = pk2(p0[10], p0[11]); w1.z = pk2(p0[12], p0[13]); w1.w = pk2(p0[14], p0[15]);
        w2.x = pk2(p1[0], p1[1]); w2.y = pk2(p1[2], p1[3]); w2.z = pk2(p1[4], p1[5]); w2.w = pk2(p1[6], p1[7]);
        w3.x = pk2(p1[8], p1[9]); w3.y = pk2(p1[10], p1[11]); w3.z = pk2(p1[12], p1[13]); w3.w = pk2(p1[14], p1[15]);
        const bf16x8 pa0 = __builtin_bit_cast(bf16x8, w0), pa1 = __builtin_bit_cast(bf16x8, w1), pa2 = __builtin_bit_cast(bf16x8, w2), pa3 = __builtin_bit_cast(bf16x8, w3);
#define ATT_VF(d0, ks) ({ const s16x4 lo_ = vtr(vp + so + (d0) * 4096 + (ks) * 1024), hi_ = vtr(vp + so + (d0) * 4096 + (ks) * 1024 + 512); \
        (bf16x8){lo_[0], lo_[1], lo_[2], lo_[3], hi_[0], hi_[1], hi_[2], hi_[3]}; })
        o0 = __builtin_amdgcn_mfma_f32_32x32x16_bf16(pa0, ATT_VF(0, 0), o0, 0, 0, 0);
        o1 = __builtin_amdgcn_mfma_f32_32x32x16_bf16(pa0, ATT_VF(1, 0), o1, 0, 0, 0);
        o0 = __builtin_amdgcn_mfma_f32_32x32x16_bf16(pa1, ATT_VF(0, 1), o0, 0, 0, 0);
        o1 = __builtin_amdgcn_mfma_f32_32x32x16_bf16(pa1, ATT_VF(1, 1), o1, 0, 0, 0);
        o0 = __builtin_amdgcn_mfma_f32_32x32x16_bf16(pa2, ATT_VF(0, 2), o0, 0, 0, 0);
        o1 = __builtin_amdgcn_mfma_f32_32x32x16_bf16(pa2, ATT_VF(1, 2), o1, 0, 0, 0);
        o0 = __builtin_amdgcn_mfma_f32_32x32x16_bf16(pa3, ATT_VF(0, 3), o0, 0, 0, 0);
        o1 = __builtin_amdgcn_mfma_f32_32x32x16_bf16(pa3, ATT_VF(1, 3), o1, 0, 0, 0);
#undef ATT_VF
    }
#undef ATT_DMA
    const float lt = swapsum(lsum);
    asm volatile("s_waitcnt lgkmcnt(0)" ::: "memory");
    if (hi == 0) wsf[r32] = 1.0f / lt;
    asm volatile("s_waitcnt lgkmcnt(0)" ::: "memory");
    PG8_LAS float* stg = (PG8_LAS float*)(lds + L_OST) + wid * (32 * OST_LD);
#pragma unroll
    for (int r = 0; r < 16; ++r) { const int orow = crow(r, hi); const float il = wsf[orow]; stg[orow * OST_LD + r32] = o0[r] * il; stg[orow * OST_LD + 32 + r32] = o1[r] * il; }
    asm volatile("s_waitcnt lgkmcnt(0)" ::: "memory");
    const float* gain = a.in[18] + l * 512 + h * HD;
    bf16_t* MIX = (bf16_t*)(a.ws + WS_MIX);
#pragma unroll
    for (int i = 0; i < 4; ++i) {
        const int row = i * 8 + (lane >> 3), ch = lane & 7;
        const pg8::f32x4 va = *(PG8_LAS const pg8::f32x4*)(stg + row * OST_LD + ch * 8), vb = *(PG8_LAS const pg8::f32x4*)(stg + row * OST_LD + ch * 8 + 4);
        float ss = va[0] * va[0] + va[1] * va[1] + va[2] * va[2] + va[3] * va[3] + vb[0] * vb[0] + vb[1] * vb[1] + vb[2] * vb[2] + vb[3] * vb[3];
        ss += SC_DPP(ss, 0xB1); ss += SC_DPP(ss, 0x4E); ss += SC_DPP(ss, 0x141);
        const float rs = rsqrtf(ss * (1.0f / 64.0f) + 1e-6f);
        const pg8::f32x4 ga = *(const pg8::f32x4*)(gain + ch * 8), gb = *(const pg8::f32x4*)(gain + ch * 8 + 4);
        pg8::u32x4 w; w.x = pk2(va[0] * rs * ga[0], va[1] * rs * ga[1]); w.y = pk2(va[2] * rs * ga[2], va[3] * rs * ga[3]);
        w.z = pk2(vb[0] * rs * gb[0], vb[1] * rs * gb[1]); w.w = pk2(vb[2] * rs * gb[2], vb[3] * rs * gb[3]);
        *(pg8::u32x4*)(MIX + ((size_t)b * SEQ + cur * 256 + wid * 32 + row) * DM + h * HD + ch * 8) = w;
    }
}
}

__device__ __forceinline__ void phase_att(const Args& a, int l, PG8_LAS unsigned char* lds) {
    const int G = gridDim.x, bx = blockIdx.x;
    const int v = (G % 8 == 0) ? (bx % 8) * (G / 8) + bx / 8 : bx;
    for (int w = v; w < 256; w += G) {
        const int bh = w >> 2, s = w & 3;
        att::unit(a, l, bh >> 3, bh & 7, 7 - s, lds);
        att::unit(a, l, bh >> 3, bh & 7, s, lds);
    }
}

__device__ __forceinline__ void scan32(const Args& a, int l, int j, PG8_LAS unsigned char* lds) {
    const int tid = tid_fresh(), lane = tid & 63, wid = __builtin_amdgcn_readfirstlane(tid >> 6);
    const int jq = lane & 15, rr = lane >> 4;
    const char* REC = (const char*)(a.ws + WS_REC); const char* RVT = (const char*)(a.ws + WS_RVT);
    bf16_t* YR = (bf16_t*)(a.ws + WS_YRAW);
    constexpr int CSTEPS = 32, NCH = SEQ / CSTEPS, G_REC = 8 * REC_TG * 4, CH_REC = 21 * 1024, CH_V = 4096, CH = CH_REC + CH_V, NPC = 25;
    constexpr int YB_LD = 68, YB_WAVE = 16 * YB_LD * 4;
    PG8_LAS float* yb = (PG8_LAS float*)(lds + 2 * CH + wid * YB_WAVE);
    const int bh = j >> 1, hf32 = j & 1, b = bh >> 3, h = bh & 7;
    const int irow = hf32 * 32 + wid * 4 + rr;
    const char* grec = REC + (size_t)bh * NCH * G_REC; const char* gv = RVT + (size_t)bh * NCH * CH_V;
    float S0 = 0.f, S1 = 0.f, S2 = 0.f, S3 = 0.f;
    asm volatile("s_waitcnt vmcnt(0) lgkmcnt(0)" ::: "memory"); __builtin_amdgcn_s_barrier(); asm volatile("" ::: "memory");
#define SCAN_DMA(chn, bufo) do { _Pragma("unroll") for (int k_ = 0; k_ < 4; ++k_) { const int pc_ = wid * 4 + k_; if (pc_ < NPC) { \
        const char* src_ = (pc_ < 21) ? grec + (size_t)(chn) * G_REC + pc_ * 1024 + lane * 16 : gv + (size_t)(chn) * CH_V + (pc_ - 21) * 1024 + lane * 16; \
        __builtin_amdgcn_global_load_lds((const unsigned*)src_, (PG8_LAS unsigned*)(lds + (bufo) + pc_ * 1024), 16, 0, 0); } } } while (0)
    SCAN_DMA(0, 0);
    for (int ch = 0; ch < NCH; ++ch) {
        asm volatile("s_waitcnt vmcnt(0) lgkmcnt(0)" ::: "memory"); __builtin_amdgcn_s_barrier(); asm volatile("" ::: "memory");
        if (ch + 1 < NCH) SCAN_DMA(ch + 1, ((ch + 1) & 1) * CH);
        PG8_LAS const unsigned char* bufp = lds + (ch & 1) * CH;
#define SCAN_LOADW(WA, WB, grp) do { PG8_LAS const unsigned char* rp_ = bufp + (grp) * (REC_TG * 4) + jq * 160 + (jq >> 3) * 16; _Pragma("unroll") for (int k_ = 0; k_ < 5; ++k_) { \
        const pg8::u32x4 q_ = *(PG8_LAS const pg8::u32x4*)(rp_ + 16 * k_), q2_ = *(PG8_LAS const pg8::u32x4*)(rp_ + 80 + 16 * k_); \
        WA[4 * k_] = q_.x; WA[4 * k_ + 1] = q_.y; WA[4 * k_ + 2] = q_.z; WA[4 * k_ + 3] = q_.w; WB[4 * k_] = q2_.x; WB[4 * k_ + 1] = q2_.y; WB[4 * k_ + 2] = q2_.z; WB[4 * k_ + 3] = q2_.w; } } while (0)
#define SCAN_STEPS(WA, WB, hf) do { _Pragma("unroll") for (int ts = 0; ts < 4; ++ts) { \
        const unsigned uA = WA[ts * 5], aA = WA[ts * 5 + 1], bA = WA[ts * 5 + 2], kA = WA[ts * 5 + 3], rA = WA[ts * 5 + 4]; \
        const unsigned uB = WB[ts * 5], aB = WB[ts * 5 + 1], bB = WB[ts * 5 + 2], kB = WB[ts * 5 + 3], rB = WB[ts * 5 + 4]; \
        const unsigned vw = vv[(hf) * 2 + (ts >> 1)]; \
        const float sa = red16(fmix_hi(S3, aB, fmix_lo(S2, aB, fmix_hi(S1, aA, fmul_lo(S0, aA))))); \
        float t0 = fdec_lo(S0, uA), t1 = fdec_hi(S1, uA), t2 = fdec_lo(S2, uB), t3 = fdec_hi(S3, uB); \
        if (ts & 1) { t0 = fvk_lo<1>(vw, kA, t0); t1 = fvk_hi<1>(vw, kA, t1); t2 = fvk_lo<1>(vw, kB, t2); t3 = fvk_hi<1>(vw, kB, t3); } \
        else { t0 = fvk_lo<0>(vw, kA, t0); t1 = fvk_hi<0>(vw, kA, t1); t2 = fvk_lo<0>(vw, kB, t2); t3 = fvk_hi<0>(vw, kB, t3); } \
        S0 = fmix_lo(sa, bA, t0); S1 = fmix_hi(sa, bA, t1); S2 = fmix_lo(sa, bB, t2); S3 = fmix_hi(sa, bB, t3); \
        yb[((g8 & 1) * 8 + (hf) * 4 + ts) * YB_LD + rr * 16 + jq] = fmix_hi(S3, rB, fmix_lo(S2, rB, fmix_hi(S1, rA, fmul_lo(S0, rA)))); } } while (0)
        unsigned wA0[20], wB0[20], wA1[20], wB1[20];
        SCAN_LOADW(wA0, wB0, 0);
#pragma unroll 1
        for (int g8 = 0; g8 < 4; ++g8) {
            const pg8::u32x4 vv = *(PG8_LAS const pg8::u32x4*)(bufp + CH_REC + (g8 * 64 + irow) * 16);
            SCAN_LOADW(wA1, wB1, g8 * 2 + 1);
            SCAN_STEPS(wA0, wB0, 0);
            if (g8 < 3) SCAN_LOADW(wA0, wB0, g8 * 2 + 2);
            SCAN_STEPS(wA1, wB1, 1);
            if (g8 & 1) {
                asm volatile("s_waitcnt lgkmcnt(0)" ::: "memory");
                PG8_LAS const float* yp = yb + jq * YB_LD + rr * 16;
                const pg8::f32x4 y0 = *(PG8_LAS const pg8::f32x4*)(yp), y1 = *(PG8_LAS const pg8::f32x4*)(yp + 4), y2 = *(PG8_LAS const pg8::f32x4*)(yp + 8), y3 = *(PG8_LAS const pg8::f32x4*)(yp + 12);
                const pg8::f32x4 ys = (y0 + y1) + (y2 + y3);
                const float y = (ys[0] + ys[1]) + (ys[2] + ys[3]);
                const int t = ch * CSTEPS + (g8 >> 1) * 16 + jq;
                YR[((size_t)b * SEQ + t) * 512 + h * 64 + irow] = f2bf(y);
                asm volatile("s_waitcnt lgkmcnt(0)" ::: "memory");
            }
        }
#undef SCAN_LOADW
#undef SCAN_STEPS
    }
#undef SCAN_DMA
}
__device__ __forceinline__ void phase_scan_att2(const Args& a, int l, PG8_LAS unsigned char* lds) {
    const int bx = blockIdx.x;
    const int j = (bx & 7) * 16 + (bx >> 4);
    if (((bx >> 3) & 1) == 0) scan32(a, l, j, lds);
    else {
        const int bh = j >> 1, b = bh >> 3, h = bh & 7;
#pragma unroll 1
        for (int q = 0; q < 2; ++q) { const int s = 2 * (j & 1) + q; att::unit(a, l, b, h, 7 - s, lds); att::unit(a, l, b, h, s, lds); }
        __syncthreads();
        const int tid = tid_fresh(), lane = tid & 63, wid = tid >> 6;
        float* scr = (float*)((unsigned char*)lds) + wid * (64 * 33);
        CvtItem c0, c1; float4 v0[8], v1[8];
        int it = j * 8 + wid; const int NCW = 128 * 8;
        bool h0 = cvt_decode(a, l, it, c0); if (h0) cvt_load(c0, lane, v0);
        while (h0) {
            const bool h1 = cvt_decode(a, l, it + NCW, c1); if (h1) cvt_load(c1, lane, v1);
            cvt_finish(c0, lane, v0, scr);
            it += 2 * NCW;
            h0 = h1 && cvt_decode(a, l, it, c0); if (h0) cvt_load(c0, lane, v0);
            if (h1) cvt_finish(c1, lane, v1, scr);
        }
    }
}

__device__ __forceinline__ void phase_dense_res(const void* A, const void* WT, const float* RES, const bf16_t* RESB, bf16_t* OUT, PG8_LAS unsigned char* lds) {
    pg8::DenseSched S; S.init(A, DM, NTOK, WT, DM, DM);
    pg8::EpiBf16Res E{OUT, RES, DM, ALPHA, RESB};
    pg8::gemm_phase<pg8::EpiBf16Res, pg8::DenseSched, false>(lds, pg8::Dims{DM, DM, DM}, S, E);
}
__device__ __forceinline__ void phase_dense_bf16(const void* A, int M, const void* WT, int N, bf16_t* OUT, PG8_LAS unsigned char* lds) {
    pg8::DenseSched S; S.init(A, DM, M, WT, DM, N);
    pg8::EpiBf16 E{OUT, N};
    pg8::gemm_phase<pg8::EpiBf16, pg8::DenseSched, false>(lds, pg8::Dims{DM, DM, DM}, S, E);
}

__device__ __forceinline__ void ln_row(const bf16_t* in, const float* g, const float* bta, float* out, bf16_t* outb, int lane, float (&xn)[16]) {
    float x[16];
#pragma unroll
    for (int m = 0; m < 4; ++m) { const uint2 v = *(const uint2*)(in + m * 256 + lane * 4); x[m * 4] = bflo(v.x); x[m * 4 + 1] = bfhi(v.x); x[m * 4 + 2] = bflo(v.y); x[m * 4 + 3] = bfhi(v.y); }
    float s = 0.f;
#pragma unroll
    for (int k = 0; k < 16; ++k) s += x[k];
    const float mean = wsum(s) * (1.0f / 1024.0f);
    float q = 0.f;
#pragma unroll
    for (int k = 0; k < 16; ++k) { const float d = x[k] - mean; q = fmaf(d, d, q); }
    const float var = wsum(q) * (1.0f / 1024.0f);
    const float rstd = rsqrtf(var + 1e-5f);
#pragma unroll
    for (int m = 0; m < 4; ++m) {
        const float4 gv = *(const float4*)(g + m * 256 + lane * 4), bv = *(const float4*)(bta + m * 256 + lane * 4);
        float4 o;
        o.x = (x[m * 4] - mean) * rstd * gv.x + bv.x; o.y = (x[m * 4 + 1] - mean) * rstd * gv.y + bv.y;
        o.z = (x[m * 4 + 2] - mean) * rstd * gv.z + bv.z; o.w = (x[m * 4 + 3] - mean) * rstd * gv.w + bv.w;
        xn[m * 4] = o.x; xn[m * 4 + 1] = o.y; xn[m * 4 + 2] = o.z; xn[m * 4 + 3] = o.w;
        if (out) *(float4*)(out + m * 256 + lane * 4) = o;
        uint2 ob; ob.x = pk2(o.x, o.y); ob.y = pk2(o.z, o.w); *(uint2*)(outb + m * 256 + lane * 4) = ob;
    }
}
__device__ __forceinline__ void phase_ln(const bf16_t* IN, const float* g, const float* bta, float* OUT, bf16_t* OUTB) {
    const int tid = tid_fresh(), lane = tid & 63, wid = tid >> 6;
    for (int row = blockIdx.x * 8 + wid; row < NTOK; row += gridDim.x * 8) {
        float xn[16];
        ln_row(IN + (size_t)row * DM, g, bta, OUT ? OUT + (size_t)row * DM : (float*)nullptr, OUTB + (size_t)row * DM, lane, xn);
    }
}

__device__ __forceinline__ float treduce32(float (&p)[32], int lane) {
    float q[16], r[8], s4[4], t2[2];
#pragma unroll
    for (int i = 0; i < 16; ++i) { auto sw = __builtin_amdgcn_permlane32_swap(__float_as_uint(p[i]), __float_as_uint(p[i + 16]), false, false); q[i] = __uint_as_float(sw[0]) + __uint_as_float(sw[1]); }
    const bool L4 = (lane & 16) != 0, L3 = (lane & 8) != 0, L2 = (lane & 4) != 0, L1 = (lane & 2) != 0;
#pragma unroll
    for (int i = 0; i < 8; ++i) { const float snd = L4 ? q[i] : q[i + 8], keep = L4 ? q[i + 8] : q[i]; r[i] = keep + __shfl_xor(snd, 16); }
#pragma unroll
    for (int i = 0; i < 4; ++i) { const float snd = L3 ? r[i] : r[i + 4], keep = L3 ? r[i + 4] : r[i]; s4[i] = keep + SC_DPP(snd, 0x140); }
#pragma unroll
    for (int i = 0; i < 2; ++i) { const float snd = L2 ? s4[i] : s4[i + 2], keep = L2 ? s4[i + 2] : s4[i]; t2[i] = keep + SC_DPP(snd, 0x141); }
    const float snd = L1 ? t2[0] : t2[1], keep = L1 ? t2[1] : t2[0];
    float u = keep + SC_DPP(snd, 0x4E);
    u += SC_DPP(u, 0xB1);
    return __shfl(u, (lane & 31) * 2);
}
struct RouteRes { int e0, e1; float g0, g1; };
__device__ __forceinline__ RouteRes route_row(float mylogit, int lane, const float* BR) {
    const float s = sigmoidf_(mylogit);
    const float sel = (lane < 32) ? s + BR[lane & 31] : NEG_INF;
    const int gb = lane & ~3;
    const float v0 = __shfl(sel, gb), v1 = __shfl(sel, gb + 1), v2 = __shfl(sel, gb + 2), v3 = __shfl(sel, gb + 3);
    const float m1 = fmaxf(fmaxf(v0, v1), fmaxf(v2, v3));
    float m2;
    { const float lo01 = fminf(v0, v1), hi01 = fmaxf(v0, v1), lo23 = fminf(v2, v3), hi23 = fmaxf(v2, v3);
      m2 = fmaxf(fminf(hi01, hi23), fmaxf(lo01, lo23)); }
    float gs = (lane < 32) ? (m1 + m2) : NEG_INF;
    int gi = lane >> 2;
#pragma unroll
    for (int o = 32; o > 0; o >>= 1) { const float ov = __shfl_xor(gs, o); const int oi = __shfl_xor(gi, o); if (ov > gs || (ov == gs && oi < gi)) { gs = ov; gi = oi; } }
    const int gbest = gi;
    const float c0 = __shfl(sel, gbest * 4), c1 = __shfl(sel, gbest * 4 + 1), c2 = __shfl(sel, gbest * 4 + 2), c3 = __shfl(sel, gbest * 4 + 3);
    int j0 = 0; float b0 = c0;
    if (c1 > b0) { b0 = c1; j0 = 1; } if (c2 > b0) { b0 = c2; j0 = 2; } if (c3 > b0) { b0 = c3; j0 = 3; }
    int j1 = -1; float b1 = -3e38f;
    if (j0 != 0 && c0 > b1) { b1 = c0; j1 = 0; } if (j0 != 1 && c1 > b1) { b1 = c1; j1 = 1; } if (j0 != 2 && c2 > b1) { b1 = c2; j1 = 2; } if (j0 != 3 && c3 > b1) { b1 = c3; j1 = 3; }
    RouteRes R; R.e0 = gbest * 4 + j0; R.e1 = gbest * 4 + j1;
    const float s0 = __shfl(s, R.e0), s1 = __shfl(s, R.e1);
    const float inv = 1.0f / (s0 + s1);
    R.g0 = s0 * inv; R.g1 = s1 * inv;
    return R;
}
__device__ __forceinline__ void phase_ln2_router(const Args& a, int l, float* lds, bool dummy = false) {
    const int tid = tid_fresh(), lane = tid & 63, wid = tid >> 6;
    const bf16_t* PRE = (const bf16_t*)(a.ws + WS_PRE2);
    bf16_t* X2B = (bf16_t*)(a.ws + WS_X2B);
    const float* g = a.in[28] + (size_t)(l * 3 + 1) * DM; const float* bta = a.in[29] + (size_t)(l * 3 + 1) * DM;
    const float* WR = a.in[23]; const float* BR = a.in[24];
    unsigned* cnt = (unsigned*)(a.ws + WS_CTL) + CW_CNT + l * 32 + (dummy ? 128 : 0);
    int2* list = (int2*)(a.ws + (dummy ? WS_H : WS_LIST));
    int2* tokpos = (int2*)(a.ws + (dummy ? WS_H + 8 * MiB : WS_TOKPOS));
    float2* tokgate = (float2*)(a.ws + (dummy ? WS_H + 9 * MiB : WS_TOKGATE));
    constexpr int WR_LD = DM + 4;
    unsigned* lcnt = (unsigned*)(lds + NEXP * WR_LD);
    int* lres = (int*)(lds + NEXP * WR_LD + 64);
    __syncthreads();
    {
        float4 wv[16];
#pragma unroll
        for (int q = 0; q < 16; ++q) wv[q] = *(const float4*)(WR + (size_t)(q * NTHREADS + tid) * 4);
#pragma unroll
        for (int q = 0; q < 16; ++q) { const int idx = (q * NTHREADS + tid) * 4, k = idx >> 5, e = idx & 31;
            lds[e * WR_LD + k] = wv[q].x; lds[(e + 1) * WR_LD + k] = wv[q].y; lds[(e + 2) * WR_LD + k] = wv[q].z; lds[(e + 3) * WR_LD + k] = wv[q].w; }
    }
    if (tid < 64) lcnt[tid] = 0u;
    __syncthreads();
    int nloc = 0;
    for (int row = (blockIdx.x * 8 + wid) * 2; row < NTOK; row += gridDim.x * 16) {
        float xa[16], xb[16];
        ln_row(PRE + (size_t)row * DM, g, bta, (float*)nullptr, X2B + (size_t)row * DM, lane, xa);
        ln_row(PRE + (size_t)(row + 1) * DM, g, bta, (float*)nullptr, X2B + (size_t)(row + 1) * DM, lane, xb);
        float pa[32], pb[32];
#pragma unroll
        for (int e = 0; e < NEXP; ++e) {
            float sa_ = 0.f, sb_ = 0.f;
#pragma unroll
            for (int m = 0; m < 4; ++m) { const float4 wv = *(const float4*)&lds[e * WR_LD + m * 256 + lane * 4];
                sa_ = fmaf(xa[m * 4], wv.x, sa_); sa_ = fmaf(xa[m * 4 + 1], wv.y, sa_); sa_ = fmaf(xa[m * 4 + 2], wv.z, sa_); sa_ = fmaf(xa[m * 4 + 3], wv.w, sa_);
                sb_ = fmaf(xb[m * 4], wv.x, sb_); sb_ = fmaf(xb[m * 4 + 1], wv.y, sb_); sb_ = fmaf(xb[m * 4 + 2], wv.z, sb_); sb_ = fmaf(xb[m * 4 + 3], wv.w, sb_); }
            pa[e] = sa_; pb[e] = sb_;
        }
        const float la = treduce32(pa, lane), lb = treduce32(pb, lane);
#pragma unroll
        for (int q = 0; q < 2; ++q) {
            const RouteRes R = route_row(q ? lb : la, lane, BR);
            if (lane == 0) {
                const unsigned r0 = atomicAdd(&lcnt[R.e0], 1u), r1 = atomicAdd(&lcnt[R.e1], 1u);
                int* o = lres + (wid * 32 + nloc + q) * 8;
                o[0] = row + q; o[1] = R.e0; o[2] = R.e1; o[3] = (int)r0; o[4] = (int)r1; o[5] = __float_as_int(R.g0); o[6] = __float_as_int(R.g1);
            }
        }
        nloc += 2;
    }
    __syncthreads();
    if (tid < 32) lcnt[32 + tid] = atomicAdd(&cnt[tid], lcnt[tid]);
    __syncthreads();
    for (int i = lane; i < nloc; i += 64) {
        const int* o = lres + (wid * 32 + i) * 8;
        const int row = o[0], e0 = o[1], e1 = o[2]; const unsigned r0 = lcnt[32 + e0] + (unsigned)o[3], r1 = lcnt[32 + e1] + (unsigned)o[4];
        list[(size_t)e0 * LCAP + r0] = make_int2(row, o[5]);
        list[(size_t)e1 * LCAP + r1] = make_int2(row, o[6]);
        tokpos[row * 2] = make_int2(e0, (int)r0); tokpos[row * 2 + 1] = make_int2(e1, (int)r1);
        tokgate[row] = make_float2(__int_as_float(o[5]), __int_as_float(o[6]));
    }
}

constexpr int ZERO_ROW = 32768 / 2048;
struct I2 { int x, y; };
struct MoeSched {
    int G, c, T, npn; PG8_LAS I2* tab;
    const char* A; const char* B; size_t b_e, b_pn, a_tile; int colw;
    const int2* list; int gat_row0;
    __device__ void init(PG8_LAS unsigned char* lds, const unsigned* cnt, int npn_, const void* A_, size_t a_tile_, const void* B_, size_t b_e_, size_t b_pn_, int colw_, const int2* list_, int gat_row0_) {
        const int lane = tid_fresh() & 63, x = lane & 31;
        G = gridDim.x; c = blockIdx.x; npn = npn_; A = (const char*)A_; a_tile = a_tile_; B = (const char*)B_; b_e = b_e_; b_pn = b_pn_; colw = colw_; list = list_; gat_row0 = gat_row0_;
        const unsigned cnt_l = __hip_atomic_load(cnt + x, __ATOMIC_RELAXED, __HIP_MEMORY_SCOPE_AGENT);
        const int tiles = (int)((cnt_l + 255u) >> 8);
        int inc = tiles;
#pragma unroll
        for (int o = 1; o < 32; o <<= 1) { const int t = __shfl_up(inc, o, 32); if (x >= o) inc += t; }
        tab = (PG8_LAS I2*)(lds + pg8::STAGE_BYTES + 8192);
        tab[x].x = (int)cnt_l; tab[x].y = inc - tiles;
        T = __builtin_amdgcn_readfirstlane(__shfl(inc, 31));
        __syncthreads();
    }
    __device__ __forceinline__ bool next(int i, pg8::Unit& u) const {
        const long L = (long)i * G + c; if (L >= (long)T * npn) return false;
        const int ti = (int)(L / npn), pn = (int)(L % npn);
        const int my_excl = tab[__builtin_amdgcn_mbcnt_lo(~0u, 0u) & 31].y;
        const unsigned long long m = __ballot(my_excl <= ti) & 0xffffffffull;
        const int e = __popcll(m) - 1;
        const int rt = ti - tab[e].y;
        const unsigned ce = (unsigned)tab[e].x;
        u.aux = __builtin_amdgcn_readfirstlane(e | (rt << 8)); u.aux2 = __builtin_amdgcn_readfirstlane((int)ce);
        u.row0 = ti * 256; u.col0 = pn * colw;
        u.A = A + (size_t)ti * a_tile; u.B = B + (size_t)e * b_e + (size_t)pn * b_pn;
        return true;
    }
    __device__ __forceinline__ int arow(const pg8::Unit& u, int r) const {
        const int e = u.aux & 255, rank = (u.aux >> 8) * 256 + r;
        return rank < u.aux2 ? gat_row0 + list[(size_t)e * LCAP + rank].x : ZERO_ROW;
    }
};
struct EpiSwiGLU {
    static constexpr bool PERM = true;
    bf16_t* H;
    __device__ __forceinline__ void operator()(const pg8::f32x4 (&acc)[2][2][4][2], const pg8::Unit& u, int wr, int wc, int fr, int fq) const {
        const int col = u.col0 + wc * 32 + 8 * fq;
#pragma unroll
        for (int ai = 0; ai < 2; ++ai)
#pragma unroll
            for (int m = 0; m < 4; ++m) {
                const int r = wr * 64 + fr + ai * 128 + m * 16;
                float hv[8];
#pragma unroll
                for (int n = 0; n < 2; ++n)
#pragma unroll
                    for (int j = 0; j < 4; ++j) { const float g = acc[ai][0][m][n][j], up = acc[ai][1][m][n][j]; hv[n * 4 + j] = g * up * __builtin_amdgcn_rcpf(1.0f + __expf(-g)); }
                pg8::u32x4 w; w.x = pk2(hv[0], hv[1]); w.y = pk2(hv[2], hv[3]); w.z = pk2(hv[4], hv[5]); w.w = pk2(hv[6], hv[7]);
                *(pg8::u32x4*)(H + (size_t)(u.row0 + r) * DEXP + col) = w;
            }
    }
};
__device__ __forceinline__ void phase_f3(const Args& a, int l, PG8_LAS unsigned char* lds) {
    const unsigned* cnt = (const unsigned*)(a.ws + WS_CTL) + CW_CNT + l * 32;
    const int2* list = (const int2*)(a.ws + WS_LIST);
    MoeSched S; S.init(lds, cnt, 4, a.ws, 0, a.ws + WS_WEXP, (size_t)1024 * 1024 * 2, (size_t)256 * 1024 * 2, 128, list, (int)(WS_X2B / 2048));
    EpiSwiGLU E{(bf16_t*)(a.ws + WS_H)};
    pg8::gemm_phase<EpiSwiGLU, MoeSched, true>(lds, pg8::Dims{DM, DM, DM}, S, E);
}
__device__ __forceinline__ void phase_f4(const Args& a, int l, PG8_LAS unsigned char* lds) {
    const unsigned* cnt = (const unsigned*)(a.ws + WS_CTL) + CW_CNT + l * 32;
    MoeSched S; S.init(lds, cnt, 4, a.ws + WS_H, (size_t)256 * DEXP * 2, a.ws + WS_WEXP + (size_t)NEXP * 1024 * 1024 * 2, (size_t)1024 * 512 * 2, (size_t)256 * 512 * 2, 256, nullptr, 0);
    pg8::EpiBf16 E{(bf16_t*)(a.ws + WS_Y), DM};
    pg8::gemm_phase<pg8::EpiBf16, MoeSched, false>(lds, pg8::Dims{DEXP, DEXP, DEXP}, S, E);
}
__device__ __forceinline__ void phase_ln3(const Args& a, int l, float* OUT, bf16_t* OUTB) {
    const int tid = tid_fresh(), lane = tid & 63, wid = tid >> 6;
    const unsigned* cnt = (const unsigned*)(a.ws + WS_CTL) + CW_CNT + l * 32;
    const int2* tokpos = (const int2*)(a.ws + WS_TOKPOS);
    const bf16_t* X2B = (const bf16_t*)(a.ws + WS_X2B); const bf16_t* Y = (const bf16_t*)(a.ws + WS_Y);
    const float* g = a.in[28] + (size_t)(l * 3 + 2) * DM; const float* bta = a.in[29] + (size_t)(l * 3 + 2) * DM;
    int mybase = 0;
    { int acc = 0; for (int x = 0; x < NEXP; ++x) { if (x == lane) mybase = acc; acc += (int)((cnt[x] + 255u) >> 8); } }
    for (int row = blockIdx.x * 8 + wid; row < NTOK; row += gridDim.x * 8) {
        const int2 p0 = tokpos[row * 2], p1 = tokpos[row * 2 + 1]; const float2 tg = ((const float2*)(a.ws + WS_TOKGATE))[row];
        const size_t h0 = (size_t)__shfl(mybase, p0.x) * 256 + p0.y, h1 = (size_t)__shfl(mybase, p1.x) * 256 + p1.y;
        const bf16_t* xr = X2B + (size_t)row * DM; const bf16_t* y0 = Y + h0 * DM; const bf16_t* y1 = Y + h1 * DM;
        float x[16];
#pragma unroll
        for (int m = 0; m < 4; ++m) { const int o = m * 256 + lane * 4; const uint2 xb_ = *(const uint2*)(xr + o); const float4 xv = make_float4(bflo(xb_.x), bfhi(xb_.x), bflo(xb_.y), bfhi(xb_.y)); const uint2 a0 = *(const uint2*)(y0 + o), a1 = *(const uint2*)(y1 + o);
            x[m * 4] = fmaf(ALPHA, xv.x, fmaf(tg.x, bflo(a0.x), tg.y * bflo(a1.x))); x[m * 4 + 1] = fmaf(ALPHA, xv.y, fmaf(tg.x, bfhi(a0.x), tg.y * bfhi(a1.x)));
            x[m * 4 + 2] = fmaf(ALPHA, xv.z, fmaf(tg.x, bflo(a0.y), tg.y * bflo(a1.y))); x[m * 4 + 3] = fmaf(ALPHA, xv.w, fmaf(tg.x, bfhi(a0.y), tg.y * bfhi(a1.y))); }
        float s = 0.f;
#pragma unroll
        for (int k = 0; k < 16; ++k) s += x[k];
        const float mean = wsum(s) * (1.0f / 1024.0f);
        float q = 0.f;
#pragma unroll
        for (int k = 0; k < 16; ++k) { const float d = x[k] - mean; q = fmaf(d, d, q); }
        const float rstd = rsqrtf(wsum(q) * (1.0f / 1024.0f) + 1e-5f);
#pragma unroll
        for (int m = 0; m < 4; ++m) { const int o = m * 256 + lane * 4; const float4 gv = *(const float4*)(g + o), bv = *(const float4*)(bta + o); float4 r;
            r.x = (x[m * 4] - mean) * rstd * gv.x + bv.x; r.y = (x[m * 4 + 1] - mean) * rstd * gv.y + bv.y; r.z = (x[m * 4 + 2] - mean) * rstd * gv.z + bv.z; r.w = (x[m * 4 + 3] - mean) * rstd * gv.w + bv.w;
            if (OUT) *(float4*)(OUT + (size_t)row * DM + o) = r;
            if (OUTB) { uint2 ob; ob.x = pk2(r.x, r.y); ob.y = pk2(r.z, r.w); *(uint2*)(OUTB + (size_t)row * DM + o) = ob; } }
    }
}

constexpr int PH_PER_LAYER = 14, N_PHASES = 1 + 2 * PH_PER_LAYER;

__global__ void __launch_bounds__(NTHREADS, 2) mk_fwd(Args a) {
    extern __shared__ __attribute__((aligned(16))) unsigned char smem[];
    float* lds = (float*)smem;
    PG8_LAS unsigned char* lds3 = (PG8_LAS unsigned char*)smem;
    volatile LAS unsigned* xbw = (volatile LAS unsigned*)(smem + LDS_BYTES - 16);
    const int lo = a.ph_lo, hi = a.ph_hi;
    unsigned* ctl = (unsigned*)(a.ws + WS_CTL);
    XcdBarrier bar; bar.bar = ctl + CW_BAR; bar.x = 0; bar.st = xbw;
    if (hi - lo > 1) {
        if (threadIdx.x == 0) { xbw[0] = 0u; xbw[1] = 0u; }
        __syncthreads();
        bar = xcd_barrier_post(ctl + CW_BAR, xbw);
    }
#define IN(k) (lo <= (k) && (k) < hi)
#define SEAM(k) do { if (IN(k) && IN((k) + 1)) xcd_barrier(bar); } while (0)
    if (IN(0)) { phase_prologue(a, lds); if (PROBE_REP == 99) { xcd_barrier(bar); phase_prologue(a, lds); } }
    SEAM(0);
#define LAYER_BODY(l) do { \
        const int p0 = 1 + l * PH_PER_LAYER; \
        const float* xin = (l == 0) ? a.in[0] : (const float*)nullptr; const bf16_t* xinb = (l == 0) ? (const bf16_t*)nullptr : (const bf16_t*)(a.ws + WS_XB);     \
        float* xout = (l == 0) ? (float*)nullptr : a.out; \
        if (IN(p0 + 0)) { phase_g1(a, l, lds3); if (PROBE_REP == 0) { xcd_barrier(bar); phase_g1(a, l, lds3); } } \
        SEAM(p0 + 0); \
        if (IN(p0 + 1)) { phase_prep(a, l, lds); if (PROBE_REP == 1) { xcd_barrier(bar); phase_prep(a, l, lds); } } \
        SEAM(p0 + 1); \
        if (IN(p0 + 2)) { phase_scan_att2(a, l, lds3); if (PROBE_REP == 2) { xcd_barrier(bar); phase_scan_att2(a, l, lds3); } } \
        SEAM(p0 + 2); \
        if (IN(p0 + 3)) { phase_post(a, l); if (PROBE_REP == 3) { xcd_barrier(bar); phase_post(a, l); } } \
        SEAM(p0 + 3); \
        if (IN(p0 + 4)) { phase_dense_res(a.ws + WS_MIX, a.ws + WS_WOUT + (size_t)l * 2 * MiB, xin, xinb, (bf16_t*)(a.ws + WS_PRE), lds3); if (PROBE_REP == 4) { xcd_barrier(bar); phase_dense_res(a.ws + WS_MIX, a.ws + WS_WOUT + (size_t)l * 2 * MiB, xin, xinb, (bf16_t*)(a.ws + WS_PRE), lds3); } } \
        SEAM(p0 + 4); \
        if (IN(p0 + 5)) { phase_ln((const bf16_t*)(a.ws + WS_PRE), a.in[28] + (size_t)(l * 3) * DM, a.in[29] + (size_t)(l * 3) * DM, (float*)nullptr, (bf16_t*)(a.ws + WS_X1B)); if (PROBE_REP == 5) { xcd_barrier(bar); phase_ln((const bf16_t*)(a.ws + WS_PRE), a.in[28] + (size_t)(l * 3) * DM, a.in[29] + (size_t)(l * 3) * DM, (float*)nullptr, (bf16_t*)(a.ws + WS_X1B)); } } \
        SEAM(p0 + 5); \
        if (IN(p0 + 6)) { phase_dense_bf16(a.ws + WS_X1B, NTOK, a.ws + WS_WQ + (size_t)l * 2 * MiB, DM, (bf16_t*)(a.ws + WS_Q), lds3); if (PROBE_REP == 6) { xcd_barrier(bar); phase_dense_bf16(a.ws + WS_X1B, NTOK, a.ws + WS_WQ + (size_t)l * 2 * MiB, DM, (bf16_t*)(a.ws + WS_Q), lds3); } } \
        SEAM(p0 + 6); \
        if (IN(p0 + 7)) { phase_matt_s(a, lds3); if (PROBE_REP == 7) { xcd_barrier(bar); phase_matt_s(a, lds3); } } \
        SEAM(p0 + 7); \
        if (IN(p0 + 8)) { phase_matt_pv(a, lds3); if (PROBE_REP == 8) { xcd_barrier(bar); phase_matt_pv(a, lds3); } } \
        SEAM(p0 + 8); \
        if (IN(p0 + 9)) { phase_dense_res(a.ws + WS_O, a.ws + WS_WO + (size_t)l * 2 * MiB, (const float*)nullptr, (const bf16_t*)(a.ws + WS_X1B), (bf16_t*)(a.ws + WS_PRE2), lds3); if (PROBE_REP == 9) { xcd_barrier(bar); phase_dense_res(a.ws + WS_O, a.ws + WS_WO + (size_t)l * 2 * MiB, (const float*)nullptr, (const bf16_t*)(a.ws + WS_X1B), (bf16_t*)(a.ws + WS_PRE2), lds3); } } \
        SEAM(p0 + 9); \
        if (IN(p0 + 10)) { phase_ln2_router(a, l, lds); if (PROBE_REP == 10) { xcd_barrier(bar); phase_ln2_router(a, l, lds, true); } } \
        SEAM(p0 + 10); \
        if (IN(p0 + 11)) { phase_f3(a, l, lds3); if (PROBE_REP == 11) { xcd_barrier(bar); phase_f3(a, l, lds3); } } \
        SEAM(p0 + 11); \
        if (IN(p0 + 12)) { phase_f4(a, l, lds3); if (PROBE_REP == 12) { xcd_barrier(bar); phase_f4(a, l, lds3); } } \
        SEAM(p0 + 12); \
        if (IN(p0 + 13)) { { phase_ln3(a, l, xout, (l == 0) ? (bf16_t*)(a.ws + WS_XB) : (bf16_t*)nullptr); } if (PROBE_REP == 13) { xcd_barrier(bar); { phase_ln3(a, l, xout, (l == 0) ? (bf16_t*)(a.ws + WS_XB) : (bf16_t*)nullptr); } } } \
        SEAM(p0 + 13); \
    } while (0)
    LAYER_BODY(0);
    LAYER_BODY(1);
}
}

extern "C" void kernel_launch(void* const* d_in, const int* in_sizes, int n_in, void* d_out, int out_size, void* d_ws, size_t ws_size, hipStream_t stream) {
    static int grid = 0;
    if (!grid) {
        int dev = 0, cus = 0, per_cu = 0;
        (void)hipGetDevice(&dev);
        (void)hipDeviceGetAttribute(&cus, hipDeviceAttributeMultiprocessorCount, dev);
        (void)hipFuncSetAttribute((const void*)mk_fwd, hipFuncAttributeMaxDynamicSharedMemorySize, LDS_BYTES);
        (void)hipOccupancyMaxActiveBlocksPerMultiprocessor(&per_cu, mk_fwd, NTHREADS, LDS_BYTES);
        (void)hipGetLastError();
        grid = cus * 1;
        if (grid != 256) grid = 256;
    }
    if (ws_size < WS_END) return;
    (void)hipMemsetAsync(d_ws, 0, CTL_ZERO_BYTES, stream);
    Args a;
    memset(&a, 0, sizeof(a));
    for (int i = 0; i < 30; ++i) a.in[i] = (const float*)d_in[i];
    a.out = (float*)d_out; a.ws = (unsigned char*)d_ws;
#if MK_ONE_LAUNCH
    a.ph_lo = 0; a.ph_hi = N_PHASES;
    hipLaunchKernelGGL(mk_fwd, dim3(grid), dim3(NTHREADS), LDS_BYTES, stream, a);
#else
    for (int p = 0; p < N_PHASES; ++p) {
        a.ph_lo = p; a.ph_hi = p + 1;
        hipLaunchKernelGGL(mk_fwd, dim3(grid), dim3(NTHREADS), LDS_BYTES, stream, a);
    }
#endif
}
```

```cpp
#include <hip/hip_runtime.h>
#include <stdint.h>
#include <cstring>

#ifndef PROBE_REP
#define PROBE_REP -1
#endif
#ifndef MK_ONE_LAUNCH
#define MK_ONE_LAUNCH 1
#endif

namespace {
constexpr int NTHREADS = 512;
constexpr int NTOK = 16384, SEQ = 2048, NBATCH = 8, DM = 1024;
constexpr int MEMLEN = 256;
constexpr int NH = 8, HD = 64;
constexpr int IN_COLS = 3328, ZLD = 3584;
constexpr int C_Q = 0, C_K = 512, C_V = 1024, C_R = 1536, C_KR = 2048, C_VR = 2560, C_ZW = 3072, C_ZA = 3136, C_ZG = 3200, C_ZV = 3328;
constexpr int NEXP = 32, DEXP = 512;
constexpr int LCAP = 16384;
constexpr float ALPHA = 1.4142135623730951f;
constexpr float NEG_INF = -1e30f;
constexpr int LDS_BYTES = 147456;

typedef unsigned short bf16_t;
typedef float f32x2_t __attribute__((ext_vector_type(2)));
typedef __bf16 bf16x2_t __attribute__((ext_vector_type(2)));
__device__ __forceinline__ unsigned pk2(float lo, float hi) { f32x2_t v = {lo, hi}; bf16x2_t b = __builtin_convertvector(v, bf16x2_t); return __builtin_bit_cast(unsigned, b); }
__device__ __forceinline__ bf16_t f2bf(float f) { return (bf16_t)(pk2(f, 0.f) & 0xffffu); }
__device__ __forceinline__ float bf2f(bf16_t h) { return __uint_as_float((unsigned)h << 16); }
__device__ __forceinline__ float bflo(unsigned u) { return __uint_as_float(u << 16); }
__device__ __forceinline__ float bfhi(unsigned u) { return __uint_as_float(u & 0xffff0000u); }

constexpr size_t MiB = 1u << 20;
constexpr size_t WS_CTL = 0, CTL_ZERO_BYTES = 64 * 1024;
constexpr size_t WS_LIST = 2 * MiB;
constexpr size_t WS_KB = 6 * MiB;
constexpr size_t WS_TOKPOS = 10 * MiB;
constexpr size_t WS_TOKGATE = 10 * MiB + 512 * 1024;
constexpr size_t WS_KMEAN = 11 * MiB;
constexpr size_t WS_MEMB = 12 * MiB;
constexpr size_t WS_VT = 16 * MiB;
constexpr size_t WS_WIN0 = 24 * MiB, WS_WIN1 = 31 * MiB;
constexpr size_t WS_WOUT = 38 * MiB, WS_WQ = 42 * MiB, WS_WKV = 46 * MiB, WS_WO = 54 * MiB;
constexpr size_t WS_WEXP = 58 * MiB;
constexpr size_t WS_XL1 = 154 * MiB, WS_XB = 218 * MiB, WS_VFIRST = 250 * MiB;
constexpr size_t WS_Z = 266 * MiB, WS_MIX = 378 * MiB, WS_R3 = 410 * MiB, WS_END = 508 * MiB;
constexpr int REC_TG = 644;
constexpr size_t WS_REC = 410 * MiB;
constexpr size_t WS_YRAW = 492 * MiB;
constexpr size_t WS_RVT = 154 * MiB, WS_RG = 170 * MiB;
constexpr size_t WS_BON = 20 * MiB;
constexpr size_t WS_LORA = 22 * MiB;
constexpr size_t LORA_L = 512 * 288 * 2, LORA_I = 512 * 64 * 2, LORA_G = 2 * 512 * 64 * 2, LORA_V = LORA_G + 512 * 128 * 2;
constexpr size_t WS_LSUM = 21 * MiB;
constexpr size_t WS_P = 298 * MiB;
constexpr size_t WS_PRE = 266 * MiB, WS_X1 = 410 * MiB, WS_X1B = 474 * MiB;
constexpr size_t WS_Q = 330 * MiB, WS_KV = 362 * MiB, WS_O = 266 * MiB, WS_PRE2 = 330 * MiB;
constexpr size_t WS_X2 = 410 * MiB, WS_X2B = 474 * MiB;
constexpr size_t WS_H = 266 * MiB, WS_Y = 306 * MiB;

constexpr int CW_CNT = 0;
constexpr int CW_BAR = 1024;

#define XB_TMO      128
#define XB_XCNT(j)  (256  + 64 * (j))
#define XB_XSUB(j)  (1280 + 64 * (j))
#define XB_XGEN(j)  (2304 + 64 * (j))
#define XB_TOP      3328
#define XB_TOPGEN   3392
#define XCD_BAR_WORDS 3456
#define XB_SPIN_CAP (1u << 18)
#define LAS __attribute__((address_space(3)))
__device__ __forceinline__ unsigned xb_ld(unsigned* p)              { return __hip_atomic_load(p, __ATOMIC_RELAXED, __HIP_MEMORY_SCOPE_AGENT); }
__device__ __forceinline__ unsigned xb_add(unsigned* p, unsigned v) { return __hip_atomic_fetch_add(p, v, __ATOMIC_RELAXED, __HIP_MEMORY_SCOPE_AGENT); }
__device__ __forceinline__ unsigned xb_xcc_id() { return (unsigned)__builtin_amdgcn_s_getreg((3 << 11) | 20) & 0xFu; }
#define XB_SPIN(cond, bar) do { unsigned _sp = 0; while (cond) { __builtin_amdgcn_s_sleep(1); \
    if ((++_sp & 255u) == 0u) { if (xb_ld(&(bar)[XB_TMO])) break; if (_sp > XB_SPIN_CAP) { atomicAdd(&(bar)[XB_TMO], 1u); break; } } } } while (0)
struct XcdBarrier { unsigned* bar; unsigned x; volatile LAS unsigned* st; };
__device__ __forceinline__ XcdBarrier xcd_barrier_post(unsigned* bar, volatile LAS unsigned* st) {
    XcdBarrier b; b.bar = bar; b.x = xb_xcc_id(); b.st = st;
    if (threadIdx.x == 0) (void)xb_add(&bar[XB_XCNT(b.x)], 1u);
    return b;
}
__device__ __forceinline__ void xcd_barrier_complete(unsigned* bar, unsigned x, unsigned& nloc, unsigned& nx) {
    const unsigned G = gridDim.x * gridDim.y * gridDim.z;
    unsigned sum, cnt, mine, sp = 0u;
    for (;;) {
        sum = 0u; cnt = 0u; mine = 0u;
#pragma unroll
        for (unsigned j = 0; j < 16; ++j) { const unsigned c = xb_ld(&bar[XB_XCNT(j)]); sum += c; cnt += (c > 0u) ? 1u : 0u; mine = (j == x) ? c : mine; }
        if (sum == G) break;
        __builtin_amdgcn_s_sleep(1);
        if ((++sp & 255u) == 0u) { if (xb_ld(&bar[XB_TMO])) break; if (sp > XB_SPIN_CAP) { atomicAdd(&bar[XB_TMO], 1u); break; } }
    }
    nloc = mine > 0u ? mine : 1u; nx = cnt > 0u ? cnt : 1u;
}
__device__ __forceinline__ void xcd_barrier(const XcdBarrier& b) {
    asm volatile("s_waitcnt vmcnt(0)" ::: "memory");
    __syncthreads();
    if (threadIdx.x == 0) {
        unsigned* bar = b.bar;
        __builtin_amdgcn_s_waitcnt(0);
        unsigned nloc = b.st[0], nx = b.st[1];
        if (nloc == 0u) { xcd_barrier_complete(bar, b.x, nloc, nx); b.st[0] = nloc; b.st[1] = nx; }
        const unsigned old = xb_add(&bar[XB_XSUB(b.x)], 1u);
        const unsigned gen = old / nloc;
        if (old + 1u == (gen + 1u) * nloc) {
            __builtin_amdgcn_fence(__ATOMIC_RELEASE, "agent");
            asm volatile("s_waitcnt vmcnt(0)" ::: "memory");
            const unsigned og = xb_add(&bar[XB_TOP], 1u);
            const unsigned tg = og / nx;
            if (og + 1u == (tg + 1u) * nx) xb_add(&bar[XB_TOPGEN], 1u);
            else XB_SPIN(xb_ld(&bar[XB_TOPGEN]) == tg, bar);
            __builtin_amdgcn_fence(__ATOMIC_ACQUIRE, "agent");
            xb_add(&bar[XB_XGEN(b.x)], 1u);
            asm volatile("s_waitcnt vmcnt(0)" ::: "memory");
        } else {
            XB_SPIN(xb_ld(&bar[XB_XGEN(b.x)]) == gen, bar);
            __builtin_amdgcn_fence(__ATOMIC_ACQUIRE, "agent");
            asm volatile("s_waitcnt vmcnt(0)" ::: "memory");
        }
    }
    __syncthreads();
}

__device__ __forceinline__ int tid_fresh() { int t = threadIdx.x; asm volatile("" : "+v"(t)); return t; }
__device__ __forceinline__ float wsum(float v) {
#pragma unroll
    for (int o = 32; o > 0; o >>= 1) v += __shfl_xor(v, o);
    return v;
}
__device__ __forceinline__ float wmax(float v) {
#pragma unroll
    for (int o = 32; o > 0; o >>= 1) v = fmaxf(v, __shfl_xor(v, o));
    return v;
}
__device__ __forceinline__ float sigmoidf_(float x) { return 1.0f / (1.0f + __expf(-x)); }
__device__ __forceinline__ float softplusf_(float x) { return x > 20.f ? x : log1pf(__expf(x)); }

struct Args {
    const float* in[30];
    float* out;
    unsigned char* ws;
    int ph_lo, ph_hi;
};

namespace pg8 {
#define PG8_LAS __attribute__((address_space(3)))
typedef short bf16x8 __attribute__((ext_vector_type(8)));
typedef float f32x4 __attribute__((ext_vector_type(4)));
typedef unsigned u32x4 __attribute__((ext_vector_type(4)));
constexpr int BM = 256, BK = 64, HALF = 128, HTB = HALF * BK * 2, STAGE_BYTES = 8 * HTB, NXCD = 8, WGM = 8;

__host__ __device__ __forceinline__ int lds_byte(int r, int c) { const int st = (r >> 4) * 2 + (c >> 5), rr = r & 15, cc = c & 31, ob = rr * 64 + cc * 2; return st * 1024 + (ob ^ (((ob >> 9) & 1) << 5)); }
__host__ __device__ __forceinline__ void stage_rc(int b, int& R, int& C) { const int st = b / 1024, sb = b % 1024, swz = sb ^ (((sb >> 9) & 1) << 5); R = (st >> 1) * 16 + swz / 64; C = (st & 1) * 32 + (swz % 64) / 2; }
__host__ __device__ __forceinline__ int perm32(int rho) { const int n = rho >> 4, i = rho & 15; return 8 * (i >> 2) + 4 * n + (i & 3); }

struct Unit { const char* A; const char* B; int row0, col0, aux, aux2; };
struct Dims { int lda, ldb, K; };

struct TileOrder {
    int nM, nN, nwg, G, c;
    __device__ void init(int nM_, int nN_, int G_, int c_) { nM = nM_; nN = nN_; nwg = nM * nN; G = G_; c = c_; }
    __device__ bool tile(int i, int& pm, int& pn) const {
        const long L = (long)i * G + c; if (L >= nwg) return false;
        int wgid = (int)L; { const int q = nwg / NXCD, r = nwg % NXCD, xcd = wgid % NXCD, off = wgid / NXCD; wgid = (xcd < r ? xcd * (q + 1) : r * (q + 1) + (xcd - r) * q) + off; }
        const int nig = WGM * nN, gid = wgid / nig, fm = gid * WGM, gsz = (nM - fm) < WGM ? (nM - fm) : WGM;
        pm = fm + ((wgid % nig) % gsz); pn = (wgid % nig) / gsz; return true;
    }
};
struct DenseSched {
    TileOrder o; const char* A; const char* B; int lda, ldb;
    __device__ void init(const void* A_, int lda_, int M, const void* B_, int ldb_, int N) { A = (const char*)A_; B = (const char*)B_; lda = lda_; ldb = ldb_; o.init(M / BM, N / BM, gridDim.x, blockIdx.x); }
    __device__ __forceinline__ bool next(int i, Unit& u) const { int pm, pn; if (!o.tile(i, pm, pn)) return false;
        u.A = A + (size_t)pm * BM * lda * 2; u.B = B + (size_t)pn * BM * ldb * 2; u.row0 = pm * BM; u.col0 = pn * BM; u.aux = 0; u.aux2 = 0; return true; }
    __device__ __forceinline__ int arow(const Unit&, int r) const { return r; }
};

__device__ __forceinline__ unsigned cvt_pk_bf16(float lo, float hi) { unsigned r; asm volatile("v_cvt_pk_bf16_f32 %0, %1, %2" : "=v"(r) : "v"(lo), "v"(hi)); return r; }

struct EpiBf16 {
    static constexpr bool PERM = true;
    bf16_t* O; int ldc;
    __device__ __forceinline__ void operator()(const f32x4 (&acc)[2][2][4][2], const Unit& u, int wr, int wc, int fr, int fq) const {
        const int row0 = u.row0 + wr * 64 + fr, col0 = u.col0 + wc * 32 + 8 * fq;
#pragma unroll
        for (int ai = 0; ai < 2; ++ai)
#pragma unroll
            for (int m = 0; m < 4; ++m) { bf16_t* rowp = O + (size_t)(row0 + ai * HALF + m * 16) * ldc + col0;
#pragma unroll
                for (int bj = 0; bj < 2; ++bj) { const f32x4 v0 = acc[ai][bj][m][0], v1 = acc[ai][bj][m][1];
                    u32x4 w; w.x = cvt_pk_bf16(v0[0], v0[1]); w.y = cvt_pk_bf16(v0[2], v0[3]); w.z = cvt_pk_bf16(v1[0], v1[1]); w.w = cvt_pk_bf16(v1[2], v1[3]);
                    *(u32x4*)(rowp + bj * HALF) = w; } }
    }
};
struct EpiF32Res {
    static constexpr bool PERM = false;
    float* C; const float* RES; int ldc; float rs; const bf16_t* RESB;
    __device__ __forceinline__ void operator()(const f32x4 (&acc)[2][2][4][2], const Unit& u, int wr, int wc, int fr, int fq) const {
        const int row0 = u.row0 + wr * 64 + fr, col0 = u.col0 + wc * 32 + 4 * fq;
#pragma unroll
        for (int ai = 0; ai < 2; ++ai)
#pragma unroll
            for (int m = 0; m < 4; ++m) { const size_t ro = (size_t)(row0 + ai * HALF + m * 16) * ldc + col0;
#pragma unroll
                for (int bj = 0; bj < 2; ++bj)
#pragma unroll
                    for (int n = 0; n < 2; ++n) { f32x4 r;
                        if (RESB) { const uint2 rb = *(const uint2*)(RESB + ro + bj * HALF + n * 16); r = (f32x4){bflo(rb.x), bfhi(rb.x), bflo(rb.y), bfhi(rb.y)}; }
                        else r = *(const f32x4*)(RES + ro + bj * HALF + n * 16);
                        *(f32x4*)(C + ro + bj * HALF + n * 16) = acc[ai][bj][m][n] + r * rs; } }
    }
};

struct EpiBf16Res {
    static constexpr bool PERM = true;
    bf16_t* O; const float* RES; int ldc; float rs; const bf16_t* RESB;
    __device__ __forceinline__ void operator()(const f32x4 (&acc)[2][2][4][2], const Unit& u, int wr, int wc, int fr, int fq) const {
        const int row0 = u.row0 + wr * 64 + fr, col0 = u.col0 + wc * 32 + 8 * fq;
#pragma unroll
        for (int ai = 0; ai < 2; ++ai)
#pragma unroll
            for (int m = 0; m < 4; ++m) { const size_t ro = (size_t)(row0 + ai * HALF + m * 16) * ldc + col0;
#pragma unroll
                for (int bj = 0; bj < 2; ++bj) { f32x4 r0, r1;
                    if (RESB) { const uint4 rb = *(const uint4*)(RESB + ro + bj * HALF); r0 = (f32x4){bflo(rb.x), bfhi(rb.x), bflo(rb.y), bfhi(rb.y)}; r1 = (f32x4){bflo(rb.z), bfhi(rb.z), bflo(rb.w), bfhi(rb.w)}; }
                    else { r0 = *(const f32x4*)(RES + ro + bj * HALF); r1 = *(const f32x4*)(RES + ro + bj * HALF + 4); }
                    const f32x4 v0 = acc[ai][bj][m][0] + r0 * rs, v1 = acc[ai][bj][m][1] + r1 * rs;
                    u32x4 w; w.x = cvt_pk_bf16(v0[0], v0[1]); w.y = cvt_pk_bf16(v0[2], v0[3]); w.z = cvt_pk_bf16(v1[0], v1[1]); w.w = cvt_pk_bf16(v1[2], v1[3]);
                    *(u32x4*)(O + ro + bj * HALF) = w; } }
    }
};

__device__ __forceinline__ void store_bf16_tile(const f32x4 (&acc)[2][2][4][2], bf16_t* O, int ldc, int row0, int col0) {
#pragma unroll
    for (int ai = 0; ai < 2; ++ai)
#pragma unroll
        for (int m = 0; m < 4; ++m) { bf16_t* rowp = O + (size_t)(row0 + ai * HALF + m * 16) * ldc + col0;
#pragma unroll
            for (int bj = 0; bj < 2; ++bj) { const f32x4 v0 = acc[ai][bj][m][0], v1 = acc[ai][bj][m][1];
                u32x4 w; w.x = cvt_pk_bf16(v0[0], v0[1]); w.y = cvt_pk_bf16(v0[2], v0[3]); w.z = cvt_pk_bf16(v1[0], v1[1]); w.w = cvt_pk_bf16(v1[2], v1[3]);
                *(u32x4*)(rowp + bj * HALF) = w; } }
}
struct EpiG1 {
    static constexpr bool PERM = true;
    bf16_t* Z; bf16_t* KB; bf16_t* VT;
    __device__ __forceinline__ void operator()(const f32x4 (&acc)[2][2][4][2], const Unit& u, int wr, int wc, int fr, int fq) const {
        bf16_t* O = Z; int ldc = ZLD;
        if (u.aux == 1) { O = KB; ldc = 1024; } else if (u.aux >= 2) { O = VT + (size_t)(u.aux - 2) * 1024 * 256; ldc = 256; }
        store_bf16_tile(acc, O, ldc, u.row0 + wr * 64 + fr, u.col0 + wc * 32 + 8 * fq);
    }
};
struct EpiSoftmax {
    static constexpr bool PERM = true;
    bf16_t* P; float* LSUM; PG8_LAS float* xmax;
    __device__ __forceinline__ void operator()(const f32x4 (&acc)[2][2][4][2], const Unit& u, int wr, int wc, int fr, int fq) const {
        const float c = 0.0625f * 1.4426950408889634f;
#pragma unroll
        for (int ai = 0; ai < 2; ++ai)
#pragma unroll
            for (int m = 0; m < 4; ++m) {
                float mx = acc[ai][0][m][0][0];
#pragma unroll
                for (int bj = 0; bj < 2; ++bj)
#pragma unroll
                    for (int n = 0; n < 2; ++n)
#pragma unroll
                        for (int j = 0; j < 4; ++j) mx = fmaxf(mx, acc[ai][bj][m][n][j]);
                mx = fmaxf(mx, __shfl_xor(mx, 16)); mx = fmaxf(mx, __shfl_xor(mx, 32));
                if (fq == 0) xmax[wc * 256 + wr * 64 + fr + ai * 128 + m * 16] = mx;
            }
        asm volatile("s_waitcnt lgkmcnt(0)" ::: "memory"); __builtin_amdgcn_s_barrier(); asm volatile("" ::: "memory");
        const int hm = u.col0 >> 8;
#pragma unroll
        for (int ai = 0; ai < 2; ++ai)
#pragma unroll
            for (int m = 0; m < 4; ++m) {
                int r = wr * 64 + fr + ai * 128 + m * 16; asm volatile("" : "+v"(r) :: "memory");
                const float M = fmaxf(fmaxf(xmax[r], xmax[256 + r]), fmaxf(xmax[512 + r], xmax[768 + r]));
                float sum = 0.f; bf16_t* rowp = P + (size_t)(u.row0 + r) * 1024 + u.col0 + wc * 32 + 8 * fq;
#pragma unroll
                for (int bj = 0; bj < 2; ++bj) {
                    float e[8];
#pragma unroll
                    for (int n = 0; n < 2; ++n)
#pragma unroll
                        for (int j = 0; j < 4; ++j) { e[n * 4 + j] = __builtin_amdgcn_exp2f((acc[ai][bj][m][n][j] - M) * c); sum += e[n * 4 + j]; }
                    u32x4 w; w.x = pk2(e[0], e[1]); w.y = pk2(e[2], e[3]); w.z = pk2(e[4], e[5]); w.w = pk2(e[6], e[7]);
                    *(u32x4*)(rowp + bj * HALF) = w;
                }
                sum += __shfl_xor(sum, 16); sum += __shfl_xor(sum, 32);
                if (fq == 0) LSUM[((size_t)(u.row0 + r) * 4 + hm) * 4 + wc] = sum;
            }
        asm volatile("s_waitcnt lgkmcnt(0)" ::: "memory"); __builtin_amdgcn_s_barrier(); asm volatile("" ::: "memory");
    }
};
struct EpiPV {
    static constexpr bool PERM = true;
    bf16_t* O; const float* LSUM;
    __device__ __forceinline__ void operator()(const f32x4 (&acc)[2][2][4][2], const Unit& u, int wr, int wc, int fr, int fq) const {
        const int hm = u.col0 >> 8;
#pragma unroll
        for (int ai = 0; ai < 2; ++ai)
#pragma unroll
            for (int m = 0; m < 4; ++m) {
                int row = u.row0 + wr * 64 + fr + ai * 128 + m * 16; asm volatile("" : "+v"(row) :: "memory");
                const f32x4 ls = *(const f32x4*)(LSUM + ((size_t)row * 4 + hm) * 4);
                const float inv = 1.0f / ((ls[0] + ls[1]) + (ls[2] + ls[3]));
                bf16_t* rowp = O + (size_t)row * 1024 + u.col0 + wc * 32 + 8 * fq;
#pragma unroll
                for (int bj = 0; bj < 2; ++bj) { const f32x4 v0 = acc[ai][bj][m][0] * inv, v1 = acc[ai][bj][m][1] * inv;
                    u32x4 w; w.x = cvt_pk_bf16(v0[0], v0[1]); w.y = cvt_pk_bf16(v0[2], v0[3]); w.z = cvt_pk_bf16(v1[0], v1[1]); w.w = cvt_pk_bf16(v1[2], v1[3]);
                    *(u32x4*)(rowp + bj * HALF) = w; }
            }
    }
};
struct G1Sched {
    TileOrder o; const char *XB, *WIN, *MEMB, *WKV;
    __device__ void init(const void* XB_, const void* WIN_, int nN, const void* MEMB_, const void* WKV_) { XB = (const char*)XB_; WIN = (const char*)WIN_; MEMB = (const char*)MEMB_; WKV = (const char*)WKV_; o.init(64, nN, gridDim.x, blockIdx.x); }
    __device__ __forceinline__ bool next(int i, Unit& u) const {
        int pm, pn; u.aux2 = 0;
        if (o.tile(i, pm, pn)) { u.A = XB + (size_t)pm * BM * 2048; u.B = WIN + (size_t)pn * BM * 2048; u.row0 = pm * BM; u.col0 = pn * BM; u.aux = 0; return true; }
        const long L = (long)i * o.G + o.c - o.nwg;
        if (L >= 64) return false;
        if (L < 32) { pm = (int)L >> 2; pn = (int)L & 3; u.A = MEMB + (size_t)pm * BM * 2048; u.B = WKV + (size_t)pn * BM * 2048; u.row0 = pm * BM; u.col0 = pn * BM; u.aux = 1; return true; }
        const int b = ((int)L - 32) >> 2; pm = ((int)L - 32) & 3;
        u.A = WKV + (size_t)(1024 + pm * BM) * 2048; u.B = MEMB + (size_t)b * BM * 2048; u.row0 = pm * BM; u.col0 = 0; u.aux = 2 + b; return true;
    }
    __device__ __forceinline__ int arow(const Unit&, int r) const { return r; }
};
struct MattSched {
    int G, c; const char* A; const char* B; size_t b_batch; int b_head;
    __device__ void init(const void* A_, const void* B_, size_t b_batch_, int b_head_) { G = gridDim.x; c = blockIdx.x; A = (const char*)A_; B = (const char*)B_; b_batch = b_batch_; b_head = b_head_; }
    __device__ __forceinline__ bool next(int i, Unit& u) const {
        const long L = (long)i * G + c; if (L >= 256) return false;
        const int pm = (int)L >> 2, hm = (int)L & 3;
        u.A = A + ((size_t)pm * BM * 1024 + hm * 256) * 2; u.B = B + (size_t)(pm >> 3) * b_batch + (size_t)hm * b_head;
        u.row0 = pm * BM; u.col0 = hm * 256; u.aux = 0; u.aux2 = 0; return true;
    }
    __device__ __forceinline__ int arow(const Unit&, int r) const { return r; }
};

template <class Epi, class Sched, bool GATHER>
__device__ __forceinline__ void gemm_phase(PG8_LAS unsigned char* lds, const Dims g, const Sched& S, const Epi& E) {
    const int tid = tid_fresh(), wid = __builtin_amdgcn_readfirstlane(tid >> 6), wr = wid >> 2, wc = wid & 3;
    const int K = g.K, nt = K / BK;
    unsigned voffB[2];
#pragma unroll
    for (int i = 0; i < 2; ++i) { int R, C; stage_rc(tid * 16 + i * 8192, R, C); const int Rb = Epi::PERM ? ((R & ~31) + perm32(R & 31)) : R;
        voffB[i] = (unsigned)(Rb * g.ldb + C) * 2u; }
    const size_t kstep = (size_t)(BK * 2);
    const size_t hstepB = (size_t)HALF * g.ldb * 2;
    const unsigned ldsw = (unsigned)wid * 1024u;
    const int aoff = lds_byte(wr * 64 + (tid & 15), ((tid & 63) >> 4) * 8), boff = lds_byte(wc * 32 + (tid & 15), ((tid & 63) >> 4) * 8);
    const size_t hstepA = GATHER ? 0 : (size_t)HALF * g.lda * 2;
#define PG8_SA(b, h) (((b) * 2 + (h)) * HTB)
#define PG8_SB(b, h) ((4 + (b) * 2 + (h)) * HTB)
#define PG8_STAGE(bufoff, gbase, v0, v1) do { \
        __builtin_amdgcn_global_load_lds((const unsigned*)((const char*)(gbase) + (v0)), (PG8_LAS unsigned*)(lds + (bufoff) + ldsw), 16, 0, 0); \
        __builtin_amdgcn_global_load_lds((const unsigned*)((const char*)(gbase) + (v1)), (PG8_LAS unsigned*)(lds + (bufoff) + ldsw + 8192), 16, 0, 0); } while (0)
#define PG8_STAGEB(bufoff, gbase) PG8_STAGE(bufoff, gbase, voffB[0], voffB[1])
#define PG8_LDA(dst, b, h) do { _Pragma("unroll") for (int m = 0; m < 4; ++m) _Pragma("unroll") for (int k = 0; k < 2; ++k) dst[m][k] = *(const PG8_LAS bf16x8*)(lds + PG8_SA(b, h) + aoff + m * 2048 + k * 1024); } while (0)
#define PG8_LDB(dst, b, h) do { _Pragma("unroll") for (int n = 0; n < 2; ++n) _Pragma("unroll") for (int k = 0; k < 2; ++k) dst[n][k] = *(const PG8_LAS bf16x8*)(lds + PG8_SB(b, h) + boff + n * 2048 + k * 1024); } while (0)
#define PG8_MMA(ai, bj, At, Bt) do { __builtin_amdgcn_s_setprio(1); _Pragma("unroll") for (int m = 0; m < 4; ++m) _Pragma("unroll") for (int n = 0; n < 2; ++n) _Pragma("unroll") for (int k = 0; k < 2; ++k) \
        acc[ai][bj][m][n] = __builtin_amdgcn_mfma_f32_16x16x32_bf16(Bt[n][k], At[m][k], acc[ai][bj][m][n], 0, 0, 0); __builtin_amdgcn_s_setprio(0); } while (0)
#define PG8_WAIT_V(n) asm volatile("s_waitcnt vmcnt(" #n ")" ::: "memory")
#define PG8_WAIT_L(n) asm volatile("s_waitcnt lgkmcnt(" #n ")" ::: "memory")
#define PG8_BAR __builtin_amdgcn_s_barrier()
#define PG8_SCHED __builtin_amdgcn_sched_barrier(0)
#define PG8_VOFFA(dst, u) do { _Pragma("unroll") for (int i_ = 0; i_ < 2; ++i_) { int R_, C_; stage_rc(tid * 16 + i_ * 8192, R_, C_); _Pragma("unroll") for (int h_ = 0; h_ < 2; ++h_) { \
        const int rr_ = GATHER ? S.arow(u, R_ + h_ * HALF) : R_; dst[h_ * 2 + i_] = (unsigned)(rr_ * g.lda + C_) * 2u; } } } while (0)
    Unit cur, nxt; int ui = 0;
    if (!S.next(0, cur)) return;
    f32x4 acc[2][2][4][2];
#pragma unroll
    for (int a = 0; a < 2; ++a)
#pragma unroll
        for (int b = 0; b < 2; ++b)
#pragma unroll
            for (int m = 0; m < 4; ++m)
#pragma unroll
                for (int n = 0; n < 2; ++n) acc[a][b][m][n] = (f32x4){0.f, 0.f, 0.f, 0.f};
    bf16x8 At[4][2], B0[2][2], B1[2][2];
    unsigned vC[4];
    PG8_VOFFA(vC, cur);
    PG8_LAS u32x4* myN = (PG8_LAS u32x4*)(lds + STAGE_BYTES + tid * 16);
    const char* cA = cur.A; const char* cB = cur.B;
    PG8_STAGEB(PG8_SB(0, 0), cB); PG8_STAGEB(PG8_SB(0, 1), cB + hstepB); PG8_STAGE(PG8_SA(0, 0), cA, vC[0], vC[1]); PG8_STAGE(PG8_SA(0, 1), cA + hstepA, vC[2], vC[3]);
    if (wr == 1) PG8_BAR;
    PG8_WAIT_V(2); PG8_BAR;
    PG8_STAGEB(PG8_SB(1, 0), cB + kstep); PG8_STAGE(PG8_SA(1, 0), cA + kstep, vC[0], vC[1]); PG8_STAGEB(PG8_SB(1, 1), cB + hstepB + kstep);
    PG8_WAIT_V(6); PG8_BAR;
    for (;;) {
        const bool has_next = S.next(ui + 1, nxt);
        const char* nA = cA; const char* nB = cB;
        { unsigned vT[4];
#pragma unroll
          for (int q = 0; q < 4; ++q) vT[q] = vC[q];
          if (has_next) { nA = nxt.A; nB = nxt.B; PG8_VOFFA(vT, nxt); }
          *myN = (u32x4){vT[0], vT[1], vT[2], vT[3]}; }
#pragma unroll 1
        for (int t = 0; t < nt; t += 2) {
            const bool last = (t == nt - 2);
            const char* a1 = cA + (size_t)(t + 1) * kstep;
            const char* a2 = last ? nA : cA + (size_t)(t + 2) * kstep; const char* b2 = last ? nB : cB + (size_t)(t + 2) * kstep;
            const char* a3 = a2 + kstep; const char* b3 = b2 + kstep;
            PG8_LDB(B0, 0, 0); PG8_LDB(B1, 0, 1); PG8_SCHED; PG8_LDA(At, 0, 0); PG8_STAGE(PG8_SA(1, 1), a1 + hstepA, vC[2], vC[3]);
            if (last) { const u32x4 vn = *myN; vC[0] = vn.x; vC[1] = vn.y; vC[2] = vn.z; vC[3] = vn.w; }
            PG8_WAIT_V(8); PG8_WAIT_L(0); PG8_BAR; PG8_MMA(0, 0, At, B0); PG8_MMA(0, 1, At, B1); PG8_BAR; PG8_SCHED;
            PG8_LDA(At, 0, 1); PG8_STAGEB(PG8_SB(0, 0), b2); PG8_STAGEB(PG8_SB(0, 1), b2 + hstepB); PG8_STAGE(PG8_SA(0, 0), a2, vC[0], vC[1]);
            PG8_WAIT_V(8); PG8_WAIT_L(0); PG8_BAR; PG8_MMA(1, 0, At, B0); PG8_MMA(1, 1, At, B1); PG8_BAR; PG8_SCHED;
            PG8_LDB(B0, 1, 0); PG8_LDB(B1, 1, 1); PG8_SCHED; PG8_LDA(At, 1, 0); PG8_STAGE(PG8_SA(0, 1), a2 + hstepA, vC[2], vC[3]);
            PG8_WAIT_V(8); PG8_WAIT_L(0); PG8_BAR; PG8_MMA(0, 0, At, B0); PG8_MMA(0, 1, At, B1); PG8_BAR; PG8_SCHED;
            PG8_LDA(At, 1, 1); PG8_STAGEB(PG8_SB(1, 0), b3); PG8_STAGEB(PG8_SB(1, 1), b3 + hstepB); PG8_STAGE(PG8_SA(1, 0), a3, vC[0], vC[1]);
            PG8_WAIT_V(8); PG8_WAIT_L(0); PG8_BAR; PG8_MMA(1, 0, At, B0); PG8_MMA(1, 1, At, B1); PG8_BAR; PG8_SCHED;
        }
        if (wr == 0) PG8_BAR;
        { int ln_ = (int)__builtin_amdgcn_mbcnt_hi(~0u, __builtin_amdgcn_mbcnt_lo(~0u, 0u)); asm volatile("" : "+v"(ln_));
          E(acc, cur, wr, wc, ln_ & 15, ln_ >> 4); }
        if (!has_next) break;
#pragma unroll
        for (int a = 0; a < 2; ++a)
#pragma unroll
            for (int b = 0; b < 2; ++b)
#pragma unroll
                for (int m = 0; m < 4; ++m)
#pragma unroll
                    for (int n = 0; n < 2; ++n) acc[a][b][m][n] = (f32x4){0.f, 0.f, 0.f, 0.f};
        cur = nxt; cA = nA; cB = nB; ++ui;
        if (wr == 1) PG8_BAR;
    }
    PG8_WAIT_V(0);
    PG8_BAR;
#undef PG8_SA
#undef PG8_SB
#undef PG8_STAGE
#undef PG8_STAGEB
#undef PG8_LDA
#undef PG8_LDB
#undef PG8_MMA
#undef PG8_WAIT_V
#undef PG8_WAIT_L
#undef PG8_BAR
#undef PG8_SCHED
#undef PG8_VOFFA
}
}

template <int NBM, class AF, class Epi>
__device__ __forceinline__ void sgemm_tile(float* lds, int K, AF arow, const float* __restrict__ B0, const float* __restrict__ B1, int ldb, int n0, int N, Epi epi) {
    const int tid = tid_fresh();
    float* As = lds;
    float* Bs0 = lds + 16 * 132;
    float* Bs1 = lds + 2 * 16 * 132;
    const int ty = tid >> 5, tx = tid & 31;
    float acc0[8][4], acc1[8][4];
#pragma unroll
    for (int i = 0; i < 8; ++i)
#pragma unroll
        for (int j = 0; j < 4; ++j) { acc0[i][j] = 0.f; acc1[i][j] = 0.f; }
    const int ar = tid >> 2, ak = (tid & 3) * 4;
    const float* ap = arow(ar);
    const int bk = tid >> 5, bn = (tid & 31) * 4;
    const bool bok = (n0 + bn) < N;
    for (int k0 = 0; k0 < K; k0 += 16) {
        float4 av = ap ? *(const float4*)(ap + k0 + ak) : make_float4(0.f, 0.f, 0.f, 0.f);
        float4 bv0 = bok ? *(const float4*)(B0 + (size_t)(k0 + bk) * ldb + n0 + bn) : make_float4(0.f, 0.f, 0.f, 0.f);
        float4 bv1 = make_float4(0.f, 0.f, 0.f, 0.f);
        if (NBM == 2) { if (bok) bv1 = *(const float4*)(B1 + (size_t)(k0 + bk) * ldb + n0 + bn); }
        __syncthreads();
        As[(ak + 0) * 132 + ar] = av.x; As[(ak + 1) * 132 + ar] = av.y; As[(ak + 2) * 132 + ar] = av.z; As[(ak + 3) * 132 + ar] = av.w;
        *(float4*)&Bs0[bk * 132 + bn] = bv0;
        if (NBM == 2) *(float4*)&Bs1[bk * 132 + bn] = bv1;
        __syncthreads();
#pragma unroll 2
        for (int k = 0; k < 16; ++k) {
            const float4 a0 = *(const float4*)&As[k * 132 + ty * 8], a1 = *(const float4*)&As[k * 132 + ty * 8 + 4];
            const float a[8] = {a0.x, a0.y, a0.z, a0.w, a1.x, a1.y, a1.z, a1.w};
            const float4 b0 = *(const float4*)&Bs0[k * 132 + tx * 4];
            const float bb0[4] = {b0.x, b0.y, b0.z, b0.w};
#pragma unroll
            for (int i = 0; i < 8; ++i)
#pragma unroll
                for (int j = 0; j < 4; ++j) acc0[i][j] = fmaf(a[i], bb0[j], acc0[i][j]);
            if (NBM == 2) {
                const float4 b1 = *(const float4*)&Bs1[k * 132 + tx * 4];
                const float bb1[4] = {b1.x, b1.y, b1.z, b1.w};
#pragma unroll
                for (int i = 0; i < 8; ++i)
#pragma unroll
                    for (int j = 0; j < 4; ++j) acc1[i][j] = fmaf(a[i], bb1[j], acc1[i][j]);
            }
        }
    }
    if (bok) {
#pragma unroll
        for (int i = 0; i < 8; ++i)
#pragma unroll
            for (int j = 0; j < 4; ++j) epi(ty * 8 + i, tx * 4 + j, acc0[i][j], acc1[i][j]);
    }
}

__device__ __forceinline__ void transpose_blk(const float* W, int N, bf16_t* WT, int K, int k0, int n0, int drow0, float* scr, int lane) {
    const int kr = lane >> 3, n4 = (lane & 7) * 4;
    float4 v[8];
#pragma unroll
    for (int i = 0; i < 8; ++i) v[i] = *(const float4*)(W + (size_t)(k0 + i * 8 + kr) * N + n0 + n4);
#pragma unroll
    for (int i = 0; i < 8; ++i) { float* d = scr + (i * 8 + kr) * 33 + n4; d[0] = v[i].x; d[1] = v[i].y; d[2] = v[i].z; d[3] = v[i].w; }
    asm volatile("s_waitcnt lgkmcnt(0)" ::: "memory");
    const int c = lane & 7;
#pragma unroll
    for (int j = 0; j < 4; ++j) { const int n = (lane >> 3) + 8 * j; const float* sp = scr + (8 * c) * 33 + n;
        uint4 o; o.x = pk2(sp[0 * 33], sp[1 * 33]); o.y = pk2(sp[2 * 33], sp[3 * 33]); o.z = pk2(sp[4 * 33], sp[5 * 33]); o.w = pk2(sp[6 * 33], sp[7 * 33]);
        *(uint4*)(WT + (size_t)(drow0 + n) * K + k0 + 8 * c) = o; }
    asm volatile("s_waitcnt lgkmcnt(0)" ::: "memory");
}
__device__ __forceinline__ void transpose_item(const float* W, int K, int N, bf16_t* WT, int row_off, float* scr, int item, int lane) {
    const int nblk = N / 32, kb = item / nblk, nb = item % nblk;
    transpose_blk(W, N, WT, K, 64 * kb, 32 * nb, row_off + 32 * nb, scr, lane);
}
struct CvtItem { const float* W; bf16_t* WT; int N, K, k0, n0, drow0; };
__device__ __forceinline__ bool cvt_decode(const Args& a, int l, int it, CvtItem& c) {
    if (it >= NEXP * 768) return false;
    bf16_t* WGU = (bf16_t*)(a.ws + WS_WEXP); bf16_t* WD = WGU + (size_t)NEXP * 1024 * 1024;
    const int e = it / 768; int r = it % 768;
    if (r < 512) {
        const bool up = r >= 256; r &= 255; const int kb = r >> 4, nb = r & 15, n0 = 32 * nb;
        c.W = (up ? a.in[26] : a.in[25]) + ((size_t)l * NEXP + e) * DM * DEXP; c.N = DEXP; c.WT = WGU + (size_t)e * 1024 * 1024; c.K = DM; c.k0 = 64 * kb; c.n0 = n0; c.drow0 = 256 * (n0 >> 7) + (n0 & 127) + (up ? 128 : 0);
    } else {
        r -= 512; const int kb = r >> 5, nb = r & 31;
        c.W = a.in[27] + ((size_t)l * NEXP + e) * DEXP * DM; c.N = DM; c.WT = WD + (size_t)e * 1024 * 512; c.K = DEXP; c.k0 = 64 * kb; c.n0 = 32 * nb; c.drow0 = 32 * nb;
    }
    return true;
}
__device__ __forceinline__ void cvt_load(const CvtItem& c, int lane, float4 (&v)[8]) {
    const int kr = lane >> 3, n4 = (lane & 7) * 4;
#pragma unroll
    for (int i = 0; i < 8; ++i) v[i] = *(const float4*)(c.W + (size_t)(c.k0 + i * 8 + kr) * c.N + c.n0 + n4);
}
__device__ __forceinline__ void cvt_finish(const CvtItem& c, int lane, const float4 (&v)[8], float* scr) {
    const int kr = lane >> 3, n4 = (lane & 7) * 4;
#pragma unroll
    for (int i = 0; i < 8; ++i) { float* d = scr + (i * 8 + kr) * 33 + n4; d[0] = v[i].x; d[1] = v[i].y; d[2] = v[i].z; d[3] = v[i].w; }
    asm volatile("s_waitcnt lgkmcnt(0)" ::: "memory");
    const int cc = lane & 7;
#pragma unroll
    for (int j = 0; j < 4; ++j) { const int n = (lane >> 3) + 8 * j; const float* sp = scr + (8 * cc) * 33 + n;
        uint4 o; o.x = pk2(sp[0 * 33], sp[1 * 33]); o.y = pk2(sp[2 * 33], sp[3 * 33]); o.z = pk2(sp[4 * 33], sp[5 * 33]); o.w = pk2(sp[6 * 33], sp[7 * 33]);
        *(uint4*)(c.WT + (size_t)(c.drow0 + n) * c.K + c.k0 + 8 * cc) = o; }
    asm volatile("s_waitcnt lgkmcnt(0)" ::: "memory");
}
__device__ __forceinline__ void convert_experts(const Args& a, int l, float* lds) {
    const int tid = tid_fresh(), lane = tid & 63, wid = tid >> 6;
    float* scr = lds + wid * (64 * 33);
    const int gw = blockIdx.x * 8 + wid, NGW = gridDim.x * 8;
    bf16_t* WGU = (bf16_t*)(a.ws + WS_WEXP); bf16_t* WD = WGU + (size_t)NEXP * 1024 * 1024;
    for (int it = gw; it < NEXP * 768; it += NGW) {
        const int e = it / 768; int r = it % 768;
        if (r < 512) {
            const bool up = r >= 256; r &= 255; const int kb = r >> 4, nb = r & 15, n0 = 32 * nb;
            const float* W = (up ? a.in[26] : a.in[25]) + ((size_t)l * NEXP + e) * DM * DEXP;
            transpose_blk(W, DEXP, WGU + (size_t)e * 1024 * 1024, DM, 64 * kb, n0, 256 * (n0 >> 7) + (n0 & 127) + (up ? 128 : 0), scr, lane);
        } else {
            r -= 512; const int kb = r >> 5, nb = r & 31;
            const float* W = a.in[27] + ((size_t)l * NEXP + e) * DEXP * DM;
            transpose_blk(W, DM, WD + (size_t)e * 1024 * 512, DEXP, 64 * kb, 32 * nb, 32 * nb, scr, lane);
        }
    }
}
__device__ __forceinline__ void cvt_row(const float* in, bf16_t* out, int lane) {
#pragma unroll
    for (int j = 0; j < 4; ++j) { const float4 v = *(const float4*)(in + j * 256 + lane * 4); uint2 o; o.x = pk2(v.x, v.y); o.y = pk2(v.z, v.w); *(uint2*)(out + j * 256 + lane * 4) = o; }
}
__device__ __forceinline__ void phase_prologue(const Args& a, float* lds) {
    const int tid = tid_fresh(), lane = tid & 63, wid = tid >> 6;
    float* scr = lds + wid * (64 * 33);
    const int gw = blockIdx.x * 8 + wid, NGW = gridDim.x * 8;
    bf16_t* WIN0 = (bf16_t*)(a.ws + WS_WIN0); bf16_t* WIN1 = (bf16_t*)(a.ws + WS_WIN1);
    constexpr int I_IN = 16 * 104, I_VR = 16, I_SQ = 16 * 32, I_KV = 16 * 64;
    constexpr int NITEMS = 2 * I_IN + I_VR + 6 * I_SQ + 2 * I_KV;
    for (int it = gw; it < NITEMS; it += NGW) {
        int r = it;
        if (r < I_IN) { transpose_item(a.in[2], DM, IN_COLS, WIN0, 0, scr, r, lane); continue; } r -= I_IN;
        if (r < I_IN) { transpose_item(a.in[2] + (size_t)DM * IN_COLS, DM, IN_COLS, WIN1, 0, scr, r, lane); continue; } r -= I_IN;
        if (r < I_VR) { transpose_item(a.in[3], DM, 32, WIN1, IN_COLS, scr, r, lane); continue; } r -= I_VR;
        constexpr int I_L = 3 * I_SQ + I_KV;
        const int l = r / I_L; r -= l * I_L;
        if (r < I_SQ) { transpose_item(a.in[19] + (size_t)l * DM * DM, DM, DM, (bf16_t*)(a.ws + WS_WOUT) + (size_t)l * DM * DM, 0, scr, r, lane); continue; } r -= I_SQ;
        if (r < I_SQ) { transpose_item(a.in[20] + (size_t)l * DM * DM, DM, DM, (bf16_t*)(a.ws + WS_WQ) + (size_t)l * DM * DM, 0, scr, r, lane); continue; } r -= I_SQ;
        if (r < I_KV) { transpose_item(a.in[21] + (size_t)l * DM * 2048, DM, 2048, (bf16_t*)(a.ws + WS_WKV) + (size_t)l * DM * 2048, 0, scr, r, lane); continue; } r -= I_KV;
        transpose_item(a.in[22] + (size_t)l * DM * DM, DM, DM, (bf16_t*)(a.ws + WS_WO) + (size_t)l * DM * DM, 0, scr, r, lane);
    }
    for (int r = gw; r < 224; r += NGW) {
#pragma unroll
        for (int j = 0; j < 2; ++j) *(uint4*)(WIN1 + (size_t)(3360 + r) * DM + j * 512 + lane * 8) = make_uint4(0u, 0u, 0u, 0u);
    }
    bf16_t* XB = (bf16_t*)(a.ws + WS_XB); bf16_t* MEMB = (bf16_t*)(a.ws + WS_MEMB);
    for (int m = gw; m < NTOK; m += NGW) cvt_row(a.in[0] + (size_t)m * DM, XB + (size_t)m * DM, lane);
    for (int m = gw; m < NBATCH * MEMLEN; m += NGW) cvt_row(a.in[1] + (size_t)m * DM, MEMB + (size_t)m * DM, lane);
    {
        const int gt = blockIdx.x * NTHREADS + tid, NGT = gridDim.x * NTHREADS;
        for (int idx = gt; idx < 2 * 512 * 288; idx += NGT) {
            const int l = idx / (512 * 288); int r = idx % (512 * 288);
            bf16_t* base = (bf16_t*)(a.ws + WS_LORA + (size_t)l * LORA_L);
            if (r < 512 * 64) { const int n = r >> 6, k = r & 63; base[r] = f2bf(a.in[7][((size_t)l * 64 + k) * 512 + n]); continue; } r -= 512 * 64;
            if (r < 512 * 64) { const int n = r >> 6, k = r & 63; base[512 * 64 + r] = f2bf(a.in[9][((size_t)l * 64 + k) * 512 + n]); continue; } r -= 512 * 64;
            if (r < 512 * 128) { const int n = r >> 7, k = r & 127; base[2 * 512 * 64 + r] = f2bf(a.in[12][((size_t)l * 128 + k) * 512 + n]); continue; } r -= 512 * 128;
            { const int n = r >> 5, k = r & 31; base[2 * 512 * 64 + 512 * 128 + r] = f2bf(a.in[11][(size_t)k * 512 + n]); }
        }
    }
}

__device__ __forceinline__ void phase_g1(const Args& a, int l, PG8_LAS unsigned char* lds) {
    pg8::G1Sched S; S.init(a.ws + WS_XB, a.ws + (l == 0 ? WS_WIN0 : WS_WIN1), l == 0 ? IN_COLS / 256 : ZLD / 256, a.ws + WS_MEMB, a.ws + WS_WKV + (size_t)l * 4 * MiB);
    pg8::EpiG1 E{(bf16_t*)(a.ws + WS_Z), (bf16_t*)(a.ws + WS_KB), (bf16_t*)(a.ws + WS_VT)};
    pg8::gemm_phase<pg8::EpiG1, pg8::G1Sched, false>(lds, pg8::Dims{DM, DM, DM}, S, E);
}
__device__ __forceinline__ void phase_matt_s(const Args& a, PG8_LAS unsigned char* lds) {
    pg8::MattSched S; S.init(a.ws + WS_Q, a.ws + WS_KB, (size_t)256 * 1024 * 2, 256 * 2);
    pg8::EpiSoftmax E{(bf16_t*)(a.ws + WS_P), (float*)(a.ws + WS_LSUM), (PG8_LAS float*)(lds + pg8::STAGE_BYTES + 8192 + 512)};
    pg8::gemm_phase<pg8::EpiSoftmax, pg8::MattSched, false>(lds, pg8::Dims{1024, 1024, 256}, S, E);
}
__device__ __forceinline__ void phase_matt_pv(const Args& a, PG8_LAS unsigned char* lds) {
    pg8::MattSched S; S.init(a.ws + WS_P, a.ws + WS_VT, (size_t)1024 * 256 * 2, 256 * 256 * 2);
    pg8::EpiPV E{(bf16_t*)(a.ws + WS_O), (const float*)(a.ws + WS_LSUM)};
    pg8::gemm_phase<pg8::EpiPV, pg8::MattSched, false>(lds, pg8::Dims{1024, 256, 256}, S, E);
}

typedef _Float16 h8_t __attribute__((ext_vector_type(8)));
typedef _Float16 h2_t __attribute__((ext_vector_type(2)));
__device__ __forceinline__ unsigned pkh2(float lo, float hi) { h2_t v = {(_Float16)lo, (_Float16)hi}; return __builtin_bit_cast(unsigned, v); }
#define SC_DPP(x, ctrl) __int_as_float(__builtin_amdgcn_mov_dpp(__float_as_int(x), ctrl, 0xF, 0xF, true))
__device__ __forceinline__ float sum32(float x) {
    x += SC_DPP(x, 0xB1); x += SC_DPP(x, 0x4E); x += SC_DPP(x, 0x141); x += SC_DPP(x, 0x140);
    return x + __shfl_xor(x, 16);
}
__device__ __forceinline__ void phase_prep(const Args& a, int l, float* lds) {
    typedef short bf16x8 __attribute__((ext_vector_type(8)));
    typedef float f32x16 __attribute__((ext_vector_type(16)));
    const bf16_t* Z = (const bf16_t*)(a.ws + WS_Z);
    const int tid = tid_fresh(), lane = tid & 63, wid = tid >> 6;
    float* KM = (float*)(a.ws + WS_KMEAN);
    for (int u = blockIdx.x * 8 + wid; u < NBATCH * NH * 8; u += gridDim.x * 8) {
        const int nb = u & 7, h = (u >> 3) & 7, b = u >> 6, rg = lane >> 3, ch = lane & 7;
        const bf16_t* p = Z + (size_t)(b * SEQ + nb * 256 + rg) * ZLD + C_K + h * HD + ch * 8;
        float acc[8];
#pragma unroll
        for (int j = 0; j < 8; ++j) acc[j] = 0.f;
#pragma unroll 8
        for (int i = 0; i < 32; ++i) { const uint4 v = *(const uint4*)(p + (size_t)(i * 8) * ZLD);
            acc[0] += bflo(v.x); acc[1] += bfhi(v.x); acc[2] += bflo(v.y); acc[3] += bfhi(v.y); acc[4] += bflo(v.z); acc[5] += bfhi(v.z); acc[6] += bflo(v.w); acc[7] += bfhi(v.w); }
#pragma unroll
        for (int j = 0; j < 8; ++j) { float x = acc[j]; x += __shfl_xor(x, 8); x += __shfl_xor(x, 16); x += __shfl_xor(x, 32); acc[j] = x * (1.0f / 256.0f); }
        if (rg == 0) { *(float4*)(KM + (size_t)u * 64 + ch * 8) = make_float4(acc[0], acc[1], acc[2], acc[3]); *(float4*)(KM + (size_t)u * 64 + ch * 8 + 4) = make_float4(acc[4], acc[5], acc[6], acc[7]); }
    }
    const float* mu = a.in[4] + (size_t)l * 1792;
    const float* muv = a.in[5];
    const bf16_t* WdT = (const bf16_t*)(a.ws + WS_LORA + (size_t)l * LORA_L); const bf16_t* WiT = (const bf16_t*)(a.ws + WS_LORA + (size_t)l * LORA_L + LORA_I);
    const bf16_t* WgT = (const bf16_t*)(a.ws + WS_LORA + (size_t)l * LORA_L + LORA_G); const bf16_t* WvT = (const bf16_t*)(a.ws + WS_LORA + LORA_V);
    unsigned* REC = (unsigned*)(a.ws + WS_REC);
    _Float16* RVT = (_Float16*)(a.ws + WS_RVT); bf16_t* RGp = (bf16_t*)(a.ws + WS_RG); float* BON = (float*)(a.ws + WS_BON);
    bf16_t* VF = (bf16_t*)(a.ws + WS_VFIRST);
    uint4* afr = (uint4*)lds;
    for (int tb = blockIdx.x; tb < 512; tb += gridDim.x) {
        int lane_t = lane; asm volatile("" : "+v"(lane_t));
        const int r32 = lane_t & 31, hi = lane_t >> 5;
        const int h = wid, t0 = tb * 32, b = t0 / SEQ, tt0 = t0 % SEQ, bh = b * NH + h;
        const size_t tokA = (size_t)t0 + r32;
        const bool firstA = (tt0 == 0) && (r32 == 0);
        const size_t tokP = firstA ? tokA : tokA - 1;
        __syncthreads();
#pragma unroll
        for (int m = 0; m < 3; ++m) {
            const int idx = wid + 8 * m;
            if (idx < (l == 1 ? 18 : 16)) {
                int zcol; const float* mup; int act;
                if (idx < 8) { zcol = C_ZG + 16 * idx; mup = mu + (C_ZG - C_R) + 16 * idx; act = 2; }
                else if (idx < 12) { zcol = C_ZW + 16 * (idx - 8); mup = mu + (C_ZW - C_R) + 16 * (idx - 8); act = 1; }
                else if (idx < 16) { zcol = C_ZA + 16 * (idx - 12); mup = mu + (C_ZA - C_R) + 16 * (idx - 12); act = 0; }
                else { zcol = C_ZV + 16 * (idx - 16); mup = muv + 16 * (idx - 16); act = 0; }
                zcol += 8 * hi; mup += 8 * hi;
                const uint4 cu_ = *(const uint4*)(Z + tokA * ZLD + zcol); uint4 pv_ = *(const uint4*)(Z + tokP * ZLD + zcol); if (firstA) pv_ = make_uint4(0u, 0u, 0u, 0u);
                const float4 m0_ = *(const float4*)(mup), m1_ = *(const float4*)(mup + 4);
                float x_[8]; const unsigned cw_[4] = {cu_.x, cu_.y, cu_.z, cu_.w}, pw_[4] = {pv_.x, pv_.y, pv_.z, pv_.w}; const float mm_[8] = {m0_.x, m0_.y, m0_.z, m0_.w, m1_.x, m1_.y, m1_.z, m1_.w};
#pragma unroll
                for (int q_ = 0; q_ < 4; ++q_) { const float c0_ = bflo(cw_[q_]), c1_ = bfhi(cw_[q_]); x_[2 * q_] = c0_ + (bflo(pw_[q_]) - c0_) * mm_[2 * q_]; x_[2 * q_ + 1] = c1_ + (bfhi(pw_[q_]) - c1_) * mm_[2 * q_ + 1]; }
                if (act == 1) {
#pragma unroll
                    for (int q_ = 0; q_ < 8; ++q_) x_[q_] = 1.0f - 2.0f * __builtin_amdgcn_rcpf(__expf(2.0f * x_[q_]) + 1.0f);
                } else if (act == 2) {
#pragma unroll
                    for (int q_ = 0; q_ < 8; ++q_) x_[q_] = __builtin_amdgcn_rcpf(1.0f + __expf(-x_[q_]));
                }
                afr[idx * 64 + lane_t] = make_uint4(pk2(x_[0], x_[1]), pk2(x_[2], x_[3]), pk2(x_[4], x_[5]), pk2(x_[6], x_[7]));
            }
        }
        __syncthreads();
#define PREP_AFRAG(dst, idx_) do { const uint4 q_ = afr[(idx_) * 64 + lane_t]; pg8::u32x4 w_; w_.x = q_.x; w_.y = q_.y; w_.z = q_.z; w_.w = q_.w; dst = __builtin_bit_cast(bf16x8, w_); } while (0)
        const int chB = h * 64 + r32;
#define PREP_TOK(r) int hq_ = hi; asm volatile("" : "+v"(hq_)); const int tq = ((r) & 3) + 8 * ((r) >> 2) + 4 * hq_, t = tt0 + tq; const size_t tok = (size_t)t0 + tq; (void)t; (void)tok
#define PREP_RB(t, j) (((((size_t)bh * 512 + ((t) >> 2)) * 32 + ((j) >> 1)) * 4 + ((t) & 3)) * 5)
        f32x16 acc[2];
#pragma unroll
        for (int nb = 0; nb < 2; ++nb)
#pragma unroll
            for (int r = 0; r < 16; ++r) acc[nb][r] = 0.f;
#pragma unroll 1
        for (int sO = 0; sO < 8; sO += 4) {
            asm volatile("" ::: "memory");
#pragma unroll
            for (int sJ = 0; sJ < 4; ++sJ) { const int sI = sO + sJ;
                bf16x8 af; PREP_AFRAG(af, sI);
#pragma unroll
                for (int nb = 0; nb < 2; ++nb) acc[nb] = __builtin_amdgcn_mfma_f32_32x32x16_bf16(af, *(const bf16x8*)(WgT + (size_t)(chB + 32 * nb) * 128 + 16 * sI + 8 * hi), acc[nb], 0, 0, 0); }
        }
#pragma unroll
        for (int nb = 0; nb < 2; ++nb)
#pragma unroll
            for (int r = 0; r < 16; ++r) { PREP_TOK(r); RGp[tok * 512 + chB + 32 * nb] = f2bf(acc[nb][r]); }
#pragma unroll
        for (int nb = 0; nb < 2; ++nb)
#pragma unroll
            for (int r = 0; r < 16; ++r) acc[nb][r] = 0.f;
        asm volatile("" ::: "memory");
#pragma unroll
        for (int sI = 0; sI < 4; ++sI) {
            bf16x8 af; PREP_AFRAG(af, 8 + sI);
#pragma unroll
            for (int nb = 0; nb < 2; ++nb) acc[nb] = __builtin_amdgcn_mfma_f32_32x32x16_bf16(af, *(const bf16x8*)(WdT + (size_t)(chB + 32 * nb) * 64 + 16 * sI + 8 * hi), acc[nb], 0, 0, 0);
        }
        unsigned UW[2][8];
#pragma unroll
        for (int nb = 0; nb < 2; ++nb) {
            const float w0c = a.in[6][l * 512 + chB + 32 * nb];
#pragma unroll
            for (int g = 0; g < 4; ++g)
#pragma unroll
                for (int ts = 0; ts < 2; ++ts) { float uu[2];
#pragma unroll
                    for (int e = 0; e < 2; ++e) { const float sd = w0c + acc[nb][4 * g + ts + 2 * e]; const float sp = (sd < -15.f) ? -sd : __logf(1.0f + __expf(-sd)); uu[e] = 1.0f - __expf(-__expf(-sp - 0.5f)); }
                    UW[nb][2 * g + ts] = pkh2(uu[0], uu[1]); }
        }
        f32x16 aia[2], vga[2];
#pragma unroll
        for (int nb = 0; nb < 2; ++nb)
#pragma unroll
            for (int r = 0; r < 16; ++r) { aia[nb][r] = 0.f; vga[nb][r] = 0.f; }
        asm volatile("" ::: "memory");
#pragma unroll
        for (int sI = 0; sI < 4; ++sI) {
            bf16x8 af; PREP_AFRAG(af, 12 + sI);
#pragma unroll
            for (int nb = 0; nb < 2; ++nb) aia[nb] = __builtin_amdgcn_mfma_f32_32x32x16_bf16(af, *(const bf16x8*)(WiT + (size_t)(chB + 32 * nb) * 64 + 16 * sI + 8 * hi), aia[nb], 0, 0, 0);
        }
        if (l == 1) {
            asm volatile("" ::: "memory");
#pragma unroll
            for (int sI = 0; sI < 2; ++sI) {
                bf16x8 af; PREP_AFRAG(af, 16 + sI);
#pragma unroll
                for (int nb = 0; nb < 2; ++nb) vga[nb] = __builtin_amdgcn_mfma_f32_32x32x16_bf16(af, *(const bf16x8*)(WvT + (size_t)(chB + 32 * nb) * 32 + 16 * sI + 8 * hi), vga[nb], 0, 0, 0);
            }
        }
#undef PREP_AFRAG
        float ss[16], bon[16]; unsigned KW[2][8], RW[2][8], QW[2][8], AW[2][8];
#pragma unroll
        for (int r = 0; r < 16; ++r) { ss[r] = 0.f; bon[r] = 0.f; }
#pragma unroll
        for (int nb = 0; nb < 2; ++nb) {
            const int j = 32 * nb + r32, c = h * 64 + j;
            const float a0c = a.in[8][l * 512 + c], v0c = a.in[10][c];
            const float mu_r = mu[c], mu_k = mu[512 + c], mu_v = mu[1024 + c];
            const float kk_c = a.in[13][l * 512 + c], ka_c = a.in[14][l * 512 + c], rk_c = a.in[15][l * 512 + c];
            float v4[4], kp2[2], rr2[2], kq2[2], ai2[2];
#pragma unroll
            for (int r = 0; r < 16; ++r) {
                if ((r & 3) == 0) asm volatile("" ::: "memory");
                PREP_TOK(r);
                const float ai = sigmoidf_(a0c + aia[nb][r]);
                const float zr = bf2f(Z[tok * ZLD + C_R + c]), zk = bf2f(Z[tok * ZLD + C_KR + c]), zv = bf2f(Z[tok * ZLD + C_VR + c]);
                const size_t tokp = (t != 0) ? tok - 1 : tok; const float pm_ = (t != 0) ? 1.0f : 0.0f;
                const float pr = pm_ * bf2f(Z[tokp * ZLD + C_R + c]), pk = pm_ * bf2f(Z[tokp * ZLD + C_KR + c]), pv = pm_ * bf2f(Z[tokp * ZLD + C_VR + c]);
                const float rr_ = zr + (pr - zr) * mu_r, kx = zk + (pk - zk) * mu_k;
                float v = zv + (pv - zv) * mu_v;
                if (l == 0) VF[tok * 512 + c] = f2bf(v);
                else v = v + (bf2f(VF[tok * 512 + c]) - v) * sigmoidf_(v0c + vga[nb][r]);
                const float kkraw = kx * kk_c, kp = kx * (1.0f + (ai - 1.0f) * ka_c);
                ss[r] = fmaf(kkraw, kkraw, ss[r]); bon[r] = fmaf(rr_ * kp, rk_c, bon[r]);
                if ((r & 3) < 2) { kp2[r & 1] = kp; rr2[r & 1] = rr_; kq2[r & 1] = kkraw; ai2[r & 1] = ai; }
                else { const int wI = 2 * (r >> 2) + (r & 1); KW[nb][wI] = pkh2(kp2[r & 1], kp); RW[nb][wI] = pkh2(rr2[r & 1], rr_); QW[nb][wI] = pkh2(kq2[r & 1], kkraw); AW[nb][wI] = pkh2(ai2[r & 1], ai); }
                v4[r & 3] = v;
                if ((r & 3) == 3) {
                    uint2 pv2; pv2.x = pk2(v4[0], v4[1]); pv2.y = pk2(v4[2], v4[3]);
                    *(uint2*)(RVT + (((size_t)bh * 256 + ((tt0 >> 3) + (r >> 2))) * 64 + j) * 8 + 4 * hi) = pv2;
                }
            }
        }
        float rn[16];
#pragma unroll
        for (int r = 0; r < 16; ++r) {
            PREP_TOK(r);
            const float sst = sum32(ss[r]), bt = sum32(bon[r]);
            rn[r] = rsqrtf(fmaxf(sst, 1e-24f));
            BON[tok * 8 + h] = bt;
        }
        const unsigned psel = (r32 & 1) ? 0x03020706u : 0x05040100u;
#pragma unroll
        for (int nb = 0; nb < 2; ++nb)
#pragma unroll
            for (int g = 0; g < 4; ++g) {
                asm volatile("" ::: "memory");
                unsigned outw[10];
#pragma unroll
                for (int ts = 0; ts < 2; ++ts) {
                    const int wI = 2 * g + ts;
                    const h2_t q2 = __builtin_bit_cast(h2_t, QW[nb][wI]), a2 = __builtin_bit_cast(h2_t, AW[nb][wI]);
                    const float k0 = (float)q2[0] * rn[4 * g + ts], k1 = (float)q2[1] * rn[4 * g + ts + 2];
                    const unsigned mine[5] = {UW[nb][wI], pkh2(-k0, -k1), pkh2(k0 * (float)a2[0], k1 * (float)a2[1]), KW[nb][wI], RW[nb][wI]};
#pragma unroll
                    for (int q = 0; q < 5; ++q) { const unsigned oth = (unsigned)__builtin_amdgcn_mov_dpp((int)mine[q], 0xB1, 0xF, 0xF, true); outw[ts * 5 + q] = __builtin_amdgcn_perm(oth, mine[q], psel); }
                }
                const int tg = (tt0 >> 2) + 2 * g + hi, j2r = 16 * nb + (r32 >> 1);
                unsigned* dst = REC + ((size_t)bh * 512 + tg) * REC_TG + j2r * 20 + (j2r >> 4) * 4 + ((r32 & 1) ? 10 : 0);
#pragma unroll
                for (int k = 0; k < 5; ++k) { uint2 o2; o2.x = outw[2 * k]; o2.y = outw[2 * k + 1]; *(uint2*)(dst + 2 * k) = o2; }
            }
#undef PREP_TOK
#undef PREP_RB
    }
}

__device__ __forceinline__ float dpp_add(float x, float y_src, int) { return x + y_src; }
__device__ __forceinline__ float red32(float x) {
    x += SC_DPP(x, 0xB1); x += SC_DPP(x, 0x4E); x += SC_DPP(x, 0x141); x += SC_DPP(x, 0x140);
    auto rr = __builtin_amdgcn_permlane32_swap(__float_as_uint(x), __float_as_uint(x), false, false);
    return __uint_as_float(rr[0]) + __uint_as_float(rr[1]);
}
__device__ __forceinline__ float fmul_lo(float a, unsigned h) { float d; asm("v_fma_mix_f32 %0, %1, %2, 0 op_sel_hi:[0,1,0]" : "=v"(d) : "v"(a), "v"(h)); return d; }
__device__ __forceinline__ float fmix_lo(float a, unsigned h, float c) { float d; asm("v_fma_mix_f32 %0, %1, %2, %3 op_sel_hi:[0,1,0]" : "=v"(d) : "v"(a), "v"(h), "v"(c)); return d; }
__device__ __forceinline__ float fmix_hi(float a, unsigned h, float c) { float d; asm("v_fma_mix_f32 %0, %1, %2, %3 op_sel:[0,1,0] op_sel_hi:[0,1,0]" : "=v"(d) : "v"(a), "v"(h), "v"(c)); return d; }
__device__ __forceinline__ float fdec_lo(float sv, unsigned u) { float d; asm("v_fma_mix_f32 %0, -%1, %2, %1 op_sel_hi:[0,1,0]" : "=v"(d) : "v"(sv), "v"(u)); return d; }
__device__ __forceinline__ float fdec_hi(float sv, unsigned u) { float d; asm("v_fma_mix_f32 %0, -%1, %2, %1 op_sel:[0,1,0] op_sel_hi:[0,1,0]" : "=v"(d) : "v"(sv), "v"(u)); return d; }
template <int VH> __device__ __forceinline__ float fvk_lo(unsigned v, unsigned k, float c) { float d;
    if (VH) asm("v_fma_mix_f32 %0, %1, %2, %3 op_sel:[1,0,0] op_sel_hi:[1,1,0]" : "=v"(d) : "v"(v), "v"(k), "v"(c)); else asm("v_fma_mix_f32 %0, %1, %2, %3 op_sel:[0,0,0] op_sel_hi:[1,1,0]" : "=v"(d) : "v"(v), "v"(k), "v"(c)); return d; }
template <int VH> __device__ __forceinline__ float fvk_hi(unsigned v, unsigned k, float c) { float d;
    if (VH) asm("v_fma_mix_f32 %0, %1, %2, %3 op_sel:[1,1,0] op_sel_hi:[1,1,0]" : "=v"(d) : "v"(v), "v"(k), "v"(c)); else asm("v_fma_mix_f32 %0, %1, %2, %3 op_sel:[0,1,0] op_sel_hi:[1,1,0]" : "=v"(d) : "v"(v), "v"(k), "v"(c)); return d; }

__device__ __forceinline__ float red16(float x) {
    x += SC_DPP(x, 0xB1); x += SC_DPP(x, 0x4E); x += SC_DPP(x, 0x141); x += SC_DPP(x, 0x140);
    return x;
}
__device__ __forceinline__ float ffma(float a, float b, float c) { float d; asm("v_fma_f32 %0, %1, %2, %3" : "=v"(d) : "v"(a), "v"(b), "v"(c)); return d; }
__device__ __forceinline__ float fmul(float a, float b) { float d; asm("v_mul_f32 %0, %1, %2" : "=v"(d) : "v"(a), "v"(b)); return d; }
__device__ __forceinline__ float fnfma(float a, float b, float c) { float d; asm("v_fma_f32 %0, -%1, %2, %3" : "=v"(d) : "v"(a), "v"(b), "v"(c)); return d; }
__device__ __forceinline__ float h2f_lo(unsigned w) { float d; asm("v_cvt_f32_f16 %0, %1" : "=v"(d) : "v"(w)); return d; }
__device__ __forceinline__ float h2f_hi(unsigned w) { float d; asm("v_cvt_f32_f16_sdwa %0, %1 dst_sel:DWORD dst_unused:UNUSED_PAD src0_sel:WORD_1" : "=v"(d) : "v"(w)); return d; }
__device__ __forceinline__ void phase_scan(const Args& a, int l, PG8_LAS unsigned char* lds) {
    const int tid = tid_fresh(), lane = tid & 63, wid = __builtin_amdgcn_readfirstlane(tid >> 6);
    const int j2 = (lane & 15) | ((lane >> 5) << 4), rr = (lane >> 4) & 1;
    const char* REC = (const char*)(a.ws + WS_REC); const char* RVT = (const char*)(a.ws + WS_RVT);
    bf16_t* YR = (bf16_t*)(a.ws + WS_YRAW);
    constexpr int CSTEPS = 32, NCH = SEQ / CSTEPS, G_REC = 8 * REC_TG * 4  , CH_REC = 21 * 1024, CH_V = 4096, CH = CH_REC + CH_V, NPC = 25;
    constexpr int YB_LD = 68, YB_WAVE = 16 * YB_LD * 4;
    PG8_LAS float* yb = (PG8_LAS float*)(lds + 2 * CH + wid * YB_WAVE);
    float* scr = (float*)((unsigned char*)lds + 2 * CH + 8 * YB_WAVE) + (wid & 3) * (64 * 33);
    const bool cvw = wid < 4;
    const int cw = blockIdx.x * 4 + (wid & 3), NCW = gridDim.x * 4;
    int cvt_next = cvw ? cw : NEXP * 768; bool have = false; CvtItem ci; float4 cv[8];
    for (int u = blockIdx.x; u < 256; u += gridDim.x) {
        const int bh = u >> 2, rg = u & 3, b = bh >> 3, h = bh & 7;
        const int irow = rg * 16 + wid * 2 + rr;
        const char* grec = REC + (size_t)bh * NCH * G_REC; const char* gv = RVT + (size_t)bh * NCH * CH_V;
        float S0 = 0.f, S1 = 0.f;
        __syncthreads();
#define SCAN_DMA(chn, bufo) do { _Pragma("unroll") for (int k_ = 0; k_ < 4; ++k_) { const int pc_ = wid * 4 + k_; if (pc_ < NPC) { \
            const char* src_ = (pc_ < 21) ? grec + (size_t)(chn) * G_REC + pc_ * 1024 + lane * 16 : gv + (size_t)(chn) * CH_V + (pc_ - 21) * 1024 + lane * 16; \
            __builtin_amdgcn_global_load_lds((const unsigned*)src_, (PG8_LAS unsigned*)(lds + (bufo) + pc_ * 1024), 16, 0, 0); } } } while (0)
        SCAN_DMA(0, 0);
        for (int ch = 0; ch < NCH; ++ch) {
            asm volatile("s_waitcnt vmcnt(0)" ::: "memory");
            __syncthreads();
            if (ch + 1 < NCH) SCAN_DMA(ch + 1, ((ch + 1) & 1) * CH);
            if (have) { cvt_finish(ci, lane, cv, scr); have = false; }
            { const int cm = ch & 7; if (cvw && (cm == 0 || cm == 3 || cm == 5)) { if (cvt_decode(a, l, cvt_next, ci)) { cvt_load(ci, lane, cv); have = true; cvt_next += NCW; } } }
            PG8_LAS const unsigned char* bufp = lds + (ch & 1) * CH;
#define SCAN_LOADW(W, grp) do { PG8_LAS const unsigned char* rp_ = bufp + (grp) * (REC_TG * 4) + j2 * 80 + (j2 >> 4) * 16; _Pragma("unroll") for (int k_ = 0; k_ < 5; ++k_) { \
                const pg8::u32x4 q_ = *(PG8_LAS const pg8::u32x4*)(rp_ + 16 * k_); W[4 * k_] = q_.x; W[4 * k_ + 1] = q_.y; W[4 * k_ + 2] = q_.z; W[4 * k_ + 3] = q_.w; } } while (0)
#define SCAN_STEPS(W, hf) do { _Pragma("unroll") for (int ts = 0; ts < 4; ++ts) { \
                const unsigned wu = W[ts * 5], wa = W[ts * 5 + 1], wb = W[ts * 5 + 2], wk = W[ts * 5 + 3], wr_ = W[ts * 5 + 4]; \
                const unsigned vw = vv[(hf) * 2 + (ts >> 1)]; \
                const float sa = red32(fmix_hi(S1, wa, fmul_lo(S0, wa))); \
                float t0 = fdec_lo(S0, wu), t1 = fdec_hi(S1, wu); \
                if (ts & 1) { t0 = fvk_lo<1>(vw, wk, t0); t1 = fvk_hi<1>(vw, wk, t1); } else { t0 = fvk_lo<0>(vw, wk, t0); t1 = fvk_hi<0>(vw, wk, t1); } \
                S0 = fmix_lo(sa, wb, t0); S1 = fmix_hi(sa, wb, t1); \
                yb[((g8 & 1) * 8 + (hf) * 4 + ts) * YB_LD + rr * 32 + j2] = fmix_hi(S1, wr_, fmul_lo(S0, wr_)); } } while (0)
            unsigned wA[20], wB[20];
            SCAN_LOADW(wA, 0);
#pragma unroll 1
            for (int g8 = 0; g8 < 4; ++g8) {
                const pg8::u32x4 vv = *(PG8_LAS const pg8::u32x4*)(bufp + CH_REC + (g8 * 64 + irow) * 16);
                SCAN_LOADW(wB, g8 * 2 + 1);
                SCAN_STEPS(wA, 0);
                if (g8 < 3) SCAN_LOADW(wA, g8 * 2 + 2);
                SCAN_STEPS(wB, 1);
                if (g8 & 1) {
                    asm volatile("s_waitcnt lgkmcnt(0)" ::: "memory");
                    PG8_LAS const float* yp = yb + (j2 & 15) * YB_LD + rr * 32 + (j2 >> 4) * 16;
                    const pg8::f32x4 y0 = *(PG8_LAS const pg8::f32x4*)(yp), y1 = *(PG8_LAS const pg8::f32x4*)(yp + 4), y2 = *(PG8_LAS const pg8::f32x4*)(yp + 8), y3 = *(PG8_LAS const pg8::f32x4*)(yp + 12);
                    const pg8::f32x4 ys = (y0 + y1) + (y2 + y3);
                    float y = (ys[0] + ys[1]) + (ys[2] + ys[3]);
                    { auto sw = __builtin_amdgcn_permlane32_swap(__float_as_uint(y), __float_as_uint(y), false, false); y = __uint_as_float(sw[0]) + __uint_as_float(sw[1]); }
                    const int t = ch * CSTEPS + (g8 >> 1) * 16 + (j2 & 15);
                    if (j2 < 16) YR[((size_t)b * SEQ + t) * 512 + h * 64 + irow] = f2bf(y);
                    asm volatile("s_waitcnt lgkmcnt(0)" ::: "memory");
                }
            }
#undef SCAN_LOADW
#undef SCAN_STEPS
        }
#undef SCAN_DMA
    }
    if (have) cvt_finish(ci, lane, cv, scr);
    while (cvt_decode(a, l, cvt_next, ci)) { cvt_load(ci, lane, cv); cvt_finish(ci, lane, cv, scr); cvt_next += NCW; }
}

__device__ __forceinline__ void phase_post(const Args& a, int l) {
    const int tid = tid_fresh(), lane = tid & 63, wid = tid >> 6;
    const bf16_t* YR = (const bf16_t*)(a.ws + WS_YRAW); const _Float16* RVT = (const _Float16*)(a.ws + WS_RVT);
    const bf16_t* RGp = (const bf16_t*)(a.ws + WS_RG); const float* BON = (const float*)(a.ws + WS_BON);
    bf16_t* MIX = (bf16_t*)(a.ws + WS_MIX);
    for (int u = blockIdx.x; u < 64 * 256; u += gridDim.x) {
        const int bh = u >> 8, t8 = u & 255, b = bh >> 3, h = bh & 7, t = t8 * 8 + wid;
        const size_t tok = (size_t)b * SEQ + t; const int c = h * 64 + lane;
        const float y = bf2f(YR[tok * 512 + c]);
        const float my = wsum(y) * (1.0f / 64.0f);
        const float dy = y - my;
        const float var = wsum(dy * dy) * (1.0f / 64.0f);
        const float yn = dy * rsqrtf(var + 64e-5f) * a.in[16][l * 512 + c] + a.in[17][l * 512 + c];
        const float v = bf2f(((const bf16_t*)RVT)[(((size_t)bh * 256 + t8) * 64 + lane) * 8 + wid]);
        MIX[tok * DM + 512 + c] = f2bf((yn + BON[tok * 8 + h] * v) * bf2f(RGp[tok * 512 + c]));
    }
}

namespace att {
typedef short bf16x8 __attribute__((ext_vector_type(8)));
typedef short s16x4 __attribute__((ext_vector_type(4)));
typedef float f32x16 __attribute__((ext_vector_type(16)));
typedef __attribute__((address_space(3))) const unsigned char* lds_cptr;
constexpr int SLOT = 8192, L_K = 0, L_V = 2 * SLOT, L_WS = 4 * SLOT, L_KM = L_WS + 8 * 256, L_OST = L_KM + 2048, OST_LD = 68, L_END = L_OST + 8 * 32 * OST_LD * 4;
constexpr float C2 = 0.125f * 1.4426950408889634f;
__device__ __forceinline__ int crow(int r, int hi) { return (r & 3) + 8 * (r >> 2) + 4 * hi; }
__device__ __forceinline__ s16x4 vtr(lds_cptr p) { return __builtin_bit_cast(s16x4, __builtin_amdgcn_ds_read_tr16_b64_v4i16((__attribute__((address_space(3))) s16x4*)p)); }
__device__ __forceinline__ float swapmax(float x) { auto rr = __builtin_amdgcn_permlane32_swap(__float_as_uint(x), __float_as_uint(x), false, false); return fmaxf(__uint_as_float(rr[0]), __uint_as_float(rr[1])); }
__device__ __forceinline__ float swapsum(float x) { auto rr = __builtin_amdgcn_permlane32_swap(__float_as_uint(x), __float_as_uint(x), false, false); return __uint_as_float(rr[0]) + __uint_as_float(rr[1]); }

__device__ __forceinline__ void unit(const Args& a, int l, int b, int h, int cur, PG8_LAS unsigned char* lds) {
    const int tid = tid_fresh(), lane = tid & 63, r32 = lane & 31, hi = lane >> 5, wid = __builtin_amdgcn_readfirstlane(tid >> 6);
    const bf16_t* Zb = (const bf16_t*)(a.ws + WS_Z) + (size_t)b * SEQ * ZLD;
    const int qrel = wid * 32 + r32, qpos = cur * 256 + qrel;
    PG8_LAS float* wsf = (PG8_LAS float*)(lds + L_WS) + wid * 64;
    PG8_LAS float* kmf = (PG8_LAS float*)(lds + L_KM);
    __syncthreads();
    kmf[tid] = ((const float*)(a.ws + WS_KMEAN))[(size_t)(b * NH + h) * 512 + tid];
    const bf16_t* ksrc = Zb + (size_t)lane * ZLD + C_K + h * HD + wid * 8;
    const bf16_t* vsrc = Zb + (size_t)(16 * (wid & 3) + (lane >> 2)) * ZLD + C_V + h * HD + (wid >> 2) * 32 + (lane & 3) * 8;
#define ATT_DMA(kpos0, slot) do { \
        __builtin_amdgcn_global_load_lds((const unsigned*)(ksrc + (size_t)(kpos0) * ZLD), (PG8_LAS unsigned*)(lds + L_K + (slot) * SLOT + wid * 1024), 16, 0, 0); \
        __builtin_amdgcn_global_load_lds((const unsigned*)(vsrc + (size_t)(kpos0) * ZLD), (PG8_LAS unsigned*)(lds + L_V + (slot) * SLOT + wid * 1024), 16, 0, 0); } while (0)
    ATT_DMA(cur * 256, 0);
    bf16x8 qr[4];
#pragma unroll
    for (int d0 = 0; d0 < 4; ++d0) qr[d0] = *(const bf16x8*)(Zb + (size_t)qpos * ZLD + C_Q + h * HD + d0 * 16 + hi * 8);
    __syncthreads();
    unsigned selbits = 0u;
    {
        float g[8];
#pragma unroll
        for (int n = 0; n < 8; ++n) g[n] = 0.f;
#pragma unroll
        for (int d0 = 0; d0 < 4; ++d0)
#pragma unroll
            for (int j = 0; j < 8; ++j) { const float qv = bf2f((bf16_t)qr[d0][j]);
#pragma unroll
                for (int n = 0; n < 8; ++n) g[n] = fmaf(qv, kmf[n * 64 + d0 * 16 + hi * 8 + j], g[n]); }
#pragma unroll
        for (int n = 0; n < 8; ++n) g[n] = (n < cur) ? swapsum(g[n]) : NEG_INF;
        if (cur <= 3) selbits = (1u << cur) - 1u;
        else {
            int s0 = -1, s1 = -1, s2 = -1; float bv = -3e38f;
#pragma unroll
            for (int n = 0; n < 8; ++n) if (g[n] > bv) { bv = g[n]; s0 = n; }
            bv = -3e38f;
#pragma unroll
            for (int n = 0; n < 8; ++n) if (n != s0 && g[n] > bv) { bv = g[n]; s1 = n; }
            bv = -3e38f;
#pragma unroll
            for (int n = 0; n < 8; ++n) if (n != s0 && n != s1 && g[n] > bv) { bv = g[n]; s2 = n; }
            selbits = (1u << s0) | (1u << s1) | (1u << s2);
        }
    }
    const float s8 = 8.0f * exp2f(-(float)(h + 1));
    f32x16 base;
#pragma unroll
    for (int r = 0; r < 16; ++r) base[r] = s8 * (float)crow(r, hi);
    f32x16 o0, o1;
#pragma unroll
    for (int r = 0; r < 16; ++r) { o0[r] = 0.f; o1[r] = 0.f; }
    float m = -INFINITY, lsum = 0.f;
    const int NT = 4 * (cur + 1);
    const lds_cptr kp = (lds_cptr)(lds + L_K) + hi * 1024 + r32 * 16;
    const lds_cptr vp = (lds_cptr)(lds + L_V) + ((lane >> 4) & 1) * 32 + (lane & 3) * 8 + (4 * hi + ((lane & 15) >> 2)) * 64;
    for (int it = 0; it < NT; ++it) {
        asm volatile("s_waitcnt vmcnt(0)" ::: "memory");
        __syncthreads();
        const int blk = (it < 4) ? cur : ((it >> 2) - 1);
        const int kpos0 = blk * 256 + (it & 3) * 64;
        if (it + 1 < NT) { const int nblk = (it + 1 < 4) ? cur : (((it + 1) >> 2) - 1); ATT_DMA(nblk * 256 + ((it + 1) & 3) * 64, (it + 1) & 1); }
        const int so = (it & 1) * SLOT;
        f32x16 p0 = base, p1 = base;
#pragma unroll
        for (int d0 = 0; d0 < 4; ++d0) {
            const bf16x8 k0 = *(const __attribute__((address_space(3))) bf16x8*)(kp + so + d0 * 2048);
            const bf16x8 k1 = *(const __attribute__((address_space(3))) bf16x8*)(kp + so + d0 * 2048 + 512);
            p0 = __builtin_amdgcn_mfma_f32_32x32x16_bf16(k0, qr[d0], p0, 0, 0, 0);
            p1 = __builtin_amdgcn_mfma_f32_32x32x16_bf16(k1, qr[d0], p1, 0, 0, 0);
        }
        const bool rowsel = (it < 4) || ((selbits >> blk) & 1u);
        const float cb = rowsel ? -s8 * (float)(qpos - kpos0) : -INFINITY;
        const float cb1 = cb + s8 * 32.0f;
        if (it < 4) {
            const int kb0 = (it & 3) * 64 + 4 * hi;
#pragma unroll
            for (int r = 0; r < 16; ++r) { const int kv = kb0 + (r & 3) + 8 * (r >> 2); if (kv > qrel) p0[r] = -INFINITY; if (kv + 32 > qrel) p1[r] = -INFINITY; }
        }
        float mx0 = p0[0], mx1 = p1[0];
#pragma unroll
        for (int r = 1; r < 16; ++r) { mx0 = fmaxf(mx0, p0[r]); mx1 = fmaxf(mx1, p1[r]); }
        const float mx = swapmax(fmaxf(mx0 + cb, mx1 + cb1));
        if (__any((mx - m) * C2 > 6.0f)) {
            const float mn = fmaxf(m, mx);
            const float alpha = __builtin_amdgcn_exp2f((m - mn) * C2);
            m = mn; lsum *= alpha;
            asm volatile("s_waitcnt lgkmcnt(0)" ::: "memory");
            if (hi == 0) wsf[r32] = alpha;
            asm volatile("s_waitcnt lgkmcnt(0)" ::: "memory");
#pragma unroll
            for (int r = 0; r < 16; ++r) { const float al = wsf[crow(r, hi)]; o0[r] *= al; o1[r] *= al; }
        }
        const float tb0 = (cb - m) * C2, tb1 = (cb1 - m) * C2;
        float ls = 0.f;
#pragma unroll
        for (int r = 0; r < 16; ++r) { p0[r] = __builtin_amdgcn_exp2f(fmaf(p0[r], C2, tb0)); p1[r] = __builtin_amdgcn_exp2f(fmaf(p1[r], C2, tb1)); ls += p0[r] + p1[r]; }
        lsum += ls;
        pg8::u32x4 w0, w1, w2, w3;
        w0.x = pk2(p0[0], p0[1]); w0.y = pk2(p0[2], p0[3]); w0.z = pk2(p0[4], p0[5]); w0.w = pk2(p0[6], p0[7]);
        w1.x = pk2(p0[8], p0[9]); w1.y = pk2(p0[10], p0[11]); w1.z = pk2(p0[12], p0[13]); w1.w = pk2(p0[14], p0[15]);
        w2.x = pk2(p1[0], p1[1]); w2.y = pk2(p1[2], p1[3]); w2.z = pk2(p1[4], p1[5]); w2.w = pk2(p1[6], p1[7]);
        w3.x = pk2(p1[8], p1[9]); w3.y = pk2(p1[10], p1[11]); w3.z = pk2(p1[12], p1[13]); w3.w = pk2(p1[14], p1[15]);
        const bf16x8 pa0 = __builtin_bit_cast(bf16x8, w0), pa1 = __builtin_bit_cast(bf16x8, w1), pa2 = __builtin_bit_cast(bf16x8, w2), pa3 = __builtin_bit_cast(bf16x8, w3);
#define ATT_VF(d0, ks) ({ const s16x4 lo_ = vtr(vp + so + (d0) * 4096 + (ks) * 1024), hi_ = vtr(vp + so + (d0) * 4096 + (ks) * 1024 + 512); \
        (bf16x8){lo_[0], lo_[1], lo_[2], lo_[3], hi_[0], hi_[1], hi_[2], hi_[3]}; })
        o0 = __builtin_amdgcn_mfma_f32_32x32x16_bf16(pa0, ATT_VF(0, 0), o0, 0, 0, 0);
        o1 = __builtin_amdgcn_mfma_f32_32x32x16_bf16(pa0, ATT_VF(1, 0), o1, 0, 0, 0);
        o0 = __builtin_amdgcn_mfma_f32_32x32x16_bf16(pa1, ATT_VF(0, 1), o0, 0, 0, 0);
        o1 = __builtin_amdgcn_mfma_f32_32x32x16_bf16(pa1, ATT_VF(1, 1), o1, 0, 0, 0);
        o0 = __builtin_amdgcn_mfma_f32_32x32x16_bf16(pa2, ATT_VF(0, 2), o0, 0, 0, 0);
        o1 = __builtin_amdgcn_mfma_f32_32x32x16_bf16(pa2, ATT_VF(1, 2), o1, 0, 0, 0);
        o0 = __builtin_amdgcn_mfma_f32_32x32x16_bf16(pa3, ATT_VF(0, 3), o0, 0, 0, 0);
        o1 = __builtin_amdgcn_mfma_f32_32x32x16_bf16(pa3, ATT_VF(1, 3), o1, 0, 0, 0);
#undef ATT_VF
    }
#undef ATT_DMA
    const float lt = swapsum(lsum);
    asm volatile("s_waitcnt lgkmcnt(0)" ::: "memory");
    if (hi == 0) wsf[r32] = 1.0f / lt;
    asm volatile("s_waitcnt lgkmcnt(0)" ::: "memory");
    PG8_LAS float* stg = (PG8_LAS float*)(lds + L_OST) + wid * (32 * OST_LD);
#pragma unroll
    for (int r = 0; r < 16; ++r) { const int orow = crow(r, hi); const float il = wsf[orow]; stg[orow * OST_LD + r32] = o0[r] * il; stg[orow * OST_LD + 32 + r32] = o1[r] * il; }
    asm volatile("s_waitcnt lgkmcnt(0)" ::: "memory");
    const float* gain = a.in[18] + l * 512 + h * HD;
    bf16_t* MIX = (bf16_t*)(a.ws + WS_MIX);
#pragma unroll
    for (int i = 0; i < 4; ++i) {
        const int row = i * 8 + (lane >> 3), ch = lane & 7;
        const pg8::f32x4 va = *(PG8_LAS const pg8::f32x4*)(stg + row * OST_LD + ch * 8), vb = *(PG8_LAS const pg8::f32x4*)(stg + row * OST_LD + ch * 8 + 4);
        float ss = va[0] * va[0] + va[1] * va[1] + va[2] * va[2] + va[3] * va[3] + vb[0] * vb[0] + vb[1] * vb[1] + vb[2] * vb[2] + vb[3] * vb[3];
        ss += SC_DPP(ss, 0xB1); ss += SC_DPP(ss, 0x4E); ss += SC_DPP(ss, 0x141);
        const float rs = rsqrtf(ss * (1.0f / 64.0f) + 1e-6f);
        const pg8::f32x4 ga = *(const pg8::f32x4*)(gain + ch * 8), gb = *(const pg8::f32x4*)(gain + ch * 8 + 4);
        pg8::u32x4 w; w.x = pk2(va[0] * rs * ga[0], va[1] * rs * ga[1]); w.y = pk2(va[2] * rs * ga[2], va[3] * rs * ga[3]);
        w.z = pk2(vb[0] * rs * gb[0], vb[1] * rs * gb[1]); w.w = pk2(vb[2] * rs * gb[2], vb[3] * rs * gb[3]);
        *(pg8::u32x4*)(MIX + ((size_t)b * SEQ + cur * 256 + wid * 32 + row) * DM + h * HD + ch * 8) = w;
    }
}
}

__device__ __forceinline__ void phase_att(const Args& a, int l, PG8_LAS unsigned char* lds) {
    const int G = gridDim.x, bx = blockIdx.x;
    const int v = (G % 8 == 0) ? (bx % 8) * (G / 8) + bx / 8 : bx;
    for (int w = v; w < 256; w += G) {
        const int bh = w >> 2, s = w & 3;
        att::unit(a, l, bh >> 3, bh & 7, 7 - s, lds);
        att::unit(a, l, bh >> 3, bh & 7, s, lds);
    }
}

constexpr int CK_STRIDE = 4 * REC_TG * 4, CK_FR = 2048, CK_FM1 = 4096, CK_FM2 = 4608, CK_FBK = 5120, CK_W = 9216;
__device__ __forceinline__ void phase_prep2(const Args& a, float* lds) {
    typedef float f32x4 __attribute__((ext_vector_type(4)));
    const int tid = tid_fresh(), lane0 = tid & 63, wid = tid >> 6;
    float* L = lds + wid * 4352;
    unsigned char* REC = a.ws + WS_REC;
    for (int task = blockIdx.x * 8 + wid; task < 64 * 128; task += gridDim.x * 8) {
        int lane = lane0; asm volatile("" : "+v"(lane));
        const int bh = task >> 7, c = task & 127, j = lane, j2 = j >> 1, hf = j & 1;
        unsigned char* blob = REC + ((size_t)bh * 512 + 4 * c) * (REC_TG * 4);
        float w[16], av[16], bv[16], kv[16], rv[16];
#pragma unroll
        for (int tg = 0; tg < 4; ++tg) {
            const unsigned* rp = (const unsigned*)(blob + (size_t)tg * (REC_TG * 4)) + j2 * 20 + (j2 >> 4) * 4;
            unsigned wd[20];
#pragma unroll
            for (int q = 0; q < 5; ++q) { const uint4 x = *(const uint4*)(rp + 4 * q); wd[4 * q] = x.x; wd[4 * q + 1] = x.y; wd[4 * q + 2] = x.z; wd[4 * q + 3] = x.w; }
#pragma unroll
            for (int ts = 0; ts < 4; ++ts) { const int s_ = tg * 4 + ts;
#define P2H(q) ({ const h2_t h_ = __builtin_bit_cast(h2_t, wd[ts * 5 + (q)]); (float)(hf ? h_[1] : h_[0]); })
                w[s_] = 1.0f - P2H(0); av[s_] = P2H(1); bv[s_] = P2H(2); kv[s_] = P2H(3); rv[s_] = P2H(4);
#undef P2H
            }
        }
        asm volatile("s_waitcnt vmcnt(0)" ::: "memory");
        float ah[16], rh[16];
        {
            float Wc = 1.0f, bh_[16], kh_[16];
#pragma unroll
            for (int s_ = 0; s_ < 16; ++s_) { ah[s_] = av[s_] * Wc; Wc *= w[s_]; rh[s_] = rv[s_] * Wc; const float iw = 1.0f / Wc; bh_[s_] = bv[s_] * iw; kh_[s_] = kv[s_] * iw; }
#pragma unroll
            for (int s_ = 0; s_ < 16; ++s_) { L[s_ * 68 + j] = bh_[s_]; L[1088 + s_ * 68 + j] = kh_[s_]; L[2176 + s_ * 68 + j] = ah[s_]; L[3264 + s_ * 68 + j] = rh[s_]; }
#pragma unroll
            for (int g = 0; g < 4; ++g) { uint4 o; o.x = pk2(bh_[4 * g] * Wc, bh_[4 * g + 1] * Wc); o.y = pk2(bh_[4 * g + 2] * Wc, bh_[4 * g + 3] * Wc);
                o.z = pk2(kh_[4 * g] * Wc, kh_[4 * g + 1] * Wc); o.w = pk2(kh_[4 * g + 2] * Wc, kh_[4 * g + 3] * Wc);
                *(uint4*)(blob + CK_FBK + (j >> 4) * 1024 + ((j & 15) + 16 * g) * 16) = o; }
            *(float*)(blob + CK_W + j * 4) = Wc;
        }
        asm volatile("s_waitcnt lgkmcnt(0)" ::: "memory");
        { const int rI = lane & 15, gI = lane >> 4;
          f32x4 gab = {0.f, 0.f, 0.f, 0.f}, gak = gab, gbr = gab, gkr = gab;
#pragma unroll 4
          for (int kk = 0; kk < 16; ++kk) { const int o = rI * 68 + 4 * kk + gI;
            const float aB = L[o], aK = L[1088 + o], bA = L[2176 + o], bR = L[3264 + o];
            gab = __builtin_amdgcn_mfma_f32_16x16x4f32(aB, bA, gab, 0, 0, 0); gak = __builtin_amdgcn_mfma_f32_16x16x4f32(aK, bA, gak, 0, 0, 0);
            gbr = __builtin_amdgcn_mfma_f32_16x16x4f32(aB, bR, gbr, 0, 0, 0); gkr = __builtin_amdgcn_mfma_f32_16x16x4f32(aK, bR, gkr, 0, 0, 0); }
          asm volatile("s_waitcnt lgkmcnt(0)" ::: "memory");
          f32x4 nab, nbr;
#pragma unroll
          for (int e = 0; e < 4; ++e) { const int s_ = 4 * gI + e; nab[e] = (s_ < rI) ? gab[e] : 0.f; nbr[e] = (s_ <= rI) ? gbr[e] : 0.f;
              L[512 + s_ * 16 + rI] = (s_ < rI) ? gak[e] : 0.f; L[768 + s_ * 16 + rI] = (s_ <= rI) ? gkr[e] : 0.f; }
          *(f32x4*)&L[rI * 16 + 4 * gI] = nab; *(f32x4*)&L[256 + rI * 16 + 4 * gI] = nbr;
        }
        asm volatile("s_waitcnt lgkmcnt(0)" ::: "memory");
        { bf16_t* IM = (bf16_t*)((unsigned char*)L + 4096);
          const int ks = j >> 5, jw = j & 31, g = (jw & 15) >> 2, jj = ((jw >> 4) << 2) | (jw & 3);
          const int sp = lane & 15, oA = ks * 512 + (16 * g) * 8 + jj, oM = 2048 + (16 * (sp >> 3)) * 8 + (sp & 7);
          const bool mw = lane < 16;
          float x[16], m1[16];
#pragma unroll
          for (int t = 0; t < 16; ++t) {
            float nt[16], nr[16];
#pragma unroll
            for (int q = 0; q < 4; ++q) { const f32x4 v = *(const f32x4*)&L[t * 16 + 4 * q]; nt[4 * q] = v[0]; nt[4 * q + 1] = v[1]; nt[4 * q + 2] = v[2]; nt[4 * q + 3] = v[3];
                                          const f32x4 u = *(const f32x4*)&L[256 + t * 16 + 4 * q]; nr[4 * q] = u[0]; nr[4 * q + 1] = u[1]; nr[4 * q + 2] = u[2]; nr[4 * q + 3] = u[3]; }
            float xa = ah[t], ma = L[512 + sp * 16 + t], ra = rh[t], mb = L[768 + sp * 16 + t];
#pragma unroll
            for (int s_ = 0; s_ < 16; ++s_) if (s_ < t) { xa = fmaf(x[s_], nt[s_], xa); ma = fmaf(m1[s_], nt[s_], ma); }
            x[t] = xa; m1[t] = ma;
#pragma unroll
            for (int s_ = 0; s_ < 16; ++s_) if (s_ <= t) { ra = fmaf(x[s_], nr[s_], ra); mb = fmaf(m1[s_], nr[s_], mb); }
            IM[oA + t * 8] = f2bf(xa); IM[1024 + oA + t * 8] = f2bf(ra);
            if (mw) { IM[oM + t * 8] = f2bf(ma); IM[256 + oM + t * 8] = f2bf(mb); }
            asm volatile("" ::: "memory");
          }
          asm volatile("s_waitcnt lgkmcnt(0)" ::: "memory");
          const uint4* IMq = (const uint4*)IM;
          *(uint4*)(blob + lane * 16) = IMq[lane]; *(uint4*)(blob + 1024 + lane * 16) = IMq[64 + lane];
          *(uint4*)(blob + CK_FR + lane * 16) = IMq[128 + lane]; *(uint4*)(blob + CK_FR + 1024 + lane * 16) = IMq[192 + lane];
          if (lane < 32) { *(uint4*)(blob + CK_FM1 + lane * 16) = IMq[256 + lane]; *(uint4*)(blob + CK_FM2 + lane * 16) = IMq[288 + lane]; }
        }
        asm volatile("s_waitcnt lgkmcnt(0)" ::: "memory");
    }
}
__device__ __forceinline__ void scan2_unit(const Args& a, int u, PG8_LAS unsigned char* lds) {
    typedef short bf16x8 __attribute__((ext_vector_type(8)));
    typedef float f32x4 __attribute__((ext_vector_type(4)));
    const int tid = tid_fresh(), lane = tid & 63, wid = __builtin_amdgcn_readfirstlane(tid >> 6);
    const int bh = u >> 2, rg = u & 3, b = bh >> 3, h = bh & 7;
    const int i16 = lane & 15, g = lane >> 4, irow = rg * 16 + i16;
    const unsigned char* REC = a.ws + WS_REC; const unsigned char* RVB = a.ws + WS_RVT; const unsigned char* ZERO = a.ws + 32768;
    bf16_t* YR = (bf16_t*)(a.ws + WS_YRAW);
    constexpr int DEPTH = 6, SLOTB = 16 * 1024, NCK = SEQ / 16;
#define S2_SRC(pc, c) ({ const unsigned char* blob_ = REC + ((size_t)bh * 512 + 4 * (c)) * (REC_TG * 4); const unsigned char* r_; \
        if ((pc) < 4) r_ = blob_ + (pc) * 1024 + lane * 16; \
        else if ((pc) < 6) r_ = (lane < 32) ? blob_ + CK_FM1 + ((pc) - 4) * 512 + lane * 16 : ZERO + lane * 16; \
        else if ((pc) < 10) r_ = blob_ + CK_FBK + ((pc) - 6) * 1024 + lane * 16; \
        else if ((pc) < 14) r_ = blob_ + CK_W + (16 * ((pc) - 10) + 4 * g) * 4; \
        else if ((pc) == 14) r_ = (g < 2) ? RVB + (((size_t)bh * 256 + 2 * (c) + g) * 64 + irow) * 16 : ZERO + lane * 16; \
        else r_ = RVB + (((size_t)bh * 256 + 2 * (c) + (g >> 1)) * 64 + irow) * 16; \
        r_; })
#define S2_DMA(pc, c) __builtin_amdgcn_global_load_lds((const unsigned*)S2_SRC(pc, c), (PG8_LAS unsigned*)(lds + ((c) % DEPTH) * SLOTB + (pc) * 1024), 16, 0, 0)
    asm volatile("s_waitcnt vmcnt(0) lgkmcnt(0)" ::: "memory"); __builtin_amdgcn_s_barrier(); asm volatile("" ::: "memory");
    if (wid > 0) {
        for (int c = 0; c < DEPTH - 1; ++c) { S2_DMA(wid - 1, c); S2_DMA(wid + 6, c); if (wid + 13 < 16) S2_DMA(wid + 13, c); }
    }
    f32x4 ST[4];
#pragma unroll
    for (int q = 0; q < 4; ++q) ST[q] = (f32x4){0.f, 0.f, 0.f, 0.f};
    for (int c = 0; c < NCK; ++c) {
        if (wid > 0) {
            if (wid + 13 < 16) asm volatile("s_waitcnt vmcnt(12)" ::: "memory"); else asm volatile("s_waitcnt vmcnt(8)" ::: "memory");
        }
        asm volatile("s_waitcnt lgkmcnt(0)" ::: "memory"); __builtin_amdgcn_s_barrier(); asm volatile("" ::: "memory");
        if (wid > 0) {
            const int cn = c + DEPTH - 1;
            if (cn < NCK) { S2_DMA(wid - 1, cn); S2_DMA(wid + 6, cn); if (wid + 13 < 16) S2_DMA(wid + 13, cn); }
            else { S2_DMA(wid - 1, NCK - 1); S2_DMA(wid + 6, NCK - 1); if (wid + 13 < 16) S2_DMA(wid + 13, NCK - 1); }
        } else {
            PG8_LAS const unsigned char* sl = lds + (c % DEPTH) * SLOTB + lane * 16;
#define S2_FR(pc) (*(PG8_LAS const bf16x8*)(sl + (pc) * 1024))
            const bf16x8 fa0 = S2_FR(0), fa1 = S2_FR(1), fr0 = S2_FR(2), fr1 = S2_FR(3), fm1 = S2_FR(4), fm2 = S2_FR(5), vb = S2_FR(14);
            const pg8::u32x4 v4w = *(PG8_LAS const pg8::u32x4*)(sl + 15 * 1024);
            pg8::u32x4 s0, s1;
            s0.x = pk2(ST[0][0], ST[0][1]); s0.y = pk2(ST[0][2], ST[0][3]); s0.z = pk2(ST[1][0], ST[1][1]); s0.w = pk2(ST[1][2], ST[1][3]);
            s1.x = pk2(ST[2][0], ST[2][1]); s1.y = pk2(ST[2][2], ST[2][3]); s1.z = pk2(ST[3][0], ST[3][1]); s1.w = pk2(ST[3][2], ST[3][3]);
            const bf16x8 sb0 = __builtin_bit_cast(bf16x8, s0), sb1 = __builtin_bit_cast(bf16x8, s1);
            f32x4 PT = {0.f, 0.f, 0.f, 0.f}, YT = PT;
            PT = __builtin_amdgcn_mfma_f32_16x16x32_bf16(fa0, sb0, PT, 0, 0, 0); YT = __builtin_amdgcn_mfma_f32_16x16x32_bf16(fr0, sb0, YT, 0, 0, 0);
            PT = __builtin_amdgcn_mfma_f32_16x16x32_bf16(fa1, sb1, PT, 0, 0, 0); YT = __builtin_amdgcn_mfma_f32_16x16x32_bf16(fr1, sb1, YT, 0, 0, 0);
            PT = __builtin_amdgcn_mfma_f32_16x16x32_bf16(fm1, vb, PT, 0, 0, 0);  YT = __builtin_amdgcn_mfma_f32_16x16x32_bf16(fm2, vb, YT, 0, 0, 0);
            pg8::u32x4 pv; pv.x = pk2(PT[0], PT[1]); pv.y = pk2(PT[2], PT[3]); pv.z = (g & 1) ? v4w.z : v4w.x; pv.w = (g & 1) ? v4w.w : v4w.y;
            const bf16x8 pvb = __builtin_bit_cast(bf16x8, pv);
#pragma unroll
            for (int jt = 0; jt < 4; ++jt) { const f32x4 wv = *(PG8_LAS const f32x4*)(sl + (10 + jt) * 1024);
                ST[jt] = __builtin_amdgcn_mfma_f32_16x16x32_bf16(S2_FR(6 + jt), pvb, ST[jt] * wv, 0, 0, 0); }
#undef S2_FR
            const size_t tok = (size_t)b * SEQ + 16 * c + 4 * g;
#pragma unroll
            for (int e = 0; e < 4; ++e) YR[(tok + e) * 512 + h * 64 + irow] = f2bf(YT[e]);
        }
    }
    asm volatile("s_waitcnt vmcnt(0) lgkmcnt(0)" ::: "memory"); __builtin_amdgcn_s_barrier(); asm volatile("" ::: "memory");
#undef S2_SRC
#undef S2_DMA
}

__device__ __forceinline__ void scan32(const Args& a, int l, int j, PG8_LAS unsigned char* lds) {
    const int tid = tid_fresh(), lane = tid & 63, wid = __builtin_amdgcn_readfirstlane(tid >> 6);
    const int jq = lane & 15, rr = lane >> 4;
    const char* REC = (const char*)(a.ws + WS_REC); const char* RVT = (const char*)(a.ws + WS_RVT);
    bf16_t* YR = (bf16_t*)(a.ws + WS_YRAW);
    constexpr int CSTEPS = 32, NCH = SEQ / CSTEPS, G_REC = 8 * REC_TG * 4, CH_REC = 21 * 1024, CH_V = 4096, CH = CH_REC + CH_V, NPC = 25;
    constexpr int YB_LD = 68, YB_WAVE = 16 * YB_LD * 4;
    PG8_LAS float* yb = (PG8_LAS float*)(lds + 2 * CH + wid * YB_WAVE);
    const int bh = j >> 1, hf32 = j & 1, b = bh >> 3, h = bh & 7;
    const int irow = hf32 * 32 + wid * 4 + rr;
    const char* grec = REC + (size_t)bh * NCH * G_REC; const char* gv = RVT + (size_t)bh * NCH * CH_V;
    float S0 = 0.f, S1 = 0.f, S2 = 0.f, S3 = 0.f;
    asm volatile("s_waitcnt vmcnt(0) lgkmcnt(0)" ::: "memory"); __builtin_amdgcn_s_barrier(); asm volatile("" ::: "memory");
#define SCAN_DMA(chn, bufo) do { _Pragma("unroll") for (int k_ = 0; k_ < 4; ++k_) { const int pc_ = wid * 4 + k_; if (pc_ < NPC) { \
        const char* src_ = (pc_ < 21) ? grec + (size_t)(chn) * G_REC + pc_ * 1024 + lane * 16 : gv + (size_t)(chn) * CH_V + (pc_ - 21) * 1024 + lane * 16; \
        __builtin_amdgcn_global_load_lds((const unsigned*)src_, (PG8_LAS unsigned*)(lds + (bufo) + pc_ * 1024), 16, 0, 0); } } } while (0)
    SCAN_DMA(0, 0);
    for (int ch = 0; ch < NCH; ++ch) {
        asm volatile("s_waitcnt vmcnt(0) lgkmcnt(0)" ::: "memory"); __builtin_amdgcn_s_barrier(); asm volatile("" ::: "memory");
        if (ch + 1 < NCH) SCAN_DMA(ch + 1, ((ch + 1) & 1) * CH);
        PG8_LAS const unsigned char* bufp = lds + (ch & 1) * CH;
#define SCAN_LOADW(WA, WB, grp) do { PG8_LAS const unsigned char* rp_ = bufp + (grp) * (REC_TG * 4) + jq * 160 + (jq >> 3) * 16; _Pragma("unroll") for (int k_ = 0; k_ < 5; ++k_) { \
        const pg8::u32x4 q_ = *(PG8_LAS const pg8::u32x4*)(rp_ + 16 * k_), q2_ = *(PG8_LAS const pg8::u32x4*)(rp_ + 80 + 16 * k_); \
        WA[4 * k_] = q_.x; WA[4 * k_ + 1] = q_.y; WA[4 * k_ + 2] = q_.z; WA[4 * k_ + 3] = q_.w; WB[4 * k_] = q2_.x; WB[4 * k_ + 1] = q2_.y; WB[4 * k_ + 2] = q2_.z; WB[4 * k_ + 3] = q2_.w; } } while (0)
#define SCAN_STEPS(WA, WB, hf) do { _Pragma("unroll") for (int ts = 0; ts < 4; ++ts) { \
        const unsigned uA = WA[ts * 5], aA = WA[ts * 5 + 1], bA = WA[ts * 5 + 2], kA = WA[ts * 5 + 3], rA = WA[ts * 5 + 4]; \
        const unsigned uB = WB[ts * 5], aB = WB[ts * 5 + 1], bB = WB[ts * 5 + 2], kB = WB[ts * 5 + 3], rB = WB[ts * 5 + 4]; \
        const unsigned vw = vv[(hf) * 2 + (ts >> 1)]; \
        const float sa = red16(fmix_hi(S3, aB, fmix_lo(S2, aB, fmix_hi(S1, aA, fmul_lo(S0, aA))))); \
        float t0 = fdec_lo(S0, uA), t1 = fdec_hi(S1, uA), t2 = fdec_lo(S2, uB), t3 = fdec_hi(S3, uB); \
        if (ts & 1) { t0 = fvk_lo<1>(vw, kA, t0); t1 = fvk_hi<1>(vw, kA, t1); t2 = fvk_lo<1>(vw, kB, t2); t3 = fvk_hi<1>(vw, kB, t3); } \
        else { t0 = fvk_lo<0>(vw, kA, t0); t1 = fvk_hi<0>(vw, kA, t1); t2 = fvk_lo<0>(vw, kB, t2); t3 = fvk_hi<0>(vw, kB, t3); } \
        S0 = fmix_lo(sa, bA, t0); S1 = fmix_hi(sa, bA, t1); S2 = fmix_lo(sa, bB, t2); S3 = fmix_hi(sa, bB, t3); \
        yb[((g8 & 1) * 8 + (hf) * 4 + ts) * YB_LD + rr * 16 + jq] = fmix_hi(S3, rB, fmix_lo(S2, rB, fmix_hi(S1, rA, fmul_lo(S0, rA)))); } } while (0)
        unsigned wA0[20], wB0[20], wA1[20], wB1[20];
        SCAN_LOADW(wA0, wB0, 0);
#pragma unroll 1
        for (int g8 = 0; g8 < 4; ++g8) {
            const pg8::u32x4 vv = *(PG8_LAS const pg8::u32x4*)(bufp + CH_REC + (g8 * 64 + irow) * 16);
            SCAN_LOADW(wA1, wB1, g8 * 2 + 1);
            SCAN_STEPS(wA0, wB0, 0);
            if (g8 < 3) SCAN_LOADW(wA0, wB0, g8 * 2 + 2);
            SCAN_STEPS(wA1, wB1, 1);
            if (g8 & 1) {
                asm volatile("s_waitcnt lgkmcnt(0)" ::: "memory");
                PG8_LAS const float* yp = yb + jq * YB_LD + rr * 16;
                const pg8::f32x4 y0 = *(PG8_LAS const pg8::f32x4*)(yp), y1 = *(PG8_LAS const pg8::f32x4*)(yp + 4), y2 = *(PG8_LAS const pg8::f32x4*)(yp + 8), y3 = *(PG8_LAS const pg8::f32x4*)(yp + 12);
                const pg8::f32x4 ys = (y0 + y1) + (y2 + y3);
                const float y = (ys[0] + ys[1]) + (ys[2] + ys[3]);
                const int t = ch * CSTEPS + (g8 >> 1) * 16 + jq;
                YR[((size_t)b * SEQ + t) * 512 + h * 64 + irow] = f2bf(y);
                asm volatile("s_waitcnt lgkmcnt(0)" ::: "memory");
            }
        }
#undef SCAN_LOADW
#undef SCAN_STEPS
    }
#undef SCAN_DMA
}
__device__ __forceinline__ void phase_scan_att2(const Args& a, int l, PG8_LAS unsigned char* lds) {
    const int bx = blockIdx.x;
    const int j = (bx & 7) * 16 + (bx >> 4);
    if (((bx >> 3) & 1) == 0) scan32(a, l, j, lds);
    else {
        const int bh = j >> 1, b = bh >> 3, h = bh & 7;
#pragma unroll 1
        for (int q = 0; q < 2; ++q) { const int s = 2 * (j & 1) + q; att::unit(a, l, b, h, 7 - s, lds); att::unit(a, l, b, h, s, lds); }
        __syncthreads();
        const int tid = tid_fresh(), lane = tid & 63, wid = tid >> 6;
        float* scr = (float*)((unsigned char*)lds) + wid * (64 * 33);
        CvtItem c0, c1; float4 v0[8], v1[8];
        int it = j * 8 + wid; const int NCW = 128 * 8;
        bool h0 = cvt_decode(a, l, it, c0); if (h0) cvt_load(c0, lane, v0);
        while (h0) {
            const bool h1 = cvt_decode(a, l, it + NCW, c1); if (h1) cvt_load(c1, lane, v1);
            cvt_finish(c0, lane, v0, scr);
            it += 2 * NCW;
            h0 = h1 && cvt_decode(a, l, it, c0); if (h0) cvt_load(c0, lane, v0);
            if (h1) cvt_finish(c1, lane, v1, scr);
        }
    }
}

__device__ __forceinline__ void phase_scan2_att(const Args& a, int l, PG8_LAS unsigned char* lds) {
    const int G = gridDim.x, bx = blockIdx.x;
    const int v = (G % 8 == 0) ? (bx % 8) * (G / 8) + bx / 8 : bx;
    for (int u = v; u < 256; u += G) scan2_unit(a, u, lds);
    for (int w = v; w < 256; w += G) { const int bh = w >> 2, s = w & 3; att::unit(a, l, bh >> 3, bh & 7, 7 - s, lds); att::unit(a, l, bh >> 3, bh & 7, s, lds); }
    __syncthreads();
    const int tid = tid_fresh(), lane = tid & 63, wid = tid >> 6;
    float* scr = (float*)((unsigned char*)lds) + wid * (64 * 33);
    CvtItem c0, c1; float4 v0[8], v1[8];
    int it = bx * 8 + wid; const int NCW = G * 8;
    bool h0 = cvt_decode(a, l, it, c0); if (h0) cvt_load(c0, lane, v0);
    while (h0) {
        const bool h1 = cvt_decode(a, l, it + NCW, c1); if (h1) cvt_load(c1, lane, v1);
        cvt_finish(c0, lane, v0, scr);
        it += 2 * NCW;
        h0 = h1 && cvt_decode(a, l, it, c0); if (h0) cvt_load(c0, lane, v0);
        if (h1) cvt_finish(c1, lane, v1, scr);
    }
}

__device__ __forceinline__ void phase_dense_res(const void* A, const void* WT, const float* RES, const bf16_t* RESB, bf16_t* OUT, PG8_LAS unsigned char* lds) {
    pg8::DenseSched S; S.init(A, DM, NTOK, WT, DM, DM);
    pg8::EpiBf16Res E{OUT, RES, DM, ALPHA, RESB};
    pg8::gemm_phase<pg8::EpiBf16Res, pg8::DenseSched, false>(lds, pg8::Dims{DM, DM, DM}, S, E);
}
__device__ __forceinline__ void phase_dense_bf16(const void* A, int M, const void* WT, int N, bf16_t* OUT, PG8_LAS unsigned char* lds) {
    pg8::DenseSched S; S.init(A, DM, M, WT, DM, N);
    pg8::EpiBf16 E{OUT, N};
    pg8::gemm_phase<pg8::EpiBf16, pg8::DenseSched, false>(lds, pg8::Dims{DM, DM, DM}, S, E);
}

__device__ __forceinline__ void ln_row(const bf16_t* in, const float* g, const float* bta, float* out, bf16_t* outb, int lane, float (&xn)[16]) {
    float x[16];
#pragma unroll
    for (int m = 0; m < 4; ++m) { const uint2 v = *(const uint2*)(in + m * 256 + lane * 4); x[m * 4] = bflo(v.x); x[m * 4 + 1] = bfhi(v.x); x[m * 4 + 2] = bflo(v.y); x[m * 4 + 3] = bfhi(v.y); }
    float s = 0.f;
#pragma unroll
    for (int k = 0; k < 16; ++k) s += x[k];
    const float mean = wsum(s) * (1.0f / 1024.0f);
    float q = 0.f;
#pragma unroll
    for (int k = 0; k < 16; ++k) { const float d = x[k] - mean; q = fmaf(d, d, q); }
    const float var = wsum(q) * (1.0f / 1024.0f);
    const float rstd = rsqrtf(var + 1e-5f);
#pragma unroll
    for (int m = 0; m < 4; ++m) {
        const float4 gv = *(const float4*)(g + m * 256 + lane * 4), bv = *(const float4*)(bta + m * 256 + lane * 4);
        float4 o;
        o.x = (x[m * 4] - mean) * rstd * gv.x + bv.x; o.y = (x[m * 4 + 1] - mean) * rstd * gv.y + bv.y;
        o.z = (x[m * 4 + 2] - mean) * rstd * gv.z + bv.z; o.w = (x[m * 4 + 3] - mean) * rstd * gv.w + bv.w;
        xn[m * 4] = o.x; xn[m * 4 + 1] = o.y; xn[m * 4 + 2] = o.z; xn[m * 4 + 3] = o.w;
        if (out) *(float4*)(out + m * 256 + lane * 4) = o;
        uint2 ob; ob.x = pk2(o.x, o.y); ob.y = pk2(o.z, o.w); *(uint2*)(outb + m * 256 + lane * 4) = ob;
    }
}
__device__ __forceinline__ void phase_ln(const bf16_t* IN, const float* g, const float* bta, float* OUT, bf16_t* OUTB) {
    const int tid = tid_fresh(), lane = tid & 63, wid = tid >> 6;
    for (int row = blockIdx.x * 8 + wid; row < NTOK; row += gridDim.x * 8) {
        float xn[16];
        ln_row(IN + (size_t)row * DM, g, bta, OUT ? OUT + (size_t)row * DM : (float*)nullptr, OUTB + (size_t)row * DM, lane, xn);
    }
}

__device__ __forceinline__ float treduce32(float (&p)[32], int lane) {
    float q[16], r[8], s4[4], t2[2];
#pragma unroll
    for (int i = 0; i < 16; ++i) { auto sw = __builtin_amdgcn_permlane32_swap(__float_as_uint(p[i]), __float_as_uint(p[i + 16]), false, false); q[i] = __uint_as_float(sw[0]) + __uint_as_float(sw[1]); }
    const bool L4 = (lane & 16) != 0, L3 = (lane & 8) != 0, L2 = (lane & 4) != 0, L1 = (lane & 2) != 0;
#pragma unroll
    for (int i = 0; i < 8; ++i) { const float snd = L4 ? q[i] : q[i + 8], keep = L4 ? q[i + 8] : q[i]; r[i] = keep + __shfl_xor(snd, 16); }
#pragma unroll
    for (int i = 0; i < 4; ++i) { const float snd = L3 ? r[i] : r[i + 4], keep = L3 ? r[i + 4] : r[i]; s4[i] = keep + SC_DPP(snd, 0x140); }
#pragma unroll
    for (int i = 0; i < 2; ++i) { const float snd = L2 ? s4[i] : s4[i + 2], keep = L2 ? s4[i + 2] : s4[i]; t2[i] = keep + SC_DPP(snd, 0x141); }
    const float snd = L1 ? t2[0] : t2[1], keep = L1 ? t2[1] : t2[0];
    float u = keep + SC_DPP(snd, 0x4E);
    u += SC_DPP(u, 0xB1);
    return __shfl(u, (lane & 31) * 2);
}
struct RouteRes { int e0, e1; float g0, g1; };
__device__ __forceinline__ RouteRes route_row(float mylogit, int lane, const float* BR) {
    const float s = sigmoidf_(mylogit);
    const float sel = (lane < 32) ? s + BR[lane & 31] : NEG_INF;
    const int gb = lane & ~3;
    const float v0 = __shfl(sel, gb), v1 = __shfl(sel, gb + 1), v2 = __shfl(sel, gb + 2), v3 = __shfl(sel, gb + 3);
    const float m1 = fmaxf(fmaxf(v0, v1), fmaxf(v2, v3));
    float m2;
    { const float lo01 = fminf(v0, v1), hi01 = fmaxf(v0, v1), lo23 = fminf(v2, v3), hi23 = fmaxf(v2, v3);
      m2 = fmaxf(fminf(hi01, hi23), fmaxf(lo01, lo23)); }
    float gs = (lane < 32) ? (m1 + m2) : NEG_INF;
    int gi = lane >> 2;
#pragma unroll
    for (int o = 32; o > 0; o >>= 1) { const float ov = __shfl_xor(gs, o); const int oi = __shfl_xor(gi, o); if (ov > gs || (ov == gs && oi < gi)) { gs = ov; gi = oi; } }
    const int gbest = gi;
    const float c0 = __shfl(sel, gbest * 4), c1 = __shfl(sel, gbest * 4 + 1), c2 = __shfl(sel, gbest * 4 + 2), c3 = __shfl(sel, gbest * 4 + 3);
    int j0 = 0; float b0 = c0;
    if (c1 > b0) { b0 = c1; j0 = 1; } if (c2 > b0) { b0 = c2; j0 = 2; } if (c3 > b0) { b0 = c3; j0 = 3; }
    int j1 = -1; float b1 = -3e38f;
    if (j0 != 0 && c0 > b1) { b1 = c0; j1 = 0; } if (j0 != 1 && c1 > b1) { b1 = c1; j1 = 1; } if (j0 != 2 && c2 > b1) { b1 = c2; j1 = 2; } if (j0 != 3 && c3 > b1) { b1 = c3; j1 = 3; }
    RouteRes R; R.e0 = gbest * 4 + j0; R.e1 = gbest * 4 + j1;
    const float s0 = __shfl(s, R.e0), s1 = __shfl(s, R.e1);
    const float inv = 1.0f / (s0 + s1);
    R.g0 = s0 * inv; R.g1 = s1 * inv;
    return R;
}
__device__ __forceinline__ void phase_ln2_router(const Args& a, int l, float* lds, bool dummy = false) {
    const int tid = tid_fresh(), lane = tid & 63, wid = tid >> 6;
    const bf16_t* PRE = (const bf16_t*)(a.ws + WS_PRE2);
    bf16_t* X2B = (bf16_t*)(a.ws + WS_X2B);
    const float* g = a.in[28] + (size_t)(l * 3 + 1) * DM; const float* bta = a.in[29] + (size_t)(l * 3 + 1) * DM;
    const float* WR = a.in[23]; const float* BR = a.in[24];
    unsigned* cnt = (unsigned*)(a.ws + WS_CTL) + CW_CNT + l * 32 + (dummy ? 128 : 0);
    int2* list = (int2*)(a.ws + (dummy ? WS_H : WS_LIST));
    int2* tokpos = (int2*)(a.ws + (dummy ? WS_H + 8 * MiB : WS_TOKPOS));
    float2* tokgate = (float2*)(a.ws + (dummy ? WS_H + 9 * MiB : WS_TOKGATE));
    constexpr int WR_LD = DM + 4;
    unsigned* lcnt = (unsigned*)(lds + NEXP * WR_LD);
    int* lres = (int*)(lds + NEXP * WR_LD + 64);
    __syncthreads();
    {
        float4 wv[16];
#pragma unroll
        for (int q = 0; q < 16; ++q) wv[q] = *(const float4*)(WR + (size_t)(q * NTHREADS + tid) * 4);
#pragma unroll
        for (int q = 0; q < 16; ++q) { const int idx = (q * NTHREADS + tid) * 4, k = idx >> 5, e = idx & 31;
            lds[e * WR_LD + k] = wv[q].x; lds[(e + 1) * WR_LD + k] = wv[q].y; lds[(e + 2) * WR_LD + k] = wv[q].z; lds[(e + 3) * WR_LD + k] = wv[q].w; }
    }
    if (tid < 64) lcnt[tid] = 0u;
    __syncthreads();
    int nloc = 0;
    for (int row = (blockIdx.x * 8 + wid) * 2; row < NTOK; row += gridDim.x * 16) {
        float xa[16], xb[16];
        ln_row(PRE + (size_t)row * DM, g, bta, (float*)nullptr, X2B + (size_t)row * DM, lane, xa);
        ln_row(PRE + (size_t)(row + 1) * DM, g, bta, (float*)nullptr, X2B + (size_t)(row + 1) * DM, lane, xb);
        float pa[32], pb[32];
#pragma unroll
        for (int e = 0; e < NEXP; ++e) {
            float sa_ = 0.f, sb_ = 0.f;
#pragma unroll
            for (int m = 0; m < 4; ++m) { const float4 wv = *(const float4*)&lds[e * WR_LD + m * 256 + lane * 4];
                sa_ = fmaf(xa[m * 4], wv.x, sa_); sa_ = fmaf(xa[m * 4 + 1], wv.y, sa_); sa_ = fmaf(xa[m * 4 + 2], wv.z, sa_); sa_ = fmaf(xa[m * 4 + 3], wv.w, sa_);
                sb_ = fmaf(xb[m * 4], wv.x, sb_); sb_ = fmaf(xb[m * 4 + 1], wv.y, sb_); sb_ = fmaf(xb[m * 4 + 2], wv.z, sb_); sb_ = fmaf(xb[m * 4 + 3], wv.w, sb_); }
            pa[e] = sa_; pb[e] = sb_;
        }
        const float la = treduce32(pa, lane), lb = treduce32(pb, lane);
#pragma unroll
        for (int q = 0; q < 2; ++q) {
            const RouteRes R = route_row(q ? lb : la, lane, BR);
            if (lane == 0) {
                const unsigned r0 = atomicAdd(&lcnt[R.e0], 1u), r1 = atomicAdd(&lcnt[R.e1], 1u);
                int* o = lres + (wid * 32 + nloc + q) * 8;
                o[0] = row + q; o[1] = R.e0; o[2] = R.e1; o[3] = (int)r0; o[4] = (int)r1; o[5] = __float_as_int(R.g0); o[6] = __float_as_int(R.g1);
            }
        }
        nloc += 2;
    }
    __syncthreads();
    if (tid < 32) lcnt[32 + tid] = atomicAdd(&cnt[tid], lcnt[tid]);
    __syncthreads();
    for (int i = lane; i < nloc; i += 64) {
        const int* o = lres + (wid * 32 + i) * 8;
        const int row = o[0], e0 = o[1], e1 = o[2]; const unsigned r0 = lcnt[32 + e0] + (unsigned)o[3], r1 = lcnt[32 + e1] + (unsigned)o[4];
        list[(size_t)e0 * LCAP + r0] = make_int2(row, o[5]);
        list[(size_t)e1 * LCAP + r1] = make_int2(row, o[6]);
        tokpos[row * 2] = make_int2(e0, (int)r0); tokpos[row * 2 + 1] = make_int2(e1, (int)r1);
        tokgate[row] = make_float2(__int_as_float(o[5]), __int_as_float(o[6]));
    }
}

constexpr int ZERO_ROW = 32768 / 2048;
struct I2 { int x, y; };
struct MoeSched {
    int G, c, T, npn; PG8_LAS I2* tab;
    const char* A; const char* B; size_t b_e, b_pn, a_tile; int colw;
    const int2* list; int gat_row0;
    __device__ void init(PG8_LAS unsigned char* lds, const unsigned* cnt, int npn_, const void* A_, size_t a_tile_, const void* B_, size_t b_e_, size_t b_pn_, int colw_, const int2* list_, int gat_row0_) {
        const int lane = tid_fresh() & 63, x = lane & 31;
        G = gridDim.x; c = blockIdx.x; npn = npn_; A = (const char*)A_; a_tile = a_tile_; B = (const char*)B_; b_e = b_e_; b_pn = b_pn_; colw = colw_; list = list_; gat_row0 = gat_row0_;
        const unsigned cnt_l = __hip_atomic_load(cnt + x, __ATOMIC_RELAXED, __HIP_MEMORY_SCOPE_AGENT);
        const int tiles = (int)((cnt_l + 255u) >> 8);
        int inc = tiles;
#pragma unroll
        for (int o = 1; o < 32; o <<= 1) { const int t = __shfl_up(inc, o, 32); if (x >= o) inc += t; }
        tab = (PG8_LAS I2*)(lds + pg8::STAGE_BYTES + 8192);
        tab[x].x = (int)cnt_l; tab[x].y = inc - tiles;
        T = __builtin_amdgcn_readfirstlane(__shfl(inc, 31));
        __syncthreads();
    }
    __device__ __forceinline__ bool next(int i, pg8::Unit& u) const {
        const long L = (long)i * G + c; if (L >= (long)T * npn) return false;
        const int ti = (int)(L / npn), pn = (int)(L % npn);
        const int my_excl = tab[__builtin_amdgcn_mbcnt_lo(~0u, 0u) & 31].y;
        const unsigned long long m = __ballot(my_excl <= ti) & 0xffffffffull;
        const int e = __popcll(m) - 1;
        const int rt = ti - tab[e].y;
        const unsigned ce = (unsigned)tab[e].x;
        u.aux = __builtin_amdgcn_readfirstlane(e | (rt << 8)); u.aux2 = __builtin_amdgcn_readfirstlane((int)ce);
        u.row0 = ti * 256; u.col0 = pn * colw;
        u.A = A + (size_t)ti * a_tile; u.B = B + (size_t)e * b_e + (size_t)pn * b_pn;
        return true;
    }
    __device__ __forceinline__ int arow(const pg8::Unit& u, int r) const {
        const int e = u.aux & 255, rank = (u.aux >> 8) * 256 + r;
        return rank < u.aux2 ? gat_row0 + list[(size_t)e * LCAP + rank].x : ZERO_ROW;
    }
};
struct EpiSwiGLU {
    static constexpr bool PERM = true;
    bf16_t* H;
    __device__ __forceinline__ void operator()(const pg8::f32x4 (&acc)[2][2][4][2], const pg8::Unit& u, int wr, int wc, int fr, int fq) const {
        const int col = u.col0 + wc * 32 + 8 * fq;
#pragma unroll
        for (int ai = 0; ai < 2; ++ai)
#pragma unroll
            for (int m = 0; m < 4; ++m) {
                const int r = wr * 64 + fr + ai * 128 + m * 16;
                float hv[8];
#pragma unroll
                for (int n = 0; n < 2; ++n)
#pragma unroll
                    for (int j = 0; j < 4; ++j) { const float g = acc[ai][0][m][n][j], up = acc[ai][1][m][n][j]; hv[n * 4 + j] = g * up * __builtin_amdgcn_rcpf(1.0f + __expf(-g)); }
                pg8::u32x4 w; w.x = pk2(hv[0], hv[1]); w.y = pk2(hv[2], hv[3]); w.z = pk2(hv[4], hv[5]); w.w = pk2(hv[6], hv[7]);
                *(pg8::u32x4*)(H + (size_t)(u.row0 + r) * DEXP + col) = w;
            }
    }
};
__device__ __forceinline__ void phase_f3(const Args& a, int l, PG8_LAS unsigned char* lds) {
    const unsigned* cnt = (const unsigned*)(a.ws + WS_CTL) + CW_CNT + l * 32;
    const int2* list = (const int2*)(a.ws + WS_LIST);
    MoeSched S; S.init(lds, cnt, 4, a.ws, 0, a.ws + WS_WEXP, (size_t)1024 * 1024 * 2, (size_t)256 * 1024 * 2, 128, list, (int)(WS_X2B / 2048));
    EpiSwiGLU E{(bf16_t*)(a.ws + WS_H)};
    pg8::gemm_phase<EpiSwiGLU, MoeSched, true>(lds, pg8::Dims{DM, DM, DM}, S, E);
}
__device__ __forceinline__ void phase_f4(const Args& a, int l, PG8_LAS unsigned char* lds) {
    const unsigned* cnt = (const unsigned*)(a.ws + WS_CTL) + CW_CNT + l * 32;
    MoeSched S; S.init(lds, cnt, 4, a.ws + WS_H, (size_t)256 * DEXP * 2, a.ws + WS_WEXP + (size_t)NEXP * 1024 * 1024 * 2, (size_t)1024 * 512 * 2, (size_t)256 * 512 * 2, 256, nullptr, 0);
    pg8::EpiBf16 E{(bf16_t*)(a.ws + WS_Y), DM};
    pg8::gemm_phase<pg8::EpiBf16, MoeSched, false>(lds, pg8::Dims{DEXP, DEXP, DEXP}, S, E);
}
__device__ __forceinline__ void phase_ln3(const Args& a, int l, float* OUT, bf16_t* OUTB) {
    const int tid = tid_fresh(), lane = tid & 63, wid = tid >> 6;
    const unsigned* cnt = (const unsigned*)(a.ws + WS_CTL) + CW_CNT + l * 32;
    const int2* tokpos = (const int2*)(a.ws + WS_TOKPOS);
    const bf16_t* X2B = (const bf16_t*)(a.ws + WS_X2B); const bf16_t* Y = (const bf16_t*)(a.ws + WS_Y);
    const float* g = a.in[28] + (size_t)(l * 3 + 2) * DM; const float* bta = a.in[29] + (size_t)(l * 3 + 2) * DM;
    int mybase = 0;
    { int acc = 0; for (int x = 0; x < NEXP; ++x) { if (x == lane) mybase = acc; acc += (int)((cnt[x] + 255u) >> 8); } }
    for (int row = blockIdx.x * 8 + wid; row < NTOK; row += gridDim.x * 8) {
        const int2 p0 = tokpos[row * 2], p1 = tokpos[row * 2 + 1]; const float2 tg = ((const float2*)(a.ws + WS_TOKGATE))[row];
        const size_t h0 = (size_t)__shfl(mybase, p0.x) * 256 + p0.y, h1 = (size_t)__shfl(mybase, p1.x) * 256 + p1.y;
        const bf16_t* xr = X2B + (size_t)row * DM; const bf16_t* y0 = Y + h0 * DM; const bf16_t* y1 = Y + h1 * DM;
        float x[16];
#pragma unroll
        for (int m = 0; m < 4; ++m) { const int o = m * 256 + lane * 4; const uint2 xb_ = *(const uint2*)(xr + o); const float4 xv = make_float4(bflo(xb_.x), bfhi(xb_.x), bflo(xb_.y), bfhi(xb_.y)); const uint2 a0 = *(const uint2*)(y0 + o), a1 = *(const uint2*)(y1 + o);
            x[m * 4] = fmaf(ALPHA, xv.x, fmaf(tg.x, bflo(a0.x), tg.y * bflo(a1.x))); x[m * 4 + 1] = fmaf(ALPHA, xv.y, fmaf(tg.x, bfhi(a0.x), tg.y * bfhi(a1.x)));
            x[m * 4 + 2] = fmaf(ALPHA, xv.z, fmaf(tg.x, bflo(a0.y), tg.y * bflo(a1.y))); x[m * 4 + 3] = fmaf(ALPHA, xv.w, fmaf(tg.x, bfhi(a0.y), tg.y * bfhi(a1.y))); }
        float s = 0.f;
#pragma unroll
        for (int k = 0; k < 16; ++k) s += x[k];
        const float mean = wsum(s) * (1.0f / 1024.0f);
        float q = 0.f;
#pragma unroll
        for (int k = 0; k < 16; ++k) { const float d = x[k] - mean; q = fmaf(d, d, q); }
        const float rstd = rsqrtf(wsum(q) * (1.0f / 1024.0f) + 1e-5f);
#pragma unroll
        for (int m = 0; m < 4; ++m) { const int o = m * 256 + lane * 4; const float4 gv = *(const float4*)(g + o), bv = *(const float4*)(bta + o); float4 r;
            r.x = (x[m * 4] - mean) * rstd * gv.x + bv.x; r.y = (x[m * 4 + 1] - mean) * rstd * gv.y + bv.y; r.z = (x[m * 4 + 2] - mean) * rstd * gv.z + bv.z; r.w = (x[m * 4 + 3] - mean) * rstd * gv.w + bv.w;
            if (OUT) *(float4*)(OUT + (size_t)row * DM + o) = r;
            if (OUTB) { uint2 ob; ob.x = pk2(r.x, r.y); ob.y = pk2(r.z, r.w); *(uint2*)(OUTB + (size_t)row * DM + o) = ob; } }
    }
}

constexpr int PH_PER_LAYER = 15, N_PHASES = 1 + 2 * PH_PER_LAYER;

__global__ void __launch_bounds__(NTHREADS, 2) mk_fwd(Args a) {
    extern __shared__ __attribute__((aligned(16))) unsigned char smem[];
    float* lds = (float*)smem;
    PG8_LAS unsigned char* lds3 = (PG8_LAS unsigned char*)smem;
    volatile LAS unsigned* xbw = (volatile LAS unsigned*)(smem + LDS_BYTES - 16);
    const int lo = a.ph_lo, hi = a.ph_hi;
    unsigned* ctl = (unsigned*)(a.ws + WS_CTL);
    XcdBarrier bar; bar.bar = ctl + CW_BAR; bar.x = 0; bar.st = xbw;
    if (hi - lo > 1) {
        if (threadIdx.x == 0) { xbw[0] = 0u; xbw[1] = 0u; }
        __syncthreads();
        bar = xcd_barrier_post(ctl + CW_BAR, xbw);
    }
#define IN(k) (lo <= (k) && (k) < hi)
#define SEAM(k) do { if (IN(k) && IN((k) + 1)) xcd_barrier(bar); } while (0)
    if (IN(0)) { phase_prologue(a, lds); if (PROBE_REP == 99) { xcd_barrier(bar); phase_prologue(a, lds); } }
    SEAM(0);
#define LAYER_BODY(l) do { \
        const int p0 = 1 + l * PH_PER_LAYER; \
        const float* xin = (l == 0) ? a.in[0] : (const float*)nullptr; const bf16_t* xinb = (l == 0) ? (const bf16_t*)nullptr : (const bf16_t*)(a.ws + WS_XB);     \
        float* xout = (l == 0) ? (float*)nullptr : a.out; \
        if (IN(p0 + 0)) { phase_g1(a, l, lds3); if (PROBE_REP == 0) { xcd_barrier(bar); phase_g1(a, l, lds3); } } \
        SEAM(p0 + 0); \
        if (IN(p0 + 1)) { phase_prep(a, l, lds); if (PROBE_REP == 1) { xcd_barrier(bar); phase_prep(a, l, lds); } } \
        SEAM(p0 + 1); \
        if (IN(p0 + 2)) { phase_prep2(a, lds); if (PROBE_REP == 2) { xcd_barrier(bar); } } \
        SEAM(p0 + 2); \
        if (IN(p0 + 3)) { phase_scan2_att(a, l, lds3); if (PROBE_REP == 3) { xcd_barrier(bar); phase_scan2_att(a, l, lds3); } } \
        SEAM(p0 + 3); \
        if (IN(p0 + 4)) { phase_post(a, l); if (PROBE_REP == 4) { xcd_barrier(bar); phase_post(a, l); } } \
        SEAM(p0 + 4); \
        if (IN(p0 + 5)) { phase_dense_res(a.ws + WS_MIX, a.ws + WS_WOUT + (size_t)l * 2 * MiB, xin, xinb, (bf16_t*)(a.ws + WS_PRE), lds3); if (PROBE_REP == 5) { xcd_barrier(bar); phase_dense_res(a.ws + WS_MIX, a.ws + WS_WOUT + (size_t)l * 2 * MiB, xin, xinb, (bf16_t*)(a.ws + WS_PRE), lds3); } } \
        SEAM(p0 + 5); \
        if (IN(p0 + 6)) { phase_ln((const bf16_t*)(a.ws + WS_PRE), a.in[28] + (size_t)(l * 3) * DM, a.in[29] + (size_t)(l * 3) * DM, (float*)nullptr, (bf16_t*)(a.ws + WS_X1B)); if (PROBE_REP == 6) { xcd_barrier(bar); phase_ln((const bf16_t*)(a.ws + WS_PRE), a.in[28] + (size_t)(l * 3) * DM, a.in[29] + (size_t)(l * 3) * DM, (float*)nullptr, (bf16_t*)(a.ws + WS_X1B)); } } \
        SEAM(p0 + 6); \
        if (IN(p0 + 7)) { phase_dense_bf16(a.ws + WS_X1B, NTOK, a.ws + WS_WQ + (size_t)l * 2 * MiB, DM, (bf16_t*)(a.ws + WS_Q), lds3); if (PROBE_REP == 7) { xcd_barrier(bar); phase_dense_bf16(a.ws + WS_X1B, NTOK, a.ws + WS_WQ + (size_t)l * 2 * MiB, DM, (bf16_t*)(a.ws + WS_Q), lds3); } } \
        SEAM(p0 + 7); \
        if (IN(p0 + 8)) { phase_matt_s(a, lds3); if (PROBE_REP == 8) { xcd_barrier(bar); phase_matt_s(a, lds3); } } \
        SEAM(p0 + 8); \
        if (IN(p0 + 9)) { phase_matt_pv(a, lds3); if (PROBE_REP == 9) { xcd_barrier(bar); phase_matt_pv(a, lds3); } } \
        SEAM(p0 + 9); \
        if (IN(p0 + 10)) { phase_dense_res(a.ws + WS_O, a.ws + WS_WO + (size_t)l * 2 * MiB, (const float*)nullptr, (const bf16_t*)(a.ws + WS_X1B), (bf16_t*)(a.ws + WS_PRE2), lds3); if (PROBE_REP == 10) { xcd_barrier(bar); phase_dense_res(a.ws + WS_O, a.ws + WS_WO + (size_t)l * 2 * MiB, (const float*)nullptr, (const bf16_t*)(a.ws + WS_X1B), (bf16_t*)(a.ws + WS_PRE2), lds3); } } \
        SEAM(p0 + 10); \
        if (IN(p0 + 11)) { phase_ln2_router(a, l, lds); if (PROBE_REP == 11) { xcd_barrier(bar); phase_ln2_router(a, l, lds, true); } } \
        SEAM(p0 + 11); \
        if (IN(p0 + 12)) { phase_f3(a, l, lds3); if (PROBE_REP == 12) { xcd_barrier(bar); phase_f3(a, l, lds3); } } \
        SEAM(p0 + 12); \
        if (IN(p0 + 13)) { phase_f4(a, l, lds3); if (PROBE_REP == 13) { xcd_barrier(bar); phase_f4(a, l, lds3); } } \
        SEAM(p0 + 13); \
        if (IN(p0 + 14)) { { phase_ln3(a, l, xout, (l == 0) ? (bf16_t*)(a.ws + WS_XB) : (bf16_t*)nullptr); } if (PROBE_REP == 14) { xcd_barrier(bar); { phase_ln3(a, l, xout, (l == 0) ? (bf16_t*)(a.ws + WS_XB) : (bf16_t*)nullptr); } } } \
        SEAM(p0 + 14); \
    } while (0)
    LAYER_BODY(0);
    LAYER_BODY(1);
}
}

extern "C" void kernel_launch(void* const* d_in, const int* in_sizes, int n_in, void* d_out, int out_size, void* d_ws, size_t ws_size, hipStream_t stream) {
    static int grid = 0;
    if (!grid) {
        int dev = 0, cus = 0, per_cu = 0;
        (void)hipGetDevice(&dev);
        (void)hipDeviceGetAttribute(&cus, hipDeviceAttributeMultiprocessorCount, dev);
        (void)hipFuncSetAttribute((const void*)mk_fwd, hipFuncAttributeMaxDynamicSharedMemorySize, LDS_BYTES);
        (void)hipOccupancyMaxActiveBlocksPerMultiprocessor(&per_cu, mk_fwd, NTHREADS, LDS_BYTES);
        (void)hipGetLastError();
        grid = cus * 1;
        if (grid != 256) grid = 256;
    }
    if (ws_size < WS_END) return;
    (void)hipMemsetAsync(d_ws, 0, CTL_ZERO_BYTES, stream);
    Args a;
    memset(&a, 0, sizeof(a));
    for (int i = 0; i < 30; ++i) a.in[i] = (const float*)d_in[i];
    a.out = (float*)d_out; a.ws = (unsigned char*)d_ws;
#if MK_ONE_LAUNCH
    a.ph_lo = 0; a.ph_hi = N_PHASES;
    hipLaunchKernelGGL(mk_fwd, dim3(grid), dim3(NTHREADS), LDS_BYTES, stream, a);
#else
    for (int p = 0; p < N_PHASES; ++p) {
        a.ph_lo = p; a.ph_hi = p + 1;
        hipLaunchKernelGGL(mk_fwd, dim3(grid), dim3(NTHREADS), LDS_BYTES, stream, a);
    }
#endif
}
```

```cpp
#include <hip/hip_runtime.h>
#include <stdint.h>
#include <cstring>

#ifndef PROBE_REP
#define PROBE_REP -1
#endif
#ifndef PROBE_T
#define PROBE_T -1
#endif
#ifndef MK_ONE_LAUNCH
#define MK_ONE_LAUNCH 1
#endif

namespace {
constexpr int NTHREADS = 512;
constexpr int NTOK = 16384, SEQ = 2048, NBATCH = 8, DM = 1024;
constexpr int MEMLEN = 256;
constexpr int NH = 8, HD = 64;
constexpr int IN_COLS = 3328, ZLD = 3584;
constexpr int C_Q = 0, C_K = 512, C_V = 1024, C_R = 1536, C_KR = 2048, C_VR = 2560, C_ZW = 3072, C_ZA = 3136, C_ZG = 3200, C_ZV = 3328;
constexpr int NEXP = 32, DEXP = 512;
constexpr int LCAP = 16384;
constexpr float ALPHA = 1.4142135623730951f;
constexpr float NEG_INF = -1e30f;
constexpr int LDS_BYTES = 147456;

typedef unsigned short bf16_t;
typedef float f32x2_t __attribute__((ext_vector_type(2)));
typedef __bf16 bf16x2_t __attribute__((ext_vector_type(2)));
__device__ __forceinline__ unsigned pk2(float lo, float hi) { f32x2_t v = {lo, hi}; bf16x2_t b = __builtin_convertvector(v, bf16x2_t); return __builtin_bit_cast(unsigned, b); }
__device__ __forceinline__ bf16_t f2bf(float f) { return (bf16_t)(pk2(f, 0.f) & 0xffffu); }
__device__ __forceinline__ float bf2f(bf16_t h) { return __uint_as_float((unsigned)h << 16); }
__device__ __forceinline__ float bflo(unsigned u) { return __uint_as_float(u << 16); }
__device__ __forceinline__ float bfhi(unsigned u) { return __uint_as_float(u & 0xffff0000u); }

constexpr size_t MiB = 1u << 20;
constexpr size_t WS_CTL = 0, CTL_ZERO_BYTES = 64 * 1024;
constexpr size_t WS_LIST = 2 * MiB;
constexpr size_t WS_KB = 6 * MiB;
constexpr size_t WS_TOKPOS = 10 * MiB;
constexpr size_t WS_TOKGATE = 10 * MiB + 512 * 1024;
constexpr size_t WS_KMEAN = 11 * MiB;
constexpr size_t WS_MEMB = 12 * MiB;
constexpr size_t WS_VT = 16 * MiB;
constexpr size_t WS_WIN0 = 24 * MiB, WS_WIN1 = 31 * MiB;
constexpr size_t WS_WOUT = 38 * MiB, WS_WQ = 42 * MiB, WS_WKV = 46 * MiB, WS_WO = 54 * MiB;
constexpr size_t WS_WEXP = 58 * MiB;
constexpr size_t WS_XL1 = 154 * MiB, WS_XB = 218 * MiB, WS_VFIRST = 250 * MiB;
constexpr size_t WS_Z = 266 * MiB, WS_MIX = 378 * MiB, WS_R3 = 410 * MiB, WS_END = 508 * MiB;
constexpr int REC_TG = 644;
constexpr size_t WS_REC = 410 * MiB;
constexpr size_t WS_YRAW = 492 * MiB;
constexpr size_t WS_RVT = 154 * MiB, WS_RG = 170 * MiB;
constexpr size_t WS_BON = 20 * MiB;
constexpr size_t WS_LORA = 22 * MiB;
constexpr size_t LORA_L = 512 * 288 * 2, LORA_I = 512 * 64 * 2, LORA_G = 2 * 512 * 64 * 2, LORA_V = LORA_G + 512 * 128 * 2;
constexpr size_t WS_LSUM = 21 * MiB;
constexpr size_t WS_P = 298 * MiB;
constexpr size_t WS_PRE = 266 * MiB, WS_X1 = 410 * MiB, WS_X1B = 474 * MiB;
constexpr size_t WS_Q = 330 * MiB, WS_KV = 362 * MiB, WS_O = 266 * MiB, WS_PRE2 = 330 * MiB;
constexpr size_t WS_X2 = 410 * MiB, WS_X2B = 474 * MiB;
constexpr size_t WS_H = 266 * MiB, WS_Y = 306 * MiB;

constexpr int CW_CNT = 0;
constexpr int CW_BAR = 1024;

#define XB_TMO      128
#define XB_XCNT(j)  (256  + 64 * (j))
#define XB_XSUB(j)  (1280 + 64 * (j))
#define XB_XGEN(j)  (2304 + 64 * (j))
#define XB_TOP      3328
#define XB_TOPGEN   3392
#define XCD_BAR_WORDS 3456
#define XB_SPIN_CAP (1u << 18)
#define LAS __attribute__((address_space(3)))
__device__ __forceinline__ unsigned xb_ld(unsigned* p)              { return __hip_atomic_load(p, __ATOMIC_RELAXED, __HIP_MEMORY_SCOPE_AGENT); }
__device__ __forceinline__ unsigned xb_add(unsigned* p, unsigned v) { return __hip_atomic_fetch_add(p, v, __ATOMIC_RELAXED, __HIP_MEMORY_SCOPE_AGENT); }
__device__ __forceinline__ unsigned xb_xcc_id() { return (unsigned)__builtin_amdgcn_s_getreg((3 << 11) | 20) & 0xFu; }
#define XB_SPIN(cond, bar) do { unsigned _sp = 0; while (cond) { __builtin_amdgcn_s_sleep(1); \
    if ((++_sp & 255u) == 0u) { if (xb_ld(&(bar)[XB_TMO])) break; if (_sp > XB_SPIN_CAP) { atomicAdd(&(bar)[XB_TMO], 1u); break; } } } } while (0)
struct XcdBarrier { unsigned* bar; unsigned x; volatile LAS unsigned* st; };
__device__ __forceinline__ XcdBarrier xcd_barrier_post(unsigned* bar, volatile LAS unsigned* st) {
    XcdBarrier b; b.bar = bar; b.x = xb_xcc_id(); b.st = st;
    if (threadIdx.x == 0) (void)xb_add(&bar[XB_XCNT(b.x)], 1u);
    return b;
}
__device__ __forceinline__ void xcd_barrier_complete(unsigned* bar, unsigned x, unsigned& nloc, unsigned& nx) {
    const unsigned G = gridDim.x * gridDim.y * gridDim.z;
    unsigned sum, cnt, mine, sp = 0u;
    for (;;) {
        sum = 0u; cnt = 0u; mine = 0u;
#pragma unroll
        for (unsigned j = 0; j < 16; ++j) { const unsigned c = xb_ld(&bar[XB_XCNT(j)]); sum += c; cnt += (c > 0u) ? 1u : 0u; mine = (j == x) ? c : mine; }
        if (sum == G) break;
        __builtin_amdgcn_s_sleep(1);
        if ((++sp & 255u) == 0u) { if (xb_ld(&bar[XB_TMO])) break; if (sp > XB_SPIN_CAP) { atomicAdd(&bar[XB_TMO], 1u); break; } }
    }
    nloc = mine > 0u ? mine : 1u; nx = cnt > 0u ? cnt : 1u;
}
__device__ __forceinline__ void xcd_barrier(const XcdBarrier& b) {
    asm volatile("s_waitcnt vmcnt(0)" ::: "memory");
    __syncthreads();
    if (threadIdx.x == 0) {
        unsigned* bar = b.bar;
        __builtin_amdgcn_s_waitcnt(0);
        unsigned nloc = b.st[0], nx = b.st[1];
        if (nloc == 0u) { xcd_barrier_complete(bar, b.x, nloc, nx); b.st[0] = nloc; b.st[1] = nx; }
        const unsigned old = xb_add(&bar[XB_XSUB(b.x)], 1u);
        const unsigned gen = old / nloc;
        if (old + 1u == (gen + 1u) * nloc) {
            __builtin_amdgcn_fence(__ATOMIC_RELEASE, "agent");
            asm volatile("s_waitcnt vmcnt(0)" ::: "memory");
            const unsigned og = xb_add(&bar[XB_TOP], 1u);
            const unsigned tg = og / nx;
            if (og + 1u == (tg + 1u) * nx) xb_add(&bar[XB_TOPGEN], 1u);
            else XB_SPIN(xb_ld(&bar[XB_TOPGEN]) == tg, bar);
            __builtin_amdgcn_fence(__ATOMIC_ACQUIRE, "agent");
            xb_add(&bar[XB_XGEN(b.x)], 1u);
            asm volatile("s_waitcnt vmcnt(0)" ::: "memory");
        } else {
            XB_SPIN(xb_ld(&bar[XB_XGEN(b.x)]) == gen, bar);
            __builtin_amdgcn_fence(__ATOMIC_ACQUIRE, "agent");
            asm volatile("s_waitcnt vmcnt(0)" ::: "memory");
        }
    }
    __syncthreads();
}

__device__ __forceinline__ int tid_fresh() { int t = threadIdx.x; asm volatile("" : "+v"(t)); return t; }
template <int CTRL> __device__ __forceinline__ float dppf(float v) { return __int_as_float(__builtin_amdgcn_mov_dpp(__float_as_int(v), CTRL, 0xF, 0xF, true)); }
__device__ __forceinline__ float wsum(float v) {
    v += dppf<0xB1>(v); v += dppf<0x4E>(v); v += dppf<0x141>(v); v += dppf<0x140>(v);
    auto r16 = __builtin_amdgcn_permlane16_swap(__float_as_uint(v), __float_as_uint(v), false, false); v = __uint_as_float(r16[0]) + __uint_as_float(r16[1]);
    auto r32 = __builtin_amdgcn_permlane32_swap(__float_as_uint(v), __float_as_uint(v), false, false); v = __uint_as_float(r32[0]) + __uint_as_float(r32[1]);
    return v;
}
__device__ __forceinline__ float wmax(float v) {
#pragma unroll
    for (int o = 32; o > 0; o >>= 1) v = fmaxf(v, __shfl_xor(v, o));
    return v;
}
__device__ __forceinline__ float sigmoidf_(float x) { return 1.0f / (1.0f + __expf(-x)); }
__device__ __forceinline__ float sigmoid_fast(float x) { return __builtin_amdgcn_rcpf(1.0f + __expf(-x)); }
__device__ __forceinline__ float softplusf_(float x) { return x > 20.f ? x : log1pf(__expf(x)); }

struct Args {
    const float* in[30];
    float* out;
    unsigned char* ws;
    int ph_lo, ph_hi;
};

namespace pg8 {
#define PG8_LAS __attribute__((address_space(3)))
typedef short bf16x8 __attribute__((ext_vector_type(8)));
typedef float f32x4 __attribute__((ext_vector_type(4)));
typedef unsigned u32x4 __attribute__((ext_vector_type(4)));
constexpr int BM = 256, BK = 64, HALF = 128, HTB = HALF * BK * 2, STAGE_BYTES = 8 * HTB, NXCD = 8, WGM = 8;

__host__ __device__ __forceinline__ int lds_byte(int r, int c) { const int st = (r >> 4) * 2 + (c >> 5), rr = r & 15, cc = c & 31, ob = rr * 64 + cc * 2; return st * 1024 + (ob ^ (((ob >> 9) & 1) << 5)); }
__host__ __device__ __forceinline__ void stage_rc(int b, int& R, int& C) { const int st = b / 1024, sb = b % 1024, swz = sb ^ (((sb >> 9) & 1) << 5); R = (st >> 1) * 16 + swz / 64; C = (st & 1) * 32 + (swz % 64) / 2; }
__host__ __device__ __forceinline__ int perm32(int rho) { const int n = rho >> 4, i = rho & 15; return 8 * (i >> 2) + 4 * n + (i & 3); }

struct Unit { const char* A; const char* B; int row0, col0, aux, aux2; };
struct Dims { int lda, ldb, K; };

struct TileOrder {
    int nM, nN, nwg, G, c;
    __device__ void init(int nM_, int nN_, int G_, int c_) { nM = nM_; nN = nN_; nwg = nM * nN; G = G_; c = c_; }
    __device__ bool tile(int i, int& pm, int& pn) const {
        const long L = (long)i * G + c; if (L >= nwg) return false;
        int wgid = (int)L; { const int q = nwg / NXCD, r = nwg % NXCD, xcd = wgid % NXCD, off = wgid / NXCD; wgid = (xcd < r ? xcd * (q + 1) : r * (q + 1) + (xcd - r) * q) + off; }
        const int nig = WGM * nN, gid = wgid / nig, fm = gid * WGM, gsz = (nM - fm) < WGM ? (nM - fm) : WGM;
        pm = fm + ((wgid % nig) % gsz); pn = (wgid % nig) / gsz; return true;
    }
};
struct DenseSched {
    TileOrder o; const char* A; const char* B; int lda, ldb;
    __device__ void init(const void* A_, int lda_, int M, const void* B_, int ldb_, int N) { A = (const char*)A_; B = (const char*)B_; lda = lda_; ldb = ldb_; o.init(M / BM, N / BM, gridDim.x, blockIdx.x); }
    __device__ __forceinline__ bool next(int i, Unit& u) const { int pm, pn; if (!o.tile(i, pm, pn)) return false;
        u.A = A + (size_t)pm * BM * lda * 2; u.B = B + (size_t)pn * BM * ldb * 2; u.row0 = pm * BM; u.col0 = pn * BM; u.aux = 0; u.aux2 = 0; return true; }
    __device__ __forceinline__ int arow(const Unit&, int r) const { return r; }
};

__device__ __forceinline__ unsigned cvt_pk_bf16(float lo, float hi) { unsigned r; asm volatile("v_cvt_pk_bf16_f32 %0, %1, %2" : "=v"(r) : "v"(lo), "v"(hi)); return r; }

struct EpiBf16 {
    static constexpr bool PERM = true;
    bf16_t* O; int ldc;
    __device__ __forceinline__ void operator()(const f32x4 (&acc)[2][2][4][2], const Unit& u, int wr, int wc, int fr, int fq) const {
        const int row0 = u.row0 + wr * 64 + fr, col0 = u.col0 + wc * 32 + 8 * fq;
#pragma unroll
        for (int ai = 0; ai < 2; ++ai)
#pragma unroll
            for (int m = 0; m < 4; ++m) { bf16_t* rowp = O + (size_t)(row0 + ai * HALF + m * 16) * ldc + col0;
#pragma unroll
                for (int bj = 0; bj < 2; ++bj) { const f32x4 v0 = acc[ai][bj][m][0], v1 = acc[ai][bj][m][1];
                    u32x4 w; w.x = cvt_pk_bf16(v0[0], v0[1]); w.y = cvt_pk_bf16(v0[2], v0[3]); w.z = cvt_pk_bf16(v1[0], v1[1]); w.w = cvt_pk_bf16(v1[2], v1[3]);
                    *(u32x4*)(rowp + bj * HALF) = w; } }
    }
};
struct EpiF32Res {
    static constexpr bool PERM = false;
    float* C; const float* RES; int ldc; float rs; const bf16_t* RESB;
    __device__ __forceinline__ void operator()(const f32x4 (&acc)[2][2][4][2], const Unit& u, int wr, int wc, int fr, int fq) const {
        const int row0 = u.row0 + wr * 64 + fr, col0 = u.col0 + wc * 32 + 4 * fq;
#pragma unroll
        for (int ai = 0; ai < 2; ++ai)
#pragma unroll
            for (int m = 0; m < 4; ++m) { const size_t ro = (size_t)(row0 + ai * HALF + m * 16) * ldc + col0;
#pragma unroll
                for (int bj = 0; bj < 2; ++bj)
#pragma unroll
                    for (int n = 0; n < 2; ++n) { f32x4 r;
                        if (RESB) { const uint2 rb = *(const uint2*)(RESB + ro + bj * HALF + n * 16); r = (f32x4){bflo(rb.x), bfhi(rb.x), bflo(rb.y), bfhi(rb.y)}; }
                        else r = *(const f32x4*)(RES + ro + bj * HALF + n * 16);
                        *(f32x4*)(C + ro + bj * HALF + n * 16) = acc[ai][bj][m][n] + r * rs; } }
    }
};

struct EpiBf16Res {
    static constexpr bool PERM = true;
    bf16_t* O; const float* RES; int ldc; float rs; const bf16_t* RESB;
    __device__ __forceinline__ void operator()(const f32x4 (&acc)[2][2][4][2], const Unit& u, int wr, int wc, int fr, int fq) const {
        const int row0 = u.row0 + wr * 64 + fr, col0 = u.col0 + wc * 32 + 8 * fq;
#pragma unroll
        for (int ai = 0; ai < 2; ++ai)
#pragma unroll
            for (int m = 0; m < 4; ++m) { const size_t ro = (size_t)(row0 + ai * HALF + m * 16) * ldc + col0;
#pragma unroll
                for (int bj = 0; bj < 2; ++bj) { f32x4 r0, r1;
                    if (RESB) { const uint4 rb = *(const uint4*)(RESB + ro + bj * HALF); r0 = (f32x4){bflo(rb.x), bfhi(rb.x), bflo(rb.y), bfhi(rb.y)}; r1 = (f32x4){bflo(rb.z), bfhi(rb.z), bflo(rb.w), bfhi(rb.w)}; }
                    else { r0 = *(const f32x4*)(RES + ro + bj * HALF); r1 = *(const f32x4*)(RES + ro + bj * HALF + 4); }
                    const f32x4 v0 = acc[ai][bj][m][0] + r0 * rs, v1 = acc[ai][bj][m][1] + r1 * rs;
                    u32x4 w; w.x = cvt_pk_bf16(v0[0], v0[1]); w.y = cvt_pk_bf16(v0[2], v0[3]); w.z = cvt_pk_bf16(v1[0], v1[1]); w.w = cvt_pk_bf16(v1[2], v1[3]);
                    *(u32x4*)(O + ro + bj * HALF) = w; } }
    }
};

__device__ __forceinline__ void store_bf16_tile(const f32x4 (&acc)[2][2][4][2], bf16_t* O, int ldc, int row0, int col0) {
#pragma unroll
    for (int ai = 0; ai < 2; ++ai)
#pragma unroll
        for (int m = 0; m < 4; ++m) { bf16_t* rowp = O + (size_t)(row0 + ai * HALF + m * 16) * ldc + col0;
#pragma unroll
            for (int bj = 0; bj < 2; ++bj) { const f32x4 v0 = acc[ai][bj][m][0], v1 = acc[ai][bj][m][1];
                u32x4 w; w.x = cvt_pk_bf16(v0[0], v0[1]); w.y = cvt_pk_bf16(v0[2], v0[3]); w.z = cvt_pk_bf16(v1[0], v1[1]); w.w = cvt_pk_bf16(v1[2], v1[3]);
                *(u32x4*)(rowp + bj * HALF) = w; } }
}
struct EpiG1 {
    static constexpr bool PERM = true;
    bf16_t* Z; bf16_t* KB; bf16_t* VT;
    __device__ __forceinline__ void operator()(const f32x4 (&acc)[2][2][4][2], const Unit& u, int wr, int wc, int fr, int fq) const {
        bf16_t* O = Z; int ldc = ZLD;
        if (u.aux == 1) { O = KB; ldc = 1024; } else if (u.aux >= 2) { O = VT + (size_t)(u.aux - 2) * 1024 * 256; ldc = 256; }
        store_bf16_tile(acc, O, ldc, u.row0 + wr * 64 + fr, u.col0 + wc * 32 + 8 * fq);
    }
};
struct EpiSoftmax {
    static constexpr bool PERM = true;
    bf16_t* P; float* LSUM; PG8_LAS float* xmax;
    __device__ __forceinline__ void operator()(const f32x4 (&acc)[2][2][4][2], const Unit& u, int wr, int wc, int fr, int fq) const {
        const float c = 0.0625f * 1.4426950408889634f;
#pragma unroll
        for (int ai = 0; ai < 2; ++ai)
#pragma unroll
            for (int m = 0; m < 4; ++m) {
                float mx = acc[ai][0][m][0][0];
#pragma unroll
                for (int bj = 0; bj < 2; ++bj)
#pragma unroll
                    for (int n = 0; n < 2; ++n)
#pragma unroll
                        for (int j = 0; j < 4; ++j) mx = fmaxf(mx, acc[ai][bj][m][n][j]);
                mx = fmaxf(mx, __shfl_xor(mx, 16)); mx = fmaxf(mx, __shfl_xor(mx, 32));
                if (fq == 0) xmax[wc * 256 + wr * 64 + fr + ai * 128 + m * 16] = mx;
            }
        asm volatile("s_waitcnt lgkmcnt(0)" ::: "memory"); __builtin_amdgcn_s_barrier(); asm volatile("" ::: "memory");
        const int hm = u.col0 >> 8;
#pragma unroll
        for (int ai = 0; ai < 2; ++ai)
#pragma unroll
            for (int m = 0; m < 4; ++m) {
                int r = wr * 64 + fr + ai * 128 + m * 16; asm volatile("" : "+v"(r) :: "memory");
                const float M = fmaxf(fmaxf(xmax[r], xmax[256 + r]), fmaxf(xmax[512 + r], xmax[768 + r]));
                float sum = 0.f; bf16_t* rowp = P + (size_t)(u.row0 + r) * 1024 + u.col0 + wc * 32 + 8 * fq;
#pragma unroll
                for (int bj = 0; bj < 2; ++bj) {
                    float e[8];
#pragma unroll
                    for (int n = 0; n < 2; ++n)
#pragma unroll
                        for (int j = 0; j < 4; ++j) { e[n * 4 + j] = __builtin_amdgcn_exp2f((acc[ai][bj][m][n][j] - M) * c); sum += e[n * 4 + j]; }
                    u32x4 w; w.x = pk2(e[0], e[1]); w.y = pk2(e[2], e[3]); w.z = pk2(e[4], e[5]); w.w = pk2(e[6], e[7]);
                    *(u32x4*)(rowp + bj * HALF) = w;
                }
                sum += __shfl_xor(sum, 16); sum += __shfl_xor(sum, 32);
                if (fq == 0) LSUM[((size_t)(u.row0 + r) * 4 + hm) * 4 + wc] = sum;
            }
        asm volatile("s_waitcnt lgkmcnt(0)" ::: "memory"); __builtin_amdgcn_s_barrier(); asm volatile("" ::: "memory");
    }
};
struct EpiPV {
    static constexpr bool PERM = true;
    bf16_t* O; const float* LSUM;
    __device__ __forceinline__ void operator()(const f32x4 (&acc)[2][2][4][2], const Unit& u, int wr, int wc, int fr, int fq) const {
        const int hm = u.col0 >> 8;
#pragma unroll
        for (int ai = 0; ai < 2; ++ai)
#pragma unroll
            for (int m = 0; m < 4; ++m) {
                int row = u.row0 + wr * 64 + fr + ai * 128 + m * 16; asm volatile("" : "+v"(row) :: "memory");
                const f32x4 ls = *(const f32x4*)(LSUM + ((size_t)row * 4 + hm) * 4);
                const float inv = 1.0f / ((ls[0] + ls[1]) + (ls[2] + ls[3]));
                bf16_t* rowp = O + (size_t)row * 1024 + u.col0 + wc * 32 + 8 * fq;
#pragma unroll
                for (int bj = 0; bj < 2; ++bj) { const f32x4 v0 = acc[ai][bj][m][0] * inv, v1 = acc[ai][bj][m][1] * inv;
                    u32x4 w; w.x = cvt_pk_bf16(v0[0], v0[1]); w.y = cvt_pk_bf16(v0[2], v0[3]); w.z = cvt_pk_bf16(v1[0], v1[1]); w.w = cvt_pk_bf16(v1[2], v1[3]);
                    *(u32x4*)(rowp + bj * HALF) = w; }
            }
    }
};
struct G1Sched {
    TileOrder o; const char *XB, *WIN, *MEMB, *WKV;
    __device__ void init(const void* XB_, const void* WIN_, int nN, const void* MEMB_, const void* WKV_) { XB = (const char*)XB_; WIN = (const char*)WIN_; MEMB = (const char*)MEMB_; WKV = (const char*)WKV_; o.init(64, nN, gridDim.x, blockIdx.x); }
    __device__ __forceinline__ bool next(int i, Unit& u) const {
        int pm, pn; u.aux2 = 0;
        if (o.tile(i, pm, pn)) { u.A = XB + (size_t)pm * BM * 2048; u.B = WIN + (size_t)pn * BM * 2048; u.row0 = pm * BM; u.col0 = pn * BM; u.aux = 0; return true; }
        const long L = (long)i * o.G + o.c - o.nwg;
        if (L >= 64) return false;
        if (L < 32) { pm = (int)L >> 2; pn = (int)L & 3; u.A = MEMB + (size_t)pm * BM * 2048; u.B = WKV + (size_t)pn * BM * 2048; u.row0 = pm * BM; u.col0 = pn * BM; u.aux = 1; return true; }
        const int b = ((int)L - 32) >> 2; pm = ((int)L - 32) & 3;
        u.A = WKV + (size_t)(1024 + pm * BM) * 2048; u.B = MEMB + (size_t)b * BM * 2048; u.row0 = pm * BM; u.col0 = 0; u.aux = 2 + b; return true;
    }
    __device__ __forceinline__ int arow(const Unit&, int r) const { return r; }
};
struct MattSched {
    int G, c; const char* A; const char* B; size_t b_batch; int b_head;
    __device__ void init(const void* A_, const void* B_, size_t b_batch_, int b_head_) { G = gridDim.x; c = blockIdx.x; A = (const char*)A_; B = (const char*)B_; b_batch = b_batch_; b_head = b_head_; }
    __device__ __forceinline__ bool next(int i, Unit& u) const {
        const long L = (long)i * G + c; if (L >= 256) return false;
        const int pm = (int)L >> 2, hm = (int)L & 3;
        u.A = A + ((size_t)pm * BM * 1024 + hm * 256) * 2; u.B = B + (size_t)(pm >> 3) * b_batch + (size_t)hm * b_head;
        u.row0 = pm * BM; u.col0 = hm * 256; u.aux = 0; u.aux2 = 0; return true;
    }
    __device__ __forceinline__ int arow(const Unit&, int r) const { return r; }
};

template <class Epi, class Sched, bool GATHER>
__device__ __forceinline__ void gemm_phase(PG8_LAS unsigned char* lds, const Dims g, const Sched& S, const Epi& E) {
    const int tid = tid_fresh(), wid = __builtin_amdgcn_readfirstlane(tid >> 6), wr = wid >> 2, wc = wid & 3;
    const int K = g.K, nt = K / BK;
    unsigned voffB[2];
#pragma unroll
    for (int i = 0; i < 2; ++i) { int R, C; stage_rc(tid * 16 + i * 8192, R, C); const int Rb = Epi::PERM ? ((R & ~31) + perm32(R & 31)) : R;
        voffB[i] = (unsigned)(Rb * g.ldb + C) * 2u; }
    const size_t kstep = (size_t)(BK * 2);
    const size_t hstepB = (size_t)HALF * g.ldb * 2;
    const unsigned ldsw = (unsigned)wid * 1024u;
    const int aoff = lds_byte(wr * 64 + (tid & 15), ((tid & 63) >> 4) * 8), boff = lds_byte(wc * 32 + (tid & 15), ((tid & 63) >> 4) * 8);
    const size_t hstepA = GATHER ? 0 : (size_t)HALF * g.lda * 2;
#define PG8_SA(b, h) (((b) * 2 + (h)) * HTB)
#define PG8_SB(b, h) ((4 + (b) * 2 + (h)) * HTB)
#define PG8_STAGE(bufoff, gbase, v0, v1) do { \
        __builtin_amdgcn_global_load_lds((const unsigned*)((const char*)(gbase) + (v0)), (PG8_LAS unsigned*)(lds + (bufoff) + ldsw), 16, 0, 0); \
        __builtin_amdgcn_global_load_lds((const unsigned*)((const char*)(gbase) + (v1)), (PG8_LAS unsigned*)(lds + (bufoff) + ldsw + 8192), 16, 0, 0); } while (0)
#define PG8_STAGEB(bufoff, gbase) PG8_STAGE(bufoff, gbase, voffB[0], voffB[1])
#define PG8_LDA(dst, b, h) do { _Pragma("unroll") for (int m = 0; m < 4; ++m) _Pragma("unroll") for (int k = 0; k < 2; ++k) dst[m][k] = *(const PG8_LAS bf16x8*)(lds + PG8_SA(b, h) + aoff + m * 2048 + k * 1024); } while (0)
#define PG8_LDB(dst, b, h) do { _Pragma("unroll") for (int n = 0; n < 2; ++n) _Pragma("unroll") for (int k = 0; k < 2; ++k) dst[n][k] = *(const PG8_LAS bf16x8*)(lds + PG8_SB(b, h) + boff + n * 2048 + k * 1024); } while (0)
#define PG8_MMA(ai, bj, At, Bt) do { __builtin_amdgcn_s_setprio(1); _Pragma("unroll") for (int m = 0; m < 4; ++m) _Pragma("unroll") for (int n = 0; n < 2; ++n) _Pragma("unroll") for (int k = 0; k < 2; ++k) \
        acc[ai][bj][m][n] = __builtin_amdgcn_mfma_f32_16x16x32_bf16(Bt[n][k], At[m][k], acc[ai][bj][m][n], 0, 0, 0); __builtin_amdgcn_s_setprio(0); } while (0)
#define PG8_WAIT_V(n) asm volatile("s_waitcnt vmcnt(" #n ")" ::: "memory")
#define PG8_WAIT_L(n) asm volatile("s_waitcnt lgkmcnt(" #n ")" ::: "memory")
#define PG8_BAR __builtin_amdgcn_s_barrier()
#define PG8_SCHED __builtin_amdgcn_sched_barrier(0)
#define PG8_VOFFA(dst, u) do { _Pragma("unroll") for (int i_ = 0; i_ < 2; ++i_) { int R_, C_; stage_rc(tid * 16 + i_ * 8192, R_, C_); _Pragma("unroll") for (int h_ = 0; h_ < 2; ++h_) { \
        const int rr_ = GATHER ? S.arow(u, R_ + h_ * HALF) : R_; dst[h_ * 2 + i_] = (unsigned)(rr_ * g.lda + C_) * 2u; } } } while (0)
    Unit cur, nxt; int ui = 0;
    if (!S.next(0, cur)) return;
    f32x4 acc[2][2][4][2];
#pragma unroll
    for (int a = 0; a < 2; ++a)
#pragma unroll
        for (int b = 0; b < 2; ++b)
#pragma unroll
            for (int m = 0; m < 4; ++m)
#pragma unroll
                for (int n = 0; n < 2; ++n) acc[a][b][m][n] = (f32x4){0.f, 0.f, 0.f, 0.f};
    bf16x8 At[4][2], B0[2][2], B1[2][2];
    unsigned vC[4];
    PG8_VOFFA(vC, cur);
    PG8_LAS u32x4* myN = (PG8_LAS u32x4*)(lds + STAGE_BYTES + tid * 16);
    const char* cA = cur.A; const char* cB = cur.B;
    PG8_STAGEB(PG8_SB(0, 0), cB); PG8_STAGEB(PG8_SB(0, 1), cB + hstepB); PG8_STAGE(PG8_SA(0, 0), cA, vC[0], vC[1]); PG8_STAGE(PG8_SA(0, 1), cA + hstepA, vC[2], vC[3]);
    if (wr == 1) PG8_BAR;
    PG8_WAIT_V(2); PG8_BAR;
    PG8_STAGEB(PG8_SB(1, 0), cB + kstep); PG8_STAGE(PG8_SA(1, 0), cA + kstep, vC[0], vC[1]); PG8_STAGEB(PG8_SB(1, 1), cB + hstepB + kstep);
    PG8_WAIT_V(6); PG8_BAR;
    for (;;) {
        const bool has_next = S.next(ui + 1, nxt);
        const char* nA = cA; const char* nB = cB;
        { unsigned vT[4];
#pragma unroll
          for (int q = 0; q < 4; ++q) vT[q] = vC[q];
          if (has_next) { nA = nxt.A; nB = nxt.B; PG8_VOFFA(vT, nxt); }
          *myN = (u32x4){vT[0], vT[1], vT[2], vT[3]}; }
#pragma unroll 1
        for (int t = 0; t < nt; t += 2) {
            const bool last = (t == nt - 2);
            const char* a1 = cA + (size_t)(t + 1) * kstep;
            const char* a2 = last ? nA : cA + (size_t)(t + 2) * kstep; const char* b2 = last ? nB : cB + (size_t)(t + 2) * kstep;
            const char* a3 = a2 + kstep; const char* b3 = b2 + kstep;
            PG8_LDB(B0, 0, 0); PG8_LDB(B1, 0, 1); PG8_SCHED; PG8_LDA(At, 0, 0); PG8_STAGE(PG8_SA(1, 1), a1 + hstepA, vC[2], vC[3]);
            if (last) { const u32x4 vn = *myN; vC[0] = vn.x; vC[1] = vn.y; vC[2] = vn.z; vC[3] = vn.w; }
            PG8_WAIT_V(8); PG8_WAIT_L(0); PG8_BAR; PG8_MMA(0, 0, At, B0); PG8_MMA(0, 1, At, B1); PG8_BAR; PG8_SCHED;
            PG8_LDA(At, 0, 1); PG8_STAGEB(PG8_SB(0, 0), b2); PG8_STAGEB(PG8_SB(0, 1), b2 + hstepB); PG8_STAGE(PG8_SA(0, 0), a2, vC[0], vC[1]);
            PG8_WAIT_V(8); PG8_WAIT_L(0); PG8_BAR; PG8_MMA(1, 0, At, B0); PG8_MMA(1, 1, At, B1); PG8_BAR; PG8_SCHED;
            PG8_LDB(B0, 1, 0); PG8_LDB(B1, 1, 1); PG8_SCHED; PG8_LDA(At, 1, 0); PG8_STAGE(PG8_SA(0, 1), a2 + hstepA, vC[2], vC[3]);
            PG8_WAIT_V(8); PG8_WAIT_L(0); PG8_BAR; PG8_MMA(0, 0, At, B0); PG8_MMA(0, 1, At, B1); PG8_BAR; PG8_SCHED;
            PG8_LDA(At, 1, 1); PG8_STAGEB(PG8_SB(1, 0), b3); PG8_STAGEB(PG8_SB(1, 1), b3 + hstepB); PG8_STAGE(PG8_SA(1, 0), a3, vC[0], vC[1]);
            PG8_WAIT_V(8); PG8_WAIT_L(0); PG8_BAR; PG8_MMA(1, 0, At, B0); PG8_MMA(1, 1, At, B1); PG8_BAR; PG8_SCHED;
        }
        if (wr == 0) PG8_BAR;
        { int ln_ = (int)__builtin_amdgcn_mbcnt_hi(~0u, __builtin_amdgcn_mbcnt_lo(~0u, 0u)); asm volatile("" : "+v"(ln_));
          E(acc, cur, wr, wc, ln_ & 15, ln_ >> 4); }
        if (!has_next) break;
#pragma unroll
        for (int a = 0; a < 2; ++a)
#pragma unroll
            for (int b = 0; b < 2; ++b)
#pragma unroll
                for (int m = 0; m < 4; ++m)
#pragma unroll
                    for (int n = 0; n < 2; ++n) acc[a][b][m][n] = (f32x4){0.f, 0.f, 0.f, 0.f};
        cur = nxt; cA = nA; cB = nB; ++ui;
        if (wr == 1) PG8_BAR;
    }
    PG8_WAIT_V(0);
    PG8_BAR;
#undef PG8_SA
#undef PG8_SB
#undef PG8_STAGE
#undef PG8_STAGEB
#undef PG8_LDA
#undef PG8_LDB
#undef PG8_MMA
#undef PG8_WAIT_V
#undef PG8_WAIT_L
#undef PG8_BAR
#undef PG8_SCHED
#undef PG8_VOFFA
}
}

template <int NBM, class AF, class Epi>
__device__ __forceinline__ void sgemm_tile(float* lds, int K, AF arow, const float* __restrict__ B0, const float* __restrict__ B1, int ldb, int n0, int N, Epi epi) {
    const int tid = tid_fresh();
    float* As = lds;
    float* Bs0 = lds + 16 * 132;
    float* Bs1 = lds + 2 * 16 * 132;
    const int ty = tid >> 5, tx = tid & 31;
    float acc0[8][4], acc1[8][4];
#pragma unroll
    for (int i = 0; i < 8; ++i)
#pragma unroll
        for (int j = 0; j < 4; ++j) { acc0[i][j] = 0.f; acc1[i][j] = 0.f; }
    const int ar = tid >> 2, ak = (tid & 3) * 4;
    const float* ap = arow(ar);
    const int bk = tid >> 5, bn = (tid & 31) * 4;
    const bool bok = (n0 + bn) < N;
    for (int k0 = 0; k0 < K; k0 += 16) {
        float4 av = ap ? *(const float4*)(ap + k0 + ak) : make_float4(0.f, 0.f, 0.f, 0.f);
        float4 bv0 = bok ? *(const float4*)(B0 + (size_t)(k0 + bk) * ldb + n0 + bn) : make_float4(0.f, 0.f, 0.f, 0.f);
        float4 bv1 = make_float4(0.f, 0.f, 0.f, 0.f);
        if (NBM == 2) { if (bok) bv1 = *(const float4*)(B1 + (size_t)(k0 + bk) * ldb + n0 + bn); }
        __syncthreads();
        As[(ak + 0) * 132 + ar] = av.x; As[(ak + 1) * 132 + ar] = av.y; As[(ak + 2) * 132 + ar] = av.z; As[(ak + 3) * 132 + ar] = av.w;
        *(float4*)&Bs0[bk * 132 + bn] = bv0;
        if (NBM == 2) *(float4*)&Bs1[bk * 132 + bn] = bv1;
        __syncthreads();
#pragma unroll 2
        for (int k = 0; k < 16; ++k) {
            const float4 a0 = *(const float4*)&As[k * 132 + ty * 8], a1 = *(const float4*)&As[k * 132 + ty * 8 + 4];
            const float a[8] = {a0.x, a0.y, a0.z, a0.w, a1.x, a1.y, a1.z, a1.w};
            const float4 b0 = *(const float4*)&Bs0[k * 132 + tx * 4];
            const float bb0[4] = {b0.x, b0.y, b0.z, b0.w};
#pragma unroll
            for (int i = 0; i < 8; ++i)
#pragma unroll
                for (int j = 0; j < 4; ++j) acc0[i][j] = fmaf(a[i], bb0[j], acc0[i][j]);
            if (NBM == 2) {
                const float4 b1 = *(const float4*)&Bs1[k * 132 + tx * 4];
                const float bb1[4] = {b1.x, b1.y, b1.z, b1.w};
#pragma unroll
                for (int i = 0; i < 8; ++i)
#pragma unroll
                    for (int j = 0; j < 4; ++j) acc1[i][j] = fmaf(a[i], bb1[j], acc1[i][j]);
            }
        }
    }
    if (bok) {
#pragma unroll
        for (int i = 0; i < 8; ++i)
#pragma unroll
            for (int j = 0; j < 4; ++j) epi(ty * 8 + i, tx * 4 + j, acc0[i][j], acc1[i][j]);
    }
}

__device__ __forceinline__ void transpose_blk(const float* W, int N, bf16_t* WT, int K, int k0, int n0, int drow0, float* scr, int lane) {
    const int kr = lane >> 3, n4 = (lane & 7) * 4;
    float4 v[8];
#pragma unroll
    for (int i = 0; i < 8; ++i) v[i] = *(const float4*)(W + (size_t)(k0 + i * 8 + kr) * N + n0 + n4);
#pragma unroll
    for (int i = 0; i < 8; ++i) { float* d = scr + (i * 8 + kr) * 33 + n4; d[0] = v[i].x; d[1] = v[i].y; d[2] = v[i].z; d[3] = v[i].w; }
    asm volatile("s_waitcnt lgkmcnt(0)" ::: "memory");
    const int c = lane & 7;
#pragma unroll
    for (int j = 0; j < 4; ++j) { const int n = (lane >> 3) + 8 * j; const float* sp = scr + (8 * c) * 33 + n;
        uint4 o; o.x = pk2(sp[0 * 33], sp[1 * 33]); o.y = pk2(sp[2 * 33], sp[3 * 33]); o.z = pk2(sp[4 * 33], sp[5 * 33]); o.w = pk2(sp[6 * 33], sp[7 * 33]);
        *(uint4*)(WT + (size_t)(drow0 + n) * K + k0 + 8 * c) = o; }
    asm volatile("s_waitcnt lgkmcnt(0)" ::: "memory");
}
__device__ __forceinline__ void transpose_item(const float* W, int K, int N, bf16_t* WT, int row_off, float* scr, int item, int lane) {
    const int nblk = N / 32, kb = item / nblk, nb = item % nblk;
    transpose_blk(W, N, WT, K, 64 * kb, 32 * nb, row_off + 32 * nb, scr, lane);
}
struct CvtItem { const float* W; bf16_t* WT; int N, K, k0, n0, drow0; };
__device__ __forceinline__ bool cvt_decode(const Args& a, int l, int it, CvtItem& c) {
    if (it >= NEXP * 768) return false;
    bf16_t* WGU = (bf16_t*)(a.ws + WS_WEXP); bf16_t* WD = WGU + (size_t)NEXP * 1024 * 1024;
    const int e = it / 768; int r = it % 768;
    if (r < 512) {
        const bool up = r >= 256; r &= 255; const int kb = r >> 4, nb = r & 15, n0 = 32 * nb;
        c.W = (up ? a.in[26] : a.in[25]) + ((size_t)l * NEXP + e) * DM * DEXP; c.N = DEXP; c.WT = WGU + (size_t)e * 1024 * 1024; c.K = DM; c.k0 = 64 * kb; c.n0 = n0; c.drow0 = 256 * (n0 >> 7) + (n0 & 127) + (up ? 128 : 0);
    } else {
        r -= 512; const int kb = r >> 5, nb = r & 31;
        c.W = a.in[27] + ((size_t)l * NEXP + e) * DEXP * DM; c.N = DM; c.WT = WD + (size_t)e * 1024 * 512; c.K = DEXP; c.k0 = 64 * kb; c.n0 = 32 * nb; c.drow0 = 32 * nb;
    }
    return true;
}
__device__ __forceinline__ void cvt_load(const CvtItem& c, int lane, float4 (&v)[8]) {
    const int kr = lane >> 3, n4 = (lane & 7) * 4;
#pragma unroll
    for (int i = 0; i < 8; ++i) v[i] = *(const float4*)(c.W + (size_t)(c.k0 + i * 8 + kr) * c.N + c.n0 + n4);
}
__device__ __forceinline__ void cvt_finish(const CvtItem& c, int lane, const float4 (&v)[8], float* scr) {
    const int kr = lane >> 3, n4 = (lane & 7) * 4;
#pragma unroll
    for (int i = 0; i < 8; ++i) { float* d = scr + (i * 8 + kr) * 33 + n4; d[0] = v[i].x; d[1] = v[i].y; d[2] = v[i].z; d[3] = v[i].w; }
    asm volatile("s_waitcnt lgkmcnt(0)" ::: "memory");
    const int cc = lane & 7;
#pragma unroll
    for (int j = 0; j < 4; ++j) { const int n = (lane >> 3) + 8 * j; const float* sp = scr + (8 * cc) * 33 + n;
        uint4 o; o.x = pk2(sp[0 * 33], sp[1 * 33]); o.y = pk2(sp[2 * 33], sp[3 * 33]); o.z = pk2(sp[4 * 33], sp[5 * 33]); o.w = pk2(sp[6 * 33], sp[7 * 33]);
        *(uint4*)(c.WT + (size_t)(c.drow0 + n) * c.K + c.k0 + 8 * cc) = o; }
    asm volatile("s_waitcnt lgkmcnt(0)" ::: "memory");
}
__device__ __forceinline__ void convert_experts(const Args& a, int l, float* lds) {
    const int tid = tid_fresh(), lane = tid & 63, wid = tid >> 6;
    float* scr = lds + wid * (64 * 33);
    const int gw = blockIdx.x * 8 + wid, NGW = gridDim.x * 8;
    bf16_t* WGU = (bf16_t*)(a.ws + WS_WEXP); bf16_t* WD = WGU + (size_t)NEXP * 1024 * 1024;
    for (int it = gw; it < NEXP * 768; it += NGW) {
        const int e = it / 768; int r = it % 768;
        if (r < 512) {
            const bool up = r >= 256; r &= 255; const int kb = r >> 4, nb = r & 15, n0 = 32 * nb;
            const float* W = (up ? a.in[26] : a.in[25]) + ((size_t)l * NEXP + e) * DM * DEXP;
            transpose_blk(W, DEXP, WGU + (size_t)e * 1024 * 1024, DM, 64 * kb, n0, 256 * (n0 >> 7) + (n0 & 127) + (up ? 128 : 0), scr, lane);
        } else {
            r -= 512; const int kb = r >> 5, nb = r & 31;
            const float* W = a.in[27] + ((size_t)l * NEXP + e) * DEXP * DM;
            transpose_blk(W, DM, WD + (size_t)e * 1024 * 512, DEXP, 64 * kb, 32 * nb, 32 * nb, scr, lane);
        }
    }
}
__device__ __forceinline__ void cvt_row(const float* in, bf16_t* out, int lane) {
#pragma unroll
    for (int j = 0; j < 4; ++j) { const float4 v = *(const float4*)(in + j * 256 + lane * 4); uint2 o; o.x = pk2(v.x, v.y); o.y = pk2(v.z, v.w); *(uint2*)(out + j * 256 + lane * 4) = o; }
}
__device__ __forceinline__ void phase_prologue(const Args& a, float* lds) {
    const int tid = tid_fresh(), lane = tid & 63, wid = tid >> 6;
    float* scr = lds + wid * (64 * 33);
    const int gw = blockIdx.x * 8 + wid, NGW = gridDim.x * 8;
    bf16_t* WIN0 = (bf16_t*)(a.ws + WS_WIN0); bf16_t* WIN1 = (bf16_t*)(a.ws + WS_WIN1);
    constexpr int I_IN = 16 * 104, I_VR = 16, I_SQ = 16 * 32, I_KV = 16 * 64;
    constexpr int NITEMS = 2 * I_IN + I_VR + 6 * I_SQ + 2 * I_KV;
    for (int it = gw; it < NITEMS; it += NGW) {
        int r = it;
        if (r < I_IN) { transpose_item(a.in[2], DM, IN_COLS, WIN0, 0, scr, r, lane); continue; } r -= I_IN;
        if (r < I_IN) { transpose_item(a.in[2] + (size_t)DM * IN_COLS, DM, IN_COLS, WIN1, 0, scr, r, lane); continue; } r -= I_IN;
        if (r < I_VR) { transpose_item(a.in[3], DM, 32, WIN1, IN_COLS, scr, r, lane); continue; } r -= I_VR;
        constexpr int I_L = 3 * I_SQ + I_KV;
        const int l = r / I_L; r -= l * I_L;
        if (r < I_SQ) { transpose_item(a.in[19] + (size_t)l * DM * DM, DM, DM, (bf16_t*)(a.ws + WS_WOUT) + (size_t)l * DM * DM, 0, scr, r, lane); continue; } r -= I_SQ;
        if (r < I_SQ) { transpose_item(a.in[20] + (size_t)l * DM * DM, DM, DM, (bf16_t*)(a.ws + WS_WQ) + (size_t)l * DM * DM, 0, scr, r, lane); continue; } r -= I_SQ;
        if (r < I_KV) { transpose_item(a.in[21] + (size_t)l * DM * 2048, DM, 2048, (bf16_t*)(a.ws + WS_WKV) + (size_t)l * DM * 2048, 0, scr, r, lane); continue; } r -= I_KV;
        transpose_item(a.in[22] + (size_t)l * DM * DM, DM, DM, (bf16_t*)(a.ws + WS_WO) + (size_t)l * DM * DM, 0, scr, r, lane);
    }
    for (int r = gw; r < 224; r += NGW) {
#pragma unroll
        for (int j = 0; j < 2; ++j) *(uint4*)(WIN1 + (size_t)(3360 + r) * DM + j * 512 + lane * 8) = make_uint4(0u, 0u, 0u, 0u);
    }
    bf16_t* XB = (bf16_t*)(a.ws + WS_XB); bf16_t* MEMB = (bf16_t*)(a.ws + WS_MEMB);
    for (int m = gw; m < NTOK; m += NGW) cvt_row(a.in[0] + (size_t)m * DM, XB + (size_t)m * DM, lane);
    for (int m = gw; m < NBATCH * MEMLEN; m += NGW) cvt_row(a.in[1] + (size_t)m * DM, MEMB + (size_t)m * DM, lane);
    {
        const int gt = blockIdx.x * NTHREADS + tid, NGT = gridDim.x * NTHREADS;
        for (int idx = gt; idx < 2 * 512 * 288; idx += NGT) {
            const int l = idx / (512 * 288); int r = idx % (512 * 288);
            bf16_t* base = (bf16_t*)(a.ws + WS_LORA + (size_t)l * LORA_L);
            if (r < 512 * 64) { const int n = r >> 6, k = r & 63; base[r] = f2bf(a.in[7][((size_t)l * 64 + k) * 512 + n]); continue; } r -= 512 * 64;
            if (r < 512 * 64) { const int n = r >> 6, k = r & 63; base[512 * 64 + r] = f2bf(a.in[9][((size_t)l * 64 + k) * 512 + n]); continue; } r -= 512 * 64;
            if (r < 512 * 128) { const int n = r >> 7, k = r & 127; base[2 * 512 * 64 + r] = f2bf(a.in[12][((size_t)l * 128 + k) * 512 + n]); continue; } r -= 512 * 128;
            { const int n = r >> 5, k = r & 31; base[2 * 512 * 64 + 512 * 128 + r] = f2bf(a.in[11][(size_t)k * 512 + n]); }
        }
    }
}

__device__ __forceinline__ void phase_g1(const Args& a, int l, PG8_LAS unsigned char* lds) {
    pg8::G1Sched S; S.init(a.ws + WS_XB, a.ws + (l == 0 ? WS_WIN0 : WS_WIN1), l == 0 ? IN_COLS / 256 : ZLD / 256, a.ws + WS_MEMB, a.ws + WS_WKV + (size_t)l * 4 * MiB);
    pg8::EpiG1 E{(bf16_t*)(a.ws + WS_Z), (bf16_t*)(a.ws + WS_KB), (bf16_t*)(a.ws + WS_VT)};
    pg8::gemm_phase<pg8::EpiG1, pg8::G1Sched, false>(lds, pg8::Dims{DM, DM, DM}, S, E);
}
__device__ __forceinline__ void phase_matt_s(const Args& a, PG8_LAS unsigned char* lds) {
    pg8::MattSched S; S.init(a.ws + WS_Q, a.ws + WS_KB, (size_t)256 * 1024 * 2, 256 * 2);
    pg8::EpiSoftmax E{(bf16_t*)(a.ws + WS_P), (float*)(a.ws + WS_LSUM), (PG8_LAS float*)(lds + pg8::STAGE_BYTES + 8192 + 512)};
    pg8::gemm_phase<pg8::EpiSoftmax, pg8::MattSched, false>(lds, pg8::Dims{1024, 1024, 256}, S, E);
}
__device__ __forceinline__ void phase_matt_pv(const Args& a, PG8_LAS unsigned char* lds) {
    pg8::MattSched S; S.init(a.ws + WS_P, a.ws + WS_VT, (size_t)1024 * 256 * 2, 256 * 256 * 2);
    pg8::EpiPV E{(bf16_t*)(a.ws + WS_O), (const float*)(a.ws + WS_LSUM)};
    pg8::gemm_phase<pg8::EpiPV, pg8::MattSched, false>(lds, pg8::Dims{1024, 256, 256}, S, E);
}

typedef _Float16 h8_t __attribute__((ext_vector_type(8)));
typedef _Float16 h2_t __attribute__((ext_vector_type(2)));
__device__ __forceinline__ unsigned pkh2(float lo, float hi) { h2_t v = {(_Float16)lo, (_Float16)hi}; return __builtin_bit_cast(unsigned, v); }
#define SC_DPP(x, ctrl) __int_as_float(__builtin_amdgcn_mov_dpp(__float_as_int(x), ctrl, 0xF, 0xF, true))
__device__ __forceinline__ float sum32(float x) {
    x += SC_DPP(x, 0xB1); x += SC_DPP(x, 0x4E); x += SC_DPP(x, 0x141); x += SC_DPP(x, 0x140);
    return x + __shfl_xor(x, 16);
}
__device__ __forceinline__ void phase_prep(const Args& a, int l, float* lds) {
    typedef short bf16x8 __attribute__((ext_vector_type(8)));
    typedef float f32x16 __attribute__((ext_vector_type(16)));
    const bf16_t* Z = (const bf16_t*)(a.ws + WS_Z);
    const int tid = tid_fresh(), lane = tid & 63, wid = tid >> 6;
    float* KM = (float*)(a.ws + WS_KMEAN);
    for (int u = blockIdx.x * 8 + wid; u < NBATCH * NH * 8; u += gridDim.x * 8) {
        const int nb = u & 7, h = (u >> 3) & 7, b = u >> 6, rg = lane >> 3, ch = lane & 7;
        const bf16_t* p = Z + (size_t)(b * SEQ + nb * 256 + rg) * ZLD + C_K + h * HD + ch * 8;
        float acc[8];
#pragma unroll
        for (int j = 0; j < 8; ++j) acc[j] = 0.f;
#pragma unroll 8
        for (int i = 0; i < 32; ++i) { const uint4 v = *(const uint4*)(p + (size_t)(i * 8) * ZLD);
            acc[0] += bflo(v.x); acc[1] += bfhi(v.x); acc[2] += bflo(v.y); acc[3] += bfhi(v.y); acc[4] += bflo(v.z); acc[5] += bfhi(v.z); acc[6] += bflo(v.w); acc[7] += bfhi(v.w); }
#pragma unroll
        for (int j = 0; j < 8; ++j) { float x = acc[j]; x += __shfl_xor(x, 8); x += __shfl_xor(x, 16); x += __shfl_xor(x, 32); acc[j] = x * (1.0f / 256.0f); }
        if (rg == 0) { *(float4*)(KM + (size_t)u * 64 + ch * 8) = make_float4(acc[0], acc[1], acc[2], acc[3]); *(float4*)(KM + (size_t)u * 64 + ch * 8 + 4) = make_float4(acc[4], acc[5], acc[6], acc[7]); }
    }
    const float* mu = a.in[4] + (size_t)l * 1792;
    const float* muv = a.in[5];
    const bf16_t* WdT = (const bf16_t*)(a.ws + WS_LORA + (size_t)l * LORA_L); const bf16_t* WiT = (const bf16_t*)(a.ws + WS_LORA + (size_t)l * LORA_L + LORA_I);
    const bf16_t* WgT = (const bf16_t*)(a.ws + WS_LORA + (size_t)l * LORA_L + LORA_G); const bf16_t* WvT = (const bf16_t*)(a.ws + WS_LORA + LORA_V);
    unsigned* REC = (unsigned*)(a.ws + WS_REC);
    _Float16* RVT = (_Float16*)(a.ws + WS_RVT); bf16_t* RGp = (bf16_t*)(a.ws + WS_RG); float* BON = (float*)(a.ws + WS_BON);
    bf16_t* VF = (bf16_t*)(a.ws + WS_VFIRST);
    constexpr int PREP_AFR_BYTES = 18 * 64 * 16, PREP_TILE_BYTES = 3 * 33 * 128;
    uint4* afr = (uint4*)lds;
    for (int tb = blockIdx.x; tb < 512; tb += gridDim.x) {
        int lane_t = lane; asm volatile("" : "+v"(lane_t));
        const int r32 = lane_t & 31, hi = lane_t >> 5;
        const int h = wid, t0 = tb * 32, b = t0 / SEQ, tt0 = t0 % SEQ, bh = b * NH + h;
        const size_t tokA = (size_t)t0 + r32;
        const bool firstA = (tt0 == 0) && (r32 == 0);
        const size_t tokP = firstA ? tokA : tokA - 1;
        PG8_LAS unsigned char* tileL = (PG8_LAS unsigned char*)lds + PREP_AFR_BYTES + wid * PREP_TILE_BYTES;
        {
            const int rowl = lane_t >> 3, ch8 = lane_t & 7;
            const size_t tprev = (t0 == 0) ? 0 : (size_t)t0 - 1;
#pragma unroll
            for (int op = 0; op < 3; ++op) {
                const int zc = (op == 0 ? C_R : op == 1 ? C_KR : C_VR) + h * 64;
                if (lane_t < 8) __builtin_amdgcn_global_load_lds((const unsigned*)(Z + tprev * ZLD + zc + lane_t * 8), (PG8_LAS unsigned*)(tileL + (op * 33) * 128), 16, 0, 0);
#pragma unroll
                for (int k = 0; k < 4; ++k)
                    __builtin_amdgcn_global_load_lds((const unsigned*)(Z + ((size_t)t0 + 8 * k + rowl) * ZLD + zc + ch8 * 8), (PG8_LAS unsigned*)(tileL + (op * 33 + 1 + 8 * k) * 128), 16, 0, 0);
            }
        }
        uint4* VFL = (uint4*)(a.ws + WS_VFIRST) + (((size_t)tb * 8 + h) * 2) * 128 + lane_t * 2;
        uint4 vfq[2][2];
        if (l == 1) { vfq[0][0] = VFL[0]; vfq[0][1] = VFL[1]; vfq[1][0] = VFL[128]; vfq[1][1] = VFL[129]; }
        __syncthreads();
#pragma unroll
        for (int m = 0; m < 3; ++m) {
            const int idx = wid + 8 * m;
            if (idx < (l == 1 ? 18 : 16)) {
                int zcol; const float* mup; int act;
                if (idx < 8) { zcol = C_ZG + 16 * idx; mup = mu + (C_ZG - C_R) + 16 * idx; act = 2; }
                else if (idx < 12) { zcol = C_ZW + 16 * (idx - 8); mup = mu + (C_ZW - C_R) + 16 * (idx - 8); act = 1; }
                else if (idx < 16) { zcol = C_ZA + 16 * (idx - 12); mup = mu + (C_ZA - C_R) + 16 * (idx - 12); act = 0; }
                else { zcol = C_ZV + 16 * (idx - 16); mup = muv + 16 * (idx - 16); act = 0; }
                zcol += 8 * hi; mup += 8 * hi;
                const uint4 cu_ = *(const uint4*)(Z + tokA * ZLD + zcol); uint4 pv_ = *(const uint4*)(Z + tokP * ZLD + zcol); if (firstA) pv_ = make_uint4(0u, 0u, 0u, 0u);
                const float4 m0_ = *(const float4*)(mup), m1_ = *(const float4*)(mup + 4);
                float x_[8]; const unsigned cw_[4] = {cu_.x, cu_.y, cu_.z, cu_.w}, pw_[4] = {pv_.x, pv_.y, pv_.z, pv_.w}; const float mm_[8] = {m0_.x, m0_.y, m0_.z, m0_.w, m1_.x, m1_.y, m1_.z, m1_.w};
#pragma unroll
                for (int q_ = 0; q_ < 4; ++q_) { const float c0_ = bflo(cw_[q_]), c1_ = bfhi(cw_[q_]); x_[2 * q_] = c0_ + (bflo(pw_[q_]) - c0_) * mm_[2 * q_]; x_[2 * q_ + 1] = c1_ + (bfhi(pw_[q_]) - c1_) * mm_[2 * q_ + 1]; }
                if (act == 1) {
#pragma unroll
                    for (int q_ = 0; q_ < 8; ++q_) x_[q_] = 1.0f - 2.0f * __builtin_amdgcn_rcpf(__expf(2.0f * x_[q_]) + 1.0f);
                } else if (act == 2) {
#pragma unroll
                    for (int q_ = 0; q_ < 8; ++q_) x_[q_] = __builtin_amdgcn_rcpf(1.0f + __expf(-x_[q_]));
                }
                afr[idx * 64 + lane_t] = make_uint4(pk2(x_[0], x_[1]), pk2(x_[2], x_[3]), pk2(x_[4], x_[5]), pk2(x_[6], x_[7]));
            }
        }
        __syncthreads();
#define PREP_AFRAG(dst, idx_) do { const uint4 q_ = afr[(idx_) * 64 + lane_t]; pg8::u32x4 w_; w_.x = q_.x; w_.y = q_.y; w_.z = q_.z; w_.w = q_.w; dst = __builtin_bit_cast(bf16x8, w_); } while (0)
        const int chB = h * 64 + r32;
#define PREP_TOK(r) int hq_ = hi; asm volatile("" : "+v"(hq_)); const int tq = ((r) & 3) + 8 * ((r) >> 2) + 4 * hq_, t = tt0 + tq; const size_t tok = (size_t)t0 + tq; (void)t; (void)tok
#define PREP_RB(t, j) (((((size_t)bh * 512 + ((t) >> 2)) * 32 + ((j) >> 1)) * 4 + ((t) & 3)) * 5)
        f32x16 acc[2];
#pragma unroll
        for (int nb = 0; nb < 2; ++nb)
#pragma unroll
            for (int r = 0; r < 16; ++r) acc[nb][r] = 0.f;
#pragma unroll 1
        for (int sO = 0; sO < 8; sO += 4) {
            asm volatile("" ::: "memory");
#pragma unroll
            for (int sJ = 0; sJ < 4; ++sJ) { const int sI = sO + sJ;
                bf16x8 af; PREP_AFRAG(af, sI);
#pragma unroll
                for (int nb = 0; nb < 2; ++nb) acc[nb] = __builtin_amdgcn_mfma_f32_32x32x16_bf16(af, *(const bf16x8*)(WgT + (size_t)(chB + 32 * nb) * 128 + 16 * sI + 8 * hi), acc[nb], 0, 0, 0); }
        }
#pragma unroll
        for (int nb = 0; nb < 2; ++nb)
#pragma unroll
            for (int r = 0; r < 16; ++r) { PREP_TOK(r); RGp[tok * 512 + chB + 32 * nb] = f2bf(acc[nb][r]); }
#pragma unroll
        for (int nb = 0; nb < 2; ++nb)
#pragma unroll
            for (int r = 0; r < 16; ++r) acc[nb][r] = 0.f;
        asm volatile("" ::: "memory");
#pragma unroll
        for (int sI = 0; sI < 4; ++sI) {
            bf16x8 af; PREP_AFRAG(af, 8 + sI);
#pragma unroll
            for (int nb = 0; nb < 2; ++nb) acc[nb] = __builtin_amdgcn_mfma_f32_32x32x16_bf16(af, *(const bf16x8*)(WdT + (size_t)(chB + 32 * nb) * 64 + 16 * sI + 8 * hi), acc[nb], 0, 0, 0);
        }
        unsigned UW[2][8];
#pragma unroll
        for (int nb = 0; nb < 2; ++nb) {
            const float w0c = a.in[6][l * 512 + chB + 32 * nb];
#pragma unroll
            for (int g = 0; g < 4; ++g)
#pragma unroll
                for (int ts = 0; ts < 2; ++ts) { float uu[2];
#pragma unroll
                    for (int e = 0; e < 2; ++e) { const float sd = w0c + acc[nb][4 * g + ts + 2 * e]; const float sp = (sd < -15.f) ? -sd : __logf(1.0f + __expf(-sd)); uu[e] = 1.0f - __expf(-__expf(-sp - 0.5f)); }
                    UW[nb][2 * g + ts] = pkh2(uu[0], uu[1]); }
        }
        f32x16 aia[2], vga[2];
#pragma unroll
        for (int nb = 0; nb < 2; ++nb)
#pragma unroll
            for (int r = 0; r < 16; ++r) { aia[nb][r] = 0.f; vga[nb][r] = 0.f; }
        asm volatile("" ::: "memory");
#pragma unroll
        for (int sI = 0; sI < 4; ++sI) {
            bf16x8 af; PREP_AFRAG(af, 12 + sI);
#pragma unroll
            for (int nb = 0; nb < 2; ++nb) aia[nb] = __builtin_amdgcn_mfma_f32_32x32x16_bf16(af, *(const bf16x8*)(WiT + (size_t)(chB + 32 * nb) * 64 + 16 * sI + 8 * hi), aia[nb], 0, 0, 0);
        }
        if (l == 1) {
            asm volatile("" ::: "memory");
#pragma unroll
            for (int sI = 0; sI < 2; ++sI) {
                bf16x8 af; PREP_AFRAG(af, 16 + sI);
#pragma unroll
                for (int nb = 0; nb < 2; ++nb) vga[nb] = __builtin_amdgcn_mfma_f32_32x32x16_bf16(af, *(const bf16x8*)(WvT + (size_t)(chB + 32 * nb) * 32 + 16 * sI + 8 * hi), vga[nb], 0, 0, 0);
            }
        }
#undef PREP_AFRAG
        asm volatile("s_waitcnt vmcnt(0)" ::: "memory");
        float ss[16], bon[16]; unsigned KW[2][8], RW[2][8], QW[2][8], AW[2][8];
#pragma unroll
        for (int r = 0; r < 16; ++r) { ss[r] = 0.f; bon[r] = 0.f; }
#pragma unroll
        for (int nb = 0; nb < 2; ++nb) {
            const int j = 32 * nb + r32, c = h * 64 + j;
            const float a0c = a.in[8][l * 512 + c], v0c = a.in[10][c];
            const float mu_r = mu[c], mu_k = mu[512 + c], mu_v = mu[1024 + c];
            const float kk_c = a.in[13][l * 512 + c], ka_c = a.in[14][l * 512 + c], rk_c = a.in[15][l * 512 + c];
            float v4[4], kp2[2], rr2[2], kq2[2], ai2[2];
            float lr_ = 0.f, lk_ = 0.f, lv_ = 0.f, vfe = 0.f; unsigned vfo[8];
            const unsigned vfi[8] = {vfq[nb][0].x, vfq[nb][0].y, vfq[nb][0].z, vfq[nb][0].w, vfq[nb][1].x, vfq[nb][1].y, vfq[nb][1].z, vfq[nb][1].w};
#pragma unroll
            for (int r = 0; r < 16; ++r) {
                PREP_TOK(r);
                const float ai = sigmoid_fast(a0c + aia[nb][r]);
                PG8_LAS const bf16_t* tp_ = (PG8_LAS const bf16_t*)tileL + (1 + tq) * 64 + j;
                const float zr = bf2f(tp_[0]), zk = bf2f(tp_[33 * 64]), zv = bf2f(tp_[66 * 64]);
                float pr, pk, pv;
                if ((r & 3) == 0) { const float pm_ = (t != 0) ? 1.0f : 0.0f; pr = pm_ * bf2f(tp_[-64]); pk = pm_ * bf2f(tp_[32 * 64]); pv = pm_ * bf2f(tp_[65 * 64]); }
                else { pr = lr_; pk = lk_; pv = lv_; }
                lr_ = zr; lk_ = zk; lv_ = zv;
                const float rr_ = zr + (pr - zr) * mu_r, kx = zk + (pk - zk) * mu_k;
                float v = zv + (pv - zv) * mu_v;
                if (l == 0) { if (r & 1) vfo[r >> 1] = pk2(vfe, v); else vfe = v; }
                else { const float vf_ = (r & 1) ? bfhi(vfi[r >> 1]) : bflo(vfi[r >> 1]); v = v + (vf_ - v) * sigmoid_fast(v0c + vga[nb][r]); }
                const float kkraw = kx * kk_c, kp = kx * (1.0f + (ai - 1.0f) * ka_c);
                ss[r] = fmaf(kkraw, kkraw, ss[r]); bon[r] = fmaf(rr_ * kp, rk_c, bon[r]);
                if ((r & 3) < 2) { kp2[r & 1] = kp; rr2[r & 1] = rr_; kq2[r & 1] = kkraw; ai2[r & 1] = ai; }
                else { const int wI = 2 * (r >> 2) + (r & 1); KW[nb][wI] = pkh2(kp2[r & 1], kp); RW[nb][wI] = pkh2(rr2[r & 1], rr_); QW[nb][wI] = pkh2(kq2[r & 1], kkraw); AW[nb][wI] = pkh2(ai2[r & 1], ai); }
                v4[r & 3] = v;
                if ((r & 3) == 3) {
                    uint2 pv2; pv2.x = pk2(v4[0], v4[1]); pv2.y = pk2(v4[2], v4[3]);
                    *(uint2*)(RVT + (((size_t)bh * 256 + ((tt0 >> 3) + (r >> 2))) * 64 + j) * 8 + 4 * hi) = pv2;
                }
            }
            if (l == 0) { VFL[nb * 128] = make_uint4(vfo[0], vfo[1], vfo[2], vfo[3]); VFL[nb * 128 + 1] = make_uint4(vfo[4], vfo[5], vfo[6], vfo[7]); }
        }
        float rn[16];
#pragma unroll
        for (int r = 0; r < 16; ++r) {
            PREP_TOK(r);
            const float sst = sum32(ss[r]), bt = sum32(bon[r]);
            rn[r] = rsqrtf(fmaxf(sst, 1e-24f));
            BON[tok * 8 + h] = bt;
        }
        const unsigned psel = (r32 & 1) ? 0x03020706u : 0x05040100u;
#pragma unroll
        for (int nb = 0; nb < 2; ++nb)
#pragma unroll
            for (int g = 0; g < 4; ++g) {
                asm volatile("" ::: "memory");
                unsigned outw[10];
#pragma unroll
                for (int ts = 0; ts < 2; ++ts) {
                    const int wI = 2 * g + ts;
                    const h2_t q2 = __builtin_bit_cast(h2_t, QW[nb][wI]), a2 = __builtin_bit_cast(h2_t, AW[nb][wI]);
                    const float k0 = (float)q2[0] * rn[4 * g + ts], k1 = (float)q2[1] * rn[4 * g + ts + 2];
                    const unsigned mine[5] = {UW[nb][wI], pkh2(-k0, -k1), pkh2(k0 * (float)a2[0], k1 * (float)a2[1]), KW[nb][wI], RW[nb][wI]};
#pragma unroll
                    for (int q = 0; q < 5; ++q) { const unsigned oth = (unsigned)__builtin_amdgcn_mov_dpp((int)mine[q], 0xB1, 0xF, 0xF, true); outw[ts * 5 + q] = __builtin_amdgcn_perm(oth, mine[q], psel); }
                }
                const int tg = (tt0 >> 2) + 2 * g + hi, j2r = 16 * nb + (r32 >> 1);
                unsigned* dst = REC + ((size_t)bh * 512 + tg) * REC_TG + j2r * 20 + (j2r >> 4) * 4 + ((r32 & 1) ? 10 : 0);
#pragma unroll
                for (int k = 0; k < 5; ++k) { uint2 o2; o2.x = outw[2 * k]; o2.y = outw[2 * k + 1]; *(uint2*)(dst + 2 * k) = o2; }
            }
#undef PREP_TOK
#undef PREP_RB
    }
}

__device__ __forceinline__ float dpp_add(float x, float y_src, int) { return x + y_src; }
__device__ __forceinline__ float red32(float x) {
    x += SC_DPP(x, 0xB1); x += SC_DPP(x, 0x4E); x += SC_DPP(x, 0x141); x += SC_DPP(x, 0x140);
    auto rr = __builtin_amdgcn_permlane32_swap(__float_as_uint(x), __float_as_uint(x), false, false);
    return __uint_as_float(rr[0]) + __uint_as_float(rr[1]);
}
__device__ __forceinline__ float fmul_lo(float a, unsigned h) { float d; asm("v_fma_mix_f32 %0, %1, %2, 0 op_sel_hi:[0,1,0]" : "=v"(d) : "v"(a), "v"(h)); return d; }
__device__ __forceinline__ float fmix_lo(float a, unsigned h, float c) { float d; asm("v_fma_mix_f32 %0, %1, %2, %3 op_sel_hi:[0,1,0]" : "=v"(d) : "v"(a), "v"(h), "v"(c)); return d; }
__device__ __forceinline__ float fmix_hi(float a, unsigned h, float c) { float d; asm("v_fma_mix_f32 %0, %1, %2, %3 op_sel:[0,1,0] op_sel_hi:[0,1,0]" : "=v"(d) : "v"(a), "v"(h), "v"(c)); return d; }
__device__ __forceinline__ float fdec_lo(float sv, unsigned u) { float d; asm("v_fma_mix_f32 %0, -%1, %2, %1 op_sel_hi:[0,1,0]" : "=v"(d) : "v"(sv), "v"(u)); return d; }
__device__ __forceinline__ float fdec_hi(float sv, unsigned u) { float d; asm("v_fma_mix_f32 %0, -%1, %2, %1 op_sel:[0,1,0] op_sel_hi:[0,1,0]" : "=v"(d) : "v"(sv), "v"(u)); return d; }
template <int VH> __device__ __forceinline__ float fvk_lo(unsigned v, unsigned k, float c) { float d;
    if (VH) asm("v_fma_mix_f32 %0, %1, %2, %3 op_sel:[1,0,0] op_sel_hi:[1,1,0]" : "=v"(d) : "v"(v), "v"(k), "v"(c)); else asm("v_fma_mix_f32 %0, %1, %2, %3 op_sel:[0,0,0] op_sel_hi:[1,1,0]" : "=v"(d) : "v"(v), "v"(k), "v"(c)); return d; }
template <int VH> __device__ __forceinline__ float fvk_hi(unsigned v, unsigned k, float c) { float d;
    if (VH) asm("v_fma_mix_f32 %0, %1, %2, %3 op_sel:[1,1,0] op_sel_hi:[1,1,0]" : "=v"(d) : "v"(v), "v"(k), "v"(c)); else asm("v_fma_mix_f32 %0, %1, %2, %3 op_sel:[0,1,0] op_sel_hi:[1,1,0]" : "=v"(d) : "v"(v), "v"(k), "v"(c)); return d; }

__device__ __forceinline__ float red16(float x) {
    x += SC_DPP(x, 0xB1); x += SC_DPP(x, 0x4E); x += SC_DPP(x, 0x141); x += SC_DPP(x, 0x140);
    return x;
}
__device__ __forceinline__ float ffma(float a, float b, float c) { float d; asm("v_fma_f32 %0, %1, %2, %3" : "=v"(d) : "v"(a), "v"(b), "v"(c)); return d; }
__device__ __forceinline__ float fmul(float a, float b) { float d; asm("v_mul_f32 %0, %1, %2" : "=v"(d) : "v"(a), "v"(b)); return d; }
__device__ __forceinline__ float fnfma(float a, float b, float c) { float d; asm("v_fma_f32 %0, -%1, %2, %3" : "=v"(d) : "v"(a), "v"(b), "v"(c)); return d; }
__device__ __forceinline__ float h2f_lo(unsigned w) { float d; asm("v_cvt_f32_f16 %0, %1" : "=v"(d) : "v"(w)); return d; }
__device__ __forceinline__ float h2f_hi(unsigned w) { float d; asm("v_cvt_f32_f16_sdwa %0, %1 dst_sel:DWORD dst_unused:UNUSED_PAD src0_sel:WORD_1" : "=v"(d) : "v"(w)); return d; }
__device__ __forceinline__ void phase_scan(const Args& a, int l, PG8_LAS unsigned char* lds) {
    const int tid = tid_fresh(), lane = tid & 63, wid = __builtin_amdgcn_readfirstlane(tid >> 6);
    const int j2 = (lane & 15) | ((lane >> 5) << 4), rr = (lane >> 4) & 1;
    const char* REC = (const char*)(a.ws + WS_REC); const char* RVT = (const char*)(a.ws + WS_RVT);
    bf16_t* YR = (bf16_t*)(a.ws + WS_YRAW);
    constexpr int CSTEPS = 32, NCH = SEQ / CSTEPS, G_REC = 8 * REC_TG * 4  , CH_REC = 21 * 1024, CH_V = 4096, CH = CH_REC + CH_V, NPC = 25;
    constexpr int YB_LD = 68, YB_WAVE = 16 * YB_LD * 4;
    PG8_LAS float* yb = (PG8_LAS float*)(lds + 2 * CH + wid * YB_WAVE);
    float* scr = (float*)((unsigned char*)lds + 2 * CH + 8 * YB_WAVE) + (wid & 3) * (64 * 33);
    const bool cvw = wid < 4;
    const int cw = blockIdx.x * 4 + (wid & 3), NCW = gridDim.x * 4;
    int cvt_next = cvw ? cw : NEXP * 768; bool have = false; CvtItem ci; float4 cv[8];
    for (int u = blockIdx.x; u < 256; u += gridDim.x) {
        const int bh = u >> 2, rg = u & 3, b = bh >> 3, h = bh & 7;
        const int irow = rg * 16 + wid * 2 + rr;
        const char* grec = REC + (size_t)bh * NCH * G_REC; const char* gv = RVT + (size_t)bh * NCH * CH_V;
        float S0 = 0.f, S1 = 0.f;
        __syncthreads();
#define SCAN_DMA(chn, bufo) do { _Pragma("unroll") for (int k_ = 0; k_ < 4; ++k_) { const int pc_ = wid * 4 + k_; if (pc_ < NPC) { \
            const char* src_ = (pc_ < 21) ? grec + (size_t)(chn) * G_REC + pc_ * 1024 + lane * 16 : gv + (size_t)(chn) * CH_V + (pc_ - 21) * 1024 + lane * 16; \
            __builtin_amdgcn_global_load_lds((const unsigned*)src_, (PG8_LAS unsigned*)(lds + (bufo) + pc_ * 1024), 16, 0, 0); } } } while (0)
        SCAN_DMA(0, 0);
        for (int ch = 0; ch < NCH; ++ch) {
            asm volatile("s_waitcnt vmcnt(0)" ::: "memory");
            __syncthreads();
            if (ch + 1 < NCH) SCAN_DMA(ch + 1, ((ch + 1) & 1) * CH);
            if (have) { cvt_finish(ci, lane, cv, scr); have = false; }
            { const int cm = ch & 7; if (cvw && (cm == 0 || cm == 3 || cm == 5)) { if (cvt_decode(a, l, cvt_next, ci)) { cvt_load(ci, lane, cv); have = true; cvt_next += NCW; } } }
            PG8_LAS const unsigned char* bufp = lds + (ch & 1) * CH;
#define SCAN_LOADW(W, grp) do { PG8_LAS const unsigned char* rp_ = bufp + (grp) * (REC_TG * 4) + j2 * 80 + (j2 >> 4) * 16; _Pragma("unroll") for (int k_ = 0; k_ < 5; ++k_) { \
                const pg8::u32x4 q_ = *(PG8_LAS const pg8::u32x4*)(rp_ + 16 * k_); W[4 * k_] = q_.x; W[4 * k_ + 1] = q_.y; W[4 * k_ + 2] = q_.z; W[4 * k_ + 3] = q_.w; } } while (0)
#define SCAN_STEPS(W, hf) do { _Pragma("unroll") for (int ts = 0; ts < 4; ++ts) { \
                const unsigned wu = W[ts * 5], wa = W[ts * 5 + 1], wb = W[ts * 5 + 2], wk = W[ts * 5 + 3], wr_ = W[ts * 5 + 4]; \
                const unsigned vw = vv[(hf) * 2 + (ts >> 1)]; \
                const float sa = red32(fmix_hi(S1, wa, fmul_lo(S0, wa))); \
                float t0 = fdec_lo(S0, wu), t1 = fdec_hi(S1, wu); \
                if (ts & 1) { t0 = fvk_lo<1>(vw, wk, t0); t1 = fvk_hi<1>(vw, wk, t1); } else { t0 = fvk_lo<0>(vw, wk, t0); t1 = fvk_hi<0>(vw, wk, t1); } \
                S0 = fmix_lo(sa, wb, t0); S1 = fmix_hi(sa, wb, t1); \
                yb[((g8 & 1) * 8 + (hf) * 4 + ts) * YB_LD + rr * 32 + j2] = fmix_hi(S1, wr_, fmul_lo(S0, wr_)); } } while (0)
            unsigned wA[20], wB[20];
            SCAN_LOADW(wA, 0);
#pragma unroll 1
            for (int g8 = 0; g8 < 4; ++g8) {
                const pg8::u32x4 vv = *(PG8_LAS const pg8::u32x4*)(bufp + CH_REC + (g8 * 64 + irow) * 16);
                SCAN_LOADW(wB, g8 * 2 + 1);
                SCAN_STEPS(wA, 0);
                if (g8 < 3) SCAN_LOADW(wA, g8 * 2 + 2);
                SCAN_STEPS(wB, 1);
                if (g8 & 1) {
                    asm volatile("s_waitcnt lgkmcnt(0)" ::: "memory");
                    PG8_LAS const float* yp = yb + (j2 & 15) * YB_LD + rr * 32 + (j2 >> 4) * 16;
                    const pg8::f32x4 y0 = *(PG8_LAS const pg8::f32x4*)(yp), y1 = *(PG8_LAS const pg8::f32x4*)(yp + 4), y2 = *(PG8_LAS const pg8::f32x4*)(yp + 8), y3 = *(PG8_LAS const pg8::f32x4*)(yp + 12);
                    const pg8::f32x4 ys = (y0 + y1) + (y2 + y3);
                    float y = (ys[0] + ys[1]) + (ys[2] + ys[3]);
                    { auto sw = __builtin_amdgcn_permlane32_swap(__float_as_uint(y), __float_as_uint(y), false, false); y = __uint_as_float(sw[0]) + __uint_as_float(sw[1]); }
                    const int t = ch * CSTEPS + (g8 >> 1) * 16 + (j2 & 15);
                    if (j2 < 16) YR[((size_t)b * SEQ + t) * 512 + h * 64 + irow] = f2bf(y);
                    asm volatile("s_waitcnt lgkmcnt(0)" ::: "memory");
                }
            }
#undef SCAN_LOADW
#undef SCAN_STEPS
        }
#undef SCAN_DMA
    }
    if (have) cvt_finish(ci, lane, cv, scr);
    while (cvt_decode(a, l, cvt_next, ci)) { cvt_load(ci, lane, cv); cvt_finish(ci, lane, cv, scr); cvt_next += NCW; }
}

struct PostIn { uint4 vq; bf16_t y[8], rg[8]; float bon, gm, bt; };
__device__ __forceinline__ void post_load(const Args& a, int l, int u, int lane, PostIn& p) {
    const int bh = u >> 8, t8 = u & 255, b = bh >> 3, h = bh & 7; const size_t tok0 = (size_t)b * SEQ + t8 * 8; const int c = h * 64 + lane;
    const bf16_t* YR = (const bf16_t*)(a.ws + WS_YRAW); const bf16_t* RGp = (const bf16_t*)(a.ws + WS_RG);
    p.vq = *(const uint4*)(a.ws + WS_RVT + (((size_t)bh * 256 + t8) * 64 + lane) * 16);
#pragma unroll
    for (int k = 0; k < 8; ++k) { p.y[k] = YR[(tok0 + k) * 512 + c]; p.rg[k] = RGp[(tok0 + k) * 512 + c]; }
    p.bon = ((const float*)(a.ws + WS_BON))[(tok0 + (lane & 7)) * 8 + h];
    p.gm = a.in[16][l * 512 + c]; p.bt = a.in[17][l * 512 + c];
}
__device__ __forceinline__ void post_finish(const Args& a, int u, int lane, const PostIn& p) {
    const int bh = u >> 8, t8 = u & 255, b = bh >> 3, h = bh & 7; const size_t tok0 = (size_t)b * SEQ + t8 * 8; const int c = h * 64 + lane;
    bf16_t* MIX = (bf16_t*)(a.ws + WS_MIX);
    const unsigned vw[4] = {p.vq.x, p.vq.y, p.vq.z, p.vq.w};
#pragma unroll
    for (int k = 0; k < 8; ++k) {
        const float y = bf2f(p.y[k]);
        const float my = wsum(y) * (1.0f / 64.0f);
        const float dy = y - my;
        const float var = wsum(dy * dy) * (1.0f / 64.0f);
        const float yn = dy * rsqrtf(var + 64e-5f) * p.gm + p.bt;
        const float v = (k & 1) ? bfhi(vw[k >> 1]) : bflo(vw[k >> 1]);
        const float bon = __shfl(p.bon, k);
        MIX[(tok0 + k) * DM + 512 + c] = f2bf((yn + bon * v) * bf2f(p.rg[k]));
    }
}
__device__ __forceinline__ void phase_post(const Args& a, int l) {
    const int tid = tid_fresh(), lane = tid & 63, wid = tid >> 6;
    const int NW = gridDim.x * 8;
    int u = blockIdx.x * 8 + wid;
    PostIn p0, p1;
    if (u < 64 * 256) post_load(a, l, u, lane, p0);
    while (u < 64 * 256) {
        const int u1 = u + NW; const bool h1 = u1 < 64 * 256;
        if (h1) post_load(a, l, u1, lane, p1);
        post_finish(a, u, lane, p0);
        u = u1 + NW;
        if (!h1) break;
        if (u < 64 * 256) post_load(a, l, u, lane, p0);
        post_finish(a, u1, lane, p1);
    }
}

namespace att {
typedef short bf16x8 __attribute__((ext_vector_type(8)));
typedef short s16x4 __attribute__((ext_vector_type(4)));
typedef float f32x16 __attribute__((ext_vector_type(16)));
typedef __attribute__((address_space(3))) const unsigned char* lds_cptr;
constexpr int SLOT = 8192, L_K = 0, L_V = 2 * SLOT, L_WS = 4 * SLOT, L_KM = L_WS + 8 * 256, L_OST = L_KM + 2048, OST_LD = 68, L_END = L_OST + 8 * 32 * OST_LD * 4;
constexpr float C2 = 0.125f * 1.4426950408889634f;
__device__ __forceinline__ int crow(int r, int hi) { return (r & 3) + 8 * (r >> 2) + 4 * hi; }
__device__ __forceinline__ s16x4 vtr(lds_cptr p) { return __builtin_bit_cast(s16x4, __builtin_amdgcn_ds_read_tr16_b64_v4i16((__attribute__((address_space(3))) s16x4*)p)); }
__device__ __forceinline__ float swapmax(float x) { auto rr = __builtin_amdgcn_permlane32_swap(__float_as_uint(x), __float_as_uint(x), false, false); return fmaxf(__uint_as_float(rr[0]), __uint_as_float(rr[1])); }
__device__ __forceinline__ float swapsum(float x) { auto rr = __builtin_amdgcn_permlane32_swap(__float_as_uint(x), __float_as_uint(x), false, false); return __uint_as_float(rr[0]) + __uint_as_float(rr[1]); }

__device__ __forceinline__ void unit(const Args& a, int l, int b, int h, int cur, PG8_LAS unsigned char* lds) {
    const int tid = tid_fresh(), lane = tid & 63, r32 = lane & 31, hi = lane >> 5, wid = __builtin_amdgcn_readfirstlane(tid >> 6);
    const bf16_t* Zb = (const bf16_t*)(a.ws + WS_Z) + (size_t)b * SEQ * ZLD;
    const int qrel = wid * 32 + r32, qpos = cur * 256 + qrel;
    PG8_LAS float* wsf = (PG8_LAS float*)(lds + L_WS) + wid * 64;
    PG8_LAS float* kmf = (PG8_LAS float*)(lds + L_KM);
    __syncthreads();
    kmf[tid] = ((const float*)(a.ws + WS_KMEAN))[(size_t)(b * NH + h) * 512 + tid];
    const bf16_t* ksrc = Zb + (size_t)lane * ZLD + C_K + h * HD + wid * 8;
    const bf16_t* vsrc = Zb + (size_t)(16 * (wid & 3) + (lane >> 2)) * ZLD + C_V + h * HD + (wid >> 2) * 32 + (lane & 3) * 8;
#define ATT_DMA(kpos0, slot) do { \
        __builtin_amdgcn_global_load_lds((const unsigned*)(ksrc + (size_t)(kpos0) * ZLD), (PG8_LAS unsigned*)(lds + L_K + (slot) * SLOT + wid * 1024), 16, 0, 0); \
        __builtin_amdgcn_global_load_lds((const unsigned*)(vsrc + (size_t)(kpos0) * ZLD), (PG8_LAS unsigned*)(lds + L_V + (slot) * SLOT + wid * 1024), 16, 0, 0); } while (0)
    ATT_DMA(cur * 256, 0);
    bf16x8 qr[4];
#pragma unroll
    for (int d0 = 0; d0 < 4; ++d0) qr[d0] = *(const bf16x8*)(Zb + (size_t)qpos * ZLD + C_Q + h * HD + d0 * 16 + hi * 8);
    __syncthreads();
    unsigned selbits = 0u;
    {
        float g[8];
#pragma unroll
        for (int n = 0; n < 8; ++n) g[n] = 0.f;
#pragma unroll
        for (int d0 = 0; d0 < 4; ++d0)
#pragma unroll
            for (int j = 0; j < 8; ++j) { const float qv = bf2f((bf16_t)qr[d0][j]);
#pragma unroll
                for (int n = 0; n < 8; ++n) g[n] = fmaf(qv, kmf[n * 64 + d0 * 16 + hi * 8 + j], g[n]); }
#pragma unroll
        for (int n = 0; n < 8; ++n) g[n] = (n < cur) ? swapsum(g[n]) : NEG_INF;
        if (cur <= 3) selbits = (1u << cur) - 1u;
        else {
            int s0 = -1, s1 = -1, s2 = -1; float bv = -3e38f;
#pragma unroll
            for (int n = 0; n < 8; ++n) if (g[n] > bv) { bv = g[n]; s0 = n; }
            bv = -3e38f;
#pragma unroll
            for (int n = 0; n < 8; ++n) if (n != s0 && g[n] > bv) { bv = g[n]; s1 = n; }
            bv = -3e38f;
#pragma unroll
            for (int n = 0; n < 8; ++n) if (n != s0 && n != s1 && g[n] > bv) { bv = g[n]; s2 = n; }
            selbits = (1u << s0) | (1u << s1) | (1u << s2);
        }
    }
    const float s8 = 8.0f * exp2f(-(float)(h + 1));
    f32x16 base;
#pragma unroll
    for (int r = 0; r < 16; ++r) base[r] = s8 * (float)crow(r, hi);
    f32x16 o0, o1;
#pragma unroll
    for (int r = 0; r < 16; ++r) { o0[r] = 0.f; o1[r] = 0.f; }
    float m = -INFINITY, lsum = 0.f;
    const int NT = 4 * (cur + 1);
    const lds_cptr kp = (lds_cptr)(lds + L_K) + hi * 1024 + r32 * 16;
    const lds_cptr vp = (lds_cptr)(lds + L_V) + ((lane >> 4) & 1) * 32 + (lane & 3) * 8 + (4 * hi + ((lane & 15) >> 2)) * 64;
    for (int it = 0; it < NT; ++it) {
        asm volatile("s_waitcnt vmcnt(0)" ::: "memory");
        __syncthreads();
        const int blk = (it < 4) ? cur : ((it >> 2) - 1);
        const int kpos0 = blk * 256 + (it & 3) * 64;
        if (it + 1 < NT) { const int nblk = (it + 1 < 4) ? cur : (((it + 1) >> 2) - 1); ATT_DMA(nblk * 256 + ((it + 1) & 3) * 64, (it + 1) & 1); }
        const int so = (it & 1) * SLOT;
        f32x16 p0 = base, p1 = base;
#pragma unroll
        for (int d0 = 0; d0 < 4; ++d0) {
            const bf16x8 k0 = *(const __attribute__((address_space(3))) bf16x8*)(kp + so + d0 * 2048);
            const bf16x8 k1 = *(const __attribute__((address_space(3))) bf16x8*)(kp + so + d0 * 2048 + 512);
            p0 = __builtin_amdgcn_mfma_f32_32x32x16_bf16(k0, qr[d0], p0, 0, 0, 0);
            p1 = __builtin_amdgcn_mfma_f32_32x32x16_bf16(k1, qr[d0], p1, 0, 0, 0);
        }
        const bool rowsel = (it < 4) || ((selbits >> blk) & 1u);
        const float cb = rowsel ? -s8 * (float)(qpos - kpos0) : -INFINITY;
        const float cb1 = cb + s8 * 32.0f;
        if (it < 4) {
            const int kb0 = (it & 3) * 64 + 4 * hi;
#pragma unroll
            for (int r = 0; r < 16; ++r) { const int kv = kb0 + (r & 3) + 8 * (r >> 2); if (kv > qrel) p0[r] = -INFINITY; if (kv + 32 > qrel) p1[r] = -INFINITY; }
        }
        float mx0 = p0[0], mx1 = p1[0];
#pragma unroll
        for (int r = 1; r < 16; ++r) { mx0 = fmaxf(mx0, p0[r]); mx1 = fmaxf(mx1, p1[r]); }
        const float mx = swapmax(fmaxf(mx0 + cb, mx1 + cb1));
        if (__any((mx - m) * C2 > 6.0f)) {
            const float mn = fmaxf(m, mx);
            const float alpha = __builtin_amdgcn_exp2f((m - mn) * C2);
            m = mn; lsum *= alpha;
            asm volatile("s_waitcnt lgkmcnt(0)" ::: "memory");
            if (hi == 0) wsf[r32] = alpha;
            asm volatile("s_waitcnt lgkmcnt(0)" ::: "memory");
#pragma unroll
            for (int r = 0; r < 16; ++r) { const float al = wsf[crow(r, hi)]; o0[r] *= al; o1[r] *= al; }
        }
        const float tb0 = (cb - m) * C2, tb1 = (cb1 - m) * C2;
        float ls = 0.f;
#pragma unroll
        for (int r = 0; r < 16; ++r) { p0[r] = __builtin_amdgcn_exp2f(fmaf(p0[r], C2, tb0)); p1[r] = __builtin_amdgcn_exp2f(fmaf(p1[r], C2, tb1)); ls += p0[r] + p1[r]; }
        lsum += ls;
        pg8::u32x4 w0, w1, w2, w3;
        w0.x = pk2(p0[0], p0[1]); w0.y = pk2(p0[2], p0[3]); w0.z = pk2(p0[4], p0[5]); w0.w = pk2(p0[6], p0[7]);
        w1.x = pk2(p0[8], p0[9]); w1.y = pk2(p0[10], p0[11]); w1.z = pk2(p0[12], p0[13]); w1.w = pk2(p0[14], p0[15]);
        w2.x = pk2(p1[0], p1[1]); w2.y = pk2(p1[2], p1[3]); w2.z = pk2(p1[4], p1[5]); w2.w = pk2(p1[6], p1[7]);
        w3.x = pk2(p1[8], p1[9]); w3.y = pk2(p1[10], p1[11]); w3.z = pk2(p1[12], p1[13]); w3.w = pk2(p1[14], p1[15]);
        const bf16x8 pa0 = __builtin_bit_cast(bf16x8, w0), pa1 = __builtin_bit_cast(bf16x8, w1), pa2 = __builtin_bit_cast(bf16x8, w2), pa3 = __builtin_bit_cast(bf16x8, w3);
#define ATT_VF(d0, ks) ({ const s16x4 lo_ = vtr(vp + so + (d0) * 4096 + (ks) * 1024), hi_ = vtr(vp + so + (d0) * 4096 + (ks) * 1024 + 512); \
        (bf16x8){lo_[0], lo_[1], lo_[2], lo_[3], hi_[0], hi_[1], hi_[2], hi_[3]}; })
        o0 = __builtin_amdgcn_mfma_f32_32x32x16_bf16(pa0, ATT_VF(0, 0), o0, 0, 0, 0);
        o1 = __builtin_amdgcn_mfma_f32_32x32x16_bf16(pa0, ATT_VF(1, 0), o1, 0, 0, 0);
        o0 = __builtin_amdgcn_mfma_f32_32x32x16_bf16(pa1, ATT_VF(0, 1), o0, 0, 0, 0);
        o1 = __builtin_amdgcn_mfma_f32_32x32x16_bf16(pa1, ATT_VF(1, 1), o1, 0, 0, 0);
        o0 = __builtin_amdgcn_mfma_f32_32x32x16_bf16(pa2, ATT_VF(0, 2), o0, 0, 0, 0);
        o1 = __builtin_amdgcn_mfma_f32_32x32x16_bf16(pa2, ATT_VF(1, 2), o1, 0, 0, 0);
        o0 = __builtin_amdgcn_mfma_f32_32x32x16_bf16(pa3, ATT_VF(0, 3), o0, 0, 0, 0);
        o1 = __builtin_amdgcn_mfma_f32_32x32x16_bf16(pa3, ATT_VF(1, 3), o1, 0, 0, 0);
#undef ATT_VF
    }
#undef ATT_DMA
    const float lt = swapsum(lsum);
    asm volatile("s_waitcnt lgkmcnt(0)" ::: "memory");
    if (hi == 0) wsf[r32] = 1.0f / lt;
    asm volatile("s_waitcnt lgkmcnt(0)" ::: "memory");
    PG8_LAS float* stg = (PG8_LAS float*)(lds + L_OST) + wid * (32 * OST_LD);
#pragma unroll
    for (int r = 0; r < 16; ++r) { const int orow = crow(r, hi); const float il = wsf[orow]; stg[orow * OST_LD + r32] = o0[r] * il; stg[orow * OST_LD + 32 + r32] = o1[r] * il; }
    asm volatile("s_waitcnt lgkmcnt(0)" ::: "memory");
    const float* gain = a.in[18] + l * 512 + h * HD;
    bf16_t* MIX = (bf16_t*)(a.ws + WS_MIX);
#pragma unroll
    for (int i = 0; i < 4; ++i) {
        const int row = i * 8 + (lane >> 3), ch = lane & 7;
        const pg8::f32x4 va = *(PG8_LAS const pg8::f32x4*)(stg + row * OST_LD + ch * 8), vb = *(PG8_LAS const pg8::f32x4*)(stg + row * OST_LD + ch * 8 + 4);
        float ss = va[0] * va[0] + va[1] * va[1] + va[2] * va[2] + va[3] * va[3] + vb[0] * vb[0] + vb[1] * vb[1] + vb[2] * vb[2] + vb[3] * vb[3];
        ss += SC_DPP(ss, 0xB1); ss += SC_DPP(ss, 0x4E); ss += SC_DPP(ss, 0x141);
        const float rs = rsqrtf(ss * (1.0f / 64.0f) + 1e-6f);
        const pg8::f32x4 ga = *(const pg8::f32x4*)(gain + ch * 8), gb = *(const pg8::f32x4*)(gain + ch * 8 + 4);
        pg8::u32x4 w; w.x = pk2(va[0] * rs * ga[0], va[1] * rs * ga[1]); w.y = pk2(va[2] * rs * ga[2], va[3] * rs * ga[3]);
        w.z = pk2(vb[0] * rs * gb[0], vb[1] * rs * gb[1]); w.w = pk2(vb[2] * rs * gb[2], vb[3] * rs * gb[3]);
        *(pg8::u32x4*)(MIX + ((size_t)b * SEQ + cur * 256 + wid * 32 + row) * DM + h * HD + ch * 8) = w;
    }
}
}

__device__ __forceinline__ void phase_att(const Args& a, int l, PG8_LAS unsigned char* lds) {
    const int G = gridDim.x, bx = blockIdx.x;
    const int v = (G % 8 == 0) ? (bx % 8) * (G / 8) + bx / 8 : bx;
    for (int w = v; w < 256; w += G) {
        const int bh = w >> 2, s = w & 3;
        att::unit(a, l, bh >> 3, bh & 7, 7 - s, lds);
        att::unit(a, l, bh >> 3, bh & 7, s, lds);
    }
}

constexpr int CK_STRIDE = 4 * REC_TG * 4, CK_FR = 2048, CK_FM1 = 4096, CK_FM2 = 4608, CK_FBK = 5120, CK_W = 9216;
__device__ __forceinline__ void phase_prep2(const Args& a, float* lds, const bool probe = false) {
    typedef float f32x4 __attribute__((ext_vector_type(4)));
    const int tid = tid_fresh(), lane0 = tid & 63, wid = tid >> 6;
    float* L = lds + wid * 4352;
    unsigned char* REC = a.ws + WS_REC;
    for (int task = blockIdx.x * 8 + wid; task < 64 * 128; task += gridDim.x * 8) {
        int lane = lane0; asm volatile("" : "+v"(lane));
        const int bh = task >> 7, c = task & 127, j = lane, j2 = j >> 1, hf = j & 1;
        unsigned char* blob = REC + ((size_t)bh * 512 + 4 * c) * (REC_TG * 4);
        unsigned char* ob = probe ? a.ws + WS_MIX + (size_t)(task & 2047) * 10304 : blob;
        float w[16], av[16], bv[16], kv[16], rv[16];
#pragma unroll
        for (int tg = 0; tg < 4; ++tg) {
            const unsigned* rp = (const unsigned*)(blob + (size_t)tg * (REC_TG * 4)) + j2 * 20 + (j2 >> 4) * 4;
            unsigned wd[20];
#pragma unroll
            for (int q = 0; q < 5; ++q) { const uint4 x = *(const uint4*)(rp + 4 * q); wd[4 * q] = x.x; wd[4 * q + 1] = x.y; wd[4 * q + 2] = x.z; wd[4 * q + 3] = x.w; }
#pragma unroll
            for (int ts = 0; ts < 4; ++ts) { const int s_ = tg * 4 + ts;
#define P2H(q) ({ const h2_t h_ = __builtin_bit_cast(h2_t, wd[ts * 5 + (q)]); (float)(hf ? h_[1] : h_[0]); })
                w[s_] = 1.0f - P2H(0); av[s_] = P2H(1); bv[s_] = P2H(2); kv[s_] = P2H(3); rv[s_] = P2H(4);
#undef P2H
            }
        }
        asm volatile("s_waitcnt vmcnt(0)" ::: "memory");
        float ah[16], rh[16];
        {
            float Wc = 1.0f, bh_[16], kh_[16];
#pragma unroll
            for (int s_ = 0; s_ < 16; ++s_) { ah[s_] = av[s_] * Wc; Wc *= w[s_]; rh[s_] = rv[s_] * Wc; const float iw = 1.0f / Wc; bh_[s_] = bv[s_] * iw; kh_[s_] = kv[s_] * iw; }
#pragma unroll
            for (int s_ = 0; s_ < 16; ++s_) { L[s_ * 68 + j] = bh_[s_]; L[1088 + s_ * 68 + j] = kh_[s_]; L[2176 + s_ * 68 + j] = ah[s_]; L[3264 + s_ * 68 + j] = rh[s_]; }
#pragma unroll
            for (int g = 0; g < 4; ++g) { uint4 o; o.x = pk2(bh_[4 * g] * Wc, bh_[4 * g + 1] * Wc); o.y = pk2(bh_[4 * g + 2] * Wc, bh_[4 * g + 3] * Wc);
                o.z = pk2(kh_[4 * g] * Wc, kh_[4 * g + 1] * Wc); o.w = pk2(kh_[4 * g + 2] * Wc, kh_[4 * g + 3] * Wc);
                *(uint4*)(ob + CK_FBK + (j >> 4) * 1024 + ((j & 15) + 16 * g) * 16) = o; }
            *(float*)(ob + CK_W + j * 4) = Wc;
        }
        asm volatile("s_waitcnt lgkmcnt(0)" ::: "memory");
        { const int rI = lane & 15, gI = lane >> 4;
          f32x4 gab = {0.f, 0.f, 0.f, 0.f}, gak = gab, gbr = gab, gkr = gab;
#pragma unroll 4
          for (int kk = 0; kk < 16; ++kk) { const int o = rI * 68 + 4 * kk + gI;
            const float aB = L[o], aK = L[1088 + o], bA = L[2176 + o], bR = L[3264 + o];
            gab = __builtin_amdgcn_mfma_f32_16x16x4f32(aB, bA, gab, 0, 0, 0); gak = __builtin_amdgcn_mfma_f32_16x16x4f32(aK, bA, gak, 0, 0, 0);
            gbr = __builtin_amdgcn_mfma_f32_16x16x4f32(aB, bR, gbr, 0, 0, 0); gkr = __builtin_amdgcn_mfma_f32_16x16x4f32(aK, bR, gkr, 0, 0, 0); }
          asm volatile("s_waitcnt lgkmcnt(0)" ::: "memory");
          f32x4 nab, nbr;
#pragma unroll
          for (int e = 0; e < 4; ++e) { const int s_ = 4 * gI + e; nab[e] = (s_ < rI) ? gab[e] : 0.f; nbr[e] = (s_ <= rI) ? gbr[e] : 0.f;
              L[512 + s_ * 16 + rI] = (s_ < rI) ? gak[e] : 0.f; L[768 + s_ * 16 + rI] = (s_ <= rI) ? gkr[e] : 0.f; }
          *(f32x4*)&L[rI * 16 + 4 * gI] = nab; *(f32x4*)&L[256 + rI * 16 + 4 * gI] = nbr;
        }
        asm volatile("s_waitcnt lgkmcnt(0)" ::: "memory");
        { bf16_t* IM = (bf16_t*)((unsigned char*)L + 4096);
          const int ks = j >> 5, jw = j & 31, g = (jw & 15) >> 2, jj = ((jw >> 4) << 2) | (jw & 3);
          const int sp = lane & 15, oA = ks * 512 + (16 * g) * 8 + jj, oM = 2048 + (16 * (sp >> 3)) * 8 + (sp & 7);
          const bool mw = lane < 16;
          float x[16], m1[16];
#pragma unroll
          for (int t = 0; t < 16; ++t) {
            float nt[16], nr[16];
#pragma unroll
            for (int q = 0; q < 4; ++q) { const f32x4 v = *(const f32x4*)&L[t * 16 + 4 * q]; nt[4 * q] = v[0]; nt[4 * q + 1] = v[1]; nt[4 * q + 2] = v[2]; nt[4 * q + 3] = v[3];
                                          const f32x4 u = *(const f32x4*)&L[256 + t * 16 + 4 * q]; nr[4 * q] = u[0]; nr[4 * q + 1] = u[1]; nr[4 * q + 2] = u[2]; nr[4 * q + 3] = u[3]; }
            float xa = ah[t], ma = L[512 + sp * 16 + t], ra = rh[t], mb = L[768 + sp * 16 + t];
#pragma unroll
            for (int s_ = 0; s_ < 16; ++s_) if (s_ < t) { xa = fmaf(x[s_], nt[s_], xa); ma = fmaf(m1[s_], nt[s_], ma); }
            x[t] = xa; m1[t] = ma;
#pragma unroll
            for (int s_ = 0; s_ < 16; ++s_) if (s_ <= t) { ra = fmaf(x[s_], nr[s_], ra); mb = fmaf(m1[s_], nr[s_], mb); }
            IM[oA + t * 8] = f2bf(xa); IM[1024 + oA + t * 8] = f2bf(ra);
            if (mw) { IM[oM + t * 8] = f2bf(ma); IM[256 + oM + t * 8] = f2bf(mb); }
            asm volatile("" ::: "memory");
          }
          asm volatile("s_waitcnt lgkmcnt(0)" ::: "memory");
          const uint4* IMq = (const uint4*)IM;
          *(uint4*)(ob + lane * 16) = IMq[lane]; *(uint4*)(ob + 1024 + lane * 16) = IMq[64 + lane];
          *(uint4*)(ob + CK_FR + lane * 16) = IMq[128 + lane]; *(uint4*)(ob + CK_FR + 1024 + lane * 16) = IMq[192 + lane];
          if (lane < 32) { *(uint4*)(ob + CK_FM1 + lane * 16) = IMq[256 + lane]; *(uint4*)(ob + CK_FM2 + lane * 16) = IMq[288 + lane]; }
        }
        asm volatile("s_waitcnt lgkmcnt(0)" ::: "memory");
    }
}
__device__ __forceinline__ void scan2_unit(const Args& a, int u, PG8_LAS unsigned char* lds) {
    typedef short bf16x8 __attribute__((ext_vector_type(8)));
    typedef float f32x4 __attribute__((ext_vector_type(4)));
    const int tid = tid_fresh(), lane = tid & 63, wid = __builtin_amdgcn_readfirstlane(tid >> 6);
    const int bh = u >> 2, rg = u & 3, b = bh >> 3, h = bh & 7;
    const int i16 = lane & 15, g = lane >> 4, irow = rg * 16 + i16;
    const unsigned char* REC = a.ws + WS_REC; const unsigned char* RVB = a.ws + WS_RVT; const unsigned char* ZERO = a.ws + 32768;
    bf16_t* YR = (bf16_t*)(a.ws + WS_YRAW);
    constexpr int DEPTH = 6, SLOTB = 16 * 1024, NCK = SEQ / 16;
#define S2_SRC(pc, c) ({ const unsigned char* blob_ = REC + ((size_t)bh * 512 + 4 * (c)) * (REC_TG * 4); const unsigned char* r_; \
        if ((pc) < 4) r_ = blob_ + (pc) * 1024 + lane * 16; \
        else if ((pc) < 6) r_ = (lane < 32) ? blob_ + CK_FM1 + ((pc) - 4) * 512 + lane * 16 : ZERO + lane * 16; \
        else if ((pc) < 10) r_ = blob_ + CK_FBK + ((pc) - 6) * 1024 + lane * 16; \
        else if ((pc) < 14) r_ = blob_ + CK_W + (16 * ((pc) - 10) + 4 * g) * 4; \
        else if ((pc) == 14) r_ = (g < 2) ? RVB + (((size_t)bh * 256 + 2 * (c) + g) * 64 + irow) * 16 : ZERO + lane * 16; \
        else r_ = RVB + (((size_t)bh * 256 + 2 * (c) + (g >> 1)) * 64 + irow) * 16; \
        r_; })
#define S2_DMA(pc, c) __builtin_amdgcn_global_load_lds((const unsigned*)S2_SRC(pc, c), (PG8_LAS unsigned*)(lds + ((c) % DEPTH) * SLOTB + (pc) * 1024), 16, 0, 0)
    asm volatile("s_waitcnt vmcnt(0) lgkmcnt(0)" ::: "memory"); __builtin_amdgcn_s_barrier(); asm volatile("" ::: "memory");
    if (wid > 0) {
        for (int c = 0; c < DEPTH - 1; ++c) { S2_DMA(wid - 1, c); S2_DMA(wid + 6, c); if (wid + 13 < 16) S2_DMA(wid + 13, c); }
    }
    f32x4 ST[4];
#pragma unroll
    for (int q = 0; q < 4; ++q) ST[q] = (f32x4){0.f, 0.f, 0.f, 0.f};
    for (int c = 0; c < NCK; ++c) {
        if (wid > 0) {
            if (wid + 13 < 16) asm volatile("s_waitcnt vmcnt(12)" ::: "memory"); else asm volatile("s_waitcnt vmcnt(8)" ::: "memory");
        }
        asm volatile("s_waitcnt lgkmcnt(0)" ::: "memory"); __builtin_amdgcn_s_barrier(); asm volatile("" ::: "memory");
        if (wid > 0) {
            const int cn = c + DEPTH - 1;
            if (cn < NCK) { S2_DMA(wid - 1, cn); S2_DMA(wid + 6, cn); if (wid + 13 < 16) S2_DMA(wid + 13, cn); }
            else { S2_DMA(wid - 1, NCK - 1); S2_DMA(wid + 6, NCK - 1); if (wid + 13 < 16) S2_DMA(wid + 13, NCK - 1); }
        } else {
            PG8_LAS const unsigned char* sl = lds + (c % DEPTH) * SLOTB + lane * 16;
#define S2_FR(pc) (*(PG8_LAS const bf16x8*)(sl + (pc) * 1024))
            const bf16x8 fa0 = S2_FR(0), fa1 = S2_FR(1), fr0 = S2_FR(2), fr1 = S2_FR(3), fm1 = S2_FR(4), fm2 = S2_FR(5), vb = S2_FR(14);
            const pg8::u32x4 v4w = *(PG8_LAS const pg8::u32x4*)(sl + 15 * 1024);
            pg8::u32x4 s0, s1;
            s0.x = pk2(ST[0][0], ST[0][1]); s0.y = pk2(ST[0][2], ST[0][3]); s0.z = pk2(ST[1][0], ST[1][1]); s0.w = pk2(ST[1][2], ST[1][3]);
            s1.x = pk2(ST[2][0], ST[2][1]); s1.y = pk2(ST[2][2], ST[2][3]); s1.z = pk2(ST[3][0], ST[3][1]); s1.w = pk2(ST[3][2], ST[3][3]);
            const bf16x8 sb0 = __builtin_bit_cast(bf16x8, s0), sb1 = __builtin_bit_cast(bf16x8, s1);
            f32x4 PT = {0.f, 0.f, 0.f, 0.f}, YT = PT;
            PT = __builtin_amdgcn_mfma_f32_16x16x32_bf16(fa0, sb0, PT, 0, 0, 0); YT = __builtin_amdgcn_mfma_f32_16x16x32_bf16(fr0, sb0, YT, 0, 0, 0);
            PT = __builtin_amdgcn_mfma_f32_16x16x32_bf16(fa1, sb1, PT, 0, 0, 0); YT = __builtin_amdgcn_mfma_f32_16x16x32_bf16(fr1, sb1, YT, 0, 0, 0);
            PT = __builtin_amdgcn_mfma_f32_16x16x32_bf16(fm1, vb, PT, 0, 0, 0);  YT = __builtin_amdgcn_mfma_f32_16x16x32_bf16(fm2, vb, YT, 0, 0, 0);
            pg8::u32x4 pv; pv.x = pk2(PT[0], PT[1]); pv.y = pk2(PT[2], PT[3]); pv.z = (g & 1) ? v4w.z : v4w.x; pv.w = (g & 1) ? v4w.w : v4w.y;
            const bf16x8 pvb = __builtin_bit_cast(bf16x8, pv);
#pragma unroll
            for (int jt = 0; jt < 4; ++jt) { const f32x4 wv = *(PG8_LAS const f32x4*)(sl + (10 + jt) * 1024);
                ST[jt] = __builtin_amdgcn_mfma_f32_16x16x32_bf16(S2_FR(6 + jt), pvb, ST[jt] * wv, 0, 0, 0); }
#undef S2_FR
            const size_t tok = (size_t)b * SEQ + 16 * c + 4 * g;
#pragma unroll
            for (int e = 0; e < 4; ++e) YR[(tok + e) * 512 + h * 64 + irow] = f2bf(YT[e]);
        }
    }
    asm volatile("s_waitcnt vmcnt(0) lgkmcnt(0)" ::: "memory"); __builtin_amdgcn_s_barrier(); asm volatile("" ::: "memory");
#undef S2_SRC
#undef S2_DMA
}

__device__ __forceinline__ void scan32(const Args& a, int l, int j, PG8_LAS unsigned char* lds) {
    const int tid = tid_fresh(), lane = tid & 63, wid = __builtin_amdgcn_readfirstlane(tid >> 6);
    const int jq = lane & 15, rr = lane >> 4;
    const char* REC = (const char*)(a.ws + WS_REC); const char* RVT = (const char*)(a.ws + WS_RVT);
    bf16_t* YR = (bf16_t*)(a.ws + WS_YRAW);
    constexpr int CSTEPS = 32, NCH = SEQ / CSTEPS, G_REC = 8 * REC_TG * 4, CH_REC = 21 * 1024, CH_V = 4096, CH = CH_REC + CH_V, NPC = 25;
    constexpr int YB_LD = 68, YB_WAVE = 16 * YB_LD * 4;
    PG8_LAS float* yb = (PG8_LAS float*)(lds + 2 * CH + wid * YB_WAVE);
    const int bh = j >> 1, hf32 = j & 1, b = bh >> 3, h = bh & 7;
    const int irow = hf32 * 32 + wid * 4 + rr;
    const char* grec = REC + (size_t)bh * NCH * G_REC; const char* gv = RVT + (size_t)bh * NCH * CH_V;
    float S0 = 0.f, S1 = 0.f, S2 = 0.f, S3 = 0.f;
    asm volatile("s_waitcnt vmcnt(0) lgkmcnt(0)" ::: "memory"); __builtin_amdgcn_s_barrier(); asm volatile("" ::: "memory");
#define SCAN_DMA(chn, bufo) do { _Pragma("unroll") for (int k_ = 0; k_ < 4; ++k_) { const int pc_ = wid * 4 + k_; if (pc_ < NPC) { \
        const char* src_ = (pc_ < 21) ? grec + (size_t)(chn) * G_REC + pc_ * 1024 + lane * 16 : gv + (size_t)(chn) * CH_V + (pc_ - 21) * 1024 + lane * 16; \
        __builtin_amdgcn_global_load_lds((const unsigned*)src_, (PG8_LAS unsigned*)(lds + (bufo) + pc_ * 1024), 16, 0, 0); } } } while (0)
    SCAN_DMA(0, 0);
    for (int ch = 0; ch < NCH; ++ch) {
        asm volatile("s_waitcnt vmcnt(0) lgkmcnt(0)" ::: "memory"); __builtin_amdgcn_s_barrier(); asm volatile("" ::: "memory");
        if (ch + 1 < NCH) SCAN_DMA(ch + 1, ((ch + 1) & 1) * CH);
        PG8_LAS const unsigned char* bufp = lds + (ch & 1) * CH;
#define SCAN_LOADW(WA, WB, grp) do { PG8_LAS const unsigned char* rp_ = bufp + (grp) * (REC_TG * 4) + jq * 160 + (jq >> 3) * 16; _Pragma("unroll") for (int k_ = 0; k_ < 5; ++k_) { \
        const pg8::u32x4 q_ = *(PG8_LAS const pg8::u32x4*)(rp_ + 16 * k_), q2_ = *(PG8_LAS const pg8::u32x4*)(rp_ + 80 + 16 * k_); \
        WA[4 * k_] = q_.x; WA[4 * k_ + 1] = q_.y; WA[4 * k_ + 2] = q_.z; WA[4 * k_ + 3] = q_.w; WB[4 * k_] = q2_.x; WB[4 * k_ + 1] = q2_.y; WB[4 * k_ + 2] = q2_.z; WB[4 * k_ + 3] = q2_.w; } } while (0)
#define SCAN_STEPS(WA, WB, hf) do { _Pragma("unroll") for (int ts = 0; ts < 4; ++ts) { \
        const unsigned uA = WA[ts * 5], aA = WA[ts * 5 + 1], bA = WA[ts * 5 + 2], kA = WA[ts * 5 + 3], rA = WA[ts * 5 + 4]; \
        const unsigned uB = WB[ts * 5], aB = WB[ts * 5 + 1], bB = WB[ts * 5 + 2], kB = WB[ts * 5 + 3], rB = WB[ts * 5 + 4]; \
        const unsigned vw = vv[(hf) * 2 + (ts >> 1)]; \
        const float sa = red16(fmix_hi(S3, aB, fmix_lo(S2, aB, fmix_hi(S1, aA, fmul_lo(S0, aA))))); \
        float t0 = fdec_lo(S0, uA), t1 = fdec_hi(S1, uA), t2 = fdec_lo(S2, uB), t3 = fdec_hi(S3, uB); \
        if (ts & 1) { t0 = fvk_lo<1>(vw, kA, t0); t1 = fvk_hi<1>(vw, kA, t1); t2 = fvk_lo<1>(vw, kB, t2); t3 = fvk_hi<1>(vw, kB, t3); } \
        else { t0 = fvk_lo<0>(vw, kA, t0); t1 = fvk_hi<0>(vw, kA, t1); t2 = fvk_lo<0>(vw, kB, t2); t3 = fvk_hi<0>(vw, kB, t3); } \
        S0 = fmix_lo(sa, bA, t0); S1 = fmix_hi(sa, bA, t1); S2 = fmix_lo(sa, bB, t2); S3 = fmix_hi(sa, bB, t3); \
        yb[((g8 & 1) * 8 + (hf) * 4 + ts) * YB_LD + rr * 16 + jq] = fmix_hi(S3, rB, fmix_lo(S2, rB, fmix_hi(S1, rA, fmul_lo(S0, rA)))); } } while (0)
        unsigned wA0[20], wB0[20], wA1[20], wB1[20];
        SCAN_LOADW(wA0, wB0, 0);
#pragma unroll 1
        for (int g8 = 0; g8 < 4; ++g8) {
            const pg8::u32x4 vv = *(PG8_LAS const pg8::u32x4*)(bufp + CH_REC + (g8 * 64 + irow) * 16);
            SCAN_LOADW(wA1, wB1, g8 * 2 + 1);
            SCAN_STEPS(wA0, wB0, 0);
            if (g8 < 3) SCAN_LOADW(wA0, wB0, g8 * 2 + 2);
            SCAN_STEPS(wA1, wB1, 1);
            if (g8 & 1) {
                asm volatile("s_waitcnt lgkmcnt(0)" ::: "memory");
                PG8_LAS const float* yp = yb + jq * YB_LD + rr * 16;
                const pg8::f32x4 y0 = *(PG8_LAS const pg8::f32x4*)(yp), y1 = *(PG8_LAS const pg8::f32x4*)(yp + 4), y2 = *(PG8_LAS const pg8::f32x4*)(yp + 8), y3 = *(PG8_LAS const pg8::f32x4*)(yp + 12);
                const pg8::f32x4 ys = (y0 + y1) + (y2 + y3);
                const float y = (ys[0] + ys[1]) + (ys[2] + ys[3]);
                const int t = ch * CSTEPS + (g8 >> 1) * 16 + jq;
                YR[((size_t)b * SEQ + t) * 512 + h * 64 + irow] = f2bf(y);
                asm volatile("s_waitcnt lgkmcnt(0)" ::: "memory");
            }
        }
#undef SCAN_LOADW
#undef SCAN_STEPS
    }
#undef SCAN_DMA
}
__device__ __forceinline__ void phase_scan_att2(const Args& a, int l, PG8_LAS unsigned char* lds) {
    const int bx = blockIdx.x;
    const int j = (bx & 7) * 16 + (bx >> 4);
    if (((bx >> 3) & 1) == 0) scan32(a, l, j, lds);
    else {
        const int bh = j >> 1, b = bh >> 3, h = bh & 7;
#pragma unroll 1
        for (int q = 0; q < 2; ++q) { const int s = 2 * (j & 1) + q; att::unit(a, l, b, h, 7 - s, lds); att::unit(a, l, b, h, s, lds); }
        __syncthreads();
        const int tid = tid_fresh(), lane = tid & 63, wid = tid >> 6;
        float* scr = (float*)((unsigned char*)lds) + wid * (64 * 33);
        CvtItem c0, c1; float4 v0[8], v1[8];
        int it = j * 8 + wid; const int NCW = 128 * 8;
        bool h0 = cvt_decode(a, l, it, c0); if (h0) cvt_load(c0, lane, v0);
        while (h0) {
            const bool h1 = cvt_decode(a, l, it + NCW, c1); if (h1) cvt_load(c1, lane, v1);
            cvt_finish(c0, lane, v0, scr);
            it += 2 * NCW;
            h0 = h1 && cvt_decode(a, l, it, c0); if (h0) cvt_load(c0, lane, v0);
            if (h1) cvt_finish(c1, lane, v1, scr);
        }
    }
}

__device__ __forceinline__ void phase_scan2_att(const Args& a, int l, PG8_LAS unsigned char* lds, const int parts = 7) {
    const int G = gridDim.x, bx = blockIdx.x;
    const int v = (G % 8 == 0) ? (bx % 8) * (G / 8) + bx / 8 : bx;
    if (parts & 1) for (int u = v; u < 256; u += G) scan2_unit(a, u, lds);
    if (parts & 2) for (int w = v; w < 256; w += G) { const int bh = w >> 2, s = w & 3; att::unit(a, l, bh >> 3, bh & 7, 7 - s, lds); att::unit(a, l, bh >> 3, bh & 7, s, lds); }
    if (!(parts & 4)) return;
    __syncthreads();
    const int tid = tid_fresh(), lane = tid & 63, wid = tid >> 6;
    float* scr = (float*)((unsigned char*)lds) + wid * (64 * 33);
    CvtItem c0, c1; float4 v0[8], v1[8];
    int it = bx * 8 + wid; const int NCW = G * 8;
    bool h0 = cvt_decode(a, l, it, c0); if (h0) cvt_load(c0, lane, v0);
    while (h0) {
        const bool h1 = cvt_decode(a, l, it + NCW, c1); if (h1) cvt_load(c1, lane, v1);
        cvt_finish(c0, lane, v0, scr);
        it += 2 * NCW;
        h0 = h1 && cvt_decode(a, l, it, c0); if (h0) cvt_load(c0, lane, v0);
        if (h1) cvt_finish(c1, lane, v1, scr);
    }
}

__device__ __forceinline__ void phase_dense_res(const void* A, const void* WT, const float* RES, const bf16_t* RESB, bf16_t* OUT, PG8_LAS unsigned char* lds) {
    pg8::DenseSched S; S.init(A, DM, NTOK, WT, DM, DM);
    pg8::EpiBf16Res E{OUT, RES, DM, ALPHA, RESB};
    pg8::gemm_phase<pg8::EpiBf16Res, pg8::DenseSched, false>(lds, pg8::Dims{DM, DM, DM}, S, E);
}
__device__ __forceinline__ void phase_dense_bf16(const void* A, int M, const void* WT, int N, bf16_t* OUT, PG8_LAS unsigned char* lds) {
    pg8::DenseSched S; S.init(A, DM, M, WT, DM, N);
    pg8::EpiBf16 E{OUT, N};
    pg8::gemm_phase<pg8::EpiBf16, pg8::DenseSched, false>(lds, pg8::Dims{DM, DM, DM}, S, E);
}

__device__ __forceinline__ void ln_load(const bf16_t* in, int lane, uint2 (&raw)[4]) {
#pragma unroll
    for (int m = 0; m < 4; ++m) raw[m] = *(const uint2*)(in + m * 256 + lane * 4);
}
__device__ __forceinline__ void ln_calc(const uint2 (&raw)[4], const float* g, const float* bta, float* out, bf16_t* outb, int lane, float (&xn)[16]) {
    float x[16];
#pragma unroll
    for (int m = 0; m < 4; ++m) { const uint2 v = raw[m]; x[m * 4] = bflo(v.x); x[m * 4 + 1] = bfhi(v.x); x[m * 4 + 2] = bflo(v.y); x[m * 4 + 3] = bfhi(v.y); }
    float s = 0.f;
#pragma unroll
    for (int k = 0; k < 16; ++k) s += x[k];
    const float mean = wsum(s) * (1.0f / 1024.0f);
    float q = 0.f;
#pragma unroll
    for (int k = 0; k < 16; ++k) { const float d = x[k] - mean; q = fmaf(d, d, q); }
    const float var = wsum(q) * (1.0f / 1024.0f);
    const float rstd = rsqrtf(var + 1e-5f);
#pragma unroll
    for (int m = 0; m < 4; ++m) {
        const float4 gv = *(const float4*)(g + m * 256 + lane * 4), bv = *(const float4*)(bta + m * 256 + lane * 4);
        float4 o;
        o.x = (x[m * 4] - mean) * rstd * gv.x + bv.x; o.y = (x[m * 4 + 1] - mean) * rstd * gv.y + bv.y;
        o.z = (x[m * 4 + 2] - mean) * rstd * gv.z + bv.z; o.w = (x[m * 4 + 3] - mean) * rstd * gv.w + bv.w;
        xn[m * 4] = o.x; xn[m * 4 + 1] = o.y; xn[m * 4 + 2] = o.z; xn[m * 4 + 3] = o.w;
        if (out) *(float4*)(out + m * 256 + lane * 4) = o;
        uint2 ob; ob.x = pk2(o.x, o.y); ob.y = pk2(o.z, o.w); *(uint2*)(outb + m * 256 + lane * 4) = ob;
    }
}
__device__ __forceinline__ void ln_row(const bf16_t* in, const float* g, const float* bta, float* out, bf16_t* outb, int lane, float (&xn)[16]) {
    uint2 raw[4]; ln_load(in, lane, raw); ln_calc(raw, g, bta, out, outb, lane, xn);
}
__device__ __forceinline__ void phase_ln(const bf16_t* IN, const float* g, const float* bta, float* OUT, bf16_t* OUTB) {
    const int tid = tid_fresh(), lane = tid & 63, wid = tid >> 6;
    const int RS = gridDim.x * 8;
    int row = blockIdx.x * 8 + wid;
    uint2 rA[4], rB[4]; float xn[16];
    if (row < NTOK) ln_load(IN + (size_t)row * DM, lane, rA);
    while (row < NTOK) {
        const int r1 = row + RS; const bool h1 = r1 < NTOK;
        if (h1) ln_load(IN + (size_t)r1 * DM, lane, rB);
        ln_calc(rA, g, bta, OUT ? OUT + (size_t)row * DM : (float*)nullptr, OUTB + (size_t)row * DM, lane, xn);
        row = r1 + RS;
        if (!h1) break;
        if (row < NTOK) ln_load(IN + (size_t)row * DM, lane, rA);
        ln_calc(rB, g, bta, OUT ? OUT + (size_t)r1 * DM : (float*)nullptr, OUTB + (size_t)r1 * DM, lane, xn);
    }
}

__device__ __forceinline__ float treduce32(float (&p)[32], int lane) {
    float q[16], r[8], s4[4], t2[2];
#pragma unroll
    for (int i = 0; i < 16; ++i) { auto sw = __builtin_amdgcn_permlane32_swap(__float_as_uint(p[i]), __float_as_uint(p[i + 16]), false, false); q[i] = __uint_as_float(sw[0]) + __uint_as_float(sw[1]); }
    const bool L4 = (lane & 16) != 0, L3 = (lane & 8) != 0, L2 = (lane & 4) != 0, L1 = (lane & 2) != 0;
#pragma unroll
    for (int i = 0; i < 8; ++i) { const float snd = L4 ? q[i] : q[i + 8], keep = L4 ? q[i + 8] : q[i]; r[i] = keep + __shfl_xor(snd, 16); }
#pragma unroll
    for (int i = 0; i < 4; ++i) { const float snd = L3 ? r[i] : r[i + 4], keep = L3 ? r[i + 4] : r[i]; s4[i] = keep + SC_DPP(snd, 0x140); }
#pragma unroll
    for (int i = 0; i < 2; ++i) { const float snd = L2 ? s4[i] : s4[i + 2], keep = L2 ? s4[i + 2] : s4[i]; t2[i] = keep + SC_DPP(snd, 0x141); }
    const float snd = L1 ? t2[0] : t2[1], keep = L1 ? t2[1] : t2[0];
    float u = keep + SC_DPP(snd, 0x4E);
    u += SC_DPP(u, 0xB1);
    return __shfl(u, (lane & 31) * 2);
}
struct RouteRes { int e0, e1; float g0, g1; };
__device__ __forceinline__ RouteRes route_row(float mylogit, int lane, const float* BR) {
    const float s = sigmoidf_(mylogit);
    const float sel = (lane < 32) ? s + BR[lane & 31] : NEG_INF;
    const int gb = lane & ~3;
    const float v0 = __shfl(sel, gb), v1 = __shfl(sel, gb + 1), v2 = __shfl(sel, gb + 2), v3 = __shfl(sel, gb + 3);
    const float m1 = fmaxf(fmaxf(v0, v1), fmaxf(v2, v3));
    float m2;
    { const float lo01 = fminf(v0, v1), hi01 = fmaxf(v0, v1), lo23 = fminf(v2, v3), hi23 = fmaxf(v2, v3);
      m2 = fmaxf(fminf(hi01, hi23), fmaxf(lo01, lo23)); }
    float gs = (lane < 32) ? (m1 + m2) : NEG_INF;
    int gi = lane >> 2;
#pragma unroll
    for (int o = 32; o > 0; o >>= 1) { const float ov = __shfl_xor(gs, o); const int oi = __shfl_xor(gi, o); if (ov > gs || (ov == gs && oi < gi)) { gs = ov; gi = oi; } }
    const int gbest = gi;
    const float c0 = __shfl(sel, gbest * 4), c1 = __shfl(sel, gbest * 4 + 1), c2 = __shfl(sel, gbest * 4 + 2), c3 = __shfl(sel, gbest * 4 + 3);
    int j0 = 0; float b0 = c0;
    if (c1 > b0) { b0 = c1; j0 = 1; } if (c2 > b0) { b0 = c2; j0 = 2; } if (c3 > b0) { b0 = c3; j0 = 3; }
    int j1 = -1; float b1 = -3e38f;
    if (j0 != 0 && c0 > b1) { b1 = c0; j1 = 0; } if (j0 != 1 && c1 > b1) { b1 = c1; j1 = 1; } if (j0 != 2 && c2 > b1) { b1 = c2; j1 = 2; } if (j0 != 3 && c3 > b1) { b1 = c3; j1 = 3; }
    RouteRes R; R.e0 = gbest * 4 + j0; R.e1 = gbest * 4 + j1;
    const float s0 = __shfl(s, R.e0), s1 = __shfl(s, R.e1);
    const float inv = 1.0f / (s0 + s1);
    R.g0 = s0 * inv; R.g1 = s1 * inv;
    return R;
}
__device__ __forceinline__ void phase_ln2_router(const Args& a, int l, float* lds, bool dummy = false) {
    const int tid = tid_fresh(), lane = tid & 63, wid = tid >> 6;
    const bf16_t* PRE = (const bf16_t*)(a.ws + WS_PRE2);
    bf16_t* X2B = (bf16_t*)(a.ws + WS_X2B);
    const float* g = a.in[28] + (size_t)(l * 3 + 1) * DM; const float* bta = a.in[29] + (size_t)(l * 3 + 1) * DM;
    const float* WR = a.in[23]; const float* BR = a.in[24];
    unsigned* cnt = (unsigned*)(a.ws + WS_CTL) + CW_CNT + l * 32 + (dummy ? 128 : 0);
    int2* list = (int2*)(a.ws + (dummy ? WS_H : WS_LIST));
    int2* tokpos = (int2*)(a.ws + (dummy ? WS_H + 8 * MiB : WS_TOKPOS));
    float2* tokgate = (float2*)(a.ws + (dummy ? WS_H + 9 * MiB : WS_TOKGATE));
    constexpr int WR_LD = DM + 4;
    unsigned* lcnt = (unsigned*)(lds + NEXP * WR_LD);
    int* lres = (int*)(lds + NEXP * WR_LD + 64);
    __syncthreads();
    {
        float4 wv[16];
#pragma unroll
        for (int q = 0; q < 16; ++q) wv[q] = *(const float4*)(WR + (size_t)(q * NTHREADS + tid) * 4);
#pragma unroll
        for (int q = 0; q < 16; ++q) { const int idx = (q * NTHREADS + tid) * 4, k = idx >> 5, e = idx & 31;
            lds[e * WR_LD + k] = wv[q].x; lds[(e + 1) * WR_LD + k] = wv[q].y; lds[(e + 2) * WR_LD + k] = wv[q].z; lds[(e + 3) * WR_LD + k] = wv[q].w; }
    }
    if (tid < 64) lcnt[tid] = 0u;
    __syncthreads();
    int nloc = 0;
    uint2 rwa[4], rwb[4];
    { const int row0 = (blockIdx.x * 8 + wid) * 2; if (row0 < NTOK) { ln_load(PRE + (size_t)row0 * DM, lane, rwa); ln_load(PRE + (size_t)(row0 + 1) * DM, lane, rwb); } }
    for (int row = (blockIdx.x * 8 + wid) * 2; row < NTOK; row += gridDim.x * 16) {
        float xa[16], xb[16];
        ln_calc(rwa, g, bta, (float*)nullptr, X2B + (size_t)row * DM, lane, xa);
        ln_calc(rwb, g, bta, (float*)nullptr, X2B + (size_t)(row + 1) * DM, lane, xb);
        { const int rn = row + gridDim.x * 16; if (rn < NTOK) { ln_load(PRE + (size_t)rn * DM, lane, rwa); ln_load(PRE + (size_t)(rn + 1) * DM, lane, rwb); } }
        float pa[32], pb[32];
#pragma unroll
        for (int e = 0; e < NEXP; ++e) {
            float sa_ = 0.f, sb_ = 0.f;
#pragma unroll
            for (int m = 0; m < 4; ++m) { const float4 wv = *(const float4*)&lds[e * WR_LD + m * 256 + lane * 4];
                sa_ = fmaf(xa[m * 4], wv.x, sa_); sa_ = fmaf(xa[m * 4 + 1], wv.y, sa_); sa_ = fmaf(xa[m * 4 + 2], wv.z, sa_); sa_ = fmaf(xa[m * 4 + 3], wv.w, sa_);
                sb_ = fmaf(xb[m * 4], wv.x, sb_); sb_ = fmaf(xb[m * 4 + 1], wv.y, sb_); sb_ = fmaf(xb[m * 4 + 2], wv.z, sb_); sb_ = fmaf(xb[m * 4 + 3], wv.w, sb_); }
            pa[e] = sa_; pb[e] = sb_;
        }
        const float la = treduce32(pa, lane), lb = treduce32(pb, lane);
#pragma unroll
        for (int q = 0; q < 2; ++q) {
            const RouteRes R = route_row(q ? lb : la, lane, BR);
            if (lane == 0) {
                const unsigned r0 = atomicAdd(&lcnt[R.e0], 1u), r1 = atomicAdd(&lcnt[R.e1], 1u);
                int* o = lres + (wid * 32 + nloc + q) * 8;
                o[0] = row + q; o[1] = R.e0; o[2] = R.e1; o[3] = (int)r0; o[4] = (int)r1; o[5] = __float_as_int(R.g0); o[6] = __float_as_int(R.g1);
            }
        }
        nloc += 2;
    }
    __syncthreads();
    if (tid < 32) lcnt[32 + tid] = atomicAdd(&cnt[tid], lcnt[tid]);
    __syncthreads();
    for (int i = lane; i < nloc; i += 64) {
        const int* o = lres + (wid * 32 + i) * 8;
        const int row = o[0], e0 = o[1], e1 = o[2]; const unsigned r0 = lcnt[32 + e0] + (unsigned)o[3], r1 = lcnt[32 + e1] + (unsigned)o[4];
        list[(size_t)e0 * LCAP + r0] = make_int2(row, o[5]);
        list[(size_t)e1 * LCAP + r1] = make_int2(row, o[6]);
        tokpos[row * 2] = make_int2(e0, (int)r0); tokpos[row * 2 + 1] = make_int2(e1, (int)r1);
        tokgate[row] = make_float2(__int_as_float(o[5]), __int_as_float(o[6]));
    }
}

constexpr int ZERO_ROW = 32768 / 2048;
struct I2 { int x, y; };
struct MoeSched {
    int G, c, T, npn; PG8_LAS I2* tab;
    const char* A; const char* B; size_t b_e, b_pn, a_tile; int colw;
    const int2* list; int gat_row0;
    __device__ void init(PG8_LAS unsigned char* lds, const unsigned* cnt, int npn_, const void* A_, size_t a_tile_, const void* B_, size_t b_e_, size_t b_pn_, int colw_, const int2* list_, int gat_row0_) {
        const int lane = tid_fresh() & 63, x = lane & 31;
        G = gridDim.x; c = blockIdx.x; npn = npn_; A = (const char*)A_; a_tile = a_tile_; B = (const char*)B_; b_e = b_e_; b_pn = b_pn_; colw = colw_; list = list_; gat_row0 = gat_row0_;
        const unsigned cnt_l = __hip_atomic_load(cnt + x, __ATOMIC_RELAXED, __HIP_MEMORY_SCOPE_AGENT);
        const int tiles = (int)((cnt_l + 255u) >> 8);
        int inc = tiles;
#pragma unroll
        for (int o = 1; o < 32; o <<= 1) { const int t = __shfl_up(inc, o, 32); if (x >= o) inc += t; }
        tab = (PG8_LAS I2*)(lds + pg8::STAGE_BYTES + 8192);
        tab[x].x = (int)cnt_l; tab[x].y = inc - tiles;
        T = __builtin_amdgcn_readfirstlane(__shfl(inc, 31));
        __syncthreads();
    }
    __device__ __forceinline__ bool next(int i, pg8::Unit& u) const {
        const long L = (long)i * G + c; if (L >= (long)T * npn) return false;
        const int ti = (int)(L / npn), pn = (int)(L % npn);
        const int my_excl = tab[__builtin_amdgcn_mbcnt_lo(~0u, 0u) & 31].y;
        const unsigned long long m = __ballot(my_excl <= ti) & 0xffffffffull;
        const int e = __popcll(m) - 1;
        const int rt = ti - tab[e].y;
        const unsigned ce = (unsigned)tab[e].x;
        u.aux = __builtin_amdgcn_readfirstlane(e | (rt << 8)); u.aux2 = __builtin_amdgcn_readfirstlane((int)ce);
        u.row0 = ti * 256; u.col0 = pn * colw;
        u.A = A + (size_t)ti * a_tile; u.B = B + (size_t)e * b_e + (size_t)pn * b_pn;
        return true;
    }
    __device__ __forceinline__ int arow(const pg8::Unit& u, int r) const {
        const int e = u.aux & 255, rank = (u.aux >> 8) * 256 + r;
        return rank < u.aux2 ? gat_row0 + list[(size_t)e * LCAP + rank].x : ZERO_ROW;
    }
};
struct EpiSwiGLU {
    static constexpr bool PERM = true;
    bf16_t* H;
    __device__ __forceinline__ void operator()(const pg8::f32x4 (&acc)[2][2][4][2], const pg8::Unit& u, int wr, int wc, int fr, int fq) const {
        const int col = u.col0 + wc * 32 + 8 * fq;
#pragma unroll
        for (int ai = 0; ai < 2; ++ai)
#pragma unroll
            for (int m = 0; m < 4; ++m) {
                const int r = wr * 64 + fr + ai * 128 + m * 16;
                float hv[8];
#pragma unroll
                for (int n = 0; n < 2; ++n)
#pragma unroll
                    for (int j = 0; j < 4; ++j) { const float g = acc[ai][0][m][n][j], up = acc[ai][1][m][n][j]; hv[n * 4 + j] = g * up * __builtin_amdgcn_rcpf(1.0f + __expf(-g)); }
                pg8::u32x4 w; w.x = pk2(hv[0], hv[1]); w.y = pk2(hv[2], hv[3]); w.z = pk2(hv[4], hv[5]); w.w = pk2(hv[6], hv[7]);
                *(pg8::u32x4*)(H + (size_t)(u.row0 + r) * DEXP + col) = w;
            }
    }
};
__device__ __forceinline__ void phase_f3(const Args& a, int l, PG8_LAS unsigned char* lds) {
    const unsigned* cnt = (const unsigned*)(a.ws + WS_CTL) + CW_CNT + l * 32;
    const int2* list = (const int2*)(a.ws + WS_LIST);
    MoeSched S; S.init(lds, cnt, 4, a.ws, 0, a.ws + WS_WEXP, (size_t)1024 * 1024 * 2, (size_t)256 * 1024 * 2, 128, list, (int)(WS_X2B / 2048));
    EpiSwiGLU E{(bf16_t*)(a.ws + WS_H)};
    pg8::gemm_phase<EpiSwiGLU, MoeSched, true>(lds, pg8::Dims{DM, DM, DM}, S, E);
}
__device__ __forceinline__ void phase_f4(const Args& a, int l, PG8_LAS unsigned char* lds) {
    const unsigned* cnt = (const unsigned*)(a.ws + WS_CTL) + CW_CNT + l * 32;
    MoeSched S; S.init(lds, cnt, 4, a.ws + WS_H, (size_t)256 * DEXP * 2, a.ws + WS_WEXP + (size_t)NEXP * 1024 * 1024 * 2, (size_t)1024 * 512 * 2, (size_t)256 * 512 * 2, 256, nullptr, 0);
    pg8::EpiBf16 E{(bf16_t*)(a.ws + WS_Y), DM};
    pg8::gemm_phase<pg8::EpiBf16, MoeSched, false>(lds, pg8::Dims{DEXP, DEXP, DEXP}, S, E);
}
__device__ __forceinline__ void phase_ln3(const Args& a, int l, float* OUT, bf16_t* OUTB) {
    const int tid = tid_fresh(), lane = tid & 63, wid = tid >> 6;
    const unsigned* cnt = (const unsigned*)(a.ws + WS_CTL) + CW_CNT + l * 32;
    const int2* tokpos = (const int2*)(a.ws + WS_TOKPOS);
    const bf16_t* X2B = (const bf16_t*)(a.ws + WS_X2B); const bf16_t* Y = (const bf16_t*)(a.ws + WS_Y);
    const float* g = a.in[28] + (size_t)(l * 3 + 2) * DM; const float* bta = a.in[29] + (size_t)(l * 3 + 2) * DM;
    int mybase = 0;
    { int acc = 0; for (int x = 0; x < NEXP; ++x) { if (x == lane) mybase = acc; acc += (int)((cnt[x] + 255u) >> 8); } }
    struct TP { int2 p0, p1; float2 tg; };
    struct RowIn { uint2 x[4], y0[4], y1[4]; float2 tg; };
    auto tp_load = [&](int row, TP& t) { t.p0 = tokpos[row * 2]; t.p1 = tokpos[row * 2 + 1]; t.tg = ((const float2*)(a.ws + WS_TOKGATE))[row]; };
    auto row_load = [&](int row, const TP& t, RowIn& r) {
        const size_t h0 = (size_t)__shfl(mybase, t.p0.x) * 256 + t.p0.y, h1 = (size_t)__shfl(mybase, t.p1.x) * 256 + t.p1.y;
        const bf16_t* xr = X2B + (size_t)row * DM; const bf16_t* y0 = Y + h0 * DM; const bf16_t* y1 = Y + h1 * DM;
        r.tg = t.tg;
#pragma unroll
        for (int m = 0; m < 4; ++m) { const int o = m * 256 + lane * 4; r.x[m] = *(const uint2*)(xr + o); r.y0[m] = *(const uint2*)(y0 + o); r.y1[m] = *(const uint2*)(y1 + o); }
    };
    auto row_fin = [&](int row, const RowIn& r) {
        const float2 tg = r.tg;
        float x[16];
#pragma unroll
        for (int m = 0; m < 4; ++m) { const uint2 xb_ = r.x[m]; const float4 xv = make_float4(bflo(xb_.x), bfhi(xb_.x), bflo(xb_.y), bfhi(xb_.y)); const uint2 a0 = r.y0[m], a1 = r.y1[m];
            x[m * 4] = fmaf(ALPHA, xv.x, fmaf(tg.x, bflo(a0.x), tg.y * bflo(a1.x))); x[m * 4 + 1] = fmaf(ALPHA, xv.y, fmaf(tg.x, bfhi(a0.x), tg.y * bfhi(a1.x)));
            x[m * 4 + 2] = fmaf(ALPHA, xv.z, fmaf(tg.x, bflo(a0.y), tg.y * bflo(a1.y))); x[m * 4 + 3] = fmaf(ALPHA, xv.w, fmaf(tg.x, bfhi(a0.y), tg.y * bfhi(a1.y))); }
        float s_ = 0.f;
#pragma unroll
        for (int k = 0; k < 16; ++k) s_ += x[k];
        const float mean = wsum(s_) * (1.0f / 1024.0f);
        float q = 0.f;
#pragma unroll
        for (int k = 0; k < 16; ++k) { const float d = x[k] - mean; q = fmaf(d, d, q); }
        const float rstd = rsqrtf(wsum(q) * (1.0f / 1024.0f) + 1e-5f);
#pragma unroll
        for (int m = 0; m < 4; ++m) { const int o = m * 256 + lane * 4; const float4 gv = *(const float4*)(g + o), bv = *(const float4*)(bta + o); float4 rr;
            rr.x = (x[m * 4] - mean) * rstd * gv.x + bv.x; rr.y = (x[m * 4 + 1] - mean) * rstd * gv.y + bv.y; rr.z = (x[m * 4 + 2] - mean) * rstd * gv.z + bv.z; rr.w = (x[m * 4 + 3] - mean) * rstd * gv.w + bv.w;
            if (OUT) *(float4*)(OUT + (size_t)row * DM + o) = rr;
            if (OUTB) { uint2 ob; ob.x = pk2(rr.x, rr.y); ob.y = pk2(rr.z, rr.w); *(uint2*)(OUTB + (size_t)row * DM + o) = ob; } }
    };
    const int RS = gridDim.x * 8;
    int r = blockIdx.x * 8 + wid;
    TP pA, pB; RowIn iA, iB;
    bool vA = r < NTOK, vB = r + RS < NTOK;
    if (vA) tp_load(r, pA);
    if (vB) tp_load(r + RS, pB);
    if (vA) row_load(r, pA, iA);
    while (vA) {
        if (vB) row_load(r + RS, pB, iB);
        const bool vC = r + 2 * RS < NTOK; if (vC) tp_load(r + 2 * RS, pA);
        row_fin(r, iA);
        if (!vB) break;
        if (vC) row_load(r + 2 * RS, pA, iA);
        const bool vD = r + 3 * RS < NTOK; if (vD) tp_load(r + 3 * RS, pB);
        row_fin(r + RS, iB);
        r += 2 * RS; vA = vC; vB = vD;
    }
}

constexpr int PH_PER_LAYER = 15, N_PHASES = 1 + 2 * PH_PER_LAYER;

__global__ void __launch_bounds__(NTHREADS, 2) mk_fwd(Args a) {
    extern __shared__ __attribute__((aligned(16))) unsigned char smem[];
    float* lds = (float*)smem;
    PG8_LAS unsigned char* lds3 = (PG8_LAS unsigned char*)smem;
    volatile LAS unsigned* xbw = (volatile LAS unsigned*)(smem + LDS_BYTES - 16);
    const int lo = a.ph_lo, hi = a.ph_hi;
    unsigned* ctl = (unsigned*)(a.ws + WS_CTL);
    XcdBarrier bar; bar.bar = ctl + CW_BAR; bar.x = 0; bar.st = xbw;
    if (hi - lo > 1) {
        if (threadIdx.x == 0) { xbw[0] = 0u; xbw[1] = 0u; }
        __syncthreads();
        bar = xcd_barrier_post(ctl + CW_BAR, xbw);
    }
#define IN(k) (lo <= (k) && (k) < hi)
#define SEAM(k) do { if (IN(k) && IN((k) + 1)) xcd_barrier(bar); \
        if (PROBE_T >= 0) { const long long now_ = wall_clock64(); if (PROBE_T == ((k) == 0 ? 99 : ((k) - 1) % PH_PER_LAYER)) { const long long d_ = now_ - t_seam; while (wall_clock64() - now_ < d_) {} t_seam = wall_clock64(); } else t_seam = now_; } } while (0)
    long long t_seam = (PROBE_T >= 0) ? wall_clock64() : 0;
    if (IN(0)) { phase_prologue(a, lds); if (PROBE_REP == 99) { xcd_barrier(bar); phase_prologue(a, lds); } }
    SEAM(0);
#define LAYER_BODY(l) do { \
        const int p0 = 1 + l * PH_PER_LAYER; \
        const float* xin = (l == 0) ? a.in[0] : (const float*)nullptr; const bf16_t* xinb = (l == 0) ? (const bf16_t*)nullptr : (const bf16_t*)(a.ws + WS_XB);     \
        float* xout = (l == 0) ? (float*)nullptr : a.out; \
        if (IN(p0 + 0)) { phase_g1(a, l, lds3); if (PROBE_REP == 0) { xcd_barrier(bar); phase_g1(a, l, lds3); } } \
        SEAM(p0 + 0); \
        if (IN(p0 + 1)) { phase_prep(a, l, lds); if (PROBE_REP == 1) { xcd_barrier(bar); phase_prep(a, l, lds); } } \
        SEAM(p0 + 1); \
        if (IN(p0 + 2)) { phase_prep2(a, lds); if (PROBE_REP == 2) { xcd_barrier(bar); phase_prep2(a, lds, true); } } \
        SEAM(p0 + 2); \
        if (IN(p0 + 3)) { phase_scan2_att(a, l, lds3); if (PROBE_REP == 3) { xcd_barrier(bar); phase_scan2_att(a, l, lds3); } if (PROBE_REP >= 31 && PROBE_REP <= 37) { xcd_barrier(bar); phase_scan2_att(a, l, lds3, PROBE_REP - 30); } } \
        SEAM(p0 + 3); \
        if (IN(p0 + 4)) { phase_post(a, l); if (PROBE_REP == 4) { xcd_barrier(bar); phase_post(a, l); } } \
        SEAM(p0 + 4); \
        if (IN(p0 + 5)) { phase_dense_res(a.ws + WS_MIX, a.ws + WS_WOUT + (size_t)l * 2 * MiB, xin, xinb, (bf16_t*)(a.ws + WS_PRE), lds3); if (PROBE_REP == 5) { xcd_barrier(bar); phase_dense_res(a.ws + WS_MIX, a.ws + WS_WOUT + (size_t)l * 2 * MiB, xin, xinb, (bf16_t*)(a.ws + WS_PRE), lds3); } } \
        SEAM(p0 + 5); \
        if (IN(p0 + 6)) { phase_ln((const bf16_t*)(a.ws + WS_PRE), a.in[28] + (size_t)(l * 3) * DM, a.in[29] + (size_t)(l * 3) * DM, (float*)nullptr, (bf16_t*)(a.ws + WS_X1B)); if (PROBE_REP == 6) { xcd_barrier(bar); phase_ln((const bf16_t*)(a.ws + WS_PRE), a.in[28] + (size_t)(l * 3) * DM, a.in[29] + (size_t)(l * 3) * DM, (float*)nullptr, (bf16_t*)(a.ws + WS_X1B)); } } \
        SEAM(p0 + 6); \
        if (IN(p0 + 7)) { phase_dense_bf16(a.ws + WS_X1B, NTOK, a.ws + WS_WQ + (size_t)l * 2 * MiB, DM, (bf16_t*)(a.ws + WS_Q), lds3); if (PROBE_REP == 7) { xcd_barrier(bar); phase_dense_bf16(a.ws + WS_X1B, NTOK, a.ws + WS_WQ + (size_t)l * 2 * MiB, DM, (bf16_t*)(a.ws + WS_Q), lds3); } } \
        SEAM(p0 + 7); \
        if (IN(p0 + 8)) { phase_matt_s(a, lds3); if (PROBE_REP == 8) { xcd_barrier(bar); phase_matt_s(a, lds3); } } \
        SEAM(p0 + 8); \
        if (IN(p0 + 9)) { phase_matt_pv(a, lds3); if (PROBE_REP == 9) { xcd_barrier(bar); phase_matt_pv(a, lds3); } } \
        SEAM(p0 + 9); \
        if (IN(p0 + 10)) { phase_dense_res(a.ws + WS_O, a.ws + WS_WO + (size_t)l * 2 * MiB, (const float*)nullptr, (const bf16_t*)(a.ws + WS_X1B), (bf16_t*)(a.ws + WS_PRE2), lds3); if (PROBE_REP == 10) { xcd_barrier(bar); phase_dense_res(a.ws + WS_O, a.ws + WS_WO + (size_t)l * 2 * MiB, (const float*)nullptr, (const bf16_t*)(a.ws + WS_X1B), (bf16_t*)(a.ws + WS_PRE2), lds3); } } \
        SEAM(p0 + 10); \
        if (IN(p0 + 11)) { phase_ln2_router(a, l, lds); if (PROBE_REP == 11) { xcd_barrier(bar); phase_ln2_router(a, l, lds, true); } } \
        SEAM(p0 + 11); \
        if (IN(p0 + 12)) { phase_f3(a, l, lds3); if (PROBE_REP == 12) { xcd_barrier(bar); phase_f3(a, l, lds3); } } \
        SEAM(p0 + 12); \
        if (IN(p0 + 13)) { phase_f4(a, l, lds3); if (PROBE_REP == 13) { xcd_barrier(bar); phase_f4(a, l, lds3); } } \
        SEAM(p0 + 13); \
        if (IN(p0 + 14)) { { phase_ln3(a, l, xout, (l == 0) ? (bf16_t*)(a.ws + WS_XB) : (bf16_t*)nullptr); } if (PROBE_REP == 14) { xcd_barrier(bar); { phase_ln3(a, l, xout, (l == 0) ? (bf16_t*)(a.ws + WS_XB) : (bf16_t*)nullptr); } } } \
        SEAM(p0 + 14); \
    } while (0)
    LAYER_BODY(0);
    LAYER_BODY(1);
}
}

extern "C" void kernel_launch(void* const* d_in, const int* in_sizes, int n_in, void* d_out, int out_size, void* d_ws, size_t ws_size, hipStream_t stream) {
    static int grid = 0;
    if (!grid) {
        int dev = 0, cus = 0, per_cu = 0;
        (void)hipGetDevice(&dev);
        (void)hipDeviceGetAttribute(&cus, hipDeviceAttributeMultiprocessorCount, dev);
        (void)hipFuncSetAttribute((const void*)mk_fwd, hipFuncAttributeMaxDynamicSharedMemorySize, LDS_BYTES);
        (void)hipOccupancyMaxActiveBlocksPerMultiprocessor(&per_cu, mk_fwd, NTHREADS, LDS_BYTES);
        (void)hipGetLastError();
        grid = cus * 1;
        if (grid != 256) grid = 256;
    }
    if (ws_size < WS_END) return;
    (void)hipMemsetAsync(d_ws, 0, CTL_ZERO_BYTES, stream);
    Args a;
    memset(&a, 0, sizeof(a));
    for (int i = 0; i < 30; ++i) a.in[i] = (const float*)d_in[i];
    a.out = (float*)d_out; a.ws = (unsigned char*)d_ws;
#if MK_ONE_LAUNCH
    a.ph_lo = 0; a.ph_hi = N_PHASES;
    hipLaunchKernelGGL(mk_fwd, dim3(grid), dim3(NTHREADS), LDS_BYTES, stream, a);
#else
    for (int p = 0; p < N_PHASES; ++p) {
        a.ph_lo = p; a.ph_hi = p + 1;
        hipLaunchKernelGGL(mk_fwd, dim3(grid), dim3(NTHREADS), LDS_BYTES, stream, a);
    }
#endif
}
```

```cpp
#include <hip/hip_runtime.h>
#include <stdint.h>
#include <cstring>

#ifndef PROBE_REP
#define PROBE_REP -1
#endif
#ifndef PROBE_T
#define PROBE_T -1
#endif
#ifndef MK_ONE_LAUNCH
#define MK_ONE_LAUNCH 1
#endif

namespace {
constexpr int NTHREADS = 512;
constexpr int NTOK = 16384, SEQ = 2048, NBATCH = 8, DM = 1024;
constexpr int MEMLEN = 256;
constexpr int NH = 8, HD = 64;
constexpr int IN_COLS = 3328, ZLD = 3584;
constexpr int C_Q = 0, C_K = 512, C_V = 1024, C_R = 1536, C_KR = 2048, C_VR = 2560, C_ZW = 3072, C_ZA = 3136, C_ZG = 3200, C_ZV = 3328;
constexpr int NEXP = 32, DEXP = 512;
constexpr int LCAP = 16384;
constexpr float ALPHA = 1.4142135623730951f;
constexpr float NEG_INF = -1e30f;
constexpr int LDS_BYTES = 147456;

typedef unsigned short bf16_t;
typedef float f32x2_t __attribute__((ext_vector_type(2)));
typedef __bf16 bf16x2_t __attribute__((ext_vector_type(2)));
__device__ __forceinline__ unsigned pk2(float lo, float hi) { f32x2_t v = {lo, hi}; bf16x2_t b = __builtin_convertvector(v, bf16x2_t); return __builtin_bit_cast(unsigned, b); }
__device__ __forceinline__ bf16_t f2bf(float f) { return (bf16_t)(pk2(f, 0.f) & 0xffffu); }
__device__ __forceinline__ float bf2f(bf16_t h) { return __uint_as_float((unsigned)h << 16); }
__device__ __forceinline__ float bflo(unsigned u) { return __uint_as_float(u << 16); }
__device__ __forceinline__ float bfhi(unsigned u) { return __uint_as_float(u & 0xffff0000u); }

constexpr size_t MiB = 1u << 20;
constexpr size_t WS_CTL = 0, CTL_ZERO_BYTES = 64 * 1024;
constexpr size_t WS_LIST = 2 * MiB;
constexpr size_t WS_KB = 6 * MiB;
constexpr size_t WS_TOKPOS = 10 * MiB;
constexpr size_t WS_TOKGATE = 10 * MiB + 512 * 1024;
constexpr size_t WS_KMEAN = 11 * MiB;
constexpr size_t WS_MEMB = 12 * MiB;
constexpr size_t WS_VT = 16 * MiB;
constexpr size_t WS_WIN0 = 24 * MiB, WS_WIN1 = 31 * MiB;
constexpr size_t WS_WOUT = 38 * MiB, WS_WQ = 42 * MiB, WS_WKV = 46 * MiB, WS_WO = 54 * MiB;
constexpr size_t WS_WEXP = 58 * MiB;
constexpr size_t WS_XL1 = 154 * MiB, WS_XB = 218 * MiB, WS_VFIRST = 250 * MiB;
constexpr size_t WS_Z = 266 * MiB, WS_MIX = 378 * MiB, WS_R3 = 410 * MiB, WS_END = 508 * MiB;
constexpr int REC_TG = 644;
constexpr size_t WS_REC = 410 * MiB;
constexpr size_t WS_YRAW = 492 * MiB;
constexpr size_t WS_RVT = 154 * MiB, WS_RG = 170 * MiB;
constexpr size_t WS_BON = 20 * MiB;
constexpr size_t WS_LORA = 22 * MiB;
constexpr size_t LORA_L = 512 * 288 * 2, LORA_I = 512 * 64 * 2, LORA_G = 2 * 512 * 64 * 2, LORA_V = LORA_G + 512 * 128 * 2;
constexpr size_t WS_LSUM = 21 * MiB;
constexpr size_t WS_P = 298 * MiB;
constexpr size_t WS_PRE = 266 * MiB, WS_X1 = 410 * MiB, WS_X1B = 474 * MiB;
constexpr size_t WS_Q = 330 * MiB, WS_KV = 362 * MiB, WS_O = 266 * MiB, WS_PRE2 = 330 * MiB;
constexpr size_t WS_X2 = 410 * MiB, WS_X2B = 474 * MiB;
constexpr size_t WS_H = 266 * MiB, WS_Y = 306 * MiB;

constexpr int CW_CNT = 0;
constexpr int CW_BAR = 1024;
constexpr int CW_TILE = 5120;
constexpr int CW_F4CTR = 5632;

#define XB_TMO      128
#define XB_XCNT(j)  (256  + 64 * (j))
#define XB_XSUB(j)  (1280 + 64 * (j))
#define XB_XGEN(j)  (2304 + 64 * (j))
#define XB_TOP      3328
#define XB_TOPGEN   3392
#define XCD_BAR_WORDS 3456
#define XB_SPIN_CAP (1u << 18)
#define LAS __attribute__((address_space(3)))
__device__ __forceinline__ unsigned xb_ld(unsigned* p)              { return __hip_atomic_load(p, __ATOMIC_RELAXED, __HIP_MEMORY_SCOPE_AGENT); }
__device__ __forceinline__ unsigned xb_add(unsigned* p, unsigned v) { return __hip_atomic_fetch_add(p, v, __ATOMIC_RELAXED, __HIP_MEMORY_SCOPE_AGENT); }
__device__ __forceinline__ unsigned xb_xcc_id() { return (unsigned)__builtin_amdgcn_s_getreg((3 << 11) | 20) & 0xFu; }
#define XB_SPIN(cond, bar) do { unsigned _sp = 0; while (cond) { __builtin_amdgcn_s_sleep(1); \
    if ((++_sp & 255u) == 0u) { if (xb_ld(&(bar)[XB_TMO])) break; if (_sp > XB_SPIN_CAP) { atomicAdd(&(bar)[XB_TMO], 1u); break; } } } } while (0)
struct XcdBarrier { unsigned* bar; unsigned x; volatile LAS unsigned* st; };
__device__ __forceinline__ XcdBarrier xcd_barrier_post(unsigned* bar, volatile LAS unsigned* st) {
    XcdBarrier b; b.bar = bar; b.x = xb_xcc_id(); b.st = st;
    if (threadIdx.x == 0) (void)xb_add(&bar[XB_XCNT(b.x)], 1u);
    return b;
}
__device__ __forceinline__ void xcd_barrier_complete(unsigned* bar, unsigned x, unsigned& nloc, unsigned& nx) {
    const unsigned G = gridDim.x * gridDim.y * gridDim.z;
    unsigned sum, cnt, mine, sp = 0u;
    for (;;) {
        sum = 0u; cnt = 0u; mine = 0u;
#pragma unroll
        for (unsigned j = 0; j < 16; ++j) { const unsigned c = xb_ld(&bar[XB_XCNT(j)]); sum += c; cnt += (c > 0u) ? 1u : 0u; mine = (j == x) ? c : mine; }
        if (sum == G) break;
        __builtin_amdgcn_s_sleep(1);
        if ((++sp & 255u) == 0u) { if (xb_ld(&bar[XB_TMO])) break; if (sp > XB_SPIN_CAP) { atomicAdd(&bar[XB_TMO], 1u); break; } }
    }
    nloc = mine > 0u ? mine : 1u; nx = cnt > 0u ? cnt : 1u;
}
__device__ __forceinline__ void xcd_barrier(const XcdBarrier& b) {
    asm volatile("s_waitcnt vmcnt(0)" ::: "memory");
    __syncthreads();
    if (threadIdx.x == 0) {
        unsigned* bar = b.bar;
        __builtin_amdgcn_s_waitcnt(0);
        unsigned nloc = b.st[0], nx = b.st[1];
        if (nloc == 0u) { xcd_barrier_complete(bar, b.x, nloc, nx); b.st[0] = nloc; b.st[1] = nx; }
        const unsigned old = xb_add(&bar[XB_XSUB(b.x)], 1u);
        const unsigned gen = old / nloc;
        if (old + 1u == (gen + 1u) * nloc) {
            __builtin_amdgcn_fence(__ATOMIC_RELEASE, "agent");
            asm volatile("s_waitcnt vmcnt(0)" ::: "memory");
            const unsigned og = xb_add(&bar[XB_TOP], 1u);
            const unsigned tg = og / nx;
            if (og + 1u == (tg + 1u) * nx) xb_add(&bar[XB_TOPGEN], 1u);
            else XB_SPIN(xb_ld(&bar[XB_TOPGEN]) == tg, bar);
            __builtin_amdgcn_fence(__ATOMIC_ACQUIRE, "agent");
            xb_add(&bar[XB_XGEN(b.x)], 1u);
            asm volatile("s_waitcnt vmcnt(0)" ::: "memory");
        } else {
            XB_SPIN(xb_ld(&bar[XB_XGEN(b.x)]) == gen, bar);
            __builtin_amdgcn_fence(__ATOMIC_ACQUIRE, "agent");
            asm volatile("s_waitcnt vmcnt(0)" ::: "memory");
        }
    }
    __syncthreads();
}

__device__ __forceinline__ int tid_fresh() { int t = threadIdx.x; asm volatile("" : "+v"(t)); return t; }
template <int CTRL> __device__ __forceinline__ float dppf(float v) { return __int_as_float(__builtin_amdgcn_mov_dpp(__float_as_int(v), CTRL, 0xF, 0xF, true)); }
__device__ __forceinline__ float wsum(float v) {
    v += dppf<0xB1>(v); v += dppf<0x4E>(v); v += dppf<0x141>(v); v += dppf<0x140>(v);
    auto r16 = __builtin_amdgcn_permlane16_swap(__float_as_uint(v), __float_as_uint(v), false, false); v = __uint_as_float(r16[0]) + __uint_as_float(r16[1]);
    auto r32 = __builtin_amdgcn_permlane32_swap(__float_as_uint(v), __float_as_uint(v), false, false); v = __uint_as_float(r32[0]) + __uint_as_float(r32[1]);
    return v;
}
__device__ __forceinline__ float wmax(float v) {
#pragma unroll
    for (int o = 32; o > 0; o >>= 1) v = fmaxf(v, __shfl_xor(v, o));
    return v;
}
__device__ __forceinline__ float sigmoidf_(float x) { return 1.0f / (1.0f + __expf(-x)); }
__device__ __forceinline__ float sigmoid_fast(float x) { return __builtin_amdgcn_rcpf(1.0f + __expf(-x)); }
__device__ __forceinline__ float softplusf_(float x) { return x > 20.f ? x : log1pf(__expf(x)); }

struct Args {
    const float* in[30];
    float* out;
    unsigned char* ws;
    int ph_lo, ph_hi;
};

namespace pg8 {
#define PG8_LAS __attribute__((address_space(3)))
typedef short bf16x8 __attribute__((ext_vector_type(8)));
typedef float f32x4 __attribute__((ext_vector_type(4)));
typedef unsigned u32x4 __attribute__((ext_vector_type(4)));
constexpr int BM = 256, BK = 64, HALF = 128, HTB = HALF * BK * 2, STAGE_BYTES = 8 * HTB, NXCD = 8, WGM = 8;

__host__ __device__ __forceinline__ int lds_byte(int r, int c) { const int st = (r >> 4) * 2 + (c >> 5), rr = r & 15, cc = c & 31, ob = rr * 64 + cc * 2; return st * 1024 + (ob ^ (((ob >> 9) & 1) << 5)); }
__host__ __device__ __forceinline__ void stage_rc(int b, int& R, int& C) { const int st = b / 1024, sb = b % 1024, swz = sb ^ (((sb >> 9) & 1) << 5); R = (st >> 1) * 16 + swz / 64; C = (st & 1) * 32 + (swz % 64) / 2; }
__host__ __device__ __forceinline__ int perm32(int rho) { const int n = rho >> 4, i = rho & 15; return 8 * (i >> 2) + 4 * n + (i & 3); }

struct Unit { const char* A; const char* B; int row0, col0, aux, aux2; };
struct Dims { int lda, ldb, K; };

struct TileOrder {
    int nM, nN, nwg, G, c;
    __device__ void init(int nM_, int nN_, int G_, int c_) { nM = nM_; nN = nN_; nwg = nM * nN; G = G_; c = c_; }
    __device__ bool tile(int i, int& pm, int& pn) const {
        const long L = (long)i * G + c; if (L >= nwg) return false;
        int wgid = (int)L; { const int q = nwg / NXCD, r = nwg % NXCD, xcd = wgid % NXCD, off = wgid / NXCD; wgid = (xcd < r ? xcd * (q + 1) : r * (q + 1) + (xcd - r) * q) + off; }
        const int nig = WGM * nN, gid = wgid / nig, fm = gid * WGM, gsz = (nM - fm) < WGM ? (nM - fm) : WGM;
        pm = fm + ((wgid % nig) % gsz); pn = (wgid % nig) / gsz; return true;
    }
};
struct DenseSched {
    TileOrder o; const char* A; const char* B; int lda, ldb;
    __device__ void init(const void* A_, int lda_, int M, const void* B_, int ldb_, int N) { A = (const char*)A_; B = (const char*)B_; lda = lda_; ldb = ldb_; o.init(M / BM, N / BM, gridDim.x, blockIdx.x); }
    __device__ __forceinline__ bool next(int i, Unit& u) const { int pm, pn; if (!o.tile(i, pm, pn)) return false;
        u.A = A + (size_t)pm * BM * lda * 2; u.B = B + (size_t)pn * BM * ldb * 2; u.row0 = pm * BM; u.col0 = pn * BM; u.aux = 0; u.aux2 = 0; return true; }
    __device__ __forceinline__ int arow(const Unit&, int r) const { return r; }
};

__device__ __forceinline__ unsigned cvt_pk_bf16(float lo, float hi) { unsigned r; asm volatile("v_cvt_pk_bf16_f32 %0, %1, %2" : "=v"(r) : "v"(lo), "v"(hi)); return r; }

struct EpiBf16 {
    static constexpr bool PERM = true;
    bf16_t* O; int ldc;
    __device__ __forceinline__ void operator()(const f32x4 (&acc)[2][2][4][2], const Unit& u, int wr, int wc, int fr, int fq) const {
        const int row0 = u.row0 + wr * 64 + fr, col0 = u.col0 + wc * 32 + 8 * fq;
#pragma unroll
        for (int ai = 0; ai < 2; ++ai)
#pragma unroll
            for (int m = 0; m < 4; ++m) { bf16_t* rowp = O + (size_t)(row0 + ai * HALF + m * 16) * ldc + col0;
#pragma unroll
                for (int bj = 0; bj < 2; ++bj) { const f32x4 v0 = acc[ai][bj][m][0], v1 = acc[ai][bj][m][1];
                    u32x4 w; w.x = cvt_pk_bf16(v0[0], v0[1]); w.y = cvt_pk_bf16(v0[2], v0[3]); w.z = cvt_pk_bf16(v1[0], v1[1]); w.w = cvt_pk_bf16(v1[2], v1[3]);
                    *(u32x4*)(rowp + bj * HALF) = w; } }
    }
};
struct EpiF32Res {
    static constexpr bool PERM = false;
    float* C; const float* RES; int ldc; float rs; const bf16_t* RESB;
    __device__ __forceinline__ void operator()(const f32x4 (&acc)[2][2][4][2], const Unit& u, int wr, int wc, int fr, int fq) const {
        const int row0 = u.row0 + wr * 64 + fr, col0 = u.col0 + wc * 32 + 4 * fq;
#pragma unroll
        for (int ai = 0; ai < 2; ++ai)
#pragma unroll
            for (int m = 0; m < 4; ++m) { const size_t ro = (size_t)(row0 + ai * HALF + m * 16) * ldc + col0;
#pragma unroll
                for (int bj = 0; bj < 2; ++bj)
#pragma unroll
                    for (int n = 0; n < 2; ++n) { f32x4 r;
                        if (RESB) { const uint2 rb = *(const uint2*)(RESB + ro + bj * HALF + n * 16); r = (f32x4){bflo(rb.x), bfhi(rb.x), bflo(rb.y), bfhi(rb.y)}; }
                        else r = *(const f32x4*)(RES + ro + bj * HALF + n * 16);
                        *(f32x4*)(C + ro + bj * HALF + n * 16) = acc[ai][bj][m][n] + r * rs; } }
    }
};

struct EpiBf16Res {
    static constexpr bool PERM = true;
    bf16_t* O; const float* RES; int ldc; float rs; const bf16_t* RESB;
    __device__ __forceinline__ void operator()(const f32x4 (&acc)[2][2][4][2], const Unit& u, int wr, int wc, int fr, int fq) const {
        const int row0 = u.row0 + wr * 64 + fr, col0 = u.col0 + wc * 32 + 8 * fq;
#pragma unroll
        for (int ai = 0; ai < 2; ++ai)
#pragma unroll
            for (int m = 0; m < 4; ++m) { const size_t ro = (size_t)(row0 + ai * HALF + m * 16) * ldc + col0;
#pragma unroll
                for (int bj = 0; bj < 2; ++bj) { f32x4 r0, r1;
                    if (RESB) { const uint4 rb = *(const uint4*)(RESB + ro + bj * HALF); r0 = (f32x4){bflo(rb.x), bfhi(rb.x), bflo(rb.y), bfhi(rb.y)}; r1 = (f32x4){bflo(rb.z), bfhi(rb.z), bflo(rb.w), bfhi(rb.w)}; }
                    else { r0 = *(const f32x4*)(RES + ro + bj * HALF); r1 = *(const f32x4*)(RES + ro + bj * HALF + 4); }
                    const f32x4 v0 = acc[ai][bj][m][0] + r0 * rs, v1 = acc[ai][bj][m][1] + r1 * rs;
                    u32x4 w; w.x = cvt_pk_bf16(v0[0], v0[1]); w.y = cvt_pk_bf16(v0[2], v0[3]); w.z = cvt_pk_bf16(v1[0], v1[1]); w.w = cvt_pk_bf16(v1[2], v1[3]);
                    *(u32x4*)(O + ro + bj * HALF) = w; } }
    }
};

__device__ __forceinline__ void store_bf16_tile(const f32x4 (&acc)[2][2][4][2], bf16_t* O, int ldc, int row0, int col0) {
#pragma unroll
    for (int ai = 0; ai < 2; ++ai)
#pragma unroll
        for (int m = 0; m < 4; ++m) { bf16_t* rowp = O + (size_t)(row0 + ai * HALF + m * 16) * ldc + col0;
#pragma unroll
            for (int bj = 0; bj < 2; ++bj) { const f32x4 v0 = acc[ai][bj][m][0], v1 = acc[ai][bj][m][1];
                u32x4 w; w.x = cvt_pk_bf16(v0[0], v0[1]); w.y = cvt_pk_bf16(v0[2], v0[3]); w.z = cvt_pk_bf16(v1[0], v1[1]); w.w = cvt_pk_bf16(v1[2], v1[3]);
                *(u32x4*)(rowp + bj * HALF) = w; } }
}
struct EpiG1 {
    static constexpr bool PERM = true;
    bf16_t* Z; bf16_t* KB; bf16_t* VT;
    __device__ __forceinline__ void operator()(const f32x4 (&acc)[2][2][4][2], const Unit& u, int wr, int wc, int fr, int fq) const {
        bf16_t* O = Z; int ldc = ZLD;
        if (u.aux == 1) { O = KB; ldc = 1024; } else if (u.aux >= 2) { O = VT + (size_t)(u.aux - 2) * 1024 * 256; ldc = 256; }
        store_bf16_tile(acc, O, ldc, u.row0 + wr * 64 + fr, u.col0 + wc * 32 + 8 * fq);
    }
};
struct EpiSoftmax {
    static constexpr bool PERM = true;
    bf16_t* P; float* LSUM; PG8_LAS float* xmax;
    __device__ __forceinline__ void operator()(const f32x4 (&acc)[2][2][4][2], const Unit& u, int wr, int wc, int fr, int fq) const {
        const float c = 0.0625f * 1.4426950408889634f;
#pragma unroll
        for (int ai = 0; ai < 2; ++ai)
#pragma unroll
            for (int m = 0; m < 4; ++m) {
                float mx = acc[ai][0][m][0][0];
#pragma unroll
                for (int bj = 0; bj < 2; ++bj)
#pragma unroll
                    for (int n = 0; n < 2; ++n)
#pragma unroll
                        for (int j = 0; j < 4; ++j) mx = fmaxf(mx, acc[ai][bj][m][n][j]);
                mx = fmaxf(mx, __shfl_xor(mx, 16)); mx = fmaxf(mx, __shfl_xor(mx, 32));
                if (fq == 0) xmax[wc * 256 + wr * 64 + fr + ai * 128 + m * 16] = mx;
            }
        asm volatile("s_waitcnt lgkmcnt(0)" ::: "memory"); __builtin_amdgcn_s_barrier(); asm volatile("" ::: "memory");
        const int hm = u.col0 >> 8;
#pragma unroll
        for (int ai = 0; ai < 2; ++ai)
#pragma unroll
            for (int m = 0; m < 4; ++m) {
                int r = wr * 64 + fr + ai * 128 + m * 16; asm volatile("" : "+v"(r) :: "memory");
                const float M = fmaxf(fmaxf(xmax[r], xmax[256 + r]), fmaxf(xmax[512 + r], xmax[768 + r]));
                float sum = 0.f; bf16_t* rowp = P + (size_t)(u.row0 + r) * 1024 + u.col0 + wc * 32 + 8 * fq;
#pragma unroll
                for (int bj = 0; bj < 2; ++bj) {
                    float e[8];
#pragma unroll
                    for (int n = 0; n < 2; ++n)
#pragma unroll
                        for (int j = 0; j < 4; ++j) { e[n * 4 + j] = __builtin_amdgcn_exp2f((acc[ai][bj][m][n][j] - M) * c); sum += e[n * 4 + j]; }
                    u32x4 w; w.x = pk2(e[0], e[1]); w.y = pk2(e[2], e[3]); w.z = pk2(e[4], e[5]); w.w = pk2(e[6], e[7]);
                    *(u32x4*)(rowp + bj * HALF) = w;
                }
                sum += __shfl_xor(sum, 16); sum += __shfl_xor(sum, 32);
                if (fq == 0) LSUM[((size_t)(u.row0 + r) * 4 + hm) * 4 + wc] = sum;
            }
        asm volatile("s_waitcnt lgkmcnt(0)" ::: "memory"); __builtin_amdgcn_s_barrier(); asm volatile("" ::: "memory");
    }
};
struct EpiPV {
    static constexpr bool PERM = true;
    bf16_t* O; const float* LSUM;
    __device__ __forceinline__ void operator()(const f32x4 (&acc)[2][2][4][2], const Unit& u, int wr, int wc, int fr, int fq) const {
        const int hm = u.col0 >> 8;
#pragma unroll
        for (int ai = 0; ai < 2; ++ai)
#pragma unroll
            for (int m = 0; m < 4; ++m) {
                int row = u.row0 + wr * 64 + fr + ai * 128 + m * 16; asm volatile("" : "+v"(row) :: "memory");
                const f32x4 ls = *(const f32x4*)(LSUM + ((size_t)row * 4 + hm) * 4);
                const float inv = 1.0f / ((ls[0] + ls[1]) + (ls[2] + ls[3]));
                bf16_t* rowp = O + (size_t)row * 1024 + u.col0 + wc * 32 + 8 * fq;
#pragma unroll
                for (int bj = 0; bj < 2; ++bj) { const f32x4 v0 = acc[ai][bj][m][0] * inv, v1 = acc[ai][bj][m][1] * inv;
                    u32x4 w; w.x = cvt_pk_bf16(v0[0], v0[1]); w.y = cvt_pk_bf16(v0[2], v0[3]); w.z = cvt_pk_bf16(v1[0], v1[1]); w.w = cvt_pk_bf16(v1[2], v1[3]);
                    *(u32x4*)(rowp + bj * HALF) = w; }
            }
    }
};
struct G1Sched {
    TileOrder o; const char *XB, *WIN, *MEMB, *WKV;
    __device__ void init(const void* XB_, const void* WIN_, int nN, const void* MEMB_, const void* WKV_) { XB = (const char*)XB_; WIN = (const char*)WIN_; MEMB = (const char*)MEMB_; WKV = (const char*)WKV_; o.init(64, nN, gridDim.x, blockIdx.x); }
    __device__ __forceinline__ bool next(int i, Unit& u) const {
        int pm, pn; u.aux2 = 0;
        if (o.tile(i, pm, pn)) { u.A = XB + (size_t)pm * BM * 2048; u.B = WIN + (size_t)pn * BM * 2048; u.row0 = pm * BM; u.col0 = pn * BM; u.aux = 0; return true; }
        const long L = (long)i * o.G + o.c - o.nwg;
        if (L >= 64) return false;
        if (L < 32) { pm = (int)L >> 2; pn = (int)L & 3; u.A = MEMB + (size_t)pm * BM * 2048; u.B = WKV + (size_t)pn * BM * 2048; u.row0 = pm * BM; u.col0 = pn * BM; u.aux = 1; return true; }
        const int b = ((int)L - 32) >> 2; pm = ((int)L - 32) & 3;
        u.A = WKV + (size_t)(1024 + pm * BM) * 2048; u.B = MEMB + (size_t)b * BM * 2048; u.row0 = pm * BM; u.col0 = 0; u.aux = 2 + b; return true;
    }
    __device__ __forceinline__ int arow(const Unit&, int r) const { return r; }
};
struct MattSched {
    int G, c; const char* A; const char* B; size_t b_batch; int b_head;
    __device__ void init(const void* A_, const void* B_, size_t b_batch_, int b_head_) { G = gridDim.x; c = blockIdx.x; A = (const char*)A_; B = (const char*)B_; b_batch = b_batch_; b_head = b_head_; }
    __device__ __forceinline__ bool next(int i, Unit& u) const {
        const long L = (long)i * G + c; if (L >= 256) return false;
        const int pm = (int)L >> 2, hm = (int)L & 3;
        u.A = A + ((size_t)pm * BM * 1024 + hm * 256) * 2; u.B = B + (size_t)(pm >> 3) * b_batch + (size_t)hm * b_head;
        u.row0 = pm * BM; u.col0 = hm * 256; u.aux = 0; u.aux2 = 0; return true;
    }
    __device__ __forceinline__ int arow(const Unit&, int r) const { return r; }
};

template <class Epi, class Sched, bool GATHER, int ACP = 0>
__device__ __forceinline__ void gemm_phase(PG8_LAS unsigned char* lds, const Dims g, const Sched& S, const Epi& E) {
    const int tid = tid_fresh(), wid = __builtin_amdgcn_readfirstlane(tid >> 6), wr = wid >> 2, wc = wid & 3;
    const int K = g.K, nt = K / BK;
    unsigned voffB[2];
#pragma unroll
    for (int i = 0; i < 2; ++i) { int R, C; stage_rc(tid * 16 + i * 8192, R, C); const int Rb = Epi::PERM ? ((R & ~31) + perm32(R & 31)) : R;
        voffB[i] = (unsigned)(Rb * g.ldb + C) * 2u; }
    const size_t kstep = (size_t)(BK * 2);
    const size_t hstepB = (size_t)HALF * g.ldb * 2;
    const unsigned ldsw = (unsigned)wid * 1024u;
    const int aoff = lds_byte(wr * 64 + (tid & 15), ((tid & 63) >> 4) * 8), boff = lds_byte(wc * 32 + (tid & 15), ((tid & 63) >> 4) * 8);
    const size_t hstepA = GATHER ? 0 : (size_t)HALF * g.lda * 2;
#define PG8_SA(b, h) (((b) * 2 + (h)) * HTB)
#define PG8_SB(b, h) ((4 + (b) * 2 + (h)) * HTB)
#define PG8_STAGE_X(bufoff, gbase, v0, v1, aux) do { \
        __builtin_amdgcn_global_load_lds((const unsigned*)((const char*)(gbase) + (v0)), (PG8_LAS unsigned*)(lds + (bufoff) + ldsw), 16, 0, aux); \
        __builtin_amdgcn_global_load_lds((const unsigned*)((const char*)(gbase) + (v1)), (PG8_LAS unsigned*)(lds + (bufoff) + ldsw + 8192), 16, 0, aux); } while (0)
#define PG8_STAGE(bufoff, gbase, v0, v1) PG8_STAGE_X(bufoff, gbase, v0, v1, ACP)
#define PG8_STAGEB(bufoff, gbase) PG8_STAGE_X(bufoff, gbase, voffB[0], voffB[1], 0)
#define PG8_LDA(dst, b, h) do { _Pragma("unroll") for (int m = 0; m < 4; ++m) _Pragma("unroll") for (int k = 0; k < 2; ++k) dst[m][k] = *(const PG8_LAS bf16x8*)(lds + PG8_SA(b, h) + aoff + m * 2048 + k * 1024); } while (0)
#define PG8_LDB(dst, b, h) do { _Pragma("unroll") for (int n = 0; n < 2; ++n) _Pragma("unroll") for (int k = 0; k < 2; ++k) dst[n][k] = *(const PG8_LAS bf16x8*)(lds + PG8_SB(b, h) + boff + n * 2048 + k * 1024); } while (0)
#define PG8_MMA(ai, bj, At, Bt) do { __builtin_amdgcn_s_setprio(1); _Pragma("unroll") for (int m = 0; m < 4; ++m) _Pragma("unroll") for (int n = 0; n < 2; ++n) _Pragma("unroll") for (int k = 0; k < 2; ++k) \
        acc[ai][bj][m][n] = __builtin_amdgcn_mfma_f32_16x16x32_bf16(Bt[n][k], At[m][k], acc[ai][bj][m][n], 0, 0, 0); __builtin_amdgcn_s_setprio(0); } while (0)
#define PG8_WAIT_V(n) asm volatile("s_waitcnt vmcnt(" #n ")" ::: "memory")
#define PG8_WAIT_L(n) asm volatile("s_waitcnt lgkmcnt(" #n ")" ::: "memory")
#define PG8_BAR __builtin_amdgcn_s_barrier()
#define PG8_SCHED __builtin_amdgcn_sched_barrier(0)
#define PG8_VOFFA(dst, u) do { _Pragma("unroll") for (int i_ = 0; i_ < 2; ++i_) { int R_, C_; stage_rc(tid * 16 + i_ * 8192, R_, C_); _Pragma("unroll") for (int h_ = 0; h_ < 2; ++h_) { \
        const int rr_ = GATHER ? S.arow(u, R_ + h_ * HALF) : R_; dst[h_ * 2 + i_] = (unsigned)(rr_ * g.lda + C_) * 2u; } } } while (0)
    Unit cur, nxt; int ui = 0;
    if (!S.next(0, cur)) return;
    f32x4 acc[2][2][4][2];
#pragma unroll
    for (int a = 0; a < 2; ++a)
#pragma unroll
        for (int b = 0; b < 2; ++b)
#pragma unroll
            for (int m = 0; m < 4; ++m)
#pragma unroll
                for (int n = 0; n < 2; ++n) acc[a][b][m][n] = (f32x4){0.f, 0.f, 0.f, 0.f};
    bf16x8 At[4][2], B0[2][2], B1[2][2];
    unsigned vC[4];
    PG8_VOFFA(vC, cur);
    PG8_LAS u32x4* myN = (PG8_LAS u32x4*)(lds + STAGE_BYTES + tid * 16);
    const char* cA = cur.A; const char* cB = cur.B;
    PG8_STAGEB(PG8_SB(0, 0), cB); PG8_STAGEB(PG8_SB(0, 1), cB + hstepB); PG8_STAGE(PG8_SA(0, 0), cA, vC[0], vC[1]); PG8_STAGE(PG8_SA(0, 1), cA + hstepA, vC[2], vC[3]);
    if (wr == 1) PG8_BAR;
    PG8_WAIT_V(2); PG8_BAR;
    PG8_STAGEB(PG8_SB(1, 0), cB + kstep); PG8_STAGE(PG8_SA(1, 0), cA + kstep, vC[0], vC[1]); PG8_STAGEB(PG8_SB(1, 1), cB + hstepB + kstep);
    PG8_WAIT_V(6); PG8_BAR;
    for (;;) {
        const bool has_next = S.next(ui + 1, nxt);
        const char* nA = cA; const char* nB = cB;
        { unsigned vT[4];
#pragma unroll
          for (int q = 0; q < 4; ++q) vT[q] = vC[q];
          if (has_next) { nA = nxt.A; nB = nxt.B; PG8_VOFFA(vT, nxt); }
          *myN = (u32x4){vT[0], vT[1], vT[2], vT[3]}; }
#pragma unroll 1
        for (int t = 0; t < nt; t += 2) {
            const bool last = (t == nt - 2);
            const char* a1 = cA + (size_t)(t + 1) * kstep;
            const char* a2 = last ? nA : cA + (size_t)(t + 2) * kstep; const char* b2 = last ? nB : cB + (size_t)(t + 2) * kstep;
            const char* a3 = a2 + kstep; const char* b3 = b2 + kstep;
            PG8_LDB(B0, 0, 0); PG8_LDB(B1, 0, 1); PG8_SCHED; PG8_LDA(At, 0, 0); PG8_STAGE(PG8_SA(1, 1), a1 + hstepA, vC[2], vC[3]);
            if (last) { const u32x4 vn = *myN; vC[0] = vn.x; vC[1] = vn.y; vC[2] = vn.z; vC[3] = vn.w; }
            PG8_WAIT_V(8); PG8_WAIT_L(0); PG8_BAR; PG8_MMA(0, 0, At, B0); PG8_MMA(0, 1, At, B1); PG8_BAR; PG8_SCHED;
            PG8_LDA(At, 0, 1); PG8_STAGEB(PG8_SB(0, 0), b2); PG8_STAGEB(PG8_SB(0, 1), b2 + hstepB); PG8_STAGE(PG8_SA(0, 0), a2, vC[0], vC[1]);
            PG8_WAIT_V(8); PG8_WAIT_L(0); PG8_BAR; PG8_MMA(1, 0, At, B0); PG8_MMA(1, 1, At, B1); PG8_BAR; PG8_SCHED;
            PG8_LDB(B0, 1, 0); PG8_LDB(B1, 1, 1); PG8_SCHED; PG8_LDA(At, 1, 0); PG8_STAGE(PG8_SA(0, 1), a2 + hstepA, vC[2], vC[3]);
            PG8_WAIT_V(8); PG8_WAIT_L(0); PG8_BAR; PG8_MMA(0, 0, At, B0); PG8_MMA(0, 1, At, B1); PG8_BAR; PG8_SCHED;
            PG8_LDA(At, 1, 1); PG8_STAGEB(PG8_SB(1, 0), b3); PG8_STAGEB(PG8_SB(1, 1), b3 + hstepB); PG8_STAGE(PG8_SA(1, 0), a3, vC[0], vC[1]);
            PG8_WAIT_V(8); PG8_WAIT_L(0); PG8_BAR; PG8_MMA(1, 0, At, B0); PG8_MMA(1, 1, At, B1); PG8_BAR; PG8_SCHED;
        }
        if (wr == 0) PG8_BAR;
        { int ln_ = (int)__builtin_amdgcn_mbcnt_hi(~0u, __builtin_amdgcn_mbcnt_lo(~0u, 0u)); asm volatile("" : "+v"(ln_));
          E(acc, cur, wr, wc, ln_ & 15, ln_ >> 4); }
        if (!has_next) break;
#pragma unroll
        for (int a = 0; a < 2; ++a)
#pragma unroll
            for (int b = 0; b < 2; ++b)
#pragma unroll
                for (int m = 0; m < 4; ++m)
#pragma unroll
                    for (int n = 0; n < 2; ++n) acc[a][b][m][n] = (f32x4){0.f, 0.f, 0.f, 0.f};
        cur = nxt; cA = nA; cB = nB; ++ui;
        if (wr == 1) PG8_BAR;
    }
    PG8_WAIT_V(0);
    PG8_BAR;
#undef PG8_SA
#undef PG8_SB
#undef PG8_STAGE
#undef PG8_STAGE_X
#undef PG8_STAGEB
#undef PG8_LDA
#undef PG8_LDB
#undef PG8_MMA
#undef PG8_WAIT_V
#undef PG8_WAIT_L
#undef PG8_BAR
#undef PG8_SCHED
#undef PG8_VOFFA
}
}

template <int NBM, class AF, class Epi>
__device__ __forceinline__ void sgemm_tile(float* lds, int K, AF arow, const float* __restrict__ B0, const float* __restrict__ B1, int ldb, int n0, int N, Epi epi) {
    const int tid = tid_fresh();
    float* As = lds;
    float* Bs0 = lds + 16 * 132;
    float* Bs1 = lds + 2 * 16 * 132;
    const int ty = tid >> 5, tx = tid & 31;
    float acc0[8][4], acc1[8][4];
#pragma unroll
    for (int i = 0; i < 8; ++i)
#pragma unroll
        for (int j = 0; j < 4; ++j) { acc0[i][j] = 0.f; acc1[i][j] = 0.f; }
    const int ar = tid >> 2, ak = (tid & 3) * 4;
    const float* ap = arow(ar);
    const int bk = tid >> 5, bn = (tid & 31) * 4;
    const bool bok = (n0 + bn) < N;
    for (int k0 = 0; k0 < K; k0 += 16) {
        float4 av = ap ? *(const float4*)(ap + k0 + ak) : make_float4(0.f, 0.f, 0.f, 0.f);
        float4 bv0 = bok ? *(const float4*)(B0 + (size_t)(k0 + bk) * ldb + n0 + bn) : make_float4(0.f, 0.f, 0.f, 0.f);
        float4 bv1 = make_float4(0.f, 0.f, 0.f, 0.f);
        if (NBM == 2) { if (bok) bv1 = *(const float4*)(B1 + (size_t)(k0 + bk) * ldb + n0 + bn); }
        __syncthreads();
        As[(ak + 0) * 132 + ar] = av.x; As[(ak + 1) * 132 + ar] = av.y; As[(ak + 2) * 132 + ar] = av.z; As[(ak + 3) * 132 + ar] = av.w;
        *(float4*)&Bs0[bk * 132 + bn] = bv0;
        if (NBM == 2) *(float4*)&Bs1[bk * 132 + bn] = bv1;
        __syncthreads();
#pragma unroll 2
        for (int k = 0; k < 16; ++k) {
            const float4 a0 = *(const float4*)&As[k * 132 + ty * 8], a1 = *(const float4*)&As[k * 132 + ty * 8 + 4];
            const float a[8] = {a0.x, a0.y, a0.z, a0.w, a1.x, a1.y, a1.z, a1.w};
            const float4 b0 = *(const float4*)&Bs0[k * 132 + tx * 4];
            const float bb0[4] = {b0.x, b0.y, b0.z, b0.w};
#pragma unroll
            for (int i = 0; i < 8; ++i)
#pragma unroll
                for (int j = 0; j < 4; ++j) acc0[i][j] = fmaf(a[i], bb0[j], acc0[i][j]);
            if (NBM == 2) {
                const float4 b1 = *(const float4*)&Bs1[k * 132 + tx * 4];
                const float bb1[4] = {b1.x, b1.y, b1.z, b1.w};
#pragma unroll
                for (int i = 0; i < 8; ++i)
#pragma unroll
                    for (int j = 0; j < 4; ++j) acc1[i][j] = fmaf(a[i], bb1[j], acc1[i][j]);
            }
        }
    }
    if (bok) {
#pragma unroll
        for (int i = 0; i < 8; ++i)
#pragma unroll
            for (int j = 0; j < 4; ++j) epi(ty * 8 + i, tx * 4 + j, acc0[i][j], acc1[i][j]);
    }
}

__device__ __forceinline__ void transpose_blk(const float* W, int N, bf16_t* WT, int K, int k0, int n0, int drow0, float* scr, int lane) {
    const int kr = lane >> 3, n4 = (lane & 7) * 4;
    float4 v[8];
#pragma unroll
    for (int i = 0; i < 8; ++i) v[i] = *(const float4*)(W + (size_t)(k0 + i * 8 + kr) * N + n0 + n4);
#pragma unroll
    for (int i = 0; i < 8; ++i) { float* d = scr + (i * 8 + kr) * 33 + n4; d[0] = v[i].x; d[1] = v[i].y; d[2] = v[i].z; d[3] = v[i].w; }
    asm volatile("s_waitcnt lgkmcnt(0)" ::: "memory");
    const int c = lane & 7;
#pragma unroll
    for (int j = 0; j < 4; ++j) { const int n = (lane >> 3) + 8 * j; const float* sp = scr + (8 * c) * 33 + n;
        uint4 o; o.x = pk2(sp[0 * 33], sp[1 * 33]); o.y = pk2(sp[2 * 33], sp[3 * 33]); o.z = pk2(sp[4 * 33], sp[5 * 33]); o.w = pk2(sp[6 * 33], sp[7 * 33]);
        *(uint4*)(WT + (size_t)(drow0 + n) * K + k0 + 8 * c) = o; }
    asm volatile("s_waitcnt lgkmcnt(0)" ::: "memory");
}
__device__ __forceinline__ void transpose_item(const float* W, int K, int N, bf16_t* WT, int row_off, float* scr, int item, int lane) {
    const int nblk = N / 32, kb = item / nblk, nb = item % nblk;
    transpose_blk(W, N, WT, K, 64 * kb, 32 * nb, row_off + 32 * nb, scr, lane);
}
struct CvtItem { const float* W; bf16_t* WT; int N, K, k0, n0, drow0; };
__device__ __forceinline__ bool cvt_decode(const Args& a, int l, int it, CvtItem& c) {
    if (it >= NEXP * 768) return false;
    bf16_t* WGU = (bf16_t*)(a.ws + WS_WEXP); bf16_t* WD = WGU + (size_t)NEXP * 1024 * 1024;
    const int e = it / 768; int r = it % 768;
    if (r < 512) {
        const bool up = r >= 256; r &= 255; const int kb = r >> 4, nb = r & 15, n0 = 32 * nb;
        c.W = (up ? a.in[26] : a.in[25]) + ((size_t)l * NEXP + e) * DM * DEXP; c.N = DEXP; c.WT = WGU + (size_t)e * 1024 * 1024; c.K = DM; c.k0 = 64 * kb; c.n0 = n0; c.drow0 = 256 * (n0 >> 7) + (n0 & 127) + (up ? 128 : 0);
    } else {
        r -= 512; const int kb = r >> 5, nb = r & 31;
        c.W = a.in[27] + ((size_t)l * NEXP + e) * DEXP * DM; c.N = DM; c.WT = WD + (size_t)e * 1024 * 512; c.K = DEXP; c.k0 = 64 * kb; c.n0 = 32 * nb; c.drow0 = 32 * nb;
    }
    return true;
}
__device__ __forceinline__ void cvt_load(const CvtItem& c, int lane, float4 (&v)[8]) {
    const int kr = lane >> 3, n4 = (lane & 7) * 4;
#pragma unroll
    for (int i = 0; i < 8; ++i) { typedef float f4v_ __attribute__((ext_vector_type(4))); const f4v_ t_ = __builtin_nontemporal_load((const f4v_*)(c.W + (size_t)(c.k0 + i * 8 + kr) * c.N + c.n0 + n4)); v[i] = make_float4(t_[0], t_[1], t_[2], t_[3]); }
}
__device__ __forceinline__ void cvt_finish(const CvtItem& c, int lane, const float4 (&v)[8], float* scr) {
    const int kr = lane >> 3, n4 = (lane & 7) * 4;
#pragma unroll
    for (int i = 0; i < 8; ++i) { float* d = scr + (i * 8 + kr) * 33 + n4; d[0] = v[i].x; d[1] = v[i].y; d[2] = v[i].z; d[3] = v[i].w; }
    asm volatile("s_waitcnt lgkmcnt(0)" ::: "memory");
    const int cc = lane & 7;
#pragma unroll
    for (int j = 0; j < 4; ++j) { const int n = (lane >> 3) + 8 * j; const float* sp = scr + (8 * cc) * 33 + n;
        uint4 o; o.x = pk2(sp[0 * 33], sp[1 * 33]); o.y = pk2(sp[2 * 33], sp[3 * 33]); o.z = pk2(sp[4 * 33], sp[5 * 33]); o.w = pk2(sp[6 * 33], sp[7 * 33]);
        *(uint4*)(c.WT + (size_t)(c.drow0 + n) * c.K + c.k0 + 8 * cc) = o; }
    asm volatile("s_waitcnt lgkmcnt(0)" ::: "memory");
}
__device__ __forceinline__ void convert_experts(const Args& a, int l, float* lds) {
    const int tid = tid_fresh(), lane = tid & 63, wid = tid >> 6;
    float* scr = lds + wid * (64 * 33);
    const int gw = blockIdx.x * 8 + wid, NGW = gridDim.x * 8;
    bf16_t* WGU = (bf16_t*)(a.ws + WS_WEXP); bf16_t* WD = WGU + (size_t)NEXP * 1024 * 1024;
    for (int it = gw; it < NEXP * 768; it += NGW) {
        const int e = it / 768; int r = it % 768;
        if (r < 512) {
            const bool up = r >= 256; r &= 255; const int kb = r >> 4, nb = r & 15, n0 = 32 * nb;
            const float* W = (up ? a.in[26] : a.in[25]) + ((size_t)l * NEXP + e) * DM * DEXP;
            transpose_blk(W, DEXP, WGU + (size_t)e * 1024 * 1024, DM, 64 * kb, n0, 256 * (n0 >> 7) + (n0 & 127) + (up ? 128 : 0), scr, lane);
        } else {
            r -= 512; const int kb = r >> 5, nb = r & 31;
            const float* W = a.in[27] + ((size_t)l * NEXP + e) * DEXP * DM;
            transpose_blk(W, DM, WD + (size_t)e * 1024 * 512, DEXP, 64 * kb, 32 * nb, 32 * nb, scr, lane);
        }
    }
}
__device__ __forceinline__ void cvt_row(const float* in, bf16_t* out, int lane) {
#pragma unroll
    for (int j = 0; j < 4; ++j) { const float4 v = *(const float4*)(in + j * 256 + lane * 4); uint2 o; o.x = pk2(v.x, v.y); o.y = pk2(v.z, v.w); *(uint2*)(out + j * 256 + lane * 4) = o; }
}
__device__ __forceinline__ bool pro_decode(const Args& a, int it, CvtItem& c) {
    constexpr int I_IN = 16 * 104, I_VR = 16, I_SQ = 16 * 32, I_KV = 16 * 64;
    constexpr int NITEMS = 2 * I_IN + I_VR + 6 * I_SQ + 2 * I_KV;
    if (it >= NITEMS) return false;
    const float* W; int K = DM, N; bf16_t* WT; int row_off = 0; int r = it;
    bf16_t* WIN0 = (bf16_t*)(a.ws + WS_WIN0); bf16_t* WIN1 = (bf16_t*)(a.ws + WS_WIN1);
    if (r < I_IN) { W = a.in[2]; N = IN_COLS; WT = WIN0; }
    else if ((r -= I_IN) < I_IN) { W = a.in[2] + (size_t)DM * IN_COLS; N = IN_COLS; WT = WIN1; }
    else if ((r -= I_IN) < I_VR) { W = a.in[3]; N = 32; WT = WIN1; row_off = IN_COLS; }
    else {
        r -= I_VR;
        constexpr int I_L = 3 * I_SQ + I_KV;
        const int l = r / I_L; r -= l * I_L;
        if (r < I_SQ) { W = a.in[19] + (size_t)l * DM * DM; N = DM; WT = (bf16_t*)(a.ws + WS_WOUT) + (size_t)l * DM * DM; }
        else if ((r -= I_SQ) < I_SQ) { W = a.in[20] + (size_t)l * DM * DM; N = DM; WT = (bf16_t*)(a.ws + WS_WQ) + (size_t)l * DM * DM; }
        else if ((r -= I_SQ) < I_KV) { W = a.in[21] + (size_t)l * DM * 2048; N = 2048; WT = (bf16_t*)(a.ws + WS_WKV) + (size_t)l * DM * 2048; }
        else { r -= I_KV; W = a.in[22] + (size_t)l * DM * DM; N = DM; WT = (bf16_t*)(a.ws + WS_WO) + (size_t)l * DM * DM; }
    }
    const int nblk = N / 32, kb = r / nblk, nb = r % nblk;
    c.W = W; c.WT = WT; c.N = N; c.K = K; c.k0 = 64 * kb; c.n0 = 32 * nb; c.drow0 = row_off + 32 * nb;
    return true;
}
__device__ __forceinline__ void phase_prologue(const Args& a, float* lds) {
    const int tid = tid_fresh(), lane = tid & 63, wid = tid >> 6;
    float* scr = lds + wid * (64 * 33);
    const int gw = blockIdx.x * 8 + wid, NGW = gridDim.x * 8;
    bf16_t* WIN1 = (bf16_t*)(a.ws + WS_WIN1);
    {
        CvtItem c0, c1; float4 v0[8], v1[8];
        int it = gw;
        bool h0 = pro_decode(a, it, c0); if (h0) cvt_load(c0, lane, v0);
        while (h0) {
            const bool h1 = pro_decode(a, it + NGW, c1); if (h1) cvt_load(c1, lane, v1);
            cvt_finish(c0, lane, v0, scr);
            it += 2 * NGW;
            h0 = h1 && pro_decode(a, it, c0); if (h0) cvt_load(c0, lane, v0);
            if (h1) cvt_finish(c1, lane, v1, scr);
        }
    }
    for (int r = gw; r < 224; r += NGW) {
#pragma unroll
        for (int j = 0; j < 2; ++j) *(uint4*)(WIN1 + (size_t)(3360 + r) * DM + j * 512 + lane * 8) = make_uint4(0u, 0u, 0u, 0u);
    }
    bf16_t* XB = (bf16_t*)(a.ws + WS_XB); bf16_t* MEMB = (bf16_t*)(a.ws + WS_MEMB);
    for (int m = gw; m < NTOK + NBATCH * MEMLEN; m += 4 * NGW) {
        float4 v[4][4];
#pragma unroll
        for (int q = 0; q < 4; ++q) { const int mm = m + q * NGW;
            if (mm < NTOK + NBATCH * MEMLEN) { const float* in = (mm < NTOK) ? a.in[0] + (size_t)mm * DM : a.in[1] + (size_t)(mm - NTOK) * DM;
#pragma unroll
                for (int j = 0; j < 4; ++j) v[q][j] = *(const float4*)(in + j * 256 + lane * 4); } }
#pragma unroll
        for (int q = 0; q < 4; ++q) { const int mm = m + q * NGW;
            if (mm < NTOK + NBATCH * MEMLEN) { bf16_t* out = (mm < NTOK) ? XB + (size_t)mm * DM : MEMB + (size_t)(mm - NTOK) * DM;
#pragma unroll
                for (int j = 0; j < 4; ++j) { uint2 o; o.x = pk2(v[q][j].x, v[q][j].y); o.y = pk2(v[q][j].z, v[q][j].w); *(uint2*)(out + j * 256 + lane * 4) = o; } } }
    }
    {
        const int gt = blockIdx.x * NTHREADS + tid, NGT = gridDim.x * NTHREADS;
        for (int idx = gt; idx < 2 * 512 * 288; idx += NGT) {
            const int l = idx / (512 * 288); const int r = idx % (512 * 288), kk = r >> 9, n = r & 511;
            bf16_t* base = (bf16_t*)(a.ws + WS_LORA + (size_t)l * LORA_L);
            if (kk < 64) base[n * 64 + kk] = f2bf(a.in[7][((size_t)l * 64 + kk) * 512 + n]);
            else if (kk < 128) base[512 * 64 + n * 64 + (kk - 64)] = f2bf(a.in[9][((size_t)l * 64 + (kk - 64)) * 512 + n]);
            else if (kk < 256) base[2 * 512 * 64 + n * 128 + (kk - 128)] = f2bf(a.in[12][((size_t)l * 128 + (kk - 128)) * 512 + n]);
            else base[2 * 512 * 64 + 512 * 128 + n * 32 + (kk - 256)] = f2bf(a.in[11][(size_t)(kk - 256) * 512 + n]);
        }
    }
}

__device__ __forceinline__ void phase_g1(const Args& a, int l, PG8_LAS unsigned char* lds) {
    pg8::G1Sched S; S.init(a.ws + WS_XB, a.ws + (l == 0 ? WS_WIN0 : WS_WIN1), l == 0 ? IN_COLS / 256 : ZLD / 256, a.ws + WS_MEMB, a.ws + WS_WKV + (size_t)l * 4 * MiB);
    pg8::EpiG1 E{(bf16_t*)(a.ws + WS_Z), (bf16_t*)(a.ws + WS_KB), (bf16_t*)(a.ws + WS_VT)};
    pg8::gemm_phase<pg8::EpiG1, pg8::G1Sched, false>(lds, pg8::Dims{DM, DM, DM}, S, E);
}
__device__ __forceinline__ void phase_matt_s(const Args& a, PG8_LAS unsigned char* lds) {
    pg8::MattSched S; S.init(a.ws + WS_Q, a.ws + WS_KB, (size_t)256 * 1024 * 2, 256 * 2);
    pg8::EpiSoftmax E{(bf16_t*)(a.ws + WS_P), (float*)(a.ws + WS_LSUM), (PG8_LAS float*)(lds + pg8::STAGE_BYTES + 8192 + 512)};
    pg8::gemm_phase<pg8::EpiSoftmax, pg8::MattSched, false>(lds, pg8::Dims{1024, 1024, 256}, S, E);
}
__device__ __forceinline__ void phase_matt_pv(const Args& a, PG8_LAS unsigned char* lds) {
    pg8::MattSched S; S.init(a.ws + WS_P, a.ws + WS_VT, (size_t)1024 * 256 * 2, 256 * 256 * 2);
    pg8::EpiPV E{(bf16_t*)(a.ws + WS_O), (const float*)(a.ws + WS_LSUM)};
    pg8::gemm_phase<pg8::EpiPV, pg8::MattSched, false>(lds, pg8::Dims{1024, 256, 256}, S, E);
}

typedef _Float16 h8_t __attribute__((ext_vector_type(8)));
typedef _Float16 h2_t __attribute__((ext_vector_type(2)));
__device__ __forceinline__ unsigned pkh2(float lo, float hi) { h2_t v = {(_Float16)lo, (_Float16)hi}; return __builtin_bit_cast(unsigned, v); }
#define SC_DPP(x, ctrl) __int_as_float(__builtin_amdgcn_mov_dpp(__float_as_int(x), ctrl, 0xF, 0xF, true))
__device__ __forceinline__ float sum32(float x) {
    x += SC_DPP(x, 0xB1); x += SC_DPP(x, 0x4E); x += SC_DPP(x, 0x141); x += SC_DPP(x, 0x140);
    return x + __shfl_xor(x, 16);
}
__device__ __forceinline__ void phase_prep(const Args& a, int l, float* lds) {
    typedef short bf16x8 __attribute__((ext_vector_type(8)));
    typedef float f32x16 __attribute__((ext_vector_type(16)));
    const bf16_t* Z = (const bf16_t*)(a.ws + WS_Z);
    const int tid = tid_fresh(), lane = tid & 63, wid = tid >> 6;
    float* KM = (float*)(a.ws + WS_KMEAN);
    for (int u = blockIdx.x * 8 + wid; u < NBATCH * NH * 8; u += gridDim.x * 8) {
        const int nb = u & 7, h = (u >> 3) & 7, b = u >> 6, rg = lane >> 3, ch = lane & 7;
        const bf16_t* p = Z + (size_t)(b * SEQ + nb * 256 + rg) * ZLD + C_K + h * HD + ch * 8;
        float acc[8];
#pragma unroll
        for (int j = 0; j < 8; ++j) acc[j] = 0.f;
#pragma unroll 8
        for (int i = 0; i < 32; ++i) { const uint4 v = *(const uint4*)(p + (size_t)(i * 8) * ZLD);
            acc[0] += bflo(v.x); acc[1] += bfhi(v.x); acc[2] += bflo(v.y); acc[3] += bfhi(v.y); acc[4] += bflo(v.z); acc[5] += bfhi(v.z); acc[6] += bflo(v.w); acc[7] += bfhi(v.w); }
#pragma unroll
        for (int j = 0; j < 8; ++j) { float x = acc[j]; x += __shfl_xor(x, 8); x += __shfl_xor(x, 16); x += __shfl_xor(x, 32); acc[j] = x * (1.0f / 256.0f); }
        if (rg == 0) { *(float4*)(KM + (size_t)u * 64 + ch * 8) = make_float4(acc[0], acc[1], acc[2], acc[3]); *(float4*)(KM + (size_t)u * 64 + ch * 8 + 4) = make_float4(acc[4], acc[5], acc[6], acc[7]); }
    }
    const float* mu = a.in[4] + (size_t)l * 1792;
    const float* muv = a.in[5];
    const bf16_t* WdT = (const bf16_t*)(a.ws + WS_LORA + (size_t)l * LORA_L); const bf16_t* WiT = (const bf16_t*)(a.ws + WS_LORA + (size_t)l * LORA_L + LORA_I);
    const bf16_t* WgT = (const bf16_t*)(a.ws + WS_LORA + (size_t)l * LORA_L + LORA_G); const bf16_t* WvT = (const bf16_t*)(a.ws + WS_LORA + LORA_V);
    unsigned* REC = (unsigned*)(a.ws + WS_REC);
    _Float16* RVT = (_Float16*)(a.ws + WS_RVT); bf16_t* RGp = (bf16_t*)(a.ws + WS_RG); float* BON = (float*)(a.ws + WS_BON);
    bf16_t* VF = (bf16_t*)(a.ws + WS_VFIRST);
    constexpr int PREP_AFR_BYTES = 18 * 64 * 16, PREP_TILE_BYTES = 3 * 33 * 128;
    uint4* afr = (uint4*)lds;
    for (int tb = blockIdx.x; tb < 512; tb += gridDim.x) {
        int lane_t = lane; asm volatile("" : "+v"(lane_t));
        const int r32 = lane_t & 31, hi = lane_t >> 5;
        const int h = wid, t0 = tb * 32, b = t0 / SEQ, tt0 = t0 % SEQ, bh = b * NH + h;
        const size_t tokA = (size_t)t0 + r32;
        const bool firstA = (tt0 == 0) && (r32 == 0);
        const size_t tokP = firstA ? tokA : tokA - 1;
        PG8_LAS unsigned char* tileL = (PG8_LAS unsigned char*)lds + PREP_AFR_BYTES + wid * PREP_TILE_BYTES;
        {
            const int rowl = lane_t >> 3, ch8 = lane_t & 7;
            const size_t tprev = (t0 == 0) ? 0 : (size_t)t0 - 1;
#pragma unroll
            for (int op = 0; op < 3; ++op) {
                const int zc = (op == 0 ? C_R : op == 1 ? C_KR : C_VR) + h * 64;
                if (lane_t < 8) __builtin_amdgcn_global_load_lds((const unsigned*)(Z + tprev * ZLD + zc + lane_t * 8), (PG8_LAS unsigned*)(tileL + (op * 33) * 128), 16, 0, 0);
#pragma unroll
                for (int k = 0; k < 4; ++k)
                    __builtin_amdgcn_global_load_lds((const unsigned*)(Z + ((size_t)t0 + 8 * k + rowl) * ZLD + zc + ch8 * 8), (PG8_LAS unsigned*)(tileL + (op * 33 + 1 + 8 * k) * 128), 16, 0, 0);
            }
        }
        uint4* VFL = (uint4*)(a.ws + WS_VFIRST) + (((size_t)tb * 8 + h) * 2) * 128 + lane_t * 2;
        uint4 vfq[2][2];
        if (l == 1) { vfq[0][0] = VFL[0]; vfq[0][1] = VFL[1]; vfq[1][0] = VFL[128]; vfq[1][1] = VFL[129]; }
        __syncthreads();
#pragma unroll
        for (int m = 0; m < 3; ++m) {
            const int idx = wid + 8 * m;
            if (idx < (l == 1 ? 18 : 16)) {
                int zcol; const float* mup; int act;
                if (idx < 8) { zcol = C_ZG + 16 * idx; mup = mu + (C_ZG - C_R) + 16 * idx; act = 2; }
                else if (idx < 12) { zcol = C_ZW + 16 * (idx - 8); mup = mu + (C_ZW - C_R) + 16 * (idx - 8); act = 1; }
                else if (idx < 16) { zcol = C_ZA + 16 * (idx - 12); mup = mu + (C_ZA - C_R) + 16 * (idx - 12); act = 0; }
                else { zcol = C_ZV + 16 * (idx - 16); mup = muv + 16 * (idx - 16); act = 0; }
                zcol += 8 * hi; mup += 8 * hi;
                const uint4 cu_ = *(const uint4*)(Z + tokA * ZLD + zcol); uint4 pv_ = *(const uint4*)(Z + tokP * ZLD + zcol); if (firstA) pv_ = make_uint4(0u, 0u, 0u, 0u);
                const float4 m0_ = *(const float4*)(mup), m1_ = *(const float4*)(mup + 4);
                float x_[8]; const unsigned cw_[4] = {cu_.x, cu_.y, cu_.z, cu_.w}, pw_[4] = {pv_.x, pv_.y, pv_.z, pv_.w}; const float mm_[8] = {m0_.x, m0_.y, m0_.z, m0_.w, m1_.x, m1_.y, m1_.z, m1_.w};
#pragma unroll
                for (int q_ = 0; q_ < 4; ++q_) { const float c0_ = bflo(cw_[q_]), c1_ = bfhi(cw_[q_]); x_[2 * q_] = c0_ + (bflo(pw_[q_]) - c0_) * mm_[2 * q_]; x_[2 * q_ + 1] = c1_ + (bfhi(pw_[q_]) - c1_) * mm_[2 * q_ + 1]; }
                if (act == 1) {
#pragma unroll
                    for (int q_ = 0; q_ < 8; ++q_) x_[q_] = 1.0f - 2.0f * __builtin_amdgcn_rcpf(__expf(2.0f * x_[q_]) + 1.0f);
                } else if (act == 2) {
#pragma unroll
                    for (int q_ = 0; q_ < 8; ++q_) x_[q_] = __builtin_amdgcn_rcpf(1.0f + __expf(-x_[q_]));
                }
                afr[idx * 64 + lane_t] = make_uint4(pk2(x_[0], x_[1]), pk2(x_[2], x_[3]), pk2(x_[4], x_[5]), pk2(x_[6], x_[7]));
            }
        }
        __syncthreads();
#define PREP_AFRAG(dst, idx_) do { const uint4 q_ = afr[(idx_) * 64 + lane_t]; pg8::u32x4 w_; w_.x = q_.x; w_.y = q_.y; w_.z = q_.z; w_.w = q_.w; dst = __builtin_bit_cast(bf16x8, w_); } while (0)
        const int chB = h * 64 + r32;
#define PREP_TOK(r) int hq_ = hi; asm volatile("" : "+v"(hq_)); const int tq = ((r) & 3) + 8 * ((r) >> 2) + 4 * hq_, t = tt0 + tq; const size_t tok = (size_t)t0 + tq; (void)t; (void)tok
#define PREP_RB(t, j) (((((size_t)bh * 512 + ((t) >> 2)) * 32 + ((j) >> 1)) * 4 + ((t) & 3)) * 5)
        f32x16 acc[2];
#pragma unroll
        for (int nb = 0; nb < 2; ++nb)
#pragma unroll
            for (int r = 0; r < 16; ++r) acc[nb][r] = 0.f;
#pragma unroll 1
        for (int sO = 0; sO < 8; sO += 4) {
            asm volatile("" ::: "memory");
#pragma unroll
            for (int sJ = 0; sJ < 4; ++sJ) { const int sI = sO + sJ;
                bf16x8 af; PREP_AFRAG(af, sI);
#pragma unroll
                for (int nb = 0; nb < 2; ++nb) acc[nb] = __builtin_amdgcn_mfma_f32_32x32x16_bf16(af, *(const bf16x8*)(WgT + (size_t)(chB + 32 * nb) * 128 + 16 * sI + 8 * hi), acc[nb], 0, 0, 0); }
        }
#pragma unroll
        for (int nb = 0; nb < 2; ++nb)
#pragma unroll
            for (int r = 0; r < 16; ++r) { PREP_TOK(r); RGp[tok * 512 + chB + 32 * nb] = f2bf(acc[nb][r]); }
#pragma unroll
        for (int nb = 0; nb < 2; ++nb)
#pragma unroll
            for (int r = 0; r < 16; ++r) acc[nb][r] = 0.f;
        asm volatile("" ::: "memory");
#pragma unroll
        for (int sI = 0; sI < 4; ++sI) {
            bf16x8 af; PREP_AFRAG(af, 8 + sI);
#pragma unroll
            for (int nb = 0; nb < 2; ++nb) acc[nb] = __builtin_amdgcn_mfma_f32_32x32x16_bf16(af, *(const bf16x8*)(WdT + (size_t)(chB + 32 * nb) * 64 + 16 * sI + 8 * hi), acc[nb], 0, 0, 0);
        }
        unsigned UW[2][8];
#pragma unroll
        for (int nb = 0; nb < 2; ++nb) {
            const float w0c = a.in[6][l * 512 + chB + 32 * nb];
#pragma unroll
            for (int g = 0; g < 4; ++g)
#pragma unroll
                for (int ts = 0; ts < 2; ++ts) { float uu[2];
#pragma unroll
                    for (int e = 0; e < 2; ++e) { const float sd = w0c + acc[nb][4 * g + ts + 2 * e]; const float sp = (sd < -15.f) ? -sd : __logf(1.0f + __expf(-sd)); uu[e] = 1.0f - __expf(-__expf(-sp - 0.5f)); }
                    UW[nb][2 * g + ts] = pkh2(uu[0], uu[1]); }
        }
        f32x16 aia[2], vga[2];
#pragma unroll
        for (int nb = 0; nb < 2; ++nb)
#pragma unroll
            for (int r = 0; r < 16; ++r) { aia[nb][r] = 0.f; vga[nb][r] = 0.f; }
        asm volatile("" ::: "memory");
#pragma unroll
        for (int sI = 0; sI < 4; ++sI) {
            bf16x8 af; PREP_AFRAG(af, 12 + sI);
#pragma unroll
            for (int nb = 0; nb < 2; ++nb) aia[nb] = __builtin_amdgcn_mfma_f32_32x32x16_bf16(af, *(const bf16x8*)(WiT + (size_t)(chB + 32 * nb) * 64 + 16 * sI + 8 * hi), aia[nb], 0, 0, 0);
        }
        if (l == 1) {
            asm volatile("" ::: "memory");
#pragma unroll
            for (int sI = 0; sI < 2; ++sI) {
                bf16x8 af; PREP_AFRAG(af, 16 + sI);
#pragma unroll
                for (int nb = 0; nb < 2; ++nb) vga[nb] = __builtin_amdgcn_mfma_f32_32x32x16_bf16(af, *(const bf16x8*)(WvT + (size_t)(chB + 32 * nb) * 32 + 16 * sI + 8 * hi), vga[nb], 0, 0, 0);
            }
        }
#undef PREP_AFRAG
        asm volatile("s_waitcnt vmcnt(0)" ::: "memory");
        float ss[16], bon[16]; unsigned KW[2][8], RW[2][8], QW[2][8], AW[2][8];
#pragma unroll
        for (int r = 0; r < 16; ++r) { ss[r] = 0.f; bon[r] = 0.f; }
#pragma unroll
        for (int nb = 0; nb < 2; ++nb) {
            const int j = 32 * nb + r32, c = h * 64 + j;
            const float a0c = a.in[8][l * 512 + c], v0c = a.in[10][c];
            const float mu_r = mu[c], mu_k = mu[512 + c], mu_v = mu[1024 + c];
            const float kk_c = a.in[13][l * 512 + c], ka_c = a.in[14][l * 512 + c], rk_c = a.in[15][l * 512 + c];
            float v4[4], kp2[2], rr2[2], kq2[2], ai2[2];
            float lr_ = 0.f, lk_ = 0.f, lv_ = 0.f, vfe = 0.f; unsigned vfo[8];
            const unsigned vfi[8] = {vfq[nb][0].x, vfq[nb][0].y, vfq[nb][0].z, vfq[nb][0].w, vfq[nb][1].x, vfq[nb][1].y, vfq[nb][1].z, vfq[nb][1].w};
#pragma unroll
            for (int r = 0; r < 16; ++r) {
                PREP_TOK(r);
                const float ai = sigmoid_fast(a0c + aia[nb][r]);
                PG8_LAS const bf16_t* tp_ = (PG8_LAS const bf16_t*)tileL + (1 + tq) * 64 + j;
                const float zr = bf2f(tp_[0]), zk = bf2f(tp_[33 * 64]), zv = bf2f(tp_[66 * 64]);
                float pr, pk, pv;
                if ((r & 3) == 0) { const float pm_ = (t != 0) ? 1.0f : 0.0f; pr = pm_ * bf2f(tp_[-64]); pk = pm_ * bf2f(tp_[32 * 64]); pv = pm_ * bf2f(tp_[65 * 64]); }
                else { pr = lr_; pk = lk_; pv = lv_; }
                lr_ = zr; lk_ = zk; lv_ = zv;
                const float rr_ = zr + (pr - zr) * mu_r, kx = zk + (pk - zk) * mu_k;
                float v = zv + (pv - zv) * mu_v;
                if (l == 0) { if (r & 1) vfo[r >> 1] = pk2(vfe, v); else vfe = v; }
                else { const float vf_ = (r & 1) ? bfhi(vfi[r >> 1]) : bflo(vfi[r >> 1]); v = v + (vf_ - v) * sigmoid_fast(v0c + vga[nb][r]); }
                const float kkraw = kx * kk_c, kp = kx * (1.0f + (ai - 1.0f) * ka_c);
                ss[r] = fmaf(kkraw, kkraw, ss[r]); bon[r] = fmaf(rr_ * kp, rk_c, bon[r]);
                if ((r & 3) < 2) { kp2[r & 1] = kp; rr2[r & 1] = rr_; kq2[r & 1] = kkraw; ai2[r & 1] = ai; }
                else { const int wI = 2 * (r >> 2) + (r & 1); KW[nb][wI] = pkh2(kp2[r & 1], kp); RW[nb][wI] = pkh2(rr2[r & 1], rr_); QW[nb][wI] = pkh2(kq2[r & 1], kkraw); AW[nb][wI] = pkh2(ai2[r & 1], ai); }
                v4[r & 3] = v;
                if ((r & 3) == 3) {
                    uint2 pv2; pv2.x = pk2(v4[0], v4[1]); pv2.y = pk2(v4[2], v4[3]);
                    *(uint2*)(RVT + (((size_t)bh * 256 + ((tt0 >> 3) + (r >> 2))) * 64 + j) * 8 + 4 * hi) = pv2;
                }
            }
            if (l == 0) { VFL[nb * 128] = make_uint4(vfo[0], vfo[1], vfo[2], vfo[3]); VFL[nb * 128 + 1] = make_uint4(vfo[4], vfo[5], vfo[6], vfo[7]); }
        }
        float rn[16];
#pragma unroll
        for (int r = 0; r < 16; ++r) {
            PREP_TOK(r);
            const float sst = sum32(ss[r]), bt = sum32(bon[r]);
            rn[r] = rsqrtf(fmaxf(sst, 1e-24f));
            BON[tok * 8 + h] = bt;
        }
        const unsigned psel = (r32 & 1) ? 0x03020706u : 0x05040100u;
#pragma unroll
        for (int nb = 0; nb < 2; ++nb)
#pragma unroll
            for (int g = 0; g < 4; ++g) {
                asm volatile("" ::: "memory");
                unsigned outw[10];
#pragma unroll
                for (int ts = 0; ts < 2; ++ts) {
                    const int wI = 2 * g + ts;
                    const h2_t q2 = __builtin_bit_cast(h2_t, QW[nb][wI]), a2 = __builtin_bit_cast(h2_t, AW[nb][wI]);
                    const float k0 = (float)q2[0] * rn[4 * g + ts], k1 = (float)q2[1] * rn[4 * g + ts + 2];
                    const unsigned mine[5] = {UW[nb][wI], pkh2(-k0, -k1), pkh2(k0 * (float)a2[0], k1 * (float)a2[1]), KW[nb][wI], RW[nb][wI]};
#pragma unroll
                    for (int q = 0; q < 5; ++q) { const unsigned oth = (unsigned)__builtin_amdgcn_mov_dpp((int)mine[q], 0xB1, 0xF, 0xF, true); outw[ts * 5 + q] = __builtin_amdgcn_perm(oth, mine[q], psel); }
                }
                const int tg = (tt0 >> 2) + 2 * g + hi, j2r = 16 * nb + (r32 >> 1);
                unsigned* dst = REC + ((size_t)bh * 512 + tg) * REC_TG + j2r * 20 + (j2r >> 4) * 4 + ((r32 & 1) ? 10 : 0);
#pragma unroll
                for (int k = 0; k < 5; ++k) { uint2 o2; o2.x = outw[2 * k]; o2.y = outw[2 * k + 1]; *(uint2*)(dst + 2 * k) = o2; }
            }
#undef PREP_TOK
#undef PREP_RB
    }
}

__device__ __forceinline__ float dpp_add(float x, float y_src, int) { return x + y_src; }
__device__ __forceinline__ float red32(float x) {
    x += SC_DPP(x, 0xB1); x += SC_DPP(x, 0x4E); x += SC_DPP(x, 0x141); x += SC_DPP(x, 0x140);
    auto rr = __builtin_amdgcn_permlane32_swap(__float_as_uint(x), __float_as_uint(x), false, false);
    return __uint_as_float(rr[0]) + __uint_as_float(rr[1]);
}
__device__ __forceinline__ float fmul_lo(float a, unsigned h) { float d; asm("v_fma_mix_f32 %0, %1, %2, 0 op_sel_hi:[0,1,0]" : "=v"(d) : "v"(a), "v"(h)); return d; }
__device__ __forceinline__ float fmix_lo(float a, unsigned h, float c) { float d; asm("v_fma_mix_f32 %0, %1, %2, %3 op_sel_hi:[0,1,0]" : "=v"(d) : "v"(a), "v"(h), "v"(c)); return d; }
__device__ __forceinline__ float fmix_hi(float a, unsigned h, float c) { float d; asm("v_fma_mix_f32 %0, %1, %2, %3 op_sel:[0,1,0] op_sel_hi:[0,1,0]" : "=v"(d) : "v"(a), "v"(h), "v"(c)); return d; }
__device__ __forceinline__ float fdec_lo(float sv, unsigned u) { float d; asm("v_fma_mix_f32 %0, -%1, %2, %1 op_sel_hi:[0,1,0]" : "=v"(d) : "v"(sv), "v"(u)); return d; }
__device__ __forceinline__ float fdec_hi(float sv, unsigned u) { float d; asm("v_fma_mix_f32 %0, -%1, %2, %1 op_sel:[0,1,0] op_sel_hi:[0,1,0]" : "=v"(d) : "v"(sv), "v"(u)); return d; }
template <int VH> __device__ __forceinline__ float fvk_lo(unsigned v, unsigned k, float c) { float d;
    if (VH) asm("v_fma_mix_f32 %0, %1, %2, %3 op_sel:[1,0,0] op_sel_hi:[1,1,0]" : "=v"(d) : "v"(v), "v"(k), "v"(c)); else asm("v_fma_mix_f32 %0, %1, %2, %3 op_sel:[0,0,0] op_sel_hi:[1,1,0]" : "=v"(d) : "v"(v), "v"(k), "v"(c)); return d; }
template <int VH> __device__ __forceinline__ float fvk_hi(unsigned v, unsigned k, float c) { float d;
    if (VH) asm("v_fma_mix_f32 %0, %1, %2, %3 op_sel:[1,1,0] op_sel_hi:[1,1,0]" : "=v"(d) : "v"(v), "v"(k), "v"(c)); else asm("v_fma_mix_f32 %0, %1, %2, %3 op_sel:[0,1,0] op_sel_hi:[1,1,0]" : "=v"(d) : "v"(v), "v"(k), "v"(c)); return d; }

__device__ __forceinline__ float red16(float x) {
    x += SC_DPP(x, 0xB1); x += SC_DPP(x, 0x4E); x += SC_DPP(x, 0x141); x += SC_DPP(x, 0x140);
    return x;
}
__device__ __forceinline__ float ffma(float a, float b, float c) { float d; asm("v_fma_f32 %0, %1, %2, %3" : "=v"(d) : "v"(a), "v"(b), "v"(c)); return d; }
__device__ __forceinline__ float fmul(float a, float b) { float d; asm("v_mul_f32 %0, %1, %2" : "=v"(d) : "v"(a), "v"(b)); return d; }
__device__ __forceinline__ float fnfma(float a, float b, float c) { float d; asm("v_fma_f32 %0, -%1, %2, %3" : "=v"(d) : "v"(a), "v"(b), "v"(c)); return d; }
__device__ __forceinline__ float h2f_lo(unsigned w) { float d; asm("v_cvt_f32_f16 %0, %1" : "=v"(d) : "v"(w)); return d; }
__device__ __forceinline__ float h2f_hi(unsigned w) { float d; asm("v_cvt_f32_f16_sdwa %0, %1 dst_sel:DWORD dst_unused:UNUSED_PAD src0_sel:WORD_1" : "=v"(d) : "v"(w)); return d; }
__device__ __forceinline__ void phase_scan(const Args& a, int l, PG8_LAS unsigned char* lds) {
    const int tid = tid_fresh(), lane = tid & 63, wid = __builtin_amdgcn_readfirstlane(tid >> 6);
    const int j2 = (lane & 15) | ((lane >> 5) << 4), rr = (lane >> 4) & 1;
    const char* REC = (const char*)(a.ws + WS_REC); const char* RVT = (const char*)(a.ws + WS_RVT);
    bf16_t* YR = (bf16_t*)(a.ws + WS_YRAW);
    constexpr int CSTEPS = 32, NCH = SEQ / CSTEPS, G_REC = 8 * REC_TG * 4  , CH_REC = 21 * 1024, CH_V = 4096, CH = CH_REC + CH_V, NPC = 25;
    constexpr int YB_LD = 68, YB_WAVE = 16 * YB_LD * 4;
    PG8_LAS float* yb = (PG8_LAS float*)(lds + 2 * CH + wid * YB_WAVE);
    float* scr = (float*)((unsigned char*)lds + 2 * CH + 8 * YB_WAVE) + (wid & 3) * (64 * 33);
    const bool cvw = wid < 4;
    const int cw = blockIdx.x * 4 + (wid & 3), NCW = gridDim.x * 4;
    int cvt_next = cvw ? cw : NEXP * 768; bool have = false; CvtItem ci; float4 cv[8];
    for (int u = blockIdx.x; u < 256; u += gridDim.x) {
        const int bh = u >> 2, rg = u & 3, b = bh >> 3, h = bh & 7;
        const int irow = rg * 16 + wid * 2 + rr;
        const char* grec = REC + (size_t)bh * NCH * G_REC; const char* gv = RVT + (size_t)bh * NCH * CH_V;
        float S0 = 0.f, S1 = 0.f;
        __syncthreads();
#define SCAN_DMA(chn, bufo) do { _Pragma("unroll") for (int k_ = 0; k_ < 4; ++k_) { const int pc_ = wid * 4 + k_; if (pc_ < NPC) { \
            const char* src_ = (pc_ < 21) ? grec + (size_t)(chn) * G_REC + pc_ * 1024 + lane * 16 : gv + (size_t)(chn) * CH_V + (pc_ - 21) * 1024 + lane * 16; \
            __builtin_amdgcn_global_load_lds((const unsigned*)src_, (PG8_LAS unsigned*)(lds + (bufo) + pc_ * 1024), 16, 0, 0); } } } while (0)
        SCAN_DMA(0, 0);
        for (int ch = 0; ch < NCH; ++ch) {
            asm volatile("s_waitcnt vmcnt(0)" ::: "memory");
            __syncthreads();
            if (ch + 1 < NCH) SCAN_DMA(ch + 1, ((ch + 1) & 1) * CH);
            if (have) { cvt_finish(ci, lane, cv, scr); have = false; }
            { const int cm = ch & 7; if (cvw && (cm == 0 || cm == 3 || cm == 5)) { if (cvt_decode(a, l, cvt_next, ci)) { cvt_load(ci, lane, cv); have = true; cvt_next += NCW; } } }
            PG8_LAS const unsigned char* bufp = lds + (ch & 1) * CH;
#define SCAN_LOADW(W, grp) do { PG8_LAS const unsigned char* rp_ = bufp + (grp) * (REC_TG * 4) + j2 * 80 + (j2 >> 4) * 16; _Pragma("unroll") for (int k_ = 0; k_ < 5; ++k_) { \
                const pg8::u32x4 q_ = *(PG8_LAS const pg8::u32x4*)(rp_ + 16 * k_); W[4 * k_] = q_.x; W[4 * k_ + 1] = q_.y; W[4 * k_ + 2] = q_.z; W[4 * k_ + 3] = q_.w; } } while (0)
#define SCAN_STEPS(W, hf) do { _Pragma("unroll") for (int ts = 0; ts < 4; ++ts) { \
                const unsigned wu = W[ts * 5], wa = W[ts * 5 + 1], wb = W[ts * 5 + 2], wk = W[ts * 5 + 3], wr_ = W[ts * 5 + 4]; \
                const unsigned vw = vv[(hf) * 2 + (ts >> 1)]; \
                const float sa = red32(fmix_hi(S1, wa, fmul_lo(S0, wa))); \
                float t0 = fdec_lo(S0, wu), t1 = fdec_hi(S1, wu); \
                if (ts & 1) { t0 = fvk_lo<1>(vw, wk, t0); t1 = fvk_hi<1>(vw, wk, t1); } else { t0 = fvk_lo<0>(vw, wk, t0); t1 = fvk_hi<0>(vw, wk, t1); } \
                S0 = fmix_lo(sa, wb, t0); S1 = fmix_hi(sa, wb, t1); \
                yb[((g8 & 1) * 8 + (hf) * 4 + ts) * YB_LD + rr * 32 + j2] = fmix_hi(S1, wr_, fmul_lo(S0, wr_)); } } while (0)
            unsigned wA[20], wB[20];
            SCAN_LOADW(wA, 0);
#pragma unroll 1
            for (int g8 = 0; g8 < 4; ++g8) {
                const pg8::u32x4 vv = *(PG8_LAS const pg8::u32x4*)(bufp + CH_REC + (g8 * 64 + irow) * 16);
                SCAN_LOADW(wB, g8 * 2 + 1);
                SCAN_STEPS(wA, 0);
                if (g8 < 3) SCAN_LOADW(wA, g8 * 2 + 2);
                SCAN_STEPS(wB, 1);
                if (g8 & 1) {
                    asm volatile("s_waitcnt lgkmcnt(0)" ::: "memory");
                    PG8_LAS const float* yp = yb + (j2 & 15) * YB_LD + rr * 32 + (j2 >> 4) * 16;
                    const pg8::f32x4 y0 = *(PG8_LAS const pg8::f32x4*)(yp), y1 = *(PG8_LAS const pg8::f32x4*)(yp + 4), y2 = *(PG8_LAS const pg8::f32x4*)(yp + 8), y3 = *(PG8_LAS const pg8::f32x4*)(yp + 12);
                    const pg8::f32x4 ys = (y0 + y1) + (y2 + y3);
                    float y = (ys[0] + ys[1]) + (ys[2] + ys[3]);
                    { auto sw = __builtin_amdgcn_permlane32_swap(__float_as_uint(y), __float_as_uint(y), false, false); y = __uint_as_float(sw[0]) + __uint_as_float(sw[1]); }
                    const int t = ch * CSTEPS + (g8 >> 1) * 16 + (j2 & 15);
                    if (j2 < 16) YR[((size_t)b * SEQ + t) * 512 + h * 64 + irow] = f2bf(y);
                    asm volatile("s_waitcnt lgkmcnt(0)" ::: "memory");
                }
            }
#undef SCAN_LOADW
#undef SCAN_STEPS
        }
#undef SCAN_DMA
    }
    if (have) cvt_finish(ci, lane, cv, scr);
    while (cvt_decode(a, l, cvt_next, ci)) { cvt_load(ci, lane, cv); cvt_finish(ci, lane, cv, scr); cvt_next += NCW; }
}

struct PostIn { uint4 vq; bf16_t y[8], rg[8]; float bon, gm, bt; };
__device__ __forceinline__ void post_load(const Args& a, int l, int u, int lane, PostIn& p) {
    const int bh = u >> 8, t8 = u & 255, b = bh >> 3, h = bh & 7; const size_t tok0 = (size_t)b * SEQ + t8 * 8; const int c = h * 64 + lane;
    const bf16_t* YR = (const bf16_t*)(a.ws + WS_YRAW); const bf16_t* RGp = (const bf16_t*)(a.ws + WS_RG);
    p.vq = *(const uint4*)(a.ws + WS_RVT + (((size_t)bh * 256 + t8) * 64 + lane) * 16);
#pragma unroll
    for (int k = 0; k < 8; ++k) { p.y[k] = YR[(tok0 + k) * 512 + c]; p.rg[k] = RGp[(tok0 + k) * 512 + c]; }
    p.bon = ((const float*)(a.ws + WS_BON))[(tok0 + (lane & 7)) * 8 + h];
    p.gm = a.in[16][l * 512 + c]; p.bt = a.in[17][l * 512 + c];
}
__device__ __forceinline__ void post_finish(const Args& a, int u, int lane, const PostIn& p) {
    const int bh = u >> 8, t8 = u & 255, b = bh >> 3, h = bh & 7; const size_t tok0 = (size_t)b * SEQ + t8 * 8; const int c = h * 64 + lane;
    bf16_t* MIX = (bf16_t*)(a.ws + WS_MIX);
    const unsigned vw[4] = {p.vq.x, p.vq.y, p.vq.z, p.vq.w};
#pragma unroll
    for (int k = 0; k < 8; ++k) {
        const float y = bf2f(p.y[k]);
        const float my = wsum(y) * (1.0f / 64.0f);
        const float dy = y - my;
        const float var = wsum(dy * dy) * (1.0f / 64.0f);
        const float yn = dy * rsqrtf(var + 64e-5f) * p.gm + p.bt;
        const float v = (k & 1) ? bfhi(vw[k >> 1]) : bflo(vw[k >> 1]);
        const float bon = __shfl(p.bon, k);
        MIX[(tok0 + k) * DM + 512 + c] = f2bf((yn + bon * v) * bf2f(p.rg[k]));
    }
}
__device__ __forceinline__ void phase_post(const Args& a, int l) {
    const int tid = tid_fresh(), lane = tid & 63, wid = tid >> 6;
    const int NW = gridDim.x * 8;
    int u = blockIdx.x * 8 + wid;
    PostIn p0, p1;
    if (u < 64 * 256) post_load(a, l, u, lane, p0);
    while (u < 64 * 256) {
        const int u1 = u + NW; const bool h1 = u1 < 64 * 256;
        if (h1) post_load(a, l, u1, lane, p1);
        post_finish(a, u, lane, p0);
        u = u1 + NW;
        if (!h1) break;
        if (u < 64 * 256) post_load(a, l, u, lane, p0);
        post_finish(a, u1, lane, p1);
    }
}

namespace att {
typedef short bf16x8 __attribute__((ext_vector_type(8)));
typedef short s16x4 __attribute__((ext_vector_type(4)));
typedef float f32x16 __attribute__((ext_vector_type(16)));
typedef __attribute__((address_space(3))) const unsigned char* lds_cptr;
constexpr int SLOT = 8192, L_K = 0, L_V = 2 * SLOT, L_WS = 4 * SLOT, L_KM = L_WS + 8 * 256, L_OST = L_KM + 2048, OST_LD = 68, L_END = L_OST + 8 * 32 * OST_LD * 4;
constexpr float C2 = 0.125f * 1.4426950408889634f;
__device__ __forceinline__ int crow(int r, int hi) { return (r & 3) + 8 * (r >> 2) + 4 * hi; }
__device__ __forceinline__ s16x4 vtr(lds_cptr p) { return __builtin_bit_cast(s16x4, __builtin_amdgcn_ds_read_tr16_b64_v4i16((__attribute__((address_space(3))) s16x4*)p)); }
__device__ __forceinline__ float swapmax(float x) { auto rr = __builtin_amdgcn_permlane32_swap(__float_as_uint(x), __float_as_uint(x), false, false); return fmaxf(__uint_as_float(rr[0]), __uint_as_float(rr[1])); }
__device__ __forceinline__ float swapsum(float x) { auto rr = __builtin_amdgcn_permlane32_swap(__float_as_uint(x), __float_as_uint(x), false, false); return __uint_as_float(rr[0]) + __uint_as_float(rr[1]); }

__device__ __forceinline__ void unit(const Args& a, int l, int b, int h, int cur, PG8_LAS unsigned char* lds) {
    const int tid = tid_fresh(), lane = tid & 63, r32 = lane & 31, hi = lane >> 5, wid = __builtin_amdgcn_readfirstlane(tid >> 6);
    const bf16_t* Zb = (const bf16_t*)(a.ws + WS_Z) + (size_t)b * SEQ * ZLD;
    const int qrel = wid * 32 + r32, qpos = cur * 256 + qrel;
    PG8_LAS float* wsf = (PG8_LAS float*)(lds + L_WS) + wid * 64;
    PG8_LAS float* kmf = (PG8_LAS float*)(lds + L_KM);
    __syncthreads();
    kmf[tid] = ((const float*)(a.ws + WS_KMEAN))[(size_t)(b * NH + h) * 512 + tid];
    const bf16_t* ksrc = Zb + (size_t)lane * ZLD + C_K + h * HD + wid * 8;
    const bf16_t* vsrc = Zb + (size_t)(16 * (wid & 3) + (lane >> 2)) * ZLD + C_V + h * HD + (wid >> 2) * 32 + (lane & 3) * 8;
#define ATT_DMA(kpos0, slot) do { \
        __builtin_amdgcn_global_load_lds((const unsigned*)(ksrc + (size_t)(kpos0) * ZLD), (PG8_LAS unsigned*)(lds + L_K + (slot) * SLOT + wid * 1024), 16, 0, 0); \
        __builtin_amdgcn_global_load_lds((const unsigned*)(vsrc + (size_t)(kpos0) * ZLD), (PG8_LAS unsigned*)(lds + L_V + (slot) * SLOT + wid * 1024), 16, 0, 0); } while (0)
    ATT_DMA(cur * 256, 0);
    bf16x8 qr[4];
#pragma unroll
    for (int d0 = 0; d0 < 4; ++d0) qr[d0] = *(const bf16x8*)(Zb + (size_t)qpos * ZLD + C_Q + h * HD + d0 * 16 + hi * 8);
    __syncthreads();
    unsigned selbits = 0u;
    {
        float g[8];
#pragma unroll
        for (int n = 0; n < 8; ++n) g[n] = 0.f;
#pragma unroll
        for (int d0 = 0; d0 < 4; ++d0)
#pragma unroll
            for (int j = 0; j < 8; ++j) { const float qv = bf2f((bf16_t)qr[d0][j]);
#pragma unroll
                for (int n = 0; n < 8; ++n) g[n] = fmaf(qv, kmf[n * 64 + d0 * 16 + hi * 8 + j], g[n]); }
#pragma unroll
        for (int n = 0; n < 8; ++n) g[n] = (n < cur) ? swapsum(g[n]) : NEG_INF;
        if (cur <= 3) selbits = (1u << cur) - 1u;
        else {
            int s0 = -1, s1 = -1, s2 = -1; float bv = -3e38f;
#pragma unroll
            for (int n = 0; n < 8; ++n) if (g[n] > bv) { bv = g[n]; s0 = n; }
            bv = -3e38f;
#pragma unroll
            for (int n = 0; n < 8; ++n) if (n != s0 && g[n] > bv) { bv = g[n]; s1 = n; }
            bv = -3e38f;
#pragma unroll
            for (int n = 0; n < 8; ++n) if (n != s0 && n != s1 && g[n] > bv) { bv = g[n]; s2 = n; }
            selbits = (1u << s0) | (1u << s1) | (1u << s2);
        }
    }
    const float s8 = 8.0f * exp2f(-(float)(h + 1));
    f32x16 base;
#pragma unroll
    for (int r = 0; r < 16; ++r) base[r] = s8 * (float)crow(r, hi);
    f32x16 o0, o1;
#pragma unroll
    for (int r = 0; r < 16; ++r) { o0[r] = 0.f; o1[r] = 0.f; }
    float m = -INFINITY, lsum = 0.f;
    const int NT = 4 * (cur + 1);
    const lds_cptr kp = (lds_cptr)(lds + L_K) + hi * 1024 + r32 * 16;
    const lds_cptr vp = (lds_cptr)(lds + L_V) + ((lane >> 4) & 1) * 32 + (lane & 3) * 8 + (4 * hi + ((lane & 15) >> 2)) * 64;
    for (int it = 0; it < NT; ++it) {
        asm volatile("s_waitcnt vmcnt(0)" ::: "memory");
        __syncthreads();
        const int blk = (it < 4) ? cur : ((it >> 2) - 1);
        const int kpos0 = blk * 256 + (it & 3) * 64;
        if (it + 1 < NT) { const int nblk = (it + 1 < 4) ? cur : (((it + 1) >> 2) - 1); ATT_DMA(nblk * 256 + ((it + 1) & 3) * 64, (it + 1) & 1); }
        const int so = (it & 1) * SLOT;
        f32x16 p0 = base, p1 = base;
#pragma unroll
        for (int d0 = 0; d0 < 4; ++d0) {
            const bf16x8 k0 = *(const __attribute__((address_space(3))) bf16x8*)(kp + so + d0 * 2048);
            const bf16x8 k1 = *(const __attribute__((address_space(3))) bf16x8*)(kp + so + d0 * 2048 + 512);
            p0 = __builtin_amdgcn_mfma_f32_32x32x16_bf16(k0, qr[d0], p0, 0, 0, 0);
            p1 = __builtin_amdgcn_mfma_f32_32x32x16_bf16(k1, qr[d0], p1, 0, 0, 0);
        }
        const bool rowsel = (it < 4) || ((selbits >> blk) & 1u);
        const float cb = rowsel ? -s8 * (float)(qpos - kpos0) : -INFINITY;
        const float cb1 = cb + s8 * 32.0f;
        if (it < 4) {
            const int kb0 = (it & 3) * 64 + 4 * hi;
#pragma unroll
            for (int r = 0; r < 16; ++r) { const int kv = kb0 + (r & 3) + 8 * (r >> 2); if (kv > qrel) p0[r] = -INFINITY; if (kv + 32 > qrel) p1[r] = -INFINITY; }
        }
        float mx0 = p0[0], mx1 = p1[0];
#pragma unroll
        for (int r = 1; r < 16; ++r) { mx0 = fmaxf(mx0, p0[r]); mx1 = fmaxf(mx1, p1[r]); }
        const float mx = swapmax(fmaxf(mx0 + cb, mx1 + cb1));
        if (__any((mx - m) * C2 > 6.0f)) {
            const float mn = fmaxf(m, mx);
            const float alpha = __builtin_amdgcn_exp2f((m - mn) * C2);
            m = mn; lsum *= alpha;
            asm volatile("s_waitcnt lgkmcnt(0)" ::: "memory");
            if (hi == 0) wsf[r32] = alpha;
            asm volatile("s_waitcnt lgkmcnt(0)" ::: "memory");
#pragma unroll
            for (int r = 0; r < 16; ++r) { const float al = wsf[crow(r, hi)]; o0[r] *= al; o1[r] *= al; }
        }
        const float tb0 = (cb - m) * C2, tb1 = (cb1 - m) * C2;
        float ls = 0.f;
#pragma unroll
        for (int r = 0; r < 16; ++r) { p0[r] = __builtin_amdgcn_exp2f(fmaf(p0[r], C2, tb0)); p1[r] = __builtin_amdgcn_exp2f(fmaf(p1[r], C2, tb1)); ls += p0[r] + p1[r]; }
        lsum += ls;
        pg8::u32x4 w0, w1, w2, w3;
        w0.x = pk2(p0[0], p0[1]); w0.y = pk2(p0[2], p0[3]); w0.z = pk2(p0[4], p0[5]); w0.w = pk2(p0[6], p0[7]);
        w1.x = pk2(p0[8], p0[9]); w1.y = pk2(p0[10], p0[11]); w1.z = pk2(p0[12], p0[13]); w1.w = pk2(p0[14], p0[15]);
        w2.x = pk2(p1[0], p1[1]); w2.y = pk2(p1[2], p1[3]); w2.z = pk2(p1[4], p1[5]); w2.w = pk2(p1[6], p1[7]);
        w3.x = pk2(p1[8], p1[9]); w3.y = pk2(p1[10], p1[11]); w3.z = pk2(p1[12], p1[13]); w3.w = pk2(p1[14], p1[15]);
        const bf16x8 pa0 = __builtin_bit_cast(bf16x8, w0), pa1 = __builtin_bit_cast(bf16x8, w1), pa2 = __builtin_bit_cast(bf16x8, w2), pa3 = __builtin_bit_cast(bf16x8, w3);
#define ATT_VF(d0, ks) ({ const s16x4 lo_ = vtr(vp + so + (d0) * 4096 + (ks) * 1024), hi_ = vtr(vp + so + (d0) * 4096 + (ks) * 1024 + 512); \
        (bf16x8){lo_[0], lo_[1], lo_[2], lo_[3], hi_[0], hi_[1], hi_[2], hi_[3]}; })
        o0 = __builtin_amdgcn_mfma_f32_32x32x16_bf16(pa0, ATT_VF(0, 0), o0, 0, 0, 0);
        o1 = __builtin_amdgcn_mfma_f32_32x32x16_bf16(pa0, ATT_VF(1, 0), o1, 0, 0, 0);
        o0 = __builtin_amdgcn_mfma_f32_32x32x16_bf16(pa1, ATT_VF(0, 1), o0, 0, 0, 0);
        o1 = __builtin_amdgcn_mfma_f32_32x32x16_bf16(pa1, ATT_VF(1, 1), o1, 0, 0, 0);
        o0 = __builtin_amdgcn_mfma_f32_32x32x16_bf16(pa2, ATT_VF(0, 2), o0, 0, 0, 0);
        o1 = __builtin_amdgcn_mfma_f32_32x32x16_bf16(pa2, ATT_VF(1, 2), o1, 0, 0, 0);
        o0 = __builtin_amdgcn_mfma_f32_32x32x16_bf16(pa3, ATT_VF(0, 3), o0, 0, 0, 0);
        o1 = __builtin_amdgcn_mfma_f32_32x32x16_bf16(pa3, ATT_VF(1, 3), o1, 0, 0, 0);
#undef ATT_VF
    }
#undef ATT_DMA
    const float lt = swapsum(lsum);
    asm volatile("s_waitcnt lgkmcnt(0)" ::: "memory");
    if (hi == 0) wsf[r32] = 1.0f / lt;
    asm volatile("s_waitcnt lgkmcnt(0)" ::: "memory");
    PG8_LAS float* stg = (PG8_LAS float*)(lds + L_OST) + wid * (32 * OST_LD);
#pragma unroll
    for (int r = 0; r < 16; ++r) { const int orow = crow(r, hi); const float il = wsf[orow]; stg[orow * OST_LD + r32] = o0[r] * il; stg[orow * OST_LD + 32 + r32] = o1[r] * il; }
    asm volatile("s_waitcnt lgkmcnt(0)" ::: "memory");
    const float* gain = a.in[18] + l * 512 + h * HD;
    bf16_t* MIX = (bf16_t*)(a.ws + WS_MIX);
#pragma unroll
    for (int i = 0; i < 4; ++i) {
        const int row = i * 8 + (lane >> 3), ch = lane & 7;
        const pg8::f32x4 va = *(PG8_LAS const pg8::f32x4*)(stg + row * OST_LD + ch * 8), vb = *(PG8_LAS const pg8::f32x4*)(stg + row * OST_LD + ch * 8 + 4);
        float ss = va[0] * va[0] + va[1] * va[1] + va[2] * va[2] + va[3] * va[3] + vb[0] * vb[0] + vb[1] * vb[1] + vb[2] * vb[2] + vb[3] * vb[3];
        ss += SC_DPP(ss, 0xB1); ss += SC_DPP(ss, 0x4E); ss += SC_DPP(ss, 0x141);
        const float rs = rsqrtf(ss * (1.0f / 64.0f) + 1e-6f);
        const pg8::f32x4 ga = *(const pg8::f32x4*)(gain + ch * 8), gb = *(const pg8::f32x4*)(gain + ch * 8 + 4);
        pg8::u32x4 w; w.x = pk2(va[0] * rs * ga[0], va[1] * rs * ga[1]); w.y = pk2(va[2] * rs * ga[2], va[3] * rs * ga[3]);
        w.z = pk2(vb[0] * rs * gb[0], vb[1] * rs * gb[1]); w.w = pk2(vb[2] * rs * gb[2], vb[3] * rs * gb[3]);
        *(pg8::u32x4*)(MIX + ((size_t)b * SEQ + cur * 256 + wid * 32 + row) * DM + h * HD + ch * 8) = w;
    }
}
}

__device__ __forceinline__ void phase_att(const Args& a, int l, PG8_LAS unsigned char* lds) {
    const int G = gridDim.x, bx = blockIdx.x;
    const int v = (G % 8 == 0) ? (bx % 8) * (G / 8) + bx / 8 : bx;
    for (int w = v; w < 256; w += G) {
        const int bh = w >> 2, s = w & 3;
        att::unit(a, l, bh >> 3, bh & 7, 7 - s, lds);
        att::unit(a, l, bh >> 3, bh & 7, s, lds);
    }
}

constexpr int CK_STRIDE = 4 * REC_TG * 4, CK_FR = 2048, CK_FM1 = 4096, CK_FM2 = 4608, CK_FBK = 5120, CK_W = 9216;
__device__ __forceinline__ void phase_prep2(const Args& a, float* lds, const bool probe = false) {
    typedef float f32x4 __attribute__((ext_vector_type(4)));
    const int tid = tid_fresh(), lane0 = tid & 63, wid = tid >> 6;
    float* L = lds + wid * 4352;
    unsigned char* REC = a.ws + WS_REC;
    for (int task = blockIdx.x * 8 + wid; task < 64 * 128; task += gridDim.x * 8) {
        int lane = lane0; asm volatile("" : "+v"(lane));
        const int bh = task >> 7, c = task & 127, j = lane, j2 = j >> 1, hf = j & 1;
        unsigned char* blob = REC + ((size_t)bh * 512 + 4 * c) * (REC_TG * 4);
        unsigned char* ob = probe ? a.ws + WS_MIX + (size_t)(task & 2047) * 10304 : blob;
        float w[16], av[16], bv[16], kv[16], rv[16];
#pragma unroll
        for (int tg = 0; tg < 4; ++tg) {
            const unsigned* rp = (const unsigned*)(blob + (size_t)tg * (REC_TG * 4)) + j2 * 20 + (j2 >> 4) * 4;
            unsigned wd[20];
#pragma unroll
            for (int q = 0; q < 5; ++q) { const uint4 x = *(const uint4*)(rp + 4 * q); wd[4 * q] = x.x; wd[4 * q + 1] = x.y; wd[4 * q + 2] = x.z; wd[4 * q + 3] = x.w; }
#pragma unroll
            for (int ts = 0; ts < 4; ++ts) { const int s_ = tg * 4 + ts;
#define P2H(q) ({ const h2_t h_ = __builtin_bit_cast(h2_t, wd[ts * 5 + (q)]); (float)(hf ? h_[1] : h_[0]); })
                w[s_] = 1.0f - P2H(0); av[s_] = P2H(1); bv[s_] = P2H(2); kv[s_] = P2H(3); rv[s_] = P2H(4);
#undef P2H
            }
        }
        asm volatile("s_waitcnt vmcnt(0)" ::: "memory");
        float ah[16], rh[16];
        {
            float Wc = 1.0f, bh_[16], kh_[16];
#pragma unroll
            for (int s_ = 0; s_ < 16; ++s_) { ah[s_] = av[s_] * Wc; Wc *= w[s_]; rh[s_] = rv[s_] * Wc; const float iw = 1.0f / Wc; bh_[s_] = bv[s_] * iw; kh_[s_] = kv[s_] * iw; }
#pragma unroll
            for (int s_ = 0; s_ < 16; ++s_) { L[s_ * 68 + j] = bh_[s_]; L[1088 + s_ * 68 + j] = kh_[s_]; L[2176 + s_ * 68 + j] = ah[s_]; L[3264 + s_ * 68 + j] = rh[s_]; }
#pragma unroll
            for (int g = 0; g < 4; ++g) { uint4 o; o.x = pk2(bh_[4 * g] * Wc, bh_[4 * g + 1] * Wc); o.y = pk2(bh_[4 * g + 2] * Wc, bh_[4 * g + 3] * Wc);
                o.z = pk2(kh_[4 * g] * Wc, kh_[4 * g + 1] * Wc); o.w = pk2(kh_[4 * g + 2] * Wc, kh_[4 * g + 3] * Wc);
                *(uint4*)(ob + CK_FBK + (j >> 4) * 1024 + ((j & 15) + 16 * g) * 16) = o; }
            *(float*)(ob + CK_W + j * 4) = Wc;
        }
        asm volatile("s_waitcnt lgkmcnt(0)" ::: "memory");
        { const int rI = lane & 15, gI = lane >> 4;
          f32x4 gab = {0.f, 0.f, 0.f, 0.f}, gak = gab, gbr = gab, gkr = gab;
#pragma unroll 4
          for (int kk = 0; kk < 16; ++kk) { const int o = rI * 68 + 4 * kk + gI;
            const float aB = L[o], aK = L[1088 + o], bA = L[2176 + o], bR = L[3264 + o];
            gab = __builtin_amdgcn_mfma_f32_16x16x4f32(aB, bA, gab, 0, 0, 0); gak = __builtin_amdgcn_mfma_f32_16x16x4f32(aK, bA, gak, 0, 0, 0);
            gbr = __builtin_amdgcn_mfma_f32_16x16x4f32(aB, bR, gbr, 0, 0, 0); gkr = __builtin_amdgcn_mfma_f32_16x16x4f32(aK, bR, gkr, 0, 0, 0); }
          asm volatile("s_waitcnt lgkmcnt(0)" ::: "memory");
          f32x4 nab, nbr;
#pragma unroll
          for (int e = 0; e < 4; ++e) { const int s_ = 4 * gI + e; nab[e] = (s_ < rI) ? gab[e] : 0.f; nbr[e] = (s_ <= rI) ? gbr[e] : 0.f;
              L[512 + s_ * 16 + rI] = (s_ < rI) ? gak[e] : 0.f; L[768 + s_ * 16 + rI] = (s_ <= rI) ? gkr[e] : 0.f; }
          *(f32x4*)&L[rI * 16 + 4 * gI] = nab; *(f32x4*)&L[256 + rI * 16 + 4 * gI] = nbr;
        }
        asm volatile("s_waitcnt lgkmcnt(0)" ::: "memory");
        { bf16_t* IM = (bf16_t*)((unsigned char*)L + 4096);
          const int ks = j >> 5, jw = j & 31, g = (jw & 15) >> 2, jj = ((jw >> 4) << 2) | (jw & 3);
          const int sp = lane & 15, oA = ks * 512 + (16 * g) * 8 + jj, oM = 2048 + (16 * (sp >> 2)) * 8 + (sp & 3);
          const bool mw = lane < 16;
          float x[16], m1[16];
#pragma unroll
          for (int t = 0; t < 16; ++t) {
            float nt[16], nr[16];
#pragma unroll
            for (int q = 0; q < 4; ++q) { const f32x4 v = *(const f32x4*)&L[t * 16 + 4 * q]; nt[4 * q] = v[0]; nt[4 * q + 1] = v[1]; nt[4 * q + 2] = v[2]; nt[4 * q + 3] = v[3];
                                          const f32x4 u = *(const f32x4*)&L[256 + t * 16 + 4 * q]; nr[4 * q] = u[0]; nr[4 * q + 1] = u[1]; nr[4 * q + 2] = u[2]; nr[4 * q + 3] = u[3]; }
            float xa = ah[t], ma = L[512 + sp * 16 + t], ra = rh[t], mb = L[768 + sp * 16 + t];
#pragma unroll
            for (int s_ = 0; s_ < 16; ++s_) if (s_ < t) { xa = fmaf(x[s_], nt[s_], xa); ma = fmaf(m1[s_], nt[s_], ma); }
            x[t] = xa; m1[t] = ma;
#pragma unroll
            for (int s_ = 0; s_ < 16; ++s_) if (s_ <= t) { ra = fmaf(x[s_], nr[s_], ra); mb = fmaf(m1[s_], nr[s_], mb); }
            IM[oA + t * 8] = f2bf(xa); IM[1024 + oA + t * 8] = f2bf(ra);
            if (mw) { IM[oM + t * 8] = f2bf(ma); IM[4 + oM + t * 8] = f2bf(mb); }
            asm volatile("" ::: "memory");
          }
          asm volatile("s_waitcnt lgkmcnt(0)" ::: "memory");
          const uint4* IMq = (const uint4*)IM;
          *(uint4*)(ob + lane * 16) = IMq[lane]; *(uint4*)(ob + 1024 + lane * 16) = IMq[64 + lane];
          *(uint4*)(ob + CK_FR + lane * 16) = IMq[128 + lane]; *(uint4*)(ob + CK_FR + 1024 + lane * 16) = IMq[192 + lane];
          *(uint4*)(ob + CK_FM1 + lane * 16) = IMq[256 + lane];
        }
        asm volatile("s_waitcnt lgkmcnt(0)" ::: "memory");
    }
}
__device__ __forceinline__ int scan2_unit(const Args& a, int l, int u, PG8_LAS unsigned char* lds, int cvt_k0, const int mode = 0) {
    typedef short bf16x8 __attribute__((ext_vector_type(8)));
    typedef float f32x4 __attribute__((ext_vector_type(4)));
    const int tid = tid_fresh(), lane = tid & 63, wid = __builtin_amdgcn_readfirstlane(tid >> 6);
    const int bh = u >> 2, rg = u & 3, b = bh >> 3, h = bh & 7;
    const int i16 = lane & 15, g = lane >> 4, irow = rg * 16 + i16;
    const unsigned char* REC = a.ws + WS_REC; const unsigned char* RVB = a.ws + WS_RVT; const unsigned char* ZERO = a.ws + 32768;
    bf16_t* YR = (bf16_t*)(a.ws + WS_YRAW);
    constexpr int DEPTH = 6, SLOTB = 11264, NCK = SEQ / 16, FLG_OFF = DEPTH * SLOTB, SCR_OFF = FLG_OFF + 256, CVT_PER_WG = 96;
    constexpr int L_FMM = 4096, L_FBK = 5120, L_V = 9216, L_W = 10240;
    volatile PG8_LAS unsigned* flg = (volatile PG8_LAS unsigned*)(lds + FLG_OFF);
#define S2_BLOB(c) (REC + ((size_t)bh * 512 + 4 * (c)) * (REC_TG * 4))
#define S2_SLOT(c) (lds + ((c) % DEPTH) * SLOTB)
#define S2_G2L(src_, dst_) __builtin_amdgcn_global_load_lds((const unsigned*)(src_), (PG8_LAS unsigned*)(dst_), 16, 0, 0)
#define S2_ISSUE_A(c) do { const unsigned char* bl_ = S2_BLOB(c) + lane * 16; PG8_LAS unsigned char* sl_ = S2_SLOT(c); \
        S2_G2L(bl_, sl_); S2_G2L(bl_ + 1024, sl_ + 1024); S2_G2L(bl_ + 2048, sl_ + 2048); S2_G2L(bl_ + 3072, sl_ + 3072); S2_G2L(bl_ + CK_FM1, sl_ + L_FMM); \
        S2_G2L(RVB + (((size_t)bh * 256 + 2 * (c) + (g >> 1)) * 64 + irow) * 16, sl_ + L_V); } while (0)
#define S2_ISSUE_B(c) do { const unsigned char* bl_ = S2_BLOB(c) + lane * 16; PG8_LAS unsigned char* sl_ = S2_SLOT(c); \
        S2_G2L(bl_ + CK_FBK, sl_ + L_FBK); S2_G2L(bl_ + CK_FBK + 1024, sl_ + L_FBK + 1024); S2_G2L(bl_ + CK_FBK + 2048, sl_ + L_FBK + 2048); S2_G2L(bl_ + CK_FBK + 3072, sl_ + L_FBK + 3072); \
        S2_G2L(S2_BLOB(c) + CK_W + (lane & 15) * 16, sl_ + L_W); } while (0)
    asm volatile("s_waitcnt vmcnt(0) lgkmcnt(0)" ::: "memory"); __builtin_amdgcn_s_barrier(); asm volatile("" ::: "memory");
    if (tid == 0) { flg[0] = 0u; flg[1] = 0u; flg[2] = 0u; flg[3] = 0u; flg[4] = (unsigned)cvt_k0; }
    asm volatile("s_waitcnt lgkmcnt(0)" ::: "memory"); __builtin_amdgcn_s_barrier(); asm volatile("" ::: "memory");
    if (wid == 0) {
        typedef short s16x4_ __attribute__((ext_vector_type(4)));
        typedef unsigned u32x2_ __attribute__((ext_vector_type(2)));
        f32x4 ST[4];
#pragma unroll
        for (int q = 0; q < 4; ++q) ST[q] = (f32x4){0.f, 0.f, 0.f, 0.f};
        unsigned known = 0u;
        struct Frag { bf16x8 fa0, fa1, fr0, fr1, fbk[4]; pg8::u32x4 fmm, v4w; f32x4 wv[4]; };
#define S2_WAITRDY(cc) do { while (known < (unsigned)((cc) + 1)) { const unsigned r0_ = flg[0], r1_ = flg[1]; known = r0_ < r1_ ? r0_ : r1_; if (known < (unsigned)((cc) + 1)) __builtin_amdgcn_s_sleep(1); } asm volatile("" ::: "memory"); } while (0)
#define S2_LOAD(X, cc) do { PG8_LAS const unsigned char* sl0_ = S2_SLOT(cc); PG8_LAS const unsigned char* sl_ = sl0_ + lane * 16; \
            X.fa0 = *(PG8_LAS const bf16x8*)(sl_); X.fa1 = *(PG8_LAS const bf16x8*)(sl_ + 1024); X.fr0 = *(PG8_LAS const bf16x8*)(sl_ + 2048); X.fr1 = *(PG8_LAS const bf16x8*)(sl_ + 3072); \
            X.fmm = *(PG8_LAS const pg8::u32x4*)(sl_ + L_FMM); X.v4w = *(PG8_LAS const pg8::u32x4*)(sl_ + L_V); \
            _Pragma("unroll") for (int jt = 0; jt < 4; ++jt) { X.fbk[jt] = *(PG8_LAS const bf16x8*)(sl_ + L_FBK + jt * 1024); X.wv[jt] = *(PG8_LAS const f32x4*)(sl0_ + L_W + (16 * jt + 4 * g) * 4); } \
            { const unsigned r0_ = flg[0], r1_ = flg[1]; known = r0_ < r1_ ? r0_ : r1_; } \
            asm volatile("" ::: "memory"); flg[2] = (unsigned)((cc) + 1); asm volatile("" ::: "memory"); } while (0)
#define S2_COMP(X, cc) do { \
            pg8::u32x4 s0, s1; \
            s0.x = pk2(ST[0][0], ST[0][1]); s0.y = pk2(ST[0][2], ST[0][3]); s0.z = pk2(ST[1][0], ST[1][1]); s0.w = pk2(ST[1][2], ST[1][3]); \
            s1.x = pk2(ST[2][0], ST[2][1]); s1.y = pk2(ST[2][2], ST[2][3]); s1.z = pk2(ST[3][0], ST[3][1]); s1.w = pk2(ST[3][2], ST[3][3]); \
            const bf16x8 sb0 = __builtin_bit_cast(bf16x8, s0), sb1 = __builtin_bit_cast(bf16x8, s1); \
            const u32x2_ vh_ = {(g & 1) ? X.v4w.z : X.v4w.x, (g & 1) ? X.v4w.w : X.v4w.y}, m1_ = {X.fmm.x, X.fmm.y}, m2_ = {X.fmm.z, X.fmm.w}; \
              \
            const pg8::u32x4 vq_ = {vh_[0], vh_[1], 0u, 0u}, q1_ = {m1_[0], m1_[1], 0u, 0u}, q2_ = {m2_[0], m2_[1], 0u, 0u}; \
            const bf16x8 vh = __builtin_bit_cast(bf16x8, vq_), fm1 = __builtin_bit_cast(bf16x8, q1_), fm2 = __builtin_bit_cast(bf16x8, q2_); \
            f32x4 PT = {0.f, 0.f, 0.f, 0.f}, YT = PT; \
            PT = __builtin_amdgcn_mfma_f32_16x16x32_bf16(X.fa0, sb0, PT, 0, 0, 0); YT = __builtin_amdgcn_mfma_f32_16x16x32_bf16(X.fr0, sb0, YT, 0, 0, 0); \
            PT = __builtin_amdgcn_mfma_f32_16x16x32_bf16(X.fa1, sb1, PT, 0, 0, 0); YT = __builtin_amdgcn_mfma_f32_16x16x32_bf16(X.fr1, sb1, YT, 0, 0, 0); \
            PT = __builtin_amdgcn_mfma_f32_16x16x32_bf16(fm1, vh, PT, 0, 0, 0);  YT = __builtin_amdgcn_mfma_f32_16x16x32_bf16(fm2, vh, YT, 0, 0, 0); \
            pg8::u32x4 pv; pv.x = pk2(PT[0], PT[1]); pv.y = pk2(PT[2], PT[3]); pv.z = vh_[0]; pv.w = vh_[1]; \
            const bf16x8 pvb = __builtin_bit_cast(bf16x8, pv); \
            _Pragma("unroll") for (int jt = 0; jt < 4; ++jt) ST[jt] = __builtin_amdgcn_mfma_f32_16x16x32_bf16(X.fbk[jt], pvb, ST[jt] * X.wv[jt], 0, 0, 0); \
            const size_t tok = (size_t)b * SEQ + 16 * (cc) + 4 * g; \
            _Pragma("unroll") for (int e = 0; e < 4; ++e) if (mode == 0 || YT[e] == 12345.678f) YR[(tok + e) * 512 + h * 64 + irow] = f2bf(YT[e]); } while (0)
        if (mode == 2) {
            for (int c = 0; c < NCK; ++c) { S2_WAITRDY(c); { const unsigned r0 = flg[0], r1 = flg[1]; known = r0 < r1 ? r0 : r1; } flg[2] = (unsigned)(c + 1); }
        } else {
            Frag F, G;
            S2_WAITRDY(0); S2_LOAD(F, 0);
            for (int c = 0; c < NCK; c += 2) {
                S2_WAITRDY(c + 1); S2_LOAD(G, c + 1);
                S2_COMP(F, c);
                if (c + 2 < NCK) { S2_WAITRDY(c + 2); S2_LOAD(F, c + 2); }
                S2_COMP(G, c + 1);
            }
        }
#undef S2_WAITRDY
#undef S2_LOAD
#undef S2_COMP
        asm volatile("" ::: "memory");
        flg[3] = 1u;
    } else if (wid == 4 || wid == 5) {
        const int d = wid - 4;
        if (mode != 1) { if (d == 0) { for (int c = 0; c < DEPTH - 1; ++c) S2_ISSUE_A(c); } else { for (int c = 0; c < DEPTH - 1; ++c) S2_ISSUE_B(c); } }
        if (mode == 1) flg[d] = (unsigned)NCK;
        for (int c = (mode == 1 ? NCK : 0); c < NCK; ++c) {
            if (mode == 1) {} else if (NCK - 1 - c >= DEPTH - 2) { if (d == 0) asm volatile("s_waitcnt vmcnt(%0)" :: "n"((DEPTH - 2) * 6) : "memory"); else asm volatile("s_waitcnt vmcnt(%0)" :: "n"((DEPTH - 2) * 5) : "memory"); }
            else asm volatile("s_waitcnt vmcnt(0)" ::: "memory");
            flg[d] = (unsigned)(c + 1);
            asm volatile("" ::: "memory");
            const int cn = c + DEPTH - 1;
            if (cn < NCK) {
                while (flg[2] < (unsigned)c) __builtin_amdgcn_s_sleep(2);
                asm volatile("" ::: "memory");
                if (mode != 1) { if (d == 0) S2_ISSUE_A(cn); else S2_ISSUE_B(cn); }
            }
        }
    } else {
        const int rank = (wid < 4) ? wid - 1 : wid - 3;
        float* scr = (float*)((unsigned char*)lds + SCR_OFF) + rank * (64 * 33);
        unsigned* ctr = (unsigned*)((unsigned char*)lds + FLG_OFF + 16);
        const int G = gridDim.x, bx = blockIdx.x;
        CvtItem cA, cB; float4 vA[8], vB[8];
#define S2_GRAB(cI, hI) do { int k_ = -1; if (flg[3] == 0u) { unsigned kk_ = 0u; if (lane == 0) kk_ = atomicAdd(ctr, 1u); k_ = __builtin_amdgcn_readfirstlane((int)kk_); } \
            hI = (k_ >= 0) && (k_ < CVT_PER_WG) && cvt_decode(a, l, bx * 8 + (k_ & 7) + G * 8 * (k_ >> 3), cI); } while (0)
        bool hA, hB;
        S2_GRAB(cA, hA); if (hA) cvt_load(cA, lane, vA);
        while (hA) {
            S2_GRAB(cB, hB); if (hB) cvt_load(cB, lane, vB);
            cvt_finish(cA, lane, vA, scr);
            if (!hB) break;
            S2_GRAB(cA, hA); if (hA) cvt_load(cA, lane, vA);
            cvt_finish(cB, lane, vB, scr);
        }
#undef S2_GRAB
    }
    asm volatile("s_waitcnt vmcnt(0) lgkmcnt(0)" ::: "memory"); __builtin_amdgcn_s_barrier(); asm volatile("" ::: "memory");
    const unsigned kn = flg[4];
    asm volatile("s_waitcnt lgkmcnt(0)" ::: "memory"); __builtin_amdgcn_s_barrier(); asm volatile("" ::: "memory");
#undef S2_BLOB
#undef S2_SLOT
#undef S2_G2L
#undef S2_ISSUE_A
#undef S2_ISSUE_B
    return __builtin_amdgcn_readfirstlane((int)(kn < (unsigned)CVT_PER_WG ? kn : (unsigned)CVT_PER_WG));
}

__device__ __forceinline__ void scan32(const Args& a, int l, int j, PG8_LAS unsigned char* lds) {
    const int tid = tid_fresh(), lane = tid & 63, wid = __builtin_amdgcn_readfirstlane(tid >> 6);
    const int jq = lane & 15, rr = lane >> 4;
    const char* REC = (const char*)(a.ws + WS_REC); const char* RVT = (const char*)(a.ws + WS_RVT);
    bf16_t* YR = (bf16_t*)(a.ws + WS_YRAW);
    constexpr int CSTEPS = 32, NCH = SEQ / CSTEPS, G_REC = 8 * REC_TG * 4, CH_REC = 21 * 1024, CH_V = 4096, CH = CH_REC + CH_V, NPC = 25;
    constexpr int YB_LD = 68, YB_WAVE = 16 * YB_LD * 4;
    PG8_LAS float* yb = (PG8_LAS float*)(lds + 2 * CH + wid * YB_WAVE);
    const int bh = j >> 1, hf32 = j & 1, b = bh >> 3, h = bh & 7;
    const int irow = hf32 * 32 + wid * 4 + rr;
    const char* grec = REC + (size_t)bh * NCH * G_REC; const char* gv = RVT + (size_t)bh * NCH * CH_V;
    float S0 = 0.f, S1 = 0.f, S2 = 0.f, S3 = 0.f;
    asm volatile("s_waitcnt vmcnt(0) lgkmcnt(0)" ::: "memory"); __builtin_amdgcn_s_barrier(); asm volatile("" ::: "memory");
#define SCAN_DMA(chn, bufo) do { _Pragma("unroll") for (int k_ = 0; k_ < 4; ++k_) { const int pc_ = wid * 4 + k_; if (pc_ < NPC) { \
        const char* src_ = (pc_ < 21) ? grec + (size_t)(chn) * G_REC + pc_ * 1024 + lane * 16 : gv + (size_t)(chn) * CH_V + (pc_ - 21) * 1024 + lane * 16; \
        __builtin_amdgcn_global_load_lds((const unsigned*)src_, (PG8_LAS unsigned*)(lds + (bufo) + pc_ * 1024), 16, 0, 0); } } } while (0)
    SCAN_DMA(0, 0);
    for (int ch = 0; ch < NCH; ++ch) {
        asm volatile("s_waitcnt vmcnt(0) lgkmcnt(0)" ::: "memory"); __builtin_amdgcn_s_barrier(); asm volatile("" ::: "memory");
        if (ch + 1 < NCH) SCAN_DMA(ch + 1, ((ch + 1) & 1) * CH);
        PG8_LAS const unsigned char* bufp = lds + (ch & 1) * CH;
#define SCAN_LOADW(WA, WB, grp) do { PG8_LAS const unsigned char* rp_ = bufp + (grp) * (REC_TG * 4) + jq * 160 + (jq >> 3) * 16; _Pragma("unroll") for (int k_ = 0; k_ < 5; ++k_) { \
        const pg8::u32x4 q_ = *(PG8_LAS const pg8::u32x4*)(rp_ + 16 * k_), q2_ = *(PG8_LAS const pg8::u32x4*)(rp_ + 80 + 16 * k_); \
        WA[4 * k_] = q_.x; WA[4 * k_ + 1] = q_.y; WA[4 * k_ + 2] = q_.z; WA[4 * k_ + 3] = q_.w; WB[4 * k_] = q2_.x; WB[4 * k_ + 1] = q2_.y; WB[4 * k_ + 2] = q2_.z; WB[4 * k_ + 3] = q2_.w; } } while (0)
#define SCAN_STEPS(WA, WB, hf) do { _Pragma("unroll") for (int ts = 0; ts < 4; ++ts) { \
        const unsigned uA = WA[ts * 5], aA = WA[ts * 5 + 1], bA = WA[ts * 5 + 2], kA = WA[ts * 5 + 3], rA = WA[ts * 5 + 4]; \
        const unsigned uB = WB[ts * 5], aB = WB[ts * 5 + 1], bB = WB[ts * 5 + 2], kB = WB[ts * 5 + 3], rB = WB[ts * 5 + 4]; \
        const unsigned vw = vv[(hf) * 2 + (ts >> 1)]; \
        const float sa = red16(fmix_hi(S3, aB, fmix_lo(S2, aB, fmix_hi(S1, aA, fmul_lo(S0, aA))))); \
        float t0 = fdec_lo(S0, uA), t1 = fdec_hi(S1, uA), t2 = fdec_lo(S2, uB), t3 = fdec_hi(S3, uB); \
        if (ts & 1) { t0 = fvk_lo<1>(vw, kA, t0); t1 = fvk_hi<1>(vw, kA, t1); t2 = fvk_lo<1>(vw, kB, t2); t3 = fvk_hi<1>(vw, kB, t3); } \
        else { t0 = fvk_lo<0>(vw, kA, t0); t1 = fvk_hi<0>(vw, kA, t1); t2 = fvk_lo<0>(vw, kB, t2); t3 = fvk_hi<0>(vw, kB, t3); } \
        S0 = fmix_lo(sa, bA, t0); S1 = fmix_hi(sa, bA, t1); S2 = fmix_lo(sa, bB, t2); S3 = fmix_hi(sa, bB, t3); \
        yb[((g8 & 1) * 8 + (hf) * 4 + ts) * YB_LD + rr * 16 + jq] = fmix_hi(S3, rB, fmix_lo(S2, rB, fmix_hi(S1, rA, fmul_lo(S0, rA)))); } } while (0)
        unsigned wA0[20], wB0[20], wA1[20], wB1[20];
        SCAN_LOADW(wA0, wB0, 0);
#pragma unroll 1
        for (int g8 = 0; g8 < 4; ++g8) {
            const pg8::u32x4 vv = *(PG8_LAS const pg8::u32x4*)(bufp + CH_REC + (g8 * 64 + irow) * 16);
            SCAN_LOADW(wA1, wB1, g8 * 2 + 1);
            SCAN_STEPS(wA0, wB0, 0);
            if (g8 < 3) SCAN_LOADW(wA0, wB0, g8 * 2 + 2);
            SCAN_STEPS(wA1, wB1, 1);
            if (g8 & 1) {
                asm volatile("s_waitcnt lgkmcnt(0)" ::: "memory");
                PG8_LAS const float* yp = yb + jq * YB_LD + rr * 16;
                const pg8::f32x4 y0 = *(PG8_LAS const pg8::f32x4*)(yp), y1 = *(PG8_LAS const pg8::f32x4*)(yp + 4), y2 = *(PG8_LAS const pg8::f32x4*)(yp + 8), y3 = *(PG8_LAS const pg8::f32x4*)(yp + 12);
                const pg8::f32x4 ys = (y0 + y1) + (y2 + y3);
                const float y = (ys[0] + ys[1]) + (ys[2] + ys[3]);
                const int t = ch * CSTEPS + (g8 >> 1) * 16 + jq;
                YR[((size_t)b * SEQ + t) * 512 + h * 64 + irow] = f2bf(y);
                asm volatile("s_waitcnt lgkmcnt(0)" ::: "memory");
            }
        }
#undef SCAN_LOADW
#undef SCAN_STEPS
    }
#undef SCAN_DMA
}
__device__ __forceinline__ void phase_scan_att2(const Args& a, int l, PG8_LAS unsigned char* lds) {
    const int bx = blockIdx.x;
    const int j = (bx & 7) * 16 + (bx >> 4);
    if (((bx >> 3) & 1) == 0) scan32(a, l, j, lds);
    else {
        const int bh = j >> 1, b = bh >> 3, h = bh & 7;
#pragma unroll 1
        for (int q = 0; q < 2; ++q) { const int s = 2 * (j & 1) + q; att::unit(a, l, b, h, 7 - s, lds); att::unit(a, l, b, h, s, lds); }
        __syncthreads();
        const int tid = tid_fresh(), lane = tid & 63, wid = tid >> 6;
        float* scr = (float*)((unsigned char*)lds) + wid * (64 * 33);
        CvtItem c0, c1; float4 v0[8], v1[8];
        int it = j * 8 + wid; const int NCW = 128 * 8;
        bool h0 = cvt_decode(a, l, it, c0); if (h0) cvt_load(c0, lane, v0);
        while (h0) {
            const bool h1 = cvt_decode(a, l, it + NCW, c1); if (h1) cvt_load(c1, lane, v1);
            cvt_finish(c0, lane, v0, scr);
            it += 2 * NCW;
            h0 = h1 && cvt_decode(a, l, it, c0); if (h0) cvt_load(c0, lane, v0);
            if (h1) cvt_finish(c1, lane, v1, scr);
        }
    }
}

__device__ __forceinline__ void phase_scan2_att(const Args& a, int l, PG8_LAS unsigned char* lds, const int parts = 7) {
    const int G = gridDim.x, bx = blockIdx.x;
    const int v = (G % 8 == 0) ? (bx % 8) * (G / 8) + bx / 8 : bx;
    int k0 = (parts & 4) ? 0 : 96;
    if (parts & 1) for (int u = v; u < 256; u += G) k0 = scan2_unit(a, l, u, lds, k0, (parts >> 3) & 3);
    if (parts & 2) for (int w = v; w < 256; w += G) { const int bh = w >> 2, s = w & 3; att::unit(a, l, bh >> 3, bh & 7, 7 - s, lds); att::unit(a, l, bh >> 3, bh & 7, s, lds); }
    if (k0 >= 96) return;
    __syncthreads();
    const int tid = tid_fresh(), lane = tid & 63, wid = tid >> 6;
    float* scr = (float*)((unsigned char*)lds) + wid * (64 * 33);
    CvtItem c0, c1; float4 v0[8], v1[8];
    int k = k0 + wid;
#define P3_IT(k_) (bx * 8 + ((k_) & 7) + G * 8 * ((k_) >> 3))
    bool h0 = k < 96 && cvt_decode(a, l, P3_IT(k), c0); if (h0) cvt_load(c0, lane, v0);
    while (h0) {
        const bool h1 = k + 8 < 96 && cvt_decode(a, l, P3_IT(k + 8), c1); if (h1) cvt_load(c1, lane, v1);
        cvt_finish(c0, lane, v0, scr);
        k += 16;
        h0 = h1 && k < 96 && cvt_decode(a, l, P3_IT(k), c0); if (h0) cvt_load(c0, lane, v0);
        if (h1) cvt_finish(c1, lane, v1, scr);
    }
#undef P3_IT
}

__device__ __forceinline__ void phase_dense_res(const void* A, const void* WT, const float* RES, const bf16_t* RESB, bf16_t* OUT, PG8_LAS unsigned char* lds) {
    pg8::DenseSched S; S.init(A, DM, NTOK, WT, DM, DM);
    pg8::EpiBf16Res E{OUT, RES, DM, ALPHA, RESB};
    pg8::gemm_phase<pg8::EpiBf16Res, pg8::DenseSched, false>(lds, pg8::Dims{DM, DM, DM}, S, E);
}
__device__ __forceinline__ void phase_dense_bf16(const void* A, int M, const void* WT, int N, bf16_t* OUT, PG8_LAS unsigned char* lds) {
    pg8::DenseSched S; S.init(A, DM, M, WT, DM, N);
    pg8::EpiBf16 E{OUT, N};
    pg8::gemm_phase<pg8::EpiBf16, pg8::DenseSched, false>(lds, pg8::Dims{DM, DM, DM}, S, E);
}

__device__ __forceinline__ void ln_load(const bf16_t* in, int lane, uint2 (&raw)[4]) {
#pragma unroll
    for (int m = 0; m < 4; ++m) raw[m] = *(const uint2*)(in + m * 256 + lane * 4);
}
__device__ __forceinline__ void ln_calc(const uint2 (&raw)[4], const float* g, const float* bta, float* out, bf16_t* outb, int lane, float (&xn)[16]) {
    float x[16];
#pragma unroll
    for (int m = 0; m < 4; ++m) { const uint2 v = raw[m]; x[m * 4] = bflo(v.x); x[m * 4 + 1] = bfhi(v.x); x[m * 4 + 2] = bflo(v.y); x[m * 4 + 3] = bfhi(v.y); }
    float s = 0.f;
#pragma unroll
    for (int k = 0; k < 16; ++k) s += x[k];
    const float mean = wsum(s) * (1.0f / 1024.0f);
    float q = 0.f;
#pragma unroll
    for (int k = 0; k < 16; ++k) { const float d = x[k] - mean; q = fmaf(d, d, q); }
    const float var = wsum(q) * (1.0f / 1024.0f);
    const float rstd = rsqrtf(var + 1e-5f);
#pragma unroll
    for (int m = 0; m < 4; ++m) {
        const float4 gv = *(const float4*)(g + m * 256 + lane * 4), bv = *(const float4*)(bta + m * 256 + lane * 4);
        float4 o;
        o.x = (x[m * 4] - mean) * rstd * gv.x + bv.x; o.y = (x[m * 4 + 1] - mean) * rstd * gv.y + bv.y;
        o.z = (x[m * 4 + 2] - mean) * rstd * gv.z + bv.z; o.w = (x[m * 4 + 3] - mean) * rstd * gv.w + bv.w;
        xn[m * 4] = o.x; xn[m * 4 + 1] = o.y; xn[m * 4 + 2] = o.z; xn[m * 4 + 3] = o.w;
        if (out) *(float4*)(out + m * 256 + lane * 4) = o;
        uint2 ob; ob.x = pk2(o.x, o.y); ob.y = pk2(o.z, o.w); *(uint2*)(outb + m * 256 + lane * 4) = ob;
    }
}
__device__ __forceinline__ void ln_row(const bf16_t* in, const float* g, const float* bta, float* out, bf16_t* outb, int lane, float (&xn)[16]) {
    uint2 raw[4]; ln_load(in, lane, raw); ln_calc(raw, g, bta, out, outb, lane, xn);
}
__device__ __forceinline__ void phase_ln(const bf16_t* IN, const float* g, const float* bta, float* OUT, bf16_t* OUTB) {
    const int tid = tid_fresh(), lane = tid & 63, wid = tid >> 6;
    const int RS = gridDim.x * 8;
    int row = blockIdx.x * 8 + wid;
    uint2 rA[4], rB[4]; float xn[16];
    if (row < NTOK) ln_load(IN + (size_t)row * DM, lane, rA);
    while (row < NTOK) {
        const int r1 = row + RS; const bool h1 = r1 < NTOK;
        if (h1) ln_load(IN + (size_t)r1 * DM, lane, rB);
        ln_calc(rA, g, bta, OUT ? OUT + (size_t)row * DM : (float*)nullptr, OUTB + (size_t)row * DM, lane, xn);
        row = r1 + RS;
        if (!h1) break;
        if (row < NTOK) ln_load(IN + (size_t)row * DM, lane, rA);
        ln_calc(rB, g, bta, OUT ? OUT + (size_t)r1 * DM : (float*)nullptr, OUTB + (size_t)r1 * DM, lane, xn);
    }
}

__device__ __forceinline__ float treduce32(float (&p)[32], int lane) {
    float q[16], r[8], s4[4], t2[2];
#pragma unroll
    for (int i = 0; i < 16; ++i) { auto sw = __builtin_amdgcn_permlane32_swap(__float_as_uint(p[i]), __float_as_uint(p[i + 16]), false, false); q[i] = __uint_as_float(sw[0]) + __uint_as_float(sw[1]); }
    const bool L4 = (lane & 16) != 0, L3 = (lane & 8) != 0, L2 = (lane & 4) != 0, L1 = (lane & 2) != 0;
#pragma unroll
    for (int i = 0; i < 8; ++i) { const float snd = L4 ? q[i] : q[i + 8], keep = L4 ? q[i + 8] : q[i]; r[i] = keep + __shfl_xor(snd, 16); }
#pragma unroll
    for (int i = 0; i < 4; ++i) { const float snd = L3 ? r[i] : r[i + 4], keep = L3 ? r[i + 4] : r[i]; s4[i] = keep + SC_DPP(snd, 0x140); }
#pragma unroll
    for (int i = 0; i < 2; ++i) { const float snd = L2 ? s4[i] : s4[i + 2], keep = L2 ? s4[i + 2] : s4[i]; t2[i] = keep + SC_DPP(snd, 0x141); }
    const float snd = L1 ? t2[0] : t2[1], keep = L1 ? t2[1] : t2[0];
    float u = keep + SC_DPP(snd, 0x4E);
    u += SC_DPP(u, 0xB1);
    return __shfl(u, (lane & 31) * 2);
}
struct RouteRes { int e0, e1; float g0, g1; };
__device__ __forceinline__ RouteRes route_row(float mylogit, int lane, const float* BR) {
    const float s = sigmoidf_(mylogit);
    const float sel = (lane < 32) ? s + BR[lane & 31] : NEG_INF;
    const int gb = lane & ~3;
    const float v0 = __shfl(sel, gb), v1 = __shfl(sel, gb + 1), v2 = __shfl(sel, gb + 2), v3 = __shfl(sel, gb + 3);
    const float m1 = fmaxf(fmaxf(v0, v1), fmaxf(v2, v3));
    float m2;
    { const float lo01 = fminf(v0, v1), hi01 = fmaxf(v0, v1), lo23 = fminf(v2, v3), hi23 = fmaxf(v2, v3);
      m2 = fmaxf(fminf(hi01, hi23), fmaxf(lo01, lo23)); }
    float gs = (lane < 32) ? (m1 + m2) : NEG_INF;
    int gi = lane >> 2;
#pragma unroll
    for (int o = 32; o > 0; o >>= 1) { const float ov = __shfl_xor(gs, o); const int oi = __shfl_xor(gi, o); if (ov > gs || (ov == gs && oi < gi)) { gs = ov; gi = oi; } }
    const int gbest = gi;
    const float c0 = __shfl(sel, gbest * 4), c1 = __shfl(sel, gbest * 4 + 1), c2 = __shfl(sel, gbest * 4 + 2), c3 = __shfl(sel, gbest * 4 + 3);
    int j0 = 0; float b0 = c0;
    if (c1 > b0) { b0 = c1; j0 = 1; } if (c2 > b0) { b0 = c2; j0 = 2; } if (c3 > b0) { b0 = c3; j0 = 3; }
    int j1 = -1; float b1 = -3e38f;
    if (j0 != 0 && c0 > b1) { b1 = c0; j1 = 0; } if (j0 != 1 && c1 > b1) { b1 = c1; j1 = 1; } if (j0 != 2 && c2 > b1) { b1 = c2; j1 = 2; } if (j0 != 3 && c3 > b1) { b1 = c3; j1 = 3; }
    RouteRes R; R.e0 = gbest * 4 + j0; R.e1 = gbest * 4 + j1;
    const float s0 = __shfl(s, R.e0), s1 = __shfl(s, R.e1);
    const float inv = 1.0f / (s0 + s1);
    R.g0 = s0 * inv; R.g1 = s1 * inv;
    return R;
}
__device__ __forceinline__ void phase_ln2_router(const Args& a, int l, float* lds, bool dummy = false) {
    const int tid = tid_fresh(), lane = tid & 63, wid = tid >> 6;
    const bf16_t* PRE = (const bf16_t*)(a.ws + WS_PRE2);
    bf16_t* X2B = (bf16_t*)(a.ws + WS_X2B);
    const float* g = a.in[28] + (size_t)(l * 3 + 1) * DM; const float* bta = a.in[29] + (size_t)(l * 3 + 1) * DM;
    const float* WR = a.in[23]; const float* BR = a.in[24];
    unsigned* cnt = (unsigned*)(a.ws + WS_CTL) + CW_CNT + l * 32 + (dummy ? 128 : 0);
    int2* list = (int2*)(a.ws + (dummy ? WS_H : WS_LIST));
    int2* tokpos = (int2*)(a.ws + (dummy ? WS_H + 8 * MiB : WS_TOKPOS));
    float2* tokgate = (float2*)(a.ws + (dummy ? WS_H + 9 * MiB : WS_TOKGATE));
    constexpr int WR_LD = DM + 4;
    unsigned* lcnt = (unsigned*)(lds + NEXP * WR_LD);
    int* lres = (int*)(lds + NEXP * WR_LD + 64);
    __syncthreads();
    {
        float4 wv[16];
#pragma unroll
        for (int q = 0; q < 16; ++q) wv[q] = *(const float4*)(WR + (size_t)(q * NTHREADS + tid) * 4);
#pragma unroll
        for (int q = 0; q < 16; ++q) { const int idx = (q * NTHREADS + tid) * 4, k = idx >> 5, e = idx & 31;
            lds[e * WR_LD + k] = wv[q].x; lds[(e + 1) * WR_LD + k] = wv[q].y; lds[(e + 2) * WR_LD + k] = wv[q].z; lds[(e + 3) * WR_LD + k] = wv[q].w; }
    }
    if (tid < 64) lcnt[tid] = 0u;
    __syncthreads();
    int nloc = 0;
    uint2 rwa[4], rwb[4];
    { const int row0 = (blockIdx.x * 8 + wid) * 2; if (row0 < NTOK) { ln_load(PRE + (size_t)row0 * DM, lane, rwa); ln_load(PRE + (size_t)(row0 + 1) * DM, lane, rwb); } }
    for (int row = (blockIdx.x * 8 + wid) * 2; row < NTOK; row += gridDim.x * 16) {
        float xa[16], xb[16];
        ln_calc(rwa, g, bta, (float*)nullptr, X2B + (size_t)row * DM, lane, xa);
        ln_calc(rwb, g, bta, (float*)nullptr, X2B + (size_t)(row + 1) * DM, lane, xb);
        { const int rn = row + gridDim.x * 16; if (rn < NTOK) { ln_load(PRE + (size_t)rn * DM, lane, rwa); ln_load(PRE + (size_t)(rn + 1) * DM, lane, rwb); } }
        float pa[32], pb[32];
#pragma unroll
        for (int e = 0; e < NEXP; ++e) {
            float sa_ = 0.f, sb_ = 0.f;
#pragma unroll
            for (int m = 0; m < 4; ++m) { const float4 wv = *(const float4*)&lds[e * WR_LD + m * 256 + lane * 4];
                sa_ = fmaf(xa[m * 4], wv.x, sa_); sa_ = fmaf(xa[m * 4 + 1], wv.y, sa_); sa_ = fmaf(xa[m * 4 + 2], wv.z, sa_); sa_ = fmaf(xa[m * 4 + 3], wv.w, sa_);
                sb_ = fmaf(xb[m * 4], wv.x, sb_); sb_ = fmaf(xb[m * 4 + 1], wv.y, sb_); sb_ = fmaf(xb[m * 4 + 2], wv.z, sb_); sb_ = fmaf(xb[m * 4 + 3], wv.w, sb_); }
            pa[e] = sa_; pb[e] = sb_;
        }
        const float la = treduce32(pa, lane), lb = treduce32(pb, lane);
#pragma unroll
        for (int q = 0; q < 2; ++q) {
            const RouteRes R = route_row(q ? lb : la, lane, BR);
            if (lane == 0) {
                const unsigned r0 = atomicAdd(&lcnt[R.e0], 1u), r1 = atomicAdd(&lcnt[R.e1], 1u);
                int* o = lres + (wid * 32 + nloc + q) * 8;
                o[0] = row + q; o[1] = R.e0; o[2] = R.e1; o[3] = (int)r0; o[4] = (int)r1; o[5] = __float_as_int(R.g0); o[6] = __float_as_int(R.g1);
            }
        }
        nloc += 2;
    }
    __syncthreads();
    if (tid < 32) lcnt[32 + tid] = atomicAdd(&cnt[tid], lcnt[tid]);
    __syncthreads();
    for (int i = lane; i < nloc; i += 64) {
        const int* o = lres + (wid * 32 + i) * 8;
        const int row = o[0], e0 = o[1], e1 = o[2]; const unsigned r0 = lcnt[32 + e0] + (unsigned)o[3], r1 = lcnt[32 + e1] + (unsigned)o[4];
        list[(size_t)e0 * LCAP + r0] = make_int2(row, o[5]);
        list[(size_t)e1 * LCAP + r1] = make_int2(row, o[6]);
        tokpos[row * 2] = make_int2(e0, (int)r0); tokpos[row * 2 + 1] = make_int2(e1, (int)r1);
        tokgate[row] = make_float2(__int_as_float(o[5]), __int_as_float(o[6]));
    }
}

constexpr int ZERO_ROW = 32768 / 2048;
struct I2 { int x, y; };
struct MoeSched {
    int G, c, T, npn; PG8_LAS I2* tab;
    const char* A; const char* B; size_t b_e, b_pn, a_tile; int colw;
    const int2* list; int gat_row0;
    __device__ void init(PG8_LAS unsigned char* lds, const unsigned* cnt, int npn_, const void* A_, size_t a_tile_, const void* B_, size_t b_e_, size_t b_pn_, int colw_, const int2* list_, int gat_row0_) {
        const int lane = tid_fresh() & 63, x = lane & 31;
        G = gridDim.x; c = blockIdx.x; npn = npn_; A = (const char*)A_; a_tile = a_tile_; B = (const char*)B_; b_e = b_e_; b_pn = b_pn_; colw = colw_; list = list_; gat_row0 = gat_row0_;
        const unsigned cnt_l = __hip_atomic_load(cnt + x, __ATOMIC_RELAXED, __HIP_MEMORY_SCOPE_AGENT);
        const int tiles = (int)((cnt_l + 255u) >> 8);
        int inc = tiles;
#pragma unroll
        for (int o = 1; o < 32; o <<= 1) { const int t = __shfl_up(inc, o, 32); if (x >= o) inc += t; }
        tab = (PG8_LAS I2*)(lds + pg8::STAGE_BYTES + 8192);
        tab[x].x = (int)cnt_l; tab[x].y = inc - tiles;
        T = __builtin_amdgcn_readfirstlane(__shfl(inc, 31));
        __syncthreads();
    }
    __device__ __forceinline__ bool next(int i, pg8::Unit& u) const { return unit_of((long)i * G + c, u); }
    __device__ __forceinline__ bool unit_of(long L, pg8::Unit& u) const {
        if (L >= (long)T * npn) return false;
        const int ti = (int)(L / npn), pn = (int)(L % npn);
        const int my_excl = tab[__builtin_amdgcn_mbcnt_lo(~0u, 0u) & 31].y;
        const unsigned long long m = __ballot(my_excl <= ti) & 0xffffffffull;
        const int e = __popcll(m) - 1;
        const int rt = ti - tab[e].y;
        const unsigned ce = (unsigned)tab[e].x;
        u.aux = __builtin_amdgcn_readfirstlane(e | (rt << 8)); u.aux2 = __builtin_amdgcn_readfirstlane((int)ce);
        u.row0 = ti * 256; u.col0 = pn * colw;
        u.A = A + (size_t)ti * a_tile; u.B = B + (size_t)e * b_e + (size_t)pn * b_pn;
        return true;
    }
    __device__ __forceinline__ int arow(const pg8::Unit& u, int r) const {
        const int e = u.aux & 255, rank = (u.aux >> 8) * 256 + r;
        return rank < u.aux2 ? gat_row0 + list[(size_t)e * LCAP + rank].x : ZERO_ROW;
    }
};
struct EpiSwiGLU {
    static constexpr bool PERM = true;
    bf16_t* H;
    __device__ __forceinline__ void operator()(const pg8::f32x4 (&acc)[2][2][4][2], const pg8::Unit& u, int wr, int wc, int fr, int fq) const {
        const int col = u.col0 + wc * 32 + 8 * fq;
#pragma unroll
        for (int ai = 0; ai < 2; ++ai)
#pragma unroll
            for (int m = 0; m < 4; ++m) {
                const int r = wr * 64 + fr + ai * 128 + m * 16;
                float hv[8];
#pragma unroll
                for (int n = 0; n < 2; ++n)
#pragma unroll
                    for (int j = 0; j < 4; ++j) { const float g = acc[ai][0][m][n][j], up = acc[ai][1][m][n][j]; hv[n * 4 + j] = g * up * __builtin_amdgcn_rcpf(1.0f + __expf(-g)); }
                pg8::u32x4 w; w.x = pk2(hv[0], hv[1]); w.y = pk2(hv[2], hv[3]); w.z = pk2(hv[4], hv[5]); w.w = pk2(hv[6], hv[7]);
                *(pg8::u32x4*)(H + (size_t)(u.row0 + r) * DEXP + col) = w;
            }
    }
};
__device__ __forceinline__ void phase_f3(const Args& a, int l, PG8_LAS unsigned char* lds) {
    const unsigned* cnt = (const unsigned*)(a.ws + WS_CTL) + CW_CNT + l * 32;
    const int2* list = (const int2*)(a.ws + WS_LIST);
    MoeSched S; S.init(lds, cnt, 4, a.ws, 0, a.ws + WS_WEXP, (size_t)1024 * 1024 * 2, (size_t)256 * 1024 * 2, 128, list, (int)(WS_X2B / 2048));
    EpiSwiGLU E{(bf16_t*)(a.ws + WS_H)};
    pg8::gemm_phase<EpiSwiGLU, MoeSched, true>(lds, pg8::Dims{DM, DM, DM}, S, E);
}
__device__ __forceinline__ void phase_f4(const Args& a, int l, PG8_LAS unsigned char* lds) {
    const unsigned* cnt = (const unsigned*)(a.ws + WS_CTL) + CW_CNT + l * 32;
    MoeSched S; S.init(lds, cnt, 4, a.ws + WS_H, (size_t)256 * DEXP * 2, a.ws + WS_WEXP + (size_t)NEXP * 1024 * 1024 * 2, (size_t)1024 * 512 * 2, (size_t)256 * 512 * 2, 256, nullptr, 0);
    pg8::EpiBf16 E{(bf16_t*)(a.ws + WS_Y), DM};
    pg8::gemm_phase<pg8::EpiBf16, MoeSched, false>(lds, pg8::Dims{DEXP, DEXP, DEXP}, S, E);
}
struct MoeListSched {
    MoeSched base; PG8_LAS const int* ul; int n;
    __device__ __forceinline__ bool next(int i, pg8::Unit& u) const { if (i >= n) return false; return base.unit_of((long)ul[i], u); }
    __device__ __forceinline__ int arow(const pg8::Unit& u, int r) const { return base.arow(u, r); }
};
struct F4Plan { int U, nLate, nE, nEarlyUnits, tpr, q, ne; bool plain; };
__device__ __forceinline__ F4Plan f4_plan(int T, int G) {
    F4Plan p; p.U = 4 * T; const int R = (p.U + G - 1) / G; p.nLate = p.U - G * (R - 1); p.nE = G - p.nLate;
    p.plain = (G & 3) || p.nE <= 0 || R < 2;
    p.tpr = G / 4; p.q = p.nLate / 4; p.ne = p.tpr - p.q;
    p.nEarlyUnits = p.plain ? p.U : p.ne * (R - 1) * 4;
    if (p.plain) { p.nLate = G; p.nE = 0; }
    return p;
}
__device__ __forceinline__ int f4_unit(const F4Plan& p, int gidx) {
    if (p.plain) return gidx;
    const int pn = gidx & 3;
    if (gidx < p.nEarlyUnits) { const int e = gidx >> 2, r = e / p.ne, pos = e % p.ne; return ((p.tpr * r + p.q + pos) << 2) | pn; }
    const int e = (gidx - p.nEarlyUnits) >> 2, r = e / p.q, pos = e % p.q;
    return ((p.tpr * r + pos) << 2) | pn;
}
__device__ __forceinline__ void phase_f34(const Args& a, int l, PG8_LAS unsigned char* lds) {
    const unsigned* cnt = (const unsigned*)(a.ws + WS_CTL) + CW_CNT + l * 32;
    unsigned* ctlw = (unsigned*)(a.ws + WS_CTL);
    unsigned* done = ctlw + CW_TILE + l * 256; unsigned* bar = ctlw + CW_BAR;
    const int2* list = (const int2*)(a.ws + WS_LIST);
    int T;
    {
        MoeSched S; S.init(lds, cnt, 4, a.ws, 0, a.ws + WS_WEXP, (size_t)1024 * 1024 * 2, (size_t)256 * 1024 * 2, 128, list, (int)(WS_X2B / 2048));
        EpiSwiGLU E{(bf16_t*)(a.ws + WS_H)};
        pg8::gemm_phase<EpiSwiGLU, MoeSched, true>(lds, pg8::Dims{DM, DM, DM}, S, E);
        T = S.T;
    }
    asm volatile("s_waitcnt vmcnt(0)" ::: "memory");
    __syncthreads();
    if (threadIdx.x == 0) {
        __builtin_amdgcn_fence(__ATOMIC_RELEASE, "agent");
        for (long L = blockIdx.x; L < (long)T * 4; L += gridDim.x) (void)xb_add(&done[L >> 2], 1u);
    }
    MoeListSched S4;
    S4.base.init(lds, cnt, 4, a.ws + WS_H, (size_t)256 * DEXP * 2, a.ws + WS_WEXP + (size_t)NEXP * 1024 * 1024 * 2, (size_t)1024 * 512 * 2, (size_t)256 * 512 * 2, 256, nullptr, 0);
    PG8_LAS int* ul = (PG8_LAS int*)(lds + pg8::STAGE_BYTES + 8192 + 256);
    const F4Plan P = f4_plan(T, (int)gridDim.x);
    if (threadIdx.x == 0) {
        const int c = (int)blockIdx.x; const bool late = c < P.nLate;
        int nj = 0, n1 = 0;
        for (int k = 0; k < 16; ++k) {
            const int gidx = late ? (k + 2) * P.nE + k * P.nLate + c : (k == 0 ? 0 : k * P.nE + (k - 1) * P.nLate) + (c - P.nLate);
            if (gidx >= P.U) break;
            ul[nj++] = f4_unit(P, gidx); if (gidx < P.nEarlyUnits) n1 = nj;
        }
        ul[16] = n1; ul[17] = nj;
    }
    __syncthreads();
    const int n1 = ul[16], nj = ul[17];
    pg8::EpiBf16 E4{(bf16_t*)(a.ws + WS_Y), DM};
#pragma unroll 1
    for (int part = 0; part < 2; ++part) {
        const int j0 = part ? n1 : 0, j1 = part ? nj : n1;
        if (j1 <= j0) continue;
        if (threadIdx.x == 0) { for (int j = j0; j < j1; ++j) { const int tl = ul[j] >> 2; XB_SPIN(xb_ld(&done[tl]) < 4u, bar); } asm volatile("s_waitcnt vmcnt(0)" ::: "memory"); }
        __syncthreads();
        S4.ul = ul + j0; S4.n = j1 - j0;
        pg8::gemm_phase<pg8::EpiBf16, MoeListSched, false>(lds, pg8::Dims{DEXP, DEXP, DEXP}, S4, E4);
        __syncthreads();
    }
}
__device__ __forceinline__ void phase_ln3(const Args& a, int l, float* OUT, bf16_t* OUTB) {
    const int tid = tid_fresh(), lane = tid & 63, wid = tid >> 6;
    const unsigned* cnt = (const unsigned*)(a.ws + WS_CTL) + CW_CNT + l * 32;
    const int2* tokpos = (const int2*)(a.ws + WS_TOKPOS);
    const bf16_t* X2B = (const bf16_t*)(a.ws + WS_X2B); const bf16_t* Y = (const bf16_t*)(a.ws + WS_Y);
    const float* g = a.in[28] + (size_t)(l * 3 + 2) * DM; const float* bta = a.in[29] + (size_t)(l * 3 + 2) * DM;
    int mybase = 0;
    { int acc = 0; for (int x = 0; x < NEXP; ++x) { if (x == lane) mybase = acc; acc += (int)((cnt[x] + 255u) >> 8); } }
    struct TP { int2 p0, p1; float2 tg; };
    struct RowIn { uint2 x[4], y0[4], y1[4]; float2 tg; };
    auto tp_load = [&](int row, TP& t) { t.p0 = tokpos[row * 2]; t.p1 = tokpos[row * 2 + 1]; t.tg = ((const float2*)(a.ws + WS_TOKGATE))[row]; };
    auto row_load = [&](int row, const TP& t, RowIn& r) {
        const size_t h0 = (size_t)__shfl(mybase, t.p0.x) * 256 + t.p0.y, h1 = (size_t)__shfl(mybase, t.p1.x) * 256 + t.p1.y;
        const bf16_t* xr = X2B + (size_t)row * DM; const bf16_t* y0 = Y + h0 * DM; const bf16_t* y1 = Y + h1 * DM;
        r.tg = t.tg;
#pragma unroll
        for (int m = 0; m < 4; ++m) { const int o = m * 256 + lane * 4; r.x[m] = *(const uint2*)(xr + o); r.y0[m] = *(const uint2*)(y0 + o); r.y1[m] = *(const uint2*)(y1 + o); }
    };
    auto row_fin = [&](int row, const RowIn& r) {
        const float2 tg = r.tg;
        float x[16];
#pragma unroll
        for (int m = 0; m < 4; ++m) { const uint2 xb_ = r.x[m]; const float4 xv = make_float4(bflo(xb_.x), bfhi(xb_.x), bflo(xb_.y), bfhi(xb_.y)); const uint2 a0 = r.y0[m], a1 = r.y1[m];
            x[m * 4] = fmaf(ALPHA, xv.x, fmaf(tg.x, bflo(a0.x), tg.y * bflo(a1.x))); x[m * 4 + 1] = fmaf(ALPHA, xv.y, fmaf(tg.x, bfhi(a0.x), tg.y * bfhi(a1.x)));
            x[m * 4 + 2] = fmaf(ALPHA, xv.z, fmaf(tg.x, bflo(a0.y), tg.y * bflo(a1.y))); x[m * 4 + 3] = fmaf(ALPHA, xv.w, fmaf(tg.x, bfhi(a0.y), tg.y * bfhi(a1.y))); }
        float s_ = 0.f;
#pragma unroll
        for (int k = 0; k < 16; ++k) s_ += x[k];
        const float mean = wsum(s_) * (1.0f / 1024.0f);
        float q = 0.f;
#pragma unroll
        for (int k = 0; k < 16; ++k) { const float d = x[k] - mean; q = fmaf(d, d, q); }
        const float rstd = rsqrtf(wsum(q) * (1.0f / 1024.0f) + 1e-5f);
#pragma unroll
        for (int m = 0; m < 4; ++m) { const int o = m * 256 + lane * 4; const float4 gv = *(const float4*)(g + o), bv = *(const float4*)(bta + o); float4 rr;
            rr.x = (x[m * 4] - mean) * rstd * gv.x + bv.x; rr.y = (x[m * 4 + 1] - mean) * rstd * gv.y + bv.y; rr.z = (x[m * 4 + 2] - mean) * rstd * gv.z + bv.z; rr.w = (x[m * 4 + 3] - mean) * rstd * gv.w + bv.w;
            if (OUT) *(float4*)(OUT + (size_t)row * DM + o) = rr;
            if (OUTB) { uint2 ob; ob.x = pk2(rr.x, rr.y); ob.y = pk2(rr.z, rr.w); *(uint2*)(OUTB + (size_t)row * DM + o) = ob; } }
    };
    const int RS = gridDim.x * 8;
    int r = blockIdx.x * 8 + wid;
    TP pA, pB; RowIn iA, iB;
    bool vA = r < NTOK, vB = r + RS < NTOK;
    if (vA) tp_load(r, pA);
    if (vB) tp_load(r + RS, pB);
    if (vA) row_load(r, pA, iA);
    while (vA) {
        if (vB) row_load(r + RS, pB, iB);
        const bool vC = r + 2 * RS < NTOK; if (vC) tp_load(r + 2 * RS, pA);
        row_fin(r, iA);
        if (!vB) break;
        if (vC) row_load(r + 2 * RS, pA, iA);
        const bool vD = r + 3 * RS < NTOK; if (vD) tp_load(r + 3 * RS, pB);
        row_fin(r + RS, iB);
        r += 2 * RS; vA = vC; vB = vD;
    }
}

constexpr int PH_PER_LAYER = 14, N_PHASES = 1 + 2 * PH_PER_LAYER;

__global__ void __launch_bounds__(NTHREADS, 2) mk_fwd(Args a) {
    extern __shared__ __attribute__((aligned(16))) unsigned char smem[];
    float* lds = (float*)smem;
    PG8_LAS unsigned char* lds3 = (PG8_LAS unsigned char*)smem;
    volatile LAS unsigned* xbw = (volatile LAS unsigned*)(smem + LDS_BYTES - 16);
    const int lo = a.ph_lo, hi = a.ph_hi;
    unsigned* ctl = (unsigned*)(a.ws + WS_CTL);
    XcdBarrier bar; bar.bar = ctl + CW_BAR; bar.x = 0; bar.st = xbw;
    if (hi - lo > 1) {
        if (threadIdx.x == 0) { xbw[0] = 0u; xbw[1] = 0u; }
        __syncthreads();
        bar = xcd_barrier_post(ctl + CW_BAR, xbw);
    }
#define IN(k) (lo <= (k) && (k) < hi)
#define SEAM(k) do { if (IN(k) && IN((k) + 1)) xcd_barrier(bar); \
        if (PROBE_T >= 0) { const long long now_ = wall_clock64(); if (PROBE_T == ((k) == 0 ? 99 : ((k) - 1) % PH_PER_LAYER)) { const long long d_ = now_ - t_seam; while (wall_clock64() - now_ < d_) {} t_seam = wall_clock64(); } else t_seam = now_; } } while (0)
    long long t_seam = (PROBE_T >= 0) ? wall_clock64() : 0;
    if (IN(0)) { phase_prologue(a, lds); if (PROBE_REP == 99) { xcd_barrier(bar); phase_prologue(a, lds); } }
    SEAM(0);
#define LAYER_BODY(l) do { \
        const int p0 = 1 + l * PH_PER_LAYER; \
        const float* xin = (l == 0) ? a.in[0] : (const float*)nullptr; const bf16_t* xinb = (l == 0) ? (const bf16_t*)nullptr : (const bf16_t*)(a.ws + WS_XB);     \
        float* xout = (l == 0) ? (float*)nullptr : a.out; \
        if (IN(p0 + 0)) { phase_g1(a, l, lds3); if (PROBE_REP == 0) { xcd_barrier(bar); phase_g1(a, l, lds3); } } \
        SEAM(p0 + 0); \
        if (IN(p0 + 1)) { phase_prep(a, l, lds); if (PROBE_REP == 1) { xcd_barrier(bar); phase_prep(a, l, lds); } } \
        SEAM(p0 + 1); \
        if (IN(p0 + 2)) { phase_prep2(a, lds); if (PROBE_REP == 2) { xcd_barrier(bar); phase_prep2(a, lds, true); } } \
        SEAM(p0 + 2); \
        if (IN(p0 + 3)) { phase_scan2_att(a, l, lds3); if (PROBE_REP == 3) { xcd_barrier(bar); phase_scan2_att(a, l, lds3); } if (PROBE_REP >= 31 && PROBE_REP <= 37) { xcd_barrier(bar); phase_scan2_att(a, l, lds3, PROBE_REP - 30); } if (PROBE_REP == 41 || PROBE_REP == 42) { xcd_barrier(bar); phase_scan2_att(a, l, lds3, 1 + 8 * (PROBE_REP - 40)); } } \
        SEAM(p0 + 3); \
        if (IN(p0 + 4)) { phase_post(a, l); if (PROBE_REP == 4) { xcd_barrier(bar); phase_post(a, l); } } \
        SEAM(p0 + 4); \
        if (IN(p0 + 5)) { phase_dense_res(a.ws + WS_MIX, a.ws + WS_WOUT + (size_t)l * 2 * MiB, xin, xinb, (bf16_t*)(a.ws + WS_PRE), lds3); if (PROBE_REP == 5) { xcd_barrier(bar); phase_dense_res(a.ws + WS_MIX, a.ws + WS_WOUT + (size_t)l * 2 * MiB, xin, xinb, (bf16_t*)(a.ws + WS_PRE), lds3); } } \
        SEAM(p0 + 5); \
        if (IN(p0 + 6)) { phase_ln((const bf16_t*)(a.ws + WS_PRE), a.in[28] + (size_t)(l * 3) * DM, a.in[29] + (size_t)(l * 3) * DM, (float*)nullptr, (bf16_t*)(a.ws + WS_X1B)); if (PROBE_REP == 6) { xcd_barrier(bar); phase_ln((const bf16_t*)(a.ws + WS_PRE), a.in[28] + (size_t)(l * 3) * DM, a.in[29] + (size_t)(l * 3) * DM, (float*)nullptr, (bf16_t*)(a.ws + WS_X1B)); } } \
        SEAM(p0 + 6); \
        if (IN(p0 + 7)) { phase_dense_bf16(a.ws + WS_X1B, NTOK, a.ws + WS_WQ + (size_t)l * 2 * MiB, DM, (bf16_t*)(a.ws + WS_Q), lds3); if (PROBE_REP == 7) { xcd_barrier(bar); phase_dense_bf16(a.ws + WS_X1B, NTOK, a.ws + WS_WQ + (size_t)l * 2 * MiB, DM, (bf16_t*)(a.ws + WS_Q), lds3); } } \
        SEAM(p0 + 7); \
        if (IN(p0 + 8)) { phase_matt_s(a, lds3); if (PROBE_REP == 8) { xcd_barrier(bar); phase_matt_s(a, lds3); } } \
        SEAM(p0 + 8); \
        if (IN(p0 + 9)) { phase_matt_pv(a, lds3); if (PROBE_REP == 9) { xcd_barrier(bar); phase_matt_pv(a, lds3); } } \
        SEAM(p0 + 9); \
        if (IN(p0 + 10)) { phase_dense_res(a.ws + WS_O, a.ws + WS_WO + (size_t)l * 2 * MiB, (const float*)nullptr, (const bf16_t*)(a.ws + WS_X1B), (bf16_t*)(a.ws + WS_PRE2), lds3); if (PROBE_REP == 10) { xcd_barrier(bar); phase_dense_res(a.ws + WS_O, a.ws + WS_WO + (size_t)l * 2 * MiB, (const float*)nullptr, (const bf16_t*)(a.ws + WS_X1B), (bf16_t*)(a.ws + WS_PRE2), lds3); } } \
        SEAM(p0 + 10); \
        if (IN(p0 + 11)) { phase_ln2_router(a, l, lds); if (PROBE_REP == 11) { xcd_barrier(bar); phase_ln2_router(a, l, lds, true); } } \
        SEAM(p0 + 11); \
        if (IN(p0 + 12)) { phase_f34(a, l, lds3); } \
        SEAM(p0 + 12); \
        if (IN(p0 + 13)) { { phase_ln3(a, l, xout, (l == 0) ? (bf16_t*)(a.ws + WS_XB) : (bf16_t*)nullptr); } if (PROBE_REP == 13) { xcd_barrier(bar); { phase_ln3(a, l, xout, (l == 0) ? (bf16_t*)(a.ws + WS_XB) : (bf16_t*)nullptr); } } } \
        SEAM(p0 + 13); \
    } while (0)
    LAYER_BODY(0);
    LAYER_BODY(1);
}
}

extern "C" void kernel_launch(void* const* d_in, const int* in_sizes, int n_in, void* d_out, int out_size, void* d_ws, size_t ws_size, hipStream_t stream) {
    static int grid = 0;
    if (!grid) {
        int dev = 0, cus = 0, per_cu = 0;
        (void)hipGetDevice(&dev);
        (void)hipDeviceGetAttribute(&cus, hipDeviceAttributeMultiprocessorCount, dev);
        (void)hipFuncSetAttribute((const void*)mk_fwd, hipFuncAttributeMaxDynamicSharedMemorySize, LDS_BYTES);
        (void)hipOccupancyMaxActiveBlocksPerMultiprocessor(&per_cu, mk_fwd, NTHREADS, LDS_BYTES);
        (void)hipGetLastError();
        grid = cus * 1;
        if (grid != 256) grid = 256;
    }
    if (ws_size < WS_END) return;
    (void)hipMemsetAsync(d_ws, 0, CTL_ZERO_BYTES, stream);
    Args a;
    memset(&a, 0, sizeof(a));
    for (int i = 0; i < 30; ++i) a.in[i] = (const float*)d_in[i];
    a.out = (float*)d_out; a.ws = (unsigned char*)d_ws;
#if MK_ONE_LAUNCH
    a.ph_lo = 0; a.ph_hi = N_PHASES;
    hipLaunchKernelGGL(mk_fwd, dim3(grid), dim3(NTHREADS), LDS_BYTES, stream, a);
#else
    for (int p = 0; p < N_PHASES; ++p) {
        a.ph_lo = p; a.ph_hi = p + 1;
        hipLaunchKernelGGL(mk_fwd, dim3(grid), dim3(NTHREADS), LDS_BYTES, stream, a);
    }
#endif
}
```

```cpp
#include <hip/hip_runtime.h>
#include <stdint.h>
#include <cstring>

#ifndef PROBE_REP
#define PROBE_REP -1
#endif
#ifndef PROBE_T
#define PROBE_T -1
#endif
#ifndef MK_ONE_LAUNCH
#define MK_ONE_LAUNCH 1
#endif

namespace {
constexpr int NTHREADS = 512;
constexpr int NTOK = 16384, SEQ = 2048, NBATCH = 8, DM = 1024;
constexpr int MEMLEN = 256;
constexpr int NH = 8, HD = 64;
constexpr int IN_COLS = 3328, ZLD = 3584;
constexpr int C_Q = 0, C_K = 512, C_V = 1024, C_R = 1536, C_KR = 2048, C_VR = 2560, C_ZW = 3072, C_ZA = 3136, C_ZG = 3200, C_ZV = 3328;
constexpr int NEXP = 32, DEXP = 512;
constexpr int LCAP = 16384;
constexpr float ALPHA = 1.4142135623730951f;
constexpr float NEG_INF = -1e30f;
constexpr int LDS_BYTES = 147456;

typedef unsigned short bf16_t;
typedef float f32x2_t __attribute__((ext_vector_type(2)));
typedef __bf16 bf16x2_t __attribute__((ext_vector_type(2)));
__device__ __forceinline__ unsigned pk2(float lo, float hi) { f32x2_t v = {lo, hi}; bf16x2_t b = __builtin_convertvector(v, bf16x2_t); return __builtin_bit_cast(unsigned, b); }
__device__ __forceinline__ bf16_t f2bf(float f) { return (bf16_t)(pk2(f, 0.f) & 0xffffu); }
__device__ __forceinline__ float bf2f(bf16_t h) { return __uint_as_float((unsigned)h << 16); }
__device__ __forceinline__ float bflo(unsigned u) { return __uint_as_float(u << 16); }
__device__ __forceinline__ float bfhi(unsigned u) { return __uint_as_float(u & 0xffff0000u); }

constexpr size_t MiB = 1u << 20;
constexpr size_t WS_CTL = 0, CTL_ZERO_BYTES = 64 * 1024;
constexpr size_t WS_LIST = 2 * MiB;
constexpr size_t WS_KB = 6 * MiB;
constexpr size_t WS_TOKPOS = 10 * MiB;
constexpr size_t WS_TOKGATE = 10 * MiB + 512 * 1024;
constexpr size_t WS_KMEAN = 11 * MiB;
constexpr size_t WS_MEMB = 12 * MiB;
constexpr size_t WS_VT = 16 * MiB;
constexpr size_t WS_WIN0 = 24 * MiB, WS_WIN1 = 31 * MiB;
constexpr size_t WS_WOUT = 38 * MiB, WS_WQ = 42 * MiB, WS_WKV = 46 * MiB, WS_WO = 54 * MiB;
constexpr size_t WS_WEXP = 58 * MiB;
constexpr size_t WS_XL1 = 154 * MiB, WS_XB = 218 * MiB, WS_VFIRST = 250 * MiB;
constexpr size_t WS_Z = 266 * MiB, WS_MIX = 378 * MiB, WS_R3 = 410 * MiB, WS_END = 508 * MiB;
constexpr int REC_TG = 644;
constexpr size_t WS_REC = 410 * MiB;
constexpr size_t WS_YRAW = 492 * MiB;
constexpr size_t WS_RVT = 154 * MiB, WS_RG = 170 * MiB;
constexpr size_t WS_BON = 20 * MiB;
constexpr size_t WS_LORA = 22 * MiB;
constexpr size_t LORA_L = 512 * 288 * 2, LORA_I = 512 * 64 * 2, LORA_G = 2 * 512 * 64 * 2, LORA_V = LORA_G + 512 * 128 * 2;
constexpr size_t WS_LSUM = 21 * MiB;
constexpr size_t WS_P = 298 * MiB;
constexpr size_t WS_PRE = 266 * MiB, WS_X1 = 410 * MiB, WS_X1B = 474 * MiB;
constexpr size_t WS_Q = 330 * MiB, WS_KV = 362 * MiB, WS_O = 266 * MiB, WS_PRE2 = 330 * MiB;
constexpr size_t WS_X2 = 410 * MiB, WS_X2B = 474 * MiB;
constexpr size_t WS_H = 266 * MiB, WS_Y = 306 * MiB;

constexpr int CW_CNT = 0;
constexpr int CW_BAR = 1024;
constexpr int CW_TILE = 5120;
constexpr int CW_F4CTR = 5632;

#define XB_TMO      128
#define XB_XCNT(j)  (256  + 64 * (j))
#define XB_XSUB(j)  (1280 + 64 * (j))
#define XB_XGEN(j)  (2304 + 64 * (j))
#define XB_TOP      3328
#define XB_TOPGEN   3392
#define XCD_BAR_WORDS 3456
#define XB_SPIN_CAP (1u << 18)
#define LAS __attribute__((address_space(3)))
__device__ __forceinline__ unsigned xb_ld(unsigned* p)              { return __hip_atomic_load(p, __ATOMIC_RELAXED, __HIP_MEMORY_SCOPE_AGENT); }
__device__ __forceinline__ unsigned xb_add(unsigned* p, unsigned v) { return __hip_atomic_fetch_add(p, v, __ATOMIC_RELAXED, __HIP_MEMORY_SCOPE_AGENT); }
__device__ __forceinline__ unsigned xb_xcc_id() { return (unsigned)__builtin_amdgcn_s_getreg((3 << 11) | 20) & 0xFu; }
#define XB_SPIN(cond, bar) do { unsigned _sp = 0; while (cond) { __builtin_amdgcn_s_sleep(1); \
    if ((++_sp & 255u) == 0u) { if (xb_ld(&(bar)[XB_TMO])) break; if (_sp > XB_SPIN_CAP) { atomicAdd(&(bar)[XB_TMO], 1u); break; } } } } while (0)
struct XcdBarrier { unsigned* bar; unsigned x; volatile LAS unsigned* st; };
__device__ __forceinline__ XcdBarrier xcd_barrier_post(unsigned* bar, volatile LAS unsigned* st) {
    XcdBarrier b; b.bar = bar; b.x = xb_xcc_id(); b.st = st;
    if (threadIdx.x == 0) (void)xb_add(&bar[XB_XCNT(b.x)], 1u);
    return b;
}
__device__ __forceinline__ void xcd_barrier_complete(unsigned* bar, unsigned x, unsigned& nloc, unsigned& nx) {
    const unsigned G = gridDim.x * gridDim.y * gridDim.z;
    unsigned sum, cnt, mine, sp = 0u;
    for (;;) {
        sum = 0u; cnt = 0u; mine = 0u;
#pragma unroll
        for (unsigned j = 0; j < 16; ++j) { const unsigned c = xb_ld(&bar[XB_XCNT(j)]); sum += c; cnt += (c > 0u) ? 1u : 0u; mine = (j == x) ? c : mine; }
        if (sum == G) break;
        __builtin_amdgcn_s_sleep(1);
        if ((++sp & 255u) == 0u) { if (xb_ld(&bar[XB_TMO])) break; if (sp > XB_SPIN_CAP) { atomicAdd(&bar[XB_TMO], 1u); break; } }
    }
    nloc = mine > 0u ? mine : 1u; nx = cnt > 0u ? cnt : 1u;
}
__device__ __forceinline__ void xcd_barrier(const XcdBarrier& b) {
    asm volatile("s_waitcnt vmcnt(0)" ::: "memory");
    __syncthreads();
    if (threadIdx.x == 0) {
        unsigned* bar = b.bar;
        __builtin_amdgcn_s_waitcnt(0);
        unsigned nloc = b.st[0], nx = b.st[1];
        if (nloc == 0u) { xcd_barrier_complete(bar, b.x, nloc, nx); b.st[0] = nloc; b.st[1] = nx; }
        const unsigned old = xb_add(&bar[XB_XSUB(b.x)], 1u);
        const unsigned gen = old / nloc;
        if (old + 1u == (gen + 1u) * nloc) {
            __builtin_amdgcn_fence(__ATOMIC_RELEASE, "agent");
            asm volatile("s_waitcnt vmcnt(0)" ::: "memory");
            const unsigned og = xb_add(&bar[XB_TOP], 1u);
            const unsigned tg = og / nx;
            if (og + 1u == (tg + 1u) * nx) xb_add(&bar[XB_TOPGEN], 1u);
            else XB_SPIN(xb_ld(&bar[XB_TOPGEN]) == tg, bar);
            __builtin_amdgcn_fence(__ATOMIC_ACQUIRE, "agent");
            xb_add(&bar[XB_XGEN(b.x)], 1u);
            asm volatile("s_waitcnt vmcnt(0)" ::: "memory");
        } else {
            XB_SPIN(xb_ld(&bar[XB_XGEN(b.x)]) == gen, bar);
            __builtin_amdgcn_fence(__ATOMIC_ACQUIRE, "agent");
            asm volatile("s_waitcnt vmcnt(0)" ::: "memory");
        }
    }
    __syncthreads();
}

__device__ __forceinline__ int tid_fresh() { int t = threadIdx.x; asm volatile("" : "+v"(t)); return t; }
template <int CTRL> __device__ __forceinline__ float dppf(float v) { return __int_as_float(__builtin_amdgcn_mov_dpp(__float_as_int(v), CTRL, 0xF, 0xF, true)); }
__device__ __forceinline__ float wsum(float v) {
    v += dppf<0xB1>(v); v += dppf<0x4E>(v); v += dppf<0x141>(v); v += dppf<0x140>(v);
    auto r16 = __builtin_amdgcn_permlane16_swap(__float_as_uint(v), __float_as_uint(v), false, false); v = __uint_as_float(r16[0]) + __uint_as_float(r16[1]);
    auto r32 = __builtin_amdgcn_permlane32_swap(__float_as_uint(v), __float_as_uint(v), false, false); v = __uint_as_float(r32[0]) + __uint_as_float(r32[1]);
    return v;
}
__device__ __forceinline__ float wmax(float v) {
#pragma unroll
    for (int o = 32; o > 0; o >>= 1) v = fmaxf(v, __shfl_xor(v, o));
    return v;
}
__device__ __forceinline__ float sigmoidf_(float x) { return 1.0f / (1.0f + __expf(-x)); }
__device__ __forceinline__ float sigmoid_fast(float x) { return __builtin_amdgcn_rcpf(1.0f + __expf(-x)); }
__device__ __forceinline__ float softplusf_(float x) { return x > 20.f ? x : log1pf(__expf(x)); }

struct Args {
    const float* in[30];
    float* out;
    unsigned char* ws;
    int ph_lo, ph_hi;
};

namespace pg8 {
#define PG8_LAS __attribute__((address_space(3)))
typedef short bf16x8 __attribute__((ext_vector_type(8)));
typedef float f32x4 __attribute__((ext_vector_type(4)));
typedef unsigned u32x4 __attribute__((ext_vector_type(4)));
constexpr int BM = 256, BK = 64, HALF = 128, HTB = HALF * BK * 2, STAGE_BYTES = 8 * HTB, NXCD = 8, WGM = 8;

__host__ __device__ __forceinline__ int lds_byte(int r, int c) { const int st = (r >> 4) * 2 + (c >> 5), rr = r & 15, cc = c & 31, ob = rr * 64 + cc * 2; return st * 1024 + (ob ^ (((ob >> 9) & 1) << 5)); }
__host__ __device__ __forceinline__ void stage_rc(int b, int& R, int& C) { const int st = b / 1024, sb = b % 1024, swz = sb ^ (((sb >> 9) & 1) << 5); R = (st >> 1) * 16 + swz / 64; C = (st & 1) * 32 + (swz % 64) / 2; }
__host__ __device__ __forceinline__ int perm32(int rho) { const int n = rho >> 4, i = rho & 15; return 8 * (i >> 2) + 4 * n + (i & 3); }

struct Unit { const char* A; const char* B; int row0, col0, aux, aux2; };
struct Dims { int lda, ldb, K; };

struct TileOrder {
    int nM, nN, nwg, G, c;
    __device__ void init(int nM_, int nN_, int G_, int c_) { nM = nM_; nN = nN_; nwg = nM * nN; G = G_; c = c_; }
    __device__ bool tile(int i, int& pm, int& pn) const {
        const long L = (long)i * G + c; if (L >= nwg) return false;
        int wgid = (int)L; { const int q = nwg / NXCD, r = nwg % NXCD, xcd = wgid % NXCD, off = wgid / NXCD; wgid = (xcd < r ? xcd * (q + 1) : r * (q + 1) + (xcd - r) * q) + off; }
        const int nig = WGM * nN, gid = wgid / nig, fm = gid * WGM, gsz = (nM - fm) < WGM ? (nM - fm) : WGM;
        pm = fm + ((wgid % nig) % gsz); pn = (wgid % nig) / gsz; return true;
    }
};
struct DenseSched {
    TileOrder o; const char* A; const char* B; int lda, ldb;
    __device__ void init(const void* A_, int lda_, int M, const void* B_, int ldb_, int N) { A = (const char*)A_; B = (const char*)B_; lda = lda_; ldb = ldb_; o.init(M / BM, N / BM, gridDim.x, blockIdx.x); }
    __device__ __forceinline__ bool next(int i, Unit& u) const { int pm, pn; if (!o.tile(i, pm, pn)) return false;
        u.A = A + (size_t)pm * BM * lda * 2; u.B = B + (size_t)pn * BM * ldb * 2; u.row0 = pm * BM; u.col0 = pn * BM; u.aux = 0; u.aux2 = 0; return true; }
    __device__ __forceinline__ int arow(const Unit&, int r) const { return r; }
};

struct GroupSched {
    int G, c; const char* A; const char* B; int lda, ldb;
    __device__ void init(const void* A_, int lda_, const void* B_, int ldb_) { G = gridDim.x; c = blockIdx.x; A = (const char*)A_; B = (const char*)B_; lda = lda_; ldb = ldb_; }
    __device__ __forceinline__ bool next(int i, Unit& u) const {
        const long L = (long)i * G + c; if (L >= 256) return false;
        const int pm = (int)L >> 2, pn = (int)L & 3;
        u.A = A + (size_t)pm * BM * lda * 2; u.B = B + (size_t)pn * BM * ldb * 2; u.row0 = pm * BM; u.col0 = pn * BM; u.aux = 0; u.aux2 = 0; return true; }
    __device__ __forceinline__ int arow(const Unit&, int r) const { return r; }
};

__device__ __forceinline__ unsigned cvt_pk_bf16(float lo, float hi) { unsigned r; asm volatile("v_cvt_pk_bf16_f32 %0, %1, %2" : "=v"(r) : "v"(lo), "v"(hi)); return r; }

struct EpiBf16 {
    static constexpr bool PERM = true;
    bf16_t* O; int ldc;
    __device__ __forceinline__ void operator()(const f32x4 (&acc)[2][2][4][2], const Unit& u, int wr, int wc, int fr, int fq) const {
        const int row0 = u.row0 + wr * 64 + fr, col0 = u.col0 + wc * 32 + 8 * fq;
#pragma unroll
        for (int ai = 0; ai < 2; ++ai)
#pragma unroll
            for (int m = 0; m < 4; ++m) { bf16_t* rowp = O + (size_t)(row0 + ai * HALF + m * 16) * ldc + col0;
#pragma unroll
                for (int bj = 0; bj < 2; ++bj) { const f32x4 v0 = acc[ai][bj][m][0], v1 = acc[ai][bj][m][1];
                    u32x4 w; w.x = cvt_pk_bf16(v0[0], v0[1]); w.y = cvt_pk_bf16(v0[2], v0[3]); w.z = cvt_pk_bf16(v1[0], v1[1]); w.w = cvt_pk_bf16(v1[2], v1[3]);
                    *(u32x4*)(rowp + bj * HALF) = w; } }
    }
};
struct EpiF32Res {
    static constexpr bool PERM = false;
    float* C; const float* RES; int ldc; float rs; const bf16_t* RESB;
    __device__ __forceinline__ void operator()(const f32x4 (&acc)[2][2][4][2], const Unit& u, int wr, int wc, int fr, int fq) const {
        const int row0 = u.row0 + wr * 64 + fr, col0 = u.col0 + wc * 32 + 4 * fq;
#pragma unroll
        for (int ai = 0; ai < 2; ++ai)
#pragma unroll
            for (int m = 0; m < 4; ++m) { const size_t ro = (size_t)(row0 + ai * HALF + m * 16) * ldc + col0;
#pragma unroll
                for (int bj = 0; bj < 2; ++bj)
#pragma unroll
                    for (int n = 0; n < 2; ++n) { f32x4 r;
                        if (RESB) { const uint2 rb = *(const uint2*)(RESB + ro + bj * HALF + n * 16); r = (f32x4){bflo(rb.x), bfhi(rb.x), bflo(rb.y), bfhi(rb.y)}; }
                        else r = *(const f32x4*)(RES + ro + bj * HALF + n * 16);
                        *(f32x4*)(C + ro + bj * HALF + n * 16) = acc[ai][bj][m][n] + r * rs; } }
    }
};

struct EpiBf16Res {
    static constexpr bool PERM = true;
    bf16_t* O; const float* RES; int ldc; float rs; const bf16_t* RESB;
    __device__ __forceinline__ void operator()(const f32x4 (&acc)[2][2][4][2], const Unit& u, int wr, int wc, int fr, int fq) const {
        const int row0 = u.row0 + wr * 64 + fr, col0 = u.col0 + wc * 32 + 8 * fq;
#pragma unroll
        for (int ai = 0; ai < 2; ++ai)
#pragma unroll
            for (int m = 0; m < 4; ++m) { const size_t ro = (size_t)(row0 + ai * HALF + m * 16) * ldc + col0;
#pragma unroll
                for (int bj = 0; bj < 2; ++bj) { f32x4 r0, r1;
                    if (RESB) { const uint4 rb = *(const uint4*)(RESB + ro + bj * HALF); r0 = (f32x4){bflo(rb.x), bfhi(rb.x), bflo(rb.y), bfhi(rb.y)}; r1 = (f32x4){bflo(rb.z), bfhi(rb.z), bflo(rb.w), bfhi(rb.w)}; }
                    else { r0 = *(const f32x4*)(RES + ro + bj * HALF); r1 = *(const f32x4*)(RES + ro + bj * HALF + 4); }
                    const f32x4 v0 = acc[ai][bj][m][0] + r0 * rs, v1 = acc[ai][bj][m][1] + r1 * rs;
                    u32x4 w; w.x = cvt_pk_bf16(v0[0], v0[1]); w.y = cvt_pk_bf16(v0[2], v0[3]); w.z = cvt_pk_bf16(v1[0], v1[1]); w.w = cvt_pk_bf16(v1[2], v1[3]);
                    *(u32x4*)(O + ro + bj * HALF) = w; } }
    }
};

__device__ __forceinline__ void store_bf16_tile(const f32x4 (&acc)[2][2][4][2], bf16_t* O, int ldc, int row0, int col0) {
#pragma unroll
    for (int ai = 0; ai < 2; ++ai)
#pragma unroll
        for (int m = 0; m < 4; ++m) { bf16_t* rowp = O + (size_t)(row0 + ai * HALF + m * 16) * ldc + col0;
#pragma unroll
            for (int bj = 0; bj < 2; ++bj) { const f32x4 v0 = acc[ai][bj][m][0], v1 = acc[ai][bj][m][1];
                u32x4 w; w.x = cvt_pk_bf16(v0[0], v0[1]); w.y = cvt_pk_bf16(v0[2], v0[3]); w.z = cvt_pk_bf16(v1[0], v1[1]); w.w = cvt_pk_bf16(v1[2], v1[3]);
                *(u32x4*)(rowp + bj * HALF) = w; } }
}
struct EpiG1 {
    static constexpr bool PERM = true;
    bf16_t* Z; bf16_t* KB; bf16_t* VT;
    __device__ __forceinline__ void operator()(const f32x4 (&acc)[2][2][4][2], const Unit& u, int wr, int wc, int fr, int fq) const {
        bf16_t* O = Z; int ldc = ZLD;
        if (u.aux == 1) { O = KB; ldc = 1024; } else if (u.aux >= 2) { O = VT + (size_t)(u.aux - 2) * 1024 * 256; ldc = 256; }
        store_bf16_tile(acc, O, ldc, u.row0 + wr * 64 + fr, u.col0 + wc * 32 + 8 * fq);
    }
};
struct EpiSoftmax {
    static constexpr bool PERM = true;
    bf16_t* P; float* LSUM; PG8_LAS float* xmax;
    __device__ __forceinline__ void operator()(const f32x4 (&acc)[2][2][4][2], const Unit& u, int wr, int wc, int fr, int fq) const {
        const float c = 0.0625f * 1.4426950408889634f;
#pragma unroll
        for (int ai = 0; ai < 2; ++ai)
#pragma unroll
            for (int m = 0; m < 4; ++m) {
                float mx = acc[ai][0][m][0][0];
#pragma unroll
                for (int bj = 0; bj < 2; ++bj)
#pragma unroll
                    for (int n = 0; n < 2; ++n)
#pragma unroll
                        for (int j = 0; j < 4; ++j) mx = fmaxf(mx, acc[ai][bj][m][n][j]);
                mx = fmaxf(mx, __shfl_xor(mx, 16)); mx = fmaxf(mx, __shfl_xor(mx, 32));
                if (fq == 0) xmax[wc * 256 + wr * 64 + fr + ai * 128 + m * 16] = mx;
            }
        asm volatile("s_waitcnt lgkmcnt(0)" ::: "memory"); __builtin_amdgcn_s_barrier(); asm volatile("" ::: "memory");
        const int hm = u.col0 >> 8;
#pragma unroll
        for (int ai = 0; ai < 2; ++ai)
#pragma unroll
            for (int m = 0; m < 4; ++m) {
                int r = wr * 64 + fr + ai * 128 + m * 16; asm volatile("" : "+v"(r) :: "memory");
                const float M = fmaxf(fmaxf(xmax[r], xmax[256 + r]), fmaxf(xmax[512 + r], xmax[768 + r]));
                float sum = 0.f; bf16_t* rowp = P + (size_t)(u.row0 + r) * 1024 + u.col0 + wc * 32 + 8 * fq;
#pragma unroll
                for (int bj = 0; bj < 2; ++bj) {
                    float e[8];
#pragma unroll
                    for (int n = 0; n < 2; ++n)
#pragma unroll
                        for (int j = 0; j < 4; ++j) { e[n * 4 + j] = __builtin_amdgcn_exp2f((acc[ai][bj][m][n][j] - M) * c); sum += e[n * 4 + j]; }
                    u32x4 w; w.x = pk2(e[0], e[1]); w.y = pk2(e[2], e[3]); w.z = pk2(e[4], e[5]); w.w = pk2(e[6], e[7]);
                    *(u32x4*)(rowp + bj * HALF) = w;
                }
                sum += __shfl_xor(sum, 16); sum += __shfl_xor(sum, 32);
                if (fq == 0) LSUM[((size_t)(u.row0 + r) * 4 + hm) * 4 + wc] = sum;
            }
        asm volatile("s_waitcnt lgkmcnt(0)" ::: "memory"); __builtin_amdgcn_s_barrier(); asm volatile("" ::: "memory");
    }
};
struct EpiPV {
    static constexpr bool PERM = true;
    bf16_t* O; const float* LSUM;
    __device__ __forceinline__ void operator()(const f32x4 (&acc)[2][2][4][2], const Unit& u, int wr, int wc, int fr, int fq) const {
        const int hm = u.col0 >> 8;
#pragma unroll
        for (int ai = 0; ai < 2; ++ai)
#pragma unroll
            for (int m = 0; m < 4; ++m) {
                int row = u.row0 + wr * 64 + fr + ai * 128 + m * 16; asm volatile("" : "+v"(row) :: "memory");
                const f32x4 ls = *(const f32x4*)(LSUM + ((size_t)row * 4 + hm) * 4);
                const float inv = 1.0f / ((ls[0] + ls[1]) + (ls[2] + ls[3]));
                bf16_t* rowp = O + (size_t)row * 1024 + u.col0 + wc * 32 + 8 * fq;
#pragma unroll
                for (int bj = 0; bj < 2; ++bj) { const f32x4 v0 = acc[ai][bj][m][0] * inv, v1 = acc[ai][bj][m][1] * inv;
                    u32x4 w; w.x = cvt_pk_bf16(v0[0], v0[1]); w.y = cvt_pk_bf16(v0[2], v0[3]); w.z = cvt_pk_bf16(v1[0], v1[1]); w.w = cvt_pk_bf16(v1[2], v1[3]);
                    *(u32x4*)(rowp + bj * HALF) = w; }
            }
    }
};
struct G1Sched {
    TileOrder o; const char *XB, *WIN, *MEMB, *WKV;
    __device__ void init(const void* XB_, const void* WIN_, int nN, const void* MEMB_, const void* WKV_) { XB = (const char*)XB_; WIN = (const char*)WIN_; MEMB = (const char*)MEMB_; WKV = (const char*)WKV_; o.init(64, nN, gridDim.x, blockIdx.x); }
    __device__ __forceinline__ bool next(int i, Unit& u) const {
        int pm, pn; u.aux2 = 0;
        if (o.tile(i, pm, pn)) { u.A = XB + (size_t)pm * BM * 2048; u.B = WIN + (size_t)pn * BM * 2048; u.row0 = pm * BM; u.col0 = pn * BM; u.aux = 0; return true; }
        const long L = (long)i * o.G + o.c - o.nwg;
        if (L >= 64) return false;
        if (L < 32) { pm = (int)L >> 2; pn = (int)L & 3; u.A = MEMB + (size_t)pm * BM * 2048; u.B = WKV + (size_t)pn * BM * 2048; u.row0 = pm * BM; u.col0 = pn * BM; u.aux = 1; return true; }
        const int b = ((int)L - 32) >> 2; pm = ((int)L - 32) & 3;
        u.A = WKV + (size_t)(1024 + pm * BM) * 2048; u.B = MEMB + (size_t)b * BM * 2048; u.row0 = pm * BM; u.col0 = 0; u.aux = 2 + b; return true;
    }
    __device__ __forceinline__ int arow(const Unit&, int r) const { return r; }
};
struct MattSched {
    int G, c; const char* A; const char* B; size_t b_batch; int b_head;
    __device__ void init(const void* A_, const void* B_, size_t b_batch_, int b_head_) { G = gridDim.x; c = blockIdx.x; A = (const char*)A_; B = (const char*)B_; b_batch = b_batch_; b_head = b_head_; }
    __device__ __forceinline__ bool next(int i, Unit& u) const {
        const long L = (long)i * G + c; if (L >= 256) return false;
        const int pm = (int)L >> 2, hm = (int)L & 3;
        u.A = A + ((size_t)pm * BM * 1024 + hm * 256) * 2; u.B = B + (size_t)(pm >> 3) * b_batch + (size_t)hm * b_head;
        u.row0 = pm * BM; u.col0 = hm * 256; u.aux = 0; u.aux2 = 0; return true;
    }
    __device__ __forceinline__ int arow(const Unit&, int r) const { return r; }
};

template <class Epi, class Sched, bool GATHER, int ACP = 0>
__device__ __forceinline__ void gemm_phase(PG8_LAS unsigned char* lds, const Dims g, const Sched& S, const Epi& E) {
    const int tid = tid_fresh(), wid = __builtin_amdgcn_readfirstlane(tid >> 6), wr = wid >> 2, wc = wid & 3;
    const int K = g.K, nt = K / BK;
    unsigned voffB[2];
#pragma unroll
    for (int i = 0; i < 2; ++i) { int R, C; stage_rc(tid * 16 + i * 8192, R, C); const int Rb = Epi::PERM ? ((R & ~31) + perm32(R & 31)) : R;
        voffB[i] = (unsigned)(Rb * g.ldb + C) * 2u; }
    const size_t kstep = (size_t)(BK * 2);
    const size_t hstepB = (size_t)HALF * g.ldb * 2;
    const unsigned ldsw = (unsigned)wid * 1024u;
    const int aoff = lds_byte(wr * 64 + (tid & 15), ((tid & 63) >> 4) * 8), boff = lds_byte(wc * 32 + (tid & 15), ((tid & 63) >> 4) * 8);
    const size_t hstepA = GATHER ? 0 : (size_t)HALF * g.lda * 2;
#define PG8_SA(b, h) (((b) * 2 + (h)) * HTB)
#define PG8_SB(b, h) ((4 + (b) * 2 + (h)) * HTB)
#define PG8_STAGE_X(bufoff, gbase, v0, v1, aux) do { \
        __builtin_amdgcn_global_load_lds((const unsigned*)((const char*)(gbase) + (v0)), (PG8_LAS unsigned*)(lds + (bufoff) + ldsw), 16, 0, aux); \
        __builtin_amdgcn_global_load_lds((const unsigned*)((const char*)(gbase) + (v1)), (PG8_LAS unsigned*)(lds + (bufoff) + ldsw + 8192), 16, 0, aux); } while (0)
#define PG8_STAGE(bufoff, gbase, v0, v1) PG8_STAGE_X(bufoff, gbase, v0, v1, ACP)
#define PG8_STAGEB(bufoff, gbase) PG8_STAGE_X(bufoff, gbase, voffB[0], voffB[1], 0)
#define PG8_LDA(dst, b, h) do { _Pragma("unroll") for (int m = 0; m < 4; ++m) _Pragma("unroll") for (int k = 0; k < 2; ++k) dst[m][k] = *(const PG8_LAS bf16x8*)(lds + PG8_SA(b, h) + aoff + m * 2048 + k * 1024); } while (0)
#define PG8_LDB(dst, b, h) do { _Pragma("unroll") for (int n = 0; n < 2; ++n) _Pragma("unroll") for (int k = 0; k < 2; ++k) dst[n][k] = *(const PG8_LAS bf16x8*)(lds + PG8_SB(b, h) + boff + n * 2048 + k * 1024); } while (0)
#define PG8_MMA(ai, bj, At, Bt) do { __builtin_amdgcn_s_setprio(1); _Pragma("unroll") for (int m = 0; m < 4; ++m) _Pragma("unroll") for (int n = 0; n < 2; ++n) _Pragma("unroll") for (int k = 0; k < 2; ++k) \
        acc[ai][bj][m][n] = __builtin_amdgcn_mfma_f32_16x16x32_bf16(Bt[n][k], At[m][k], acc[ai][bj][m][n], 0, 0, 0); __builtin_amdgcn_s_setprio(0); } while (0)
#define PG8_WAIT_V(n) asm volatile("s_waitcnt vmcnt(" #n ")" ::: "memory")
#define PG8_WAIT_L(n) asm volatile("s_waitcnt lgkmcnt(" #n ")" ::: "memory")
#define PG8_BAR __builtin_amdgcn_s_barrier()
#define PG8_SCHED __builtin_amdgcn_sched_barrier(0)
#define PG8_VOFFA(dst, u) do { _Pragma("unroll") for (int i_ = 0; i_ < 2; ++i_) { int R_, C_; stage_rc(tid * 16 + i_ * 8192, R_, C_); _Pragma("unroll") for (int h_ = 0; h_ < 2; ++h_) { \
        const int rr_ = GATHER ? S.arow(u, R_ + h_ * HALF) : R_; dst[h_ * 2 + i_] = (unsigned)(rr_ * g.lda + C_) * 2u; } } } while (0)
    Unit cur, nxt; int ui = 0;
    if (!S.next(0, cur)) return;
    f32x4 acc[2][2][4][2];
#pragma unroll
    for (int a = 0; a < 2; ++a)
#pragma unroll
        for (int b = 0; b < 2; ++b)
#pragma unroll
            for (int m = 0; m < 4; ++m)
#pragma unroll
                for (int n = 0; n < 2; ++n) acc[a][b][m][n] = (f32x4){0.f, 0.f, 0.f, 0.f};
    bf16x8 At[4][2], B0[2][2], B1[2][2];
    unsigned vC[4];
    PG8_VOFFA(vC, cur);
    PG8_LAS u32x4* myN = (PG8_LAS u32x4*)(lds + STAGE_BYTES + tid * 16);
    const char* cA = cur.A; const char* cB = cur.B;
    PG8_STAGEB(PG8_SB(0, 0), cB); PG8_STAGEB(PG8_SB(0, 1), cB + hstepB); PG8_STAGE(PG8_SA(0, 0), cA, vC[0], vC[1]); PG8_STAGE(PG8_SA(0, 1), cA + hstepA, vC[2], vC[3]);
    if (wr == 1) PG8_BAR;
    PG8_WAIT_V(2); PG8_BAR;
    PG8_STAGEB(PG8_SB(1, 0), cB + kstep); PG8_STAGE(PG8_SA(1, 0), cA + kstep, vC[0], vC[1]); PG8_STAGEB(PG8_SB(1, 1), cB + hstepB + kstep);
    PG8_WAIT_V(6); PG8_BAR;
    for (;;) {
        const bool has_next = S.next(ui + 1, nxt);
        const char* nA = cA; const char* nB = cB;
        { unsigned vT[4];
#pragma unroll
          for (int q = 0; q < 4; ++q) vT[q] = vC[q];
          if (has_next) { nA = nxt.A; nB = nxt.B; PG8_VOFFA(vT, nxt); }
          *myN = (u32x4){vT[0], vT[1], vT[2], vT[3]}; }
#pragma unroll 1
        for (int t = 0; t < nt; t += 2) {
            const bool last = (t == nt - 2);
            const char* a1 = cA + (size_t)(t + 1) * kstep;
            const char* a2 = last ? nA : cA + (size_t)(t + 2) * kstep; const char* b2 = last ? nB : cB + (size_t)(t + 2) * kstep;
            const char* a3 = a2 + kstep; const char* b3 = b2 + kstep;
            PG8_LDB(B0, 0, 0); PG8_LDB(B1, 0, 1); PG8_SCHED; PG8_LDA(At, 0, 0); PG8_STAGE(PG8_SA(1, 1), a1 + hstepA, vC[2], vC[3]);
            if (last) { const u32x4 vn = *myN; vC[0] = vn.x; vC[1] = vn.y; vC[2] = vn.z; vC[3] = vn.w; }
            PG8_WAIT_V(8); PG8_WAIT_L(0); PG8_BAR; PG8_MMA(0, 0, At, B0); PG8_MMA(0, 1, At, B1); PG8_BAR; PG8_SCHED;
            PG8_LDA(At, 0, 1); PG8_STAGEB(PG8_SB(0, 0), b2); PG8_STAGEB(PG8_SB(0, 1), b2 + hstepB); PG8_STAGE(PG8_SA(0, 0), a2, vC[0], vC[1]);
            PG8_WAIT_V(8); PG8_WAIT_L(0); PG8_BAR; PG8_MMA(1, 0, At, B0); PG8_MMA(1, 1, At, B1); PG8_BAR; PG8_SCHED;
            PG8_LDB(B0, 1, 0); PG8_LDB(B1, 1, 1); PG8_SCHED; PG8_LDA(At, 1, 0); PG8_STAGE(PG8_SA(0, 1), a2 + hstepA, vC[2], vC[3]);
            PG8_WAIT_V(8); PG8_WAIT_L(0); PG8_BAR; PG8_MMA(0, 0, At, B0); PG8_MMA(0, 1, At, B1); PG8_BAR; PG8_SCHED;
            PG8_LDA(At, 1, 1); PG8_STAGEB(PG8_SB(1, 0), b3); PG8_STAGEB(PG8_SB(1, 1), b3 + hstepB); PG8_STAGE(PG8_SA(1, 0), a3, vC[0], vC[1]);
            PG8_WAIT_V(8); PG8_WAIT_L(0); PG8_BAR; PG8_MMA(1, 0, At, B0); PG8_MMA(1, 1, At, B1); PG8_BAR; PG8_SCHED;
        }
        if (wr == 0) PG8_BAR;
        { int ln_ = (int)__builtin_amdgcn_mbcnt_hi(~0u, __builtin_amdgcn_mbcnt_lo(~0u, 0u)); asm volatile("" : "+v"(ln_));
          E(acc, cur, wr, wc, ln_ & 15, ln_ >> 4); }
        if (!has_next) break;
#pragma unroll
        for (int a = 0; a < 2; ++a)
#pragma unroll
            for (int b = 0; b < 2; ++b)
#pragma unroll
                for (int m = 0; m < 4; ++m)
#pragma unroll
                    for (int n = 0; n < 2; ++n) acc[a][b][m][n] = (f32x4){0.f, 0.f, 0.f, 0.f};
        cur = nxt; cA = nA; cB = nB; ++ui;
        if (wr == 1) PG8_BAR;
    }
    PG8_WAIT_V(0);
    PG8_BAR;
#undef PG8_SA
#undef PG8_SB
#undef PG8_STAGE
#undef PG8_STAGE_X
#undef PG8_STAGEB
#undef PG8_LDA
#undef PG8_LDB
#undef PG8_MMA
#undef PG8_WAIT_V
#undef PG8_WAIT_L
#undef PG8_BAR
#undef PG8_SCHED
#undef PG8_VOFFA
}
}

template <int NBM, class AF, class Epi>
__device__ __forceinline__ void sgemm_tile(float* lds, int K, AF arow, const float* __restrict__ B0, const float* __restrict__ B1, int ldb, int n0, int N, Epi epi) {
    const int tid = tid_fresh();
    float* As = lds;
    float* Bs0 = lds + 16 * 132;
    float* Bs1 = lds + 2 * 16 * 132;
    const int ty = tid >> 5, tx = tid & 31;
    float acc0[8][4], acc1[8][4];
#pragma unroll
    for (int i = 0; i < 8; ++i)
#pragma unroll
        for (int j = 0; j < 4; ++j) { acc0[i][j] = 0.f; acc1[i][j] = 0.f; }
    const int ar = tid >> 2, ak = (tid & 3) * 4;
    const float* ap = arow(ar);
    const int bk = tid >> 5, bn = (tid & 31) * 4;
    const bool bok = (n0 + bn) < N;
    for (int k0 = 0; k0 < K; k0 += 16) {
        float4 av = ap ? *(const float4*)(ap + k0 + ak) : make_float4(0.f, 0.f, 0.f, 0.f);
        float4 bv0 = bok ? *(const float4*)(B0 + (size_t)(k0 + bk) * ldb + n0 + bn) : make_float4(0.f, 0.f, 0.f, 0.f);
        float4 bv1 = make_float4(0.f, 0.f, 0.f, 0.f);
        if (NBM == 2) { if (bok) bv1 = *(const float4*)(B1 + (size_t)(k0 + bk) * ldb + n0 + bn); }
        __syncthreads();
        As[(ak + 0) * 132 + ar] = av.x; As[(ak + 1) * 132 + ar] = av.y; As[(ak + 2) * 132 + ar] = av.z; As[(ak + 3) * 132 + ar] = av.w;
        *(float4*)&Bs0[bk * 132 + bn] = bv0;
        if (NBM == 2) *(float4*)&Bs1[bk * 132 + bn] = bv1;
        __syncthreads();
#pragma unroll 2
        for (int k = 0; k < 16; ++k) {
            const float4 a0 = *(const float4*)&As[k * 132 + ty * 8], a1 = *(const float4*)&As[k * 132 + ty * 8 + 4];
            const float a[8] = {a0.x, a0.y, a0.z, a0.w, a1.x, a1.y, a1.z, a1.w};
            const float4 b0 = *(const float4*)&Bs0[k * 132 + tx * 4];
            const float bb0[4] = {b0.x, b0.y, b0.z, b0.w};
#pragma unroll
            for (int i = 0; i < 8; ++i)
#pragma unroll
                for (int j = 0; j < 4; ++j) acc0[i][j] = fmaf(a[i], bb0[j], acc0[i][j]);
            if (NBM == 2) {
                const float4 b1 = *(const float4*)&Bs1[k * 132 + tx * 4];
                const float bb1[4] = {b1.x, b1.y, b1.z, b1.w};
#pragma unroll
                for (int i = 0; i < 8; ++i)
#pragma unroll
                    for (int j = 0; j < 4; ++j) acc1[i][j] = fmaf(a[i], bb1[j], acc1[i][j]);
            }
        }
    }
    if (bok) {
#pragma unroll
        for (int i = 0; i < 8; ++i)
#pragma unroll
            for (int j = 0; j < 4; ++j) epi(ty * 8 + i, tx * 4 + j, acc0[i][j], acc1[i][j]);
    }
}

__device__ __forceinline__ void transpose_blk(const float* W, int N, bf16_t* WT, int K, int k0, int n0, int drow0, float* scr, int lane) {
    const int kr = lane >> 3, n4 = (lane & 7) * 4;
    float4 v[8];
#pragma unroll
    for (int i = 0; i < 8; ++i) v[i] = *(const float4*)(W + (size_t)(k0 + i * 8 + kr) * N + n0 + n4);
#pragma unroll
    for (int i = 0; i < 8; ++i) { float* d = scr + (i * 8 + kr) * 33 + n4; d[0] = v[i].x; d[1] = v[i].y; d[2] = v[i].z; d[3] = v[i].w; }
    asm volatile("s_waitcnt lgkmcnt(0)" ::: "memory");
    const int c = lane & 7;
#pragma unroll
    for (int j = 0; j < 4; ++j) { const int n = (lane >> 3) + 8 * j; const float* sp = scr + (8 * c) * 33 + n;
        uint4 o; o.x = pk2(sp[0 * 33], sp[1 * 33]); o.y = pk2(sp[2 * 33], sp[3 * 33]); o.z = pk2(sp[4 * 33], sp[5 * 33]); o.w = pk2(sp[6 * 33], sp[7 * 33]);
        *(uint4*)(WT + (size_t)(drow0 + n) * K + k0 + 8 * c) = o; }
    asm volatile("s_waitcnt lgkmcnt(0)" ::: "memory");
}
__device__ __forceinline__ void transpose_item(const float* W, int K, int N, bf16_t* WT, int row_off, float* scr, int item, int lane) {
    const int nblk = N / 32, kb = item / nblk, nb = item % nblk;
    transpose_blk(W, N, WT, K, 64 * kb, 32 * nb, row_off + 32 * nb, scr, lane);
}
struct CvtItem { const float* W; bf16_t* WT; int N, K, k0, n0, drow0; };
__device__ __forceinline__ bool cvt_decode(const Args& a, int l, int it, CvtItem& c) {
    if (it >= NEXP * 768) return false;
    bf16_t* WGU = (bf16_t*)(a.ws + WS_WEXP); bf16_t* WD = WGU + (size_t)NEXP * 1024 * 1024;
    const int e = it / 768; int r = it % 768;
    if (r < 512) {
        const bool up = r >= 256; r &= 255; const int kb = r >> 4, nb = r & 15, n0 = 32 * nb;
        c.W = (up ? a.in[26] : a.in[25]) + ((size_t)l * NEXP + e) * DM * DEXP; c.N = DEXP; c.WT = WGU + (size_t)e * 1024 * 1024; c.K = DM; c.k0 = 64 * kb; c.n0 = n0; c.drow0 = 256 * (n0 >> 7) + (n0 & 127) + (up ? 128 : 0);
    } else {
        r -= 512; const int kb = r >> 5, nb = r & 31;
        c.W = a.in[27] + ((size_t)l * NEXP + e) * DEXP * DM; c.N = DM; c.WT = WD + (size_t)e * 1024 * 512; c.K = DEXP; c.k0 = 64 * kb; c.n0 = 32 * nb; c.drow0 = 32 * nb;
    }
    return true;
}
__device__ __forceinline__ void cvt_load(const CvtItem& c, int lane, float4 (&v)[8]) {
    const int kr = lane >> 3, n4 = (lane & 7) * 4;
#pragma unroll
    for (int i = 0; i < 8; ++i) { typedef float f4v_ __attribute__((ext_vector_type(4))); const f4v_ t_ = __builtin_nontemporal_load((const f4v_*)(c.W + (size_t)(c.k0 + i * 8 + kr) * c.N + c.n0 + n4)); v[i] = make_float4(t_[0], t_[1], t_[2], t_[3]); }
}
__device__ __forceinline__ void cvt_finish(const CvtItem& c, int lane, const float4 (&v)[8], float* scr) {
    const int kr = lane >> 3, n4 = (lane & 7) * 4;
#pragma unroll
    for (int i = 0; i < 8; ++i) { float* d = scr + (i * 8 + kr) * 33 + n4; d[0] = v[i].x; d[1] = v[i].y; d[2] = v[i].z; d[3] = v[i].w; }
    asm volatile("s_waitcnt lgkmcnt(0)" ::: "memory");
    const int cc = lane & 7;
#pragma unroll
    for (int j = 0; j < 4; ++j) { const int n = (lane >> 3) + 8 * j; const float* sp = scr + (8 * cc) * 33 + n;
        uint4 o; o.x = pk2(sp[0 * 33], sp[1 * 33]); o.y = pk2(sp[2 * 33], sp[3 * 33]); o.z = pk2(sp[4 * 33], sp[5 * 33]); o.w = pk2(sp[6 * 33], sp[7 * 33]);
        *(uint4*)(c.WT + (size_t)(c.drow0 + n) * c.K + c.k0 + 8 * cc) = o; }
    asm volatile("s_waitcnt lgkmcnt(0)" ::: "memory");
}
__device__ __forceinline__ void convert_experts(const Args& a, int l, float* lds) {
    const int tid = tid_fresh(), lane = tid & 63, wid = tid >> 6;
    float* scr = lds + wid * (64 * 33);
    const int gw = blockIdx.x * 8 + wid, NGW = gridDim.x * 8;
    bf16_t* WGU = (bf16_t*)(a.ws + WS_WEXP); bf16_t* WD = WGU + (size_t)NEXP * 1024 * 1024;
    for (int it = gw; it < NEXP * 768; it += NGW) {
        const int e = it / 768; int r = it % 768;
        if (r < 512) {
            const bool up = r >= 256; r &= 255; const int kb = r >> 4, nb = r & 15, n0 = 32 * nb;
            const float* W = (up ? a.in[26] : a.in[25]) + ((size_t)l * NEXP + e) * DM * DEXP;
            transpose_blk(W, DEXP, WGU + (size_t)e * 1024 * 1024, DM, 64 * kb, n0, 256 * (n0 >> 7) + (n0 & 127) + (up ? 128 : 0), scr, lane);
        } else {
            r -= 512; const int kb = r >> 5, nb = r & 31;
            const float* W = a.in[27] + ((size_t)l * NEXP + e) * DEXP * DM;
            transpose_blk(W, DM, WD + (size_t)e * 1024 * 512, DEXP, 64 * kb, 32 * nb, 32 * nb, scr, lane);
        }
    }
}
__device__ __forceinline__ void cvt_row(const float* in, bf16_t* out, int lane) {
#pragma unroll
    for (int j = 0; j < 4; ++j) { const float4 v = *(const float4*)(in + j * 256 + lane * 4); uint2 o; o.x = pk2(v.x, v.y); o.y = pk2(v.z, v.w); *(uint2*)(out + j * 256 + lane * 4) = o; }
}
__device__ __forceinline__ bool pro_decode(const Args& a, int it, CvtItem& c) {
    constexpr int I_IN = 16 * 104, I_VR = 16, I_SQ = 16 * 32, I_KV = 16 * 64;
    constexpr int NITEMS = 2 * I_IN + I_VR + 6 * I_SQ + 2 * I_KV;
    if (it < 0 || it >= NITEMS) return false;
    const float* W; int K = DM, N; bf16_t* WT; int row_off = 0; int r = it;
    bf16_t* WIN0 = (bf16_t*)(a.ws + WS_WIN0); bf16_t* WIN1 = (bf16_t*)(a.ws + WS_WIN1);
    if (r < I_IN) { W = a.in[2]; N = IN_COLS; WT = WIN0; }
    else if ((r -= I_IN) < I_IN) { W = a.in[2] + (size_t)DM * IN_COLS; N = IN_COLS; WT = WIN1; }
    else if ((r -= I_IN) < I_VR) { W = a.in[3]; N = 32; WT = WIN1; row_off = IN_COLS; }
    else {
        r -= I_VR;
        constexpr int I_L = 3 * I_SQ + I_KV;
        const int l = r / I_L; r -= l * I_L;
        if (r < I_SQ) { W = a.in[19] + (size_t)l * DM * DM; N = DM; WT = (bf16_t*)(a.ws + WS_WOUT) + (size_t)l * DM * DM; }
        else if ((r -= I_SQ) < I_SQ) { W = a.in[20] + (size_t)l * DM * DM; N = DM; WT = (bf16_t*)(a.ws + WS_WQ) + (size_t)l * DM * DM; }
        else if ((r -= I_SQ) < I_KV) { W = a.in[21] + (size_t)l * DM * 2048; N = 2048; WT = (bf16_t*)(a.ws + WS_WKV) + (size_t)l * DM * 2048; }
        else { r -= I_KV; W = a.in[22] + (size_t)l * DM * DM; N = DM; WT = (bf16_t*)(a.ws + WS_WO) + (size_t)l * DM * DM; }
    }
    const int nblk = N / 32, kb = r / nblk, nb = r % nblk;
    c.W = W; c.WT = WT; c.N = N; c.K = K; c.k0 = 64 * kb; c.n0 = 32 * nb; c.drow0 = row_off + 32 * nb;
    return true;
}
constexpr int PRO_I_IN = 16 * 104, PRO_I_VR = 16, PRO_I_SQ = 16 * 32, PRO_I_KV = 16 * 64, PRO_I_L = 3 * PRO_I_SQ + PRO_I_KV;
constexpr int PRO_NESS = PRO_I_IN + PRO_I_KV, PRO_NALL = 2 * PRO_I_IN + PRO_I_VR + 2 * PRO_I_L, PRO_NDEF = PRO_NALL - PRO_NESS;
__device__ __forceinline__ int pro_item(int part, int e) {
    if (part == 2) return e < PRO_NALL ? e : -1;
    if (part == 0) { if (e >= PRO_NESS) return -1; return e < PRO_I_IN ? e : 2 * PRO_I_IN + PRO_I_VR + 2 * PRO_I_SQ + (e - PRO_I_IN); }
    if (e >= PRO_NDEF) return -1;
    if (e < PRO_I_IN + PRO_I_VR) return PRO_I_IN + e;
    e -= PRO_I_IN + PRO_I_VR;
    const int base = 2 * PRO_I_IN + PRO_I_VR;
    if (e < 2 * PRO_I_SQ) return base + e;
    if (e < 3 * PRO_I_SQ) return base + PRO_I_KV + e;
    return base + PRO_I_L + (e - 3 * PRO_I_SQ);
}
__device__ __forceinline__ void pro_items(const Args& a, float* lds, int part, int gw, int NGW, int lane, int wid) {
    float* scr = lds + wid * (64 * 33);
    CvtItem c0, c1; float4 v0[8], v1[8];
    int e = gw;
    bool h0 = pro_decode(a, pro_item(part, e), c0); if (h0) cvt_load(c0, lane, v0);
    while (h0) {
        const bool h1 = pro_decode(a, pro_item(part, e + NGW), c1); if (h1) cvt_load(c1, lane, v1);
        cvt_finish(c0, lane, v0, scr);
        e += 2 * NGW;
        h0 = h1 && pro_decode(a, pro_item(part, e), c0); if (h0) cvt_load(c0, lane, v0);
        if (h1) cvt_finish(c1, lane, v1, scr);
    }
}
__device__ __forceinline__ void pro_deferred_rest(const Args& a, int gw, int NGW, int lane, int gt, int NGT) {
    bf16_t* WIN1 = (bf16_t*)(a.ws + WS_WIN1);
    for (int r = gw; r < 224; r += NGW) {
#pragma unroll
        for (int j = 0; j < 2; ++j) *(uint4*)(WIN1 + (size_t)(3360 + r) * DM + j * 512 + lane * 8) = make_uint4(0u, 0u, 0u, 0u);
    }
    for (int idx = gt; idx < 2 * 512 * 288; idx += NGT) {
        const int l = idx / (512 * 288); const int r = idx % (512 * 288), kk = r >> 9, n = r & 511;
        bf16_t* base = (bf16_t*)(a.ws + WS_LORA + (size_t)l * LORA_L);
        if (kk < 64) base[n * 64 + kk] = f2bf(a.in[7][((size_t)l * 64 + kk) * 512 + n]);
        else if (kk < 128) base[512 * 64 + n * 64 + (kk - 64)] = f2bf(a.in[9][((size_t)l * 64 + (kk - 64)) * 512 + n]);
        else if (kk < 256) base[2 * 512 * 64 + n * 128 + (kk - 128)] = f2bf(a.in[12][((size_t)l * 128 + (kk - 128)) * 512 + n]);
        else base[2 * 512 * 64 + 512 * 128 + n * 32 + (kk - 256)] = f2bf(a.in[11][(size_t)(kk - 256) * 512 + n]);
    }
}
__device__ __forceinline__ void phase_prologue(const Args& a, float* lds) {
    const int tid = tid_fresh(), lane = tid & 63, wid = tid >> 6;
    const int gw = blockIdx.x * 8 + wid, NGW = gridDim.x * 8;
    const bool split = gridDim.x == 256;
    pro_items(a, lds, split ? 0 : 2, gw, NGW, lane, wid);
    if (!split) pro_deferred_rest(a, gw, NGW, lane, blockIdx.x * NTHREADS + tid, gridDim.x * NTHREADS);
    bf16_t* XB = (bf16_t*)(a.ws + WS_XB); bf16_t* MEMB = (bf16_t*)(a.ws + WS_MEMB);
    for (int m = gw; m < NTOK + NBATCH * MEMLEN; m += 4 * NGW) {
        float4 v[4][4];
#pragma unroll
        for (int q = 0; q < 4; ++q) { const int mm = m + q * NGW;
            if (mm < NTOK + NBATCH * MEMLEN) { const float* in = (mm < NTOK) ? a.in[0] + (size_t)mm * DM : a.in[1] + (size_t)(mm - NTOK) * DM;
#pragma unroll
                for (int j = 0; j < 4; ++j) v[q][j] = *(const float4*)(in + j * 256 + lane * 4); } }
#pragma unroll
        for (int q = 0; q < 4; ++q) { const int mm = m + q * NGW;
            if (mm < NTOK + NBATCH * MEMLEN) { bf16_t* out = (mm < NTOK) ? XB + (size_t)mm * DM : MEMB + (size_t)(mm - NTOK) * DM;
#pragma unroll
                for (int j = 0; j < 4; ++j) { uint2 o; o.x = pk2(v[q][j].x, v[q][j].y); o.y = pk2(v[q][j].z, v[q][j].w); *(uint2*)(out + j * 256 + lane * 4) = o; } } }
    }
}
__device__ __forceinline__ void prologue_deferred(const Args& a, float* lds) {
    const int tid = tid_fresh(), lane = tid & 63, wid = tid >> 6;
    __syncthreads();
    const int vb = (int)blockIdx.x - 128;
    pro_items(a, lds, 1, vb * 8 + wid, 128 * 8, lane, wid);
    pro_deferred_rest(a, vb * 8 + wid, 128 * 8, lane, vb * NTHREADS + tid, 128 * NTHREADS);
}

__device__ __forceinline__ void phase_g1(const Args& a, int l, PG8_LAS unsigned char* lds) {
    pg8::G1Sched S; S.init(a.ws + WS_XB, a.ws + (l == 0 ? WS_WIN0 : WS_WIN1), l == 0 ? IN_COLS / 256 : ZLD / 256, a.ws + WS_MEMB, a.ws + WS_WKV + (size_t)l * 4 * MiB);
    pg8::EpiG1 E{(bf16_t*)(a.ws + WS_Z), (bf16_t*)(a.ws + WS_KB), (bf16_t*)(a.ws + WS_VT)};
    pg8::gemm_phase<pg8::EpiG1, pg8::G1Sched, false>(lds, pg8::Dims{DM, DM, DM}, S, E);
    if (l == 0 && gridDim.x == 256 && blockIdx.x >= 128) prologue_deferred(a, (float*)(unsigned char*)lds);
}
__device__ __forceinline__ void phase_matt_s(const Args& a, PG8_LAS unsigned char* lds) {
    pg8::MattSched S; S.init(a.ws + WS_Q, a.ws + WS_KB, (size_t)256 * 1024 * 2, 256 * 2);
    pg8::EpiSoftmax E{(bf16_t*)(a.ws + WS_P), (float*)(a.ws + WS_LSUM), (PG8_LAS float*)(lds + pg8::STAGE_BYTES + 8192 + 512)};
    pg8::gemm_phase<pg8::EpiSoftmax, pg8::MattSched, false>(lds, pg8::Dims{1024, 1024, 256}, S, E);
}
__device__ __forceinline__ void phase_matt_pv(const Args& a, PG8_LAS unsigned char* lds) {
    pg8::MattSched S; S.init(a.ws + WS_P, a.ws + WS_VT, (size_t)1024 * 256 * 2, 256 * 256 * 2);
    pg8::EpiPV E{(bf16_t*)(a.ws + WS_O), (const float*)(a.ws + WS_LSUM)};
    pg8::gemm_phase<pg8::EpiPV, pg8::MattSched, false>(lds, pg8::Dims{1024, 256, 256}, S, E);
}

typedef _Float16 h8_t __attribute__((ext_vector_type(8)));
typedef _Float16 h2_t __attribute__((ext_vector_type(2)));
__device__ __forceinline__ unsigned pkh2(float lo, float hi) { h2_t v = {(_Float16)lo, (_Float16)hi}; return __builtin_bit_cast(unsigned, v); }
#define SC_DPP(x, ctrl) __int_as_float(__builtin_amdgcn_mov_dpp(__float_as_int(x), ctrl, 0xF, 0xF, true))
__device__ __forceinline__ float sum32(float x) {
    x += SC_DPP(x, 0xB1); x += SC_DPP(x, 0x4E); x += SC_DPP(x, 0x141); x += SC_DPP(x, 0x140);
    return x + __shfl_xor(x, 16);
}
__device__ __forceinline__ void phase_prep(const Args& a, int l, float* lds) {
    typedef short bf16x8 __attribute__((ext_vector_type(8)));
    typedef float f32x16 __attribute__((ext_vector_type(16)));
    const bf16_t* Z = (const bf16_t*)(a.ws + WS_Z);
    const int tid = tid_fresh(), lane = tid & 63, wid = tid >> 6;
    float* KM = (float*)(a.ws + WS_KMEAN);
    for (int u = blockIdx.x * 8 + wid; u < NBATCH * NH * 8; u += gridDim.x * 8) {
        const int nb = u & 7, h = (u >> 3) & 7, b = u >> 6, rg = lane >> 3, ch = lane & 7;
        const bf16_t* p = Z + (size_t)(b * SEQ + nb * 256 + rg) * ZLD + C_K + h * HD + ch * 8;
        float acc[8];
#pragma unroll
        for (int j = 0; j < 8; ++j) acc[j] = 0.f;
#pragma unroll 8
        for (int i = 0; i < 32; ++i) { const uint4 v = *(const uint4*)(p + (size_t)(i * 8) * ZLD);
            acc[0] += bflo(v.x); acc[1] += bfhi(v.x); acc[2] += bflo(v.y); acc[3] += bfhi(v.y); acc[4] += bflo(v.z); acc[5] += bfhi(v.z); acc[6] += bflo(v.w); acc[7] += bfhi(v.w); }
#pragma unroll
        for (int j = 0; j < 8; ++j) { float x = acc[j]; x += __shfl_xor(x, 8); x += __shfl_xor(x, 16); x += __shfl_xor(x, 32); acc[j] = x * (1.0f / 256.0f); }
        if (rg == 0) { *(float4*)(KM + (size_t)u * 64 + ch * 8) = make_float4(acc[0], acc[1], acc[2], acc[3]); *(float4*)(KM + (size_t)u * 64 + ch * 8 + 4) = make_float4(acc[4], acc[5], acc[6], acc[7]); }
    }
    const float* mu = a.in[4] + (size_t)l * 1792;
    const float* muv = a.in[5];
    const bf16_t* WdT = (const bf16_t*)(a.ws + WS_LORA + (size_t)l * LORA_L); const bf16_t* WiT = (const bf16_t*)(a.ws + WS_LORA + (size_t)l * LORA_L + LORA_I);
    const bf16_t* WgT = (const bf16_t*)(a.ws + WS_LORA + (size_t)l * LORA_L + LORA_G); const bf16_t* WvT = (const bf16_t*)(a.ws + WS_LORA + LORA_V);
    unsigned* REC = (unsigned*)(a.ws + WS_REC);
    _Float16* RVT = (_Float16*)(a.ws + WS_RVT); bf16_t* RGp = (bf16_t*)(a.ws + WS_RG); float* BON = (float*)(a.ws + WS_BON);
    bf16_t* VF = (bf16_t*)(a.ws + WS_VFIRST);
    constexpr int PREP_AFR_BYTES = 18 * 64 * 16, PREP_TILE_BYTES = 3 * 33 * 128;
    uint4* afr = (uint4*)lds;
    for (int tb = blockIdx.x; tb < 512; tb += gridDim.x) {
        int lane_t = lane; asm volatile("" : "+v"(lane_t));
        const int r32 = lane_t & 31, hi = lane_t >> 5;
        const int h = wid, t0 = tb * 32, b = t0 / SEQ, tt0 = t0 % SEQ, bh = b * NH + h;
        const size_t tokA = (size_t)t0 + r32;
        const bool firstA = (tt0 == 0) && (r32 == 0);
        const size_t tokP = firstA ? tokA : tokA - 1;
        PG8_LAS unsigned char* tileL = (PG8_LAS unsigned char*)lds + PREP_AFR_BYTES + wid * PREP_TILE_BYTES;
        {
            const int rowl = lane_t >> 3, ch8 = lane_t & 7;
            const size_t tprev = (t0 == 0) ? 0 : (size_t)t0 - 1;
#pragma unroll
            for (int op = 0; op < 3; ++op) {
                const int zc = (op == 0 ? C_R : op == 1 ? C_KR : C_VR) + h * 64;
                if (lane_t < 8) __builtin_amdgcn_global_load_lds((const unsigned*)(Z + tprev * ZLD + zc + lane_t * 8), (PG8_LAS unsigned*)(tileL + (op * 33) * 128), 16, 0, 0);
#pragma unroll
                for (int k = 0; k < 4; ++k)
                    __builtin_amdgcn_global_load_lds((const unsigned*)(Z + ((size_t)t0 + 8 * k + rowl) * ZLD + zc + ch8 * 8), (PG8_LAS unsigned*)(tileL + (op * 33 + 1 + 8 * k) * 128), 16, 0, 0);
            }
        }
        uint4* VFL = (uint4*)(a.ws + WS_VFIRST) + (((size_t)tb * 8 + h) * 2) * 128 + lane_t * 2;
        uint4 vfq[2][2];
        if (l == 1) { vfq[0][0] = VFL[0]; vfq[0][1] = VFL[1]; vfq[1][0] = VFL[128]; vfq[1][1] = VFL[129]; }
        __syncthreads();
#pragma unroll
        for (int m = 0; m < 3; ++m) {
            const int idx = wid + 8 * m;
            if (idx < (l == 1 ? 18 : 16)) {
                int zcol; const float* mup; int act;
                if (idx < 8) { zcol = C_ZG + 16 * idx; mup = mu + (C_ZG - C_R) + 16 * idx; act = 2; }
                else if (idx < 12) { zcol = C_ZW + 16 * (idx - 8); mup = mu + (C_ZW - C_R) + 16 * (idx - 8); act = 1; }
                else if (idx < 16) { zcol = C_ZA + 16 * (idx - 12); mup = mu + (C_ZA - C_R) + 16 * (idx - 12); act = 0; }
                else { zcol = C_ZV + 16 * (idx - 16); mup = muv + 16 * (idx - 16); act = 0; }
                zcol += 8 * hi; mup += 8 * hi;
                const uint4 cu_ = *(const uint4*)(Z + tokA * ZLD + zcol); uint4 pv_ = *(const uint4*)(Z + tokP * ZLD + zcol); if (firstA) pv_ = make_uint4(0u, 0u, 0u, 0u);
                const float4 m0_ = *(const float4*)(mup), m1_ = *(const float4*)(mup + 4);
                float x_[8]; const unsigned cw_[4] = {cu_.x, cu_.y, cu_.z, cu_.w}, pw_[4] = {pv_.x, pv_.y, pv_.z, pv_.w}; const float mm_[8] = {m0_.x, m0_.y, m0_.z, m0_.w, m1_.x, m1_.y, m1_.z, m1_.w};
#pragma unroll
                for (int q_ = 0; q_ < 4; ++q_) { const float c0_ = bflo(cw_[q_]), c1_ = bfhi(cw_[q_]); x_[2 * q_] = c0_ + (bflo(pw_[q_]) - c0_) * mm_[2 * q_]; x_[2 * q_ + 1] = c1_ + (bfhi(pw_[q_]) - c1_) * mm_[2 * q_ + 1]; }
                if (act == 1) {
#pragma unroll
                    for (int q_ = 0; q_ < 8; ++q_) x_[q_] = 1.0f - 2.0f * __builtin_amdgcn_rcpf(__expf(2.0f * x_[q_]) + 1.0f);
                } else if (act == 2) {
#pragma unroll
                    for (int q_ = 0; q_ < 8; ++q_) x_[q_] = __builtin_amdgcn_rcpf(1.0f + __expf(-x_[q_]));
                }
                afr[idx * 64 + lane_t] = make_uint4(pk2(x_[0], x_[1]), pk2(x_[2], x_[3]), pk2(x_[4], x_[5]), pk2(x_[6], x_[7]));
            }
        }
        __syncthreads();
#define PREP_AFRAG(dst, idx_) do { const uint4 q_ = afr[(idx_) * 64 + lane_t]; pg8::u32x4 w_; w_.x = q_.x; w_.y = q_.y; w_.z = q_.z; w_.w = q_.w; dst = __builtin_bit_cast(bf16x8, w_); } while (0)
        const int chB = h * 64 + r32;
#define PREP_TOK(r) int hq_ = hi; asm volatile("" : "+v"(hq_)); const int tq = ((r) & 3) + 8 * ((r) >> 2) + 4 * hq_, t = tt0 + tq; const size_t tok = (size_t)t0 + tq; (void)t; (void)tok
#define PREP_RB(t, j) (((((size_t)bh * 512 + ((t) >> 2)) * 32 + ((j) >> 1)) * 4 + ((t) & 3)) * 5)
        f32x16 acc[2];
#pragma unroll
        for (int nb = 0; nb < 2; ++nb)
#pragma unroll
            for (int r = 0; r < 16; ++r) acc[nb][r] = 0.f;
#pragma unroll 1
        for (int sO = 0; sO < 8; sO += 4) {
            asm volatile("" ::: "memory");
#pragma unroll
            for (int sJ = 0; sJ < 4; ++sJ) { const int sI = sO + sJ;
                bf16x8 af; PREP_AFRAG(af, sI);
#pragma unroll
                for (int nb = 0; nb < 2; ++nb) acc[nb] = __builtin_amdgcn_mfma_f32_32x32x16_bf16(af, *(const bf16x8*)(WgT + (size_t)(chB + 32 * nb) * 128 + 16 * sI + 8 * hi), acc[nb], 0, 0, 0); }
        }
#pragma unroll
        for (int nb = 0; nb < 2; ++nb)
#pragma unroll
            for (int r = 0; r < 16; ++r) { PREP_TOK(r); RGp[tok * 512 + chB + 32 * nb] = f2bf(acc[nb][r]); }
#pragma unroll
        for (int nb = 0; nb < 2; ++nb)
#pragma unroll
            for (int r = 0; r < 16; ++r) acc[nb][r] = 0.f;
        asm volatile("" ::: "memory");
#pragma unroll
        for (int sI = 0; sI < 4; ++sI) {
            bf16x8 af; PREP_AFRAG(af, 8 + sI);
#pragma unroll
            for (int nb = 0; nb < 2; ++nb) acc[nb] = __builtin_amdgcn_mfma_f32_32x32x16_bf16(af, *(const bf16x8*)(WdT + (size_t)(chB + 32 * nb) * 64 + 16 * sI + 8 * hi), acc[nb], 0, 0, 0);
        }
        unsigned UW[2][8];
#pragma unroll
        for (int nb = 0; nb < 2; ++nb) {
            const float w0c = a.in[6][l * 512 + chB + 32 * nb];
#pragma unroll
            for (int g = 0; g < 4; ++g)
#pragma unroll
                for (int ts = 0; ts < 2; ++ts) { float uu[2];
#pragma unroll
                    for (int e = 0; e < 2; ++e) { const float sd = w0c + acc[nb][4 * g + ts + 2 * e]; const float sp = (sd < -15.f) ? -sd : __logf(1.0f + __expf(-sd)); uu[e] = 1.0f - __expf(-__expf(-sp - 0.5f)); }
                    UW[nb][2 * g + ts] = pkh2(uu[0], uu[1]); }
        }
        f32x16 aia[2], vga[2];
#pragma unroll
        for (int nb = 0; nb < 2; ++nb)
#pragma unroll
            for (int r = 0; r < 16; ++r) { aia[nb][r] = 0.f; vga[nb][r] = 0.f; }
        asm volatile("" ::: "memory");
#pragma unroll
        for (int sI = 0; sI < 4; ++sI) {
            bf16x8 af; PREP_AFRAG(af, 12 + sI);
#pragma unroll
            for (int nb = 0; nb < 2; ++nb) aia[nb] = __builtin_amdgcn_mfma_f32_32x32x16_bf16(af, *(const bf16x8*)(WiT + (size_t)(chB + 32 * nb) * 64 + 16 * sI + 8 * hi), aia[nb], 0, 0, 0);
        }
        if (l == 1) {
            asm volatile("" ::: "memory");
#pragma unroll
            for (int sI = 0; sI < 2; ++sI) {
                bf16x8 af; PREP_AFRAG(af, 16 + sI);
#pragma unroll
                for (int nb = 0; nb < 2; ++nb) vga[nb] = __builtin_amdgcn_mfma_f32_32x32x16_bf16(af, *(const bf16x8*)(WvT + (size_t)(chB + 32 * nb) * 32 + 16 * sI + 8 * hi), vga[nb], 0, 0, 0);
            }
        }
#undef PREP_AFRAG
        asm volatile("s_waitcnt vmcnt(0)" ::: "memory");
        float ss[16], bon[16]; unsigned KW[2][8], RW[2][8], QW[2][8], AW[2][8];
#pragma unroll
        for (int r = 0; r < 16; ++r) { ss[r] = 0.f; bon[r] = 0.f; }
#pragma unroll
        for (int nb = 0; nb < 2; ++nb) {
            const int j = 32 * nb + r32, c = h * 64 + j;
            const float a0c = a.in[8][l * 512 + c], v0c = a.in[10][c];
            const float mu_r = mu[c], mu_k = mu[512 + c], mu_v = mu[1024 + c];
            const float kk_c = a.in[13][l * 512 + c], ka_c = a.in[14][l * 512 + c], rk_c = a.in[15][l * 512 + c];
            float v4[4], kp2[2], rr2[2], kq2[2], ai2[2];
            float lr_ = 0.f, lk_ = 0.f, lv_ = 0.f, vfe = 0.f; unsigned vfo[8];
            const unsigned vfi[8] = {vfq[nb][0].x, vfq[nb][0].y, vfq[nb][0].z, vfq[nb][0].w, vfq[nb][1].x, vfq[nb][1].y, vfq[nb][1].z, vfq[nb][1].w};
#pragma unroll
            for (int r = 0; r < 16; ++r) {
                PREP_TOK(r);
                const float ai = sigmoid_fast(a0c + aia[nb][r]);
                PG8_LAS const bf16_t* tp_ = (PG8_LAS const bf16_t*)tileL + (1 + tq) * 64 + j;
                const float zr = bf2f(tp_[0]), zk = bf2f(tp_[33 * 64]), zv = bf2f(tp_[66 * 64]);
                float pr, pk, pv;
                if ((r & 3) == 0) { const float pm_ = (t != 0) ? 1.0f : 0.0f; pr = pm_ * bf2f(tp_[-64]); pk = pm_ * bf2f(tp_[32 * 64]); pv = pm_ * bf2f(tp_[65 * 64]); }
                else { pr = lr_; pk = lk_; pv = lv_; }
                lr_ = zr; lk_ = zk; lv_ = zv;
                const float rr_ = zr + (pr - zr) * mu_r, kx = zk + (pk - zk) * mu_k;
                float v = zv + (pv - zv) * mu_v;
                if (l == 0) { if (r & 1) vfo[r >> 1] = pk2(vfe, v); else vfe = v; }
                else { const float vf_ = (r & 1) ? bfhi(vfi[r >> 1]) : bflo(vfi[r >> 1]); v = v + (vf_ - v) * sigmoid_fast(v0c + vga[nb][r]); }
                const float kkraw = kx * kk_c, kp = kx * (1.0f + (ai - 1.0f) * ka_c);
                ss[r] = fmaf(kkraw, kkraw, ss[r]); bon[r] = fmaf(rr_ * kp, rk_c, bon[r]);
                if ((r & 3) < 2) { kp2[r & 1] = kp; rr2[r & 1] = rr_; kq2[r & 1] = kkraw; ai2[r & 1] = ai; }
                else { const int wI = 2 * (r >> 2) + (r & 1); KW[nb][wI] = pkh2(kp2[r & 1], kp); RW[nb][wI] = pkh2(rr2[r & 1], rr_); QW[nb][wI] = pkh2(kq2[r & 1], kkraw); AW[nb][wI] = pkh2(ai2[r & 1], ai); }
                v4[r & 3] = v;
                if ((r & 3) == 3) {
                    uint2 pv2; pv2.x = pk2(v4[0], v4[1]); pv2.y = pk2(v4[2], v4[3]);
                    *(uint2*)(RVT + (((size_t)bh * 256 + ((tt0 >> 3) + (r >> 2))) * 64 + j) * 8 + 4 * hi) = pv2;
                }
            }
            if (l == 0) { VFL[nb * 128] = make_uint4(vfo[0], vfo[1], vfo[2], vfo[3]); VFL[nb * 128 + 1] = make_uint4(vfo[4], vfo[5], vfo[6], vfo[7]); }
        }
        float rn[16];
#pragma unroll
        for (int r = 0; r < 16; ++r) {
            PREP_TOK(r);
            const float sst = sum32(ss[r]), bt = sum32(bon[r]);
            rn[r] = rsqrtf(fmaxf(sst, 1e-24f));
            BON[tok * 8 + h] = bt;
        }
        const unsigned psel = (r32 & 1) ? 0x03020706u : 0x05040100u;
#pragma unroll
        for (int nb = 0; nb < 2; ++nb)
#pragma unroll
            for (int g = 0; g < 4; ++g) {
                asm volatile("" ::: "memory");
                unsigned outw[10];
#pragma unroll
                for (int ts = 0; ts < 2; ++ts) {
                    const int wI = 2 * g + ts;
                    const h2_t q2 = __builtin_bit_cast(h2_t, QW[nb][wI]), a2 = __builtin_bit_cast(h2_t, AW[nb][wI]);
                    const float k0 = (float)q2[0] * rn[4 * g + ts], k1 = (float)q2[1] * rn[4 * g + ts + 2];
                    const unsigned mine[5] = {UW[nb][wI], pkh2(-k0, -k1), pkh2(k0 * (float)a2[0], k1 * (float)a2[1]), KW[nb][wI], RW[nb][wI]};
#pragma unroll
                    for (int q = 0; q < 5; ++q) { const unsigned oth = (unsigned)__builtin_amdgcn_mov_dpp((int)mine[q], 0xB1, 0xF, 0xF, true); outw[ts * 5 + q] = __builtin_amdgcn_perm(oth, mine[q], psel); }
                }
                const int tg = (tt0 >> 2) + 2 * g + hi, j2r = 16 * nb + (r32 >> 1);
                unsigned* dst = REC + ((size_t)bh * 512 + tg) * REC_TG + j2r * 20 + (j2r >> 4) * 4 + ((r32 & 1) ? 10 : 0);
#pragma unroll
                for (int k = 0; k < 5; ++k) { uint2 o2; o2.x = outw[2 * k]; o2.y = outw[2 * k + 1]; *(uint2*)(dst + 2 * k) = o2; }
            }
#undef PREP_TOK
#undef PREP_RB
    }
}

__device__ __forceinline__ float dpp_add(float x, float y_src, int) { return x + y_src; }
__device__ __forceinline__ float red32(float x) {
    x += SC_DPP(x, 0xB1); x += SC_DPP(x, 0x4E); x += SC_DPP(x, 0x141); x += SC_DPP(x, 0x140);
    auto rr = __builtin_amdgcn_permlane32_swap(__float_as_uint(x), __float_as_uint(x), false, false);
    return __uint_as_float(rr[0]) + __uint_as_float(rr[1]);
}
__device__ __forceinline__ float fmul_lo(float a, unsigned h) { float d; asm("v_fma_mix_f32 %0, %1, %2, 0 op_sel_hi:[0,1,0]" : "=v"(d) : "v"(a), "v"(h)); return d; }
__device__ __forceinline__ float fmix_lo(float a, unsigned h, float c) { float d; asm("v_fma_mix_f32 %0, %1, %2, %3 op_sel_hi:[0,1,0]" : "=v"(d) : "v"(a), "v"(h), "v"(c)); return d; }
__device__ __forceinline__ float fmix_hi(float a, unsigned h, float c) { float d; asm("v_fma_mix_f32 %0, %1, %2, %3 op_sel:[0,1,0] op_sel_hi:[0,1,0]" : "=v"(d) : "v"(a), "v"(h), "v"(c)); return d; }
__device__ __forceinline__ float fdec_lo(float sv, unsigned u) { float d; asm("v_fma_mix_f32 %0, -%1, %2, %1 op_sel_hi:[0,1,0]" : "=v"(d) : "v"(sv), "v"(u)); return d; }
__device__ __forceinline__ float fdec_hi(float sv, unsigned u) { float d; asm("v_fma_mix_f32 %0, -%1, %2, %1 op_sel:[0,1,0] op_sel_hi:[0,1,0]" : "=v"(d) : "v"(sv), "v"(u)); return d; }
template <int VH> __device__ __forceinline__ float fvk_lo(unsigned v, unsigned k, float c) { float d;
    if (VH) asm("v_fma_mix_f32 %0, %1, %2, %3 op_sel:[1,0,0] op_sel_hi:[1,1,0]" : "=v"(d) : "v"(v), "v"(k), "v"(c)); else asm("v_fma_mix_f32 %0, %1, %2, %3 op_sel:[0,0,0] op_sel_hi:[1,1,0]" : "=v"(d) : "v"(v), "v"(k), "v"(c)); return d; }
template <int VH> __device__ __forceinline__ float fvk_hi(unsigned v, unsigned k, float c) { float d;
    if (VH) asm("v_fma_mix_f32 %0, %1, %2, %3 op_sel:[1,1,0] op_sel_hi:[1,1,0]" : "=v"(d) : "v"(v), "v"(k), "v"(c)); else asm("v_fma_mix_f32 %0, %1, %2, %3 op_sel:[0,1,0] op_sel_hi:[1,1,0]" : "=v"(d) : "v"(v), "v"(k), "v"(c)); return d; }

__device__ __forceinline__ float red16(float x) {
    x += SC_DPP(x, 0xB1); x += SC_DPP(x, 0x4E); x += SC_DPP(x, 0x141); x += SC_DPP(x, 0x140);
    return x;
}
__device__ __forceinline__ float ffma(float a, float b, float c) { float d; asm("v_fma_f32 %0, %1, %2, %3" : "=v"(d) : "v"(a), "v"(b), "v"(c)); return d; }
__device__ __forceinline__ float fmul(float a, float b) { float d; asm("v_mul_f32 %0, %1, %2" : "=v"(d) : "v"(a), "v"(b)); return d; }
__device__ __forceinline__ float fnfma(float a, float b, float c) { float d; asm("v_fma_f32 %0, -%1, %2, %3" : "=v"(d) : "v"(a), "v"(b), "v"(c)); return d; }
__device__ __forceinline__ float h2f_lo(unsigned w) { float d; asm("v_cvt_f32_f16 %0, %1" : "=v"(d) : "v"(w)); return d; }
__device__ __forceinline__ float h2f_hi(unsigned w) { float d; asm("v_cvt_f32_f16_sdwa %0, %1 dst_sel:DWORD dst_unused:UNUSED_PAD src0_sel:WORD_1" : "=v"(d) : "v"(w)); return d; }
__device__ __forceinline__ void phase_scan(const Args& a, int l, PG8_LAS unsigned char* lds) {
    const int tid = tid_fresh(), lane = tid & 63, wid = __builtin_amdgcn_readfirstlane(tid >> 6);
    const int j2 = (lane & 15) | ((lane >> 5) << 4), rr = (lane >> 4) & 1;
    const char* REC = (const char*)(a.ws + WS_REC); const char* RVT = (const char*)(a.ws + WS_RVT);
    bf16_t* YR = (bf16_t*)(a.ws + WS_YRAW);
    constexpr int CSTEPS = 32, NCH = SEQ / CSTEPS, G_REC = 8 * REC_TG * 4  , CH_REC = 21 * 1024, CH_V = 4096, CH = CH_REC + CH_V, NPC = 25;
    constexpr int YB_LD = 68, YB_WAVE = 16 * YB_LD * 4;
    PG8_LAS float* yb = (PG8_LAS float*)(lds + 2 * CH + wid * YB_WAVE);
    float* scr = (float*)((unsigned char*)lds + 2 * CH + 8 * YB_WAVE) + (wid & 3) * (64 * 33);
    const bool cvw = wid < 4;
    const int cw = blockIdx.x * 4 + (wid & 3), NCW = gridDim.x * 4;
    int cvt_next = cvw ? cw : NEXP * 768; bool have = false; CvtItem ci; float4 cv[8];
    for (int u = blockIdx.x; u < 256; u += gridDim.x) {
        const int bh = u >> 2, rg = u & 3, b = bh >> 3, h = bh & 7;
        const int irow = rg * 16 + wid * 2 + rr;
        const char* grec = REC + (size_t)bh * NCH * G_REC; const char* gv = RVT + (size_t)bh * NCH * CH_V;
        float S0 = 0.f, S1 = 0.f;
        __syncthreads();
#define SCAN_DMA(chn, bufo) do { _Pragma("unroll") for (int k_ = 0; k_ < 4; ++k_) { const int pc_ = wid * 4 + k_; if (pc_ < NPC) { \
            const char* src_ = (pc_ < 21) ? grec + (size_t)(chn) * G_REC + pc_ * 1024 + lane * 16 : gv + (size_t)(chn) * CH_V + (pc_ - 21) * 1024 + lane * 16; \
            __builtin_amdgcn_global_load_lds((const unsigned*)src_, (PG8_LAS unsigned*)(lds + (bufo) + pc_ * 1024), 16, 0, 0); } } } while (0)
        SCAN_DMA(0, 0);
        for (int ch = 0; ch < NCH; ++ch) {
            asm volatile("s_waitcnt vmcnt(0)" ::: "memory");
            __syncthreads();
            if (ch + 1 < NCH) SCAN_DMA(ch + 1, ((ch + 1) & 1) * CH);
            if (have) { cvt_finish(ci, lane, cv, scr); have = false; }
            { const int cm = ch & 7; if (cvw && (cm == 0 || cm == 3 || cm == 5)) { if (cvt_decode(a, l, cvt_next, ci)) { cvt_load(ci, lane, cv); have = true; cvt_next += NCW; } } }
            PG8_LAS const unsigned char* bufp = lds + (ch & 1) * CH;
#define SCAN_LOADW(W, grp) do { PG8_LAS const unsigned char* rp_ = bufp + (grp) * (REC_TG * 4) + j2 * 80 + (j2 >> 4) * 16; _Pragma("unroll") for (int k_ = 0; k_ < 5; ++k_) { \
                const pg8::u32x4 q_ = *(PG8_LAS const pg8::u32x4*)(rp_ + 16 * k_); W[4 * k_] = q_.x; W[4 * k_ + 1] = q_.y; W[4 * k_ + 2] = q_.z; W[4 * k_ + 3] = q_.w; } } while (0)
#define SCAN_STEPS(W, hf) do { _Pragma("unroll") for (int ts = 0; ts < 4; ++ts) { \
                const unsigned wu = W[ts * 5], wa = W[ts * 5 + 1], wb = W[ts * 5 + 2], wk = W[ts * 5 + 3], wr_ = W[ts * 5 + 4]; \
                const unsigned vw = vv[(hf) * 2 + (ts >> 1)]; \
                const float sa = red32(fmix_hi(S1, wa, fmul_lo(S0, wa))); \
                float t0 = fdec_lo(S0, wu), t1 = fdec_hi(S1, wu); \
                if (ts & 1) { t0 = fvk_lo<1>(vw, wk, t0); t1 = fvk_hi<1>(vw, wk, t1); } else { t0 = fvk_lo<0>(vw, wk, t0); t1 = fvk_hi<0>(vw, wk, t1); } \
                S0 = fmix_lo(sa, wb, t0); S1 = fmix_hi(sa, wb, t1); \
                yb[((g8 & 1) * 8 + (hf) * 4 + ts) * YB_LD + rr * 32 + j2] = fmix_hi(S1, wr_, fmul_lo(S0, wr_)); } } while (0)
            unsigned wA[20], wB[20];
            SCAN_LOADW(wA, 0);
#pragma unroll 1
            for (int g8 = 0; g8 < 4; ++g8) {
                const pg8::u32x4 vv = *(PG8_LAS const pg8::u32x4*)(bufp + CH_REC + (g8 * 64 + irow) * 16);
                SCAN_LOADW(wB, g8 * 2 + 1);
                SCAN_STEPS(wA, 0);
                if (g8 < 3) SCAN_LOADW(wA, g8 * 2 + 2);
                SCAN_STEPS(wB, 1);
                if (g8 & 1) {
                    asm volatile("s_waitcnt lgkmcnt(0)" ::: "memory");
                    PG8_LAS const float* yp = yb + (j2 & 15) * YB_LD + rr * 32 + (j2 >> 4) * 16;
                    const pg8::f32x4 y0 = *(PG8_LAS const pg8::f32x4*)(yp), y1 = *(PG8_LAS const pg8::f32x4*)(yp + 4), y2 = *(PG8_LAS const pg8::f32x4*)(yp + 8), y3 = *(PG8_LAS const pg8::f32x4*)(yp + 12);
                    const pg8::f32x4 ys = (y0 + y1) + (y2 + y3);
                    float y = (ys[0] + ys[1]) + (ys[2] + ys[3]);
                    { auto sw = __builtin_amdgcn_permlane32_swap(__float_as_uint(y), __float_as_uint(y), false, false); y = __uint_as_float(sw[0]) + __uint_as_float(sw[1]); }
                    const int t = ch * CSTEPS + (g8 >> 1) * 16 + (j2 & 15);
                    if (j2 < 16) YR[((size_t)b * SEQ + t) * 512 + h * 64 + irow] = f2bf(y);
                    asm volatile("s_waitcnt lgkmcnt(0)" ::: "memory");
                }
            }
#undef SCAN_LOADW
#undef SCAN_STEPS
        }
#undef SCAN_DMA
    }
    if (have) cvt_finish(ci, lane, cv, scr);
    while (cvt_decode(a, l, cvt_next, ci)) { cvt_load(ci, lane, cv); cvt_finish(ci, lane, cv, scr); cvt_next += NCW; }
}

struct PostIn { uint4 vq; bf16_t y[8], rg[8]; float bon, gm, bt; };
__device__ __forceinline__ void post_load(const Args& a, int l, int u, int lane, PostIn& p) {
    const int bh = u >> 8, t8 = u & 255, b = bh >> 3, h = bh & 7; const size_t tok0 = (size_t)b * SEQ + t8 * 8; const int c = h * 64 + lane;
    const bf16_t* YR = (const bf16_t*)(a.ws + WS_YRAW); const bf16_t* RGp = (const bf16_t*)(a.ws + WS_RG);
    p.vq = *(const uint4*)(a.ws + WS_RVT + (((size_t)bh * 256 + t8) * 64 + lane) * 16);
#pragma unroll
    for (int k = 0; k < 8; ++k) { p.y[k] = YR[(tok0 + k) * 512 + c]; p.rg[k] = RGp[(tok0 + k) * 512 + c]; }
    p.bon = ((const float*)(a.ws + WS_BON))[(tok0 + (lane & 7)) * 8 + h];
    p.gm = a.in[16][l * 512 + c]; p.bt = a.in[17][l * 512 + c];
}
__device__ __forceinline__ void post_finish(const Args& a, int u, int lane, const PostIn& p) {
    const int bh = u >> 8, t8 = u & 255, b = bh >> 3, h = bh & 7; const size_t tok0 = (size_t)b * SEQ + t8 * 8; const int c = h * 64 + lane;
    bf16_t* MIX = (bf16_t*)(a.ws + WS_MIX);
    const unsigned vw[4] = {p.vq.x, p.vq.y, p.vq.z, p.vq.w};
#pragma unroll
    for (int k = 0; k < 8; ++k) {
        const float y = bf2f(p.y[k]);
        const float my = wsum(y) * (1.0f / 64.0f);
        const float dy = y - my;
        const float var = wsum(dy * dy) * (1.0f / 64.0f);
        const float yn = dy * rsqrtf(var + 64e-5f) * p.gm + p.bt;
        const float v = (k & 1) ? bfhi(vw[k >> 1]) : bflo(vw[k >> 1]);
        const float bon = __shfl(p.bon, k);
        MIX[(tok0 + k) * DM + 512 + c] = f2bf((yn + bon * v) * bf2f(p.rg[k]));
    }
}
__device__ __forceinline__ void phase_post(const Args& a, int l) {
    const int tid = tid_fresh(), lane = tid & 63, wid = tid >> 6;
    const int NW = gridDim.x * 8;
    int u = blockIdx.x * 8 + wid;
    PostIn p0, p1;
    if (u < 64 * 256) post_load(a, l, u, lane, p0);
    while (u < 64 * 256) {
        const int u1 = u + NW; const bool h1 = u1 < 64 * 256;
        if (h1) post_load(a, l, u1, lane, p1);
        post_finish(a, u, lane, p0);
        u = u1 + NW;
        if (!h1) break;
        if (u < 64 * 256) post_load(a, l, u, lane, p0);
        post_finish(a, u1, lane, p1);
    }
}

namespace att {
typedef short bf16x8 __attribute__((ext_vector_type(8)));
typedef short s16x4 __attribute__((ext_vector_type(4)));
typedef float f32x16 __attribute__((ext_vector_type(16)));
typedef __attribute__((address_space(3))) const unsigned char* lds_cptr;
constexpr int SLOT = 8192, L_K = 0, L_V = 2 * SLOT, L_WS = 4 * SLOT, L_KM = L_WS + 8 * 256, L_OST = L_KM + 2048, OST_LD = 68, L_END = L_OST + 8 * 32 * OST_LD * 4;
constexpr float C2 = 0.125f * 1.4426950408889634f;
__device__ __forceinline__ int crow(int r, int hi) { return (r & 3) + 8 * (r >> 2) + 4 * hi; }
__device__ __forceinline__ s16x4 vtr(lds_cptr p) { return __builtin_bit_cast(s16x4, __builtin_amdgcn_ds_read_tr16_b64_v4i16((__attribute__((address_space(3))) s16x4*)p)); }
__device__ __forceinline__ float swapmax(float x) { auto rr = __builtin_amdgcn_permlane32_swap(__float_as_uint(x), __float_as_uint(x), false, false); return fmaxf(__uint_as_float(rr[0]), __uint_as_float(rr[1])); }
__device__ __forceinline__ float swapsum(float x) { auto rr = __builtin_amdgcn_permlane32_swap(__float_as_uint(x), __float_as_uint(x), false, false); return __uint_as_float(rr[0]) + __uint_as_float(rr[1]); }

__device__ __forceinline__ void unit(const Args& a, int l, int b, int h, int cur, PG8_LAS unsigned char* lds) {
    const int tid = tid_fresh(), lane = tid & 63, r32 = lane & 31, hi = lane >> 5, wid = __builtin_amdgcn_readfirstlane(tid >> 6);
    const bf16_t* Zb = (const bf16_t*)(a.ws + WS_Z) + (size_t)b * SEQ * ZLD;
    const int qrel = wid * 32 + r32, qpos = cur * 256 + qrel;
    PG8_LAS float* wsf = (PG8_LAS float*)(lds + L_WS) + wid * 64;
    PG8_LAS float* kmf = (PG8_LAS float*)(lds + L_KM);
    __syncthreads();
    kmf[tid] = ((const float*)(a.ws + WS_KMEAN))[(size_t)(b * NH + h) * 512 + tid];
    const bf16_t* ksrc = Zb + (size_t)lane * ZLD + C_K + h * HD + wid * 8;
    const bf16_t* vsrc = Zb + (size_t)(16 * (wid & 3) + (lane >> 2)) * ZLD + C_V + h * HD + (wid >> 2) * 32 + (lane & 3) * 8;
#define ATT_DMA(kpos0, slot) do { \
        __builtin_amdgcn_global_load_lds((const unsigned*)(ksrc + (size_t)(kpos0) * ZLD), (PG8_LAS unsigned*)(lds + L_K + (slot) * SLOT + wid * 1024), 16, 0, 0); \
        __builtin_amdgcn_global_load_lds((const unsigned*)(vsrc + (size_t)(kpos0) * ZLD), (PG8_LAS unsigned*)(lds + L_V + (slot) * SLOT + wid * 1024), 16, 0, 0); } while (0)
    ATT_DMA(cur * 256, 0);
    bf16x8 qr[4];
#pragma unroll
    for (int d0 = 0; d0 < 4; ++d0) qr[d0] = *(const bf16x8*)(Zb + (size_t)qpos * ZLD + C_Q + h * HD + d0 * 16 + hi * 8);
    __syncthreads();
    unsigned selbits = 0u;
    {
        float g[8];
#pragma unroll
        for (int n = 0; n < 8; ++n) g[n] = 0.f;
#pragma unroll
        for (int d0 = 0; d0 < 4; ++d0)
#pragma unroll
            for (int j = 0; j < 8; ++j) { const float qv = bf2f((bf16_t)qr[d0][j]);
#pragma unroll
                for (int n = 0; n < 8; ++n) g[n] = fmaf(qv, kmf[n * 64 + d0 * 16 + hi * 8 + j], g[n]); }
#pragma unroll
        for (int n = 0; n < 8; ++n) g[n] = (n < cur) ? swapsum(g[n]) : NEG_INF;
        if (cur <= 3) selbits = (1u << cur) - 1u;
        else {
            int s0 = -1, s1 = -1, s2 = -1; float bv = -3e38f;
#pragma unroll
            for (int n = 0; n < 8; ++n) if (g[n] > bv) { bv = g[n]; s0 = n; }
            bv = -3e38f;
#pragma unroll
            for (int n = 0; n < 8; ++n) if (n != s0 && g[n] > bv) { bv = g[n]; s1 = n; }
            bv = -3e38f;
#pragma unroll
            for (int n = 0; n < 8; ++n) if (n != s0 && n != s1 && g[n] > bv) { bv = g[n]; s2 = n; }
            selbits = (1u << s0) | (1u << s1) | (1u << s2);
        }
    }
    const float s8 = 8.0f * exp2f(-(float)(h + 1));
    f32x16 base;
#pragma unroll
    for (int r = 0; r < 16; ++r) base[r] = s8 * (float)crow(r, hi);
    f32x16 o0, o1;
#pragma unroll
    for (int r = 0; r < 16; ++r) { o0[r] = 0.f; o1[r] = 0.f; }
    float m = -INFINITY, lsum = 0.f;
    const int NT = 4 * (cur + 1);
    const lds_cptr kp = (lds_cptr)(lds + L_K) + hi * 1024 + r32 * 16;
    const lds_cptr vp = (lds_cptr)(lds + L_V) + ((lane >> 4) & 1) * 32 + (lane & 3) * 8 + (4 * hi + ((lane & 15) >> 2)) * 64;
    for (int it = 0; it < NT; ++it) {
        asm volatile("s_waitcnt vmcnt(0)" ::: "memory");
        __syncthreads();
        const int blk = (it < 4) ? cur : ((it >> 2) - 1);
        const int kpos0 = blk * 256 + (it & 3) * 64;
        if (it + 1 < NT) { const int nblk = (it + 1 < 4) ? cur : (((it + 1) >> 2) - 1); ATT_DMA(nblk * 256 + ((it + 1) & 3) * 64, (it + 1) & 1); }
        const int so = (it & 1) * SLOT;
        f32x16 p0 = base, p1 = base;
#pragma unroll
        for (int d0 = 0; d0 < 4; ++d0) {
            const bf16x8 k0 = *(const __attribute__((address_space(3))) bf16x8*)(kp + so + d0 * 2048);
            const bf16x8 k1 = *(const __attribute__((address_space(3))) bf16x8*)(kp + so + d0 * 2048 + 512);
            p0 = __builtin_amdgcn_mfma_f32_32x32x16_bf16(k0, qr[d0], p0, 0, 0, 0);
            p1 = __builtin_amdgcn_mfma_f32_32x32x16_bf16(k1, qr[d0], p1, 0, 0, 0);
        }
        const bool rowsel = (it < 4) || ((selbits >> blk) & 1u);
        const float cb = rowsel ? -s8 * (float)(qpos - kpos0) : -INFINITY;
        const float cb1 = cb + s8 * 32.0f;
        if (it < 4) {
            const int kb0 = (it & 3) * 64 + 4 * hi;
#pragma unroll
            for (int r = 0; r < 16; ++r) { const int kv = kb0 + (r & 3) + 8 * (r >> 2); if (kv > qrel) p0[r] = -INFINITY; if (kv + 32 > qrel) p1[r] = -INFINITY; }
        }
        float mx0 = p0[0], mx1 = p1[0];
#pragma unroll
        for (int r = 1; r < 16; ++r) { mx0 = fmaxf(mx0, p0[r]); mx1 = fmaxf(mx1, p1[r]); }
        const float mx = swapmax(fmaxf(mx0 + cb, mx1 + cb1));
        if (__any((mx - m) * C2 > 6.0f)) {
            const float mn = fmaxf(m, mx);
            const float alpha = __builtin_amdgcn_exp2f((m - mn) * C2);
            m = mn; lsum *= alpha;
            asm volatile("s_waitcnt lgkmcnt(0)" ::: "memory");
            if (hi == 0) wsf[r32] = alpha;
            asm volatile("s_waitcnt lgkmcnt(0)" ::: "memory");
#pragma unroll
            for (int r = 0; r < 16; ++r) { const float al = wsf[crow(r, hi)]; o0[r] *= al; o1[r] *= al; }
        }
        const float tb0 = (cb - m) * C2, tb1 = (cb1 - m) * C2;
        float ls = 0.f;
#pragma unroll
        for (int r = 0; r < 16; ++r) { p0[r] = __builtin_amdgcn_exp2f(fmaf(p0[r], C2, tb0)); p1[r] = __builtin_amdgcn_exp2f(fmaf(p1[r], C2, tb1)); ls += p0[r] + p1[r]; }
        lsum += ls;
        pg8::u32x4 w0, w1, w2, w3;
        w0.x = pk2(p0[0], p0[1]); w0.y = pk2(p0[2], p0[3]); w0.z = pk2(p0[4], p0[5]); w0.w = pk2(p0[6], p0[7]);
        w1.x = pk2(p0[8], p0[9]); w1.y = pk2(p0[10], p0[11]); w1.z = pk2(p0[12], p0[13]); w1.w = pk2(p0[14], p0[15]);
        w2.x = pk2(p1[0], p1[1]); w2.y = pk2(p1[2], p1[3]); w2.z = pk2(p1[4], p1[5]); w2.w = pk2(p1[6], p1[7]);
        w3.x = pk2(p1[8], p1[9]); w3.y = pk2(p1[10], p1[11]); w3.z = pk2(p1[12], p1[13]); w3.w = pk2(p1[14], p1[15]);
        const bf16x8 pa0 = __builtin_bit_cast(bf16x8, w0), pa1 = __builtin_bit_cast(bf16x8, w1), pa2 = __builtin_bit_cast(bf16x8, w2), pa3 = __builtin_bit_cast(bf16x8, w3);
#define ATT_VF(d0, ks) ({ const s16x4 lo_ = vtr(vp + so + (d0) * 4096 + (ks) * 1024), hi_ = vtr(vp + so + (d0) * 4096 + (ks) * 1024 + 512); \
        (bf16x8){lo_[0], lo_[1], lo_[2], lo_[3], hi_[0], hi_[1], hi_[2], hi_[3]}; })
        o0 = __builtin_amdgcn_mfma_f32_32x32x16_bf16(pa0, ATT_VF(0, 0), o0, 0, 0, 0);
        o1 = __builtin_amdgcn_mfma_f32_32x32x16_bf16(pa0, ATT_VF(1, 0), o1, 0, 0, 0);
        o0 = __builtin_amdgcn_mfma_f32_32x32x16_bf16(pa1, ATT_VF(0, 1), o0, 0, 0, 0);
        o1 = __builtin_amdgcn_mfma_f32_32x32x16_bf16(pa1, ATT_VF(1, 1), o1, 0, 0, 0);
        o0 = __builtin_amdgcn_mfma_f32_32x32x16_bf16(pa2, ATT_VF(0, 2), o0, 0, 0, 0);
        o1 = __builtin_amdgcn_mfma_f32_32x32x16_bf16(pa2, ATT_VF(1, 2), o1, 0, 0, 0);
        o0 = __builtin_amdgcn_mfma_f32_32x32x16_bf16(pa3, ATT_VF(0, 3), o0, 0, 0, 0);
        o1 = __builtin_amdgcn_mfma_f32_32x32x16_bf16(pa3, ATT_VF(1, 3), o1, 0, 0, 0);
#undef ATT_VF
    }
#undef ATT_DMA
    const float lt = swapsum(lsum);
    asm volatile("s_waitcnt lgkmcnt(0)" ::: "memory");
    if (hi == 0) wsf[r32] = 1.0f / lt;
    asm volatile("s_waitcnt lgkmcnt(0)" ::: "memory");
    PG8_LAS float* stg = (PG8_LAS float*)(lds + L_OST) + wid * (32 * OST_LD);
#pragma unroll
    for (int r = 0; r < 16; ++r) { const int orow = crow(r, hi); const float il = wsf[orow]; stg[orow * OST_LD + r32] = o0[r] * il; stg[orow * OST_LD + 32 + r32] = o1[r] * il; }
    asm volatile("s_waitcnt lgkmcnt(0)" ::: "memory");
    const float* gain = a.in[18] + l * 512 + h * HD;
    bf16_t* MIX = (bf16_t*)(a.ws + WS_MIX);
#pragma unroll
    for (int i = 0; i < 4; ++i) {
        const int row = i * 8 + (lane >> 3), ch = lane & 7;
        const pg8::f32x4 va = *(PG8_LAS const pg8::f32x4*)(stg + row * OST_LD + ch * 8), vb = *(PG8_LAS const pg8::f32x4*)(stg + row * OST_LD + ch * 8 + 4);
        float ss = va[0] * va[0] + va[1] * va[1] + va[2] * va[2] + va[3] * va[3] + vb[0] * vb[0] + vb[1] * vb[1] + vb[2] * vb[2] + vb[3] * vb[3];
        ss += SC_DPP(ss, 0xB1); ss += SC_DPP(ss, 0x4E); ss += SC_DPP(ss, 0x141);
        const float rs = rsqrtf(ss * (1.0f / 64.0f) + 1e-6f);
        const pg8::f32x4 ga = *(const pg8::f32x4*)(gain + ch * 8), gb = *(const pg8::f32x4*)(gain + ch * 8 + 4);
        pg8::u32x4 w; w.x = pk2(va[0] * rs * ga[0], va[1] * rs * ga[1]); w.y = pk2(va[2] * rs * ga[2], va[3] * rs * ga[3]);
        w.z = pk2(vb[0] * rs * gb[0], vb[1] * rs * gb[1]); w.w = pk2(vb[2] * rs * gb[2], vb[3] * rs * gb[3]);
        *(pg8::u32x4*)(MIX + ((size_t)b * SEQ + cur * 256 + wid * 32 + row) * DM + h * HD + ch * 8) = w;
    }
}
}

__device__ __forceinline__ void phase_att(const Args& a, int l, PG8_LAS unsigned char* lds) {
    const int G = gridDim.x, bx = blockIdx.x;
    const int v = (G % 8 == 0) ? (bx % 8) * (G / 8) + bx / 8 : bx;
    for (int w = v; w < 256; w += G) {
        const int bh = w >> 2, s = w & 3;
        att::unit(a, l, bh >> 3, bh & 7, 7 - s, lds);
        att::unit(a, l, bh >> 3, bh & 7, s, lds);
    }
}

constexpr int CK_STRIDE = 4 * REC_TG * 4, CK_FR = 2048, CK_FM1 = 4096, CK_FM2 = 4608, CK_FBK = 5120, CK_W = 9216;
__device__ __forceinline__ void phase_prep2(const Args& a, float* lds, const bool probe = false) {
    typedef float f32x4 __attribute__((ext_vector_type(4)));
    const int tid = tid_fresh(), lane0 = tid & 63, wid = tid >> 6;
    float* L = lds + wid * 4352;
    unsigned char* REC = a.ws + WS_REC;
    for (int task = blockIdx.x * 8 + wid; task < 64 * 128; task += gridDim.x * 8) {
        int lane = lane0; asm volatile("" : "+v"(lane));
        const int bh = task >> 7, c = task & 127, j = lane, j2 = j >> 1, hf = j & 1;
        unsigned char* blob = REC + ((size_t)bh * 512 + 4 * c) * (REC_TG * 4);
        unsigned char* ob = probe ? a.ws + WS_MIX + (size_t)(task & 2047) * 10304 : blob;
        float w[16], av[16], bv[16], kv[16], rv[16];
#pragma unroll
        for (int tg = 0; tg < 4; ++tg) {
            const unsigned* rp = (const unsigned*)(blob + (size_t)tg * (REC_TG * 4)) + j2 * 20 + (j2 >> 4) * 4;
            unsigned wd[20];
#pragma unroll
            for (int q = 0; q < 5; ++q) { const uint4 x = *(const uint4*)(rp + 4 * q); wd[4 * q] = x.x; wd[4 * q + 1] = x.y; wd[4 * q + 2] = x.z; wd[4 * q + 3] = x.w; }
#pragma unroll
            for (int ts = 0; ts < 4; ++ts) { const int s_ = tg * 4 + ts;
#define P2H(q) ({ const h2_t h_ = __builtin_bit_cast(h2_t, wd[ts * 5 + (q)]); (float)(hf ? h_[1] : h_[0]); })
                w[s_] = 1.0f - P2H(0); av[s_] = P2H(1); bv[s_] = P2H(2); kv[s_] = P2H(3); rv[s_] = P2H(4);
#undef P2H
            }
        }
        asm volatile("s_waitcnt vmcnt(0)" ::: "memory");
        float ah[16], rh[16];
        {
            float Wc = 1.0f, bh_[16], kh_[16];
#pragma unroll
            for (int s_ = 0; s_ < 16; ++s_) { ah[s_] = av[s_] * Wc; Wc *= w[s_]; rh[s_] = rv[s_] * Wc; const float iw = 1.0f / Wc; bh_[s_] = bv[s_] * iw; kh_[s_] = kv[s_] * iw; }
#pragma unroll
            for (int s_ = 0; s_ < 16; ++s_) { L[s_ * 68 + j] = bh_[s_]; L[1088 + s_ * 68 + j] = kh_[s_]; L[2176 + s_ * 68 + j] = ah[s_]; L[3264 + s_ * 68 + j] = rh[s_]; }
#pragma unroll
            for (int g = 0; g < 4; ++g) { uint4 o; o.x = pk2(bh_[4 * g] * Wc, bh_[4 * g + 1] * Wc); o.y = pk2(bh_[4 * g + 2] * Wc, bh_[4 * g + 3] * Wc);
                o.z = pk2(kh_[4 * g] * Wc, kh_[4 * g + 1] * Wc); o.w = pk2(kh_[4 * g + 2] * Wc, kh_[4 * g + 3] * Wc);
                *(uint4*)(ob + CK_FBK + (j >> 4) * 1024 + ((j & 15) + 16 * g) * 16) = o; }
            *(float*)(ob + CK_W + j * 4) = Wc;
        }
        asm volatile("s_waitcnt lgkmcnt(0)" ::: "memory");
        { const int rI = lane & 15, gI = lane >> 4;
          f32x4 gab = {0.f, 0.f, 0.f, 0.f}, gak = gab, gbr = gab, gkr = gab;
#pragma unroll 4
          for (int kk = 0; kk < 16; ++kk) { const int o = rI * 68 + 4 * kk + gI;
            const float aB = L[o], aK = L[1088 + o], bA = L[2176 + o], bR = L[3264 + o];
            gab = __builtin_amdgcn_mfma_f32_16x16x4f32(aB, bA, gab, 0, 0, 0); gak = __builtin_amdgcn_mfma_f32_16x16x4f32(aK, bA, gak, 0, 0, 0);
            gbr = __builtin_amdgcn_mfma_f32_16x16x4f32(aB, bR, gbr, 0, 0, 0); gkr = __builtin_amdgcn_mfma_f32_16x16x4f32(aK, bR, gkr, 0, 0, 0); }
          asm volatile("s_waitcnt lgkmcnt(0)" ::: "memory");
          f32x4 nab, nbr;
#pragma unroll
          for (int e = 0; e < 4; ++e) { const int s_ = 4 * gI + e; nab[e] = (s_ < rI) ? gab[e] : 0.f; nbr[e] = (s_ <= rI) ? gbr[e] : 0.f;
              L[512 + s_ * 16 + rI] = (s_ < rI) ? gak[e] : 0.f; L[768 + s_ * 16 + rI] = (s_ <= rI) ? gkr[e] : 0.f; }
          *(f32x4*)&L[rI * 16 + 4 * gI] = nab; *(f32x4*)&L[256 + rI * 16 + 4 * gI] = nbr;
        }
        asm volatile("s_waitcnt lgkmcnt(0)" ::: "memory");
        { bf16_t* IM = (bf16_t*)((unsigned char*)L + 4096);
          const int ks = j >> 5, jw = j & 31, g = (jw & 15) >> 2, jj = ((jw >> 4) << 2) | (jw & 3);
          const int sp = lane & 15, oA = ks * 512 + (16 * g) * 8 + jj, oM = 2048 + (16 * (sp >> 2)) * 8 + (sp & 3);
          const bool mw = lane < 16;
          float x[16], m1[16];
#pragma unroll
          for (int t = 0; t < 16; ++t) {
            float nt[16], nr[16];
#pragma unroll
            for (int q = 0; q < 4; ++q) { const f32x4 v = *(const f32x4*)&L[t * 16 + 4 * q]; nt[4 * q] = v[0]; nt[4 * q + 1] = v[1]; nt[4 * q + 2] = v[2]; nt[4 * q + 3] = v[3];
                                          const f32x4 u = *(const f32x4*)&L[256 + t * 16 + 4 * q]; nr[4 * q] = u[0]; nr[4 * q + 1] = u[1]; nr[4 * q + 2] = u[2]; nr[4 * q + 3] = u[3]; }
            float xa = ah[t], ma = L[512 + sp * 16 + t], ra = rh[t], mb = L[768 + sp * 16 + t];
#pragma unroll
            for (int s_ = 0; s_ < 16; ++s_) if (s_ < t) { xa = fmaf(x[s_], nt[s_], xa); ma = fmaf(m1[s_], nt[s_], ma); }
            x[t] = xa; m1[t] = ma;
#pragma unroll
            for (int s_ = 0; s_ < 16; ++s_) if (s_ <= t) { ra = fmaf(x[s_], nr[s_], ra); mb = fmaf(m1[s_], nr[s_], mb); }
            IM[oA + t * 8] = f2bf(xa); IM[1024 + oA + t * 8] = f2bf(ra);
            if (mw) { IM[oM + t * 8] = f2bf(ma); IM[4 + oM + t * 8] = f2bf(mb); }
            asm volatile("" ::: "memory");
          }
          asm volatile("s_waitcnt lgkmcnt(0)" ::: "memory");
          const uint4* IMq = (const uint4*)IM;
          *(uint4*)(ob + lane * 16) = IMq[lane]; *(uint4*)(ob + 1024 + lane * 16) = IMq[64 + lane];
          *(uint4*)(ob + CK_FR + lane * 16) = IMq[128 + lane]; *(uint4*)(ob + CK_FR + 1024 + lane * 16) = IMq[192 + lane];
          *(uint4*)(ob + CK_FM1 + lane * 16) = IMq[256 + lane];
        }
        asm volatile("s_waitcnt lgkmcnt(0)" ::: "memory");
    }
}
__device__ __forceinline__ int scan2_unit(const Args& a, int l, int u, PG8_LAS unsigned char* lds, int cvt_k0, const int mode = 0) {
    typedef short bf16x8 __attribute__((ext_vector_type(8)));
    typedef float f32x4 __attribute__((ext_vector_type(4)));
    const int tid = tid_fresh(), lane = tid & 63, wid = __builtin_amdgcn_readfirstlane(tid >> 6);
    const int bh = u >> 2, rg = u & 3, b = bh >> 3, h = bh & 7;
    const int i16 = lane & 15, g = lane >> 4, irow = rg * 16 + i16;
    const unsigned char* REC = a.ws + WS_REC; const unsigned char* RVB = a.ws + WS_RVT; const unsigned char* ZERO = a.ws + 32768;
    bf16_t* YR = (bf16_t*)(a.ws + WS_YRAW);
    constexpr int DEPTH = 6, SLOTB = 11264, NCK = SEQ / 16, FLG_OFF = DEPTH * SLOTB, SCR_OFF = FLG_OFF + 256, CVT_PER_WG = 96;
    constexpr int L_FMM = 4096, L_FBK = 5120, L_V = 9216, L_W = 10240;
    volatile PG8_LAS unsigned* flg = (volatile PG8_LAS unsigned*)(lds + FLG_OFF);
#define S2_BLOB(c) (REC + ((size_t)bh * 512 + 4 * (c)) * (REC_TG * 4))
#define S2_SLOT(c) (lds + ((c) % DEPTH) * SLOTB)
#define S2_G2L(src_, dst_) __builtin_amdgcn_global_load_lds((const unsigned*)(src_), (PG8_LAS unsigned*)(dst_), 16, 0, 0)
#define S2_ISSUE_A(c) do { const unsigned char* bl_ = S2_BLOB(c) + lane * 16; PG8_LAS unsigned char* sl_ = S2_SLOT(c); \
        S2_G2L(bl_, sl_); S2_G2L(bl_ + 1024, sl_ + 1024); S2_G2L(bl_ + 2048, sl_ + 2048); S2_G2L(bl_ + 3072, sl_ + 3072); S2_G2L(bl_ + CK_FM1, sl_ + L_FMM); \
        S2_G2L(RVB + (((size_t)bh * 256 + 2 * (c) + (g >> 1)) * 64 + irow) * 16, sl_ + L_V); } while (0)
#define S2_ISSUE_B(c) do { const unsigned char* bl_ = S2_BLOB(c) + lane * 16; PG8_LAS unsigned char* sl_ = S2_SLOT(c); \
        S2_G2L(bl_ + CK_FBK, sl_ + L_FBK); S2_G2L(bl_ + CK_FBK + 1024, sl_ + L_FBK + 1024); S2_G2L(bl_ + CK_FBK + 2048, sl_ + L_FBK + 2048); S2_G2L(bl_ + CK_FBK + 3072, sl_ + L_FBK + 3072); \
        S2_G2L(S2_BLOB(c) + CK_W + (lane & 15) * 16, sl_ + L_W); } while (0)
    asm volatile("s_waitcnt vmcnt(0) lgkmcnt(0)" ::: "memory"); __builtin_amdgcn_s_barrier(); asm volatile("" ::: "memory");
    if (tid == 0) { flg[0] = 0u; flg[1] = 0u; flg[2] = 0u; flg[3] = 0u; flg[4] = (unsigned)cvt_k0; }
    asm volatile("s_waitcnt lgkmcnt(0)" ::: "memory"); __builtin_amdgcn_s_barrier(); asm volatile("" ::: "memory");
    if (wid == 0) {
        typedef short s16x4_ __attribute__((ext_vector_type(4)));
        typedef unsigned u32x2_ __attribute__((ext_vector_type(2)));
        f32x4 ST[4];
#pragma unroll
        for (int q = 0; q < 4; ++q) ST[q] = (f32x4){0.f, 0.f, 0.f, 0.f};
        unsigned known = 0u;
        struct Frag { bf16x8 fa0, fa1, fr0, fr1, fbk[4]; pg8::u32x4 fmm, v4w; f32x4 wv[4]; };
#define S2_WAITRDY(cc) do { while (known < (unsigned)((cc) + 1)) { const unsigned r0_ = flg[0], r1_ = flg[1]; known = r0_ < r1_ ? r0_ : r1_; if (known < (unsigned)((cc) + 1)) __builtin_amdgcn_s_sleep(1); } asm volatile("" ::: "memory"); } while (0)
#define S2_LOAD(X, cc) do { PG8_LAS const unsigned char* sl0_ = S2_SLOT(cc); PG8_LAS const unsigned char* sl_ = sl0_ + lane * 16; \
            X.fa0 = *(PG8_LAS const bf16x8*)(sl_); X.fa1 = *(PG8_LAS const bf16x8*)(sl_ + 1024); X.fr0 = *(PG8_LAS const bf16x8*)(sl_ + 2048); X.fr1 = *(PG8_LAS const bf16x8*)(sl_ + 3072); \
            X.fmm = *(PG8_LAS const pg8::u32x4*)(sl_ + L_FMM); X.v4w = *(PG8_LAS const pg8::u32x4*)(sl_ + L_V); \
            _Pragma("unroll") for (int jt = 0; jt < 4; ++jt) { X.fbk[jt] = *(PG8_LAS const bf16x8*)(sl_ + L_FBK + jt * 1024); X.wv[jt] = *(PG8_LAS const f32x4*)(sl0_ + L_W + (16 * jt + 4 * g) * 4); } \
            { const unsigned r0_ = flg[0], r1_ = flg[1]; known = r0_ < r1_ ? r0_ : r1_; } \
            asm volatile("" ::: "memory"); flg[2] = (unsigned)((cc) + 1); asm volatile("" ::: "memory"); } while (0)
#define S2_COMP(X, cc) do { \
            pg8::u32x4 s0, s1; \
            s0.x = pk2(ST[0][0], ST[0][1]); s0.y = pk2(ST[0][2], ST[0][3]); s0.z = pk2(ST[1][0], ST[1][1]); s0.w = pk2(ST[1][2], ST[1][3]); \
            s1.x = pk2(ST[2][0], ST[2][1]); s1.y = pk2(ST[2][2], ST[2][3]); s1.z = pk2(ST[3][0], ST[3][1]); s1.w = pk2(ST[3][2], ST[3][3]); \
            const bf16x8 sb0 = __builtin_bit_cast(bf16x8, s0), sb1 = __builtin_bit_cast(bf16x8, s1); \
            const u32x2_ vh_ = {(g & 1) ? X.v4w.z : X.v4w.x, (g & 1) ? X.v4w.w : X.v4w.y}, m1_ = {X.fmm.x, X.fmm.y}, m2_ = {X.fmm.z, X.fmm.w}; \
              \
            const pg8::u32x4 vq_ = {vh_[0], vh_[1], 0u, 0u}, q1_ = {m1_[0], m1_[1], 0u, 0u}, q2_ = {m2_[0], m2_[1], 0u, 0u}; \
            const bf16x8 vh = __builtin_bit_cast(bf16x8, vq_), fm1 = __builtin_bit_cast(bf16x8, q1_), fm2 = __builtin_bit_cast(bf16x8, q2_); \
            f32x4 PT = {0.f, 0.f, 0.f, 0.f}, YT = PT; \
            PT = __builtin_amdgcn_mfma_f32_16x16x32_bf16(X.fa0, sb0, PT, 0, 0, 0); YT = __builtin_amdgcn_mfma_f32_16x16x32_bf16(X.fr0, sb0, YT, 0, 0, 0); \
            PT = __builtin_amdgcn_mfma_f32_16x16x32_bf16(X.fa1, sb1, PT, 0, 0, 0); YT = __builtin_amdgcn_mfma_f32_16x16x32_bf16(X.fr1, sb1, YT, 0, 0, 0); \
            PT = __builtin_amdgcn_mfma_f32_16x16x32_bf16(fm1, vh, PT, 0, 0, 0);  YT = __builtin_amdgcn_mfma_f32_16x16x32_bf16(fm2, vh, YT, 0, 0, 0); \
            pg8::u32x4 pv; pv.x = pk2(PT[0], PT[1]); pv.y = pk2(PT[2], PT[3]); pv.z = vh_[0]; pv.w = vh_[1]; \
            const bf16x8 pvb = __builtin_bit_cast(bf16x8, pv); \
            _Pragma("unroll") for (int jt = 0; jt < 4; ++jt) ST[jt] = __builtin_amdgcn_mfma_f32_16x16x32_bf16(X.fbk[jt], pvb, ST[jt] * X.wv[jt], 0, 0, 0); \
            const size_t tok = (size_t)b * SEQ + 16 * (cc) + 4 * g; \
            _Pragma("unroll") for (int e = 0; e < 4; ++e) if (mode == 0 || YT[e] == 12345.678f) YR[(tok + e) * 512 + h * 64 + irow] = f2bf(YT[e]); } while (0)
        if (mode == 2) {
            for (int c = 0; c < NCK; ++c) { S2_WAITRDY(c); { const unsigned r0 = flg[0], r1 = flg[1]; known = r0 < r1 ? r0 : r1; } flg[2] = (unsigned)(c + 1); }
        } else {
            Frag F, G;
            S2_WAITRDY(0); S2_LOAD(F, 0);
            for (int c = 0; c < NCK; c += 2) {
                S2_WAITRDY(c + 1); S2_LOAD(G, c + 1);
                S2_COMP(F, c);
                if (c + 2 < NCK) { S2_WAITRDY(c + 2); S2_LOAD(F, c + 2); }
                S2_COMP(G, c + 1);
            }
        }
#undef S2_WAITRDY
#undef S2_LOAD
#undef S2_COMP
        asm volatile("" ::: "memory");
        flg[3] = 1u;
    } else if (wid == 4 || wid == 5) {
        const int d = wid - 4;
        if (mode != 1) { if (d == 0) { for (int c = 0; c < DEPTH - 1; ++c) S2_ISSUE_A(c); } else { for (int c = 0; c < DEPTH - 1; ++c) S2_ISSUE_B(c); } }
        if (mode == 1) flg[d] = (unsigned)NCK;
        for (int c = (mode == 1 ? NCK : 0); c < NCK; ++c) {
            if (mode == 1) {} else if (NCK - 1 - c >= DEPTH - 2) { if (d == 0) asm volatile("s_waitcnt vmcnt(%0)" :: "n"((DEPTH - 2) * 6) : "memory"); else asm volatile("s_waitcnt vmcnt(%0)" :: "n"((DEPTH - 2) * 5) : "memory"); }
            else asm volatile("s_waitcnt vmcnt(0)" ::: "memory");
            flg[d] = (unsigned)(c + 1);
            asm volatile("" ::: "memory");
            const int cn = c + DEPTH - 1;
            if (cn < NCK) {
                while (flg[2] < (unsigned)c) __builtin_amdgcn_s_sleep(2);
                asm volatile("" ::: "memory");
                if (mode != 1) { if (d == 0) S2_ISSUE_A(cn); else S2_ISSUE_B(cn); }
            }
        }
    } else {
        const int rank = (wid < 4) ? wid - 1 : wid - 3;
        float* scr = (float*)((unsigned char*)lds + SCR_OFF) + rank * (64 * 33);
        unsigned* ctr = (unsigned*)((unsigned char*)lds + FLG_OFF + 16);
        const int G = gridDim.x, bx = blockIdx.x;
        CvtItem cA, cB; float4 vA[8], vB[8];
#define S2_GRAB(cI, hI) do { int k_ = -1; if (flg[3] == 0u) { unsigned kk_ = 0u; if (lane == 0) kk_ = atomicAdd(ctr, 1u); k_ = __builtin_amdgcn_readfirstlane((int)kk_); } \
            hI = (k_ >= 0) && (k_ < CVT_PER_WG) && cvt_decode(a, l, bx * 8 + (k_ & 7) + G * 8 * (k_ >> 3), cI); } while (0)
        bool hA, hB;
        S2_GRAB(cA, hA); if (hA) cvt_load(cA, lane, vA);
        while (hA) {
            S2_GRAB(cB, hB); if (hB) cvt_load(cB, lane, vB);
            cvt_finish(cA, lane, vA, scr);
            if (!hB) break;
            S2_GRAB(cA, hA); if (hA) cvt_load(cA, lane, vA);
            cvt_finish(cB, lane, vB, scr);
        }
#undef S2_GRAB
    }
    asm volatile("s_waitcnt vmcnt(0) lgkmcnt(0)" ::: "memory"); __builtin_amdgcn_s_barrier(); asm volatile("" ::: "memory");
    const unsigned kn = flg[4];
    asm volatile("s_waitcnt lgkmcnt(0)" ::: "memory"); __builtin_amdgcn_s_barrier(); asm volatile("" ::: "memory");
#undef S2_BLOB
#undef S2_SLOT
#undef S2_G2L
#undef S2_ISSUE_A
#undef S2_ISSUE_B
    return __builtin_amdgcn_readfirstlane((int)(kn < (unsigned)CVT_PER_WG ? kn : (unsigned)CVT_PER_WG));
}

__device__ __forceinline__ void scan32(const Args& a, int l, int j, PG8_LAS unsigned char* lds) {
    const int tid = tid_fresh(), lane = tid & 63, wid = __builtin_amdgcn_readfirstlane(tid >> 6);
    const int jq = lane & 15, rr = lane >> 4;
    const char* REC = (const char*)(a.ws + WS_REC); const char* RVT = (const char*)(a.ws + WS_RVT);
    bf16_t* YR = (bf16_t*)(a.ws + WS_YRAW);
    constexpr int CSTEPS = 32, NCH = SEQ / CSTEPS, G_REC = 8 * REC_TG * 4, CH_REC = 21 * 1024, CH_V = 4096, CH = CH_REC + CH_V, NPC = 25;
    constexpr int YB_LD = 68, YB_WAVE = 16 * YB_LD * 4;
    PG8_LAS float* yb = (PG8_LAS float*)(lds + 2 * CH + wid * YB_WAVE);
    const int bh = j >> 1, hf32 = j & 1, b = bh >> 3, h = bh & 7;
    const int irow = hf32 * 32 + wid * 4 + rr;
    const char* grec = REC + (size_t)bh * NCH * G_REC; const char* gv = RVT + (size_t)bh * NCH * CH_V;
    float S0 = 0.f, S1 = 0.f, S2 = 0.f, S3 = 0.f;
    asm volatile("s_waitcnt vmcnt(0) lgkmcnt(0)" ::: "memory"); __builtin_amdgcn_s_barrier(); asm volatile("" ::: "memory");
#define SCAN_DMA(chn, bufo) do { _Pragma("unroll") for (int k_ = 0; k_ < 4; ++k_) { const int pc_ = wid * 4 + k_; if (pc_ < NPC) { \
        const char* src_ = (pc_ < 21) ? grec + (size_t)(chn) * G_REC + pc_ * 1024 + lane * 16 : gv + (size_t)(chn) * CH_V + (pc_ - 21) * 1024 + lane * 16; \
        __builtin_amdgcn_global_load_lds((const unsigned*)src_, (PG8_LAS unsigned*)(lds + (bufo) + pc_ * 1024), 16, 0, 0); } } } while (0)
    SCAN_DMA(0, 0);
    for (int ch = 0; ch < NCH; ++ch) {
        asm volatile("s_waitcnt vmcnt(0) lgkmcnt(0)" ::: "memory"); __builtin_amdgcn_s_barrier(); asm volatile("" ::: "memory");
        if (ch + 1 < NCH) SCAN_DMA(ch + 1, ((ch + 1) & 1) * CH);
        PG8_LAS const unsigned char* bufp = lds + (ch & 1) * CH;
#define SCAN_LOADW(WA, WB, grp) do { PG8_LAS const unsigned char* rp_ = bufp + (grp) * (REC_TG * 4) + jq * 160 + (jq >> 3) * 16; _Pragma("unroll") for (int k_ = 0; k_ < 5; ++k_) { \
        const pg8::u32x4 q_ = *(PG8_LAS const pg8::u32x4*)(rp_ + 16 * k_), q2_ = *(PG8_LAS const pg8::u32x4*)(rp_ + 80 + 16 * k_); \
        WA[4 * k_] = q_.x; WA[4 * k_ + 1] = q_.y; WA[4 * k_ + 2] = q_.z; WA[4 * k_ + 3] = q_.w; WB[4 * k_] = q2_.x; WB[4 * k_ + 1] = q2_.y; WB[4 * k_ + 2] = q2_.z; WB[4 * k_ + 3] = q2_.w; } } while (0)
#define SCAN_STEPS(WA, WB, hf) do { _Pragma("unroll") for (int ts = 0; ts < 4; ++ts) { \
        const unsigned uA = WA[ts * 5], aA = WA[ts * 5 + 1], bA = WA[ts * 5 + 2], kA = WA[ts * 5 + 3], rA = WA[ts * 5 + 4]; \
        const unsigned uB = WB[ts * 5], aB = WB[ts * 5 + 1], bB = WB[ts * 5 + 2], kB = WB[ts * 5 + 3], rB = WB[ts * 5 + 4]; \
        const unsigned vw = vv[(hf) * 2 + (ts >> 1)]; \
        const float sa = red16(fmix_hi(S3, aB, fmix_lo(S2, aB, fmix_hi(S1, aA, fmul_lo(S0, aA))))); \
        float t0 = fdec_lo(S0, uA), t1 = fdec_hi(S1, uA), t2 = fdec_lo(S2, uB), t3 = fdec_hi(S3, uB); \
        if (ts & 1) { t0 = fvk_lo<1>(vw, kA, t0); t1 = fvk_hi<1>(vw, kA, t1); t2 = fvk_lo<1>(vw, kB, t2); t3 = fvk_hi<1>(vw, kB, t3); } \
        else { t0 = fvk_lo<0>(vw, kA, t0); t1 = fvk_hi<0>(vw, kA, t1); t2 = fvk_lo<0>(vw, kB, t2); t3 = fvk_hi<0>(vw, kB, t3); } \
        S0 = fmix_lo(sa, bA, t0); S1 = fmix_hi(sa, bA, t1); S2 = fmix_lo(sa, bB, t2); S3 = fmix_hi(sa, bB, t3); \
        yb[((g8 & 1) * 8 + (hf) * 4 + ts) * YB_LD + rr * 16 + jq] = fmix_hi(S3, rB, fmix_lo(S2, rB, fmix_hi(S1, rA, fmul_lo(S0, rA)))); } } while (0)
        unsigned wA0[20], wB0[20], wA1[20], wB1[20];
        SCAN_LOADW(wA0, wB0, 0);
#pragma unroll 1
        for (int g8 = 0; g8 < 4; ++g8) {
            const pg8::u32x4 vv = *(PG8_LAS const pg8::u32x4*)(bufp + CH_REC + (g8 * 64 + irow) * 16);
            SCAN_LOADW(wA1, wB1, g8 * 2 + 1);
            SCAN_STEPS(wA0, wB0, 0);
            if (g8 < 3) SCAN_LOADW(wA0, wB0, g8 * 2 + 2);
            SCAN_STEPS(wA1, wB1, 1);
            if (g8 & 1) {
                asm volatile("s_waitcnt lgkmcnt(0)" ::: "memory");
                PG8_LAS const float* yp = yb + jq * YB_LD + rr * 16;
                const pg8::f32x4 y0 = *(PG8_LAS const pg8::f32x4*)(yp), y1 = *(PG8_LAS const pg8::f32x4*)(yp + 4), y2 = *(PG8_LAS const pg8::f32x4*)(yp + 8), y3 = *(PG8_LAS const pg8::f32x4*)(yp + 12);
                const pg8::f32x4 ys = (y0 + y1) + (y2 + y3);
                const float y = (ys[0] + ys[1]) + (ys[2] + ys[3]);
                const int t = ch * CSTEPS + (g8 >> 1) * 16 + jq;
                YR[((size_t)b * SEQ + t) * 512 + h * 64 + irow] = f2bf(y);
                asm volatile("s_waitcnt lgkmcnt(0)" ::: "memory");
            }
        }
#undef SCAN_LOADW
#undef SCAN_STEPS
    }
#undef SCAN_DMA
}
__device__ __forceinline__ void phase_scan_att2(const Args& a, int l, PG8_LAS unsigned char* lds) {
    const int bx = blockIdx.x;
    const int j = (bx & 7) * 16 + (bx >> 4);
    if (((bx >> 3) & 1) == 0) scan32(a, l, j, lds);
    else {
        const int bh = j >> 1, b = bh >> 3, h = bh & 7;
#pragma unroll 1
        for (int q = 0; q < 2; ++q) { const int s = 2 * (j & 1) + q; att::unit(a, l, b, h, 7 - s, lds); att::unit(a, l, b, h, s, lds); }
        __syncthreads();
        const int tid = tid_fresh(), lane = tid & 63, wid = tid >> 6;
        float* scr = (float*)((unsigned char*)lds) + wid * (64 * 33);
        CvtItem c0, c1; float4 v0[8], v1[8];
        int it = j * 8 + wid; const int NCW = 128 * 8;
        bool h0 = cvt_decode(a, l, it, c0); if (h0) cvt_load(c0, lane, v0);
        while (h0) {
            const bool h1 = cvt_decode(a, l, it + NCW, c1); if (h1) cvt_load(c1, lane, v1);
            cvt_finish(c0, lane, v0, scr);
            it += 2 * NCW;
            h0 = h1 && cvt_decode(a, l, it, c0); if (h0) cvt_load(c0, lane, v0);
            if (h1) cvt_finish(c1, lane, v1, scr);
        }
    }
}

__device__ __forceinline__ void phase_scan2_att(const Args& a, int l, PG8_LAS unsigned char* lds, const int parts = 7) {
    const int G = gridDim.x, bx = blockIdx.x;
    const int v = (G % 8 == 0) ? (bx % 8) * (G / 8) + bx / 8 : bx;
    int k0 = (parts & 4) ? 0 : 96;
    if (parts & 1) for (int u = v; u < 256; u += G) k0 = scan2_unit(a, l, u, lds, k0, (parts >> 3) & 3);
    if (parts & 2) for (int w = v; w < 256; w += G) { const int bh = w >> 2, s = w & 3; att::unit(a, l, bh >> 3, bh & 7, 7 - s, lds); att::unit(a, l, bh >> 3, bh & 7, s, lds); }
    if (k0 >= 96) return;
    __syncthreads();
    const int tid = tid_fresh(), lane = tid & 63, wid = tid >> 6;
    float* scr = (float*)((unsigned char*)lds) + wid * (64 * 33);
    CvtItem c0, c1; float4 v0[8], v1[8];
    int k = k0 + wid;
#define P3_IT(k_) (bx * 8 + ((k_) & 7) + G * 8 * ((k_) >> 3))
    bool h0 = k < 96 && cvt_decode(a, l, P3_IT(k), c0); if (h0) cvt_load(c0, lane, v0);
    while (h0) {
        const bool h1 = k + 8 < 96 && cvt_decode(a, l, P3_IT(k + 8), c1); if (h1) cvt_load(c1, lane, v1);
        cvt_finish(c0, lane, v0, scr);
        k += 16;
        h0 = h1 && k < 96 && cvt_decode(a, l, P3_IT(k), c0); if (h0) cvt_load(c0, lane, v0);
        if (h1) cvt_finish(c1, lane, v1, scr);
    }
#undef P3_IT
}

__device__ __forceinline__ void phase_dense_res(const void* A, const void* WT, const float* RES, const bf16_t* RESB, bf16_t* OUT, PG8_LAS unsigned char* lds) {
    pg8::DenseSched S; S.init(A, DM, NTOK, WT, DM, DM);
    pg8::EpiBf16Res E{OUT, RES, DM, ALPHA, RESB};
    pg8::gemm_phase<pg8::EpiBf16Res, pg8::DenseSched, false>(lds, pg8::Dims{DM, DM, DM}, S, E);
}
__device__ __forceinline__ void phase_dense_bf16(const void* A, int M, const void* WT, int N, bf16_t* OUT, PG8_LAS unsigned char* lds) {
    pg8::DenseSched S; S.init(A, DM, M, WT, DM, N);
    pg8::EpiBf16 E{OUT, N};
    pg8::gemm_phase<pg8::EpiBf16, pg8::DenseSched, false>(lds, pg8::Dims{DM, DM, DM}, S, E);
}

__device__ __forceinline__ void phase_q_s_pv(const Args& a, int l, PG8_LAS unsigned char* lds) {
    {
        pg8::GroupSched S; S.init(a.ws + WS_X1B, DM, a.ws + WS_WQ + (size_t)l * 2 * MiB, DM);
        pg8::EpiBf16 E{(bf16_t*)(a.ws + WS_Q), DM};
        pg8::gemm_phase<pg8::EpiBf16, pg8::GroupSched, false>(lds, pg8::Dims{DM, DM, DM}, S, E);
    }
    asm volatile("s_waitcnt vmcnt(0)" ::: "memory"); __syncthreads();
    phase_matt_s(a, lds);
    asm volatile("s_waitcnt vmcnt(0)" ::: "memory"); __syncthreads();
    phase_matt_pv(a, lds);
}

__device__ __forceinline__ void ln_load(const bf16_t* in, int lane, uint2 (&raw)[4]) {
#pragma unroll
    for (int m = 0; m < 4; ++m) raw[m] = *(const uint2*)(in + m * 256 + lane * 4);
}
__device__ __forceinline__ void ln_calc(const uint2 (&raw)[4], const float* g, const float* bta, float* out, bf16_t* outb, int lane, float (&xn)[16]) {
    float x[16];
#pragma unroll
    for (int m = 0; m < 4; ++m) { const uint2 v = raw[m]; x[m * 4] = bflo(v.x); x[m * 4 + 1] = bfhi(v.x); x[m * 4 + 2] = bflo(v.y); x[m * 4 + 3] = bfhi(v.y); }
    float s = 0.f;
#pragma unroll
    for (int k = 0; k < 16; ++k) s += x[k];
    const float mean = wsum(s) * (1.0f / 1024.0f);
    float q = 0.f;
#pragma unroll
    for (int k = 0; k < 16; ++k) { const float d = x[k] - mean; q = fmaf(d, d, q); }
    const float var = wsum(q) * (1.0f / 1024.0f);
    const float rstd = rsqrtf(var + 1e-5f);
#pragma unroll
    for (int m = 0; m < 4; ++m) {
        const float4 gv = *(const float4*)(g + m * 256 + lane * 4), bv = *(const float4*)(bta + m * 256 + lane * 4);
        float4 o;
        o.x = (x[m * 4] - mean) * rstd * gv.x + bv.x; o.y = (x[m * 4 + 1] - mean) * rstd * gv.y + bv.y;
        o.z = (x[m * 4 + 2] - mean) * rstd * gv.z + bv.z; o.w = (x[m * 4 + 3] - mean) * rstd * gv.w + bv.w;
        xn[m * 4] = o.x; xn[m * 4 + 1] = o.y; xn[m * 4 + 2] = o.z; xn[m * 4 + 3] = o.w;
        if (out) *(float4*)(out + m * 256 + lane * 4) = o;
        uint2 ob; ob.x = pk2(o.x, o.y); ob.y = pk2(o.z, o.w); *(uint2*)(outb + m * 256 + lane * 4) = ob;
    }
}
__device__ __forceinline__ void ln_row(const bf16_t* in, const float* g, const float* bta, float* out, bf16_t* outb, int lane, float (&xn)[16]) {
    uint2 raw[4]; ln_load(in, lane, raw); ln_calc(raw, g, bta, out, outb, lane, xn);
}
__device__ __forceinline__ void phase_ln(const bf16_t* IN, const float* g, const float* bta, float* OUT, bf16_t* OUTB) {
    const int tid = tid_fresh(), lane = tid & 63, wid = tid >> 6;
    const int RS = gridDim.x * 8;
    int row = blockIdx.x * 8 + wid;
    uint2 rA[4], rB[4]; float xn[16];
    if (row < NTOK) ln_load(IN + (size_t)row * DM, lane, rA);
    while (row < NTOK) {
        const int r1 = row + RS; const bool h1 = r1 < NTOK;
        if (h1) ln_load(IN + (size_t)r1 * DM, lane, rB);
        ln_calc(rA, g, bta, OUT ? OUT + (size_t)row * DM : (float*)nullptr, OUTB + (size_t)row * DM, lane, xn);
        row = r1 + RS;
        if (!h1) break;
        if (row < NTOK) ln_load(IN + (size_t)row * DM, lane, rA);
        ln_calc(rB, g, bta, OUT ? OUT + (size_t)r1 * DM : (float*)nullptr, OUTB + (size_t)r1 * DM, lane, xn);
    }
}

__device__ __forceinline__ float treduce32(float (&p)[32], int lane) {
    float q[16], r[8], s4[4], t2[2];
#pragma unroll
    for (int i = 0; i < 16; ++i) { auto sw = __builtin_amdgcn_permlane32_swap(__float_as_uint(p[i]), __float_as_uint(p[i + 16]), false, false); q[i] = __uint_as_float(sw[0]) + __uint_as_float(sw[1]); }
    const bool L4 = (lane & 16) != 0, L3 = (lane & 8) != 0, L2 = (lane & 4) != 0, L1 = (lane & 2) != 0;
#pragma unroll
    for (int i = 0; i < 8; ++i) { const float snd = L4 ? q[i] : q[i + 8], keep = L4 ? q[i + 8] : q[i]; r[i] = keep + __shfl_xor(snd, 16); }
#pragma unroll
    for (int i = 0; i < 4; ++i) { const float snd = L3 ? r[i] : r[i + 4], keep = L3 ? r[i + 4] : r[i]; s4[i] = keep + SC_DPP(snd, 0x140); }
#pragma unroll
    for (int i = 0; i < 2; ++i) { const float snd = L2 ? s4[i] : s4[i + 2], keep = L2 ? s4[i + 2] : s4[i]; t2[i] = keep + SC_DPP(snd, 0x141); }
    const float snd = L1 ? t2[0] : t2[1], keep = L1 ? t2[1] : t2[0];
    float u = keep + SC_DPP(snd, 0x4E);
    u += SC_DPP(u, 0xB1);
    return __shfl(u, (lane & 31) * 2);
}
struct RouteRes { int e0, e1; float g0, g1; };
__device__ __forceinline__ RouteRes route_row(float mylogit, int lane, const float* BR) {
    const float s = sigmoidf_(mylogit);
    const float sel = (lane < 32) ? s + BR[lane & 31] : NEG_INF;
    const int gb = lane & ~3;
    const float v0 = __shfl(sel, gb), v1 = __shfl(sel, gb + 1), v2 = __shfl(sel, gb + 2), v3 = __shfl(sel, gb + 3);
    const float m1 = fmaxf(fmaxf(v0, v1), fmaxf(v2, v3));
    float m2;
    { const float lo01 = fminf(v0, v1), hi01 = fmaxf(v0, v1), lo23 = fminf(v2, v3), hi23 = fmaxf(v2, v3);
      m2 = fmaxf(fminf(hi01, hi23), fmaxf(lo01, lo23)); }
    float gs = (lane < 32) ? (m1 + m2) : NEG_INF;
    int gi = lane >> 2;
#pragma unroll
    for (int o = 32; o > 0; o >>= 1) { const float ov = __shfl_xor(gs, o); const int oi = __shfl_xor(gi, o); if (ov > gs || (ov == gs && oi < gi)) { gs = ov; gi = oi; } }
    const int gbest = gi;
    const float c0 = __shfl(sel, gbest * 4), c1 = __shfl(sel, gbest * 4 + 1), c2 = __shfl(sel, gbest * 4 + 2), c3 = __shfl(sel, gbest * 4 + 3);
    int j0 = 0; float b0 = c0;
    if (c1 > b0) { b0 = c1; j0 = 1; } if (c2 > b0) { b0 = c2; j0 = 2; } if (c3 > b0) { b0 = c3; j0 = 3; }
    int j1 = -1; float b1 = -3e38f;
    if (j0 != 0 && c0 > b1) { b1 = c0; j1 = 0; } if (j0 != 1 && c1 > b1) { b1 = c1; j1 = 1; } if (j0 != 2 && c2 > b1) { b1 = c2; j1 = 2; } if (j0 != 3 && c3 > b1) { b1 = c3; j1 = 3; }
    RouteRes R; R.e0 = gbest * 4 + j0; R.e1 = gbest * 4 + j1;
    const float s0 = __shfl(s, R.e0), s1 = __shfl(s, R.e1);
    const float inv = 1.0f / (s0 + s1);
    R.g0 = s0 * inv; R.g1 = s1 * inv;
    return R;
}
__device__ __forceinline__ void phase_ln2_router(const Args& a, int l, float* lds, bool dummy = false) {
    const int tid = tid_fresh(), lane = tid & 63, wid = tid >> 6;
    const bf16_t* PRE = (const bf16_t*)(a.ws + WS_PRE2);
    bf16_t* X2B = (bf16_t*)(a.ws + WS_X2B);
    const float* g = a.in[28] + (size_t)(l * 3 + 1) * DM; const float* bta = a.in[29] + (size_t)(l * 3 + 1) * DM;
    const float* WR = a.in[23]; const float* BR = a.in[24];
    unsigned* cnt = (unsigned*)(a.ws + WS_CTL) + CW_CNT + l * 32 + (dummy ? 128 : 0);
    int2* list = (int2*)(a.ws + (dummy ? WS_H : WS_LIST));
    int2* tokpos = (int2*)(a.ws + (dummy ? WS_H + 8 * MiB : WS_TOKPOS));
    float2* tokgate = (float2*)(a.ws + (dummy ? WS_H + 9 * MiB : WS_TOKGATE));
    constexpr int WR_LD = DM + 4;
    unsigned* lcnt = (unsigned*)(lds + NEXP * WR_LD);
    int* lres = (int*)(lds + NEXP * WR_LD + 64);
    __syncthreads();
    {
        float4 wv[16];
#pragma unroll
        for (int q = 0; q < 16; ++q) wv[q] = *(const float4*)(WR + (size_t)(q * NTHREADS + tid) * 4);
#pragma unroll
        for (int q = 0; q < 16; ++q) { const int idx = (q * NTHREADS + tid) * 4, k = idx >> 5, e = idx & 31;
            lds[e * WR_LD + k] = wv[q].x; lds[(e + 1) * WR_LD + k] = wv[q].y; lds[(e + 2) * WR_LD + k] = wv[q].z; lds[(e + 3) * WR_LD + k] = wv[q].w; }
    }
    if (tid < 64) lcnt[tid] = 0u;
    __syncthreads();
    int nloc = 0;
    uint2 rwa[4], rwb[4];
    { const int row0 = (blockIdx.x * 8 + wid) * 2; if (row0 < NTOK) { ln_load(PRE + (size_t)row0 * DM, lane, rwa); ln_load(PRE + (size_t)(row0 + 1) * DM, lane, rwb); } }
    for (int row = (blockIdx.x * 8 + wid) * 2; row < NTOK; row += gridDim.x * 16) {
        float xa[16], xb[16];
        ln_calc(rwa, g, bta, (float*)nullptr, X2B + (size_t)row * DM, lane, xa);
        ln_calc(rwb, g, bta, (float*)nullptr, X2B + (size_t)(row + 1) * DM, lane, xb);
        { const int rn = row + gridDim.x * 16; if (rn < NTOK) { ln_load(PRE + (size_t)rn * DM, lane, rwa); ln_load(PRE + (size_t)(rn + 1) * DM, lane, rwb); } }
        float pa[32], pb[32];
        {
            float4 wq[2][4];
#pragma unroll
            for (int m = 0; m < 4; ++m) wq[0][m] = *(const float4*)&lds[m * 256 + lane * 4];
#pragma unroll
            for (int e = 0; e < NEXP; ++e) {
                if (e + 1 < NEXP) {
#pragma unroll
                    for (int m = 0; m < 4; ++m) wq[(e + 1) & 1][m] = *(const float4*)&lds[(e + 1) * WR_LD + m * 256 + lane * 4];
                }
                float sa_ = 0.f, sb_ = 0.f, sc_ = 0.f, sd_ = 0.f;
#pragma unroll
                for (int m = 0; m < 4; ++m) { const float4 wv = wq[e & 1][m];
                    sa_ = fmaf(xa[m * 4], wv.x, sa_); sc_ = fmaf(xa[m * 4 + 1], wv.y, sc_); sa_ = fmaf(xa[m * 4 + 2], wv.z, sa_); sc_ = fmaf(xa[m * 4 + 3], wv.w, sc_);
                    sb_ = fmaf(xb[m * 4], wv.x, sb_); sd_ = fmaf(xb[m * 4 + 1], wv.y, sd_); sb_ = fmaf(xb[m * 4 + 2], wv.z, sb_); sd_ = fmaf(xb[m * 4 + 3], wv.w, sd_); }
                pa[e] = sa_ + sc_; pb[e] = sb_ + sd_;
                asm volatile("" ::: "memory");
            }
        }
        const float la = treduce32(pa, lane), lb = treduce32(pb, lane);
#pragma unroll
        for (int q = 0; q < 2; ++q) {
            const RouteRes R = route_row(q ? lb : la, lane, BR);
            if (lane == 0) {
                const unsigned r0 = atomicAdd(&lcnt[R.e0], 1u), r1 = atomicAdd(&lcnt[R.e1], 1u);
                int* o = lres + (wid * 32 + nloc + q) * 8;
                o[0] = row + q; o[1] = R.e0; o[2] = R.e1; o[3] = (int)r0; o[4] = (int)r1; o[5] = __float_as_int(R.g0); o[6] = __float_as_int(R.g1);
            }
        }
        nloc += 2;
    }
    __syncthreads();
    if (tid < 32) lcnt[32 + tid] = atomicAdd(&cnt[tid], lcnt[tid]);
    __syncthreads();
    for (int i = lane; i < nloc; i += 64) {
        const int* o = lres + (wid * 32 + i) * 8;
        const int row = o[0], e0 = o[1], e1 = o[2]; const unsigned r0 = lcnt[32 + e0] + (unsigned)o[3], r1 = lcnt[32 + e1] + (unsigned)o[4];
        list[(size_t)e0 * LCAP + r0] = make_int2(row, o[5]);
        list[(size_t)e1 * LCAP + r1] = make_int2(row, o[6]);
        tokpos[row * 2] = make_int2(e0, (int)r0); tokpos[row * 2 + 1] = make_int2(e1, (int)r1);
        tokgate[row] = make_float2(__int_as_float(o[5]), __int_as_float(o[6]));
    }
}

constexpr int ZERO_ROW = 32768 / 2048;
struct I2 { int x, y; };
struct MoeSched {
    int G, c, T, npn; PG8_LAS I2* tab;
    const char* A; const char* B; size_t b_e, b_pn, a_tile; int colw;
    const int2* list; int gat_row0;
    __device__ void init(PG8_LAS unsigned char* lds, const unsigned* cnt, int npn_, const void* A_, size_t a_tile_, const void* B_, size_t b_e_, size_t b_pn_, int colw_, const int2* list_, int gat_row0_) {
        const int lane = tid_fresh() & 63, x = lane & 31;
        G = gridDim.x; c = blockIdx.x; npn = npn_; A = (const char*)A_; a_tile = a_tile_; B = (const char*)B_; b_e = b_e_; b_pn = b_pn_; colw = colw_; list = list_; gat_row0 = gat_row0_;
        const unsigned cnt_l = __hip_atomic_load(cnt + x, __ATOMIC_RELAXED, __HIP_MEMORY_SCOPE_AGENT);
        const int tiles = (int)((cnt_l + 255u) >> 8);
        int inc = tiles;
#pragma unroll
        for (int o = 1; o < 32; o <<= 1) { const int t = __shfl_up(inc, o, 32); if (x >= o) inc += t; }
        tab = (PG8_LAS I2*)(lds + pg8::STAGE_BYTES + 8192);
        tab[x].x = (int)cnt_l; tab[x].y = inc - tiles;
        T = __builtin_amdgcn_readfirstlane(__shfl(inc, 31));
        __syncthreads();
    }
    __device__ __forceinline__ bool next(int i, pg8::Unit& u) const { return unit_of((long)i * G + c, u); }
    __device__ __forceinline__ bool unit_of(long L, pg8::Unit& u) const {
        if (L >= (long)T * npn) return false;
        const int ti = (int)(L / npn), pn = (int)(L % npn);
        const int my_excl = tab[__builtin_amdgcn_mbcnt_lo(~0u, 0u) & 31].y;
        const unsigned long long m = __ballot(my_excl <= ti) & 0xffffffffull;
        const int e = __popcll(m) - 1;
        const int rt = ti - tab[e].y;
        const unsigned ce = (unsigned)tab[e].x;
        u.aux = __builtin_amdgcn_readfirstlane(e | (rt << 8)); u.aux2 = __builtin_amdgcn_readfirstlane((int)ce);
        u.row0 = ti * 256; u.col0 = pn * colw;
        u.A = A + (size_t)ti * a_tile; u.B = B + (size_t)e * b_e + (size_t)pn * b_pn;
        return true;
    }
    __device__ __forceinline__ int arow(const pg8::Unit& u, int r) const {
        const int e = u.aux & 255, rank = (u.aux >> 8) * 256 + r;
        return rank < u.aux2 ? gat_row0 + list[(size_t)e * LCAP + rank].x : ZERO_ROW;
    }
};
struct EpiSwiGLU {
    static constexpr bool PERM = true;
    bf16_t* H;
    __device__ __forceinline__ void operator()(const pg8::f32x4 (&acc)[2][2][4][2], const pg8::Unit& u, int wr, int wc, int fr, int fq) const {
        const int col = u.col0 + wc * 32 + 8 * fq;
#pragma unroll
        for (int ai = 0; ai < 2; ++ai)
#pragma unroll
            for (int m = 0; m < 4; ++m) {
                const int r = wr * 64 + fr + ai * 128 + m * 16;
                float hv[8];
#pragma unroll
                for (int n = 0; n < 2; ++n)
#pragma unroll
                    for (int j = 0; j < 4; ++j) { const float g = acc[ai][0][m][n][j], up = acc[ai][1][m][n][j]; hv[n * 4 + j] = g * up * __builtin_amdgcn_rcpf(1.0f + __expf(-g)); }
                pg8::u32x4 w; w.x = pk2(hv[0], hv[1]); w.y = pk2(hv[2], hv[3]); w.z = pk2(hv[4], hv[5]); w.w = pk2(hv[6], hv[7]);
                *(pg8::u32x4*)(H + (size_t)(u.row0 + r) * DEXP + col) = w;
            }
    }
};
__device__ __forceinline__ void phase_f3(const Args& a, int l, PG8_LAS unsigned char* lds) {
    const unsigned* cnt = (const unsigned*)(a.ws + WS_CTL) + CW_CNT + l * 32;
    const int2* list = (const int2*)(a.ws + WS_LIST);
    MoeSched S; S.init(lds, cnt, 4, a.ws, 0, a.ws + WS_WEXP, (size_t)1024 * 1024 * 2, (size_t)256 * 1024 * 2, 128, list, (int)(WS_X2B / 2048));
    EpiSwiGLU E{(bf16_t*)(a.ws + WS_H)};
    pg8::gemm_phase<EpiSwiGLU, MoeSched, true>(lds, pg8::Dims{DM, DM, DM}, S, E);
}
__device__ __forceinline__ void phase_f4(const Args& a, int l, PG8_LAS unsigned char* lds) {
    const unsigned* cnt = (const unsigned*)(a.ws + WS_CTL) + CW_CNT + l * 32;
    MoeSched S; S.init(lds, cnt, 4, a.ws + WS_H, (size_t)256 * DEXP * 2, a.ws + WS_WEXP + (size_t)NEXP * 1024 * 1024 * 2, (size_t)1024 * 512 * 2, (size_t)256 * 512 * 2, 256, nullptr, 0);
    pg8::EpiBf16 E{(bf16_t*)(a.ws + WS_Y), DM};
    pg8::gemm_phase<pg8::EpiBf16, MoeSched, false>(lds, pg8::Dims{DEXP, DEXP, DEXP}, S, E);
}
struct MoeListSched {
    MoeSched base; PG8_LAS const int* ul; int n;
    __device__ __forceinline__ bool next(int i, pg8::Unit& u) const { if (i >= n) return false; return base.unit_of((long)ul[i], u); }
    __device__ __forceinline__ int arow(const pg8::Unit& u, int r) const { return base.arow(u, r); }
};
struct F4Plan { int U, nLate, nE, nEarlyUnits, tpr, q, ne; bool plain; };
__device__ __forceinline__ F4Plan f4_plan(int T, int G) {
    F4Plan p; p.U = 4 * T; const int R = (p.U + G - 1) / G; p.nLate = p.U - G * (R - 1); p.nE = G - p.nLate;
    p.plain = (G & 3) || p.nE <= 0 || R < 2;
    p.tpr = G / 4; p.q = p.nLate / 4; p.ne = p.tpr - p.q;
    p.nEarlyUnits = p.plain ? p.U : p.ne * (R - 1) * 4;
    if (p.plain) { p.nLate = G; p.nE = 0; }
    return p;
}
__device__ __forceinline__ int f4_unit(const F4Plan& p, int gidx) {
    if (p.plain) return gidx;
    const int pn = gidx & 3;
    if (gidx < p.nEarlyUnits) { const int e = gidx >> 2, r = e / p.ne, pos = e % p.ne; return ((p.tpr * r + p.q + pos) << 2) | pn; }
    const int e = (gidx - p.nEarlyUnits) >> 2, r = e / p.q, pos = e % p.q;
    return ((p.tpr * r + pos) << 2) | pn;
}
__device__ __forceinline__ void phase_f34(const Args& a, int l, PG8_LAS unsigned char* lds) {
    const unsigned* cnt = (const unsigned*)(a.ws + WS_CTL) + CW_CNT + l * 32;
    unsigned* ctlw = (unsigned*)(a.ws + WS_CTL);
    unsigned* done = ctlw + CW_TILE + l * 256; unsigned* bar = ctlw + CW_BAR;
    const int2* list = (const int2*)(a.ws + WS_LIST);
    int T;
    {
        MoeSched S; S.init(lds, cnt, 4, a.ws, 0, a.ws + WS_WEXP, (size_t)1024 * 1024 * 2, (size_t)256 * 1024 * 2, 128, list, (int)(WS_X2B / 2048));
        EpiSwiGLU E{(bf16_t*)(a.ws + WS_H)};
        pg8::gemm_phase<EpiSwiGLU, MoeSched, true>(lds, pg8::Dims{DM, DM, DM}, S, E);
        T = S.T;
    }
    asm volatile("s_waitcnt vmcnt(0)" ::: "memory");
    __syncthreads();
    if (threadIdx.x == 0) {
        __builtin_amdgcn_fence(__ATOMIC_RELEASE, "agent");
        for (long L = blockIdx.x; L < (long)T * 4; L += gridDim.x) (void)xb_add(&done[L >> 2], 1u);
    }
    MoeListSched S4;
    S4.base.init(lds, cnt, 4, a.ws + WS_H, (size_t)256 * DEXP * 2, a.ws + WS_WEXP + (size_t)NEXP * 1024 * 1024 * 2, (size_t)1024 * 512 * 2, (size_t)256 * 512 * 2, 256, nullptr, 0);
    PG8_LAS int* ul = (PG8_LAS int*)(lds + pg8::STAGE_BYTES + 8192 + 256);
    const F4Plan P = f4_plan(T, (int)gridDim.x);
    if (threadIdx.x == 0) {
        const int c = (int)blockIdx.x; const bool late = c < P.nLate;
        int nj = 0, n1 = 0;
        for (int k = 0; k < 16; ++k) {
            const int gidx = late ? (k + 2) * P.nE + k * P.nLate + c : (k == 0 ? 0 : k * P.nE + (k - 1) * P.nLate) + (c - P.nLate);
            if (gidx >= P.U) break;
            ul[nj++] = f4_unit(P, gidx); if (gidx < P.nEarlyUnits) n1 = nj;
        }
        ul[16] = n1; ul[17] = nj;
    }
    __syncthreads();
    const int n1 = ul[16], nj = ul[17];
    pg8::EpiBf16 E4{(bf16_t*)(a.ws + WS_Y), DM};
#pragma unroll 1
    for (int part = 0; part < 2; ++part) {
        const int j0 = part ? n1 : 0, j1 = part ? nj : n1;
        if (j1 <= j0) continue;
        if (threadIdx.x == 0) { for (int j = j0; j < j1; ++j) { const int tl = ul[j] >> 2; XB_SPIN(xb_ld(&done[tl]) < 4u, bar); } asm volatile("s_waitcnt vmcnt(0)" ::: "memory"); }
        __syncthreads();
        S4.ul = ul + j0; S4.n = j1 - j0;
        pg8::gemm_phase<pg8::EpiBf16, MoeListSched, false>(lds, pg8::Dims{DEXP, DEXP, DEXP}, S4, E4);
        __syncthreads();
    }
}
__device__ __forceinline__ void phase_ln3(const Args& a, int l, float* OUT, bf16_t* OUTB) {
    const int tid = tid_fresh(), lane = tid & 63, wid = tid >> 6;
    const unsigned* cnt = (const unsigned*)(a.ws + WS_CTL) + CW_CNT + l * 32;
    const int2* tokpos = (const int2*)(a.ws + WS_TOKPOS);
    const bf16_t* X2B = (const bf16_t*)(a.ws + WS_X2B); const bf16_t* Y = (const bf16_t*)(a.ws + WS_Y);
    const float* g = a.in[28] + (size_t)(l * 3 + 2) * DM; const float* bta = a.in[29] + (size_t)(l * 3 + 2) * DM;
    int mybase = 0;
    { int acc = 0; for (int x = 0; x < NEXP; ++x) { if (x == lane) mybase = acc; acc += (int)((cnt[x] + 255u) >> 8); } }
    struct TP { int2 p0, p1; float2 tg; };
    struct RowIn { uint2 x[4], y0[4], y1[4]; float2 tg; };
    auto tp_load = [&](int row, TP& t) { t.p0 = tokpos[row * 2]; t.p1 = tokpos[row * 2 + 1]; t.tg = ((const float2*)(a.ws + WS_TOKGATE))[row]; };
    auto row_load = [&](int row, const TP& t, RowIn& r) {
        const size_t h0 = (size_t)__shfl(mybase, t.p0.x) * 256 + t.p0.y, h1 = (size_t)__shfl(mybase, t.p1.x) * 256 + t.p1.y;
        const bf16_t* xr = X2B + (size_t)row * DM; const bf16_t* y0 = Y + h0 * DM; const bf16_t* y1 = Y + h1 * DM;
        r.tg = t.tg;
#pragma unroll
        for (int m = 0; m < 4; ++m) { const int o = m * 256 + lane * 4; r.x[m] = *(const uint2*)(xr + o); r.y0[m] = *(const uint2*)(y0 + o); r.y1[m] = *(const uint2*)(y1 + o); }
    };
    auto row_fin = [&](int row, const RowIn& r) {
        const float2 tg = r.tg;
        float x[16];
#pragma unroll
        for (int m = 0; m < 4; ++m) { const uint2 xb_ = r.x[m]; const float4 xv = make_float4(bflo(xb_.x), bfhi(xb_.x), bflo(xb_.y), bfhi(xb_.y)); const uint2 a0 = r.y0[m], a1 = r.y1[m];
            x[m * 4] = fmaf(ALPHA, xv.x, fmaf(tg.x, bflo(a0.x), tg.y * bflo(a1.x))); x[m * 4 + 1] = fmaf(ALPHA, xv.y, fmaf(tg.x, bfhi(a0.x), tg.y * bfhi(a1.x)));
            x[m * 4 + 2] = fmaf(ALPHA, xv.z, fmaf(tg.x, bflo(a0.y), tg.y * bflo(a1.y))); x[m * 4 + 3] = fmaf(ALPHA, xv.w, fmaf(tg.x, bfhi(a0.y), tg.y * bfhi(a1.y))); }
        float s_ = 0.f;
#pragma unroll
        for (int k = 0; k < 16; ++k) s_ += x[k];
        const float mean = wsum(s_) * (1.0f / 1024.0f);
        float q = 0.f;
#pragma unroll
        for (int k = 0; k < 16; ++k) { const float d = x[k] - mean; q = fmaf(d, d, q); }
        const float rstd = rsqrtf(wsum(q) * (1.0f / 1024.0f) + 1e-5f);
#pragma unroll
        for (int m = 0; m < 4; ++m) { const int o = m * 256 + lane * 4; const float4 gv = *(const float4*)(g + o), bv = *(const float4*)(bta + o); float4 rr;
            rr.x = (x[m * 4] - mean) * rstd * gv.x + bv.x; rr.y = (x[m * 4 + 1] - mean) * rstd * gv.y + bv.y; rr.z = (x[m * 4 + 2] - mean) * rstd * gv.z + bv.z; rr.w = (x[m * 4 + 3] - mean) * rstd * gv.w + bv.w;
            if (OUT) *(float4*)(OUT + (size_t)row * DM + o) = rr;
            if (OUTB) { uint2 ob; ob.x = pk2(rr.x, rr.y); ob.y = pk2(rr.z, rr.w); *(uint2*)(OUTB + (size_t)row * DM + o) = ob; } }
    };
    const int RS = gridDim.x * 8;
    int r = blockIdx.x * 8 + wid;
    TP pA, pB; RowIn iA, iB;
    bool vA = r < NTOK, vB = r + RS < NTOK;
    if (vA) tp_load(r, pA);
    if (vB) tp_load(r + RS, pB);
    if (vA) row_load(r, pA, iA);
    while (vA) {
        if (vB) row_load(r + RS, pB, iB);
        const bool vC = r + 2 * RS < NTOK; if (vC) tp_load(r + 2 * RS, pA);
        row_fin(r, iA);
        if (!vB) break;
        if (vC) row_load(r + 2 * RS, pA, iA);
        const bool vD = r + 3 * RS < NTOK; if (vD) tp_load(r + 3 * RS, pB);
        row_fin(r + RS, iB);
        r += 2 * RS; vA = vC; vB = vD;
    }
}

constexpr int PH_PER_LAYER = 12, N_PHASES = 1 + 2 * PH_PER_LAYER;

__global__ void __launch_bounds__(NTHREADS, 2) mk_fwd(Args a) {
    extern __shared__ __attribute__((aligned(16))) unsigned char smem[];
    float* lds = (float*)smem;
    PG8_LAS unsigned char* lds3 = (PG8_LAS unsigned char*)smem;
    volatile LAS unsigned* xbw = (volatile LAS unsigned*)(smem + LDS_BYTES - 16);
    const int lo = a.ph_lo, hi = a.ph_hi;
    unsigned* ctl = (unsigned*)(a.ws + WS_CTL);
    XcdBarrier bar; bar.bar = ctl + CW_BAR; bar.x = 0; bar.st = xbw;
    if (hi - lo > 1) {
        if (threadIdx.x == 0) { xbw[0] = 0u; xbw[1] = 0u; }
        __syncthreads();
        bar = xcd_barrier_post(ctl + CW_BAR, xbw);
    }
#define IN(k) (lo <= (k) && (k) < hi)
#define SEAM(k) do { if (IN(k) && IN((k) + 1)) xcd_barrier(bar); \
        if (PROBE_T >= 0) { const long long now_ = wall_clock64(); if (PROBE_T == ((k) == 0 ? 99 : ((k) - 1) % PH_PER_LAYER)) { const long long d_ = now_ - t_seam; while (wall_clock64() - now_ < d_) {} t_seam = wall_clock64(); } else t_seam = now_; } } while (0)
    long long t_seam = (PROBE_T >= 0) ? wall_clock64() : 0;
    if (IN(0)) { phase_prologue(a, lds); if (PROBE_REP == 99) { xcd_barrier(bar); phase_prologue(a, lds); } }
    SEAM(0);
#define LAYER_BODY(l) do { \
        const int p0 = 1 + l * PH_PER_LAYER; \
        const float* xin = (l == 0) ? a.in[0] : (const float*)nullptr; const bf16_t* xinb = (l == 0) ? (const bf16_t*)nullptr : (const bf16_t*)(a.ws + WS_XB);     \
        float* xout = (l == 0) ? (float*)nullptr : a.out; \
        if (IN(p0 + 0)) { phase_g1(a, l, lds3); if (PROBE_REP == 0) { xcd_barrier(bar); phase_g1(a, l, lds3); } } \
        SEAM(p0 + 0); \
        if (IN(p0 + 1)) { phase_prep(a, l, lds); if (PROBE_REP == 1) { xcd_barrier(bar); phase_prep(a, l, lds); } } \
        SEAM(p0 + 1); \
        if (IN(p0 + 2)) { phase_prep2(a, lds); if (PROBE_REP == 2) { xcd_barrier(bar); phase_prep2(a, lds, true); } } \
        SEAM(p0 + 2); \
        if (IN(p0 + 3)) { phase_scan2_att(a, l, lds3); if (PROBE_REP == 3) { xcd_barrier(bar); phase_scan2_att(a, l, lds3); } if (PROBE_REP >= 31 && PROBE_REP <= 37) { xcd_barrier(bar); phase_scan2_att(a, l, lds3, PROBE_REP - 30); } if (PROBE_REP == 41 || PROBE_REP == 42) { xcd_barrier(bar); phase_scan2_att(a, l, lds3, 1 + 8 * (PROBE_REP - 40)); } } \
        SEAM(p0 + 3); \
        if (IN(p0 + 4)) { phase_post(a, l); if (PROBE_REP == 4) { xcd_barrier(bar); phase_post(a, l); } } \
        SEAM(p0 + 4); \
        if (IN(p0 + 5)) { phase_dense_res(a.ws + WS_MIX, a.ws + WS_WOUT + (size_t)l * 2 * MiB, xin, xinb, (bf16_t*)(a.ws + WS_PRE), lds3); if (PROBE_REP == 5) { xcd_barrier(bar); phase_dense_res(a.ws + WS_MIX, a.ws + WS_WOUT + (size_t)l * 2 * MiB, xin, xinb, (bf16_t*)(a.ws + WS_PRE), lds3); } } \
        SEAM(p0 + 5); \
        if (IN(p0 + 6)) { phase_ln((const bf16_t*)(a.ws + WS_PRE), a.in[28] + (size_t)(l * 3) * DM, a.in[29] + (size_t)(l * 3) * DM, (float*)nullptr, (bf16_t*)(a.ws + WS_X1B)); if (PROBE_REP == 6) { xcd_barrier(bar); phase_ln((const bf16_t*)(a.ws + WS_PRE), a.in[28] + (size_t)(l * 3) * DM, a.in[29] + (size_t)(l * 3) * DM, (float*)nullptr, (bf16_t*)(a.ws + WS_X1B)); } } \
        SEAM(p0 + 6); \
        if (IN(p0 + 7)) { phase_q_s_pv(a, l, lds3); } \
        SEAM(p0 + 7); \
        if (IN(p0 + 8)) { phase_dense_res(a.ws + WS_O, a.ws + WS_WO + (size_t)l * 2 * MiB, (const float*)nullptr, (const bf16_t*)(a.ws + WS_X1B), (bf16_t*)(a.ws + WS_PRE2), lds3); if (PROBE_REP == 8) { xcd_barrier(bar); phase_dense_res(a.ws + WS_O, a.ws + WS_WO + (size_t)l * 2 * MiB, (const float*)nullptr, (const bf16_t*)(a.ws + WS_X1B), (bf16_t*)(a.ws + WS_PRE2), lds3); } } \
        SEAM(p0 + 8); \
        if (IN(p0 + 9)) { phase_ln2_router(a, l, lds); if (PROBE_REP == 9) { xcd_barrier(bar); phase_ln2_router(a, l, lds, true); } } \
        SEAM(p0 + 9); \
        if (IN(p0 + 10)) { phase_f34(a, l, lds3); } \
        SEAM(p0 + 10); \
        if (IN(p0 + 11)) { { phase_ln3(a, l, xout, (l == 0) ? (bf16_t*)(a.ws + WS_XB) : (bf16_t*)nullptr); } if (PROBE_REP == 11) { xcd_barrier(bar); { phase_ln3(a, l, xout, (l == 0) ? (bf16_t*)(a.ws + WS_XB) : (bf16_t*)nullptr); } } } \
        SEAM(p0 + 11); \
    } while (0)
    LAYER_BODY(0);
    LAYER_BODY(1);
}
}

extern "C" void kernel_launch(void* const* d_in, const int* in_sizes, int n_in, void* d_out, int out_size, void* d_ws, size_t ws_size, hipStream_t stream) {
    static int grid = 0;
    if (!grid) {
        int dev = 0, cus = 0, per_cu = 0;
        (void)hipGetDevice(&dev);
        (void)hipDeviceGetAttribute(&cus, hipDeviceAttributeMultiprocessorCount, dev);
        (void)hipFuncSetAttribute((const void*)mk_fwd, hipFuncAttributeMaxDynamicSharedMemorySize, LDS_BYTES);
        (void)hipOccupancyMaxActiveBlocksPerMultiprocessor(&per_cu, mk_fwd, NTHREADS, LDS_BYTES);
        (void)hipGetLastError();
        grid = cus * 1;
        if (grid != 256) grid = 256;
    }
    if (ws_size < WS_END) return;
    (void)hipMemsetAsync(d_ws, 0, CTL_ZERO_BYTES, stream);
    Args a;
    memset(&a, 0, sizeof(a));
    for (int i = 0; i < 30; ++i) a.in[i] = (const float*)d_in[i];
    a.out = (float*)d_out; a.ws = (unsigned char*)d_ws;
#if MK_ONE_LAUNCH
    a.ph_lo = 0; a.ph_hi = N_PHASES;
    hipLaunchKernelGGL(mk_fwd, dim3(grid), dim3(NTHREADS), LDS_BYTES, stream, a);
#else
    for (int p = 0; p < N_PHASES; ++p) {
        a.ph_lo = p; a.ph_hi = p + 1;
        hipLaunchKernelGGL(mk_fwd, dim3(grid), dim3(NTHREADS), LDS_BYTES, stream, a);
    }
#endif
}
```
